# Optimizing an MI355X kernel written in HIP

```python
import math
import jax, jax.numpy as jnp
from jax import lax
import numpy as np

D_MODEL = 1024
BATCH = 8
SEQ = 4096
DEPTH = 1

D_MIX = D_MODEL
D_CONV = D_MIX // 2
D_RNN = D_MIX - D_CONV
N_RNN_HEADS = 8
RNN_HEAD_DIM = D_RNN // N_RNN_HEADS
CONV_WIDTH = 31
RNN_CONV_WIDTH = 4
RG_C = 8.0
D_FF = ((8 * D_MODEL // 3 + 127) // 128) * 128
N_SUBLAYERS = 3
MACARON_W = 0.5
EPS = 1e-6

kernel_name = "hymba_style_conformer_rglru_macaron_adaln_block"


def rmsnorm(x, g):
    xf = x.astype(jnp.float32)
    y = xf * lax.rsqrt(jnp.mean(xf * xf, axis=-1, keepdims=True) + EPS)
    return y.astype(x.dtype) * g


def layernorm(x, g, b):
    xf = x.astype(jnp.float32)
    mu = jnp.mean(xf, axis=-1, keepdims=True)
    var = jnp.mean(jnp.square(xf - mu), axis=-1, keepdims=True)
    y = (xf - mu) * lax.rsqrt(var + EPS)
    return y.astype(x.dtype) * g + b


def ada_rmsnorm(x, g, shift, scale):
    return rmsnorm(x, g) * (1.0 + scale[:, None, :]) + shift[:, None, :]


def causal_depthwise_conv(u, w, b):
    k = w.shape[0]
    y = lax.conv_general_dilated(
        u, w[:, None, :], window_strides=(1,), padding=[(k - 1, 0)],
        dimension_numbers=("NWC", "WIO", "NWC"), feature_group_count=u.shape[-1])
    return y + b


def swiglu_ffn(h, w_in, w_out):
    gate, up = jnp.split(h @ w_in, 2, axis=-1)
    return (jax.nn.silu(gate) * up) @ w_out


def conformer_conv_group(u_val, u_gate, conv_w, conv_b, ln_g, ln_b):
    u = u_val * jax.nn.sigmoid(u_gate)
    u = causal_depthwise_conv(u, conv_w, conv_b)
    u = layernorm(u, ln_g, ln_b)
    return jax.nn.silu(u)


def _lru_combine(left, right):
    a_l, b_l = left
    a_r, b_r = right
    return a_l * a_r, a_r * b_l + b_r


def rglru_group(u_x, u_y, conv_w, conv_b, w_a, b_a, w_i, b_i, lru_lambda):
    bsz, seq, _ = u_x.shape
    xr = causal_depthwise_conv(u_x, conv_w, conv_b)
    xh = xr.reshape(bsz, seq, N_RNN_HEADS, RNN_HEAD_DIM)
    r = jax.nn.sigmoid(jnp.einsum("bshd,hde->bshe", xh, w_a).reshape(bsz, seq, D_RNN) + b_a)
    i = jax.nn.sigmoid(jnp.einsum("bshd,hde->bshe", xh, w_i).reshape(bsz, seq, D_RNN) + b_i)
    log_a = RG_C * r.astype(jnp.float32) * jax.nn.log_sigmoid(lru_lambda.astype(jnp.float32))
    a = jnp.exp(log_a)
    mult = jnp.sqrt(-jnp.expm1(2.0 * log_a))
    bterm = mult * (i.astype(jnp.float32) * xr.astype(jnp.float32))
    _, h = lax.associative_scan(_lru_combine, (a, bterm), axis=1)
    return jax.nn.gelu(u_y) * h.astype(u_x.dtype)


def setup_inputs(seed: int = 0) -> dict:
    key = jax.random.key(seed)
    ks = jax.random.split(key, 32)
    f32 = jnp.float32
    L = DEPTH
    nrm = lambda k, shape, s: jax.random.normal(k, shape, f32) * s
    gain = lambda k, shape: 1.0 + 0.05 * jax.random.normal(k, shape, f32)
    a0 = jax.random.uniform(ks[20], (L, D_RNN), f32, 0.9, 0.999)
    s = a0 ** (1.0 / RG_C)
    lru_lambda = jnp.log(s) - jnp.log1p(-s)
    return {
        "x": jax.random.normal(ks[0], (BATCH, SEQ, D_MODEL), f32),
        "c": jax.random.normal(ks[1], (BATCH, D_MODEL), f32),
        "w_mod": nrm(ks[2], (L, D_MODEL, 3 * N_SUBLAYERS * D_MODEL), 0.5 * D_MODEL ** -0.5),
        "b_mod": nrm(ks[3], (L, 3 * N_SUBLAYERS * D_MODEL), 0.02),
        "g_ffn1": gain(ks[4], (L, D_MODEL)),
        "w_ffn1_in": nrm(ks[5], (L, D_MODEL, 2 * D_FF), D_MODEL ** -0.5),
        "w_ffn1_out": nrm(ks[6], (L, D_FF, D_MODEL), D_FF ** -0.5),
        "g_mix": gain(ks[7], (L, D_MODEL)),
        "w_in": nrm(ks[8], (L, D_MODEL, 2 * D_CONV + 2 * D_RNN), D_MODEL ** -0.5),
        "conv_w": nrm(ks[9], (L, CONV_WIDTH, D_CONV), CONV_WIDTH ** -0.5),
        "conv_b": nrm(ks[10], (L, D_CONV), 0.02),
        "ln_g": gain(ks[11], (L, D_CONV)),
        "ln_b": nrm(ks[12], (L, D_CONV), 0.02),
        "rnn_conv_w": nrm(ks[13], (L, RNN_CONV_WIDTH, D_RNN), RNN_CONV_WIDTH ** -0.5),
        "rnn_conv_b": nrm(ks[14], (L, D_RNN), 0.02),
        "w_a": nrm(ks[15], (L, N_RNN_HEADS, RNN_HEAD_DIM, RNN_HEAD_DIM), RNN_HEAD_DIM ** -0.5),
        "b_a": nrm(ks[16], (L, D_RNN), 0.02),
        "w_i": nrm(ks[17], (L, N_RNN_HEADS, RNN_HEAD_DIM, RNN_HEAD_DIM), RNN_HEAD_DIM ** -0.5),
        "b_i": nrm(ks[18], (L, D_RNN), 0.02),
        "lru_lambda": lru_lambda,
        "w_out": nrm(ks[19], (L, D_MIX, D_MODEL), D_MIX ** -0.5),
        "g_ffn2": gain(ks[21], (L, D_MODEL)),
        "w_ffn2_in": nrm(ks[22], (L, D_MODEL, 2 * D_FF), D_MODEL ** -0.5),
        "w_ffn2_out": nrm(ks[23], (L, D_FF, D_MODEL), D_FF ** -0.5),
        "w_fmod": nrm(ks[24], (D_MODEL, 2 * D_MODEL), 0.5 * D_MODEL ** -0.5),
        "b_fmod": nrm(ks[25], (2 * D_MODEL,), 0.02),
        "g_final": gain(ks[26], (D_MODEL,)),
    }


def reference(x, c, w_mod, b_mod, g_ffn1, w_ffn1_in, w_ffn1_out, g_mix, w_in,
              conv_w, conv_b, ln_g, ln_b, rnn_conv_w, rnn_conv_b, w_a, b_a, w_i, b_i,
              lru_lambda, w_out, g_ffn2, w_ffn2_in, w_ffn2_out, w_fmod, b_fmod, g_final):
    c_act = jax.nn.silu(c)
    for l in range(DEPTH):
        mod = c_act @ w_mod[l] + b_mod[l]
        sh1, sc1, gt1, sh2, sc2, gt2, sh3, sc3, gt3 = jnp.split(mod, 3 * N_SUBLAYERS, axis=-1)

        h = ada_rmsnorm(x, g_ffn1[l], sh1, sc1)
        x = x + MACARON_W * gt1[:, None, :] * swiglu_ffn(h, w_ffn1_in[l], w_ffn1_out[l])

        h = ada_rmsnorm(x, g_mix[l], sh2, sc2)
        proj = h @ w_in[l]
        u_val, u_gate, u_x, u_y = jnp.split(
            proj, [D_CONV, 2 * D_CONV, 2 * D_CONV + D_RNN], axis=-1)
        y_conv = conformer_conv_group(u_val, u_gate, conv_w[l], conv_b[l], ln_g[l], ln_b[l])
        y_rnn = rglru_group(u_x, u_y, rnn_conv_w[l], rnn_conv_b[l], w_a[l], b_a[l],
                            w_i[l], b_i[l], lru_lambda[l])
        y_mix = jnp.concatenate([y_conv, y_rnn], axis=-1) @ w_out[l]
        x = x + gt2[:, None, :] * y_mix

        h = ada_rmsnorm(x, g_ffn2[l], sh3, sc3)
        x = x + MACARON_W * gt3[:, None, :] * swiglu_ffn(h, w_ffn2_in[l], w_ffn2_out[l])

    fmod = c_act @ w_fmod + b_fmod
    f_shift, f_scale = jnp.split(fmod, 2, axis=-1)
    return ada_rmsnorm(x, g_final, f_shift, f_scale)
```

```cpp
#include <hip/hip_runtime.h>
#include <cstdio>
#include <cstdint>
namespace pg8 {
#define PG8_LAS __attribute__((address_space(3)))
typedef unsigned short bf16_t;
typedef short bf16x8 __attribute__((ext_vector_type(8)));
typedef float f32x4 __attribute__((ext_vector_type(4)));
typedef unsigned u32x4 __attribute__((ext_vector_type(4)));
constexpr int BM = 256, BK = 64, HALF = 128, HTB = HALF * BK * 2  , STAGE_BYTES = 8 * HTB, NXCD = 8, WGM = 8;

__host__ __device__ __forceinline__ int lds_byte(int r, int c) { const int st = (r >> 4) * 2 + (c >> 5), rr = r & 15, cc = c & 31, ob = rr * 64 + cc * 2; return st * 1024 + (ob ^ (((ob >> 9) & 1) << 5)); }
__host__ __device__ __forceinline__ void stage_rc(int b, int& R, int& C) { const int st = b / 1024, sb = b % 1024, swz = sb ^ (((sb >> 9) & 1) << 5); R = (st >> 1) * 16 + swz / 64; C = (st & 1) * 32 + (swz % 64) / 2; }
__host__ __device__ __forceinline__ int perm32(int rho) { const int n = rho >> 4, i = rho & 15; return 8 * (i >> 2) + 4 * n + (i & 3); }

struct Unit { int pm, pn; };
struct Gemm { const bf16_t* A; const bf16_t* Bt; int M, N, K; };

struct StaticOrder {
    int nM, nN, nwg, G, c;
    __host__ __device__ void init(int M, int N, int G_, int c_) { nM = M / BM; nN = N / BM; nwg = nM * nN; G = G_; c = c_; }
    __host__ __device__ bool next(int i, Unit& u) const {
        const long L = (long)i * G + c; if (L >= nwg) return false;
        int wgid = (int)L; { const int q = nwg / NXCD, r = nwg % NXCD, xcd = wgid % NXCD, off = wgid / NXCD; wgid = (xcd < r ? xcd * (q + 1) : r * (q + 1) + (xcd - r) * q) + off; }
        const int nig = WGM * nN, gid = wgid / nig, fm = gid * WGM, gsz = (nM - fm) < WGM ? (nM - fm) : WGM;
        u.pm = fm + ((wgid % nig) % gsz); u.pn = (wgid % nig) / gsz; return true;
    }
    __device__ __forceinline__ void a_ready(const Unit&) const {}
    __device__ __forceinline__ void done(const Unit&) const {}
};

__device__ __forceinline__ unsigned cvt_pk_bf16(float lo, float hi) { unsigned r; asm volatile("v_cvt_pk_bf16_f32 %0, %1, %2" : "=v"(r) : "v"(lo), "v"(hi)); return r; }
template <class Epi, class Sched, bool ALIGN_EPI = false, bool SP2 = false>
__device__ __forceinline__ void gemm_phase(PG8_LAS unsigned char* lds, const Gemm g, const Sched& S, const Epi& E) {
    const int tid = threadIdx.x, wid = __builtin_amdgcn_readfirstlane(tid >> 6), lane = tid & 63, wr = wid >> 2, wc = wid & 3, fr = lane & 15, fq = lane >> 4;
    const int K = g.K, nt = K / BK;
    unsigned voffA[2], voffB[2];
#pragma unroll
    for (int i = 0; i < 2; ++i) { int R, C; stage_rc(tid * 16 + i * 8192, R, C); const int Rb = Epi::PERM ? ((R & ~31) + perm32(R & 31)) : R;
        voffA[i] = (unsigned)(R * K + C) * 2u; voffB[i] = (unsigned)(Rb * K + C) * 2u; }
    const size_t kstep = (size_t)(BK * 2);
    const size_t hstep = (size_t)HALF * K * 2;
    const size_t tstep = 2 * hstep;
    const unsigned ldsw = (unsigned)wid * 1024u;
    const int aoff = lds_byte(wr * 64 + fr, fq * 8), boff = lds_byte(wc * 32 + fr, fq * 8);
#define PG8_SA(b, h) (((b) * 2 + (h)) * HTB)
#define PG8_SB(b, h) ((4 + (b) * 2 + (h)) * HTB)
#define PG8_STAGE(bufoff, gbase, voff) do { _Pragma("unroll") for (int _i = 0; _i < 2; ++_i) \
        __builtin_amdgcn_global_load_lds((const unsigned*)((const char*)(gbase) + (voff)[_i]), (PG8_LAS unsigned*)(lds + (bufoff) + ldsw + _i * 8192), 16, 0, 0); } while (0)
#define PG8_LDA(dst, b, h) do { _Pragma("unroll") for (int m = 0; m < 4; ++m) _Pragma("unroll") for (int k = 0; k < 2; ++k) dst[m][k] = *(const PG8_LAS bf16x8*)(lds + PG8_SA(b, h) + aoff + m * 2048 + k * 1024); } while (0)
#define PG8_LDB(dst, b, h) do { _Pragma("unroll") for (int n = 0; n < 2; ++n) _Pragma("unroll") for (int k = 0; k < 2; ++k) dst[n][k] = *(const PG8_LAS bf16x8*)(lds + PG8_SB(b, h) + boff + n * 2048 + k * 1024); } while (0)
#define PG8_MMA(ai, bj, At, Bt) do { __builtin_amdgcn_s_setprio(1); _Pragma("unroll") for (int m = 0; m < 4; ++m) _Pragma("unroll") for (int n = 0; n < 2; ++n) _Pragma("unroll") for (int k = 0; k < 2; ++k) \
        acc[ai][bj][m][n] = __builtin_amdgcn_mfma_f32_16x16x32_bf16(Bt[n][k], At[m][k], acc[ai][bj][m][n], 0, 0, 0); __builtin_amdgcn_s_setprio(0); } while (0)
#define PG8_WAIT_V(n) asm volatile("s_waitcnt vmcnt(" #n ")" ::: "memory")
#define PG8_WAIT_L(n) asm volatile("s_waitcnt lgkmcnt(" #n ")" ::: "memory")
#define PG8_BAR __builtin_amdgcn_s_barrier()
#define PG8_SCHED __builtin_amdgcn_sched_barrier(0)
    Unit cur, nxt; int ui = 0;
    if (!S.next(0, cur)) return;
    f32x4 acc[2][2][4][2];
#pragma unroll
    for (int a = 0; a < 2; ++a)
#pragma unroll
        for (int b = 0; b < 2; ++b)
#pragma unroll
            for (int m = 0; m < 4; ++m)
#pragma unroll
                for (int n = 0; n < 2; ++n) acc[a][b][m][n] = (f32x4){0.f, 0.f, 0.f, 0.f};
    bf16x8 At[4][2], B0[2][2], B1[2][2];
    const char* cA = (const char*)g.A + (size_t)cur.pm * tstep; const char* cB = (const char*)g.Bt + (size_t)cur.pn * tstep;
    S.a_ready(cur);
    if constexpr (SP2) {
        PG8_STAGE(PG8_SB(0, 0), cB, voffB); PG8_STAGE(PG8_SB(0, 1), cB + hstep, voffB); PG8_STAGE(PG8_SA(0, 0), cA, voffA); PG8_STAGE(PG8_SA(0, 1), cA + hstep, voffA);
        if (wr == 1) PG8_BAR;
        PG8_WAIT_V(2); PG8_BAR;
        PG8_STAGE(PG8_SB(1, 0), cB + kstep, voffB); PG8_STAGE(PG8_SA(1, 0), cA + kstep, voffA); PG8_STAGE(PG8_SB(1, 1), cB + hstep + kstep, voffB);
        PG8_WAIT_V(6); PG8_BAR;
    } else {
        PG8_STAGE(PG8_SB(0, 0), cB, voffB); PG8_STAGE(PG8_SA(0, 0), cA, voffA); PG8_STAGE(PG8_SB(0, 1), cB + hstep, voffB); PG8_STAGE(PG8_SA(0, 1), cA + hstep, voffA);
        if (wr == 1) PG8_BAR;
        PG8_WAIT_V(4); PG8_BAR;
        PG8_STAGE(PG8_SB(1, 0), cB + kstep, voffB); PG8_STAGE(PG8_SA(1, 0), cA + kstep, voffA); PG8_STAGE(PG8_SB(1, 1), cB + hstep + kstep, voffB);
        PG8_WAIT_V(6); PG8_BAR;
    }
    for (;;) {
        const bool has_next = S.next(ui + 1, nxt);
        const char* nA = has_next ? (const char*)g.A + (size_t)nxt.pm * tstep : cA; const char* nB = has_next ? (const char*)g.Bt + (size_t)nxt.pn * tstep : cB;
        for (int t = 0; t < nt; t += 2) {
            const bool last = (t == nt - 2);
            const char* a1 = cA + (size_t)(t + 1) * kstep;
            const char* a2 = last ? nA : cA + (size_t)(t + 2) * kstep; const char* b2 = last ? nB : cB + (size_t)(t + 2) * kstep;
            const char* a3 = a2 + kstep; const char* b3 = b2 + kstep;
            if (last && has_next) S.a_ready(nxt);
            if constexpr (SP2) {
            PG8_LDB(B0, 0, 0); PG8_LDB(B1, 0, 1); PG8_SCHED; PG8_LDA(At, 0, 0); PG8_STAGE(PG8_SA(1, 1), a1 + hstep, voffA);
            PG8_WAIT_V(8); PG8_WAIT_L(0); PG8_BAR; PG8_MMA(0, 0, At, B0); PG8_MMA(0, 1, At, B1); PG8_BAR; PG8_SCHED;
            PG8_LDA(At, 0, 1); PG8_STAGE(PG8_SB(0, 0), b2, voffB); PG8_STAGE(PG8_SB(0, 1), b2 + hstep, voffB); PG8_STAGE(PG8_SA(0, 0), a2, voffA);
            PG8_WAIT_V(8); PG8_WAIT_L(0); PG8_BAR; PG8_MMA(1, 0, At, B0); PG8_MMA(1, 1, At, B1); PG8_BAR; PG8_SCHED;
            PG8_LDB(B0, 1, 0); PG8_LDB(B1, 1, 1); PG8_SCHED; PG8_LDA(At, 1, 0); PG8_STAGE(PG8_SA(0, 1), a2 + hstep, voffA);
            PG8_WAIT_V(8); PG8_WAIT_L(0); PG8_BAR; PG8_MMA(0, 0, At, B0); PG8_MMA(0, 1, At, B1); PG8_BAR; PG8_SCHED;
            PG8_LDA(At, 1, 1); PG8_STAGE(PG8_SB(1, 0), b3, voffB); PG8_STAGE(PG8_SB(1, 1), b3 + hstep, voffB); PG8_STAGE(PG8_SA(1, 0), a3, voffA);
            PG8_WAIT_V(8); PG8_WAIT_L(0); PG8_BAR; PG8_MMA(1, 0, At, B0); PG8_MMA(1, 1, At, B1); PG8_BAR; PG8_SCHED;
            } else {
            PG8_LDB(B0, 0, 0); PG8_SCHED; PG8_LDA(At, 0, 0); PG8_STAGE(PG8_SA(1, 1), a1 + hstep, voffA);
            PG8_WAIT_L(8); PG8_BAR; PG8_WAIT_L(0); PG8_MMA(0, 0, At, B0); PG8_BAR; PG8_SCHED;
            PG8_LDB(B1, 0, 1); PG8_STAGE(PG8_SB(0, 0), b2, voffB);
            PG8_BAR; PG8_WAIT_L(0); PG8_MMA(0, 1, At, B1); PG8_BAR;
            PG8_LDA(At, 0, 1); PG8_STAGE(PG8_SA(0, 0), a2, voffA);
            PG8_BAR; PG8_WAIT_L(0); PG8_MMA(1, 0, At, B0); PG8_BAR; PG8_SCHED;
            PG8_STAGE(PG8_SB(0, 1), b2 + hstep, voffB);
            PG8_WAIT_V(6); PG8_BAR; PG8_MMA(1, 1, At, B1); PG8_BAR;
            PG8_LDB(B0, 1, 0); PG8_SCHED; PG8_LDA(At, 1, 0); PG8_STAGE(PG8_SA(0, 1), a2 + hstep, voffA);
            PG8_WAIT_L(8); PG8_BAR; PG8_WAIT_L(0); PG8_MMA(0, 0, At, B0); PG8_BAR; PG8_SCHED;
            PG8_LDB(B1, 1, 1); PG8_STAGE(PG8_SB(1, 0), b3, voffB);
            PG8_BAR; PG8_WAIT_L(0); PG8_MMA(0, 1, At, B1); PG8_BAR;
            PG8_LDA(At, 1, 1); PG8_STAGE(PG8_SA(1, 0), a3, voffA);
            PG8_BAR; PG8_WAIT_L(0); PG8_MMA(1, 0, At, B0); PG8_BAR; PG8_SCHED;
            PG8_STAGE(PG8_SB(1, 1), b3 + hstep, voffB);
            PG8_WAIT_V(6); PG8_BAR; PG8_MMA(1, 1, At, B1); PG8_BAR;
            }
        }
        if constexpr (ALIGN_EPI) { if (wr == 0) PG8_BAR; }
        if constexpr (!Epi::AFTER_DRAIN) { E(acc, cur, wr, wc, fr, fq); S.done(cur); }
        if (!has_next) break;
#pragma unroll
        for (int a = 0; a < 2; ++a)
#pragma unroll
            for (int b = 0; b < 2; ++b)
#pragma unroll
                for (int m = 0; m < 4; ++m)
#pragma unroll
                    for (int n = 0; n < 2; ++n) acc[a][b][m][n] = (f32x4){0.f, 0.f, 0.f, 0.f};
        cur = nxt; cA = nA; cB = nB; ++ui;
        if constexpr (ALIGN_EPI) { if (wr == 1) PG8_BAR; }
    }
    PG8_WAIT_V(0);
    if constexpr (!ALIGN_EPI) { if (wr == 0) PG8_BAR; }
    PG8_BAR;
    if constexpr (Epi::AFTER_DRAIN) { E.fused(acc, cur, wr, wc, fr, fq, lds, wid, lane); S.done(cur); }
#undef PG8_SA
#undef PG8_SB
#undef PG8_STAGE
#undef PG8_LDA
#undef PG8_LDB
#undef PG8_MMA
#undef PG8_WAIT_V
#undef PG8_WAIT_L
#undef PG8_BAR
#undef PG8_SCHED
}
}
#define GAS __attribute__((address_space(1)))
#define LAS __attribute__((address_space(3)))
typedef unsigned short bf16;
typedef unsigned v4u __attribute__((ext_vector_type(4)));
typedef float f32x4 __attribute__((ext_vector_type(4)));
typedef short bf16x8 __attribute__((ext_vector_type(8)));
typedef GAS unsigned gu32;
typedef GAS unsigned long long gu64;
#define RLX_AGENT __ATOMIC_RELAXED, __HIP_MEMORY_SCOPE_AGENT
#define LDS_WAIT() asm volatile("s_waitcnt lgkmcnt(0)" ::: "memory")
#define VM_WAIT() asm volatile("s_waitcnt vmcnt(0)" ::: "memory")
__device__ __forceinline__ unsigned long long rt() { return __builtin_amdgcn_s_memrealtime(); }
__device__ __forceinline__ unsigned f2bf(float f) { unsigned u = __builtin_bit_cast(unsigned, f); return (u + 0x7fffu + ((u >> 16) & 1u)) >> 16; }
__device__ __forceinline__ unsigned pk2(float lo, float hi) { return f2bf(lo) | (f2bf(hi) << 16); }

#define XB_TMO      128
#define XB_XCNT(j)  (256  + 64 * (j))
#define XB_XSUB(j)  (1280 + 64 * (j))
#define XB_XGEN(j)  (2304 + 64 * (j))
#define XB_TOP      3328
#define XB_TOPGEN   3392
#define XCD_BAR_WORDS 3456
#define XB_SPIN_CAP (1u << 18)

__device__ __forceinline__ unsigned xb_ld(unsigned* p)              { return __hip_atomic_load(p, __ATOMIC_RELAXED, __HIP_MEMORY_SCOPE_AGENT); }
__device__ __forceinline__ unsigned xb_add(unsigned* p, unsigned v) { return __hip_atomic_fetch_add(p, v, __ATOMIC_RELAXED, __HIP_MEMORY_SCOPE_AGENT); }
__device__ __forceinline__ unsigned xb_xcc_id() { return (unsigned)__builtin_amdgcn_s_getreg((3 << 11) | 20) & 0xFu; }
#define XB_SPIN(cond, bar) do { unsigned _sp = 0; while (cond) { __builtin_amdgcn_s_sleep(1); \
    if ((++_sp & 255u) == 0u) { if (xb_ld(&(bar)[XB_TMO])) break; if (_sp > XB_SPIN_CAP) { atomicAdd(&(bar)[XB_TMO], 1u); break; } } } } while (0)

struct XcdBarrier {
    unsigned* bar; unsigned x;
    volatile LAS unsigned* st;
};

__device__ __forceinline__ XcdBarrier xcd_barrier_post(unsigned* bar, volatile LAS unsigned* st) {
    XcdBarrier b; b.bar = bar; b.x = xb_xcc_id(); b.st = st;
    if (threadIdx.x == 0) (void)xb_add(&bar[XB_XCNT(b.x)], 1u);
    return b;
}
__device__ __forceinline__ void xcd_barrier_complete(unsigned* bar, unsigned x, unsigned& nloc, unsigned& nx) {
    const unsigned G = gridDim.x * gridDim.y * gridDim.z;
    unsigned sum, cnt, mine, sp = 0u;
    for (;;) {
        sum = 0u; cnt = 0u; mine = 0u;
#pragma unroll
        for (unsigned j = 0; j < 16; ++j) { const unsigned c = xb_ld(&bar[XB_XCNT(j)]); sum += c; cnt += (c > 0u) ? 1u : 0u; mine = (j == x) ? c : mine; }
        if (sum == G) break;
        __builtin_amdgcn_s_sleep(1);
        if ((++sp & 255u) == 0u) { if (xb_ld(&bar[XB_TMO])) break; if (sp > XB_SPIN_CAP) { atomicAdd(&bar[XB_TMO], 1u); break; } }
    }
    nloc = mine > 0u ? mine : 1u; nx = cnt > 0u ? cnt : 1u;
}

__device__ __forceinline__ void xcd_barrier(const XcdBarrier& b) {
    asm volatile("s_waitcnt vmcnt(0)" ::: "memory");
    __syncthreads();
    if (threadIdx.x == 0) {
        unsigned* bar = b.bar;
        __builtin_amdgcn_s_waitcnt(0);
        unsigned nloc = b.st[0], nx = b.st[1];
        if (nloc == 0u) { xcd_barrier_complete(bar, b.x, nloc, nx); b.st[0] = nloc; b.st[1] = nx; }
        const unsigned old = xb_add(&bar[XB_XSUB(b.x)], 1u);
        const unsigned gen = old / nloc;
        if (old + 1u == (gen + 1u) * nloc) {
            __builtin_amdgcn_fence(__ATOMIC_RELEASE, "agent");
            asm volatile("s_waitcnt vmcnt(0)" ::: "memory");
            const unsigned og = xb_add(&bar[XB_TOP], 1u);
            const unsigned tg = og / nx;
            if (og + 1u == (tg + 1u) * nx) xb_add(&bar[XB_TOPGEN], 1u);
            else XB_SPIN(xb_ld(&bar[XB_TOPGEN]) == tg, bar);
            __builtin_amdgcn_fence(__ATOMIC_ACQUIRE, "agent");
            xb_add(&bar[XB_XGEN(b.x)], 1u);
            asm volatile("s_waitcnt vmcnt(0)" ::: "memory");
        } else {
            XB_SPIN(xb_ld(&bar[XB_XGEN(b.x)]) == gen, bar);
            __builtin_amdgcn_fence(__ATOMIC_ACQUIRE, "agent");
            asm volatile("s_waitcnt vmcnt(0)" ::: "memory");
        }
    }
    __syncthreads();
}

constexpr int NWAVES = 8;
constexpr int NB = 8, SEQ = 4096, D = 1024, M = NB * SEQ, FF = 2816, FF2 = 2 * FF, DC = 512, DR = 512, NH = 8, HD = 64, CW = 31, RW = 4, NMIX = 2048;
constexpr float EPS = 1e-6f;
constexpr int LDM = 11 * D;
constexpr size_t MiB = 1u << 20;
constexpr size_t WS_CTL = 0, CTL_ZERO_BYTES = 1 * MiB;
constexpr size_t WS_MOD = 1 * MiB;
constexpr size_t WS_BIAS1 = 1 * MiB + 512 * 1024;
constexpr size_t WS_BIAS3 = 1 * MiB + 768 * 1024;
constexpr size_t WS_BIAS2 = 2 * MiB;
constexpr size_t WS_WGT = 2 * MiB + 128 * 1024;
constexpr size_t WS_TOT = 3 * MiB;
constexpr size_t WS_SSP = 5 * MiB;
constexpr size_t WS_W1I = 8 * MiB, WS_W1O = 19 * MiB, WS_WIN = 25 * MiB, WS_WOUT = 29 * MiB, WS_W2I = 31 * MiB, WS_W2O = 42 * MiB;
constexpr size_t WS_Y = 48 * MiB;
constexpr size_t WS_X1 = 112 * MiB;
constexpr size_t WS_ACT = 240 * MiB;
constexpr size_t WS_U = WS_ACT, WS_UX = WS_ACT + 32 * MiB, WS_GY = WS_ACT + 64 * MiB, WS_YMIX = WS_ACT + 96 * MiB;
constexpr size_t WS_END = 416 * MiB;
constexpr int CW_BAR = 4096;
constexpr int LDS_BYTES = 147456;
constexpr int LDSCTL_OFF = LDS_BYTES - 256;

typedef unsigned short u16;
typedef float f32x16 __attribute__((ext_vector_type(16)));
typedef float f32x2 __attribute__((ext_vector_type(2)));

__device__ __forceinline__ float wave_sum(float v) {
#pragma unroll
    for (int o = 1; o < 64; o <<= 1) v += __shfl_xor(v, o);
    return v;
}
__device__ __forceinline__ float sigmoid_fast(float x) { return __builtin_amdgcn_rcpf(1.f + __builtin_amdgcn_exp2f(-1.4426950408889634f * x)); }
__device__ __forceinline__ float silu_fast(float x) { return x * sigmoid_fast(x); }
__device__ __forceinline__ float gelu_tanh_fast(float x) { const float z = 0.7978845608028654f * (x + 0.044715f * x * x * x); return x * sigmoid_fast(2.f * z); }
__device__ __forceinline__ float bflo(unsigned w) { return __uint_as_float(w << 16); }
__device__ __forceinline__ float bfhi(unsigned w) { return __uint_as_float(w & 0xffff0000u); }
__device__ __forceinline__ unsigned cvtpk(float lo, float hi) { return pg8::cvt_pk_bf16(lo, hi); }
__device__ __forceinline__ v4u pack8(const f32x4 a, const f32x4 b) { v4u w; w.x = cvtpk(a[0], a[1]); w.y = cvtpk(a[2], a[3]); w.z = cvtpk(b[0], b[1]); w.w = cvtpk(b[2], b[3]); return w; }

__device__ __forceinline__ void load_rstd(const float* ssp, int row0, int fq, float (&rs)[2][4]) {
#pragma unroll
    for (int ai = 0; ai < 2; ++ai)
#pragma unroll
        for (int m = 0; m < 4; ++m) { const f32x4 p = *(const f32x4*)(ssp + (size_t)(row0 + ai * 128 + m * 16) * 16 + 4 * fq);
            float s = (p[0] + p[1]) + (p[2] + p[3]); s += __shfl_xor(s, 16); s += __shfl_xor(s, 32); rs[ai][m] = rsqrtf(s * (1.0f / D) + EPS); }
}
struct EpiSwiglu {
    static constexpr bool PERM = true, AFTER_DRAIN = false;
    pg8::bf16_t* act; const float* ssp; const float* bias;
    __device__ __forceinline__ void operator()(const f32x4 (&acc)[2][2][4][2], const pg8::Unit& u, int wr, int wc, int fr, int fq) const {
        const int row0 = u.pm * 256 + wr * 64 + fr, b = u.pm >> 4;
        float rs[2][4]; load_rstd(ssp, row0, fq, rs);
        const float* bp = bias + (size_t)b * FF2 + u.pn * 256 + wc * 32 + 8 * fq;
        const f32x4 bg0 = *(const f32x4*)(bp), bg1 = *(const f32x4*)(bp + 4), bu0 = *(const f32x4*)(bp + 128), bu1 = *(const f32x4*)(bp + 132);
        const int oc = u.pn * 128 + wc * 32 + 8 * fq;
#pragma unroll
        for (int ai = 0; ai < 2; ++ai)
#pragma unroll
            for (int m = 0; m < 4; ++m) { const float r = rs[ai][m];
                const f32x4 g0 = acc[ai][0][m][0] * r + bg0, g1 = acc[ai][0][m][1] * r + bg1, u0 = acc[ai][1][m][0] * r + bu0, u1 = acc[ai][1][m][1] * r + bu1;
                f32x4 a0, a1;
#pragma unroll
                for (int j = 0; j < 4; ++j) { a0[j] = silu_fast(g0[j]) * u0[j]; a1[j] = silu_fast(g1[j]) * u1[j]; }
                *(v4u*)(act + (size_t)(row0 + ai * 128 + m * 16) * FF + oc) = pack8(a0, a1); }
    }
};
template <int WHALF, bool HASY> struct EpiResid {
    static constexpr bool PERM = true, AFTER_DRAIN = false;
    static constexpr float w = WHALF ? 0.5f : 1.0f;
    const float* xin; float* xout; pg8::bf16_t* y; float* ssp; const float* gt; const float* gnext; const float* scnext;
    __device__ __forceinline__ void operator()(const f32x4 (&acc)[2][2][4][2], const pg8::Unit& u, int wr, int wc, int fr, int fq) const {
        const int row0 = u.pm * 256 + wr * 64 + fr, b = u.pm >> 4;
        float ss[2][4];
#pragma unroll
        for (int ai = 0; ai < 2; ++ai)
#pragma unroll
            for (int m = 0; m < 4; ++m) ss[ai][m] = 0.f;
#pragma unroll
        for (int bj = 0; bj < 2; ++bj) { const int c0 = u.pn * 256 + bj * 128 + wc * 32 + 8 * fq;
            const f32x4 gt0 = *(const f32x4*)(gt + (size_t)b * LDM + c0) * w, gt1 = *(const f32x4*)(gt + (size_t)b * LDM + c0 + 4) * w;
            f32x4 gs0 = {0.f, 0.f, 0.f, 0.f}, gs1 = gs0;
            if (HASY) { gs0 = *(const f32x4*)(gnext + c0) * (*(const f32x4*)(scnext + (size_t)b * LDM + c0) + 1.0f); gs1 = *(const f32x4*)(gnext + c0 + 4) * (*(const f32x4*)(scnext + (size_t)b * LDM + c0 + 4) + 1.0f); }
#pragma unroll
            for (int ai = 0; ai < 2; ++ai)
#pragma unroll
                for (int m = 0; m < 4; ++m) { const size_t off = (size_t)(row0 + ai * 128 + m * 16) * D + c0;
                    const f32x4 o0 = *(const f32x4*)(xin + off) + gt0 * acc[ai][bj][m][0], o1 = *(const f32x4*)(xin + off + 4) + gt1 * acc[ai][bj][m][1];
                    *(f32x4*)(xout + off) = o0; *(f32x4*)(xout + off + 4) = o1;
                    ss[ai][m] += (o0[0] * o0[0] + o0[1] * o0[1]) + (o0[2] * o0[2] + o0[3] * o0[3]) + (o1[0] * o1[0] + o1[1] * o1[1]) + (o1[2] * o1[2] + o1[3] * o1[3]);
                    if (HASY) *(v4u*)(y + off) = pack8(o0 * gs0, o1 * gs1); } }
#pragma unroll
        for (int ai = 0; ai < 2; ++ai)
#pragma unroll
            for (int m = 0; m < 4; ++m) { float s = ss[ai][m]; s += __shfl_xor(s, 16); s += __shfl_xor(s, 32);
                if (fq == 0) ssp[(size_t)(row0 + ai * 128 + m * 16) * 16 + u.pn * 4 + wc] = s; }
    }
};
struct EpiMixIn {
    static constexpr bool PERM = true, AFTER_DRAIN = false;
    pg8::bf16_t *U, *UX, *GY; const float* ssp; const float* bias;
    __device__ __forceinline__ void operator()(const f32x4 (&acc)[2][2][4][2], const pg8::Unit& u, int wr, int wc, int fr, int fq) const {
        const int row0 = u.pm * 256 + wr * 64 + fr, b = u.pm >> 4;
        float rs[2][4]; load_rstd(ssp, row0, fq, rs);
        const float* bp = bias + (size_t)b * NMIX + u.pn * 256 + wc * 32 + 8 * fq;
        const f32x4 b00 = *(const f32x4*)(bp), b01 = *(const f32x4*)(bp + 4), b10 = *(const f32x4*)(bp + 128), b11 = *(const f32x4*)(bp + 132);
        if (u.pn < 4) {
            const int oc = u.pn * 128 + wc * 32 + 8 * fq;
#pragma unroll
            for (int ai = 0; ai < 2; ++ai)
#pragma unroll
                for (int m = 0; m < 4; ++m) { const float r = rs[ai][m];
                    const f32x4 v0 = acc[ai][0][m][0] * r + b00, v1 = acc[ai][0][m][1] * r + b01, g0 = acc[ai][1][m][0] * r + b10, g1 = acc[ai][1][m][1] * r + b11;
                    f32x4 a0, a1;
#pragma unroll
                    for (int j = 0; j < 4; ++j) { a0[j] = v0[j] * sigmoid_fast(g0[j]); a1[j] = v1[j] * sigmoid_fast(g1[j]); }
                    *(v4u*)(U + (size_t)(row0 + ai * 128 + m * 16) * DC + oc) = pack8(a0, a1); }
        } else {
            pg8::bf16_t* dst = (u.pn < 6) ? UX : GY; const bool gel = u.pn >= 6; const int pc = (u.pn & 1) * 256 + wc * 32 + 8 * fq;
#pragma unroll
            for (int ai = 0; ai < 2; ++ai)
#pragma unroll
                for (int m = 0; m < 4; ++m) { const float r = rs[ai][m];
#pragma unroll
                    for (int bj = 0; bj < 2; ++bj) { f32x4 v0 = acc[ai][bj][m][0] * r + (bj ? b10 : b00), v1 = acc[ai][bj][m][1] * r + (bj ? b11 : b01);
                        if (gel) {
#pragma unroll
                            for (int j = 0; j < 4; ++j) { v0[j] = gelu_tanh_fast(v0[j]); v1[j] = gelu_tanh_fast(v1[j]); } }
                        *(v4u*)(dst + (size_t)(row0 + ai * 128 + m * 16) * DR + pc + bj * 128) = pack8(v0, v1); } }
        }
    }
};

__device__ __forceinline__ void p0_gemv(LAS unsigned char* lds, const float* c, const float* W, int NC, const float* bias, float* out, int j0, int tid) {
    LAS float* ca = (LAS float*)lds; LAS float* part = (LAS float*)(lds + 32768);
    for (int i = tid; i < NB * D; i += 512) { const float v = c[i]; ca[i] = v / (1.f + expf(-v)); }
    __syncthreads();
    const int cg = tid & 31, ks = tid >> 5;
    const float* wp = W + (size_t)(64 * ks) * NC + j0 + 4 * cg;
    f32x4 acc[NB];
#pragma unroll
    for (int b = 0; b < NB; ++b) acc[b] = (f32x4){0.f, 0.f, 0.f, 0.f};
#pragma unroll 4
    for (int kk = 0; kk < 64; ++kk) { const f32x4 w = *(const f32x4*)(wp + (size_t)kk * NC);
#pragma unroll
        for (int b = 0; b < NB; ++b) acc[b] += w * ca[b * D + 64 * ks + kk]; }
#pragma unroll
    for (int b = 0; b < NB; ++b) *(LAS f32x4*)(part + (ks * NB + b) * 128 + 4 * cg) = acc[b];
    __syncthreads();
#pragma unroll
    for (int r = 0; r < 2; ++r) { const int o = tid + 512 * r, b = o >> 7, col = o & 127; float s = 0.f;
#pragma unroll
        for (int k2 = 0; k2 < 16; ++k2) s += part[(k2 * NB + b) * 128 + col];
        out[(size_t)b * LDM + j0 + col] = s + bias[j0 + col]; }
    __syncthreads();
}
__device__ __forceinline__ int rowmap(int kind, int n0) {
    if (kind == 1) { const int half = n0 / FF, f = n0 - half * FF; return 256 * (f >> 7) + 128 * half + (f & 127); }
    if (kind == 2 && n0 < 1024) { const int half = n0 >> 9, f = n0 & 511; return 256 * (f >> 7) + 128 * half + (f & 127); }
    return n0;
}
__device__ __forceinline__ void p0_transpose_item(const float* W, int K, int N, bf16* WT, int kind, LAS float* scr, int item, int lane) {
    const int nblk = N / 32, kb = item / nblk, nb = item % nblk, k0 = 64 * kb, n0 = 32 * nb, r0 = rowmap(kind, n0);
#pragma unroll 8
    for (int i = 0; i < 32; ++i) { const int kk = 2 * i + (lane >> 5); scr[kk * 33 + (lane & 31)] = W[(size_t)(k0 + kk) * N + n0 + (lane & 31)]; }
    LDS_WAIT(); asm volatile("" ::: "memory");
    const int c = lane & 7;
#pragma unroll
    for (int j = 0; j < 4; ++j) { const int n = (lane >> 3) + 8 * j; const LAS float* s = scr + (8 * c) * 33 + n;
        v4u o; o.x = pk2(s[0 * 33], s[1 * 33]); o.y = pk2(s[2 * 33], s[3 * 33]); o.z = pk2(s[4 * 33], s[5 * 33]); o.w = pk2(s[6 * 33], s[7 * 33]);
        *(GAS v4u*)(WT + (size_t)(r0 + n) * K + k0 + 8 * c) = o; }
    LDS_WAIT(); asm volatile("" ::: "memory");
}

__device__ __forceinline__ void mix_conv(LAS unsigned char* lds, const bf16* U, const float* conv_w, const float* conv_b, const float* ln_g, const float* ln_b, bf16* YMIX, int G, int bx, int tid, int lane, int wave) {
    LAS unsigned char* IN = lds;
    LAS f32x4* WA = (LAS f32x4*)(lds + 63488);
    LAS f32x4* WB = WA + 31 * 64;
    for (int i = tid; i < 31 * 64; i += 512) { const int k = i >> 6, l = i & 63; WA[i] = *(const f32x4*)(conv_w + k * DC + 8 * l); WB[i] = *(const f32x4*)(conv_w + k * DC + 8 * l + 4); }
    const f32x4 cb0 = *(const f32x4*)(conv_b + 8 * lane), cb1 = *(const f32x4*)(conv_b + 8 * lane + 4);
    const f32x4 lg0 = *(const f32x4*)(ln_g + 8 * lane), lg1 = *(const f32x4*)(ln_g + 8 * lane + 4);
    const f32x4 lb0 = *(const f32x4*)(ln_b + 8 * lane), lb1 = *(const f32x4*)(ln_b + 8 * lane + 4);
    for (int item = bx; item < NB * (SEQ / 32); item += G) {
        const int b = item >> 7, t0 = (item & 127) * 32;
        __syncthreads();
        for (int i = tid; i < 62 * 64; i += 512) { const int row = i >> 6, ch = i & 63, tok = t0 - 30 + row; v4u v = {0u, 0u, 0u, 0u};
            if (tok >= 0) v = *(const v4u*)(U + ((size_t)(b * SEQ + tok)) * DC + 8 * ch);
            *(LAS v4u*)(IN + row * 1024 + ch * 16) = v; }
        __syncthreads();
        f32x4 a0[4], a1[4];
#pragma unroll
        for (int tt = 0; tt < 4; ++tt) { a0[tt] = cb0; a1[tt] = cb1; }
        f32x4 wa0 = {0.f, 0.f, 0.f, 0.f}, wa1 = wa0, wa2 = wa0, wa3 = wa0, wb0 = wa0, wb1 = wa0, wb2 = wa0, wb3 = wa0;
#pragma unroll
        for (int kk = 0; kk < 34; ++kk) {
            const v4u v = *(const LAS v4u*)(IN + (4 * wave + kk) * 1024 + lane * 16);
            const f32x4 x0 = {bflo(v.x), bfhi(v.x), bflo(v.y), bfhi(v.y)}, x1 = {bflo(v.z), bfhi(v.z), bflo(v.w), bfhi(v.w)};
            wa3 = wa2; wa2 = wa1; wa1 = wa0; wb3 = wb2; wb2 = wb1; wb1 = wb0;
            if (kk <= 30) { wa0 = WA[kk * 64 + lane]; wb0 = WB[kk * 64 + lane]; } else { wa0 = (f32x4){0.f, 0.f, 0.f, 0.f}; wb0 = wa0; }
            a0[0] += wa0 * x0; a1[0] += wb0 * x1; a0[1] += wa1 * x0; a1[1] += wb1 * x1; a0[2] += wa2 * x0; a1[2] += wb2 * x1; a0[3] += wa3 * x0; a1[3] += wb3 * x1;
        }
#pragma unroll
        for (int tt = 0; tt < 4; ++tt) {
            float s = (a0[tt][0] + a0[tt][1]) + (a0[tt][2] + a0[tt][3]) + (a1[tt][0] + a1[tt][1]) + (a1[tt][2] + a1[tt][3]);
            const float mean = wave_sum(s) * (1.0f / DC);
            const f32x4 d0 = a0[tt] - mean, d1 = a1[tt] - mean;
            float q = (d0[0] * d0[0] + d0[1] * d0[1]) + (d0[2] * d0[2] + d0[3] * d0[3]) + (d1[0] * d1[0] + d1[1] * d1[1]) + (d1[2] * d1[2] + d1[3] * d1[3]);
            const float rstd = rsqrtf(wave_sum(q) * (1.0f / DC) + EPS);
            f32x4 y0 = d0 * rstd * lg0 + lb0, y1 = d1 * rstd * lg1 + lb1;
#pragma unroll
            for (int j = 0; j < 4; ++j) { y0[j] = silu_fast(y0[j]); y1[j] = silu_fast(y1[j]); }
            *(v4u*)(YMIX + ((size_t)(b * SEQ + t0 + 4 * wave + tt)) * D + 8 * lane) = pack8(y0, y1);
        }
    }
    __syncthreads();
}

template <bool FINAL>
__device__ __forceinline__ void mix_scan(LAS unsigned char* lds, const bf16* UX, const bf16* GY, const bf16* WGT, const float* rw, const float* rb, const float* b_a, const float* b_i, const float* lam,
                                         f32x2* TOT, bf16* YMIX, int G, int bx, int lane, int wave) {
    LAS unsigned char* UXT = lds + wave * 16896;
    LAS unsigned char* XRT = UXT + 8704;
    const int h = wave, j = lane & 31, hh = lane >> 5, dg = lane & 7, tg = lane >> 3;
    f32x4 w4a[4], w4b[4];
#pragma unroll
    for (int k = 0; k < 4; ++k) { w4a[k] = *(const f32x4*)(rw + k * DR + 64 * h + 8 * dg); w4b[k] = *(const f32x4*)(rw + k * DR + 64 * h + 8 * dg + 4); }
    const f32x4 rb0 = *(const f32x4*)(rb + 64 * h + 8 * dg), rb1 = *(const f32x4*)(rb + 64 * h + 8 * dg + 4);
    float c8v[2], bav[2], biv[2];
#pragma unroll
    for (int ec = 0; ec < 2; ++ec) { const int ch = 64 * h + 32 * ec + j; c8v[ec] = -8.0f * log1pf(expf(-lam[ch])); bav[ec] = b_a[ch]; biv[ec] = b_i[ch]; }
    for (int it = bx; it < 512; it += G) {
        int b, c;
        if (it < 256) { b = it >> 6; c = it & 63; } else { b = 4 + ((it - 256) >> 6); c = 63 - ((it - 256) & 63); }
        const int tc0 = 64 * c; const size_t mrow0 = (size_t)b * SEQ + tc0;
        asm volatile("" ::: "memory");
#pragma unroll
        for (int i = 0; i < 9; ++i) { const int row = i * 8 + tg, tok = tc0 - 3 + row; v4u v = {0u, 0u, 0u, 0u};
            if (row < 67 && tok >= 0) v = *(const v4u*)(UX + ((size_t)b * SEQ + tok) * DR + 64 * h + 8 * dg);
            if (row < 68) *(LAS v4u*)(UXT + row * 128 + dg * 16) = v; }
        asm volatile("" ::: "memory");
        {
            f32x4 o0[8], o1[8];
#pragma unroll
            for (int t = 0; t < 8; ++t) { o0[t] = rb0; o1[t] = rb1; }
#pragma unroll
            for (int i = 0; i < 11; ++i) { const v4u v = *(const LAS v4u*)(UXT + (8 * tg + i) * 128 + dg * 16);
                const f32x4 x0 = {bflo(v.x), bfhi(v.x), bflo(v.y), bfhi(v.y)}, x1 = {bflo(v.z), bfhi(v.z), bflo(v.w), bfhi(v.w)};
#pragma unroll
                for (int k = 0; k < 4; ++k) { const int t = i - k; if (t >= 0 && t < 8) { o0[t] += w4a[k] * x0; o1[t] += w4b[k] * x1; } } }
#pragma unroll
            for (int t = 0; t < 8; ++t) *(LAS v4u*)(XRT + (8 * tg + t) * 128 + dg * 16) = pack8(o0[t], o1[t]);
        }
        asm volatile("" ::: "memory");
        if (FINAL) {
#pragma unroll
            for (int i = 0; i < 8; ++i) { const int row = i * 8 + tg; *(LAS v4u*)(UXT + row * 128 + dg * 16) = *(const v4u*)(GY + (mrow0 + row) * DR + 64 * h + 8 * dg); }
        }
        float Hc = 0.f;
        if (FINAL) { const f32x2* tp = TOT + ((size_t)b * 64) * DR + 64 * h + lane;
            for (int cc = 0; cc < c; ++cc) { const f32x2 ab = tp[(size_t)cc * DR]; Hc = Hc * ab.x + ab.y; } }
        pg8::bf16x8 afr[2][4];
#pragma unroll
        for (int tt = 0; tt < 2; ++tt)
#pragma unroll
            for (int ks = 0; ks < 4; ++ks) afr[tt][ks] = *(const LAS pg8::bf16x8*)(XRT + (32 * tt + j) * 128 + (16 * ks + 8 * hh) * 2);
#pragma unroll
        for (int ec = 0; ec < 2; ++ec) {
            const int ch = 64 * h + 32 * ec + j;
            pg8::bf16x8 bfr[2][4];
#pragma unroll
            for (int g = 0; g < 2; ++g)
#pragma unroll
                for (int ks = 0; ks < 4; ++ks) bfr[g][ks] = *(const pg8::bf16x8*)(WGT + ((size_t)(h * 128 + 64 * g + 32 * ec + j)) * 64 + 16 * ks + 8 * hh);
            f32x16 acc[2][2];
#pragma unroll
            for (int g = 0; g < 2; ++g)
#pragma unroll
                for (int tt = 0; tt < 2; ++tt) {
#pragma unroll
                    for (int r = 0; r < 16; ++r) acc[g][tt][r] = 0.f;
#pragma unroll
                    for (int ks = 0; ks < 4; ++ks) acc[g][tt] = __builtin_amdgcn_mfma_f32_32x32x16_bf16(afr[tt][ks], bfr[g][ks], acc[g][tt], 0, 0, 0); }
            const float c8 = c8v[ec], ba = bav[ec], bi = biv[ec];
#pragma unroll
            for (int tt = 0; tt < 2; ++tt)
#pragma unroll
                for (int r = 0; r < 16; ++r) { const int tk = 32 * tt + (r & 3) + 8 * (r >> 2) + 4 * hh;
                    const float xr = __uint_as_float((unsigned)(*(const LAS u16*)(XRT + tk * 128 + (32 * ec + j) * 2)) << 16);
                    const float rg = sigmoid_fast(acc[0][tt][r] + ba), ig = sigmoid_fast(acc[1][tt][r] + bi);
                    const float la = c8 * rg;
                    acc[0][tt][r] = __expf(la); acc[1][tt][r] = sqrtf(-expm1f(2.0f * la)) * (ig * xr); }
            float GA[2][4], GB[2][4], PA[2][4], PB[2][4];
#pragma unroll
            for (int tt = 0; tt < 2; ++tt)
#pragma unroll
                for (int q = 0; q < 4; ++q) { const float a0 = acc[0][tt][4 * q], a1 = acc[0][tt][4 * q + 1], a2 = acc[0][tt][4 * q + 2], a3 = acc[0][tt][4 * q + 3];
                    const float b0 = acc[1][tt][4 * q], b1 = acc[1][tt][4 * q + 1], b2 = acc[1][tt][4 * q + 2], b3 = acc[1][tt][4 * q + 3];
                    GA[tt][q] = (a0 * a1) * (a2 * a3); GB[tt][q] = ((b0 * a1 + b1) * a2 + b2) * a3 + b3;
                    PA[tt][q] = __shfl_xor(GA[tt][q], 32); PB[tt][q] = __shfl_xor(GB[tt][q], 32); }
            if (!FINAL) {
                float At = 1.f, Bt = 0.f;
#pragma unroll
                for (int tt = 0; tt < 2; ++tt)
#pragma unroll
                    for (int q = 0; q < 4; ++q) { const float A0 = hh ? PA[tt][q] : GA[tt][q], B0 = hh ? PB[tt][q] : GB[tt][q], A1 = hh ? GA[tt][q] : PA[tt][q], B1 = hh ? GB[tt][q] : PB[tt][q];
                        Bt = (Bt * A0 + B0) * A1 + B1; At = (At * A0) * A1; }
                if (hh == 0) TOT[((size_t)b * 64 + c) * DR + ch] = (f32x2){At, Bt};
            } else {
                float hc = __shfl(Hc, 32 * ec + j);
#pragma unroll
                for (int tt = 0; tt < 2; ++tt)
#pragma unroll
                    for (int q = 0; q < 4; ++q) { const float A0 = hh ? PA[tt][q] : GA[tt][q], B0 = hh ? PB[tt][q] : GB[tt][q], A1 = hh ? GA[tt][q] : PA[tt][q], B1 = hh ? GB[tt][q] : PB[tt][q];
                        const float mid = hc * A0 + B0; float hv = hh ? mid : hc; hc = mid * A1 + B1;
#pragma unroll
                        for (int i = 0; i < 4; ++i) { hv = acc[0][tt][4 * q + i] * hv + acc[1][tt][4 * q + i]; acc[0][tt][4 * q + i] = hv; } }
#pragma unroll
                for (int tt = 0; tt < 2; ++tt)
#pragma unroll
                    for (int r = 0; r < 16; ++r) { const int tk = 32 * tt + (r & 3) + 8 * (r >> 2) + 4 * hh;
                        LAS u16* p = (LAS u16*)(UXT + tk * 128 + (32 * ec + j) * 2);
                        const float gy = __uint_as_float((unsigned)(*p) << 16);
                        *p = (u16)f2bf(gy * acc[0][tt][r]); }
            }
        }
        if (FINAL) {
            asm volatile("" ::: "memory");
#pragma unroll
            for (int i = 0; i < 8; ++i) { const int row = i * 8 + tg; *(v4u*)(YMIX + (mrow0 + row) * D + DC + 64 * h + 8 * dg) = *(const LAS v4u*)(UXT + row * 128 + dg * 16); }
        }
    }
    __syncthreads();
}

struct Args { const float* in[27]; float* out; unsigned char* ws; int ph_lo, ph_hi; };
constexpr int NPH = 11;
#ifndef MK_PER_PHASE
#define MK_PER_PHASE 0
#endif

__global__ void __launch_bounds__(NWAVES * 64, 2) mk_fwd(Args args) {
    extern __shared__ __attribute__((aligned(16))) unsigned char lds_raw[];
    LAS unsigned char* lds = (LAS unsigned char*)lds_raw;
    const int tid = threadIdx.x, lane = tid & 63, wave = __builtin_amdgcn_readfirstlane(tid >> 6);
    const int G = gridDim.x, bx = blockIdx.x;
    const int vcu = (G % 8 == 0) ? (bx % 8) * (G / 8) + bx / 8 : bx;
    const int gw = vcu * NWAVES + wave, NGW = G * NWAVES;
    unsigned char* ws = args.ws;
    gu32* ctl = (gu32*)(ws + WS_CTL);
    const float* x = args.in[0]; const float* cvec = args.in[1]; const float* w_mod = args.in[2]; const float* b_mod = args.in[3];
    const float* g1 = args.in[4]; const float* w1i = args.in[5]; const float* w1o = args.in[6]; const float* gm = args.in[7];
    const float* w_in = args.in[8]; const float* conv_w = args.in[9]; const float* conv_b = args.in[10]; const float* ln_g = args.in[11]; const float* ln_b = args.in[12];
    const float* rw = args.in[13]; const float* rb = args.in[14]; const float* wa = args.in[15]; const float* b_a = args.in[16];
    const float* wi = args.in[17]; const float* b_i = args.in[18]; const float* lam = args.in[19]; const float* w_out = args.in[20];
    const float* g2 = args.in[21]; const float* w2i = args.in[22]; const float* w2o = args.in[23]; const float* w_fmod = args.in[24];
    const float* b_fmod = args.in[25]; const float* gf = args.in[26];
    float* out = args.out;
    float* MOD = (float*)(ws + WS_MOD); float* BIAS1 = (float*)(ws + WS_BIAS1); float* BIAS2 = (float*)(ws + WS_BIAS2); float* BIAS3 = (float*)(ws + WS_BIAS3);
    bf16* WGT = (bf16*)(ws + WS_WGT); f32x2* TOT = (f32x2*)(ws + WS_TOT); float* SSP = (float*)(ws + WS_SSP);
    bf16 *W1I = (bf16*)(ws + WS_W1I), *W1O = (bf16*)(ws + WS_W1O), *WIN = (bf16*)(ws + WS_WIN), *WOUT = (bf16*)(ws + WS_WOUT), *W2I = (bf16*)(ws + WS_W2I), *W2O = (bf16*)(ws + WS_W2O);
    bf16 *Y = (bf16*)(ws + WS_Y), *ACT = (bf16*)(ws + WS_ACT), *U = (bf16*)(ws + WS_U), *UXB = (bf16*)(ws + WS_UX), *GYB = (bf16*)(ws + WS_GY), *YMIX = (bf16*)(ws + WS_YMIX);
    float* X1 = (float*)(ws + WS_X1);

    for (int u = tid; u < (LDS_BYTES - LDSCTL_OFF) / 4; u += NWAVES * 64) ((LAS unsigned*)(lds + LDSCTL_OFF))[u] = 0u;
    __syncthreads();
    const int lo = args.ph_lo, hi = args.ph_hi;
    const bool use_bar = (hi - lo) > 1;
    XcdBarrier bar; bar.bar = (unsigned*)(ctl + CW_BAR); bar.x = 0; bar.st = nullptr;
    if (use_bar) bar = xcd_barrier_post((unsigned*)(ctl + CW_BAR), (volatile LAS unsigned*)(lds + LDSCTL_OFF) + 8);
#define IN(k) (lo <= (k) && (k) < hi)
#define SEAM(k) do { if (IN(k) && IN((k) + 1)) xcd_barrier(bar); } while (0)

    if (IN(0)) {
        constexpr int NGEMV = 88;
        const int nt_wg = G > NGEMV ? G - NGEMV : G;
        if (bx < NGEMV || G <= NGEMV) {
            for (int it = bx; it < NGEMV; it += G) {
                if (it < 72) p0_gemv(lds, cvec, w_mod, 9 * D, b_mod, MOD, 128 * it, tid);
                else p0_gemv(lds, cvec, w_fmod, 2 * D, b_fmod, MOD + 9 * D, 128 * (it - 72), tid);
            }
        }
        if (bx >= NGEMV || G <= NGEMV) {
            const int tb = G > NGEMV ? bx - NGEMV : bx;
            LAS float* scr = (LAS float*)(lds + wave * 16384);
            constexpr int I_1I = (D / 64) * (FF2 / 32), I_1O = (FF / 64) * (D / 32), I_IN = (D / 64) * (NMIX / 32), I_OUT = (D / 64) * (D / 32);
            constexpr int NITEMS = 2 * I_1I + 2 * I_1O + I_IN + I_OUT;
            for (int it = tb * NWAVES + wave; it < NITEMS; it += nt_wg * NWAVES) {
                int r = it;
                if (r < I_1I) { p0_transpose_item(w1i, D, FF2, W1I, 1, scr, r, lane); continue; } r -= I_1I;
                if (r < I_1I) { p0_transpose_item(w2i, D, FF2, W2I, 1, scr, r, lane); continue; } r -= I_1I;
                if (r < I_1O) { p0_transpose_item(w1o, FF, D, W1O, 0, scr, r, lane); continue; } r -= I_1O;
                if (r < I_1O) { p0_transpose_item(w2o, FF, D, W2O, 0, scr, r, lane); continue; } r -= I_1O;
                if (r < I_IN) { p0_transpose_item(w_in, D, NMIX, WIN, 2, scr, r, lane); continue; } r -= I_IN;
                p0_transpose_item(w_out, D, D, WOUT, 0, scr, r, lane);
            }
        }
        for (int i = bx * 512 + tid; i < NH * 128 * HD; i += G * 512) { const int d = i & 63, e2 = (i >> 6) & 127, hd = i >> 13;
            const float v = e2 < 64 ? wa[(hd * 64 + d) * 64 + e2] : wi[(hd * 64 + d) * 64 + (e2 - 64)]; WGT[i] = (bf16)f2bf(v); }
    }
    SEAM(0);
    if (IN(1)) {
        LAS float* shl = (LAS float*)lds;
        for (int i = tid; i < 3 * NB * D; i += 512) { const int t = i >> 13, r = i & 8191, b = r >> 10, k = r & 1023; shl[i] = MOD[(size_t)b * LDM + 3 * t * D + k]; }
        __syncthreads();
        for (int m = gw; m < M; m += NGW) {
            const int b = m >> 12;
            const f32x4* xr = (const f32x4*)(x + (size_t)m * D) + lane;
            f32x4 v[4]; float s = 0.f;
#pragma unroll
            for (int jj = 0; jj < 4; ++jj) { v[jj] = xr[64 * jj]; s += (v[jj][0] * v[jj][0] + v[jj][1] * v[jj][1]) + (v[jj][2] * v[jj][2] + v[jj][3] * v[jj][3]); }
            s = wave_sum(s);
#pragma unroll
            for (int jj = 0; jj < 4; ++jj) { const int k = 4 * lane + 256 * jj;
                const f32x4 o = v[jj] * *(const f32x4*)(g1 + k) * (*(const f32x4*)(MOD + (size_t)b * LDM + 1 * D + k) + 1.0f);
                *(unsigned long long*)(Y + (size_t)m * D + k) = (unsigned long long)cvtpk(o[0], o[1]) | ((unsigned long long)cvtpk(o[2], o[3]) << 32); }
            if (lane < 16) SSP[(size_t)m * 16 + lane] = lane == 0 ? s : 0.f;
        }
        for (int it = gw; it < FF2 + NMIX + FF2; it += NGW) {
            const bf16* wrow; float* op; int t, stride;
            if (it < FF2) { wrow = W1I + (size_t)it * D; op = BIAS1 + it; t = 0; stride = FF2; }
            else if (it < FF2 + NMIX) { wrow = WIN + (size_t)(it - FF2) * D; op = BIAS2 + (it - FF2); t = 1; stride = NMIX; }
            else { wrow = W2I + (size_t)(it - FF2 - NMIX) * D; op = BIAS3 + (it - FF2 - NMIX); t = 2; stride = FF2; }
            const v4u wA = *(const v4u*)(wrow + 8 * lane), wB = *(const v4u*)(wrow + 512 + 8 * lane);
            const f32x4 a0 = {bflo(wA.x), bfhi(wA.x), bflo(wA.y), bfhi(wA.y)}, a1 = {bflo(wA.z), bfhi(wA.z), bflo(wA.w), bfhi(wA.w)};
            const f32x4 c0 = {bflo(wB.x), bfhi(wB.x), bflo(wB.y), bfhi(wB.y)}, c1 = {bflo(wB.z), bfhi(wB.z), bflo(wB.w), bfhi(wB.w)};
#pragma unroll
            for (int b = 0; b < NB; ++b) { const LAS float* sp = shl + (t * NB + b) * D + 8 * lane;
                const f32x4 s0 = *(const LAS f32x4*)(sp), s1 = *(const LAS f32x4*)(sp + 4), s2 = *(const LAS f32x4*)(sp + 512), s3 = *(const LAS f32x4*)(sp + 516);
                const f32x4 p = a0 * s0 + a1 * s1 + c0 * s2 + c1 * s3;
                const float tot = wave_sum((p[0] + p[1]) + (p[2] + p[3]));
                if (lane == 0) op[(size_t)b * stride] = tot; }
        }
        __syncthreads();
    }
    SEAM(1);
    if (IN(2)) {
        pg8::Gemm g{Y, W1I, M, FF2, D}; pg8::StaticOrder S; S.init(M, FF2, G, bx);
        EpiSwiglu E{ACT, SSP, BIAS1};
        pg8::gemm_phase<EpiSwiglu, pg8::StaticOrder, true, true>(lds, g, S, E);
    }
    SEAM(2);
    if (IN(3)) {
        pg8::Gemm g{ACT, W1O, M, D, FF}; pg8::StaticOrder S; S.init(M, D, G, bx);
        EpiResid<1, true> E{x, X1, Y, SSP, MOD + 2 * D, gm, MOD + 4 * D};
        pg8::gemm_phase<EpiResid<1, true>, pg8::StaticOrder, true, true>(lds, g, S, E);
    }
    SEAM(3);
    if (IN(4)) {
        pg8::Gemm g{Y, WIN, M, NMIX, D}; pg8::StaticOrder S; S.init(M, NMIX, G, bx);
        EpiMixIn E{U, UXB, GYB, SSP, BIAS2};
        pg8::gemm_phase<EpiMixIn, pg8::StaticOrder, true, true>(lds, g, S, E);
    }
    SEAM(4);
    if (IN(5)) {
        mix_conv(lds, U, conv_w, conv_b, ln_g, ln_b, YMIX, G, bx, tid, lane, wave);
        mix_scan<false>(lds, UXB, GYB, WGT, rw, rb, b_a, b_i, lam, TOT, YMIX, G, bx, lane, wave);
    }
    SEAM(5);
    if (IN(6)) {
        mix_scan<true>(lds, UXB, GYB, WGT, rw, rb, b_a, b_i, lam, TOT, YMIX, G, bx, lane, wave);
    }
    SEAM(6);
    if (IN(7)) {
        pg8::Gemm g{YMIX, WOUT, M, D, D}; pg8::StaticOrder S; S.init(M, D, G, bx);
        EpiResid<0, true> E{X1, X1, Y, SSP, MOD + 5 * D, g2, MOD + 7 * D};
        pg8::gemm_phase<EpiResid<0, true>, pg8::StaticOrder, true, true>(lds, g, S, E);
    }
    SEAM(7);
    if (IN(8)) {
        pg8::Gemm g{Y, W2I, M, FF2, D}; pg8::StaticOrder S; S.init(M, FF2, G, bx);
        EpiSwiglu E{ACT, SSP, BIAS3};
        pg8::gemm_phase<EpiSwiglu, pg8::StaticOrder, true, true>(lds, g, S, E);
    }
    SEAM(8);
    if (IN(9)) {
        pg8::Gemm g{ACT, W2O, M, D, FF}; pg8::StaticOrder S; S.init(M, D, G, bx);
        EpiResid<1, false> E{X1, out, nullptr, SSP, MOD + 8 * D, nullptr, nullptr};
        pg8::gemm_phase<EpiResid<1, false>, pg8::StaticOrder, true, true>(lds, g, S, E);
    }
    SEAM(9);
    if (IN(10)) {
        for (int m = gw; m < M; m += NGW) {
            const int b = m >> 12;
            float s = SSP[(size_t)m * 16 + (lane & 15)];
            s += __shfl_xor(s, 1); s += __shfl_xor(s, 2); s += __shfl_xor(s, 4); s += __shfl_xor(s, 8);
            const float rstd = rsqrtf(s * (1.0f / D) + EPS);
            f32x4* xr = (f32x4*)(out + (size_t)m * D) + lane;
#pragma unroll
            for (int jj = 0; jj < 4; ++jj) { const int k = 4 * lane + 256 * jj;
                const f32x4 v = xr[64 * jj];
                xr[64 * jj] = v * rstd * *(const f32x4*)(gf + k) * (*(const f32x4*)(MOD + (size_t)b * LDM + 10 * D + k) + 1.0f) + *(const f32x4*)(MOD + (size_t)b * LDM + 9 * D + k); }
        }
    }
#undef IN
#undef SEAM
}

extern "C" void kernel_launch(void* const* d_in, const int* in_sizes, int n_in, void* d_out, int out_size, void* d_ws, size_t ws_size, hipStream_t stream) {
    static int grid = 0;
    if (grid == 0) {
        if (n_in != 27 || in_sizes[0] != M * D || out_size != M * D || ws_size < WS_END) { fprintf(stderr, "kernel_launch: unexpected shapes (n_in %d, in0 %d, out %d, ws %zu)\n", n_in, n_in > 0 ? in_sizes[0] : -1, out_size, ws_size); grid = -1; return; }
        int dev = 0, cus = 0, per_cu = 0;
        if (hipGetDevice(&dev) != hipSuccess || hipDeviceGetAttribute(&cus, hipDeviceAttributeMultiprocessorCount, dev) != hipSuccess) { grid = -1; return; }
        if (hipFuncSetAttribute((const void*)mk_fwd, hipFuncAttributeMaxDynamicSharedMemorySize, LDS_BYTES) != hipSuccess) { fprintf(stderr, "kernel_launch: hipFuncSetAttribute failed\n"); grid = -1; return; }
        if (hipOccupancyMaxActiveBlocksPerMultiprocessor(&per_cu, (const void*)mk_fwd, NWAVES * 64, LDS_BYTES) != hipSuccess || per_cu < 1) fprintf(stderr, "kernel_launch: occupancy query reports %d blocks per CU\n", per_cu);
        (void)hipGetLastError();
        grid = cus;
    }
    if (grid < 0) return;
    if (hipMemsetAsync((char*)d_ws + WS_CTL, 0, CTL_ZERO_BYTES, stream) != hipSuccess) return;
    Args a{};
    for (int i = 0; i < 27; ++i) a.in[i] = (const float*)d_in[i];
    a.out = (float*)d_out; a.ws = (unsigned char*)d_ws;
#if MK_PER_PHASE
    for (int p = 0; p < NPH; ++p) { a.ph_lo = p; a.ph_hi = p + 1; hipLaunchKernelGGL(mk_fwd, dim3(grid), dim3(NWAVES * 64), LDS_BYTES, stream, a); }
#else
    a.ph_lo = 0; a.ph_hi = NPH; hipLaunchKernelGGL(mk_fwd, dim3(grid), dim3(NWAVES * 64), LDS_BYTES, stream, a);
#endif
}
```

```cpp
#include <hip/hip_runtime.h>
#include <cstdio>
#include <cstdint>
namespace pg8 {
#define PG8_LAS __attribute__((address_space(3)))
typedef unsigned short bf16_t;
typedef short bf16x8 __attribute__((ext_vector_type(8)));
typedef float f32x4 __attribute__((ext_vector_type(4)));
typedef unsigned u32x4 __attribute__((ext_vector_type(4)));
constexpr int BM = 256, BK = 64, HALF = 128, HTB = HALF * BK * 2  , STAGE_BYTES = 8 * HTB, NXCD = 8, WGM = 8;

__host__ __device__ __forceinline__ int lds_byte(int r, int c) { const int st = (r >> 4) * 2 + (c >> 5), rr = r & 15, cc = c & 31, ob = rr * 64 + cc * 2; return st * 1024 + (ob ^ (((ob >> 9) & 1) << 5)); }
__host__ __device__ __forceinline__ void stage_rc(int b, int& R, int& C) { const int st = b / 1024, sb = b % 1024, swz = sb ^ (((sb >> 9) & 1) << 5); R = (st >> 1) * 16 + swz / 64; C = (st & 1) * 32 + (swz % 64) / 2; }
__host__ __device__ __forceinline__ int perm32(int rho) { const int n = rho >> 4, i = rho & 15; return 8 * (i >> 2) + 4 * n + (i & 3); }

struct Unit { int pm, pn; };
struct Gemm { const bf16_t* A; const bf16_t* Bt; int M, N, K; };

struct StaticOrder {
    int nM, nN, nwg, G, c;
    __host__ __device__ void init(int M, int N, int G_, int c_) { nM = M / BM; nN = N / BM; nwg = nM * nN; G = G_; c = c_; }
    __host__ __device__ bool next(int i, Unit& u) const {
        const long L = (long)i * G + c; if (L >= nwg) return false;
        int wgid = (int)L; { const int q = nwg / NXCD, r = nwg % NXCD, xcd = wgid % NXCD, off = wgid / NXCD; wgid = (xcd < r ? xcd * (q + 1) : r * (q + 1) + (xcd - r) * q) + off; }
        const int nig = WGM * nN, gid = wgid / nig, fm = gid * WGM, gsz = (nM - fm) < WGM ? (nM - fm) : WGM;
        u.pm = fm + ((wgid % nig) % gsz); u.pn = (wgid % nig) / gsz; return true;
    }
    __device__ __forceinline__ void a_ready(const Unit&) const {}
    __device__ __forceinline__ void done(const Unit&) const {}
};

__device__ __forceinline__ unsigned cvt_pk_bf16(float lo, float hi) { unsigned r; asm volatile("v_cvt_pk_bf16_f32 %0, %1, %2" : "=v"(r) : "v"(lo), "v"(hi)); return r; }
#ifndef PG8_STAGE_IN_MMA
#define PG8_STAGE_IN_MMA 0
#endif
typedef int i32x4 __attribute__((ext_vector_type(4)));
template <bool I8> __device__ __forceinline__ f32x4 mma16(const bf16x8 b, const bf16x8 a, const f32x4 c) {
    if constexpr (I8) return __builtin_bit_cast(f32x4, __builtin_amdgcn_mfma_i32_16x16x64_i8(__builtin_bit_cast(i32x4, b), __builtin_bit_cast(i32x4, a), __builtin_bit_cast(i32x4, c), 0, 0, 0));
    else return __builtin_amdgcn_mfma_f32_16x16x32_bf16(b, a, c, 0, 0, 0);
}
template <class Epi, class Sched, bool ALIGN_EPI = false, bool SP2 = false, bool I8 = false>
__device__ __forceinline__ void gemm_phase(PG8_LAS unsigned char* lds, const Gemm g, const Sched& S, const Epi& E) {
    const int tid = threadIdx.x, wid = __builtin_amdgcn_readfirstlane(tid >> 6), lane = tid & 63, wr = wid >> 2, wc = wid & 3, fr = lane & 15, fq = lane >> 4;
    const int K = g.K, nt = K / BK;
    unsigned voffA[2], voffB[2];
#pragma unroll
    for (int i = 0; i < 2; ++i) { int R, C; stage_rc(tid * 16 + i * 8192, R, C); const int Rb = Epi::PERM ? ((R & ~31) + perm32(R & 31)) : R;
        voffA[i] = (unsigned)(R * K + C) * 2u; voffB[i] = (unsigned)(Rb * K + C) * 2u; }
    const size_t kstep = (size_t)(BK * 2);
    const size_t hstep = (size_t)HALF * K * 2;
    const size_t tstep = 2 * hstep;
    const unsigned ldsw = (unsigned)wid * 1024u;
    const int aoff = lds_byte(wr * 64 + fr, fq * 8), boff = lds_byte(wc * 32 + fr, fq * 8);
#define PG8_SA(b, h) (((b) * 2 + (h)) * HTB)
#define PG8_SB(b, h) ((4 + (b) * 2 + (h)) * HTB)
#define PG8_STAGE(bufoff, gbase, voff) do { _Pragma("unroll") for (int _i = 0; _i < 2; ++_i) \
        __builtin_amdgcn_global_load_lds((const unsigned*)((const char*)(gbase) + (voff)[_i]), (PG8_LAS unsigned*)(lds + (bufoff) + ldsw + _i * 8192), 16, 0, 0); } while (0)
#define PG8_LDA(dst, b, h) do { _Pragma("unroll") for (int m = 0; m < 4; ++m) _Pragma("unroll") for (int k = 0; k < 2; ++k) dst[m][k] = *(const PG8_LAS bf16x8*)(lds + PG8_SA(b, h) + aoff + m * 2048 + k * 1024); } while (0)
#define PG8_LDB(dst, b, h) do { _Pragma("unroll") for (int n = 0; n < 2; ++n) _Pragma("unroll") for (int k = 0; k < 2; ++k) dst[n][k] = *(const PG8_LAS bf16x8*)(lds + PG8_SB(b, h) + boff + n * 2048 + k * 1024); } while (0)
#define PG8_MMA(ai, bj, At, Bt) do { __builtin_amdgcn_s_setprio(1); _Pragma("unroll") for (int m = 0; m < 4; ++m) _Pragma("unroll") for (int n = 0; n < 2; ++n) _Pragma("unroll") for (int k = 0; k < 2; ++k) \
        acc[ai][bj][m][n] = mma16<I8>(Bt[n][k], At[m][k], acc[ai][bj][m][n]); __builtin_amdgcn_s_setprio(0); } while (0)
#define PG8_WAIT_V(n) asm volatile("s_waitcnt vmcnt(" #n ")" ::: "memory")
#define PG8_WAIT_L(n) asm volatile("s_waitcnt lgkmcnt(" #n ")" ::: "memory")
#define PG8_BAR __builtin_amdgcn_s_barrier()
#define PG8_SCHED __builtin_amdgcn_sched_barrier(0)
    Unit cur, nxt; int ui = 0;
    if (!S.next(0, cur)) return;
    f32x4 acc[2][2][4][2];
#pragma unroll
    for (int a = 0; a < 2; ++a)
#pragma unroll
        for (int b = 0; b < 2; ++b)
#pragma unroll
            for (int m = 0; m < 4; ++m)
#pragma unroll
                for (int n = 0; n < 2; ++n) acc[a][b][m][n] = (f32x4){0.f, 0.f, 0.f, 0.f};
    bf16x8 At[4][2], B0[2][2], B1[2][2];
    const char* cA = (const char*)g.A + (size_t)cur.pm * tstep; const char* cB = (const char*)g.Bt + (size_t)cur.pn * tstep;
    S.a_ready(cur);
    if constexpr (SP2) {
        PG8_STAGE(PG8_SB(0, 0), cB, voffB); PG8_STAGE(PG8_SB(0, 1), cB + hstep, voffB); PG8_STAGE(PG8_SA(0, 0), cA, voffA); PG8_STAGE(PG8_SA(0, 1), cA + hstep, voffA);
        if (wr == 1) PG8_BAR;
        PG8_WAIT_V(2); PG8_BAR;
        PG8_STAGE(PG8_SB(1, 0), cB + kstep, voffB); PG8_STAGE(PG8_SA(1, 0), cA + kstep, voffA); PG8_STAGE(PG8_SB(1, 1), cB + hstep + kstep, voffB);
        PG8_WAIT_V(6); PG8_BAR;
    } else {
        PG8_STAGE(PG8_SB(0, 0), cB, voffB); PG8_STAGE(PG8_SA(0, 0), cA, voffA); PG8_STAGE(PG8_SB(0, 1), cB + hstep, voffB); PG8_STAGE(PG8_SA(0, 1), cA + hstep, voffA);
        if (wr == 1) PG8_BAR;
        PG8_WAIT_V(4); PG8_BAR;
        PG8_STAGE(PG8_SB(1, 0), cB + kstep, voffB); PG8_STAGE(PG8_SA(1, 0), cA + kstep, voffA); PG8_STAGE(PG8_SB(1, 1), cB + hstep + kstep, voffB);
        PG8_WAIT_V(6); PG8_BAR;
    }
    for (;;) {
        const bool has_next = S.next(ui + 1, nxt);
        const char* nA = has_next ? (const char*)g.A + (size_t)nxt.pm * tstep : cA; const char* nB = has_next ? (const char*)g.Bt + (size_t)nxt.pn * tstep : cB;
        asm volatile(".p2align 8" ::: "memory");
        for (int t = 0; t < nt; t += 2) {
            const bool last = (t == nt - 2);
            const char* a1 = cA + (size_t)(t + 1) * kstep;
            const char* a2 = last ? nA : cA + (size_t)(t + 2) * kstep; const char* b2 = last ? nB : cB + (size_t)(t + 2) * kstep;
            const char* a3 = a2 + kstep; const char* b3 = b2 + kstep;
            if (last && has_next) S.a_ready(nxt);
            if constexpr (SP2) {
#if PG8_STAGE_IN_MMA
            PG8_LDB(B0, 0, 0); PG8_LDB(B1, 0, 1); PG8_SCHED; PG8_LDA(At, 0, 0);
            PG8_WAIT_V(6); PG8_WAIT_L(0); PG8_BAR; PG8_MMA(0, 0, At, B0); PG8_SCHED; PG8_STAGE(PG8_SA(1, 1), a1 + hstep, voffA); PG8_SCHED; PG8_MMA(0, 1, At, B1); PG8_BAR; PG8_SCHED;
            PG8_LDA(At, 0, 1);
            PG8_WAIT_V(2); PG8_WAIT_L(0); PG8_BAR; PG8_STAGE(PG8_SB(0, 0), b2, voffB); PG8_SCHED; PG8_MMA(1, 0, At, B0); PG8_SCHED; PG8_STAGE(PG8_SB(0, 1), b2 + hstep, voffB); PG8_SCHED; PG8_MMA(1, 1, At, B1); PG8_SCHED; PG8_STAGE(PG8_SA(0, 0), a2, voffA); PG8_BAR; PG8_SCHED;
            PG8_LDB(B0, 1, 0); PG8_LDB(B1, 1, 1); PG8_SCHED; PG8_LDA(At, 1, 0);
            PG8_WAIT_V(6); PG8_WAIT_L(0); PG8_BAR; PG8_MMA(0, 0, At, B0); PG8_SCHED; PG8_STAGE(PG8_SA(0, 1), a2 + hstep, voffA); PG8_SCHED; PG8_MMA(0, 1, At, B1); PG8_BAR; PG8_SCHED;
            PG8_LDA(At, 1, 1);
            PG8_WAIT_V(2); PG8_WAIT_L(0); PG8_BAR; PG8_STAGE(PG8_SB(1, 0), b3, voffB); PG8_SCHED; PG8_MMA(1, 0, At, B0); PG8_SCHED; PG8_STAGE(PG8_SB(1, 1), b3 + hstep, voffB); PG8_SCHED; PG8_MMA(1, 1, At, B1); PG8_SCHED; PG8_STAGE(PG8_SA(1, 0), a3, voffA); PG8_BAR; PG8_SCHED;
#else
            PG8_LDB(B0, 0, 0); PG8_LDB(B1, 0, 1); PG8_SCHED; PG8_LDA(At, 0, 0); PG8_STAGE(PG8_SA(1, 1), a1 + hstep, voffA);
            PG8_WAIT_V(8); PG8_WAIT_L(0); PG8_BAR; PG8_MMA(0, 0, At, B0); PG8_MMA(0, 1, At, B1); PG8_BAR; PG8_SCHED;
            PG8_LDA(At, 0, 1); PG8_STAGE(PG8_SB(0, 0), b2, voffB); PG8_STAGE(PG8_SB(0, 1), b2 + hstep, voffB); PG8_STAGE(PG8_SA(0, 0), a2, voffA);
            PG8_WAIT_V(8); PG8_WAIT_L(0); PG8_BAR; PG8_MMA(1, 0, At, B0); PG8_MMA(1, 1, At, B1); PG8_BAR; PG8_SCHED;
            PG8_LDB(B0, 1, 0); PG8_LDB(B1, 1, 1); PG8_SCHED; PG8_LDA(At, 1, 0); PG8_STAGE(PG8_SA(0, 1), a2 + hstep, voffA);
            PG8_WAIT_V(8); PG8_WAIT_L(0); PG8_BAR; PG8_MMA(0, 0, At, B0); PG8_MMA(0, 1, At, B1); PG8_BAR; PG8_SCHED;
            PG8_LDA(At, 1, 1); PG8_STAGE(PG8_SB(1, 0), b3, voffB); PG8_STAGE(PG8_SB(1, 1), b3 + hstep, voffB); PG8_STAGE(PG8_SA(1, 0), a3, voffA);
            PG8_WAIT_V(8); PG8_WAIT_L(0); PG8_BAR; PG8_MMA(1, 0, At, B0); PG8_MMA(1, 1, At, B1); PG8_BAR; PG8_SCHED;
#endif
            } else {
            PG8_LDB(B0, 0, 0); PG8_SCHED; PG8_LDA(At, 0, 0); PG8_STAGE(PG8_SA(1, 1), a1 + hstep, voffA);
            PG8_WAIT_L(8); PG8_BAR; PG8_WAIT_L(0); PG8_MMA(0, 0, At, B0); PG8_BAR; PG8_SCHED;
            PG8_LDB(B1, 0, 1); PG8_STAGE(PG8_SB(0, 0), b2, voffB);
            PG8_BAR; PG8_WAIT_L(0); PG8_MMA(0, 1, At, B1); PG8_BAR;
            PG8_LDA(At, 0, 1); PG8_STAGE(PG8_SA(0, 0), a2, voffA);
            PG8_BAR; PG8_WAIT_L(0); PG8_MMA(1, 0, At, B0); PG8_BAR; PG8_SCHED;
            PG8_STAGE(PG8_SB(0, 1), b2 + hstep, voffB);
            PG8_WAIT_V(6); PG8_BAR; PG8_MMA(1, 1, At, B1); PG8_BAR;
            PG8_LDB(B0, 1, 0); PG8_SCHED; PG8_LDA(At, 1, 0); PG8_STAGE(PG8_SA(0, 1), a2 + hstep, voffA);
            PG8_WAIT_L(8); PG8_BAR; PG8_WAIT_L(0); PG8_MMA(0, 0, At, B0); PG8_BAR; PG8_SCHED;
            PG8_LDB(B1, 1, 1); PG8_STAGE(PG8_SB(1, 0), b3, voffB);
            PG8_BAR; PG8_WAIT_L(0); PG8_MMA(0, 1, At, B1); PG8_BAR;
            PG8_LDA(At, 1, 1); PG8_STAGE(PG8_SA(1, 0), a3, voffA);
            PG8_BAR; PG8_WAIT_L(0); PG8_MMA(1, 0, At, B0); PG8_BAR; PG8_SCHED;
            PG8_STAGE(PG8_SB(1, 1), b3 + hstep, voffB);
            PG8_WAIT_V(6); PG8_BAR; PG8_MMA(1, 1, At, B1); PG8_BAR;
            }
        }
        if constexpr (ALIGN_EPI) { if (wr == 0) PG8_BAR; }
        if constexpr (!Epi::AFTER_DRAIN) { _Pragma("unroll") for (int er = 0; er < Epi::REPS; ++er) { E(acc, cur, wr, wc, fr, fq); if (er + 1 < Epi::REPS) asm volatile("" ::: "memory"); } S.done(cur); }
        if (!has_next) break;
#pragma unroll
        for (int a = 0; a < 2; ++a)
#pragma unroll
            for (int b = 0; b < 2; ++b)
#pragma unroll
                for (int m = 0; m < 4; ++m)
#pragma unroll
                    for (int n = 0; n < 2; ++n) acc[a][b][m][n] = (f32x4){0.f, 0.f, 0.f, 0.f};
        cur = nxt; cA = nA; cB = nB; ++ui;
        if constexpr (ALIGN_EPI) { if (wr == 1) PG8_BAR; }
    }
    PG8_WAIT_V(0);
    if constexpr (!ALIGN_EPI) { if (wr == 0) PG8_BAR; }
    PG8_BAR;
    if constexpr (Epi::AFTER_DRAIN) { E.fused(acc, cur, wr, wc, fr, fq, lds, wid, lane); S.done(cur); }
#undef PG8_SA
#undef PG8_SB
#undef PG8_STAGE
#undef PG8_LDA
#undef PG8_LDB
#undef PG8_MMA
#undef PG8_WAIT_V
#undef PG8_WAIT_L
#undef PG8_BAR
#undef PG8_SCHED
}
}
#define GAS __attribute__((address_space(1)))
#define LAS __attribute__((address_space(3)))
typedef unsigned short bf16;
typedef unsigned v4u __attribute__((ext_vector_type(4)));
typedef float f32x4 __attribute__((ext_vector_type(4)));
typedef short bf16x8 __attribute__((ext_vector_type(8)));
typedef GAS unsigned gu32;
typedef GAS unsigned long long gu64;
#define RLX_AGENT __ATOMIC_RELAXED, __HIP_MEMORY_SCOPE_AGENT
#define LDS_WAIT() asm volatile("s_waitcnt lgkmcnt(0)" ::: "memory")
#define VM_WAIT() asm volatile("s_waitcnt vmcnt(0)" ::: "memory")
__device__ __forceinline__ unsigned long long rt() { return __builtin_amdgcn_s_memrealtime(); }
__device__ __forceinline__ unsigned f2bf(float f) { unsigned u = __builtin_bit_cast(unsigned, f); return (u + 0x7fffu + ((u >> 16) & 1u)) >> 16; }
__device__ __forceinline__ unsigned pk2(float lo, float hi) { return f2bf(lo) | (f2bf(hi) << 16); }

#define XB_TMO      128
#define XB_XCNT(j)  (256  + 64 * (j))
#define XB_XSUB(j)  (1280 + 64 * (j))
#define XB_XGEN(j)  (2304 + 64 * (j))
#define XB_TOP      3328
#define XB_TOPGEN   3392
#define XCD_BAR_WORDS 3456
#define XB_SPIN_CAP (1u << 18)

__device__ __forceinline__ unsigned xb_ld(unsigned* p)              { return __hip_atomic_load(p, __ATOMIC_RELAXED, __HIP_MEMORY_SCOPE_AGENT); }
__device__ __forceinline__ unsigned xb_add(unsigned* p, unsigned v) { return __hip_atomic_fetch_add(p, v, __ATOMIC_RELAXED, __HIP_MEMORY_SCOPE_AGENT); }
__device__ __forceinline__ unsigned xb_xcc_id() { return (unsigned)__builtin_amdgcn_s_getreg((3 << 11) | 20) & 0xFu; }
#define XB_SPIN(cond, bar) do { unsigned _sp = 0; while (cond) { __builtin_amdgcn_s_sleep(1); \
    if ((++_sp & 255u) == 0u) { if (xb_ld(&(bar)[XB_TMO])) break; if (_sp > XB_SPIN_CAP) { atomicAdd(&(bar)[XB_TMO], 1u); break; } } } } while (0)

struct XcdBarrier {
    unsigned* bar; unsigned x;
    volatile LAS unsigned* st;
};

__device__ __forceinline__ XcdBarrier xcd_barrier_post(unsigned* bar, volatile LAS unsigned* st) {
    XcdBarrier b; b.bar = bar; b.x = xb_xcc_id(); b.st = st;
    if (threadIdx.x == 0) (void)xb_add(&bar[XB_XCNT(b.x)], 1u);
    return b;
}
__device__ __forceinline__ void xcd_barrier_complete(unsigned* bar, unsigned x, unsigned& nloc, unsigned& nx) {
    const unsigned G = gridDim.x * gridDim.y * gridDim.z;
    unsigned sum, cnt, mine, sp = 0u;
    for (;;) {
        sum = 0u; cnt = 0u; mine = 0u;
#pragma unroll
        for (unsigned j = 0; j < 16; ++j) { const unsigned c = xb_ld(&bar[XB_XCNT(j)]); sum += c; cnt += (c > 0u) ? 1u : 0u; mine = (j == x) ? c : mine; }
        if (sum == G) break;
        __builtin_amdgcn_s_sleep(1);
        if ((++sp & 255u) == 0u) { if (xb_ld(&bar[XB_TMO])) break; if (sp > XB_SPIN_CAP) { atomicAdd(&bar[XB_TMO], 1u); break; } }
    }
    nloc = mine > 0u ? mine : 1u; nx = cnt > 0u ? cnt : 1u;
}

__device__ __forceinline__ void xcd_barrier(const XcdBarrier& b) {
    asm volatile("s_waitcnt vmcnt(0)" ::: "memory");
    __syncthreads();
    if (threadIdx.x == 0) {
        unsigned* bar = b.bar;
        __builtin_amdgcn_s_waitcnt(0);
        unsigned nloc = b.st[0], nx = b.st[1];
        if (nloc == 0u) { xcd_barrier_complete(bar, b.x, nloc, nx); b.st[0] = nloc; b.st[1] = nx; }
        const unsigned old = xb_add(&bar[XB_XSUB(b.x)], 1u);
        const unsigned gen = old / nloc;
        if (old + 1u == (gen + 1u) * nloc) {
            __builtin_amdgcn_fence(__ATOMIC_RELEASE, "agent");
            asm volatile("s_waitcnt vmcnt(0)" ::: "memory");
            const unsigned og = xb_add(&bar[XB_TOP], 1u);
            const unsigned tg = og / nx;
            if (og + 1u == (tg + 1u) * nx) xb_add(&bar[XB_TOPGEN], 1u);
            else XB_SPIN(xb_ld(&bar[XB_TOPGEN]) == tg, bar);
            __builtin_amdgcn_fence(__ATOMIC_ACQUIRE, "agent");
            xb_add(&bar[XB_XGEN(b.x)], 1u);
            asm volatile("s_waitcnt vmcnt(0)" ::: "memory");
        } else {
            XB_SPIN(xb_ld(&bar[XB_XGEN(b.x)]) == gen, bar);
            __builtin_amdgcn_fence(__ATOMIC_ACQUIRE, "agent");
            asm volatile("s_waitcnt vmcnt(0)" ::: "memory");
        }
    }
    __syncthreads();
}

constexpr int NWAVES = 8;
constexpr int NB = 8, SEQ = 4096, D = 1024, M = NB * SEQ, FF = 2816, FF2 = 2 * FF, DC = 512, DR = 512, NH = 8, HD = 64, CW = 31, RW = 4, NMIX = 2048;
constexpr float EPS = 1e-6f;
constexpr int LDM = 11 * D;
constexpr size_t MiB = 1u << 20;
constexpr size_t WS_CTL = 0, CTL_ZERO_BYTES = 1 * MiB;
constexpr size_t WS_MOD = 1 * MiB;
constexpr size_t WS_BIAS1 = 1 * MiB + 512 * 1024;
constexpr size_t WS_BIAS3 = 1 * MiB + 768 * 1024;
constexpr size_t WS_BIAS2 = 2 * MiB;
constexpr size_t WS_WGT = 2 * MiB + 128 * 1024;
constexpr size_t WS_CS1 = 2 * MiB + 384 * 1024, WS_CS3 = 2 * MiB + 448 * 1024;
constexpr size_t WS_RS1 = 2 * MiB + 512 * 1024, WS_RS3 = 2 * MiB + 640 * 1024;
constexpr size_t WS_CS2 = 2 * MiB + 480 * 1024, WS_RS2 = 2 * MiB + 768 * 1024;
constexpr size_t WS_TOT = 3 * MiB;
constexpr size_t WS_SSP = 5 * MiB;
constexpr size_t WS_W1I = 8 * MiB, WS_W1O = 19 * MiB, WS_WIN = 25 * MiB, WS_WOUT = 29 * MiB, WS_W2I = 31 * MiB, WS_W2O = 42 * MiB;
constexpr size_t WS_Y = 48 * MiB;
constexpr size_t WS_X1 = 112 * MiB;
constexpr size_t WS_ACT = 240 * MiB;
constexpr size_t WS_U = WS_ACT, WS_UX = WS_ACT + 32 * MiB, WS_GY = WS_ACT + 64 * MiB, WS_YMIX = WS_ACT + 96 * MiB;
constexpr size_t WS_SSPF = 416 * MiB;
constexpr size_t WS_SSPX = 418 * MiB;
constexpr size_t WS_SSPX3 = 422 * MiB;
constexpr size_t WS_END = 426 * MiB;
constexpr int CW_BAR = 4096, CW_SEAM = 16384, CW_SCAN = 32768, CW_SEAM7 = 49152, CW_SEAM3 = 65536;
constexpr int LDS_BYTES = 147456;
constexpr int LDSCTL_OFF = LDS_BYTES - 256;

typedef unsigned short u16;
typedef float f32x16 __attribute__((ext_vector_type(16)));
typedef float f32x2 __attribute__((ext_vector_type(2)));

__device__ __forceinline__ float wave_sum(float v) {
#pragma unroll
    for (int o = 1; o < 64; o <<= 1) v += __shfl_xor(v, o);
    return v;
}
__device__ __forceinline__ float sigmoid_fast(float x) { return __builtin_amdgcn_rcpf(1.f + __builtin_amdgcn_exp2f(-1.4426950408889634f * x)); }
__device__ __forceinline__ float silu_fast(float x) { return x * sigmoid_fast(x); }
__device__ __forceinline__ float gelu_tanh_fast(float x) { const float z = 0.7978845608028654f * (x + 0.044715f * x * x * x); return x * sigmoid_fast(2.f * z); }
__device__ __forceinline__ f32x4 sigmoid4(const f32x4 x) { const f32x4 t = x * -1.4426950408889634f; f32x4 e = {__builtin_amdgcn_exp2f(t[0]), __builtin_amdgcn_exp2f(t[1]), __builtin_amdgcn_exp2f(t[2]), __builtin_amdgcn_exp2f(t[3])};
    e = e + 1.0f; return (f32x4){__builtin_amdgcn_rcpf(e[0]), __builtin_amdgcn_rcpf(e[1]), __builtin_amdgcn_rcpf(e[2]), __builtin_amdgcn_rcpf(e[3])}; }
__device__ __forceinline__ f32x4 gelu_tanh4(const f32x4 x) { const f32x4 z2 = (x + (x * x) * x * 0.044715f) * (2.0f * 0.7978845608028654f); return x * sigmoid4(z2); }
__device__ __forceinline__ float bflo(unsigned w) { return __uint_as_float(w << 16); }
__device__ __forceinline__ float bfhi(unsigned w) { return __uint_as_float(w & 0xffff0000u); }
__device__ __forceinline__ unsigned cvtpk(float lo, float hi) { return pg8::cvt_pk_bf16(lo, hi); }
__device__ __forceinline__ v4u pack8(const f32x4 a, const f32x4 b) { v4u w; w.x = cvtpk(a[0], a[1]); w.y = cvtpk(a[2], a[3]); w.z = cvtpk(b[0], b[1]); w.w = cvtpk(b[2], b[3]); return w; }

__device__ __forceinline__ void unpack8(const v4u w, f32x4& a, f32x4& b) { a = (f32x4){bflo(w.x), bfhi(w.x), bflo(w.y), bfhi(w.y)}; b = (f32x4){bflo(w.z), bfhi(w.z), bflo(w.w), bfhi(w.w)}; }
__device__ __forceinline__ unsigned q8(float v) { int q = (int)__builtin_rintf(v); q = q < -127 ? -127 : (q > 127 ? 127 : q); return (unsigned)q & 0xffu; }
__device__ __forceinline__ unsigned q8x4(const f32x4 v) { return q8(v[0]) | (q8(v[1]) << 8) | (q8(v[2]) << 16) | (q8(v[3]) << 24); }
__device__ __forceinline__ float wave_max(float v) {
#pragma unroll
    for (int o = 1; o < 64; o <<= 1) v = fmaxf(v, __shfl_xor(v, o));
    return v;
}
typedef int i32x4v __attribute__((ext_vector_type(4)));
__device__ __forceinline__ f32x4 acc_i2f(const f32x4 a) { return __builtin_convertvector(__builtin_bit_cast(i32x4v, a), f32x4); }
__device__ __forceinline__ void load_rstd(const float* ssp, int row0, int fq, float (&rs)[2][4]) {
#pragma unroll
    for (int ai = 0; ai < 2; ++ai)
#pragma unroll
        for (int m = 0; m < 4; ++m) { const f32x4 p = *(const f32x4*)(ssp + (size_t)(row0 + ai * 128 + m * 16) * 16 + 4 * fq);
            float s = (p[0] + p[1]) + (p[2] + p[3]); s += __shfl_xor(s, 16); s += __shfl_xor(s, 32); rs[ai][m] = rsqrtf(s * (1.0f / D) + EPS); }
}
__device__ __forceinline__ void load_rstd_sc1(const float* ssp, int row0, int fq, float (&rs)[2][4]) {
#pragma unroll
    for (int ai = 0; ai < 2; ++ai)
#pragma unroll
        for (int m = 0; m < 4; ++m) { const gu32* p = (const gu32*)(ssp + (size_t)(row0 + ai * 128 + m * 16) * 16 + 4 * fq);
            const float p0 = __uint_as_float(__hip_atomic_load(p, RLX_AGENT)), p1 = __uint_as_float(__hip_atomic_load(p + 1, RLX_AGENT)), p2 = __uint_as_float(__hip_atomic_load(p + 2, RLX_AGENT)), p3 = __uint_as_float(__hip_atomic_load(p + 3, RLX_AGENT));
            float s = (p0 + p1) + (p2 + p3); s += __shfl_xor(s, 16); s += __shfl_xor(s, 32); rs[ai][m] = rsqrtf(s * (1.0f / D) + EPS); }
}
#ifndef MK_EPI_SWIGLU_REPS
#define MK_EPI_SWIGLU_REPS 1
#endif
#ifndef MK_EPI_RESID_REPS
#define MK_EPI_RESID_REPS 1
#endif
struct EpiSwiglu {
    static constexpr bool PERM = true, AFTER_DRAIN = false; static constexpr int REPS = MK_EPI_SWIGLU_REPS;
    pg8::bf16_t* act; const float* ssp; const float* bias;
    __device__ __forceinline__ void operator()(const f32x4 (&acc)[2][2][4][2], const pg8::Unit& u, int wr, int wc, int fr, int fq) const {
        const int row0 = u.pm * 256 + wr * 64 + fr, b = u.pm >> 4;
        float rs[2][4]; load_rstd(ssp, row0, fq, rs);
        const float* bp = bias + (size_t)b * FF2 + u.pn * 256 + wc * 32 + 8 * fq;
        const f32x4 bg0 = *(const f32x4*)(bp), bg1 = *(const f32x4*)(bp + 4), bu0 = *(const f32x4*)(bp + 128), bu1 = *(const f32x4*)(bp + 132);
        const int oc = u.pn * 128 + wc * 32 + 8 * fq;
#pragma unroll
        for (int ai = 0; ai < 2; ++ai)
#pragma unroll
            for (int m = 0; m < 4; ++m) { const float r = rs[ai][m];
                const f32x4 g0 = acc[ai][0][m][0] * r + bg0, g1 = acc[ai][0][m][1] * r + bg1, u0 = acc[ai][1][m][0] * r + bu0, u1 = acc[ai][1][m][1] * r + bu1;
                const f32x4 a0 = (g0 * sigmoid4(g0)) * u0, a1 = (g1 * sigmoid4(g1)) * u1;
                *(v4u*)(act + (size_t)(row0 + ai * 128 + m * 16) * FF + oc) = pack8(a0, a1); }
    }
};
struct EpiSwiglu8 {
    static constexpr bool PERM = true, AFTER_DRAIN = false; static constexpr int REPS = 1;
    pg8::bf16_t* act; const float* rs; const float* cs; const float* bias;
    __device__ __forceinline__ void operator()(const f32x4 (&acc)[2][2][4][2], const pg8::Unit& u, int wr, int wc, int fr, int fq) const {
        const int row0 = u.pm * 256 + wr * 64 + fr, b = u.pm >> 4;
        float rv[2][4];
#pragma unroll
        for (int ai = 0; ai < 2; ++ai)
#pragma unroll
            for (int m = 0; m < 4; ++m) rv[ai][m] = rs[row0 + ai * 128 + m * 16];
        const int cb = u.pn * 256 + wc * 32 + 8 * fq;
        const float* bp = bias + (size_t)b * FF2 + cb; const float* cp = cs + cb;
        const f32x4 bg0 = *(const f32x4*)(bp), bg1 = *(const f32x4*)(bp + 4), bu0 = *(const f32x4*)(bp + 128), bu1 = *(const f32x4*)(bp + 132);
        const f32x4 cg0 = *(const f32x4*)(cp), cg1 = *(const f32x4*)(cp + 4), cu0 = *(const f32x4*)(cp + 128), cu1 = *(const f32x4*)(cp + 132);
        const int oc = u.pn * 128 + wc * 32 + 8 * fq;
#pragma unroll
        for (int ai = 0; ai < 2; ++ai)
#pragma unroll
            for (int m = 0; m < 4; ++m) { const float r = rv[ai][m];
                const f32x4 g0 = acc_i2f(acc[ai][0][m][0]) * (cg0 * r) + bg0, g1 = acc_i2f(acc[ai][0][m][1]) * (cg1 * r) + bg1;
                const f32x4 u0 = acc_i2f(acc[ai][1][m][0]) * (cu0 * r) + bu0, u1 = acc_i2f(acc[ai][1][m][1]) * (cu1 * r) + bu1;
                const f32x4 a0 = (g0 * sigmoid4(g0)) * u0, a1 = (g1 * sigmoid4(g1)) * u1;
                *(v4u*)(act + (size_t)(row0 + ai * 128 + m * 16) * FF + oc) = pack8(a0, a1); }
    }
};
template <int WHALF, bool HASY, bool IN16> struct EpiResid {
    static constexpr bool PERM = true, AFTER_DRAIN = false; static constexpr int REPS = (IN16 ? 1 : MK_EPI_RESID_REPS);
    static constexpr float w = WHALF ? 0.5f : 1.0f;
    const void* xin; pg8::bf16_t* xout; pg8::bf16_t* y; float* ssp; const float* gt; const float* gnext; const float* scnext;
    __device__ __forceinline__ void operator()(const f32x4 (&acc)[2][2][4][2], const pg8::Unit& u, int wr, int wc, int fr, int fq) const {
        const int row0 = u.pm * 256 + wr * 64 + fr, b = u.pm >> 4;
        float ss[2][4];
#pragma unroll
        for (int ai = 0; ai < 2; ++ai)
#pragma unroll
            for (int m = 0; m < 4; ++m) ss[ai][m] = 0.f;
#pragma unroll
        for (int bj = 0; bj < 2; ++bj) { const int c0 = u.pn * 256 + bj * 128 + wc * 32 + 8 * fq;
            const f32x4 gt0 = *(const f32x4*)(gt + (size_t)b * LDM + c0) * w, gt1 = *(const f32x4*)(gt + (size_t)b * LDM + c0 + 4) * w;
            f32x4 gs0 = {0.f, 0.f, 0.f, 0.f}, gs1 = gs0;
            if (HASY) { gs0 = *(const f32x4*)(gnext + c0) * (*(const f32x4*)(scnext + (size_t)b * LDM + c0) + 1.0f); gs1 = *(const f32x4*)(gnext + c0 + 4) * (*(const f32x4*)(scnext + (size_t)b * LDM + c0 + 4) + 1.0f); }
#pragma unroll
            for (int ai = 0; ai < 2; ++ai)
#pragma unroll
                for (int m = 0; m < 4; ++m) { const size_t off = (size_t)(row0 + ai * 128 + m * 16) * D + c0;
                    f32x4 x0, x1;
                    if (IN16) unpack8(*(const v4u*)((const pg8::bf16_t*)xin + off), x0, x1); else { x0 = *(const f32x4*)((const float*)xin + off); x1 = *(const f32x4*)((const float*)xin + off + 4); }
                    const f32x4 o0 = x0 + gt0 * acc[ai][bj][m][0], o1 = x1 + gt1 * acc[ai][bj][m][1];
                    *(v4u*)(xout + off) = pack8(o0, o1);
                    ss[ai][m] += (o0[0] * o0[0] + o0[1] * o0[1]) + (o0[2] * o0[2] + o0[3] * o0[3]) + (o1[0] * o1[0] + o1[1] * o1[1]) + (o1[2] * o1[2] + o1[3] * o1[3]);
                    if (HASY) *(v4u*)(y + off) = pack8(o0 * gs0, o1 * gs1); } }
#pragma unroll
        for (int ai = 0; ai < 2; ++ai)
#pragma unroll
            for (int m = 0; m < 4; ++m) { float s = ss[ai][m]; s += __shfl_xor(s, 16); s += __shfl_xor(s, 32);
                if (fq == 0) ssp[(size_t)(row0 + ai * 128 + m * 16) * 16 + u.pn * 4 + wc] = s; }
    }
};
template <int WHALF, bool IN16> struct EpiResidQ {
    static constexpr bool PERM = true, AFTER_DRAIN = false; static constexpr int REPS = 1;
    static constexpr float w = WHALF ? 0.5f : 1.0f;
    const void* xin; pg8::bf16_t* xout; unsigned char* a8; float* rs; f32x2* sspx; const float* gt; const float* gnext; const float* scnext; unsigned* cnt;
    __device__ __forceinline__ void operator()(f32x4 (&acc)[2][2][4][2], const pg8::Unit& u, int wr, int wc, int fr, int fq) const {
        const int row0 = u.pm * 256 + wr * 64 + fr, b = u.pm >> 4;
        float ss[2][4], am[2][4];
#pragma unroll
        for (int ai = 0; ai < 2; ++ai)
#pragma unroll
            for (int m = 0; m < 4; ++m) { ss[ai][m] = 0.f; am[ai][m] = 0.f; }
        const unsigned voff = (unsigned)((row0 * D + u.pn * 256 + wc * 32 + 8 * fq) * 2);
        unsigned vo[4] = {voff, voff, voff, voff};
#pragma unroll
        for (int bj = 0; bj < 2; ++bj) { const int c0 = u.pn * 256 + bj * 128 + wc * 32 + 8 * fq;
            const f32x4 gt0 = *(const f32x4*)(gt + (size_t)b * LDM + c0) * w, gt1 = *(const f32x4*)(gt + (size_t)b * LDM + c0 + 4) * w;
            const f32x4 gs0 = *(const f32x4*)(gnext + c0) * (*(const f32x4*)(scnext + (size_t)b * LDM + c0) + 1.0f), gs1 = *(const f32x4*)(gnext + c0 + 4) * (*(const f32x4*)(scnext + (size_t)b * LDM + c0 + 4) + 1.0f);
#pragma unroll
            for (int ai = 0; ai < 2; ++ai)
#pragma unroll
                for (int m = 0; m < 4; ++m) { const unsigned so = (unsigned)(((ai * 128 + m * 16) * D + bj * 128) * 2); const int g = m & 3;
                    f32x4 x0, x1;
                    if (IN16) unpack8(*(const v4u*)((const char*)xin + (size_t)(vo[g] + so)), x0, x1);
                    else { const char* p = (const char*)xin + 2 * (size_t)(vo[g] + so); x0 = *(const f32x4*)p; x1 = *(const f32x4*)(p + 16); }
                    const f32x4 o0 = x0 + gt0 * acc[ai][bj][m][0], o1 = x1 + gt1 * acc[ai][bj][m][1];
                    *(v4u*)((char*)xout + (size_t)(vo[g] + so)) = pack8(o0, o1);
                    acc[ai][bj][m][0] = o0; acc[ai][bj][m][1] = o1;
                    ss[ai][m] += (o0[0] * o0[0] + o0[1] * o0[1]) + (o0[2] * o0[2] + o0[3] * o0[3]) + (o1[0] * o1[0] + o1[1] * o1[1]) + (o1[2] * o1[2] + o1[3] * o1[3]);
                    const f32x4 t0 = __builtin_elementwise_abs(o0 * gs0), t1 = __builtin_elementwise_abs(o1 * gs1);
                    am[ai][m] = fmaxf(am[ai][m], fmaxf(fmaxf(fmaxf(t0[0], t0[1]), fmaxf(t0[2], t0[3])), fmaxf(fmaxf(t1[0], t1[1]), fmaxf(t1[2], t1[3]))));
                    asm volatile("" : "+v"(vo[g]) : "v"(ss[ai][m])); } }
#pragma unroll
        for (int ai = 0; ai < 2; ++ai)
#pragma unroll
            for (int m = 0; m < 4; ++m) { float s = ss[ai][m], a = am[ai][m]; s += __shfl_xor(s, 16); s += __shfl_xor(s, 32); a = fmaxf(a, __shfl_xor(a, 16)); a = fmaxf(a, __shfl_xor(a, 32));
                if (fq == 0) __hip_atomic_store((gu64*)(sspx + (size_t)(row0 + ai * 128 + m * 16) * 16 + u.pn * 4 + wc), ((unsigned long long)__float_as_uint(a) << 32) | __float_as_uint(s), RLX_AGENT); }
        asm volatile("s_waitcnt vmcnt(0)" ::: "memory");
        unsigned* cw = cnt + 64 * u.pm;
        if ((threadIdx.x & 63) == 0) __hip_atomic_fetch_add(cw, 1u, __ATOMIC_RELAXED, __HIP_MEMORY_SCOPE_AGENT);
        if (threadIdx.x < 64) {
            unsigned sp = 0;
            while ((unsigned)__builtin_amdgcn_readfirstlane(__hip_atomic_load(cw, __ATOMIC_RELAXED, __HIP_MEMORY_SCOPE_AGENT)) < 32u) { __builtin_amdgcn_s_sleep(1); if (++sp > (1u << 20)) break; }
            __builtin_amdgcn_fence(__ATOMIC_ACQUIRE, "agent");
            asm volatile("s_waitcnt vmcnt(0)" ::: "memory");
        }
        asm volatile("" ::: "memory"); __builtin_amdgcn_s_barrier(); asm volatile("" ::: "memory");
        float qs[2][4];
#pragma unroll
        for (int ai = 0; ai < 2; ++ai)
#pragma unroll
            for (int m = 0; m < 4; ++m) { const int row = row0 + ai * 128 + m * 16; const gu64* p = (const gu64*)(sspx + (size_t)row * 16 + 4 * fq);
                float s = 0.f, a = 0.f;
#pragma unroll
                for (int e = 0; e < 4; ++e) { const unsigned long long t = __hip_atomic_load(p + e, RLX_AGENT); s += __uint_as_float((unsigned)t); a = fmaxf(a, __uint_as_float((unsigned)(t >> 32))); }
                s += __shfl_xor(s, 16); s += __shfl_xor(s, 32); a = fmaxf(a, __shfl_xor(a, 16)); a = fmaxf(a, __shfl_xor(a, 32));
                qs[ai][m] = a > 0.f ? 127.0f / a : 0.f;
                if (u.pn == 0 && wc == 0 && fq == 0) rs[row] = rsqrtf(s * (1.0f / D) + EPS) * a * (1.0f / 127.0f); }
        const unsigned voff8 = (unsigned)(row0 * D + u.pn * 256 + wc * 32 + 8 * fq);
#pragma unroll
        for (int bj = 0; bj < 2; ++bj) { const int c0 = u.pn * 256 + bj * 128 + wc * 32 + 8 * fq;
            const f32x4 gs0 = *(const f32x4*)(gnext + c0) * (*(const f32x4*)(scnext + (size_t)b * LDM + c0) + 1.0f), gs1 = *(const f32x4*)(gnext + c0 + 4) * (*(const f32x4*)(scnext + (size_t)b * LDM + c0 + 4) + 1.0f);
#pragma unroll
            for (int ai = 0; ai < 2; ++ai)
#pragma unroll
                for (int m = 0; m < 4; ++m) { const float q = qs[ai][m]; const unsigned so = (unsigned)((ai * 128 + m * 16) * D + bj * 128);
                    *(unsigned long long*)(a8 + (size_t)(voff8 + so)) = (unsigned long long)q8x4(acc[ai][bj][m][0] * gs0 * q) | ((unsigned long long)q8x4(acc[ai][bj][m][1] * gs1 * q) << 32); } }
    }
};
struct EpiResidFinal {
    static constexpr bool PERM = true, AFTER_DRAIN = false; static constexpr int REPS = 1;
    const pg8::bf16_t* xin; float* out; float* ssp; const float* gt; const float* gf; const float* fsc; const float* fsh; unsigned* cnt;
    __device__ __forceinline__ void operator()(f32x4 (&acc)[2][2][4][2], const pg8::Unit& u, int wr, int wc, int fr, int fq) const {
        const int row0 = u.pm * 256 + wr * 64 + fr, b = u.pm >> 4;
        const __amdgpu_buffer_rsrc_t rx = __builtin_amdgcn_make_buffer_rsrc((void*)xin, 0, M * D * 4, 0x00020000), ro = __builtin_amdgcn_make_buffer_rsrc((void*)out, 0, M * D * 4, 0x00020000);
        const unsigned voff = (unsigned)((row0 * D + u.pn * 256 + wc * 32 + 8 * fq) * 4);
        float ss[2][4];
#pragma unroll
        for (int ai = 0; ai < 2; ++ai)
#pragma unroll
            for (int m = 0; m < 4; ++m) ss[ai][m] = 0.f;
        unsigned vo[4] = {voff, voff, voff, voff};
#pragma unroll
        for (int bj = 0; bj < 2; ++bj) { const int c0 = u.pn * 256 + bj * 128 + wc * 32 + 8 * fq;
            const f32x4 gt0 = *(const f32x4*)(gt + (size_t)b * LDM + c0) * 0.5f, gt1 = *(const f32x4*)(gt + (size_t)b * LDM + c0 + 4) * 0.5f;
#pragma unroll
            for (int ai = 0; ai < 2; ++ai)
#pragma unroll
                for (int m = 0; m < 4; ++m) { const unsigned so = (unsigned)(((ai * 128 + m * 16) * D + bj * 128) * 4); const int g = m & 3;
                    f32x4 x0, x1; unpack8(*(const v4u*)((const char*)xin + (size_t)((vo[g] + so) >> 1)), x0, x1);
                    const f32x4 o0 = x0 + gt0 * acc[ai][bj][m][0], o1 = x1 + gt1 * acc[ai][bj][m][1];
                    acc[ai][bj][m][0] = o0; acc[ai][bj][m][1] = o1;
                    ss[ai][m] += (o0[0] * o0[0] + o0[1] * o0[1]) + (o0[2] * o0[2] + o0[3] * o0[3]) + (o1[0] * o1[0] + o1[1] * o1[1]) + (o1[2] * o1[2] + o1[3] * o1[3]);
                    asm volatile("" : "+v"(vo[g]) : "v"(ss[ai][m])); } }
#pragma unroll
        for (int ai = 0; ai < 2; ++ai)
#pragma unroll
            for (int m = 0; m < 4; ++m) { float s = ss[ai][m]; s += __shfl_xor(s, 16); s += __shfl_xor(s, 32);
                if (fq == 0) __hip_atomic_store((gu32*)(ssp + (size_t)(row0 + ai * 128 + m * 16) * 16 + u.pn * 4 + wc), __float_as_uint(s), RLX_AGENT); }
        asm volatile("s_waitcnt vmcnt(0)" ::: "memory");
        unsigned* cw = cnt + 64 * u.pm;
        if ((threadIdx.x & 63) == 0) __hip_atomic_fetch_add(cw, 1u, __ATOMIC_RELAXED, __HIP_MEMORY_SCOPE_AGENT);
        if (threadIdx.x < 64) {
            unsigned sp = 0;
            while ((unsigned)__builtin_amdgcn_readfirstlane(__hip_atomic_load(cw, __ATOMIC_RELAXED, __HIP_MEMORY_SCOPE_AGENT)) < 32u) { __builtin_amdgcn_s_sleep(1); if (++sp > (1u << 20)) break; }
            __builtin_amdgcn_fence(__ATOMIC_ACQUIRE, "agent");
            asm volatile("s_waitcnt vmcnt(0)" ::: "memory");
        }
        asm volatile("" ::: "memory"); __builtin_amdgcn_s_barrier(); asm volatile("" ::: "memory");
        float rs[2][4]; load_rstd_sc1(ssp, row0, fq, rs);
#pragma unroll
        for (int bj = 0; bj < 2; ++bj) { const int c0 = u.pn * 256 + bj * 128 + wc * 32 + 8 * fq;
            const f32x4 gs0 = *(const f32x4*)(gf + c0) * (*(const f32x4*)(fsc + (size_t)b * LDM + c0) + 1.0f), gs1 = *(const f32x4*)(gf + c0 + 4) * (*(const f32x4*)(fsc + (size_t)b * LDM + c0 + 4) + 1.0f);
            const f32x4 sh0 = *(const f32x4*)(fsh + (size_t)b * LDM + c0), sh1 = *(const f32x4*)(fsh + (size_t)b * LDM + c0 + 4);
#pragma unroll
            for (int ai = 0; ai < 2; ++ai)
#pragma unroll
                for (int m = 0; m < 4; ++m) { const unsigned so = (unsigned)(((ai * 128 + m * 16) * D + bj * 128) * 4); const float r = rs[ai][m];
                    *(f32x4*)((char*)out + (size_t)voff + so) = acc[ai][bj][m][0] * r * gs0 + sh0;
                    *(f32x4*)((char*)out + (size_t)voff + so + 16) = acc[ai][bj][m][1] * r * gs1 + sh1; } }
    }
};
struct EpiMixIn {
    static constexpr bool PERM = true, AFTER_DRAIN = false; static constexpr int REPS = 1;
    pg8::bf16_t *U, *UX, *GY; const float* ssp; const float* bias;
    __device__ __forceinline__ void operator()(const f32x4 (&acc)[2][2][4][2], const pg8::Unit& u, int wr, int wc, int fr, int fq) const {
        const int row0 = u.pm * 256 + wr * 64 + fr, b = u.pm >> 4;
        float rs[2][4]; load_rstd(ssp, row0, fq, rs);
        const float* bp = bias + (size_t)b * NMIX + u.pn * 256 + wc * 32 + 8 * fq;
        const f32x4 b00 = *(const f32x4*)(bp), b01 = *(const f32x4*)(bp + 4), b10 = *(const f32x4*)(bp + 128), b11 = *(const f32x4*)(bp + 132);
        if (u.pn < 4) {
            const int oc = u.pn * 128 + wc * 32 + 8 * fq;
#pragma unroll
            for (int ai = 0; ai < 2; ++ai)
#pragma unroll
                for (int m = 0; m < 4; ++m) { const float r = rs[ai][m];
                    const f32x4 v0 = acc[ai][0][m][0] * r + b00, v1 = acc[ai][0][m][1] * r + b01, g0 = acc[ai][1][m][0] * r + b10, g1 = acc[ai][1][m][1] * r + b11;
                    const f32x4 a0 = v0 * sigmoid4(g0), a1 = v1 * sigmoid4(g1);
                    *(v4u*)(U + (size_t)(row0 + ai * 128 + m * 16) * DC + oc) = pack8(a0, a1); }
        } else {
            pg8::bf16_t* dst = (u.pn < 6) ? UX : GY; const bool gel = u.pn >= 6; const int pc = (u.pn & 1) * 256 + wc * 32 + 8 * fq;
#pragma unroll
            for (int ai = 0; ai < 2; ++ai)
#pragma unroll
                for (int m = 0; m < 4; ++m) { const float r = rs[ai][m];
#pragma unroll
                    for (int bj = 0; bj < 2; ++bj) { f32x4 v0 = acc[ai][bj][m][0] * r + (bj ? b10 : b00), v1 = acc[ai][bj][m][1] * r + (bj ? b11 : b01);
                        if (gel) { v0 = gelu_tanh4(v0); v1 = gelu_tanh4(v1); }
                        *(v4u*)(dst + (size_t)(row0 + ai * 128 + m * 16) * DR + pc + bj * 128) = pack8(v0, v1); } }
        }
    }
};

struct EpiMixIn8 {
    static constexpr bool PERM = true, AFTER_DRAIN = false; static constexpr int REPS = 1;
    pg8::bf16_t *U, *UX, *GY; const float* rs; const float* cs; const float* bias;
    __device__ __forceinline__ void operator()(const f32x4 (&acc)[2][2][4][2], const pg8::Unit& u, int wr, int wc, int fr, int fq) const {
        const int row0 = u.pm * 256 + wr * 64 + fr, b = u.pm >> 4;
        float rv[2][4];
#pragma unroll
        for (int ai = 0; ai < 2; ++ai)
#pragma unroll
            for (int m = 0; m < 4; ++m) rv[ai][m] = rs[row0 + ai * 128 + m * 16];
        const int cb = u.pn * 256 + wc * 32 + 8 * fq;
        const float* bp = bias + (size_t)b * NMIX + cb; const float* cp = cs + cb;
        const f32x4 b00 = *(const f32x4*)(bp), b01 = *(const f32x4*)(bp + 4), b10 = *(const f32x4*)(bp + 128), b11 = *(const f32x4*)(bp + 132);
        const f32x4 c00 = *(const f32x4*)(cp), c01 = *(const f32x4*)(cp + 4), c10 = *(const f32x4*)(cp + 128), c11 = *(const f32x4*)(cp + 132);
        if (u.pn < 4) {
            const int oc = u.pn * 128 + wc * 32 + 8 * fq;
#pragma unroll
            for (int ai = 0; ai < 2; ++ai)
#pragma unroll
                for (int m = 0; m < 4; ++m) { const float r = rv[ai][m];
                    const f32x4 v0 = acc_i2f(acc[ai][0][m][0]) * (c00 * r) + b00, v1 = acc_i2f(acc[ai][0][m][1]) * (c01 * r) + b01;
                    const f32x4 g0 = acc_i2f(acc[ai][1][m][0]) * (c10 * r) + b10, g1 = acc_i2f(acc[ai][1][m][1]) * (c11 * r) + b11;
                    const f32x4 a0 = v0 * sigmoid4(g0), a1 = v1 * sigmoid4(g1);
                    *(v4u*)(U + (size_t)(row0 + ai * 128 + m * 16) * DC + oc) = pack8(a0, a1); }
        } else {
            pg8::bf16_t* dst = (u.pn < 6) ? UX : GY; const bool gel = u.pn >= 6; const int pc = (u.pn & 1) * 256 + wc * 32 + 8 * fq;
#pragma unroll
            for (int ai = 0; ai < 2; ++ai)
#pragma unroll
                for (int m = 0; m < 4; ++m) { const float r = rv[ai][m];
#pragma unroll
                    for (int bj = 0; bj < 2; ++bj) { f32x4 v0 = acc_i2f(acc[ai][bj][m][0]) * ((bj ? c10 : c00) * r) + (bj ? b10 : b00), v1 = acc_i2f(acc[ai][bj][m][1]) * ((bj ? c11 : c01) * r) + (bj ? b11 : b01);
                        if (gel) { v0 = gelu_tanh4(v0); v1 = gelu_tanh4(v1); }
                        *(v4u*)(dst + (size_t)(row0 + ai * 128 + m * 16) * DR + pc + bj * 128) = pack8(v0, v1); } }
        }
    }
};

__device__ __forceinline__ void p0_gemv(LAS unsigned char* lds, const float* c, const float* W, int NC, const float* bias, float* out, int j0, int tid) {
    LAS float* ca = (LAS float*)lds; LAS float* part = (LAS float*)(lds + 32768);
    for (int i = tid; i < NB * D; i += 512) { const float v = c[i]; ca[i] = v / (1.f + expf(-v)); }
    __syncthreads();
    const int cg = tid & 31, ks = tid >> 5;
    const float* wp = W + (size_t)(64 * ks) * NC + j0 + 4 * cg;
    f32x4 acc[NB];
#pragma unroll
    for (int b = 0; b < NB; ++b) acc[b] = (f32x4){0.f, 0.f, 0.f, 0.f};
#pragma unroll 4
    for (int kk = 0; kk < 64; ++kk) { const f32x4 w = *(const f32x4*)(wp + (size_t)kk * NC);
#pragma unroll
        for (int b = 0; b < NB; ++b) acc[b] += w * ca[b * D + 64 * ks + kk]; }
#pragma unroll
    for (int b = 0; b < NB; ++b) *(LAS f32x4*)(part + (ks * NB + b) * 128 + 4 * cg) = acc[b];
    __syncthreads();
#pragma unroll
    for (int r = 0; r < 2; ++r) { const int o = tid + 512 * r, b = o >> 7, col = o & 127; float s = 0.f;
#pragma unroll
        for (int k2 = 0; k2 < 16; ++k2) s += part[(k2 * NB + b) * 128 + col];
        out[(size_t)b * LDM + j0 + col] = s + bias[j0 + col]; }
    __syncthreads();
}
__device__ __forceinline__ int rowmap(int kind, int n0) {
    if (kind == 1) { const int half = n0 / FF, f = n0 - half * FF; return 256 * (f >> 7) + 128 * half + (f & 127); }
    if (kind == 2 && n0 < 1024) { const int half = n0 >> 9, f = n0 & 511; return 256 * (f >> 7) + 128 * half + (f & 127); }
    return n0;
}
__device__ __forceinline__ void p0_transpose_item(const float* W, int K, int N, bf16* WT, int kind, LAS float* scr, int item, int lane) {
    const int nblk = N / 32, kb = item / nblk, nb = item % nblk, k0 = 64 * kb, n0 = 32 * nb, r0 = rowmap(kind, n0);
#pragma unroll 8
    for (int i = 0; i < 32; ++i) { const int kk = 2 * i + (lane >> 5); scr[kk * 33 + (lane & 31)] = W[(size_t)(k0 + kk) * N + n0 + (lane & 31)]; }
    LDS_WAIT(); asm volatile("" ::: "memory");
    const int c = lane & 7;
#pragma unroll
    for (int j = 0; j < 4; ++j) { const int n = (lane >> 3) + 8 * j; const LAS float* s = scr + (8 * c) * 33 + n;
        v4u o; o.x = pk2(s[0 * 33], s[1 * 33]); o.y = pk2(s[2 * 33], s[3 * 33]); o.z = pk2(s[4 * 33], s[5 * 33]); o.w = pk2(s[6 * 33], s[7 * 33]);
        *(GAS v4u*)(WT + (size_t)(r0 + n) * K + k0 + 8 * c) = o; }
    LDS_WAIT(); asm volatile("" ::: "memory");
}

__device__ __forceinline__ void p0_quant_item(LAS unsigned char* lds, const float* W, int N, int kind, unsigned char* W8, float* cs, int nb, int lane, int wave) {
    LAS float* scr = (LAS float*)(lds + wave * 16896);
    LAS float* cm = (LAS float*)(lds + 8 * 16896);
    const int n0 = 32 * nb, r0 = rowmap(kind, n0);
#pragma unroll
    for (int tl = 0; tl < 2; ++tl) { const int k0 = 64 * (2 * wave + tl);
#pragma unroll 8
        for (int i = 0; i < 32; ++i) { const int kk = 2 * i + (lane >> 5); scr[tl * 2112 + kk * 33 + (lane & 31)] = W[(size_t)(k0 + kk) * N + n0 + (lane & 31)]; } }
    LDS_WAIT(); asm volatile("" ::: "memory");
    float mx = 0.f;
#pragma unroll
    for (int tl = 0; tl < 2; ++tl)
#pragma unroll 8
        for (int r = 0; r < 32; ++r) mx = fmaxf(mx, fabsf(scr[tl * 2112 + ((lane >> 5) * 32 + r) * 33 + (lane & 31)]));
    mx = fmaxf(mx, __shfl_xor(mx, 32));
    if (lane < 32) cm[wave * 32 + lane] = mx;
    __syncthreads();
    float cmax = 0.f;
#pragma unroll
    for (int w = 0; w < 8; ++w) cmax = fmaxf(cmax, cm[w * 32 + (lane & 31)]);
    const float sc = cmax > 0.f ? 127.0f / cmax : 0.f;
    if (wave == 0 && lane < 32) cs[r0 + lane] = cmax * (1.0f / 127.0f);
    const int n = lane >> 1, kh = (lane & 1) * 32;
    const float sn = __shfl(sc, n);
#pragma unroll
    for (int tl = 0; tl < 2; ++tl) { const int k0 = 64 * (2 * wave + tl); const LAS float* sp = scr + tl * 2112 + n;
#pragma unroll
        for (int hq = 0; hq < 2; ++hq) { v4u o;
#pragma unroll
            for (int dq = 0; dq < 4; ++dq) { const int k = kh + 16 * hq + 4 * dq;
                const unsigned w4 = q8(sp[(k + 0) * 33] * sn) | (q8(sp[(k + 1) * 33] * sn) << 8) | (q8(sp[(k + 2) * 33] * sn) << 16) | (q8(sp[(k + 3) * 33] * sn) << 24);
                if (dq == 0) o.x = w4; else if (dq == 1) o.y = w4; else if (dq == 2) o.z = w4; else o.w = w4; }
            *(GAS v4u*)(W8 + (size_t)(r0 + n) * D + k0 + kh + 16 * hq) = o; } }
    __syncthreads();
}

__device__ __forceinline__ void mix_conv(LAS unsigned char* lds, const bf16* U, const float* conv_w, const float* conv_b, const float* ln_g, const float* ln_b, bf16* YMIX, int G, int bx, int tid, int lane, int wave) {
    LAS unsigned char* IN = lds;
    LAS f32x4* WA = (LAS f32x4*)(lds + 63488);
    LAS f32x4* WB = WA + 31 * 64;
    for (int i = tid; i < 31 * 64; i += 512) { const int k = i >> 6, l = i & 63; WA[i] = *(const f32x4*)(conv_w + k * DC + 8 * l); WB[i] = *(const f32x4*)(conv_w + k * DC + 8 * l + 4); }
    const f32x4 cb0 = *(const f32x4*)(conv_b + 8 * lane), cb1 = *(const f32x4*)(conv_b + 8 * lane + 4);
    const f32x4 lg0 = *(const f32x4*)(ln_g + 8 * lane), lg1 = *(const f32x4*)(ln_g + 8 * lane + 4);
    const f32x4 lb0 = *(const f32x4*)(ln_b + 8 * lane), lb1 = *(const f32x4*)(ln_b + 8 * lane + 4);
    v4u pre[8];
#pragma unroll
    for (int i = 0; i < 8; ++i) { const int q = tid + 512 * i, row = q >> 6, ch = q & 63, tok = (bx & 127) * 32 - 30 + row; pre[i] = (v4u){0u, 0u, 0u, 0u};
        if (bx < NB * (SEQ / 32) && q < 62 * 64 && tok >= 0) pre[i] = *(const v4u*)(U + ((size_t)((bx >> 7) * SEQ + tok)) * DC + 8 * ch); }
    for (int item = bx; item < NB * (SEQ / 32); item += G) {
        const int b = item >> 7, t0 = (item & 127) * 32;
        __syncthreads();
#pragma unroll
        for (int i = 0; i < 8; ++i) { const int q = tid + 512 * i; if (q < 62 * 64) *(LAS v4u*)(IN + (q >> 6) * 1024 + (q & 63) * 16) = pre[i]; }
        { const int nitem = item + G, nb = nitem >> 7, nt0 = (nitem & 127) * 32;
#pragma unroll
            for (int i = 0; i < 8; ++i) { const int q = tid + 512 * i, row = q >> 6, ch = q & 63, tok = nt0 - 30 + row; pre[i] = (v4u){0u, 0u, 0u, 0u};
                if (nitem < NB * (SEQ / 32) && q < 62 * 64 && tok >= 0) pre[i] = *(const v4u*)(U + ((size_t)(nb * SEQ + tok)) * DC + 8 * ch); } }
        __syncthreads();
        f32x4 a0[4], a1[4];
#pragma unroll
        for (int tt = 0; tt < 4; ++tt) { a0[tt] = cb0; a1[tt] = cb1; }
        f32x4 wa0 = {0.f, 0.f, 0.f, 0.f}, wa1 = wa0, wa2 = wa0, wa3 = wa0, wb0 = wa0, wb1 = wa0, wb2 = wa0, wb3 = wa0;
#pragma unroll
        for (int kk = 0; kk < 34; ++kk) {
            const v4u v = *(const LAS v4u*)(IN + (4 * wave + kk) * 1024 + lane * 16);
            const f32x4 x0 = {bflo(v.x), bfhi(v.x), bflo(v.y), bfhi(v.y)}, x1 = {bflo(v.z), bfhi(v.z), bflo(v.w), bfhi(v.w)};
            wa3 = wa2; wa2 = wa1; wa1 = wa0; wb3 = wb2; wb2 = wb1; wb1 = wb0;
            if (kk <= 30) { wa0 = WA[kk * 64 + lane]; wb0 = WB[kk * 64 + lane]; } else { wa0 = (f32x4){0.f, 0.f, 0.f, 0.f}; wb0 = wa0; }
            a0[0] += wa0 * x0; a1[0] += wb0 * x1; a0[1] += wa1 * x0; a1[1] += wb1 * x1; a0[2] += wa2 * x0; a1[2] += wb2 * x1; a0[3] += wa3 * x0; a1[3] += wb3 * x1;
        }
#pragma unroll
        for (int tt = 0; tt < 4; ++tt) {
            float s = (a0[tt][0] + a0[tt][1]) + (a0[tt][2] + a0[tt][3]) + (a1[tt][0] + a1[tt][1]) + (a1[tt][2] + a1[tt][3]);
            const float mean = wave_sum(s) * (1.0f / DC);
            const f32x4 d0 = a0[tt] - mean, d1 = a1[tt] - mean;
            float q = (d0[0] * d0[0] + d0[1] * d0[1]) + (d0[2] * d0[2] + d0[3] * d0[3]) + (d1[0] * d1[0] + d1[1] * d1[1]) + (d1[2] * d1[2] + d1[3] * d1[3]);
            const float rstd = rsqrtf(wave_sum(q) * (1.0f / DC) + EPS);
            f32x4 y0 = d0 * rstd * lg0 + lb0, y1 = d1 * rstd * lg1 + lb1;
#pragma unroll
            for (int j = 0; j < 4; ++j) { y0[j] = silu_fast(y0[j]); y1[j] = silu_fast(y1[j]); }
            *(v4u*)(YMIX + ((size_t)(b * SEQ + t0 + 4 * wave + tt)) * D + 8 * lane) = pack8(y0, y1);
        }
    }
    __syncthreads();
}

__device__ __forceinline__ void scan_decode(int it, int& b, int& c) { if (it < 256) { b = it >> 6; c = it & 63; } else { b = 4 + ((it - 256) >> 6); c = 63 - ((it - 256) & 63); } }
__device__ __forceinline__ float neg_expm1(float x, float a) {
    float p = -1.0f / 5040.0f; p = p * x - 1.0f / 720.0f; p = p * x - 1.0f / 120.0f; p = p * x - 1.0f / 24.0f; p = p * x - 1.0f / 6.0f; p = p * x - 0.5f; p = p * x - 1.0f;
    float q = p * x, w = 1.0f - a * a; asm volatile("" : "+v"(q), "+v"(w));
    return x > -0.5f ? q : w;
}
__device__ __forceinline__ void gate_math16(const f32x16 pa, const f32x16 pi, float ba, float bi, float c8, f32x16& av, f32x16& bv) {
#pragma unroll
    for (int g4 = 0; g4 < 4; ++g4) {
        const f32x4 pa4 = {pa[4 * g4], pa[4 * g4 + 1], pa[4 * g4 + 2], pa[4 * g4 + 3]}, pi4 = {pi[4 * g4], pi[4 * g4 + 1], pi[4 * g4 + 2], pi[4 * g4 + 3]};
        const f32x4 rg = sigmoid4(pa4 + ba), ig = sigmoid4(pi4 + bi);
        const f32x4 l2 = rg * c8;
        const f32x4 a = {__builtin_amdgcn_exp2f(l2[0]), __builtin_amdgcn_exp2f(l2[1]), __builtin_amdgcn_exp2f(l2[2]), __builtin_amdgcn_exp2f(l2[3])};
        const f32x4 x = l2 * 1.3862943611198906f;
        f32x4 p = x * (-1.0f / 5040.0f) - 1.0f / 720.0f; p = p * x - 1.0f / 120.0f; p = p * x - 1.0f / 24.0f; p = p * x - 1.0f / 6.0f; p = p * x - 0.5f; p = p * x - 1.0f;
        const f32x4 q = p * x, w = 1.0f - a * a;
        f32x4 m2;
#pragma unroll
        for (int e = 0; e < 4; ++e) m2[e] = __builtin_amdgcn_sqrtf(x[e] > -0.5f ? q[e] : w[e]);
        const f32x4 bb = m2 * ig;
#pragma unroll
        for (int e = 0; e < 4; ++e) { av[4 * g4 + e] = a[e]; bv[4 * g4 + e] = bb[e]; }
        __builtin_amdgcn_sched_barrier(0);
    }
}
template <bool FINAL>
__device__ __forceinline__ void mix_scan(LAS unsigned char* lds, const bf16* UX, const bf16* GY, const bf16* WGT, const float* rw, const float* rb, const float* b_a, const float* b_i, const float* lam,
                                         f32x2* TOT, bf16* YMIX, int G, int bx, int lane, int wave) {
    LAS unsigned char* UXT = lds + wave * 16896;
    LAS unsigned char* XRT = UXT + 8704;
    const int h = wave, j = lane & 31, hh = lane >> 5, dg = lane & 7, tg = lane >> 3;
    float c8v[2], bav[2], biv[2];
#pragma unroll
    for (int ec = 0; ec < 2; ++ec) { const int ch = 64 * h + 32 * ec + j; c8v[ec] = -8.0f * 1.4426950408889634f * log1pf(expf(-lam[ch]));   bav[ec] = b_a[ch]; biv[ec] = b_i[ch]; }
    for (int it = bx; it < 512; it += G) {
        asm volatile("" ::: "memory");
        int b, c; scan_decode(it, b, c);
        const size_t mrow0 = (size_t)b * SEQ + 64 * c;
#pragma unroll
        for (int i = 0; i < 9; ++i) { const int row = i * 8 + tg, tok = 64 * c - 3 + row; v4u v = {0u, 0u, 0u, 0u};
            if (row < 67 && tok >= 0) v = *(const v4u*)(UX + ((size_t)b * SEQ + tok) * DR + 64 * h + 8 * dg);
            if (row < 68) *(LAS v4u*)(UXT + row * 128 + dg * 16) = v; }
        pg8::bf16x8 bfr[2][4];
#pragma unroll
        for (int g = 0; g < 2; ++g)
#pragma unroll
            for (int ks = 0; ks < 4; ++ks) bfr[g][ks] = *(const pg8::bf16x8*)(WGT + ((size_t)(h * 128 + 64 * g + j)) * 64 + 16 * ks + 8 * hh);
        v4u gyv[8];
        if (FINAL) {
#pragma unroll
            for (int i = 0; i < 8; ++i) gyv[i] = *(const v4u*)(GY + (mrow0 + i * 8 + tg) * DR + 64 * h + 8 * dg);
        }
        float Hc = 0.f;
        if (FINAL) { const f32x2* tp = TOT + ((size_t)b * 64) * DR + 64 * h + lane; int cc = 0;
            for (; cc + 8 <= c; cc += 8) { f32x2 t8[8];
#pragma unroll
                for (int u = 0; u < 8; ++u) t8[u] = tp[(size_t)(cc + u) * DR];
#pragma unroll
                for (int u = 0; u < 8; ++u) Hc = Hc * t8[u].x + t8[u].y; }
            for (; cc < c; ++cc) { const f32x2 ab = tp[(size_t)cc * DR]; Hc = Hc * ab.x + ab.y; } }
        {
            f32x4 w4a[4], w4b[4];
#pragma unroll
            for (int k = 0; k < 4; ++k) { w4a[k] = *(const f32x4*)(rw + k * DR + 64 * h + 8 * dg); w4b[k] = *(const f32x4*)(rw + k * DR + 64 * h + 8 * dg + 4); }
            const f32x4 rb0 = *(const f32x4*)(rb + 64 * h + 8 * dg), rb1 = *(const f32x4*)(rb + 64 * h + 8 * dg + 4);
#pragma unroll
            for (int th = 0; th < 2; ++th) {
                f32x4 o0[4], o1[4];
#pragma unroll
                for (int t = 0; t < 4; ++t) { o0[t] = rb0; o1[t] = rb1; }
#pragma unroll
                for (int i = 0; i < 7; ++i) { const v4u v = *(const LAS v4u*)(UXT + (8 * tg + 4 * th + i) * 128 + dg * 16);
                    const f32x4 x0 = {bflo(v.x), bfhi(v.x), bflo(v.y), bfhi(v.y)}, x1 = {bflo(v.z), bfhi(v.z), bflo(v.w), bfhi(v.w)};
#pragma unroll
                    for (int k = 0; k < 4; ++k) { const int t = i - k; if (t >= 0 && t < 4) { o0[t] += w4a[k] * x0; o1[t] += w4b[k] * x1; } } }
#pragma unroll
                for (int t = 0; t < 4; ++t) *(LAS v4u*)(XRT + (8 * tg + 4 * th + t) * 128 + dg * 16) = pack8(o0[t], o1[t]);
            }
        }
        if (FINAL) {
#pragma unroll
            for (int i = 0; i < 8; ++i) *(LAS v4u*)(UXT + (i * 8 + tg) * 128 + dg * 16) = gyv[i];
        }
#pragma unroll
        for (int ec = 0; ec < 2; ++ec) {
            const int ch = 64 * h + 32 * ec + j;
            const float c8 = c8v[ec], ba = bav[ec], bi = biv[ec];
            f32x16 av[2], bv[2];
#pragma unroll
            for (int tt = 0; tt < 2; ++tt) {
                pg8::bf16x8 afr[4];
#pragma unroll
                for (int ks = 0; ks < 4; ++ks) afr[ks] = *(const LAS pg8::bf16x8*)(XRT + (32 * tt + j) * 128 + (16 * ks + 8 * hh) * 2);
                f32x16 pa, pi;
#pragma unroll
                for (int r = 0; r < 16; ++r) { pa[r] = 0.f; pi[r] = 0.f; }
#pragma unroll
                for (int ks = 0; ks < 4; ++ks) {
                    pa = __builtin_amdgcn_mfma_f32_32x32x16_bf16(afr[ks], bfr[0][ks], pa, 0, 0, 0);
                    pi = __builtin_amdgcn_mfma_f32_32x32x16_bf16(afr[ks], bfr[1][ks], pi, 0, 0, 0); }
                if (ec == 0 && tt == 1) {
#pragma unroll
                    for (int g = 0; g < 2; ++g)
#pragma unroll
                        for (int ks = 0; ks < 4; ++ks) bfr[g][ks] = *(const pg8::bf16x8*)(WGT + ((size_t)(h * 128 + 64 * g + 32 + j)) * 64 + 16 * ks + 8 * hh);
                }
                gate_math16(pa, pi, ba, bi, c8, av[tt], bv[tt]);
                {
                    f32x16 px;
#pragma unroll
                    for (int r = 0; r < 16; ++r) px[r] = bv[tt][r] * 0.f;
                    int dd = 32 * ec + j - 8 * hh; asm volatile("" : "+v"(dd));
                    const unsigned one = (dd & 1) ? 0x3F800000u : 0x00003F80u;
#pragma unroll
                    for (int ks = 0; ks < 4; ++ks) {
                        const int dw = (dd - 16 * ks) >> 1;
                        v4u idw; idw.x = dw == 0 ? one : 0u; idw.y = dw == 1 ? one : 0u; idw.z = dw == 2 ? one : 0u; idw.w = dw == 3 ? one : 0u;
                        px = __builtin_amdgcn_mfma_f32_32x32x16_bf16(afr[ks], __builtin_bit_cast(pg8::bf16x8, idw), px, 0, 0, 0); }
#pragma unroll
                    for (int r = 0; r < 16; ++r) bv[tt][r] *= px[r];
                }
            }
            float GA[2][4], GB[2][4], PA[2][4], PB[2][4];
#pragma unroll
            for (int tt = 0; tt < 2; ++tt)
#pragma unroll
                for (int q = 0; q < 4; ++q) { const float a0 = av[tt][4 * q], a1 = av[tt][4 * q + 1], a2 = av[tt][4 * q + 2], a3 = av[tt][4 * q + 3];
                    const float b0 = bv[tt][4 * q], b1 = bv[tt][4 * q + 1], b2 = bv[tt][4 * q + 2], b3 = bv[tt][4 * q + 3];
                    GA[tt][q] = (a0 * a1) * (a2 * a3); GB[tt][q] = ((b0 * a1 + b1) * a2 + b2) * a3 + b3;
                    PA[tt][q] = __shfl_xor(GA[tt][q], 32); PB[tt][q] = __shfl_xor(GB[tt][q], 32); }
            if (!FINAL) {
                float At = 1.f, Bt = 0.f;
#pragma unroll
                for (int tt = 0; tt < 2; ++tt)
#pragma unroll
                    for (int q = 0; q < 4; ++q) { const float A0 = hh ? PA[tt][q] : GA[tt][q], B0 = hh ? PB[tt][q] : GB[tt][q], A1 = hh ? GA[tt][q] : PA[tt][q], B1 = hh ? GB[tt][q] : PB[tt][q];
                        Bt = (Bt * A0 + B0) * A1 + B1; At = (At * A0) * A1; }
                if (hh == 0) TOT[((size_t)b * 64 + c) * DR + ch] = (f32x2){At, Bt};
            } else {
                float hc = __shfl(Hc, 32 * ec + j);
#pragma unroll
                for (int tt = 0; tt < 2; ++tt)
#pragma unroll
                    for (int q = 0; q < 4; ++q) { const float A0 = hh ? PA[tt][q] : GA[tt][q], B0 = hh ? PB[tt][q] : GB[tt][q], A1 = hh ? GA[tt][q] : PA[tt][q], B1 = hh ? GB[tt][q] : PB[tt][q];
                        const float mid = hc * A0 + B0; float hv = hh ? mid : hc; hc = mid * A1 + B1;
#pragma unroll
                        for (int i = 0; i < 4; ++i) { hv = av[tt][4 * q + i] * hv + bv[tt][4 * q + i]; av[tt][4 * q + i] = hv; } }
#pragma unroll
                for (int tt = 0; tt < 2; ++tt)
#pragma unroll
                    for (int r = 0; r < 16; ++r) { const int tk = 32 * tt + (r & 3) + 8 * (r >> 2) + 4 * hh;
                        LAS u16* p = (LAS u16*)(UXT + tk * 128 + (32 * ec + j) * 2);
                        const float gy = __uint_as_float((unsigned)(*p) << 16);
                        *p = (u16)f2bf(gy * av[tt][r]); }
            }
        }
        if (FINAL) {
#pragma unroll
            for (int i = 0; i < 8; ++i) { const int row = i * 8 + tg; *(v4u*)(YMIX + (mrow0 + row) * D + DC + 64 * h + 8 * dg) = *(const LAS v4u*)(UXT + row * 128 + dg * 16); }
        }
    }
    __syncthreads();
}

__device__ __forceinline__ void mix_scan1(LAS unsigned char* lds, const bf16* UX, const bf16* GY, const bf16* WGT, const float* rw, const float* rb, const float* b_a, const float* b_i, const float* lam,
                                          f32x2* TOT, unsigned* cnt, bf16* YMIX, int G, int bx, int lane, int wave) {
    LAS unsigned char* UXT = lds + wave * 16896;
    LAS unsigned char* XRT = UXT + 8704;
    const int h = wave, j = lane & 31, hh = lane >> 5, dg = lane & 7, tg = lane >> 3;
    const int gs = G >> 3, b = bx / gs, idx = bx - b * gs;
    float c8v[2], bav[2], biv[2];
#pragma unroll
    for (int ec = 0; ec < 2; ++ec) { const int ch = 64 * h + 32 * ec + j; c8v[ec] = -8.0f * 1.4426950408889634f * log1pf(expf(-lam[ch])); bav[ec] = b_a[ch]; biv[ec] = b_i[ch]; }
    for (int c = idx, round = 0; c < 64; c += gs, ++round) {
        asm volatile("" ::: "memory");
        const size_t mrow0 = (size_t)b * SEQ + 64 * c;
#pragma unroll
        for (int i = 0; i < 9; ++i) { const int row = i * 8 + tg, tok = 64 * c - 3 + row; v4u v = {0u, 0u, 0u, 0u};
            if (row < 67 && tok >= 0) v = *(const v4u*)(UX + ((size_t)b * SEQ + tok) * DR + 64 * h + 8 * dg);
            if (row < 68) *(LAS v4u*)(UXT + row * 128 + dg * 16) = v; }
        pg8::bf16x8 bfr[2][4];
#pragma unroll
        for (int g = 0; g < 2; ++g)
#pragma unroll
            for (int ks = 0; ks < 4; ++ks) bfr[g][ks] = *(const pg8::bf16x8*)(WGT + ((size_t)(h * 128 + 64 * g + j)) * 64 + 16 * ks + 8 * hh);
        {
            f32x4 w4a[4], w4b[4];
#pragma unroll
            for (int k = 0; k < 4; ++k) { w4a[k] = *(const f32x4*)(rw + k * DR + 64 * h + 8 * dg); w4b[k] = *(const f32x4*)(rw + k * DR + 64 * h + 8 * dg + 4); }
            const f32x4 rb0 = *(const f32x4*)(rb + 64 * h + 8 * dg), rb1 = *(const f32x4*)(rb + 64 * h + 8 * dg + 4);
#pragma unroll
            for (int th = 0; th < 2; ++th) {
                f32x4 o0[4], o1[4];
#pragma unroll
                for (int t = 0; t < 4; ++t) { o0[t] = rb0; o1[t] = rb1; }
#pragma unroll
                for (int i = 0; i < 7; ++i) { const v4u v = *(const LAS v4u*)(UXT + (8 * tg + 4 * th + i) * 128 + dg * 16);
                    const f32x4 x0 = {bflo(v.x), bfhi(v.x), bflo(v.y), bfhi(v.y)}, x1 = {bflo(v.z), bfhi(v.z), bflo(v.w), bfhi(v.w)};
#pragma unroll
                    for (int k = 0; k < 4; ++k) { const int t = i - k; if (t >= 0 && t < 4) { o0[t] += w4a[k] * x0; o1[t] += w4b[k] * x1; } } }
#pragma unroll
                for (int t = 0; t < 4; ++t) *(LAS v4u*)(XRT + (8 * tg + 4 * th + t) * 128 + dg * 16) = pack8(o0[t], o1[t]);
            }
        }
#pragma unroll
        for (int ec = 0; ec < 2; ++ec) {
            const int ch = 64 * h + 32 * ec + j;
            const float c8 = c8v[ec], ba = bav[ec], bi = biv[ec];
            unsigned* cw = cnt + 64 * (8 * ec + b);
            f32x16 av[2], bv[2];
#pragma unroll
            for (int tt = 0; tt < 2; ++tt) {
                pg8::bf16x8 afr[4];
#pragma unroll
                for (int ks = 0; ks < 4; ++ks) afr[ks] = *(const LAS pg8::bf16x8*)(XRT + (32 * tt + j) * 128 + (16 * ks + 8 * hh) * 2);
                f32x16 pa, pi;
#pragma unroll
                for (int r = 0; r < 16; ++r) { pa[r] = 0.f; pi[r] = 0.f; }
#pragma unroll
                for (int ks = 0; ks < 4; ++ks) {
                    pa = __builtin_amdgcn_mfma_f32_32x32x16_bf16(afr[ks], bfr[0][ks], pa, 0, 0, 0);
                    pi = __builtin_amdgcn_mfma_f32_32x32x16_bf16(afr[ks], bfr[1][ks], pi, 0, 0, 0); }
                if (ec == 0 && tt == 1) {
#pragma unroll
                    for (int g = 0; g < 2; ++g)
#pragma unroll
                        for (int ks = 0; ks < 4; ++ks) bfr[g][ks] = *(const pg8::bf16x8*)(WGT + ((size_t)(h * 128 + 64 * g + 32 + j)) * 64 + 16 * ks + 8 * hh);
                }
                gate_math16(pa, pi, ba, bi, c8, av[tt], bv[tt]);
                {
                    f32x16 px;
#pragma unroll
                    for (int r = 0; r < 16; ++r) px[r] = bv[tt][r] * 0.f;
                    int dd = 32 * ec + j - 8 * hh; asm volatile("" : "+v"(dd));
                    const unsigned one = (dd & 1) ? 0x3F800000u : 0x00003F80u;
#pragma unroll
                    for (int ks = 0; ks < 4; ++ks) {
                        const int dw = (dd - 16 * ks) >> 1;
                        v4u idw; idw.x = dw == 0 ? one : 0u; idw.y = dw == 1 ? one : 0u; idw.z = dw == 2 ? one : 0u; idw.w = dw == 3 ? one : 0u;
                        px = __builtin_amdgcn_mfma_f32_32x32x16_bf16(afr[ks], __builtin_bit_cast(pg8::bf16x8, idw), px, 0, 0, 0); }
#pragma unroll
                    for (int r = 0; r < 16; ++r) bv[tt][r] *= px[r];
                }
            }
            float GA[2][4], GB[2][4], PA[2][4], PB[2][4];
            float At = 1.f, Bt = 0.f;
#pragma unroll
            for (int tt = 0; tt < 2; ++tt)
#pragma unroll
                for (int q = 0; q < 4; ++q) { const float a0 = av[tt][4 * q], a1 = av[tt][4 * q + 1], a2 = av[tt][4 * q + 2], a3 = av[tt][4 * q + 3];
                    const float b0 = bv[tt][4 * q], b1 = bv[tt][4 * q + 1], b2 = bv[tt][4 * q + 2], b3 = bv[tt][4 * q + 3];
                    GA[tt][q] = (a0 * a1) * (a2 * a3); GB[tt][q] = ((b0 * a1 + b1) * a2 + b2) * a3 + b3;
                    PA[tt][q] = __shfl_xor(GA[tt][q], 32); PB[tt][q] = __shfl_xor(GB[tt][q], 32);
                    const float A0 = hh ? PA[tt][q] : GA[tt][q], B0 = hh ? PB[tt][q] : GB[tt][q], A1 = hh ? GA[tt][q] : PA[tt][q], B1 = hh ? GB[tt][q] : PB[tt][q];
                    Bt = (Bt * A0 + B0) * A1 + B1; At = (At * A0) * A1; }
            if (hh == 0) __hip_atomic_store((gu64*)(TOT + ((size_t)b * 64 + c) * DR + ch), ((unsigned long long)__float_as_uint(Bt) << 32) | __float_as_uint(At), RLX_AGENT);
            asm volatile("s_waitcnt vmcnt(0)" ::: "memory");
            if (lane == 0) __hip_atomic_fetch_add(cw, 1u, __ATOMIC_RELAXED, __HIP_MEMORY_SCOPE_AGENT);
            if (ec == 0) {
#pragma unroll
                for (int i = 0; i < 8; ++i) *(LAS v4u*)(UXT + (i * 8 + tg) * 128 + dg * 16) = *(const v4u*)(GY + (mrow0 + i * 8 + tg) * DR + 64 * h + 8 * dg);
            }
            if (wave == 0) { const int upto = (round + 1) * gs < 64 ? (round + 1) * gs : 64; const unsigned need = 8u * (unsigned)upto; unsigned sp = 0;
                while ((unsigned)__builtin_amdgcn_readfirstlane(__hip_atomic_load(cw, __ATOMIC_RELAXED, __HIP_MEMORY_SCOPE_AGENT)) < need) { __builtin_amdgcn_s_sleep(1); if (++sp > (1u << 20)) break; }
                __builtin_amdgcn_fence(__ATOMIC_ACQUIRE, "agent");
                asm volatile("s_waitcnt vmcnt(0)" ::: "memory"); }
            asm volatile("" ::: "memory"); __builtin_amdgcn_s_barrier(); asm volatile("" ::: "memory");
            float hc;
            { const gu64* tp = (const gu64*)(TOT + ((size_t)b * 64) * DR + ch); const int half = (c + 1) >> 1, lo = hh ? half : 0, hi2 = hh ? c : half;
                float Ar = 1.f, Br = 0.f;
                for (int cc = lo; cc < hi2; cc += 4) { unsigned long long t16[4];
#pragma unroll
                    for (int u = 0; u < 4; ++u) t16[u] = __hip_atomic_load(tp + (size_t)(cc + u < 63 ? cc + u : 63) * DR, RLX_AGENT);
#pragma unroll
                    for (int u = 0; u < 4; ++u) { const bool ok = cc + u < hi2; const float ta = ok ? __uint_as_float((unsigned)t16[u]) : 1.f, tb = ok ? __uint_as_float((unsigned)(t16[u] >> 32)) : 0.f; Br = Br * ta + tb; Ar = Ar * ta; } }
                const float Ap = __shfl_xor(Ar, 32), Bp = __shfl_xor(Br, 32);
                hc = hh ? (Bp * Ar + Br) : (Br * Ap + Bp); }
#pragma unroll
            for (int tt = 0; tt < 2; ++tt)
#pragma unroll
                for (int q = 0; q < 4; ++q) { const float A0 = hh ? PA[tt][q] : GA[tt][q], B0 = hh ? PB[tt][q] : GB[tt][q], A1 = hh ? GA[tt][q] : PA[tt][q], B1 = hh ? GB[tt][q] : PB[tt][q];
                    const float mid = hc * A0 + B0; float hv = hh ? mid : hc; hc = mid * A1 + B1;
#pragma unroll
                    for (int i = 0; i < 4; ++i) { hv = av[tt][4 * q + i] * hv + bv[tt][4 * q + i]; av[tt][4 * q + i] = hv; } }
#pragma unroll
            for (int tt = 0; tt < 2; ++tt)
#pragma unroll
                for (int r = 0; r < 16; ++r) { const int tk = 32 * tt + (r & 3) + 8 * (r >> 2) + 4 * hh;
                    LAS u16* p = (LAS u16*)(UXT + tk * 128 + (32 * ec + j) * 2);
                    const float gy = __uint_as_float((unsigned)(*p) << 16);
                    *p = (u16)f2bf(gy * av[tt][r]); }
        }
#pragma unroll
        for (int i = 0; i < 8; ++i) { const int row = i * 8 + tg; *(v4u*)(YMIX + (mrow0 + row) * D + DC + 64 * h + 8 * dg) = *(const LAS v4u*)(UXT + row * 128 + dg * 16); }
    }
    __syncthreads();
}

struct Args { const float* in[27]; float* out; unsigned char* ws; int ph_lo, ph_hi; };
constexpr int NPH = 10;
#ifndef MK_PER_PHASE
#define MK_PER_PHASE 0
#endif
#ifndef MK_REP_LO
#define MK_REP_LO 0
#define MK_REP_HI 0
#endif

__global__ void __launch_bounds__(NWAVES * 64, 2) mk_fwd(Args args) {
    extern __shared__ __attribute__((aligned(16))) unsigned char lds_raw[];
    LAS unsigned char* lds = (LAS unsigned char*)lds_raw;
    const int tid = threadIdx.x, lane = tid & 63, wave = __builtin_amdgcn_readfirstlane(tid >> 6);
    const int G = gridDim.x, bx = blockIdx.x;
    const int vcu = (G % 8 == 0) ? (bx % 8) * (G / 8) + bx / 8 : bx;
    const int gw = vcu * NWAVES + wave, NGW = G * NWAVES;
    unsigned char* ws = args.ws;
    gu32* ctl = (gu32*)(ws + WS_CTL);
    const float* x = args.in[0]; const float* cvec = args.in[1]; const float* w_mod = args.in[2]; const float* b_mod = args.in[3];
    const float* g1 = args.in[4]; const float* w1i = args.in[5]; const float* w1o = args.in[6]; const float* gm = args.in[7];
    const float* w_in = args.in[8]; const float* conv_w = args.in[9]; const float* conv_b = args.in[10]; const float* ln_g = args.in[11]; const float* ln_b = args.in[12];
    const float* rw = args.in[13]; const float* rb = args.in[14]; const float* wa = args.in[15]; const float* b_a = args.in[16];
    const float* wi = args.in[17]; const float* b_i = args.in[18]; const float* lam = args.in[19]; const float* w_out = args.in[20];
    const float* g2 = args.in[21]; const float* w2i = args.in[22]; const float* w2o = args.in[23]; const float* w_fmod = args.in[24];
    const float* b_fmod = args.in[25]; const float* gf = args.in[26];
    float* out = args.out;
    float* MOD = (float*)(ws + WS_MOD); float* BIAS1 = (float*)(ws + WS_BIAS1); float* BIAS2 = (float*)(ws + WS_BIAS2); float* BIAS3 = (float*)(ws + WS_BIAS3);
    bf16* WGT = (bf16*)(ws + WS_WGT); f32x2* TOT = (f32x2*)(ws + WS_TOT); float* SSP = (float*)(ws + WS_SSP);
    bf16 *W1O = (bf16*)(ws + WS_W1O), *WIN = (bf16*)(ws + WS_WIN), *WOUT = (bf16*)(ws + WS_WOUT), *W2O = (bf16*)(ws + WS_W2O);
    unsigned char *W1I8 = ws + WS_W1I, *W2I8 = ws + WS_W2I, *WIN8 = ws + WS_WIN, *A8 = ws + WS_Y;
    float *CS1 = (float*)(ws + WS_CS1), *CS3 = (float*)(ws + WS_CS3), *CS2 = (float*)(ws + WS_CS2), *RS1 = (float*)(ws + WS_RS1), *RS3 = (float*)(ws + WS_RS3), *RS2 = (float*)(ws + WS_RS2);
    bf16 *Y = (bf16*)(ws + WS_Y), *ACT = (bf16*)(ws + WS_ACT), *U = (bf16*)(ws + WS_U), *UXB = (bf16*)(ws + WS_UX), *GYB = (bf16*)(ws + WS_GY), *YMIX = (bf16*)(ws + WS_YMIX);
    bf16* X1 = (bf16*)(ws + WS_X1);

    for (int u = tid; u < (LDS_BYTES - LDSCTL_OFF) / 4; u += NWAVES * 64) ((LAS unsigned*)(lds + LDSCTL_OFF))[u] = 0u;
    __syncthreads();
    const int lo = args.ph_lo, hi = args.ph_hi;
    const bool use_bar = (hi - lo) > 1;
    XcdBarrier bar; bar.bar = (unsigned*)(ctl + CW_BAR); bar.x = 0; bar.st = nullptr;
    if (use_bar) bar = xcd_barrier_post((unsigned*)(ctl + CW_BAR), (volatile LAS unsigned*)(lds + LDSCTL_OFF) + 8);
#define IN(k) (lo <= (k) && (k) < hi)
#define REPS(k) ((MK_REP_LO <= (k) && (k) < MK_REP_HI) ? 2 : 1)
#define AGAIN(k, rr) do { if ((rr) + 1 < REPS(k)) xcd_barrier(bar); } while (0)
#define SEAM(k) do { if (IN(k) && IN((k) + 1)) xcd_barrier(bar); } while (0)

    if (IN(0))
_Pragma("unroll")
    for (int rr = 0; rr < REPS(0); ++rr) {
        constexpr int NGEMV = 88;
        const int nt_wg = G > NGEMV ? G - NGEMV : G;
        if (bx < NGEMV || G <= NGEMV) {
            for (int it = bx; it < NGEMV; it += G) {
                if (it < 72) p0_gemv(lds, cvec, w_mod, 9 * D, b_mod, MOD, 128 * it, tid);
                else p0_gemv(lds, cvec, w_fmod, 2 * D, b_fmod, MOD + 9 * D, 128 * (it - 72), tid);
            }
        }
        if (bx >= NGEMV || G <= NGEMV) {
            const int tb = G > NGEMV ? bx - NGEMV : bx;
            for (int it = tb; it < 2 * (FF2 / 32); it += nt_wg) {
                if (it < FF2 / 32) p0_quant_item(lds, w1i, FF2, 1, W1I8, CS1, it, lane, wave);
                else p0_quant_item(lds, w2i, FF2, 1, W2I8, CS3, it - FF2 / 32, lane, wave);
            }
            LAS float* scr = (LAS float*)(lds + wave * 16384);
            constexpr int I_1O = (FF / 64) * (D / 32), I_IN = (D / 64) * (NMIX / 32), I_OUT = (D / 64) * (D / 32);
            constexpr int NITEMS = 2 * I_1O + I_IN + I_OUT;
            for (int it = tb * NWAVES + wave; it < NITEMS; it += nt_wg * NWAVES) {
                int r = it;
                if (r < I_1O) { p0_transpose_item(w1o, FF, D, W1O, 0, scr, r, lane); continue; } r -= I_1O;
                if (r < I_1O) { p0_transpose_item(w2o, FF, D, W2O, 0, scr, r, lane); continue; } r -= I_1O;
                if (r < I_IN) { p0_transpose_item(w_in, D, NMIX, WIN, 2, scr, r, lane); continue; } r -= I_IN;
                p0_transpose_item(w_out, D, D, WOUT, 0, scr, r, lane);
            }
        }
        for (int i = bx * 512 + tid; i < NH * 128 * HD; i += G * 512) { const int d = i & 63, e2 = (i >> 6) & 127, hd = i >> 13;
            const float v = e2 < 64 ? wa[(hd * 64 + d) * 64 + e2] : wi[(hd * 64 + d) * 64 + (e2 - 64)]; WGT[i] = (bf16)f2bf(v); }
        AGAIN(0, rr);
    }
    SEAM(0);
    if (IN(1))
_Pragma("unroll")
    for (int rr = 0; rr < REPS(1); ++rr) {
        LAS float* shl = (LAS float*)lds;
        for (int i = tid * 4; i < 3 * NB * D; i += 2048) { const int t = i >> 13, r = i & 8191, b = r >> 10, k = r & 1023; *(LAS f32x4*)(shl + i) = *(const f32x4*)(MOD + (size_t)b * LDM + 3 * t * D + k); }
        __syncthreads();
        for (int m0 = gw; m0 < M; m0 += 2 * NGW) {
            f32x4 v[2][4];
#pragma unroll
            for (int rr2 = 0; rr2 < 2; ++rr2) { const int m = (m0 + rr2 * NGW < M) ? m0 + rr2 * NGW : m0; const f32x4* xr = (const f32x4*)(x + (size_t)m * D) + lane;
#pragma unroll
                for (int jj = 0; jj < 4; ++jj) v[rr2][jj] = xr[64 * jj]; }
#pragma unroll
            for (int rr2 = 0; rr2 < 2; ++rr2) { const int m = m0 + rr2 * NGW; if (m < M) { const int b = m >> 12;
                float s = 0.f, am = 0.f;
#pragma unroll
                for (int jj = 0; jj < 4; ++jj) { const int k = 4 * lane + 256 * jj;
                    s += (v[rr2][jj][0] * v[rr2][jj][0] + v[rr2][jj][1] * v[rr2][jj][1]) + (v[rr2][jj][2] * v[rr2][jj][2] + v[rr2][jj][3] * v[rr2][jj][3]);
                    v[rr2][jj] = v[rr2][jj] * *(const f32x4*)(g1 + k) * (*(const f32x4*)(MOD + (size_t)b * LDM + 1 * D + k) + 1.0f);
                    const f32x4 t = __builtin_elementwise_abs(v[rr2][jj]); am = fmaxf(am, fmaxf(fmaxf(t[0], t[1]), fmaxf(t[2], t[3]))); }
                s = wave_sum(s); am = wave_max(am);
                const float q = am > 0.f ? 127.0f / am : 0.f;
#pragma unroll
                for (int jj = 0; jj < 4; ++jj) *(unsigned*)(A8 + (size_t)m * D + 4 * lane + 256 * jj) = q8x4(v[rr2][jj] * q);
                if (lane == 0) RS1[m] = rsqrtf(s * (1.0f / D) + EPS) * am * (1.0f / 127.0f); } }
        }
        for (int it = gw; it < FF2 + NMIX + FF2; it += NGW) {
            if (it >= FF2 && it < FF2 + NMIX) {
                const bf16* wrow = WIN + (size_t)(it - FF2) * D; float* op = BIAS2 + (it - FF2);
                const v4u wA = *(const v4u*)(wrow + 8 * lane), wB = *(const v4u*)(wrow + 512 + 8 * lane);
                f32x4 a0, a1, c0, c1; unpack8(wA, a0, a1); unpack8(wB, c0, c1);
#pragma unroll
                for (int b = 0; b < NB; ++b) { const LAS float* sp = shl + (1 * NB + b) * D + 8 * lane;
                    const f32x4 p = a0 * *(const LAS f32x4*)(sp) + a1 * *(const LAS f32x4*)(sp + 4) + c0 * *(const LAS f32x4*)(sp + 512) + c1 * *(const LAS f32x4*)(sp + 516);
                    const float tot = wave_sum((p[0] + p[1]) + (p[2] + p[3]));
                    if (lane == 0) op[(size_t)b * NMIX] = tot; }
            } else {
                const int t = it < FF2 ? 0 : 2, n = it < FF2 ? it : it - FF2 - NMIX;
                const unsigned char* wrow = (t == 0 ? W1I8 : W2I8) + (size_t)n * D; float* op = (t == 0 ? BIAS1 : BIAS3) + n; const float csn = (t == 0 ? CS1 : CS3)[n];
                const v4u w16 = *(const v4u*)(wrow + 16 * lane);
                f32x4 wf[4];
#pragma unroll
                for (int d4 = 0; d4 < 4; ++d4) { const int wv = (int)(d4 == 0 ? w16.x : d4 == 1 ? w16.y : d4 == 2 ? w16.z : w16.w);
                    wf[d4] = (f32x4){(float)((wv << 24) >> 24), (float)((wv << 16) >> 24), (float)((wv << 8) >> 24), (float)(wv >> 24)}; }
#pragma unroll
                for (int b = 0; b < NB; ++b) { const LAS float* sp = shl + (t * NB + b) * D + 16 * lane;
                    const f32x4 p = wf[0] * *(const LAS f32x4*)(sp) + wf[1] * *(const LAS f32x4*)(sp + 4) + wf[2] * *(const LAS f32x4*)(sp + 8) + wf[3] * *(const LAS f32x4*)(sp + 12);
                    const float tot = wave_sum((p[0] + p[1]) + (p[2] + p[3]));
                    if (lane == 0) op[(size_t)b * FF2] = tot * csn; }
            }
        }
        __syncthreads();
        AGAIN(1, rr);
    }
    SEAM(1);
    if (IN(2))
_Pragma("unroll")
    for (int rr = 0; rr < REPS(2); ++rr) {
        pg8::Gemm g{(const pg8::bf16_t*)A8, (const pg8::bf16_t*)W1I8, M, FF2, D / 2}; pg8::StaticOrder S; S.init(M, FF2, G, bx);
        EpiSwiglu8 E{ACT, RS1, CS1, BIAS1};
        pg8::gemm_phase<EpiSwiglu8, pg8::StaticOrder, true, true, true>(lds, g, S, E);
        AGAIN(2, rr);
    }
    SEAM(2);
    if (IN(3))
_Pragma("unroll")
    for (int rr = 0; rr < REPS(3); ++rr) {
        pg8::Gemm g{ACT, W1O, M, D, FF}; pg8::StaticOrder S; S.init(M, D, G, bx);
        EpiResid<1, true, false> E{x, X1, Y, SSP, MOD + 2 * D, gm, MOD + 4 * D};
        pg8::gemm_phase<EpiResid<1, true, false>, pg8::StaticOrder, true, true>(lds, g, S, E);
        AGAIN(3, rr);
    }
    SEAM(3);
    if (IN(4))
_Pragma("unroll")
    for (int rr = 0; rr < REPS(4); ++rr) {
        pg8::Gemm g{Y, WIN, M, NMIX, D}; pg8::StaticOrder S; S.init(M, NMIX, G, bx);
        EpiMixIn E{U, UXB, GYB, SSP, BIAS2};
        pg8::gemm_phase<EpiMixIn, pg8::StaticOrder, true, true>(lds, g, S, E);
        AGAIN(4, rr);
    }
    SEAM(4);
    if (IN(5))
_Pragma("unroll")
    for (int rr = 0; rr < REPS(5); ++rr) {
        mix_conv(lds, U, conv_w, conv_b, ln_g, ln_b, YMIX, G, bx, tid, lane, wave);
#ifdef MK_REP_CONV
        mix_conv(lds, U, conv_w, conv_b, ln_g, ln_b, YMIX, G, bx, tid, lane, wave);
#endif
        mix_scan1(lds, UXB, GYB, WGT, rw, rb, b_a, b_i, lam, TOT, (unsigned*)(ctl + CW_SCAN), YMIX, G, bx, lane, wave);
        AGAIN(5, rr);
    }
    SEAM(5);
    if (IN(7))
_Pragma("unroll")
    for (int rr = 0; rr < REPS(7); ++rr) {
        pg8::Gemm g{YMIX, WOUT, M, D, D}; pg8::StaticOrder S; S.init(M, D, G, bx);
        EpiResidQ<0, true> E{X1, X1, A8, RS3, (f32x2*)(ws + WS_SSPX), MOD + 5 * D, g2, MOD + 7 * D, (unsigned*)(ctl + CW_SEAM7)};
        pg8::gemm_phase<EpiResidQ<0, true>, pg8::StaticOrder, true, true>(lds, g, S, E);
        AGAIN(7, rr);
    }
    SEAM(7);
    if (IN(8))
_Pragma("unroll")
    for (int rr = 0; rr < REPS(8); ++rr) {
        pg8::Gemm g{(const pg8::bf16_t*)A8, (const pg8::bf16_t*)W2I8, M, FF2, D / 2}; pg8::StaticOrder S; S.init(M, FF2, G, bx);
        EpiSwiglu8 E{ACT, RS3, CS3, BIAS3};
        pg8::gemm_phase<EpiSwiglu8, pg8::StaticOrder, true, true, true>(lds, g, S, E);
        AGAIN(8, rr);
    }
    SEAM(8);
    if (IN(9))
_Pragma("unroll")
    for (int rr = 0; rr < REPS(9); ++rr) {
        pg8::Gemm g{ACT, W2O, M, D, FF}; pg8::StaticOrder S; S.init(M, D, G, bx);
        EpiResidFinal E{X1, out, (float*)(ws + WS_SSPF), MOD + 8 * D, gf, MOD + 10 * D, MOD + 9 * D, (unsigned*)(ctl + CW_SEAM)};
        pg8::gemm_phase<EpiResidFinal, pg8::StaticOrder, true, true>(lds, g, S, E);
    }
#undef IN
#undef SEAM
#undef REPS
#undef AGAIN
}

extern "C" void kernel_launch(void* const* d_in, const int* in_sizes, int n_in, void* d_out, int out_size, void* d_ws, size_t ws_size, hipStream_t stream) {
    static int grid = 0;
    if (grid == 0) {
        if (n_in != 27 || in_sizes[0] != M * D || out_size != M * D || ws_size < WS_END) { fprintf(stderr, "kernel_launch: unexpected shapes (n_in %d, in0 %d, out %d, ws %zu)\n", n_in, n_in > 0 ? in_sizes[0] : -1, out_size, ws_size); grid = -1; return; }
        int dev = 0, cus = 0, per_cu = 0;
        if (hipGetDevice(&dev) != hipSuccess || hipDeviceGetAttribute(&cus, hipDeviceAttributeMultiprocessorCount, dev) != hipSuccess) { grid = -1; return; }
        if (hipFuncSetAttribute((const void*)mk_fwd, hipFuncAttributeMaxDynamicSharedMemorySize, LDS_BYTES) != hipSuccess) { fprintf(stderr, "kernel_launch: hipFuncSetAttribute failed\n"); grid = -1; return; }
        if (hipOccupancyMaxActiveBlocksPerMultiprocessor(&per_cu, (const void*)mk_fwd, NWAVES * 64, LDS_BYTES) != hipSuccess || per_cu < 1) fprintf(stderr, "kernel_launch: occupancy query reports %d blocks per CU\n", per_cu);
        (void)hipGetLastError();
        grid = cus;
        if (grid % 8 != 0 || grid < 8) { fprintf(stderr, "kernel_launch: %d CUs: the scan's chunk rounds need a multiple of 8 workgroups\n", grid); grid = -1; return; }
    }
    if (grid < 0) return;
    if (hipMemsetAsync((char*)d_ws + WS_CTL, 0, CTL_ZERO_BYTES, stream) != hipSuccess) return;
    Args a{};
    for (int i = 0; i < 27; ++i) a.in[i] = (const float*)d_in[i];
    a.out = (float*)d_out; a.ws = (unsigned char*)d_ws;
#if MK_PER_PHASE
    for (int p = 0; p < NPH; ++p) { a.ph_lo = p; a.ph_hi = p + 1; hipLaunchKernelGGL(mk_fwd, dim3(grid), dim3(NWAVES * 64), LDS_BYTES, stream, a); }
#else
    a.ph_lo = 0; a.ph_hi = NPH; hipLaunchKernelGGL(mk_fwd, dim3(grid), dim3(NWAVES * 64), LDS_BYTES, stream, a);
#endif
}
```

```cpp
#include <hip/hip_runtime.h>
#include <cstdio>
#include <cstdint>
namespace pg8 {
#define PG8_LAS __attribute__((address_space(3)))
typedef unsigned short bf16_t;
typedef short bf16x8 __attribute__((ext_vector_type(8)));
typedef float f32x4 __attribute__((ext_vector_type(4)));
typedef unsigned u32x4 __attribute__((ext_vector_type(4)));
constexpr int BM = 256, BK = 64, HALF = 128, HTB = HALF * BK * 2  , STAGE_BYTES = 8 * HTB, NXCD = 8, WGM = 8;

__host__ __device__ __forceinline__ int lds_byte(int r, int c) { const int st = (r >> 4) * 2 + (c >> 5), rr = r & 15, cc = c & 31, ob = rr * 64 + cc * 2; return st * 1024 + (ob ^ (((ob >> 9) & 1) << 5)); }
__host__ __device__ __forceinline__ void stage_rc(int b, int& R, int& C) { const int st = b / 1024, sb = b % 1024, swz = sb ^ (((sb >> 9) & 1) << 5); R = (st >> 1) * 16 + swz / 64; C = (st & 1) * 32 + (swz % 64) / 2; }
__host__ __device__ __forceinline__ int perm32(int rho) { const int n = rho >> 4, i = rho & 15; return 8 * (i >> 2) + 4 * n + (i & 3); }

struct Unit { int pm, pn; };
struct Gemm { const bf16_t* A; const bf16_t* Bt; int M, N, K; };

struct StaticOrder {
    int nM, nN, nwg, G, c;
    __host__ __device__ void init(int M, int N, int G_, int c_) { nM = M / BM; nN = N / BM; nwg = nM * nN; G = G_; c = c_; }
    __host__ __device__ bool next(int i, Unit& u) const {
        const long L = (long)i * G + c; if (L >= nwg) return false;
        int wgid = (int)L; { const int q = nwg / NXCD, r = nwg % NXCD, xcd = wgid % NXCD, off = wgid / NXCD; wgid = (xcd < r ? xcd * (q + 1) : r * (q + 1) + (xcd - r) * q) + off; }
        const int nig = WGM * nN, gid = wgid / nig, fm = gid * WGM, gsz = (nM - fm) < WGM ? (nM - fm) : WGM;
        u.pm = fm + ((wgid % nig) % gsz); u.pn = (wgid % nig) / gsz; return true;
    }
    __device__ __forceinline__ void a_ready(const Unit&) const {}
    __device__ __forceinline__ void done(const Unit&) const {}
};

__device__ __forceinline__ unsigned cvt_pk_bf16(float lo, float hi) { unsigned r; asm volatile("v_cvt_pk_bf16_f32 %0, %1, %2" : "=v"(r) : "v"(lo), "v"(hi)); return r; }
#ifndef PG8_STAGE_IN_MMA
#define PG8_STAGE_IN_MMA 0
#endif
typedef int i32x4 __attribute__((ext_vector_type(4)));
template <bool I8> __device__ __forceinline__ f32x4 mma16(const bf16x8 b, const bf16x8 a, const f32x4 c) {
    if constexpr (I8) return __builtin_bit_cast(f32x4, __builtin_amdgcn_mfma_i32_16x16x64_i8(__builtin_bit_cast(i32x4, b), __builtin_bit_cast(i32x4, a), __builtin_bit_cast(i32x4, c), 0, 0, 0));
    else return __builtin_amdgcn_mfma_f32_16x16x32_bf16(b, a, c, 0, 0, 0);
}
template <class Epi, class Sched, bool ALIGN_EPI = false, bool SP2 = false, bool I8 = false>
__device__ __forceinline__ void gemm_phase(PG8_LAS unsigned char* lds, const Gemm g, const Sched& S, const Epi& E) {
    const int tid = threadIdx.x, wid = __builtin_amdgcn_readfirstlane(tid >> 6), lane = tid & 63, wr = wid >> 2, wc = wid & 3, fr = lane & 15, fq = lane >> 4;
    const int K = g.K, nt = K / BK;
    unsigned voffA[2], voffB[2];
#pragma unroll
    for (int i = 0; i < 2; ++i) { int R, C; stage_rc(tid * 16 + i * 8192, R, C); const int Rb = Epi::PERM ? ((R & ~31) + perm32(R & 31)) : R;
        voffA[i] = (unsigned)(R * K + C) * 2u; voffB[i] = (unsigned)(Rb * K + C) * 2u; }
    const size_t kstep = (size_t)(BK * 2);
    const size_t hstep = (size_t)HALF * K * 2;
    const size_t tstep = 2 * hstep;
    const unsigned ldsw = (unsigned)wid * 1024u;
    const int aoff = lds_byte(wr * 64 + fr, fq * 8), boff = lds_byte(wc * 32 + fr, fq * 8);
#define PG8_SA(b, h) (((b) * 2 + (h)) * HTB)
#define PG8_SB(b, h) ((4 + (b) * 2 + (h)) * HTB)
#define PG8_STAGE(bufoff, gbase, voff) do { _Pragma("unroll") for (int _i = 0; _i < 2; ++_i) \
        __builtin_amdgcn_global_load_lds((const unsigned*)((const char*)(gbase) + (voff)[_i]), (PG8_LAS unsigned*)(lds + (bufoff) + ldsw + _i * 8192), 16, 0, 0); } while (0)
#define PG8_LDA(dst, b, h) do { _Pragma("unroll") for (int m = 0; m < 4; ++m) _Pragma("unroll") for (int k = 0; k < 2; ++k) dst[m][k] = *(const PG8_LAS bf16x8*)(lds + PG8_SA(b, h) + aoff + m * 2048 + k * 1024); } while (0)
#define PG8_LDB(dst, b, h) do { _Pragma("unroll") for (int n = 0; n < 2; ++n) _Pragma("unroll") for (int k = 0; k < 2; ++k) dst[n][k] = *(const PG8_LAS bf16x8*)(lds + PG8_SB(b, h) + boff + n * 2048 + k * 1024); } while (0)
#define PG8_MMA(ai, bj, At, Bt) do { __builtin_amdgcn_s_setprio(1); _Pragma("unroll") for (int m = 0; m < 4; ++m) _Pragma("unroll") for (int n = 0; n < 2; ++n) _Pragma("unroll") for (int k = 0; k < 2; ++k) \
        acc[ai][bj][m][n] = mma16<I8>(Bt[n][k], At[m][k], acc[ai][bj][m][n]); __builtin_amdgcn_s_setprio(0); } while (0)
#define PG8_WAIT_V(n) asm volatile("s_waitcnt vmcnt(" #n ")" ::: "memory")
#define PG8_WAIT_L(n) asm volatile("s_waitcnt lgkmcnt(" #n ")" ::: "memory")
#define PG8_BAR __builtin_amdgcn_s_barrier()
#define PG8_SCHED __builtin_amdgcn_sched_barrier(0)
    Unit cur, nxt; int ui = 0;
    if (!S.next(0, cur)) return;
    f32x4 acc[2][2][4][2];
#pragma unroll
    for (int a = 0; a < 2; ++a)
#pragma unroll
        for (int b = 0; b < 2; ++b)
#pragma unroll
            for (int m = 0; m < 4; ++m)
#pragma unroll
                for (int n = 0; n < 2; ++n) acc[a][b][m][n] = (f32x4){0.f, 0.f, 0.f, 0.f};
    bf16x8 At[4][2], B0[2][2], B1[2][2];
    const char* cA = (const char*)g.A + (size_t)cur.pm * tstep; const char* cB = (const char*)g.Bt + (size_t)cur.pn * tstep;
    S.a_ready(cur);
    if constexpr (SP2) {
        PG8_STAGE(PG8_SB(0, 0), cB, voffB); PG8_STAGE(PG8_SB(0, 1), cB + hstep, voffB); PG8_STAGE(PG8_SA(0, 0), cA, voffA); PG8_STAGE(PG8_SA(0, 1), cA + hstep, voffA);
        if (wr == 1) PG8_BAR;
        PG8_WAIT_V(2); PG8_BAR;
        PG8_STAGE(PG8_SB(1, 0), cB + kstep, voffB); PG8_STAGE(PG8_SA(1, 0), cA + kstep, voffA); PG8_STAGE(PG8_SB(1, 1), cB + hstep + kstep, voffB);
        PG8_WAIT_V(6); PG8_BAR;
    } else {
        PG8_STAGE(PG8_SB(0, 0), cB, voffB); PG8_STAGE(PG8_SA(0, 0), cA, voffA); PG8_STAGE(PG8_SB(0, 1), cB + hstep, voffB); PG8_STAGE(PG8_SA(0, 1), cA + hstep, voffA);
        if (wr == 1) PG8_BAR;
        PG8_WAIT_V(4); PG8_BAR;
        PG8_STAGE(PG8_SB(1, 0), cB + kstep, voffB); PG8_STAGE(PG8_SA(1, 0), cA + kstep, voffA); PG8_STAGE(PG8_SB(1, 1), cB + hstep + kstep, voffB);
        PG8_WAIT_V(6); PG8_BAR;
    }
    for (;;) {
        const bool has_next = S.next(ui + 1, nxt);
        const char* nA = has_next ? (const char*)g.A + (size_t)nxt.pm * tstep : cA; const char* nB = has_next ? (const char*)g.Bt + (size_t)nxt.pn * tstep : cB;
        asm volatile(".p2align 8" ::: "memory");
        for (int t = 0; t < nt; t += 2) {
            const bool last = (t == nt - 2);
            const char* a1 = cA + (size_t)(t + 1) * kstep;
            const char* a2 = last ? nA : cA + (size_t)(t + 2) * kstep; const char* b2 = last ? nB : cB + (size_t)(t + 2) * kstep;
            const char* a3 = a2 + kstep; const char* b3 = b2 + kstep;
            if (last && has_next) S.a_ready(nxt);
            if constexpr (SP2) {
#if PG8_STAGE_IN_MMA
            PG8_LDB(B0, 0, 0); PG8_LDB(B1, 0, 1); PG8_SCHED; PG8_LDA(At, 0, 0);
            PG8_WAIT_V(6); PG8_WAIT_L(0); PG8_BAR; PG8_MMA(0, 0, At, B0); PG8_SCHED; PG8_STAGE(PG8_SA(1, 1), a1 + hstep, voffA); PG8_SCHED; PG8_MMA(0, 1, At, B1); PG8_BAR; PG8_SCHED;
            PG8_LDA(At, 0, 1);
            PG8_WAIT_V(2); PG8_WAIT_L(0); PG8_BAR; PG8_STAGE(PG8_SB(0, 0), b2, voffB); PG8_SCHED; PG8_MMA(1, 0, At, B0); PG8_SCHED; PG8_STAGE(PG8_SB(0, 1), b2 + hstep, voffB); PG8_SCHED; PG8_MMA(1, 1, At, B1); PG8_SCHED; PG8_STAGE(PG8_SA(0, 0), a2, voffA); PG8_BAR; PG8_SCHED;
            PG8_LDB(B0, 1, 0); PG8_LDB(B1, 1, 1); PG8_SCHED; PG8_LDA(At, 1, 0);
            PG8_WAIT_V(6); PG8_WAIT_L(0); PG8_BAR; PG8_MMA(0, 0, At, B0); PG8_SCHED; PG8_STAGE(PG8_SA(0, 1), a2 + hstep, voffA); PG8_SCHED; PG8_MMA(0, 1, At, B1); PG8_BAR; PG8_SCHED;
            PG8_LDA(At, 1, 1);
            PG8_WAIT_V(2); PG8_WAIT_L(0); PG8_BAR; PG8_STAGE(PG8_SB(1, 0), b3, voffB); PG8_SCHED; PG8_MMA(1, 0, At, B0); PG8_SCHED; PG8_STAGE(PG8_SB(1, 1), b3 + hstep, voffB); PG8_SCHED; PG8_MMA(1, 1, At, B1); PG8_SCHED; PG8_STAGE(PG8_SA(1, 0), a3, voffA); PG8_BAR; PG8_SCHED;
#else
            PG8_LDB(B0, 0, 0); PG8_LDB(B1, 0, 1); PG8_SCHED; PG8_LDA(At, 0, 0); PG8_STAGE(PG8_SA(1, 1), a1 + hstep, voffA);
            PG8_WAIT_V(8); PG8_WAIT_L(0); PG8_BAR; PG8_MMA(0, 0, At, B0); PG8_MMA(0, 1, At, B1); PG8_BAR; PG8_SCHED;
            PG8_LDA(At, 0, 1); PG8_STAGE(PG8_SB(0, 0), b2, voffB); PG8_STAGE(PG8_SB(0, 1), b2 + hstep, voffB); PG8_STAGE(PG8_SA(0, 0), a2, voffA);
            PG8_WAIT_V(8); PG8_WAIT_L(0); PG8_BAR; PG8_MMA(1, 0, At, B0); PG8_MMA(1, 1, At, B1); PG8_BAR; PG8_SCHED;
            PG8_LDB(B0, 1, 0); PG8_LDB(B1, 1, 1); PG8_SCHED; PG8_LDA(At, 1, 0); PG8_STAGE(PG8_SA(0, 1), a2 + hstep, voffA);
            PG8_WAIT_V(8); PG8_WAIT_L(0); PG8_BAR; PG8_MMA(0, 0, At, B0); PG8_MMA(0, 1, At, B1); PG8_BAR; PG8_SCHED;
            PG8_LDA(At, 1, 1); PG8_STAGE(PG8_SB(1, 0), b3, voffB); PG8_STAGE(PG8_SB(1, 1), b3 + hstep, voffB); PG8_STAGE(PG8_SA(1, 0), a3, voffA);
            PG8_WAIT_V(8); PG8_WAIT_L(0); PG8_BAR; PG8_MMA(1, 0, At, B0); PG8_MMA(1, 1, At, B1); PG8_BAR; PG8_SCHED;
#endif
            } else {
            PG8_LDB(B0, 0, 0); PG8_SCHED; PG8_LDA(At, 0, 0); PG8_STAGE(PG8_SA(1, 1), a1 + hstep, voffA);
            PG8_WAIT_L(8); PG8_BAR; PG8_WAIT_L(0); PG8_MMA(0, 0, At, B0); PG8_BAR; PG8_SCHED;
            PG8_LDB(B1, 0, 1); PG8_STAGE(PG8_SB(0, 0), b2, voffB);
            PG8_BAR; PG8_WAIT_L(0); PG8_MMA(0, 1, At, B1); PG8_BAR;
            PG8_LDA(At, 0, 1); PG8_STAGE(PG8_SA(0, 0), a2, voffA);
            PG8_BAR; PG8_WAIT_L(0); PG8_MMA(1, 0, At, B0); PG8_BAR; PG8_SCHED;
            PG8_STAGE(PG8_SB(0, 1), b2 + hstep, voffB);
            PG8_WAIT_V(6); PG8_BAR; PG8_MMA(1, 1, At, B1); PG8_BAR;
            PG8_LDB(B0, 1, 0); PG8_SCHED; PG8_LDA(At, 1, 0); PG8_STAGE(PG8_SA(0, 1), a2 + hstep, voffA);
            PG8_WAIT_L(8); PG8_BAR; PG8_WAIT_L(0); PG8_MMA(0, 0, At, B0); PG8_BAR; PG8_SCHED;
            PG8_LDB(B1, 1, 1); PG8_STAGE(PG8_SB(1, 0), b3, voffB);
            PG8_BAR; PG8_WAIT_L(0); PG8_MMA(0, 1, At, B1); PG8_BAR;
            PG8_LDA(At, 1, 1); PG8_STAGE(PG8_SA(1, 0), a3, voffA);
            PG8_BAR; PG8_WAIT_L(0); PG8_MMA(1, 0, At, B0); PG8_BAR; PG8_SCHED;
            PG8_STAGE(PG8_SB(1, 1), b3 + hstep, voffB);
            PG8_WAIT_V(6); PG8_BAR; PG8_MMA(1, 1, At, B1); PG8_BAR;
            }
        }
        if constexpr (ALIGN_EPI) { if (wr == 0) PG8_BAR; }
        if constexpr (!Epi::AFTER_DRAIN) { _Pragma("unroll") for (int er = 0; er < Epi::REPS; ++er) { E(acc, cur, wr, wc, fr, fq); if (er + 1 < Epi::REPS) asm volatile("" ::: "memory"); } S.done(cur); }
        if (!has_next) break;
#pragma unroll
        for (int a = 0; a < 2; ++a)
#pragma unroll
            for (int b = 0; b < 2; ++b)
#pragma unroll
                for (int m = 0; m < 4; ++m)
#pragma unroll
                    for (int n = 0; n < 2; ++n) acc[a][b][m][n] = (f32x4){0.f, 0.f, 0.f, 0.f};
        cur = nxt; cA = nA; cB = nB; ++ui;
        if constexpr (ALIGN_EPI) { if (wr == 1) PG8_BAR; }
    }
    PG8_WAIT_V(0);
    if constexpr (!ALIGN_EPI) { if (wr == 0) PG8_BAR; }
    PG8_BAR;
    if constexpr (Epi::AFTER_DRAIN) { E.fused(acc, cur, wr, wc, fr, fq, lds, wid, lane); S.done(cur); }
#undef PG8_SA
#undef PG8_SB
#undef PG8_STAGE
#undef PG8_LDA
#undef PG8_LDB
#undef PG8_MMA
#undef PG8_WAIT_V
#undef PG8_WAIT_L
#undef PG8_BAR
#undef PG8_SCHED
}
}
#define GAS __attribute__((address_space(1)))
#define LAS __attribute__((address_space(3)))
typedef unsigned short bf16;
typedef unsigned v4u __attribute__((ext_vector_type(4)));
typedef float f32x4 __attribute__((ext_vector_type(4)));
typedef short bf16x8 __attribute__((ext_vector_type(8)));
typedef GAS unsigned gu32;
typedef GAS unsigned long long gu64;
#define RLX_AGENT __ATOMIC_RELAXED, __HIP_MEMORY_SCOPE_AGENT
#define LDS_WAIT() asm volatile("s_waitcnt lgkmcnt(0)" ::: "memory")
#define VM_WAIT() asm volatile("s_waitcnt vmcnt(0)" ::: "memory")
__device__ __forceinline__ unsigned long long rt() { return __builtin_amdgcn_s_memrealtime(); }
__device__ __forceinline__ unsigned f2bf(float f) { unsigned u = __builtin_bit_cast(unsigned, f); return (u + 0x7fffu + ((u >> 16) & 1u)) >> 16; }
__device__ __forceinline__ unsigned pk2(float lo, float hi) { return f2bf(lo) | (f2bf(hi) << 16); }

#define XB_TMO      128
#define XB_XCNT(j)  (256  + 64 * (j))
#define XB_XSUB(j)  (1280 + 64 * (j))
#define XB_XGEN(j)  (2304 + 64 * (j))
#define XB_TOP      3328
#define XB_TOPGEN   3392
#define XCD_BAR_WORDS 3456
#define XB_SPIN_CAP (1u << 18)

__device__ __forceinline__ unsigned xb_ld(unsigned* p)              { return __hip_atomic_load(p, __ATOMIC_RELAXED, __HIP_MEMORY_SCOPE_AGENT); }
__device__ __forceinline__ unsigned xb_add(unsigned* p, unsigned v) { return __hip_atomic_fetch_add(p, v, __ATOMIC_RELAXED, __HIP_MEMORY_SCOPE_AGENT); }
__device__ __forceinline__ unsigned xb_xcc_id() { return (unsigned)__builtin_amdgcn_s_getreg((3 << 11) | 20) & 0xFu; }
#define XB_SPIN(cond, bar) do { unsigned _sp = 0; while (cond) { __builtin_amdgcn_s_sleep(1); \
    if ((++_sp & 255u) == 0u) { if (xb_ld(&(bar)[XB_TMO])) break; if (_sp > XB_SPIN_CAP) { atomicAdd(&(bar)[XB_TMO], 1u); break; } } } } while (0)

struct XcdBarrier {
    unsigned* bar; unsigned x;
    volatile LAS unsigned* st;
};

__device__ __forceinline__ XcdBarrier xcd_barrier_post(unsigned* bar, volatile LAS unsigned* st) {
    XcdBarrier b; b.bar = bar; b.x = xb_xcc_id(); b.st = st;
    if (threadIdx.x == 0) (void)xb_add(&bar[XB_XCNT(b.x)], 1u);
    return b;
}
__device__ __forceinline__ void xcd_barrier_complete(unsigned* bar, unsigned x, unsigned& nloc, unsigned& nx) {
    const unsigned G = gridDim.x * gridDim.y * gridDim.z;
    unsigned sum, cnt, mine, sp = 0u;
    for (;;) {
        sum = 0u; cnt = 0u; mine = 0u;
#pragma unroll
        for (unsigned j = 0; j < 16; ++j) { const unsigned c = xb_ld(&bar[XB_XCNT(j)]); sum += c; cnt += (c > 0u) ? 1u : 0u; mine = (j == x) ? c : mine; }
        if (sum == G) break;
        __builtin_amdgcn_s_sleep(1);
        if ((++sp & 255u) == 0u) { if (xb_ld(&bar[XB_TMO])) break; if (sp > XB_SPIN_CAP) { atomicAdd(&bar[XB_TMO], 1u); break; } }
    }
    nloc = mine > 0u ? mine : 1u; nx = cnt > 0u ? cnt : 1u;
}

__device__ __forceinline__ void xcd_barrier(const XcdBarrier& b) {
    asm volatile("s_waitcnt vmcnt(0)" ::: "memory");
    __syncthreads();
    if (threadIdx.x == 0) {
        unsigned* bar = b.bar;
        __builtin_amdgcn_s_waitcnt(0);
        unsigned nloc = b.st[0], nx = b.st[1];
        if (nloc == 0u) { xcd_barrier_complete(bar, b.x, nloc, nx); b.st[0] = nloc; b.st[1] = nx; }
        const unsigned old = xb_add(&bar[XB_XSUB(b.x)], 1u);
        const unsigned gen = old / nloc;
        if (old + 1u == (gen + 1u) * nloc) {
            __builtin_amdgcn_fence(__ATOMIC_RELEASE, "agent");
            asm volatile("s_waitcnt vmcnt(0)" ::: "memory");
            const unsigned og = xb_add(&bar[XB_TOP], 1u);
            const unsigned tg = og / nx;
            if (og + 1u == (tg + 1u) * nx) xb_add(&bar[XB_TOPGEN], 1u);
            else XB_SPIN(xb_ld(&bar[XB_TOPGEN]) == tg, bar);
            __builtin_amdgcn_fence(__ATOMIC_ACQUIRE, "agent");
            xb_add(&bar[XB_XGEN(b.x)], 1u);
            asm volatile("s_waitcnt vmcnt(0)" ::: "memory");
        } else {
            XB_SPIN(xb_ld(&bar[XB_XGEN(b.x)]) == gen, bar);
            __builtin_amdgcn_fence(__ATOMIC_ACQUIRE, "agent");
            asm volatile("s_waitcnt vmcnt(0)" ::: "memory");
        }
    }
    __syncthreads();
}

constexpr int NWAVES = 8;
constexpr int NB = 8, SEQ = 4096, D = 1024, M = NB * SEQ, FF = 2816, FF2 = 2 * FF, DC = 512, DR = 512, NH = 8, HD = 64, CW = 31, RW = 4, NMIX = 2048;
constexpr float EPS = 1e-6f;
constexpr int LDM = 11 * D;
constexpr size_t MiB = 1u << 20;
constexpr size_t WS_CTL = 0, CTL_ZERO_BYTES = 1 * MiB;
constexpr size_t WS_MOD = 1 * MiB;
constexpr size_t WS_BIAS1 = 1 * MiB + 512 * 1024;
constexpr size_t WS_BIAS3 = 1 * MiB + 768 * 1024;
constexpr size_t WS_BIAS2 = 2 * MiB;
constexpr size_t WS_WGT = 2 * MiB + 128 * 1024;
constexpr size_t WS_CS1 = 2 * MiB + 384 * 1024, WS_CS3 = 2 * MiB + 448 * 1024;
constexpr size_t WS_RS1 = 2 * MiB + 512 * 1024, WS_RS3 = 2 * MiB + 640 * 1024;
constexpr size_t WS_CS2 = 2 * MiB + 480 * 1024, WS_RS2 = 2 * MiB + 768 * 1024;
constexpr size_t WS_TOT = 3 * MiB;
constexpr size_t WS_SSP = 5 * MiB;
constexpr size_t WS_W1I = 8 * MiB, WS_W1O = 19 * MiB, WS_WIN = 25 * MiB, WS_WOUT = 29 * MiB, WS_W2I = 31 * MiB, WS_W2O = 42 * MiB;
constexpr size_t WS_Y = 48 * MiB;
constexpr size_t WS_X1 = 112 * MiB;
constexpr size_t WS_ACT = 240 * MiB;
constexpr size_t WS_U = WS_ACT, WS_UX = WS_ACT + 32 * MiB, WS_GY = WS_ACT + 64 * MiB, WS_YMIX = WS_ACT + 96 * MiB;
constexpr size_t WS_SSPF = 416 * MiB;
constexpr size_t WS_SSPX = 418 * MiB;
constexpr size_t WS_SSPX3 = 422 * MiB;
constexpr size_t WS_END = 426 * MiB;
constexpr int CW_BAR = 4096, CW_SEAM = 16384, CW_SCAN = 32768, CW_SEAM7 = 49152, CW_SEAM3 = 65536;
constexpr int LDS_BYTES = 147456;
constexpr int LDSCTL_OFF = LDS_BYTES - 256;

typedef unsigned short u16;
typedef float f32x16 __attribute__((ext_vector_type(16)));
typedef float f32x2 __attribute__((ext_vector_type(2)));

__device__ __forceinline__ float wave_sum(float v) {
#pragma unroll
    for (int o = 1; o < 64; o <<= 1) v += __shfl_xor(v, o);
    return v;
}
__device__ __forceinline__ float sigmoid_fast(float x) { return __builtin_amdgcn_rcpf(1.f + __builtin_amdgcn_exp2f(-1.4426950408889634f * x)); }
__device__ __forceinline__ float silu_fast(float x) { return x * sigmoid_fast(x); }
__device__ __forceinline__ float gelu_tanh_fast(float x) { const float z = 0.7978845608028654f * (x + 0.044715f * x * x * x); return x * sigmoid_fast(2.f * z); }
__device__ __forceinline__ f32x4 sigmoid4(const f32x4 x) { const f32x4 t = x * -1.4426950408889634f; f32x4 e = {__builtin_amdgcn_exp2f(t[0]), __builtin_amdgcn_exp2f(t[1]), __builtin_amdgcn_exp2f(t[2]), __builtin_amdgcn_exp2f(t[3])};
    e = e + 1.0f; return (f32x4){__builtin_amdgcn_rcpf(e[0]), __builtin_amdgcn_rcpf(e[1]), __builtin_amdgcn_rcpf(e[2]), __builtin_amdgcn_rcpf(e[3])}; }
__device__ __forceinline__ f32x4 gelu_tanh4(const f32x4 x) { const f32x4 z2 = (x + (x * x) * x * 0.044715f) * (2.0f * 0.7978845608028654f); return x * sigmoid4(z2); }
__device__ __forceinline__ float bflo(unsigned w) { return __uint_as_float(w << 16); }
__device__ __forceinline__ float bfhi(unsigned w) { return __uint_as_float(w & 0xffff0000u); }
__device__ __forceinline__ unsigned cvtpk(float lo, float hi) { return pg8::cvt_pk_bf16(lo, hi); }
__device__ __forceinline__ v4u pack8(const f32x4 a, const f32x4 b) { v4u w; w.x = cvtpk(a[0], a[1]); w.y = cvtpk(a[2], a[3]); w.z = cvtpk(b[0], b[1]); w.w = cvtpk(b[2], b[3]); return w; }

__device__ __forceinline__ void unpack8(const v4u w, f32x4& a, f32x4& b) { a = (f32x4){bflo(w.x), bfhi(w.x), bflo(w.y), bfhi(w.y)}; b = (f32x4){bflo(w.z), bfhi(w.z), bflo(w.w), bfhi(w.w)}; }
__device__ __forceinline__ unsigned q8(float v) { int q = (int)__builtin_rintf(v); q = q < -127 ? -127 : (q > 127 ? 127 : q); return (unsigned)q & 0xffu; }
__device__ __forceinline__ unsigned q8x4(const f32x4 v) { return q8(v[0]) | (q8(v[1]) << 8) | (q8(v[2]) << 16) | (q8(v[3]) << 24); }
__device__ __forceinline__ float wave_max(float v) {
#pragma unroll
    for (int o = 1; o < 64; o <<= 1) v = fmaxf(v, __shfl_xor(v, o));
    return v;
}
typedef int i32x4v __attribute__((ext_vector_type(4)));
__device__ __forceinline__ f32x4 acc_i2f(const f32x4 a) { return __builtin_convertvector(__builtin_bit_cast(i32x4v, a), f32x4); }
__device__ __forceinline__ void load_rstd(const float* ssp, int row0, int fq, float (&rs)[2][4]) {
#pragma unroll
    for (int ai = 0; ai < 2; ++ai)
#pragma unroll
        for (int m = 0; m < 4; ++m) { const f32x4 p = *(const f32x4*)(ssp + (size_t)(row0 + ai * 128 + m * 16) * 16 + 4 * fq);
            float s = (p[0] + p[1]) + (p[2] + p[3]); s += __shfl_xor(s, 16); s += __shfl_xor(s, 32); rs[ai][m] = rsqrtf(s * (1.0f / D) + EPS); }
}
__device__ __forceinline__ void load_rstd_sc1(const float* ssp, int row0, int fq, float (&rs)[2][4]) {
#pragma unroll
    for (int ai = 0; ai < 2; ++ai)
#pragma unroll
        for (int m = 0; m < 4; ++m) { const gu32* p = (const gu32*)(ssp + (size_t)(row0 + ai * 128 + m * 16) * 16 + 4 * fq);
            const float p0 = __uint_as_float(__hip_atomic_load(p, RLX_AGENT)), p1 = __uint_as_float(__hip_atomic_load(p + 1, RLX_AGENT)), p2 = __uint_as_float(__hip_atomic_load(p + 2, RLX_AGENT)), p3 = __uint_as_float(__hip_atomic_load(p + 3, RLX_AGENT));
            float s = (p0 + p1) + (p2 + p3); s += __shfl_xor(s, 16); s += __shfl_xor(s, 32); rs[ai][m] = rsqrtf(s * (1.0f / D) + EPS); }
}
#ifndef MK_EPI_SWIGLU_REPS
#define MK_EPI_SWIGLU_REPS 1
#endif
#ifndef MK_EPI_RESID_REPS
#define MK_EPI_RESID_REPS 1
#endif
struct EpiSwiglu {
    static constexpr bool PERM = true, AFTER_DRAIN = false; static constexpr int REPS = MK_EPI_SWIGLU_REPS;
    pg8::bf16_t* act; const float* ssp; const float* bias;
    __device__ __forceinline__ void operator()(const f32x4 (&acc)[2][2][4][2], const pg8::Unit& u, int wr, int wc, int fr, int fq) const {
        const int row0 = u.pm * 256 + wr * 64 + fr, b = u.pm >> 4;
        float rs[2][4]; load_rstd(ssp, row0, fq, rs);
        const float* bp = bias + (size_t)b * FF2 + u.pn * 256 + wc * 32 + 8 * fq;
        const f32x4 bg0 = *(const f32x4*)(bp), bg1 = *(const f32x4*)(bp + 4), bu0 = *(const f32x4*)(bp + 128), bu1 = *(const f32x4*)(bp + 132);
        const int oc = u.pn * 128 + wc * 32 + 8 * fq;
#pragma unroll
        for (int ai = 0; ai < 2; ++ai)
#pragma unroll
            for (int m = 0; m < 4; ++m) { const float r = rs[ai][m];
                const f32x4 g0 = acc[ai][0][m][0] * r + bg0, g1 = acc[ai][0][m][1] * r + bg1, u0 = acc[ai][1][m][0] * r + bu0, u1 = acc[ai][1][m][1] * r + bu1;
                const f32x4 a0 = (g0 * sigmoid4(g0)) * u0, a1 = (g1 * sigmoid4(g1)) * u1;
                *(v4u*)(act + (size_t)(row0 + ai * 128 + m * 16) * FF + oc) = pack8(a0, a1); }
    }
};
struct EpiSwiglu8 {
    static constexpr bool PERM = true, AFTER_DRAIN = false; static constexpr int REPS = 1;
    pg8::bf16_t* act; const float* rs; const float* cs; const float* bias;
    __device__ __forceinline__ void operator()(const f32x4 (&acc)[2][2][4][2], const pg8::Unit& u, int wr, int wc, int fr, int fq) const {
        const int row0 = u.pm * 256 + wr * 64 + fr, b = u.pm >> 4;
        float rv[2][4];
#pragma unroll
        for (int ai = 0; ai < 2; ++ai)
#pragma unroll
            for (int m = 0; m < 4; ++m) rv[ai][m] = rs[row0 + ai * 128 + m * 16];
        const int cb = u.pn * 256 + wc * 32 + 8 * fq;
        const float* bp = bias + (size_t)b * FF2 + cb; const float* cp = cs + cb;
        const f32x4 bg0 = *(const f32x4*)(bp), bg1 = *(const f32x4*)(bp + 4), bu0 = *(const f32x4*)(bp + 128), bu1 = *(const f32x4*)(bp + 132);
        const f32x4 cg0 = *(const f32x4*)(cp), cg1 = *(const f32x4*)(cp + 4), cu0 = *(const f32x4*)(cp + 128), cu1 = *(const f32x4*)(cp + 132);
        const int oc = u.pn * 128 + wc * 32 + 8 * fq;
#pragma unroll
        for (int ai = 0; ai < 2; ++ai)
#pragma unroll
            for (int m = 0; m < 4; ++m) { const float r = rv[ai][m];
                const f32x4 g0 = acc_i2f(acc[ai][0][m][0]) * (cg0 * r) + bg0, g1 = acc_i2f(acc[ai][0][m][1]) * (cg1 * r) + bg1;
                const f32x4 u0 = acc_i2f(acc[ai][1][m][0]) * (cu0 * r) + bu0, u1 = acc_i2f(acc[ai][1][m][1]) * (cu1 * r) + bu1;
                const f32x4 a0 = (g0 * sigmoid4(g0)) * u0, a1 = (g1 * sigmoid4(g1)) * u1;
                *(v4u*)(act + (size_t)(row0 + ai * 128 + m * 16) * FF + oc) = pack8(a0, a1); }
    }
};
template <int WHALF, bool HASY, bool IN16> struct EpiResid {
    static constexpr bool PERM = true, AFTER_DRAIN = false; static constexpr int REPS = (IN16 ? 1 : MK_EPI_RESID_REPS);
    static constexpr float w = WHALF ? 0.5f : 1.0f;
    const void* xin; pg8::bf16_t* xout; pg8::bf16_t* y; float* ssp; const float* gt; const float* gnext; const float* scnext;
    __device__ __forceinline__ void operator()(const f32x4 (&acc)[2][2][4][2], const pg8::Unit& u, int wr, int wc, int fr, int fq) const {
        const int row0 = u.pm * 256 + wr * 64 + fr, b = u.pm >> 4;
        float ss[2][4];
#pragma unroll
        for (int ai = 0; ai < 2; ++ai)
#pragma unroll
            for (int m = 0; m < 4; ++m) ss[ai][m] = 0.f;
#pragma unroll
        for (int bj = 0; bj < 2; ++bj) { const int c0 = u.pn * 256 + bj * 128 + wc * 32 + 8 * fq;
            const f32x4 gt0 = *(const f32x4*)(gt + (size_t)b * LDM + c0) * w, gt1 = *(const f32x4*)(gt + (size_t)b * LDM + c0 + 4) * w;
            f32x4 gs0 = {0.f, 0.f, 0.f, 0.f}, gs1 = gs0;
            if (HASY) { gs0 = *(const f32x4*)(gnext + c0) * (*(const f32x4*)(scnext + (size_t)b * LDM + c0) + 1.0f); gs1 = *(const f32x4*)(gnext + c0 + 4) * (*(const f32x4*)(scnext + (size_t)b * LDM + c0 + 4) + 1.0f); }
#pragma unroll
            for (int ai = 0; ai < 2; ++ai)
#pragma unroll
                for (int m = 0; m < 4; ++m) { const size_t off = (size_t)(row0 + ai * 128 + m * 16) * D + c0;
                    f32x4 x0, x1;
                    if (IN16) unpack8(*(const v4u*)((const pg8::bf16_t*)xin + off), x0, x1); else { x0 = *(const f32x4*)((const float*)xin + off); x1 = *(const f32x4*)((const float*)xin + off + 4); }
                    const f32x4 o0 = x0 + gt0 * acc[ai][bj][m][0], o1 = x1 + gt1 * acc[ai][bj][m][1];
                    *(v4u*)(xout + off) = pack8(o0, o1);
                    ss[ai][m] += (o0[0] * o0[0] + o0[1] * o0[1]) + (o0[2] * o0[2] + o0[3] * o0[3]) + (o1[0] * o1[0] + o1[1] * o1[1]) + (o1[2] * o1[2] + o1[3] * o1[3]);
                    if (HASY) *(v4u*)(y + off) = pack8(o0 * gs0, o1 * gs1); } }
#pragma unroll
        for (int ai = 0; ai < 2; ++ai)
#pragma unroll
            for (int m = 0; m < 4; ++m) { float s = ss[ai][m]; s += __shfl_xor(s, 16); s += __shfl_xor(s, 32);
                if (fq == 0) ssp[(size_t)(row0 + ai * 128 + m * 16) * 16 + u.pn * 4 + wc] = s; }
    }
};
template <int WHALF, bool IN16> struct EpiResidQ {
    static constexpr bool PERM = true, AFTER_DRAIN = false; static constexpr int REPS = 1;
    static constexpr float w = WHALF ? 0.5f : 1.0f;
    const void* xin; pg8::bf16_t* xout; unsigned char* a8; float* rs; f32x2* sspx; const float* gt; const float* gnext; const float* scnext; unsigned* cnt;
    __device__ __forceinline__ void operator()(f32x4 (&acc)[2][2][4][2], const pg8::Unit& u, int wr, int wc, int fr, int fq) const {
        const int row0 = u.pm * 256 + wr * 64 + fr, b = u.pm >> 4;
        float ss[2][4], am[2][4];
#pragma unroll
        for (int ai = 0; ai < 2; ++ai)
#pragma unroll
            for (int m = 0; m < 4; ++m) { ss[ai][m] = 0.f; am[ai][m] = 0.f; }
        const unsigned voff = (unsigned)((row0 * D + u.pn * 256 + wc * 32 + 8 * fq) * 2);
        unsigned vo[4] = {voff, voff, voff, voff};
#pragma unroll
        for (int bj = 0; bj < 2; ++bj) { const int c0 = u.pn * 256 + bj * 128 + wc * 32 + 8 * fq;
            const f32x4 gt0 = *(const f32x4*)(gt + (size_t)b * LDM + c0) * w, gt1 = *(const f32x4*)(gt + (size_t)b * LDM + c0 + 4) * w;
            const f32x4 gs0 = *(const f32x4*)(gnext + c0) * (*(const f32x4*)(scnext + (size_t)b * LDM + c0) + 1.0f), gs1 = *(const f32x4*)(gnext + c0 + 4) * (*(const f32x4*)(scnext + (size_t)b * LDM + c0 + 4) + 1.0f);
#pragma unroll
            for (int ai = 0; ai < 2; ++ai)
#pragma unroll
                for (int m = 0; m < 4; ++m) { const unsigned so = (unsigned)(((ai * 128 + m * 16) * D + bj * 128) * 2); const int g = m & 3;
                    f32x4 x0, x1;
                    if (IN16) unpack8(*(const v4u*)((const char*)xin + (size_t)(vo[g] + so)), x0, x1);
                    else { const char* p = (const char*)xin + 2 * (size_t)(vo[g] + so); x0 = *(const f32x4*)p; x1 = *(const f32x4*)(p + 16); }
                    const f32x4 o0 = x0 + gt0 * acc[ai][bj][m][0], o1 = x1 + gt1 * acc[ai][bj][m][1];
                    *(v4u*)((char*)xout + (size_t)(vo[g] + so)) = pack8(o0, o1);
                    acc[ai][bj][m][0] = o0; acc[ai][bj][m][1] = o1;
                    ss[ai][m] += (o0[0] * o0[0] + o0[1] * o0[1]) + (o0[2] * o0[2] + o0[3] * o0[3]) + (o1[0] * o1[0] + o1[1] * o1[1]) + (o1[2] * o1[2] + o1[3] * o1[3]);
                    const f32x4 t0 = __builtin_elementwise_abs(o0 * gs0), t1 = __builtin_elementwise_abs(o1 * gs1);
                    am[ai][m] = fmaxf(am[ai][m], fmaxf(fmaxf(fmaxf(t0[0], t0[1]), fmaxf(t0[2], t0[3])), fmaxf(fmaxf(t1[0], t1[1]), fmaxf(t1[2], t1[3]))));
                    asm volatile("" : "+v"(vo[g]) : "v"(ss[ai][m])); } }
#pragma unroll
        for (int ai = 0; ai < 2; ++ai)
#pragma unroll
            for (int m = 0; m < 4; ++m) { float s = ss[ai][m], a = am[ai][m]; s += __shfl_xor(s, 16); s += __shfl_xor(s, 32); a = fmaxf(a, __shfl_xor(a, 16)); a = fmaxf(a, __shfl_xor(a, 32));
                if (fq == 0) __hip_atomic_store((gu64*)(sspx + (size_t)(row0 + ai * 128 + m * 16) * 16 + u.pn * 4 + wc), ((unsigned long long)__float_as_uint(a) << 32) | __float_as_uint(s), RLX_AGENT); }
        asm volatile("s_waitcnt vmcnt(0)" ::: "memory");
        unsigned* cw = cnt + 64 * u.pm;
        if ((threadIdx.x & 63) == 0) __hip_atomic_fetch_add(cw, 1u, __ATOMIC_RELAXED, __HIP_MEMORY_SCOPE_AGENT);
        if (threadIdx.x < 64) {
            unsigned sp = 0;
            while ((unsigned)__builtin_amdgcn_readfirstlane(__hip_atomic_load(cw, __ATOMIC_RELAXED, __HIP_MEMORY_SCOPE_AGENT)) < 32u) { __builtin_amdgcn_s_sleep(1); if (++sp > (1u << 20)) break; }
            __builtin_amdgcn_fence(__ATOMIC_ACQUIRE, "agent");
            asm volatile("s_waitcnt vmcnt(0)" ::: "memory");
        }
        asm volatile("" ::: "memory"); __builtin_amdgcn_s_barrier(); asm volatile("" ::: "memory");
        float qs[2][4];
#pragma unroll
        for (int ai = 0; ai < 2; ++ai)
#pragma unroll
            for (int m = 0; m < 4; ++m) { const int row = row0 + ai * 128 + m * 16; const gu64* p = (const gu64*)(sspx + (size_t)row * 16 + 4 * fq);
                float s = 0.f, a = 0.f;
#pragma unroll
                for (int e = 0; e < 4; ++e) { const unsigned long long t = __hip_atomic_load(p + e, RLX_AGENT); s += __uint_as_float((unsigned)t); a = fmaxf(a, __uint_as_float((unsigned)(t >> 32))); }
                s += __shfl_xor(s, 16); s += __shfl_xor(s, 32); a = fmaxf(a, __shfl_xor(a, 16)); a = fmaxf(a, __shfl_xor(a, 32));
                qs[ai][m] = a > 0.f ? 127.0f / a : 0.f;
                if (u.pn == 0 && wc == 0 && fq == 0) rs[row] = rsqrtf(s * (1.0f / D) + EPS) * a * (1.0f / 127.0f); }
        const unsigned voff8 = (unsigned)(row0 * D + u.pn * 256 + wc * 32 + 8 * fq);
#pragma unroll
        for (int bj = 0; bj < 2; ++bj) { const int c0 = u.pn * 256 + bj * 128 + wc * 32 + 8 * fq;
            const f32x4 gs0 = *(const f32x4*)(gnext + c0) * (*(const f32x4*)(scnext + (size_t)b * LDM + c0) + 1.0f), gs1 = *(const f32x4*)(gnext + c0 + 4) * (*(const f32x4*)(scnext + (size_t)b * LDM + c0 + 4) + 1.0f);
#pragma unroll
            for (int ai = 0; ai < 2; ++ai)
#pragma unroll
                for (int m = 0; m < 4; ++m) { const float q = qs[ai][m]; const unsigned so = (unsigned)((ai * 128 + m * 16) * D + bj * 128);
                    *(unsigned long long*)(a8 + (size_t)(voff8 + so)) = (unsigned long long)q8x4(acc[ai][bj][m][0] * gs0 * q) | ((unsigned long long)q8x4(acc[ai][bj][m][1] * gs1 * q) << 32); } }
    }
};
struct EpiResidFinal {
    static constexpr bool PERM = true, AFTER_DRAIN = false; static constexpr int REPS = 1;
    const pg8::bf16_t* xin; float* out; float* ssp; const float* gt; const float* gf; const float* fsc; const float* fsh; unsigned* cnt;
    __device__ __forceinline__ void operator()(f32x4 (&acc)[2][2][4][2], const pg8::Unit& u, int wr, int wc, int fr, int fq) const {
        const int row0 = u.pm * 256 + wr * 64 + fr, b = u.pm >> 4;
        const __amdgpu_buffer_rsrc_t rx = __builtin_amdgcn_make_buffer_rsrc((void*)xin, 0, M * D * 4, 0x00020000), ro = __builtin_amdgcn_make_buffer_rsrc((void*)out, 0, M * D * 4, 0x00020000);
        const unsigned voff = (unsigned)((row0 * D + u.pn * 256 + wc * 32 + 8 * fq) * 4);
        float ss[2][4];
#pragma unroll
        for (int ai = 0; ai < 2; ++ai)
#pragma unroll
            for (int m = 0; m < 4; ++m) ss[ai][m] = 0.f;
        unsigned vo[4] = {voff, voff, voff, voff};
#pragma unroll
        for (int bj = 0; bj < 2; ++bj) { const int c0 = u.pn * 256 + bj * 128 + wc * 32 + 8 * fq;
            const f32x4 gt0 = *(const f32x4*)(gt + (size_t)b * LDM + c0) * 0.5f, gt1 = *(const f32x4*)(gt + (size_t)b * LDM + c0 + 4) * 0.5f;
#pragma unroll
            for (int ai = 0; ai < 2; ++ai)
#pragma unroll
                for (int m = 0; m < 4; ++m) { const unsigned so = (unsigned)(((ai * 128 + m * 16) * D + bj * 128) * 4); const int g = m & 3;
                    f32x4 x0, x1; unpack8(*(const v4u*)((const char*)xin + (size_t)((vo[g] + so) >> 1)), x0, x1);
                    const f32x4 o0 = x0 + gt0 * acc[ai][bj][m][0], o1 = x1 + gt1 * acc[ai][bj][m][1];
                    acc[ai][bj][m][0] = o0; acc[ai][bj][m][1] = o1;
                    ss[ai][m] += (o0[0] * o0[0] + o0[1] * o0[1]) + (o0[2] * o0[2] + o0[3] * o0[3]) + (o1[0] * o1[0] + o1[1] * o1[1]) + (o1[2] * o1[2] + o1[3] * o1[3]);
                    asm volatile("" : "+v"(vo[g]) : "v"(ss[ai][m])); } }
#pragma unroll
        for (int ai = 0; ai < 2; ++ai)
#pragma unroll
            for (int m = 0; m < 4; ++m) { float s = ss[ai][m]; s += __shfl_xor(s, 16); s += __shfl_xor(s, 32);
                if (fq == 0) __hip_atomic_store((gu32*)(ssp + (size_t)(row0 + ai * 128 + m * 16) * 16 + u.pn * 4 + wc), __float_as_uint(s), RLX_AGENT); }
        asm volatile("s_waitcnt vmcnt(0)" ::: "memory");
        unsigned* cw = cnt + 64 * u.pm;
        if ((threadIdx.x & 63) == 0) __hip_atomic_fetch_add(cw, 1u, __ATOMIC_RELAXED, __HIP_MEMORY_SCOPE_AGENT);
        if (threadIdx.x < 64) {
            unsigned sp = 0;
            while ((unsigned)__builtin_amdgcn_readfirstlane(__hip_atomic_load(cw, __ATOMIC_RELAXED, __HIP_MEMORY_SCOPE_AGENT)) < 32u) { __builtin_amdgcn_s_sleep(1); if (++sp > (1u << 20)) break; }
            __builtin_amdgcn_fence(__ATOMIC_ACQUIRE, "agent");
            asm volatile("s_waitcnt vmcnt(0)" ::: "memory");
        }
        asm volatile("" ::: "memory"); __builtin_amdgcn_s_barrier(); asm volatile("" ::: "memory");
        float rs[2][4]; load_rstd_sc1(ssp, row0, fq, rs);
#pragma unroll
        for (int bj = 0; bj < 2; ++bj) { const int c0 = u.pn * 256 + bj * 128 + wc * 32 + 8 * fq;
            const f32x4 gs0 = *(const f32x4*)(gf + c0) * (*(const f32x4*)(fsc + (size_t)b * LDM + c0) + 1.0f), gs1 = *(const f32x4*)(gf + c0 + 4) * (*(const f32x4*)(fsc + (size_t)b * LDM + c0 + 4) + 1.0f);
            const f32x4 sh0 = *(const f32x4*)(fsh + (size_t)b * LDM + c0), sh1 = *(const f32x4*)(fsh + (size_t)b * LDM + c0 + 4);
#pragma unroll
            for (int ai = 0; ai < 2; ++ai)
#pragma unroll
                for (int m = 0; m < 4; ++m) { const unsigned so = (unsigned)(((ai * 128 + m * 16) * D + bj * 128) * 4); const float r = rs[ai][m];
                    *(f32x4*)((char*)out + (size_t)voff + so) = acc[ai][bj][m][0] * r * gs0 + sh0;
                    *(f32x4*)((char*)out + (size_t)voff + so + 16) = acc[ai][bj][m][1] * r * gs1 + sh1; } }
    }
};
struct EpiMixIn {
    static constexpr bool PERM = true, AFTER_DRAIN = false; static constexpr int REPS = 1;
    pg8::bf16_t *U, *UX, *GY; const float* ssp; const float* bias;
    __device__ __forceinline__ void operator()(const f32x4 (&acc)[2][2][4][2], const pg8::Unit& u, int wr, int wc, int fr, int fq) const {
        const int row0 = u.pm * 256 + wr * 64 + fr, b = u.pm >> 4;
        float rs[2][4]; load_rstd(ssp, row0, fq, rs);
        const float* bp = bias + (size_t)b * NMIX + u.pn * 256 + wc * 32 + 8 * fq;
        const f32x4 b00 = *(const f32x4*)(bp), b01 = *(const f32x4*)(bp + 4), b10 = *(const f32x4*)(bp + 128), b11 = *(const f32x4*)(bp + 132);
        if (u.pn < 4) {
            const int oc = u.pn * 128 + wc * 32 + 8 * fq;
#pragma unroll
            for (int ai = 0; ai < 2; ++ai)
#pragma unroll
                for (int m = 0; m < 4; ++m) { const float r = rs[ai][m];
                    const f32x4 v0 = acc[ai][0][m][0] * r + b00, v1 = acc[ai][0][m][1] * r + b01, g0 = acc[ai][1][m][0] * r + b10, g1 = acc[ai][1][m][1] * r + b11;
                    const f32x4 a0 = v0 * sigmoid4(g0), a1 = v1 * sigmoid4(g1);
                    *(v4u*)(U + (size_t)(row0 + ai * 128 + m * 16) * DC + oc) = pack8(a0, a1); }
        } else {
            pg8::bf16_t* dst = (u.pn < 6) ? UX : GY; const bool gel = u.pn >= 6; const int pc = (u.pn & 1) * 256 + wc * 32 + 8 * fq;
#pragma unroll
            for (int ai = 0; ai < 2; ++ai)
#pragma unroll
                for (int m = 0; m < 4; ++m) { const float r = rs[ai][m];
#pragma unroll
                    for (int bj = 0; bj < 2; ++bj) { f32x4 v0 = acc[ai][bj][m][0] * r + (bj ? b10 : b00), v1 = acc[ai][bj][m][1] * r + (bj ? b11 : b01);
                        if (gel) { v0 = gelu_tanh4(v0); v1 = gelu_tanh4(v1); }
                        *(v4u*)(dst + (size_t)(row0 + ai * 128 + m * 16) * DR + pc + bj * 128) = pack8(v0, v1); } }
        }
    }
};

struct EpiMixIn8 {
    static constexpr bool PERM = true, AFTER_DRAIN = false; static constexpr int REPS = 1;
    pg8::bf16_t *U, *UX, *GY; const float* rs; const float* cs; const float* bias;
    __device__ __forceinline__ void operator()(const f32x4 (&acc)[2][2][4][2], const pg8::Unit& u, int wr, int wc, int fr, int fq) const {
        const int row0 = u.pm * 256 + wr * 64 + fr, b = u.pm >> 4;
        float rv[2][4];
#pragma unroll
        for (int ai = 0; ai < 2; ++ai)
#pragma unroll
            for (int m = 0; m < 4; ++m) rv[ai][m] = rs[row0 + ai * 128 + m * 16];
        const int cb = u.pn * 256 + wc * 32 + 8 * fq;
        const float* bp = bias + (size_t)b * NMIX + cb; const float* cp = cs + cb;
        const f32x4 b00 = *(const f32x4*)(bp), b01 = *(const f32x4*)(bp + 4), b10 = *(const f32x4*)(bp + 128), b11 = *(const f32x4*)(bp + 132);
        const f32x4 c00 = *(const f32x4*)(cp), c01 = *(const f32x4*)(cp + 4), c10 = *(const f32x4*)(cp + 128), c11 = *(const f32x4*)(cp + 132);
        if (u.pn < 4) {
            const int oc = u.pn * 128 + wc * 32 + 8 * fq;
#pragma unroll
            for (int ai = 0; ai < 2; ++ai)
#pragma unroll
                for (int m = 0; m < 4; ++m) { const float r = rv[ai][m];
                    const f32x4 v0 = acc_i2f(acc[ai][0][m][0]) * (c00 * r) + b00, v1 = acc_i2f(acc[ai][0][m][1]) * (c01 * r) + b01;
                    const f32x4 g0 = acc_i2f(acc[ai][1][m][0]) * (c10 * r) + b10, g1 = acc_i2f(acc[ai][1][m][1]) * (c11 * r) + b11;
                    const f32x4 a0 = v0 * sigmoid4(g0), a1 = v1 * sigmoid4(g1);
                    *(v4u*)(U + (size_t)(row0 + ai * 128 + m * 16) * DC + oc) = pack8(a0, a1); }
        } else {
            pg8::bf16_t* dst = (u.pn < 6) ? UX : GY; const bool gel = u.pn >= 6; const int pc = (u.pn & 1) * 256 + wc * 32 + 8 * fq;
#pragma unroll
            for (int ai = 0; ai < 2; ++ai)
#pragma unroll
                for (int m = 0; m < 4; ++m) { const float r = rv[ai][m];
#pragma unroll
                    for (int bj = 0; bj < 2; ++bj) { f32x4 v0 = acc_i2f(acc[ai][bj][m][0]) * ((bj ? c10 : c00) * r) + (bj ? b10 : b00), v1 = acc_i2f(acc[ai][bj][m][1]) * ((bj ? c11 : c01) * r) + (bj ? b11 : b01);
                        if (gel) { v0 = gelu_tanh4(v0); v1 = gelu_tanh4(v1); }
                        *(v4u*)(dst + (size_t)(row0 + ai * 128 + m * 16) * DR + pc + bj * 128) = pack8(v0, v1); } }
        }
    }
};

__device__ __forceinline__ void p0_gemv(LAS unsigned char* lds, const float* c, const float* W, int NC, const float* bias, float* out, int j0, int tid) {
    LAS float* ca = (LAS float*)lds; LAS float* part = (LAS float*)(lds + 32768);
    for (int i = tid; i < NB * D; i += 512) { const float v = c[i]; ca[i] = v / (1.f + expf(-v)); }
    __syncthreads();
    const int cg = tid & 31, ks = tid >> 5;
    const float* wp = W + (size_t)(64 * ks) * NC + j0 + 4 * cg;
    f32x4 acc[NB];
#pragma unroll
    for (int b = 0; b < NB; ++b) acc[b] = (f32x4){0.f, 0.f, 0.f, 0.f};
#pragma unroll 4
    for (int kk = 0; kk < 64; ++kk) { const f32x4 w = *(const f32x4*)(wp + (size_t)kk * NC);
#pragma unroll
        for (int b = 0; b < NB; ++b) acc[b] += w * ca[b * D + 64 * ks + kk]; }
#pragma unroll
    for (int b = 0; b < NB; ++b) *(LAS f32x4*)(part + (ks * NB + b) * 128 + 4 * cg) = acc[b];
    __syncthreads();
#pragma unroll
    for (int r = 0; r < 2; ++r) { const int o = tid + 512 * r, b = o >> 7, col = o & 127; float s = 0.f;
#pragma unroll
        for (int k2 = 0; k2 < 16; ++k2) s += part[(k2 * NB + b) * 128 + col];
        out[(size_t)b * LDM + j0 + col] = s + bias[j0 + col]; }
    __syncthreads();
}
__device__ __forceinline__ int rowmap(int kind, int n0) {
    if (kind == 1) { const int half = n0 / FF, f = n0 - half * FF; return 256 * (f >> 7) + 128 * half + (f & 127); }
    if (kind == 2 && n0 < 1024) { const int half = n0 >> 9, f = n0 & 511; return 256 * (f >> 7) + 128 * half + (f & 127); }
    return n0;
}
__device__ __forceinline__ void p0_transpose_item(const float* W, int K, int N, bf16* WT, int kind, LAS float* scr, int item, int lane) {
    const int nblk = N / 32, kb = item / nblk, nb = item % nblk, k0 = 64 * kb, n0 = 32 * nb, r0 = rowmap(kind, n0);
#pragma unroll 8
    for (int i = 0; i < 32; ++i) { const int kk = 2 * i + (lane >> 5); scr[kk * 33 + (lane & 31)] = W[(size_t)(k0 + kk) * N + n0 + (lane & 31)]; }
    LDS_WAIT(); asm volatile("" ::: "memory");
    const int c = lane & 7;
#pragma unroll
    for (int j = 0; j < 4; ++j) { const int n = (lane >> 3) + 8 * j; const LAS float* s = scr + (8 * c) * 33 + n;
        v4u o; o.x = pk2(s[0 * 33], s[1 * 33]); o.y = pk2(s[2 * 33], s[3 * 33]); o.z = pk2(s[4 * 33], s[5 * 33]); o.w = pk2(s[6 * 33], s[7 * 33]);
        *(GAS v4u*)(WT + (size_t)(r0 + n) * K + k0 + 8 * c) = o; }
    LDS_WAIT(); asm volatile("" ::: "memory");
}

__device__ __forceinline__ void p0_quant_item(LAS unsigned char* lds, const float* W, int N, int kind, unsigned char* W8, float* cs, int nb, int lane, int wave) {
    LAS float* scr = (LAS float*)(lds + wave * 16896);
    LAS float* cm = (LAS float*)(lds + 8 * 16896);
    const int n0 = 32 * nb, r0 = rowmap(kind, n0);
#pragma unroll
    for (int tl = 0; tl < 2; ++tl) { const int k0 = 64 * (2 * wave + tl);
#pragma unroll 8
        for (int i = 0; i < 32; ++i) { const int kk = 2 * i + (lane >> 5); scr[tl * 2112 + kk * 33 + (lane & 31)] = W[(size_t)(k0 + kk) * N + n0 + (lane & 31)]; } }
    LDS_WAIT(); asm volatile("" ::: "memory");
    float mx = 0.f;
#pragma unroll
    for (int tl = 0; tl < 2; ++tl)
#pragma unroll 8
        for (int r = 0; r < 32; ++r) mx = fmaxf(mx, fabsf(scr[tl * 2112 + ((lane >> 5) * 32 + r) * 33 + (lane & 31)]));
    mx = fmaxf(mx, __shfl_xor(mx, 32));
    if (lane < 32) cm[wave * 32 + lane] = mx;
    __syncthreads();
    float cmax = 0.f;
#pragma unroll
    for (int w = 0; w < 8; ++w) cmax = fmaxf(cmax, cm[w * 32 + (lane & 31)]);
    const float sc = cmax > 0.f ? 127.0f / cmax : 0.f;
    if (wave == 0 && lane < 32) cs[r0 + lane] = cmax * (1.0f / 127.0f);
    const int n = lane >> 1, kh = (lane & 1) * 32;
    const float sn = __shfl(sc, n);
#pragma unroll
    for (int tl = 0; tl < 2; ++tl) { const int k0 = 64 * (2 * wave + tl); const LAS float* sp = scr + tl * 2112 + n;
#pragma unroll
        for (int hq = 0; hq < 2; ++hq) { v4u o;
#pragma unroll
            for (int dq = 0; dq < 4; ++dq) { const int k = kh + 16 * hq + 4 * dq;
                const unsigned w4 = q8(sp[(k + 0) * 33] * sn) | (q8(sp[(k + 1) * 33] * sn) << 8) | (q8(sp[(k + 2) * 33] * sn) << 16) | (q8(sp[(k + 3) * 33] * sn) << 24);
                if (dq == 0) o.x = w4; else if (dq == 1) o.y = w4; else if (dq == 2) o.z = w4; else o.w = w4; }
            *(GAS v4u*)(W8 + (size_t)(r0 + n) * D + k0 + kh + 16 * hq) = o; } }
    __syncthreads();
}

__device__ __forceinline__ void mix_conv(LAS unsigned char* lds, const bf16* U, const float* conv_w, const float* conv_b, const float* ln_g, const float* ln_b, bf16* YMIX, int G, int bx, int tid, int lane, int wave) {
    LAS unsigned char* IN = lds;
    LAS f32x4* WA = (LAS f32x4*)(lds + 63488);
    LAS f32x4* WB = WA + 31 * 64;
    for (int i = tid; i < 31 * 64; i += 512) { const int k = i >> 6, l = i & 63; WA[i] = *(const f32x4*)(conv_w + k * DC + 8 * l); WB[i] = *(const f32x4*)(conv_w + k * DC + 8 * l + 4); }
    const f32x4 cb0 = *(const f32x4*)(conv_b + 8 * lane), cb1 = *(const f32x4*)(conv_b + 8 * lane + 4);
    const f32x4 lg0 = *(const f32x4*)(ln_g + 8 * lane), lg1 = *(const f32x4*)(ln_g + 8 * lane + 4);
    const f32x4 lb0 = *(const f32x4*)(ln_b + 8 * lane), lb1 = *(const f32x4*)(ln_b + 8 * lane + 4);
    v4u pre[8];
#pragma unroll
    for (int i = 0; i < 8; ++i) { const int q = tid + 512 * i, row = q >> 6, ch = q & 63, tok = (bx & 127) * 32 - 30 + row; pre[i] = (v4u){0u, 0u, 0u, 0u};
        if (bx < NB * (SEQ / 32) && q < 62 * 64 && tok >= 0) pre[i] = *(const v4u*)(U + ((size_t)((bx >> 7) * SEQ + tok)) * DC + 8 * ch); }
    for (int item = bx; item < NB * (SEQ / 32); item += G) {
        const int b = item >> 7, t0 = (item & 127) * 32;
        __syncthreads();
#pragma unroll
        for (int i = 0; i < 8; ++i) { const int q = tid + 512 * i; if (q < 62 * 64) *(LAS v4u*)(IN + (q >> 6) * 1024 + (q & 63) * 16) = pre[i]; }
        { const int nitem = item + G, nb = nitem >> 7, nt0 = (nitem & 127) * 32;
#pragma unroll
            for (int i = 0; i < 8; ++i) { const int q = tid + 512 * i, row = q >> 6, ch = q & 63, tok = nt0 - 30 + row; pre[i] = (v4u){0u, 0u, 0u, 0u};
                if (nitem < NB * (SEQ / 32) && q < 62 * 64 && tok >= 0) pre[i] = *(const v4u*)(U + ((size_t)(nb * SEQ + tok)) * DC + 8 * ch); } }
        __syncthreads();
        f32x4 a0[4], a1[4];
#pragma unroll
        for (int tt = 0; tt < 4; ++tt) { a0[tt] = cb0; a1[tt] = cb1; }
        f32x4 wa0 = {0.f, 0.f, 0.f, 0.f}, wa1 = wa0, wa2 = wa0, wa3 = wa0, wb0 = wa0, wb1 = wa0, wb2 = wa0, wb3 = wa0;
#pragma unroll
        for (int kk = 0; kk < 34; ++kk) {
            const v4u v = *(const LAS v4u*)(IN + (4 * wave + kk) * 1024 + lane * 16);
            const f32x4 x0 = {bflo(v.x), bfhi(v.x), bflo(v.y), bfhi(v.y)}, x1 = {bflo(v.z), bfhi(v.z), bflo(v.w), bfhi(v.w)};
            wa3 = wa2; wa2 = wa1; wa1 = wa0; wb3 = wb2; wb2 = wb1; wb1 = wb0;
            if (kk <= 30) { wa0 = WA[kk * 64 + lane]; wb0 = WB[kk * 64 + lane]; } else { wa0 = (f32x4){0.f, 0.f, 0.f, 0.f}; wb0 = wa0; }
            a0[0] += wa0 * x0; a1[0] += wb0 * x1; a0[1] += wa1 * x0; a1[1] += wb1 * x1; a0[2] += wa2 * x0; a1[2] += wb2 * x1; a0[3] += wa3 * x0; a1[3] += wb3 * x1;
        }
#pragma unroll
        for (int tt = 0; tt < 4; ++tt) {
            float s = (a0[tt][0] + a0[tt][1]) + (a0[tt][2] + a0[tt][3]) + (a1[tt][0] + a1[tt][1]) + (a1[tt][2] + a1[tt][3]);
            const float mean = wave_sum(s) * (1.0f / DC);
            const f32x4 d0 = a0[tt] - mean, d1 = a1[tt] - mean;
            float q = (d0[0] * d0[0] + d0[1] * d0[1]) + (d0[2] * d0[2] + d0[3] * d0[3]) + (d1[0] * d1[0] + d1[1] * d1[1]) + (d1[2] * d1[2] + d1[3] * d1[3]);
            const float rstd = rsqrtf(wave_sum(q) * (1.0f / DC) + EPS);
            f32x4 y0 = d0 * rstd * lg0 + lb0, y1 = d1 * rstd * lg1 + lb1;
#pragma unroll
            for (int j = 0; j < 4; ++j) { y0[j] = silu_fast(y0[j]); y1[j] = silu_fast(y1[j]); }
            *(v4u*)(YMIX + ((size_t)(b * SEQ + t0 + 4 * wave + tt)) * D + 8 * lane) = pack8(y0, y1);
        }
    }
    __syncthreads();
}

__device__ __forceinline__ void scan_decode(int it, int& b, int& c) { if (it < 256) { b = it >> 6; c = it & 63; } else { b = 4 + ((it - 256) >> 6); c = 63 - ((it - 256) & 63); } }
__device__ __forceinline__ float neg_expm1(float x, float a) {
    float p = -1.0f / 5040.0f; p = p * x - 1.0f / 720.0f; p = p * x - 1.0f / 120.0f; p = p * x - 1.0f / 24.0f; p = p * x - 1.0f / 6.0f; p = p * x - 0.5f; p = p * x - 1.0f;
    float q = p * x, w = 1.0f - a * a; asm volatile("" : "+v"(q), "+v"(w));
    return x > -0.5f ? q : w;
}
__device__ __forceinline__ void gate_math16(const f32x16 pa, const f32x16 pi, float ba, float bi, float c8, f32x16& av, f32x16& bv) {
#pragma unroll
    for (int g4 = 0; g4 < 4; ++g4) {
        const f32x4 pa4 = {pa[4 * g4], pa[4 * g4 + 1], pa[4 * g4 + 2], pa[4 * g4 + 3]}, pi4 = {pi[4 * g4], pi[4 * g4 + 1], pi[4 * g4 + 2], pi[4 * g4 + 3]};
        const f32x4 rg = sigmoid4(pa4 + ba), ig = sigmoid4(pi4 + bi);
        const f32x4 l2 = rg * c8;
        const f32x4 a = {__builtin_amdgcn_exp2f(l2[0]), __builtin_amdgcn_exp2f(l2[1]), __builtin_amdgcn_exp2f(l2[2]), __builtin_amdgcn_exp2f(l2[3])};
        const f32x4 x = l2 * 1.3862943611198906f;
        f32x4 p = x * (-1.0f / 5040.0f) - 1.0f / 720.0f; p = p * x - 1.0f / 120.0f; p = p * x - 1.0f / 24.0f; p = p * x - 1.0f / 6.0f; p = p * x - 0.5f; p = p * x - 1.0f;
        const f32x4 q = p * x, w = 1.0f - a * a;
        f32x4 m2;
#pragma unroll
        for (int e = 0; e < 4; ++e) m2[e] = __builtin_amdgcn_sqrtf(x[e] > -0.5f ? q[e] : w[e]);
        const f32x4 bb = m2 * ig;
#pragma unroll
        for (int e = 0; e < 4; ++e) { av[4 * g4 + e] = a[e]; bv[4 * g4 + e] = bb[e]; }
        __builtin_amdgcn_sched_barrier(0);
    }
}
template <bool FINAL>
__device__ __forceinline__ void mix_scan(LAS unsigned char* lds, const bf16* UX, const bf16* GY, const bf16* WGT, const float* rw, const float* rb, const float* b_a, const float* b_i, const float* lam,
                                         f32x2* TOT, bf16* YMIX, int G, int bx, int lane, int wave) {
    LAS unsigned char* UXT = lds + wave * 16896;
    LAS unsigned char* XRT = UXT + 8704;
    const int h = wave, j = lane & 31, hh = lane >> 5, dg = lane & 7, tg = lane >> 3;
    float c8v[2], bav[2], biv[2];
#pragma unroll
    for (int ec = 0; ec < 2; ++ec) { const int ch = 64 * h + 32 * ec + j; c8v[ec] = -8.0f * 1.4426950408889634f * log1pf(expf(-lam[ch]));   bav[ec] = b_a[ch]; biv[ec] = b_i[ch]; }
    for (int it = bx; it < 512; it += G) {
        asm volatile("" ::: "memory");
        int b, c; scan_decode(it, b, c);
        const size_t mrow0 = (size_t)b * SEQ + 64 * c;
#pragma unroll
        for (int i = 0; i < 9; ++i) { const int row = i * 8 + tg, tok = 64 * c - 3 + row; v4u v = {0u, 0u, 0u, 0u};
            if (row < 67 && tok >= 0) v = *(const v4u*)(UX + ((size_t)b * SEQ + tok) * DR + 64 * h + 8 * dg);
            if (row < 68) *(LAS v4u*)(UXT + row * 128 + dg * 16) = v; }
        pg8::bf16x8 bfr[2][4];
#pragma unroll
        for (int g = 0; g < 2; ++g)
#pragma unroll
            for (int ks = 0; ks < 4; ++ks) bfr[g][ks] = *(const pg8::bf16x8*)(WGT + ((size_t)(h * 128 + 64 * g + j)) * 64 + 16 * ks + 8 * hh);
        v4u gyv[8];
        if (FINAL) {
#pragma unroll
            for (int i = 0; i < 8; ++i) gyv[i] = *(const v4u*)(GY + (mrow0 + i * 8 + tg) * DR + 64 * h + 8 * dg);
        }
        float Hc = 0.f;
        if (FINAL) { const f32x2* tp = TOT + ((size_t)b * 64) * DR + 64 * h + lane; int cc = 0;
            for (; cc + 8 <= c; cc += 8) { f32x2 t8[8];
#pragma unroll
                for (int u = 0; u < 8; ++u) t8[u] = tp[(size_t)(cc + u) * DR];
#pragma unroll
                for (int u = 0; u < 8; ++u) Hc = Hc * t8[u].x + t8[u].y; }
            for (; cc < c; ++cc) { const f32x2 ab = tp[(size_t)cc * DR]; Hc = Hc * ab.x + ab.y; } }
        {
            f32x4 w4a[4], w4b[4];
#pragma unroll
            for (int k = 0; k < 4; ++k) { w4a[k] = *(const f32x4*)(rw + k * DR + 64 * h + 8 * dg); w4b[k] = *(const f32x4*)(rw + k * DR + 64 * h + 8 * dg + 4); }
            const f32x4 rb0 = *(const f32x4*)(rb + 64 * h + 8 * dg), rb1 = *(const f32x4*)(rb + 64 * h + 8 * dg + 4);
#pragma unroll
            for (int th = 0; th < 2; ++th) {
                f32x4 o0[4], o1[4];
#pragma unroll
                for (int t = 0; t < 4; ++t) { o0[t] = rb0; o1[t] = rb1; }
#pragma unroll
                for (int i = 0; i < 7; ++i) { const v4u v = *(const LAS v4u*)(UXT + (8 * tg + 4 * th + i) * 128 + dg * 16);
                    const f32x4 x0 = {bflo(v.x), bfhi(v.x), bflo(v.y), bfhi(v.y)}, x1 = {bflo(v.z), bfhi(v.z), bflo(v.w), bfhi(v.w)};
#pragma unroll
                    for (int k = 0; k < 4; ++k) { const int t = i - k; if (t >= 0 && t < 4) { o0[t] += w4a[k] * x0; o1[t] += w4b[k] * x1; } } }
#pragma unroll
                for (int t = 0; t < 4; ++t) *(LAS v4u*)(XRT + (8 * tg + 4 * th + t) * 128 + dg * 16) = pack8(o0[t], o1[t]);
            }
        }
        if (FINAL) {
#pragma unroll
            for (int i = 0; i < 8; ++i) *(LAS v4u*)(UXT + (i * 8 + tg) * 128 + dg * 16) = gyv[i];
        }
#pragma unroll
        for (int ec = 0; ec < 2; ++ec) {
            const int ch = 64 * h + 32 * ec + j;
            const float c8 = c8v[ec], ba = bav[ec], bi = biv[ec];
            f32x16 av[2], bv[2];
#pragma unroll
            for (int tt = 0; tt < 2; ++tt) {
                pg8::bf16x8 afr[4];
#pragma unroll
                for (int ks = 0; ks < 4; ++ks) afr[ks] = *(const LAS pg8::bf16x8*)(XRT + (32 * tt + j) * 128 + (16 * ks + 8 * hh) * 2);
                f32x16 pa, pi;
#pragma unroll
                for (int r = 0; r < 16; ++r) { pa[r] = 0.f; pi[r] = 0.f; }
#pragma unroll
                for (int ks = 0; ks < 4; ++ks) {
                    pa = __builtin_amdgcn_mfma_f32_32x32x16_bf16(afr[ks], bfr[0][ks], pa, 0, 0, 0);
                    pi = __builtin_amdgcn_mfma_f32_32x32x16_bf16(afr[ks], bfr[1][ks], pi, 0, 0, 0); }
                if (ec == 0 && tt == 1) {
#pragma unroll
                    for (int g = 0; g < 2; ++g)
#pragma unroll
                        for (int ks = 0; ks < 4; ++ks) bfr[g][ks] = *(const pg8::bf16x8*)(WGT + ((size_t)(h * 128 + 64 * g + 32 + j)) * 64 + 16 * ks + 8 * hh);
                }
                gate_math16(pa, pi, ba, bi, c8, av[tt], bv[tt]);
                {
                    f32x16 px;
#pragma unroll
                    for (int r = 0; r < 16; ++r) px[r] = bv[tt][r] * 0.f;
                    int dd = 32 * ec + j - 8 * hh; asm volatile("" : "+v"(dd));
                    const unsigned one = (dd & 1) ? 0x3F800000u : 0x00003F80u;
#pragma unroll
                    for (int ks = 0; ks < 4; ++ks) {
                        const int dw = (dd - 16 * ks) >> 1;
                        v4u idw; idw.x = dw == 0 ? one : 0u; idw.y = dw == 1 ? one : 0u; idw.z = dw == 2 ? one : 0u; idw.w = dw == 3 ? one : 0u;
                        px = __builtin_amdgcn_mfma_f32_32x32x16_bf16(afr[ks], __builtin_bit_cast(pg8::bf16x8, idw), px, 0, 0, 0); }
#pragma unroll
                    for (int r = 0; r < 16; ++r) bv[tt][r] *= px[r];
                }
            }
            float GA[2][4], GB[2][4], PA[2][4], PB[2][4];
#pragma unroll
            for (int tt = 0; tt < 2; ++tt)
#pragma unroll
                for (int q = 0; q < 4; ++q) { const float a0 = av[tt][4 * q], a1 = av[tt][4 * q + 1], a2 = av[tt][4 * q + 2], a3 = av[tt][4 * q + 3];
                    const float b0 = bv[tt][4 * q], b1 = bv[tt][4 * q + 1], b2 = bv[tt][4 * q + 2], b3 = bv[tt][4 * q + 3];
                    GA[tt][q] = (a0 * a1) * (a2 * a3); GB[tt][q] = ((b0 * a1 + b1) * a2 + b2) * a3 + b3;
                    PA[tt][q] = __shfl_xor(GA[tt][q], 32); PB[tt][q] = __shfl_xor(GB[tt][q], 32); }
            if (!FINAL) {
                float At = 1.f, Bt = 0.f;
#pragma unroll
                for (int tt = 0; tt < 2; ++tt)
#pragma unroll
                    for (int q = 0; q < 4; ++q) { const float A0 = hh ? PA[tt][q] : GA[tt][q], B0 = hh ? PB[tt][q] : GB[tt][q], A1 = hh ? GA[tt][q] : PA[tt][q], B1 = hh ? GB[tt][q] : PB[tt][q];
                        Bt = (Bt * A0 + B0) * A1 + B1; At = (At * A0) * A1; }
                if (hh == 0) TOT[((size_t)b * 64 + c) * DR + ch] = (f32x2){At, Bt};
            } else {
                float hc = __shfl(Hc, 32 * ec + j);
#pragma unroll
                for (int tt = 0; tt < 2; ++tt)
#pragma unroll
                    for (int q = 0; q < 4; ++q) { const float A0 = hh ? PA[tt][q] : GA[tt][q], B0 = hh ? PB[tt][q] : GB[tt][q], A1 = hh ? GA[tt][q] : PA[tt][q], B1 = hh ? GB[tt][q] : PB[tt][q];
                        const float mid = hc * A0 + B0; float hv = hh ? mid : hc; hc = mid * A1 + B1;
#pragma unroll
                        for (int i = 0; i < 4; ++i) { hv = av[tt][4 * q + i] * hv + bv[tt][4 * q + i]; av[tt][4 * q + i] = hv; } }
#pragma unroll
                for (int tt = 0; tt < 2; ++tt)
#pragma unroll
                    for (int r = 0; r < 16; ++r) { const int tk = 32 * tt + (r & 3) + 8 * (r >> 2) + 4 * hh;
                        LAS u16* p = (LAS u16*)(UXT + tk * 128 + (32 * ec + j) * 2);
                        const float gy = __uint_as_float((unsigned)(*p) << 16);
                        *p = (u16)f2bf(gy * av[tt][r]); }
            }
        }
        if (FINAL) {
#pragma unroll
            for (int i = 0; i < 8; ++i) { const int row = i * 8 + tg; *(v4u*)(YMIX + (mrow0 + row) * D + DC + 64 * h + 8 * dg) = *(const LAS v4u*)(UXT + row * 128 + dg * 16); }
        }
    }
    __syncthreads();
}

__device__ __forceinline__ void fold_chunks(const gu64* tp, int c0, int c1, int hh, float& A, float& B) {
    const int mid = (c0 + c1 + 1) >> 1, lo = hh ? mid : c0, hi2 = hh ? c1 : mid;
    float Ar = 1.f, Br = 0.f;
    for (int cc = lo; cc < hi2; cc += 4) { unsigned long long t8[4];
#pragma unroll
        for (int u = 0; u < 4; ++u) t8[u] = __hip_atomic_load(tp + (size_t)(cc + u < 63 ? cc + u : 63) * DR, RLX_AGENT);
#pragma unroll
        for (int u = 0; u < 4; ++u) { const bool ok = cc + u < hi2; const float ta = ok ? __uint_as_float((unsigned)t8[u]) : 1.f, tb = ok ? __uint_as_float((unsigned)(t8[u] >> 32)) : 0.f; Br = Br * ta + tb; Ar = Ar * ta; } }
    const float Ap = __shfl_xor(Ar, 32), Bp = __shfl_xor(Br, 32);
    A = Ar * Ap; B = hh ? (Bp * Ar + Br) : (Br * Ap + Bp);
}
__device__ __forceinline__ void mix_scan1(LAS unsigned char* lds, const bf16* UX, const bf16* GY, const bf16* WGT, const float* rw, const float* rb, const float* b_a, const float* b_i, const float* lam,
                                          f32x2* TOT, unsigned* cnt, bf16* YMIX, int G, int bx, int lane, int wave) {
    LAS unsigned char* UXT = lds + wave * 16896;
    LAS unsigned char* XRT = UXT + 8704;
    const int h = wave, j = lane & 31, hh = lane >> 5, dg = lane & 7, tg = lane >> 3;
    const int gs = G >> 3, b = bx / gs, idx = bx - b * gs;
    float c8v[2], bav[2], biv[2];
#pragma unroll
    for (int ec = 0; ec < 2; ++ec) { const int ch = 64 * h + 32 * ec + j; c8v[ec] = -8.0f * 1.4426950408889634f * log1pf(expf(-lam[ch])); bav[ec] = b_a[ch]; biv[ec] = b_i[ch]; }
    for (int c = idx, round = 0; c < 64; c += gs, ++round) {
        asm volatile("" ::: "memory");
        const size_t mrow0 = (size_t)b * SEQ + 64 * c;
#pragma unroll
        for (int i = 0; i < 9; ++i) { const int row = i * 8 + tg, tok = 64 * c - 3 + row; v4u v = {0u, 0u, 0u, 0u};
            if (row < 67 && tok >= 0) v = *(const v4u*)(UX + ((size_t)b * SEQ + tok) * DR + 64 * h + 8 * dg);
            if (row < 68) *(LAS v4u*)(UXT + row * 128 + dg * 16) = v; }
        pg8::bf16x8 bfr[2][4];
#pragma unroll
        for (int g = 0; g < 2; ++g)
#pragma unroll
            for (int ks = 0; ks < 4; ++ks) bfr[g][ks] = *(const pg8::bf16x8*)(WGT + ((size_t)(h * 128 + 64 * g + j)) * 64 + 16 * ks + 8 * hh);
        {
            f32x4 w4a[4], w4b[4];
#pragma unroll
            for (int k = 0; k < 4; ++k) { w4a[k] = *(const f32x4*)(rw + k * DR + 64 * h + 8 * dg); w4b[k] = *(const f32x4*)(rw + k * DR + 64 * h + 8 * dg + 4); }
            const f32x4 rb0 = *(const f32x4*)(rb + 64 * h + 8 * dg), rb1 = *(const f32x4*)(rb + 64 * h + 8 * dg + 4);
#pragma unroll
            for (int th = 0; th < 2; ++th) {
                f32x4 o0[4], o1[4];
#pragma unroll
                for (int t = 0; t < 4; ++t) { o0[t] = rb0; o1[t] = rb1; }
#pragma unroll
                for (int i = 0; i < 7; ++i) { const v4u v = *(const LAS v4u*)(UXT + (8 * tg + 4 * th + i) * 128 + dg * 16);
                    const f32x4 x0 = {bflo(v.x), bfhi(v.x), bflo(v.y), bfhi(v.y)}, x1 = {bflo(v.z), bfhi(v.z), bflo(v.w), bfhi(v.w)};
#pragma unroll
                    for (int k = 0; k < 4; ++k) { const int t = i - k; if (t >= 0 && t < 4) { o0[t] += w4a[k] * x0; o1[t] += w4b[k] * x1; } } }
#pragma unroll
                for (int t = 0; t < 4; ++t) *(LAS v4u*)(XRT + (8 * tg + 4 * th + t) * 128 + dg * 16) = pack8(o0[t], o1[t]);
            }
        }
#pragma unroll
        for (int ec = 0; ec < 2; ++ec) {
            const int ch = 64 * h + 32 * ec + j;
            const float c8 = c8v[ec], ba = bav[ec], bi = biv[ec];
            unsigned* cw = cnt + 64 * (8 * ec + b);
            f32x16 av[2], bv[2];
#pragma unroll
            for (int tt = 0; tt < 2; ++tt) {
                pg8::bf16x8 afr[4];
#pragma unroll
                for (int ks = 0; ks < 4; ++ks) afr[ks] = *(const LAS pg8::bf16x8*)(XRT + (32 * tt + j) * 128 + (16 * ks + 8 * hh) * 2);
                f32x16 pa, pi;
#pragma unroll
                for (int r = 0; r < 16; ++r) { pa[r] = 0.f; pi[r] = 0.f; }
#pragma unroll
                for (int ks = 0; ks < 4; ++ks) {
                    pa = __builtin_amdgcn_mfma_f32_32x32x16_bf16(afr[ks], bfr[0][ks], pa, 0, 0, 0);
                    pi = __builtin_amdgcn_mfma_f32_32x32x16_bf16(afr[ks], bfr[1][ks], pi, 0, 0, 0); }
                if (ec == 0 && tt == 1) {
#pragma unroll
                    for (int g = 0; g < 2; ++g)
#pragma unroll
                        for (int ks = 0; ks < 4; ++ks) bfr[g][ks] = *(const pg8::bf16x8*)(WGT + ((size_t)(h * 128 + 64 * g + 32 + j)) * 64 + 16 * ks + 8 * hh);
                }
                gate_math16(pa, pi, ba, bi, c8, av[tt], bv[tt]);
                {
                    f32x16 px;
#pragma unroll
                    for (int r = 0; r < 16; ++r) px[r] = bv[tt][r] * 0.f;
                    int dd = 32 * ec + j - 8 * hh; asm volatile("" : "+v"(dd));
                    const unsigned one = (dd & 1) ? 0x3F800000u : 0x00003F80u;
#pragma unroll
                    for (int ks = 0; ks < 4; ++ks) {
                        const int dw = (dd - 16 * ks) >> 1;
                        v4u idw; idw.x = dw == 0 ? one : 0u; idw.y = dw == 1 ? one : 0u; idw.z = dw == 2 ? one : 0u; idw.w = dw == 3 ? one : 0u;
                        px = __builtin_amdgcn_mfma_f32_32x32x16_bf16(afr[ks], __builtin_bit_cast(pg8::bf16x8, idw), px, 0, 0, 0); }
#pragma unroll
                    for (int r = 0; r < 16; ++r) bv[tt][r] *= px[r];
                }
            }
            float GA[2][4], GB[2][4], PA[2][4], PB[2][4];
            float At = 1.f, Bt = 0.f;
#pragma unroll
            for (int tt = 0; tt < 2; ++tt)
#pragma unroll
                for (int q = 0; q < 4; ++q) { const float a0 = av[tt][4 * q], a1 = av[tt][4 * q + 1], a2 = av[tt][4 * q + 2], a3 = av[tt][4 * q + 3];
                    const float b0 = bv[tt][4 * q], b1 = bv[tt][4 * q + 1], b2 = bv[tt][4 * q + 2], b3 = bv[tt][4 * q + 3];
                    GA[tt][q] = (a0 * a1) * (a2 * a3); GB[tt][q] = ((b0 * a1 + b1) * a2 + b2) * a3 + b3;
                    PA[tt][q] = __shfl_xor(GA[tt][q], 32); PB[tt][q] = __shfl_xor(GB[tt][q], 32);
                    const float A0 = hh ? PA[tt][q] : GA[tt][q], B0 = hh ? PB[tt][q] : GB[tt][q], A1 = hh ? GA[tt][q] : PA[tt][q], B1 = hh ? GB[tt][q] : PB[tt][q];
                    Bt = (Bt * A0 + B0) * A1 + B1; At = (At * A0) * A1; }
            if (hh == 0) __hip_atomic_store((gu64*)(TOT + ((size_t)b * 64 + c) * DR + ch), ((unsigned long long)__float_as_uint(Bt) << 32) | __float_as_uint(At), RLX_AGENT);
            asm volatile("s_waitcnt vmcnt(0)" ::: "memory");
            if (lane == 0) __hip_atomic_fetch_add(cw, 1u, __ATOMIC_RELAXED, __HIP_MEMORY_SCOPE_AGENT);
            if (ec == 0) {
#pragma unroll
                for (int i = 0; i < 8; ++i) *(LAS v4u*)(UXT + (i * 8 + tg) * 128 + dg * 16) = *(const v4u*)(GY + (mrow0 + i * 8 + tg) * DR + 64 * h + 8 * dg);
            }
            const gu64* tp = (const gu64*)(TOT + ((size_t)b * 64) * DR + ch); const int cpre = round * gs < c ? round * gs : c;
            float Apre = 1.f, Bpre = 0.f;
            if (cpre > 0) fold_chunks(tp, 0, cpre, hh, Apre, Bpre);
            if (wave == 0) { const int upto = (round + 1) * gs < 64 ? (round + 1) * gs : 64; const unsigned need = 8u * (unsigned)upto; unsigned sp = 0;
                while ((unsigned)__builtin_amdgcn_readfirstlane(__hip_atomic_load(cw, __ATOMIC_RELAXED, __HIP_MEMORY_SCOPE_AGENT)) < need) { __builtin_amdgcn_s_sleep(1); if (++sp > (1u << 20)) break; }
                __builtin_amdgcn_fence(__ATOMIC_ACQUIRE, "agent");
                asm volatile("s_waitcnt vmcnt(0)" ::: "memory"); }
            asm volatile("" ::: "memory"); __builtin_amdgcn_s_barrier(); asm volatile("" ::: "memory");
            float hc;
            { float Aq, Bq; fold_chunks(tp, cpre, c, hh, Aq, Bq); hc = Bpre * Aq + Bq; (void)Apre; }
#pragma unroll
            for (int tt = 0; tt < 2; ++tt)
#pragma unroll
                for (int q = 0; q < 4; ++q) { const float A0 = hh ? PA[tt][q] : GA[tt][q], B0 = hh ? PB[tt][q] : GB[tt][q], A1 = hh ? GA[tt][q] : PA[tt][q], B1 = hh ? GB[tt][q] : PB[tt][q];
                    const float mid = hc * A0 + B0; float hv = hh ? mid : hc; hc = mid * A1 + B1;
#pragma unroll
                    for (int i = 0; i < 4; ++i) { hv = av[tt][4 * q + i] * hv + bv[tt][4 * q + i]; av[tt][4 * q + i] = hv; } }
#pragma unroll
            for (int tt = 0; tt < 2; ++tt)
#pragma unroll
                for (int r = 0; r < 16; ++r) { const int tk = 32 * tt + (r & 3) + 8 * (r >> 2) + 4 * hh;
                    LAS u16* p = (LAS u16*)(UXT + tk * 128 + (32 * ec + j) * 2);
                    const float gy = __uint_as_float((unsigned)(*p) << 16);
                    *p = (u16)f2bf(gy * av[tt][r]); }
        }
#pragma unroll
        for (int i = 0; i < 8; ++i) { const int row = i * 8 + tg; *(v4u*)(YMIX + (mrow0 + row) * D + DC + 64 * h + 8 * dg) = *(const LAS v4u*)(UXT + row * 128 + dg * 16); }
    }
    __syncthreads();
}

struct Args { const float* in[27]; float* out; unsigned char* ws; int ph_lo, ph_hi; };
constexpr int NPH = 10;
#ifndef MK_PER_PHASE
#define MK_PER_PHASE 0
#endif
#ifndef MK_REP_LO
#define MK_REP_LO 0
#define MK_REP_HI 0
#endif

__global__ void __launch_bounds__(NWAVES * 64, 2) mk_fwd(Args args) {
    extern __shared__ __attribute__((aligned(16))) unsigned char lds_raw[];
    LAS unsigned char* lds = (LAS unsigned char*)lds_raw;
    const int tid = threadIdx.x, lane = tid & 63, wave = __builtin_amdgcn_readfirstlane(tid >> 6);
    const int G = gridDim.x, bx = blockIdx.x;
    const int vcu = (G % 8 == 0) ? (bx % 8) * (G / 8) + bx / 8 : bx;
    const int gw = vcu * NWAVES + wave, NGW = G * NWAVES;
    unsigned char* ws = args.ws;
    gu32* ctl = (gu32*)(ws + WS_CTL);
    const float* x = args.in[0]; const float* cvec = args.in[1]; const float* w_mod = args.in[2]; const float* b_mod = args.in[3];
    const float* g1 = args.in[4]; const float* w1i = args.in[5]; const float* w1o = args.in[6]; const float* gm = args.in[7];
    const float* w_in = args.in[8]; const float* conv_w = args.in[9]; const float* conv_b = args.in[10]; const float* ln_g = args.in[11]; const float* ln_b = args.in[12];
    const float* rw = args.in[13]; const float* rb = args.in[14]; const float* wa = args.in[15]; const float* b_a = args.in[16];
    const float* wi = args.in[17]; const float* b_i = args.in[18]; const float* lam = args.in[19]; const float* w_out = args.in[20];
    const float* g2 = args.in[21]; const float* w2i = args.in[22]; const float* w2o = args.in[23]; const float* w_fmod = args.in[24];
    const float* b_fmod = args.in[25]; const float* gf = args.in[26];
    float* out = args.out;
    float* MOD = (float*)(ws + WS_MOD); float* BIAS1 = (float*)(ws + WS_BIAS1); float* BIAS2 = (float*)(ws + WS_BIAS2); float* BIAS3 = (float*)(ws + WS_BIAS3);
    bf16* WGT = (bf16*)(ws + WS_WGT); f32x2* TOT = (f32x2*)(ws + WS_TOT); float* SSP = (float*)(ws + WS_SSP);
    bf16 *W1O = (bf16*)(ws + WS_W1O), *WIN = (bf16*)(ws + WS_WIN), *WOUT = (bf16*)(ws + WS_WOUT), *W2O = (bf16*)(ws + WS_W2O);
    unsigned char *W1I8 = ws + WS_W1I, *W2I8 = ws + WS_W2I, *WIN8 = ws + WS_WIN, *A8 = ws + WS_Y;
    float *CS1 = (float*)(ws + WS_CS1), *CS3 = (float*)(ws + WS_CS3), *CS2 = (float*)(ws + WS_CS2), *RS1 = (float*)(ws + WS_RS1), *RS3 = (float*)(ws + WS_RS3), *RS2 = (float*)(ws + WS_RS2);
    bf16 *Y = (bf16*)(ws + WS_Y), *ACT = (bf16*)(ws + WS_ACT), *U = (bf16*)(ws + WS_U), *UXB = (bf16*)(ws + WS_UX), *GYB = (bf16*)(ws + WS_GY), *YMIX = (bf16*)(ws + WS_YMIX);
    bf16* X1 = (bf16*)(ws + WS_X1);

    for (int u = tid; u < (LDS_BYTES - LDSCTL_OFF) / 4; u += NWAVES * 64) ((LAS unsigned*)(lds + LDSCTL_OFF))[u] = 0u;
    __syncthreads();
    const int lo = args.ph_lo, hi = args.ph_hi;
    const bool use_bar = (hi - lo) > 1;
    XcdBarrier bar; bar.bar = (unsigned*)(ctl + CW_BAR); bar.x = 0; bar.st = nullptr;
    if (use_bar) bar = xcd_barrier_post((unsigned*)(ctl + CW_BAR), (volatile LAS unsigned*)(lds + LDSCTL_OFF) + 8);
#define IN(k) (lo <= (k) && (k) < hi)
#define REPS(k) ((MK_REP_LO <= (k) && (k) < MK_REP_HI) ? 2 : 1)
#define AGAIN(k, rr) do { if ((rr) + 1 < REPS(k)) xcd_barrier(bar); } while (0)
#define SEAM(k) do { if (IN(k) && IN((k) + 1)) xcd_barrier(bar); } while (0)

    if (IN(0))
_Pragma("unroll")
    for (int rr = 0; rr < REPS(0); ++rr) {
        constexpr int NGEMV = 88;
        const int nt_wg = G > NGEMV ? G - NGEMV : G;
        if (bx < NGEMV || G <= NGEMV) {
            for (int it = bx; it < NGEMV; it += G) {
                if (it < 72) p0_gemv(lds, cvec, w_mod, 9 * D, b_mod, MOD, 128 * it, tid);
                else p0_gemv(lds, cvec, w_fmod, 2 * D, b_fmod, MOD + 9 * D, 128 * (it - 72), tid);
            }
        }
        if (bx >= NGEMV || G <= NGEMV) {
            const int tb = G > NGEMV ? bx - NGEMV : bx;
            for (int it = tb; it < 2 * (FF2 / 32); it += nt_wg) {
                if (it < FF2 / 32) p0_quant_item(lds, w1i, FF2, 1, W1I8, CS1, it, lane, wave);
                else p0_quant_item(lds, w2i, FF2, 1, W2I8, CS3, it - FF2 / 32, lane, wave);
            }
            LAS float* scr = (LAS float*)(lds + wave * 16384);
            constexpr int I_1O = (FF / 64) * (D / 32), I_IN = (D / 64) * (NMIX / 32), I_OUT = (D / 64) * (D / 32);
            constexpr int NITEMS = 2 * I_1O + I_IN + I_OUT;
            for (int it = tb * NWAVES + wave; it < NITEMS; it += nt_wg * NWAVES) {
                int r = it;
                if (r < I_1O) { p0_transpose_item(w1o, FF, D, W1O, 0, scr, r, lane); continue; } r -= I_1O;
                if (r < I_1O) { p0_transpose_item(w2o, FF, D, W2O, 0, scr, r, lane); continue; } r -= I_1O;
                if (r < I_IN) { p0_transpose_item(w_in, D, NMIX, WIN, 2, scr, r, lane); continue; } r -= I_IN;
                p0_transpose_item(w_out, D, D, WOUT, 0, scr, r, lane);
            }
        }
        for (int i = bx * 512 + tid; i < NH * 128 * HD; i += G * 512) { const int d = i & 63, e2 = (i >> 6) & 127, hd = i >> 13;
            const float v = e2 < 64 ? wa[(hd * 64 + d) * 64 + e2] : wi[(hd * 64 + d) * 64 + (e2 - 64)]; WGT[i] = (bf16)f2bf(v); }
        AGAIN(0, rr);
    }
    SEAM(0);
    if (IN(1))
_Pragma("unroll")
    for (int rr = 0; rr < REPS(1); ++rr) {
        LAS float* shl = (LAS float*)lds;
        for (int i = tid * 4; i < 3 * NB * D; i += 2048) { const int t = i >> 13, r = i & 8191, b = r >> 10, k = r & 1023; *(LAS f32x4*)(shl + i) = *(const f32x4*)(MOD + (size_t)b * LDM + 3 * t * D + k); }
        __syncthreads();
        for (int m0 = gw; m0 < M; m0 += 2 * NGW) {
            f32x4 v[2][4];
#pragma unroll
            for (int rr2 = 0; rr2 < 2; ++rr2) { const int m = (m0 + rr2 * NGW < M) ? m0 + rr2 * NGW : m0; const f32x4* xr = (const f32x4*)(x + (size_t)m * D) + lane;
#pragma unroll
                for (int jj = 0; jj < 4; ++jj) v[rr2][jj] = xr[64 * jj]; }
#pragma unroll
            for (int rr2 = 0; rr2 < 2; ++rr2) { const int m = m0 + rr2 * NGW; if (m < M) { const int b = m >> 12;
                float s = 0.f, am = 0.f;
#pragma unroll
                for (int jj = 0; jj < 4; ++jj) { const int k = 4 * lane + 256 * jj;
                    s += (v[rr2][jj][0] * v[rr2][jj][0] + v[rr2][jj][1] * v[rr2][jj][1]) + (v[rr2][jj][2] * v[rr2][jj][2] + v[rr2][jj][3] * v[rr2][jj][3]);
                    v[rr2][jj] = v[rr2][jj] * *(const f32x4*)(g1 + k) * (*(const f32x4*)(MOD + (size_t)b * LDM + 1 * D + k) + 1.0f);
                    const f32x4 t = __builtin_elementwise_abs(v[rr2][jj]); am = fmaxf(am, fmaxf(fmaxf(t[0], t[1]), fmaxf(t[2], t[3]))); }
                s = wave_sum(s); am = wave_max(am);
                const float q = am > 0.f ? 127.0f / am : 0.f;
#pragma unroll
                for (int jj = 0; jj < 4; ++jj) *(unsigned*)(A8 + (size_t)m * D + 4 * lane + 256 * jj) = q8x4(v[rr2][jj] * q);
                if (lane == 0) RS1[m] = rsqrtf(s * (1.0f / D) + EPS) * am * (1.0f / 127.0f); } }
        }
        for (int it = gw; it < FF2 + NMIX + FF2; it += NGW) {
            if (it >= FF2 && it < FF2 + NMIX) {
                const bf16* wrow = WIN + (size_t)(it - FF2) * D; float* op = BIAS2 + (it - FF2);
                const v4u wA = *(const v4u*)(wrow + 8 * lane), wB = *(const v4u*)(wrow + 512 + 8 * lane);
                f32x4 a0, a1, c0, c1; unpack8(wA, a0, a1); unpack8(wB, c0, c1);
#pragma unroll
                for (int b = 0; b < NB; ++b) { const LAS float* sp = shl + (1 * NB + b) * D + 8 * lane;
                    const f32x4 p = a0 * *(const LAS f32x4*)(sp) + a1 * *(const LAS f32x4*)(sp + 4) + c0 * *(const LAS f32x4*)(sp + 512) + c1 * *(const LAS f32x4*)(sp + 516);
                    const float tot = wave_sum((p[0] + p[1]) + (p[2] + p[3]));
                    if (lane == 0) op[(size_t)b * NMIX] = tot; }
            } else {
                const int t = it < FF2 ? 0 : 2, n = it < FF2 ? it : it - FF2 - NMIX;
                const unsigned char* wrow = (t == 0 ? W1I8 : W2I8) + (size_t)n * D; float* op = (t == 0 ? BIAS1 : BIAS3) + n; const float csn = (t == 0 ? CS1 : CS3)[n];
                const v4u w16 = *(const v4u*)(wrow + 16 * lane);
                f32x4 wf[4];
#pragma unroll
                for (int d4 = 0; d4 < 4; ++d4) { const int wv = (int)(d4 == 0 ? w16.x : d4 == 1 ? w16.y : d4 == 2 ? w16.z : w16.w);
                    wf[d4] = (f32x4){(float)((wv << 24) >> 24), (float)((wv << 16) >> 24), (float)((wv << 8) >> 24), (float)(wv >> 24)}; }
#pragma unroll
                for (int b = 0; b < NB; ++b) { const LAS float* sp = shl + (t * NB + b) * D + 16 * lane;
                    const f32x4 p = wf[0] * *(const LAS f32x4*)(sp) + wf[1] * *(const LAS f32x4*)(sp + 4) + wf[2] * *(const LAS f32x4*)(sp + 8) + wf[3] * *(const LAS f32x4*)(sp + 12);
                    const float tot = wave_sum((p[0] + p[1]) + (p[2] + p[3]));
                    if (lane == 0) op[(size_t)b * FF2] = tot * csn; }
            }
        }
        __syncthreads();
        AGAIN(1, rr);
    }
    SEAM(1);
    if (IN(2))
_Pragma("unroll")
    for (int rr = 0; rr < REPS(2); ++rr) {
        pg8::Gemm g{(const pg8::bf16_t*)A8, (const pg8::bf16_t*)W1I8, M, FF2, D / 2}; pg8::StaticOrder S; S.init(M, FF2, G, bx);
        EpiSwiglu8 E{ACT, RS1, CS1, BIAS1};
        pg8::gemm_phase<EpiSwiglu8, pg8::StaticOrder, true, true, true>(lds, g, S, E);
        AGAIN(2, rr);
    }
    SEAM(2);
    if (IN(3))
_Pragma("unroll")
    for (int rr = 0; rr < REPS(3); ++rr) {
        pg8::Gemm g{ACT, W1O, M, D, FF}; pg8::StaticOrder S; S.init(M, D, G, bx);
        EpiResid<1, true, false> E{x, X1, Y, SSP, MOD + 2 * D, gm, MOD + 4 * D};
        pg8::gemm_phase<EpiResid<1, true, false>, pg8::StaticOrder, true, true>(lds, g, S, E);
        AGAIN(3, rr);
    }
    SEAM(3);
    if (IN(4))
_Pragma("unroll")
    for (int rr = 0; rr < REPS(4); ++rr) {
        pg8::Gemm g{Y, WIN, M, NMIX, D}; pg8::StaticOrder S; S.init(M, NMIX, G, bx);
        EpiMixIn E{U, UXB, GYB, SSP, BIAS2};
        pg8::gemm_phase<EpiMixIn, pg8::StaticOrder, true, true>(lds, g, S, E);
        AGAIN(4, rr);
    }
    SEAM(4);
    if (IN(5))
_Pragma("unroll")
    for (int rr = 0; rr < REPS(5); ++rr) {
        mix_conv(lds, U, conv_w, conv_b, ln_g, ln_b, YMIX, G, bx, tid, lane, wave);
#ifdef MK_REP_CONV
        mix_conv(lds, U, conv_w, conv_b, ln_g, ln_b, YMIX, G, bx, tid, lane, wave);
#endif
        mix_scan1(lds, UXB, GYB, WGT, rw, rb, b_a, b_i, lam, TOT, (unsigned*)(ctl + CW_SCAN), YMIX, G, bx, lane, wave);
        AGAIN(5, rr);
    }
    SEAM(5);
    if (IN(7))
_Pragma("unroll")
    for (int rr = 0; rr < REPS(7); ++rr) {
        pg8::Gemm g{YMIX, WOUT, M, D, D}; pg8::StaticOrder S; S.init(M, D, G, bx);
        EpiResidQ<0, true> E{X1, X1, A8, RS3, (f32x2*)(ws + WS_SSPX), MOD + 5 * D, g2, MOD + 7 * D, (unsigned*)(ctl + CW_SEAM7)};
        pg8::gemm_phase<EpiResidQ<0, true>, pg8::StaticOrder, true, true>(lds, g, S, E);
        AGAIN(7, rr);
    }
    SEAM(7);
    if (IN(8))
_Pragma("unroll")
    for (int rr = 0; rr < REPS(8); ++rr) {
        pg8::Gemm g{(const pg8::bf16_t*)A8, (const pg8::bf16_t*)W2I8, M, FF2, D / 2}; pg8::StaticOrder S; S.init(M, FF2, G, bx);
        EpiSwiglu8 E{ACT, RS3, CS3, BIAS3};
        pg8::gemm_phase<EpiSwiglu8, pg8::StaticOrder, true, true, true>(lds, g, S, E);
        AGAIN(8, rr);
    }
    SEAM(8);
    if (IN(9))
_Pragma("unroll")
    for (int rr = 0; rr < REPS(9); ++rr) {
        pg8::Gemm g{ACT, W2O, M, D, FF}; pg8::StaticOrder S; S.init(M, D, G, bx);
        EpiResidFinal E{X1, out, (float*)(ws + WS_SSPF), MOD + 8 * D, gf, MOD + 10 * D, MOD + 9 * D, (unsigned*)(ctl + CW_SEAM)};
        pg8::gemm_phase<EpiResidFinal, pg8::StaticOrder, true, true>(lds, g, S, E);
    }
#undef IN
#undef SEAM
#undef REPS
#undef AGAIN
}

extern "C" void kernel_launch(void* const* d_in, const int* in_sizes, int n_in, void* d_out, int out_size, void* d_ws, size_t ws_size, hipStream_t stream) {
    static int grid = 0;
    if (grid == 0) {
        if (n_in != 27 || in_sizes[0] != M * D || out_size != M * D || ws_size < WS_END) { fprintf(stderr, "kernel_launch: unexpected shapes (n_in %d, in0 %d, out %d, ws %zu)\n", n_in, n_in > 0 ? in_sizes[0] : -1, out_size, ws_size); grid = -1; return; }
        int dev = 0, cus = 0, per_cu = 0;
        if (hipGetDevice(&dev) != hipSuccess || hipDeviceGetAttribute(&cus, hipDeviceAttributeMultiprocessorCount, dev) != hipSuccess) { grid = -1; return; }
        if (hipFuncSetAttribute((const void*)mk_fwd, hipFuncAttributeMaxDynamicSharedMemorySize, LDS_BYTES) != hipSuccess) { fprintf(stderr, "kernel_launch: hipFuncSetAttribute failed\n"); grid = -1; return; }
        if (hipOccupancyMaxActiveBlocksPerMultiprocessor(&per_cu, (const void*)mk_fwd, NWAVES * 64, LDS_BYTES) != hipSuccess || per_cu < 1) fprintf(stderr, "kernel_launch: occupancy query reports %d blocks per CU\n", per_cu);
        (void)hipGetLastError();
        grid = cus;
        if (grid % 8 != 0 || grid < 8) { fprintf(stderr, "kernel_launch: %d CUs: the scan's chunk rounds need a multiple of 8 workgroups\n", grid); grid = -1; return; }
    }
    if (grid < 0) return;
    if (hipMemsetAsync((char*)d_ws + WS_CTL, 0, CTL_ZERO_BYTES, stream) != hipSuccess) return;
    Args a{};
    for (int i = 0; i < 27; ++i) a.in[i] = (const float*)d_in[i];
    a.out = (float*)d_out; a.ws = (unsigned char*)d_ws;
#if MK_PER_PHASE
    for (int p = 0; p < NPH; ++p) { a.ph_lo = p; a.ph_hi = p + 1; hipLaunchKernelGGL(mk_fwd, dim3(grid), dim3(NWAVES * 64), LDS_BYTES, stream, a); }
#else
    a.ph_lo = 0; a.ph_hi = NPH; hipLaunchKernelGGL(mk_fwd, dim3(grid), dim3(NWAVES * 64), LDS_BYTES, stream, a);
#endif
}
```

```cpp
#include <hip/hip_runtime.h>
#include <cstdio>
#include <cstdint>
namespace pg8 {
#define PG8_LAS __attribute__((address_space(3)))
typedef unsigned short bf16_t;
typedef short bf16x8 __attribute__((ext_vector_type(8)));
typedef float f32x4 __attribute__((ext_vector_type(4)));
typedef unsigned u32x4 __attribute__((ext_vector_type(4)));
constexpr int BM = 256, BK = 64, HALF = 128, HTB = HALF * BK * 2  , STAGE_BYTES = 8 * HTB, NXCD = 8, WGM = 8;

__host__ __device__ __forceinline__ int lds_byte(int r, int c) { const int st = (r >> 4) * 2 + (c >> 5), rr = r & 15, cc = c & 31, ob = rr * 64 + cc * 2; return st * 1024 + (ob ^ (((ob >> 9) & 1) << 5)); }
__host__ __device__ __forceinline__ void stage_rc(int b, int& R, int& C) { const int st = b / 1024, sb = b % 1024, swz = sb ^ (((sb >> 9) & 1) << 5); R = (st >> 1) * 16 + swz / 64; C = (st & 1) * 32 + (swz % 64) / 2; }
__host__ __device__ __forceinline__ int perm32(int rho) { const int n = rho >> 4, i = rho & 15; return 8 * (i >> 2) + 4 * n + (i & 3); }

struct Unit { int pm, pn; };
struct Gemm { const bf16_t* A; const bf16_t* Bt; int M, N, K; };

struct StaticOrder {
    int nM, nN, nwg, G, c;
    __host__ __device__ void init(int M, int N, int G_, int c_) { nM = M / BM; nN = N / BM; nwg = nM * nN; G = G_; c = c_; }
    __host__ __device__ bool next(int i, Unit& u) const {
        const long L = (long)i * G + c; if (L >= nwg) return false;
        int wgid = (int)L; { const int q = nwg / NXCD, r = nwg % NXCD, xcd = wgid % NXCD, off = wgid / NXCD; wgid = (xcd < r ? xcd * (q + 1) : r * (q + 1) + (xcd - r) * q) + off; }
        const int nig = WGM * nN, gid = wgid / nig, fm = gid * WGM, gsz = (nM - fm) < WGM ? (nM - fm) : WGM;
        u.pm = fm + ((wgid % nig) % gsz); u.pn = (wgid % nig) / gsz; return true;
    }
    __device__ __forceinline__ void a_ready(const Unit&) const {}
    __device__ __forceinline__ void done(const Unit&) const {}
};

__device__ __forceinline__ unsigned cvt_pk_bf16(float lo, float hi) { unsigned r; asm volatile("v_cvt_pk_bf16_f32 %0, %1, %2" : "=v"(r) : "v"(lo), "v"(hi)); return r; }
#ifndef PG8_STAGE_IN_MMA
#define PG8_STAGE_IN_MMA 0
#endif
typedef int i32x4 __attribute__((ext_vector_type(4)));
typedef int i32x8 __attribute__((ext_vector_type(8)));
__device__ __forceinline__ i32x8 cat32(const bf16x8 lo, const bf16x8 hi) { const i32x4 p = __builtin_bit_cast(i32x4, lo), q = __builtin_bit_cast(i32x4, hi); return (i32x8){p.x, p.y, p.z, p.w, q.x, q.y, q.z, q.w}; }
__device__ __forceinline__ f32x4 mma_mx8(const i32x8 B, const i32x8 A, const f32x4 c) { return __builtin_amdgcn_mfma_scale_f32_16x16x128_f8f6f4(B, A, c, 0, 0, 0, 0x7F7F7F7F, 0, 0x7F7F7F7F); }
template <int I8> __device__ __forceinline__ f32x4 mma16(const bf16x8 b, const bf16x8 a, const f32x4 c) {
    if constexpr (I8 == 1) return __builtin_bit_cast(f32x4, __builtin_amdgcn_mfma_i32_16x16x64_i8(__builtin_bit_cast(i32x4, b), __builtin_bit_cast(i32x4, a), __builtin_bit_cast(i32x4, c), 0, 0, 0));
    else return __builtin_amdgcn_mfma_f32_16x16x32_bf16(b, a, c, 0, 0, 0);
}
template <class Epi, class Sched, bool ALIGN_EPI = false, bool SP2 = false, int I8 = 0>
__device__ __forceinline__ void gemm_phase(PG8_LAS unsigned char* lds, const Gemm g, const Sched& S, const Epi& E) {
    const int tid = threadIdx.x, wid = __builtin_amdgcn_readfirstlane(tid >> 6), lane = tid & 63, wr = wid >> 2, wc = wid & 3, fr = lane & 15, fq = lane >> 4;
    const int K = g.K, nt = K / BK;
    unsigned voffA[1], voffB[1];
    { int R, C; stage_rc(tid * 16, R, C); const int Rb = Epi::PERM ? ((R & ~31) + perm32(R & 31)) : R;
        voffA[0] = (unsigned)(R * K + C) * 2u; voffB[0] = (unsigned)(Rb * K + C) * 2u; }
    const size_t r64 = (size_t)64 * K * 2;
    const size_t kstep = (size_t)(BK * 2);
    const size_t hstep = (size_t)HALF * K * 2;
    const size_t tstep = 2 * hstep;
    const unsigned ldsw = (unsigned)wid * 1024u;
    const int aoff = lds_byte(wr * 64 + fr, fq * 8), boff = lds_byte(wc * 32 + fr, fq * 8);
#define PG8_SA(b, h) (((b) * 2 + (h)) * HTB)
#define PG8_SB(b, h) ((4 + (b) * 2 + (h)) * HTB)
#define PG8_STAGE(bufoff, gbase, voff) do { _Pragma("unroll") for (int _i = 0; _i < 2; ++_i) \
        __builtin_amdgcn_global_load_lds((const unsigned*)((const char*)(gbase) + _i * r64 + (voff)[0]), (PG8_LAS unsigned*)(lds + (bufoff) + ldsw + _i * 8192), 16, 0, 0); } while (0)
#define PG8_LDA(dst, b, h) do { _Pragma("unroll") for (int m = 0; m < 4; ++m) { if constexpr (I8 == 2) dst##8[m] = cat32(*(const PG8_LAS bf16x8*)(lds + PG8_SA(b, h) + aoff + m * 2048), *(const PG8_LAS bf16x8*)(lds + PG8_SA(b, h) + aoff + m * 2048 + 1024)); \
        else { _Pragma("unroll") for (int k = 0; k < 2; ++k) dst[m][k] = *(const PG8_LAS bf16x8*)(lds + PG8_SA(b, h) + aoff + m * 2048 + k * 1024); } } } while (0)
#define PG8_LDB(dst, b, h) do { _Pragma("unroll") for (int n = 0; n < 2; ++n) { if constexpr (I8 == 2) dst##8[n] = cat32(*(const PG8_LAS bf16x8*)(lds + PG8_SB(b, h) + boff + n * 2048), *(const PG8_LAS bf16x8*)(lds + PG8_SB(b, h) + boff + n * 2048 + 1024)); \
        else { _Pragma("unroll") for (int k = 0; k < 2; ++k) dst[n][k] = *(const PG8_LAS bf16x8*)(lds + PG8_SB(b, h) + boff + n * 2048 + k * 1024); } } } while (0)
#define PG8_MMA(ai, bj, At, Bt) do { __builtin_amdgcn_s_setprio(1); _Pragma("unroll") for (int m = 0; m < 4; ++m) _Pragma("unroll") for (int n = 0; n < 2; ++n) { \
        if constexpr (I8 == 2) acc[ai][bj][m][n] = mma_mx8(Bt##8[n], At##8[m], acc[ai][bj][m][n]); \
        else { _Pragma("unroll") for (int k = 0; k < 2; ++k) acc[ai][bj][m][n] = mma16<I8>(Bt[n][k], At[m][k], acc[ai][bj][m][n]); } } __builtin_amdgcn_s_setprio(0); } while (0)
#define PG8_WAIT_V(n) asm volatile("s_waitcnt vmcnt(" #n ")" ::: "memory")
#define PG8_WAIT_L(n) asm volatile("s_waitcnt lgkmcnt(" #n ")" ::: "memory")
#define PG8_BAR __builtin_amdgcn_s_barrier()
#define PG8_SCHED __builtin_amdgcn_sched_barrier(0)
    Unit cur, nxt; int ui = 0;
    if (!S.next(0, cur)) return;
    f32x4 acc[2][2][4][2];
#pragma unroll
    for (int a = 0; a < 2; ++a)
#pragma unroll
        for (int b = 0; b < 2; ++b)
#pragma unroll
            for (int m = 0; m < 4; ++m)
#pragma unroll
                for (int n = 0; n < 2; ++n) acc[a][b][m][n] = (f32x4){0.f, 0.f, 0.f, 0.f};
    bf16x8 At[4][2], B0[2][2], B1[2][2]; i32x8 At8[4], B08[2], B18[2];
    const char* cA = (const char*)g.A + (size_t)cur.pm * tstep; const char* cB = (const char*)g.Bt + (size_t)cur.pn * tstep;
    S.a_ready(cur);
    if constexpr (SP2) {
        PG8_STAGE(PG8_SB(0, 0), cB, voffB); PG8_STAGE(PG8_SB(0, 1), cB + hstep, voffB); PG8_STAGE(PG8_SA(0, 0), cA, voffA); PG8_STAGE(PG8_SA(0, 1), cA + hstep, voffA);
        if (wr == 1) PG8_BAR;
        PG8_WAIT_V(2); PG8_BAR;
        PG8_STAGE(PG8_SB(1, 0), cB + kstep, voffB); PG8_STAGE(PG8_SA(1, 0), cA + kstep, voffA); PG8_STAGE(PG8_SB(1, 1), cB + hstep + kstep, voffB);
        PG8_WAIT_V(6); PG8_BAR;
    } else {
        PG8_STAGE(PG8_SB(0, 0), cB, voffB); PG8_STAGE(PG8_SA(0, 0), cA, voffA); PG8_STAGE(PG8_SB(0, 1), cB + hstep, voffB); PG8_STAGE(PG8_SA(0, 1), cA + hstep, voffA);
        if (wr == 1) PG8_BAR;
        PG8_WAIT_V(4); PG8_BAR;
        PG8_STAGE(PG8_SB(1, 0), cB + kstep, voffB); PG8_STAGE(PG8_SA(1, 0), cA + kstep, voffA); PG8_STAGE(PG8_SB(1, 1), cB + hstep + kstep, voffB);
        PG8_WAIT_V(6); PG8_BAR;
    }
    for (;;) {
        const bool has_next = S.next(ui + 1, nxt);
        const char* nA = has_next ? (const char*)g.A + (size_t)nxt.pm * tstep : cA; const char* nB = has_next ? (const char*)g.Bt + (size_t)nxt.pn * tstep : cB;
        asm volatile(".p2align 8" ::: "memory");
        for (int t = 0; t < nt; t += 2) {
            const bool last = (t == nt - 2);
            const char* a1 = cA + (size_t)(t + 1) * kstep;
            const char* a2 = last ? nA : cA + (size_t)(t + 2) * kstep; const char* b2 = last ? nB : cB + (size_t)(t + 2) * kstep;
            const char* a3 = a2 + kstep; const char* b3 = b2 + kstep;
            if (last && has_next) S.a_ready(nxt);
            if constexpr (SP2) {
#if PG8_STAGE_IN_MMA
            PG8_LDB(B0, 0, 0); PG8_LDB(B1, 0, 1); PG8_SCHED; PG8_LDA(At, 0, 0);
            PG8_WAIT_V(6); PG8_WAIT_L(0); PG8_BAR; PG8_MMA(0, 0, At, B0); PG8_SCHED; PG8_STAGE(PG8_SA(1, 1), a1 + hstep, voffA); PG8_SCHED; PG8_MMA(0, 1, At, B1); PG8_BAR; PG8_SCHED;
            PG8_LDA(At, 0, 1);
            PG8_WAIT_V(2); PG8_WAIT_L(0); PG8_BAR; PG8_STAGE(PG8_SB(0, 0), b2, voffB); PG8_SCHED; PG8_MMA(1, 0, At, B0); PG8_SCHED; PG8_STAGE(PG8_SB(0, 1), b2 + hstep, voffB); PG8_SCHED; PG8_MMA(1, 1, At, B1); PG8_SCHED; PG8_STAGE(PG8_SA(0, 0), a2, voffA); PG8_BAR; PG8_SCHED;
            PG8_LDB(B0, 1, 0); PG8_LDB(B1, 1, 1); PG8_SCHED; PG8_LDA(At, 1, 0);
            PG8_WAIT_V(6); PG8_WAIT_L(0); PG8_BAR; PG8_MMA(0, 0, At, B0); PG8_SCHED; PG8_STAGE(PG8_SA(0, 1), a2 + hstep, voffA); PG8_SCHED; PG8_MMA(0, 1, At, B1); PG8_BAR; PG8_SCHED;
            PG8_LDA(At, 1, 1);
            PG8_WAIT_V(2); PG8_WAIT_L(0); PG8_BAR; PG8_STAGE(PG8_SB(1, 0), b3, voffB); PG8_SCHED; PG8_MMA(1, 0, At, B0); PG8_SCHED; PG8_STAGE(PG8_SB(1, 1), b3 + hstep, voffB); PG8_SCHED; PG8_MMA(1, 1, At, B1); PG8_SCHED; PG8_STAGE(PG8_SA(1, 0), a3, voffA); PG8_BAR; PG8_SCHED;
#else
            PG8_LDB(B0, 0, 0); PG8_LDB(B1, 0, 1); PG8_SCHED; PG8_LDA(At, 0, 0); PG8_STAGE(PG8_SA(1, 1), a1 + hstep, voffA);
            PG8_WAIT_V(8); PG8_WAIT_L(0); PG8_BAR; PG8_MMA(0, 0, At, B0); PG8_MMA(0, 1, At, B1); PG8_BAR; PG8_SCHED;
            PG8_LDA(At, 0, 1); PG8_STAGE(PG8_SB(0, 0), b2, voffB); PG8_STAGE(PG8_SB(0, 1), b2 + hstep, voffB); PG8_STAGE(PG8_SA(0, 0), a2, voffA);
            PG8_WAIT_V(8); PG8_WAIT_L(0); PG8_BAR; PG8_MMA(1, 0, At, B0); PG8_MMA(1, 1, At, B1); PG8_BAR; PG8_SCHED;
            PG8_LDB(B0, 1, 0); PG8_LDB(B1, 1, 1); PG8_SCHED; PG8_LDA(At, 1, 0); PG8_STAGE(PG8_SA(0, 1), a2 + hstep, voffA);
            PG8_WAIT_V(8); PG8_WAIT_L(0); PG8_BAR; PG8_MMA(0, 0, At, B0); PG8_MMA(0, 1, At, B1); PG8_BAR; PG8_SCHED;
            PG8_LDA(At, 1, 1); PG8_STAGE(PG8_SB(1, 0), b3, voffB); PG8_STAGE(PG8_SB(1, 1), b3 + hstep, voffB); PG8_STAGE(PG8_SA(1, 0), a3, voffA);
            PG8_WAIT_V(8); PG8_WAIT_L(0); PG8_BAR; PG8_MMA(1, 0, At, B0); PG8_MMA(1, 1, At, B1); PG8_BAR; PG8_SCHED;
#endif
            } else {
            PG8_LDB(B0, 0, 0); PG8_SCHED; PG8_LDA(At, 0, 0); PG8_STAGE(PG8_SA(1, 1), a1 + hstep, voffA);
            PG8_WAIT_L(8); PG8_BAR; PG8_WAIT_L(0); PG8_MMA(0, 0, At, B0); PG8_BAR; PG8_SCHED;
            PG8_LDB(B1, 0, 1); PG8_STAGE(PG8_SB(0, 0), b2, voffB);
            PG8_BAR; PG8_WAIT_L(0); PG8_MMA(0, 1, At, B1); PG8_BAR;
            PG8_LDA(At, 0, 1); PG8_STAGE(PG8_SA(0, 0), a2, voffA);
            PG8_BAR; PG8_WAIT_L(0); PG8_MMA(1, 0, At, B0); PG8_BAR; PG8_SCHED;
            PG8_STAGE(PG8_SB(0, 1), b2 + hstep, voffB);
            PG8_WAIT_V(6); PG8_BAR; PG8_MMA(1, 1, At, B1); PG8_BAR;
            PG8_LDB(B0, 1, 0); PG8_SCHED; PG8_LDA(At, 1, 0); PG8_STAGE(PG8_SA(0, 1), a2 + hstep, voffA);
            PG8_WAIT_L(8); PG8_BAR; PG8_WAIT_L(0); PG8_MMA(0, 0, At, B0); PG8_BAR; PG8_SCHED;
            PG8_LDB(B1, 1, 1); PG8_STAGE(PG8_SB(1, 0), b3, voffB);
            PG8_BAR; PG8_WAIT_L(0); PG8_MMA(0, 1, At, B1); PG8_BAR;
            PG8_LDA(At, 1, 1); PG8_STAGE(PG8_SA(1, 0), a3, voffA);
            PG8_BAR; PG8_WAIT_L(0); PG8_MMA(1, 0, At, B0); PG8_BAR; PG8_SCHED;
            PG8_STAGE(PG8_SB(1, 1), b3 + hstep, voffB);
            PG8_WAIT_V(6); PG8_BAR; PG8_MMA(1, 1, At, B1); PG8_BAR;
            }
        }
        if constexpr (ALIGN_EPI) { if (wr == 0) PG8_BAR; }
        if constexpr (!Epi::AFTER_DRAIN) { int ln; asm volatile("v_mbcnt_lo_u32_b32 %0, -1, 0\n\tv_mbcnt_hi_u32_b32 %0, -1, %0" : "=v"(ln));     const int fr2 = ln & 15, fq2 = ln >> 4; _Pragma("unroll") for (int er = 0; er < Epi::REPS; ++er) { E(acc, cur, wr, wc, fr2, fq2); if (er + 1 < Epi::REPS) asm volatile("" ::: "memory"); } S.done(cur); }
        if (!has_next) break;
#pragma unroll
        for (int a = 0; a < 2; ++a)
#pragma unroll
            for (int b = 0; b < 2; ++b)
#pragma unroll
                for (int m = 0; m < 4; ++m)
#pragma unroll
                    for (int n = 0; n < 2; ++n) acc[a][b][m][n] = (f32x4){0.f, 0.f, 0.f, 0.f};
        cur = nxt; cA = nA; cB = nB; ++ui;
        if constexpr (ALIGN_EPI) { if (wr == 1) PG8_BAR; }
    }
    PG8_WAIT_V(0);
    if constexpr (!ALIGN_EPI) { if (wr == 0) PG8_BAR; }
    PG8_BAR;
    if constexpr (Epi::AFTER_DRAIN) { E.fused(acc, cur, wr, wc, fr, fq, lds, wid, lane); S.done(cur); }
#undef PG8_SA
#undef PG8_SB
#undef PG8_STAGE
#undef PG8_LDA
#undef PG8_LDB
#undef PG8_MMA
#undef PG8_WAIT_V
#undef PG8_WAIT_L
#undef PG8_BAR
#undef PG8_SCHED
}
}
#define GAS __attribute__((address_space(1)))
#define LAS __attribute__((address_space(3)))
typedef unsigned short bf16;
typedef unsigned v4u __attribute__((ext_vector_type(4)));
typedef float f32x4 __attribute__((ext_vector_type(4)));
typedef short bf16x8 __attribute__((ext_vector_type(8)));
typedef GAS unsigned gu32;
typedef GAS unsigned long long gu64;
#define RLX_AGENT __ATOMIC_RELAXED, __HIP_MEMORY_SCOPE_AGENT
#define LDS_WAIT() asm volatile("s_waitcnt lgkmcnt(0)" ::: "memory")
#define VM_WAIT() asm volatile("s_waitcnt vmcnt(0)" ::: "memory")
__device__ __forceinline__ unsigned long long rt() { return __builtin_amdgcn_s_memrealtime(); }
__device__ __forceinline__ unsigned f2bf(float f) { unsigned u = __builtin_bit_cast(unsigned, f); return (u + 0x7fffu + ((u >> 16) & 1u)) >> 16; }
__device__ __forceinline__ unsigned pk2(float lo, float hi) { return f2bf(lo) | (f2bf(hi) << 16); }

#define XB_TMO      128
#define XB_XCNT(j)  (256  + 64 * (j))
#define XB_XSUB(j)  (1280 + 64 * (j))
#define XB_XGEN(j)  (2304 + 64 * (j))
#define XB_TOP      3328
#define XB_TOPGEN   3392
#define XCD_BAR_WORDS 3456
#define XB_SPIN_CAP (1u << 18)

__device__ __forceinline__ unsigned xb_ld(unsigned* p)              { return __hip_atomic_load(p, __ATOMIC_RELAXED, __HIP_MEMORY_SCOPE_AGENT); }
__device__ __forceinline__ unsigned xb_add(unsigned* p, unsigned v) { return __hip_atomic_fetch_add(p, v, __ATOMIC_RELAXED, __HIP_MEMORY_SCOPE_AGENT); }
__device__ __forceinline__ unsigned xb_xcc_id() { return (unsigned)__builtin_amdgcn_s_getreg((3 << 11) | 20) & 0xFu; }
#define XB_SPIN(cond, bar) do { unsigned _sp = 0; while (cond) { __builtin_amdgcn_s_sleep(1); \
    if ((++_sp & 255u) == 0u) { if (xb_ld(&(bar)[XB_TMO])) break; if (_sp > XB_SPIN_CAP) { atomicAdd(&(bar)[XB_TMO], 1u); break; } } } } while (0)

struct XcdBarrier {
    unsigned* bar; unsigned x;
    volatile LAS unsigned* st;
};

__device__ __forceinline__ XcdBarrier xcd_barrier_post(unsigned* bar, volatile LAS unsigned* st) {
    XcdBarrier b; b.bar = bar; b.x = xb_xcc_id(); b.st = st;
    if (threadIdx.x == 0) (void)xb_add(&bar[XB_XCNT(b.x)], 1u);
    return b;
}
__device__ __forceinline__ void xcd_barrier_complete(unsigned* bar, unsigned x, unsigned& nloc, unsigned& nx) {
    const unsigned G = gridDim.x * gridDim.y * gridDim.z;
    unsigned sum, cnt, mine, sp = 0u;
    for (;;) {
        sum = 0u; cnt = 0u; mine = 0u;
#pragma unroll
        for (unsigned j = 0; j < 16; ++j) { const unsigned c = xb_ld(&bar[XB_XCNT(j)]); sum += c; cnt += (c > 0u) ? 1u : 0u; mine = (j == x) ? c : mine; }
        if (sum == G) break;
        __builtin_amdgcn_s_sleep(1);
        if ((++sp & 255u) == 0u) { if (xb_ld(&bar[XB_TMO])) break; if (sp > XB_SPIN_CAP) { atomicAdd(&bar[XB_TMO], 1u); break; } }
    }
    nloc = mine > 0u ? mine : 1u; nx = cnt > 0u ? cnt : 1u;
}

__device__ __forceinline__ void xcd_barrier(const XcdBarrier& b) {
    asm volatile("s_waitcnt vmcnt(0)" ::: "memory");
    __syncthreads();
    if (threadIdx.x == 0) {
        unsigned* bar = b.bar;
        __builtin_amdgcn_s_waitcnt(0);
        unsigned nloc = b.st[0], nx = b.st[1];
        if (nloc == 0u) { xcd_barrier_complete(bar, b.x, nloc, nx); b.st[0] = nloc; b.st[1] = nx; }
        const unsigned old = xb_add(&bar[XB_XSUB(b.x)], 1u);
        const unsigned gen = old / nloc;
        if (old + 1u == (gen + 1u) * nloc) {
            __builtin_amdgcn_fence(__ATOMIC_RELEASE, "agent");
            asm volatile("s_waitcnt vmcnt(0)" ::: "memory");
            const unsigned og = xb_add(&bar[XB_TOP], 1u);
            const unsigned tg = og / nx;
            if (og + 1u == (tg + 1u) * nx) xb_add(&bar[XB_TOPGEN], 1u);
            else XB_SPIN(xb_ld(&bar[XB_TOPGEN]) == tg, bar);
            __builtin_amdgcn_fence(__ATOMIC_ACQUIRE, "agent");
            xb_add(&bar[XB_XGEN(b.x)], 1u);
            asm volatile("s_waitcnt vmcnt(0)" ::: "memory");
        } else {
            XB_SPIN(xb_ld(&bar[XB_XGEN(b.x)]) == gen, bar);
            __builtin_amdgcn_fence(__ATOMIC_ACQUIRE, "agent");
            asm volatile("s_waitcnt vmcnt(0)" ::: "memory");
        }
    }
    __syncthreads();
}

constexpr int NWAVES = 8;
constexpr int NB = 8, SEQ = 4096, D = 1024, M = NB * SEQ, FF = 2816, FF2 = 2 * FF, DC = 512, DR = 512, NH = 8, HD = 64, CW = 31, RW = 4, NMIX = 2048;
constexpr float EPS = 1e-6f;
constexpr int LDM = 11 * D;
constexpr size_t MiB = 1u << 20;
constexpr size_t WS_CTL = 0, CTL_ZERO_BYTES = 1 * MiB;
constexpr size_t WS_MOD = 1 * MiB;
constexpr size_t WS_BIAS1 = 1 * MiB + 512 * 1024;
constexpr size_t WS_BIAS3 = 1 * MiB + 768 * 1024;
constexpr size_t WS_BIAS2 = 2 * MiB;
constexpr size_t WS_WGT = 2 * MiB + 128 * 1024;
constexpr size_t WS_CS1 = 2 * MiB + 384 * 1024, WS_CS3 = 2 * MiB + 448 * 1024;
constexpr size_t WS_RS1 = 2 * MiB + 512 * 1024, WS_RS3 = 2 * MiB + 640 * 1024;
constexpr size_t WS_CS2 = 2 * MiB + 480 * 1024, WS_RS2 = 2 * MiB + 768 * 1024;
constexpr size_t WS_TOT = 3 * MiB;
constexpr size_t WS_SSP = 5 * MiB;
constexpr size_t WS_W1I = 8 * MiB, WS_W1O = 19 * MiB, WS_WIN = 25 * MiB, WS_WOUT = 29 * MiB, WS_W2I = 31 * MiB, WS_W2O = 42 * MiB;
constexpr size_t WS_Y = 48 * MiB;
constexpr size_t WS_X1 = 112 * MiB;
constexpr size_t WS_ACT = 240 * MiB;
constexpr size_t WS_U = WS_ACT, WS_UX = WS_ACT + 32 * MiB, WS_GY = WS_ACT + 64 * MiB, WS_YMIX = WS_ACT + 96 * MiB;
constexpr size_t WS_SSPF = 416 * MiB;
constexpr size_t WS_SSPX = 418 * MiB;
constexpr size_t WS_SSPX3 = 422 * MiB;
constexpr size_t WS_END = 426 * MiB;
constexpr int CW_BAR = 4096, CW_SEAM = 16384, CW_SCAN = 32768, CW_SEAM7 = 49152, CW_SEAM3 = 65536;
constexpr int LDS_BYTES = 147456;
constexpr int LDSCTL_OFF = LDS_BYTES - 256;

typedef unsigned short u16;
typedef float f32x16 __attribute__((ext_vector_type(16)));
typedef float f32x2 __attribute__((ext_vector_type(2)));

__device__ __forceinline__ float wave_sum(float v) {
#pragma unroll
    for (int o = 1; o < 64; o <<= 1) v += __shfl_xor(v, o);
    return v;
}
__device__ __forceinline__ float sigmoid_fast(float x) { return __builtin_amdgcn_rcpf(1.f + __builtin_amdgcn_exp2f(-1.4426950408889634f * x)); }
__device__ __forceinline__ float silu_fast(float x) { return x * sigmoid_fast(x); }
__device__ __forceinline__ float gelu_tanh_fast(float x) { const float z = 0.7978845608028654f * (x + 0.044715f * x * x * x); return x * sigmoid_fast(2.f * z); }
__device__ __forceinline__ f32x4 sigmoid4(const f32x4 x) { const f32x4 t = x * -1.4426950408889634f; f32x4 e = {__builtin_amdgcn_exp2f(t[0]), __builtin_amdgcn_exp2f(t[1]), __builtin_amdgcn_exp2f(t[2]), __builtin_amdgcn_exp2f(t[3])};
    e = e + 1.0f; return (f32x4){__builtin_amdgcn_rcpf(e[0]), __builtin_amdgcn_rcpf(e[1]), __builtin_amdgcn_rcpf(e[2]), __builtin_amdgcn_rcpf(e[3])}; }
__device__ __forceinline__ f32x4 gelu_tanh4(const f32x4 x) { const f32x4 z2 = (x + (x * x) * x * 0.044715f) * (2.0f * 0.7978845608028654f); return x * sigmoid4(z2); }
__device__ __forceinline__ float bflo(unsigned w) { return __uint_as_float(w << 16); }
__device__ __forceinline__ float bfhi(unsigned w) { return __uint_as_float(w & 0xffff0000u); }
__device__ __forceinline__ unsigned cvtpk(float lo, float hi) { return pg8::cvt_pk_bf16(lo, hi); }
__device__ __forceinline__ v4u pack8(const f32x4 a, const f32x4 b) { v4u w; w.x = cvtpk(a[0], a[1]); w.y = cvtpk(a[2], a[3]); w.z = cvtpk(b[0], b[1]); w.w = cvtpk(b[2], b[3]); return w; }

__device__ __forceinline__ void unpack8(const v4u w, f32x4& a, f32x4& b) { a = (f32x4){bflo(w.x), bfhi(w.x), bflo(w.y), bfhi(w.y)}; b = (f32x4){bflo(w.z), bfhi(w.z), bflo(w.w), bfhi(w.w)}; }
__device__ __forceinline__ unsigned q8(float v) { int q = (int)__builtin_rintf(v); q = q < -127 ? -127 : (q > 127 ? 127 : q); return (unsigned)q & 0xffu; }
__device__ __forceinline__ unsigned q8x4(const f32x4 v) { return q8(v[0]) | (q8(v[1]) << 8) | (q8(v[2]) << 16) | (q8(v[3]) << 24); }
__device__ __forceinline__ float wave_max(float v) {
#pragma unroll
    for (int o = 1; o < 64; o <<= 1) v = fmaxf(v, __shfl_xor(v, o));
    return v;
}
typedef int i32x4v __attribute__((ext_vector_type(4)));
__device__ __forceinline__ f32x4 acc_i2f(const f32x4 a) { return __builtin_convertvector(__builtin_bit_cast(i32x4v, a), f32x4); }
__device__ __forceinline__ float clamp448(float v) { return __builtin_fminf(__builtin_fmaxf(v, -448.0f), 448.0f); }
__device__ __forceinline__ unsigned f8x4(const f32x4 v) { int w = __builtin_amdgcn_cvt_pk_fp8_f32(clamp448(v[0]), clamp448(v[1]), 0, false); w = __builtin_amdgcn_cvt_pk_fp8_f32(clamp448(v[2]), clamp448(v[3]), w, true); return (unsigned)w; }
constexpr float F8_ACT_SCALE = 8.0f, F8_W_SCALE = 2048.0f;
__device__ __forceinline__ void load_rstd(const float* ssp, int row0, int fq, float (&rs)[2][4]) {
#pragma unroll
    for (int ai = 0; ai < 2; ++ai)
#pragma unroll
        for (int m = 0; m < 4; ++m) { const f32x4 p = *(const f32x4*)(ssp + (size_t)(row0 + ai * 128 + m * 16) * 16 + 4 * fq);
            float s = (p[0] + p[1]) + (p[2] + p[3]); s += __shfl_xor(s, 16); s += __shfl_xor(s, 32); rs[ai][m] = rsqrtf(s * (1.0f / D) + EPS); }
}
__device__ __forceinline__ void load_rstd_sc1(const float* ssp, int row0, int fq, float (&rs)[2][4]) {
#pragma unroll
    for (int ai = 0; ai < 2; ++ai)
#pragma unroll
        for (int m = 0; m < 4; ++m) { const gu32* p = (const gu32*)(ssp + (size_t)(row0 + ai * 128 + m * 16) * 16 + 4 * fq);
            const float p0 = __uint_as_float(__hip_atomic_load(p, RLX_AGENT)), p1 = __uint_as_float(__hip_atomic_load(p + 1, RLX_AGENT)), p2 = __uint_as_float(__hip_atomic_load(p + 2, RLX_AGENT)), p3 = __uint_as_float(__hip_atomic_load(p + 3, RLX_AGENT));
            float s = (p0 + p1) + (p2 + p3); s += __shfl_xor(s, 16); s += __shfl_xor(s, 32); rs[ai][m] = rsqrtf(s * (1.0f / D) + EPS); }
}
#ifndef MK_EPI_SWIGLU_REPS
#define MK_EPI_SWIGLU_REPS 1
#endif
#ifndef MK_EPI_RESID_REPS
#define MK_EPI_RESID_REPS 1
#endif
struct EpiSwiglu {
    static constexpr bool PERM = true, AFTER_DRAIN = false; static constexpr int REPS = MK_EPI_SWIGLU_REPS;
    pg8::bf16_t* act; const float* ssp; const float* bias;
    __device__ __forceinline__ void operator()(const f32x4 (&acc)[2][2][4][2], const pg8::Unit& u, int wr, int wc, int fr, int fq) const {
        const int row0 = u.pm * 256 + wr * 64 + fr, b = u.pm >> 4;
        float rs[2][4]; load_rstd(ssp, row0, fq, rs);
        const float* bp = bias + (size_t)b * FF2 + u.pn * 256 + wc * 32 + 8 * fq;
        const f32x4 bg0 = *(const f32x4*)(bp), bg1 = *(const f32x4*)(bp + 4), bu0 = *(const f32x4*)(bp + 128), bu1 = *(const f32x4*)(bp + 132);
        const int oc = u.pn * 128 + wc * 32 + 8 * fq;
#pragma unroll
        for (int ai = 0; ai < 2; ++ai)
#pragma unroll
            for (int m = 0; m < 4; ++m) { const float r = rs[ai][m];
                const f32x4 g0 = acc[ai][0][m][0] * r + bg0, g1 = acc[ai][0][m][1] * r + bg1, u0 = acc[ai][1][m][0] * r + bu0, u1 = acc[ai][1][m][1] * r + bu1;
                const f32x4 a0 = (g0 * sigmoid4(g0)) * u0, a1 = (g1 * sigmoid4(g1)) * u1;
                *(v4u*)(act + (size_t)(row0 + ai * 128 + m * 16) * FF + oc) = pack8(a0, a1); }
    }
};
template <bool OUT8> struct EpiSwiglu8 {
    static constexpr bool PERM = true, AFTER_DRAIN = false; static constexpr int REPS = 1;
    pg8::bf16_t* act; const float* rs; const float* cs; const float* bias;
    __device__ __forceinline__ void operator()(const f32x4 (&acc)[2][2][4][2], const pg8::Unit& u, int wr, int wc, int fr, int fq) const {
        const int row0 = u.pm * 256 + wr * 64 + fr, b = u.pm >> 4;
        float rv[2][4];
#pragma unroll
        for (int ai = 0; ai < 2; ++ai)
#pragma unroll
            for (int m = 0; m < 4; ++m) rv[ai][m] = rs[row0 + ai * 128 + m * 16];
        const int cb = u.pn * 256 + wc * 32 + 8 * fq;
        const float* bp = bias + (size_t)b * FF2 + cb; const float* cp = cs + cb;
        const f32x4 bg0 = *(const f32x4*)(bp), bg1 = *(const f32x4*)(bp + 4), bu0 = *(const f32x4*)(bp + 128), bu1 = *(const f32x4*)(bp + 132);
        const f32x4 cg0 = *(const f32x4*)(cp), cg1 = *(const f32x4*)(cp + 4), cu0 = *(const f32x4*)(cp + 128), cu1 = *(const f32x4*)(cp + 132);
        const int oc = u.pn * 128 + wc * 32 + 8 * fq;
#pragma unroll
        for (int ai = 0; ai < 2; ++ai)
#pragma unroll
            for (int m = 0; m < 4; ++m) { const float r = rv[ai][m];
                const f32x4 g0 = acc_i2f(acc[ai][0][m][0]) * (cg0 * r) + bg0, g1 = acc_i2f(acc[ai][0][m][1]) * (cg1 * r) + bg1;
                const f32x4 u0 = acc_i2f(acc[ai][1][m][0]) * (cu0 * r) + bu0, u1 = acc_i2f(acc[ai][1][m][1]) * (cu1 * r) + bu1;
                const f32x4 a0 = (g0 * sigmoid4(g0)) * u0, a1 = (g1 * sigmoid4(g1)) * u1;
                if (OUT8) *(unsigned long long*)((unsigned char*)act + (size_t)(row0 + ai * 128 + m * 16) * FF + oc) = (unsigned long long)f8x4(a0 * F8_ACT_SCALE) | ((unsigned long long)f8x4(a1 * F8_ACT_SCALE) << 32);
                else *(v4u*)(act + (size_t)(row0 + ai * 128 + m * 16) * FF + oc) = pack8(a0, a1); }
    }
};
template <int WHALF, bool HASY, bool IN16> struct EpiResid {
    static constexpr bool PERM = true, AFTER_DRAIN = false; static constexpr int REPS = (IN16 ? 1 : MK_EPI_RESID_REPS);
    static constexpr float w = WHALF ? 0.5f : 1.0f;
    const void* xin; pg8::bf16_t* xout; pg8::bf16_t* y; float* ssp; const float* gt; const float* gnext; const float* scnext;
    __device__ __forceinline__ void operator()(const f32x4 (&acc)[2][2][4][2], const pg8::Unit& u, int wr, int wc, int fr, int fq) const {
        const int row0 = u.pm * 256 + wr * 64 + fr, b = u.pm >> 4;
        float ss[2][4];
#pragma unroll
        for (int ai = 0; ai < 2; ++ai)
#pragma unroll
            for (int m = 0; m < 4; ++m) ss[ai][m] = 0.f;
#pragma unroll
        for (int bj = 0; bj < 2; ++bj) { const int c0 = u.pn * 256 + bj * 128 + wc * 32 + 8 * fq;
            const f32x4 gt0 = *(const f32x4*)(gt + (size_t)b * LDM + c0) * w, gt1 = *(const f32x4*)(gt + (size_t)b * LDM + c0 + 4) * w;
            f32x4 gs0 = {0.f, 0.f, 0.f, 0.f}, gs1 = gs0;
            if (HASY) { gs0 = *(const f32x4*)(gnext + c0) * (*(const f32x4*)(scnext + (size_t)b * LDM + c0) + 1.0f); gs1 = *(const f32x4*)(gnext + c0 + 4) * (*(const f32x4*)(scnext + (size_t)b * LDM + c0 + 4) + 1.0f); }
#pragma unroll
            for (int ai = 0; ai < 2; ++ai)
#pragma unroll
                for (int m = 0; m < 4; ++m) { const size_t off = (size_t)(row0 + ai * 128 + m * 16) * D + c0;
                    f32x4 x0, x1;
                    if (IN16) unpack8(*(const v4u*)((const pg8::bf16_t*)xin + off), x0, x1); else { x0 = *(const f32x4*)((const float*)xin + off); x1 = *(const f32x4*)((const float*)xin + off + 4); }
                    const f32x4 o0 = x0 + gt0 * acc[ai][bj][m][0], o1 = x1 + gt1 * acc[ai][bj][m][1];
                    *(v4u*)(xout + off) = pack8(o0, o1);
                    ss[ai][m] += (o0[0] * o0[0] + o0[1] * o0[1]) + (o0[2] * o0[2] + o0[3] * o0[3]) + (o1[0] * o1[0] + o1[1] * o1[1]) + (o1[2] * o1[2] + o1[3] * o1[3]);
                    if (HASY) *(v4u*)(y + off) = pack8(o0 * gs0, o1 * gs1); } }
#pragma unroll
        for (int ai = 0; ai < 2; ++ai)
#pragma unroll
            for (int m = 0; m < 4; ++m) { float s = ss[ai][m]; s += __shfl_xor(s, 16); s += __shfl_xor(s, 32);
                if (fq == 0) ssp[(size_t)(row0 + ai * 128 + m * 16) * 16 + u.pn * 4 + wc] = s; }
    }
};
template <int WHALF, bool IN16> struct EpiResidQ {
    static constexpr bool PERM = true, AFTER_DRAIN = false; static constexpr int REPS = 1;
    static constexpr float w = WHALF ? 0.5f : 1.0f;
    const void* xin; pg8::bf16_t* xout; unsigned char* a8; float* rs; f32x2* sspx; const float* gt; const float* gnext; const float* scnext; unsigned* cnt;
    __device__ __forceinline__ void operator()(f32x4 (&acc)[2][2][4][2], const pg8::Unit& u, int wr, int wc, int fr, int fq) const {
        const int row0 = u.pm * 256 + wr * 64 + fr, b = u.pm >> 4;
        float ss[2][4], am[2][4];
#pragma unroll
        for (int ai = 0; ai < 2; ++ai)
#pragma unroll
            for (int m = 0; m < 4; ++m) { ss[ai][m] = 0.f; am[ai][m] = 0.f; }
        const unsigned voff = (unsigned)((row0 * D + u.pn * 256 + wc * 32 + 8 * fq) * 2);
        unsigned vo[4] = {voff, voff, voff, voff};
#pragma unroll
        for (int bj = 0; bj < 2; ++bj) { const int c0 = u.pn * 256 + bj * 128 + wc * 32 + 8 * fq;
            const f32x4 gt0 = *(const f32x4*)(gt + (size_t)b * LDM + c0) * w, gt1 = *(const f32x4*)(gt + (size_t)b * LDM + c0 + 4) * w;
            const f32x4 gs0 = *(const f32x4*)(gnext + c0) * (*(const f32x4*)(scnext + (size_t)b * LDM + c0) + 1.0f), gs1 = *(const f32x4*)(gnext + c0 + 4) * (*(const f32x4*)(scnext + (size_t)b * LDM + c0 + 4) + 1.0f);
#pragma unroll
            for (int ai = 0; ai < 2; ++ai)
#pragma unroll
                for (int m = 0; m < 4; ++m) { const unsigned so = (unsigned)(((ai * 128 + m * 16) * D + bj * 128) * 2); const int g = m & 3;
                    f32x4 x0, x1;
                    if (IN16) unpack8(*(const v4u*)((const char*)xin + (size_t)(vo[g] + so)), x0, x1);
                    else { const char* p = (const char*)xin + 2 * (size_t)(vo[g] + so); x0 = *(const f32x4*)p; x1 = *(const f32x4*)(p + 16); }
                    const f32x4 o0 = x0 + gt0 * acc[ai][bj][m][0], o1 = x1 + gt1 * acc[ai][bj][m][1];
                    *(v4u*)((char*)xout + (size_t)(vo[g] + so)) = pack8(o0, o1);
                    acc[ai][bj][m][0] = o0; acc[ai][bj][m][1] = o1;
                    ss[ai][m] += (o0[0] * o0[0] + o0[1] * o0[1]) + (o0[2] * o0[2] + o0[3] * o0[3]) + (o1[0] * o1[0] + o1[1] * o1[1]) + (o1[2] * o1[2] + o1[3] * o1[3]);
                    const f32x4 t0 = __builtin_elementwise_abs(o0 * gs0), t1 = __builtin_elementwise_abs(o1 * gs1);
                    am[ai][m] = fmaxf(am[ai][m], fmaxf(fmaxf(fmaxf(t0[0], t0[1]), fmaxf(t0[2], t0[3])), fmaxf(fmaxf(t1[0], t1[1]), fmaxf(t1[2], t1[3]))));
                    asm volatile("" : "+v"(vo[g]) : "v"(ss[ai][m])); } }
#pragma unroll
        for (int ai = 0; ai < 2; ++ai)
#pragma unroll
            for (int m = 0; m < 4; ++m) { float s = ss[ai][m], a = am[ai][m]; s += __shfl_xor(s, 16); s += __shfl_xor(s, 32); a = fmaxf(a, __shfl_xor(a, 16)); a = fmaxf(a, __shfl_xor(a, 32));
                if (fq == 0) __hip_atomic_store((gu64*)(sspx + (size_t)(row0 + ai * 128 + m * 16) * 16 + u.pn * 4 + wc), ((unsigned long long)__float_as_uint(a) << 32) | __float_as_uint(s), RLX_AGENT); }
        asm volatile("s_waitcnt vmcnt(0)" ::: "memory");
        unsigned* cw = cnt + 64 * u.pm;
        if ((threadIdx.x & 63) == 0) __hip_atomic_fetch_add(cw, 1u, __ATOMIC_RELAXED, __HIP_MEMORY_SCOPE_AGENT);
        if (threadIdx.x < 64) {
            unsigned sp = 0;
            while ((unsigned)__builtin_amdgcn_readfirstlane(__hip_atomic_load(cw, __ATOMIC_RELAXED, __HIP_MEMORY_SCOPE_AGENT)) < 32u) { __builtin_amdgcn_s_sleep(1); if (++sp > (1u << 20)) break; }
            __builtin_amdgcn_fence(__ATOMIC_ACQUIRE, "agent");
            asm volatile("s_waitcnt vmcnt(0)" ::: "memory");
        }
        asm volatile("" ::: "memory"); __builtin_amdgcn_s_barrier(); asm volatile("" ::: "memory");
        float qs[2][4];
#pragma unroll
        for (int ai = 0; ai < 2; ++ai)
#pragma unroll
            for (int m = 0; m < 4; ++m) { const int row = row0 + ai * 128 + m * 16; const gu64* p = (const gu64*)(sspx + (size_t)row * 16 + 4 * fq);
                float s = 0.f, a = 0.f;
#pragma unroll
                for (int e = 0; e < 4; ++e) { const unsigned long long t = __hip_atomic_load(p + e, RLX_AGENT); s += __uint_as_float((unsigned)t); a = fmaxf(a, __uint_as_float((unsigned)(t >> 32))); }
                s += __shfl_xor(s, 16); s += __shfl_xor(s, 32); a = fmaxf(a, __shfl_xor(a, 16)); a = fmaxf(a, __shfl_xor(a, 32));
                qs[ai][m] = a > 0.f ? 127.0f / a : 0.f;
                if (u.pn == 0 && wc == 0 && fq == 0) rs[row] = rsqrtf(s * (1.0f / D) + EPS) * a * (1.0f / 127.0f); }
        const unsigned voff8 = (unsigned)(row0 * D + u.pn * 256 + wc * 32 + 8 * fq);
#pragma unroll
        for (int bj = 0; bj < 2; ++bj) { const int c0 = u.pn * 256 + bj * 128 + wc * 32 + 8 * fq;
            const f32x4 gs0 = *(const f32x4*)(gnext + c0) * (*(const f32x4*)(scnext + (size_t)b * LDM + c0) + 1.0f), gs1 = *(const f32x4*)(gnext + c0 + 4) * (*(const f32x4*)(scnext + (size_t)b * LDM + c0 + 4) + 1.0f);
#pragma unroll
            for (int ai = 0; ai < 2; ++ai)
#pragma unroll
                for (int m = 0; m < 4; ++m) { const float q = qs[ai][m]; const unsigned so = (unsigned)((ai * 128 + m * 16) * D + bj * 128);
                    *(unsigned long long*)(a8 + (size_t)(voff8 + so)) = (unsigned long long)q8x4(acc[ai][bj][m][0] * gs0 * q) | ((unsigned long long)q8x4(acc[ai][bj][m][1] * gs1 * q) << 32); } }
    }
};
template <bool F8> struct EpiResidFinal {
    static constexpr bool PERM = true, AFTER_DRAIN = false; static constexpr int REPS = 1;
    static constexpr float ascale = F8 ? 1.0f / (F8_ACT_SCALE * F8_W_SCALE) : 1.0f;
    const pg8::bf16_t* xin; float* out; float* ssp; const float* gt; const float* gf; const float* fsc; const float* fsh; unsigned* cnt;
    __device__ __forceinline__ void operator()(f32x4 (&acc)[2][2][4][2], const pg8::Unit& u, int wr, int wc, int fr, int fq) const {
        const int row0 = u.pm * 256 + wr * 64 + fr, b = u.pm >> 4;
        const __amdgpu_buffer_rsrc_t rx = __builtin_amdgcn_make_buffer_rsrc((void*)xin, 0, M * D * 4, 0x00020000), ro = __builtin_amdgcn_make_buffer_rsrc((void*)out, 0, M * D * 4, 0x00020000);
        const unsigned voff = (unsigned)((row0 * D + u.pn * 256 + wc * 32 + 8 * fq) * 4);
        float ss[2][4];
#pragma unroll
        for (int ai = 0; ai < 2; ++ai)
#pragma unroll
            for (int m = 0; m < 4; ++m) ss[ai][m] = 0.f;
        unsigned vo[4] = {voff, voff, voff, voff};
#pragma unroll
        for (int bj = 0; bj < 2; ++bj) { const int c0 = u.pn * 256 + bj * 128 + wc * 32 + 8 * fq;
            const float hw = 0.5f * ascale; const f32x4 gt0 = *(const f32x4*)(gt + (size_t)b * LDM + c0) * hw, gt1 = *(const f32x4*)(gt + (size_t)b * LDM + c0 + 4) * hw;
#pragma unroll
            for (int ai = 0; ai < 2; ++ai)
#pragma unroll
                for (int m = 0; m < 4; ++m) { const unsigned so = (unsigned)(((ai * 128 + m * 16) * D + bj * 128) * 4); const int g = m & 3;
                    f32x4 x0, x1; unpack8(*(const v4u*)((const char*)xin + (size_t)((vo[g] + so) >> 1)), x0, x1);
                    const f32x4 o0 = x0 + gt0 * acc[ai][bj][m][0], o1 = x1 + gt1 * acc[ai][bj][m][1];
                    acc[ai][bj][m][0] = o0; acc[ai][bj][m][1] = o1;
                    ss[ai][m] += (o0[0] * o0[0] + o0[1] * o0[1]) + (o0[2] * o0[2] + o0[3] * o0[3]) + (o1[0] * o1[0] + o1[1] * o1[1]) + (o1[2] * o1[2] + o1[3] * o1[3]);
                    asm volatile("" : "+v"(vo[g]) : "v"(ss[ai][m])); } }
#pragma unroll
        for (int ai = 0; ai < 2; ++ai)
#pragma unroll
            for (int m = 0; m < 4; ++m) { float s = ss[ai][m]; s += __shfl_xor(s, 16); s += __shfl_xor(s, 32);
                if (fq == 0) __hip_atomic_store((gu32*)(ssp + (size_t)(row0 + ai * 128 + m * 16) * 16 + u.pn * 4 + wc), __float_as_uint(s), RLX_AGENT); }
        asm volatile("s_waitcnt vmcnt(0)" ::: "memory");
        unsigned* cw = cnt + 64 * u.pm;
        if ((threadIdx.x & 63) == 0) __hip_atomic_fetch_add(cw, 1u, __ATOMIC_RELAXED, __HIP_MEMORY_SCOPE_AGENT);
        if (threadIdx.x < 64) {
            unsigned sp = 0;
            while ((unsigned)__builtin_amdgcn_readfirstlane(__hip_atomic_load(cw, __ATOMIC_RELAXED, __HIP_MEMORY_SCOPE_AGENT)) < 32u) { __builtin_amdgcn_s_sleep(1); if (++sp > (1u << 20)) break; }
            __builtin_amdgcn_fence(__ATOMIC_ACQUIRE, "agent");
            asm volatile("s_waitcnt vmcnt(0)" ::: "memory");
        }
        asm volatile("" ::: "memory"); __builtin_amdgcn_s_barrier(); asm volatile("" ::: "memory");
        float rs[2][4]; load_rstd_sc1(ssp, row0, fq, rs);
#pragma unroll
        for (int bj = 0; bj < 2; ++bj) { const int c0 = u.pn * 256 + bj * 128 + wc * 32 + 8 * fq;
            const f32x4 gs0 = *(const f32x4*)(gf + c0) * (*(const f32x4*)(fsc + (size_t)b * LDM + c0) + 1.0f), gs1 = *(const f32x4*)(gf + c0 + 4) * (*(const f32x4*)(fsc + (size_t)b * LDM + c0 + 4) + 1.0f);
            const f32x4 sh0 = *(const f32x4*)(fsh + (size_t)b * LDM + c0), sh1 = *(const f32x4*)(fsh + (size_t)b * LDM + c0 + 4);
#pragma unroll
            for (int ai = 0; ai < 2; ++ai)
#pragma unroll
                for (int m = 0; m < 4; ++m) { const unsigned so = (unsigned)(((ai * 128 + m * 16) * D + bj * 128) * 4); const float r = rs[ai][m];
                    *(f32x4*)((char*)out + (size_t)voff + so) = acc[ai][bj][m][0] * r * gs0 + sh0;
                    *(f32x4*)((char*)out + (size_t)voff + so + 16) = acc[ai][bj][m][1] * r * gs1 + sh1; } }
    }
};
struct EpiMixIn {
    static constexpr bool PERM = true, AFTER_DRAIN = false; static constexpr int REPS = 1;
    pg8::bf16_t *U, *UX, *GY; const float* ssp; const float* bias;
    __device__ __forceinline__ void operator()(const f32x4 (&acc)[2][2][4][2], const pg8::Unit& u, int wr, int wc, int fr, int fq) const {
        const int row0 = u.pm * 256 + wr * 64 + fr, b = u.pm >> 4;
        float rs[2][4]; load_rstd(ssp, row0, fq, rs);
        const float* bp = bias + (size_t)b * NMIX + u.pn * 256 + wc * 32 + 8 * fq;
        const f32x4 b00 = *(const f32x4*)(bp), b01 = *(const f32x4*)(bp + 4), b10 = *(const f32x4*)(bp + 128), b11 = *(const f32x4*)(bp + 132);
        if (u.pn < 4) {
            const int oc = u.pn * 128 + wc * 32 + 8 * fq;
#pragma unroll
            for (int ai = 0; ai < 2; ++ai)
#pragma unroll
                for (int m = 0; m < 4; ++m) { const float r = rs[ai][m];
                    const f32x4 v0 = acc[ai][0][m][0] * r + b00, v1 = acc[ai][0][m][1] * r + b01, g0 = acc[ai][1][m][0] * r + b10, g1 = acc[ai][1][m][1] * r + b11;
                    const f32x4 a0 = v0 * sigmoid4(g0), a1 = v1 * sigmoid4(g1);
                    *(v4u*)(U + (size_t)(row0 + ai * 128 + m * 16) * DC + oc) = pack8(a0, a1); }
        } else {
            pg8::bf16_t* dst = (u.pn < 6) ? UX : GY; const bool gel = u.pn >= 6; const int pc = (u.pn & 1) * 256 + wc * 32 + 8 * fq;
#pragma unroll
            for (int ai = 0; ai < 2; ++ai)
#pragma unroll
                for (int m = 0; m < 4; ++m) { const float r = rs[ai][m];
#pragma unroll
                    for (int bj = 0; bj < 2; ++bj) { f32x4 v0 = acc[ai][bj][m][0] * r + (bj ? b10 : b00), v1 = acc[ai][bj][m][1] * r + (bj ? b11 : b01);
                        if (gel) { v0 = gelu_tanh4(v0); v1 = gelu_tanh4(v1); }
                        *(v4u*)(dst + (size_t)(row0 + ai * 128 + m * 16) * DR + pc + bj * 128) = pack8(v0, v1); } }
        }
    }
};

struct EpiMixIn8 {
    static constexpr bool PERM = true, AFTER_DRAIN = false; static constexpr int REPS = 1;
    pg8::bf16_t *U, *UX, *GY; const float* rs; const float* cs; const float* bias;
    __device__ __forceinline__ void operator()(const f32x4 (&acc)[2][2][4][2], const pg8::Unit& u, int wr, int wc, int fr, int fq) const {
        const int row0 = u.pm * 256 + wr * 64 + fr, b = u.pm >> 4;
        float rv[2][4];
#pragma unroll
        for (int ai = 0; ai < 2; ++ai)
#pragma unroll
            for (int m = 0; m < 4; ++m) rv[ai][m] = rs[row0 + ai * 128 + m * 16];
        const int cb = u.pn * 256 + wc * 32 + 8 * fq;
        const float* bp = bias + (size_t)b * NMIX + cb; const float* cp = cs + cb;
        const f32x4 b00 = *(const f32x4*)(bp), b01 = *(const f32x4*)(bp + 4), b10 = *(const f32x4*)(bp + 128), b11 = *(const f32x4*)(bp + 132);
        const f32x4 c00 = *(const f32x4*)(cp), c01 = *(const f32x4*)(cp + 4), c10 = *(const f32x4*)(cp + 128), c11 = *(const f32x4*)(cp + 132);
        if (u.pn < 4) {
            const int oc = u.pn * 128 + wc * 32 + 8 * fq;
#pragma unroll
            for (int ai = 0; ai < 2; ++ai)
#pragma unroll
                for (int m = 0; m < 4; ++m) { const float r = rv[ai][m];
                    const f32x4 v0 = acc_i2f(acc[ai][0][m][0]) * (c00 * r) + b00, v1 = acc_i2f(acc[ai][0][m][1]) * (c01 * r) + b01;
                    const f32x4 g0 = acc_i2f(acc[ai][1][m][0]) * (c10 * r) + b10, g1 = acc_i2f(acc[ai][1][m][1]) * (c11 * r) + b11;
                    const f32x4 a0 = v0 * sigmoid4(g0), a1 = v1 * sigmoid4(g1);
                    *(v4u*)(U + (size_t)(row0 + ai * 128 + m * 16) * DC + oc) = pack8(a0, a1); }
        } else {
            pg8::bf16_t* dst = (u.pn < 6) ? UX : GY; const bool gel = u.pn >= 6; const int pc = (u.pn & 1) * 256 + wc * 32 + 8 * fq;
#pragma unroll
            for (int ai = 0; ai < 2; ++ai)
#pragma unroll
                for (int m = 0; m < 4; ++m) { const float r = rv[ai][m];
#pragma unroll
                    for (int bj = 0; bj < 2; ++bj) { f32x4 v0 = acc_i2f(acc[ai][bj][m][0]) * ((bj ? c10 : c00) * r) + (bj ? b10 : b00), v1 = acc_i2f(acc[ai][bj][m][1]) * ((bj ? c11 : c01) * r) + (bj ? b11 : b01);
                        if (gel) { v0 = gelu_tanh4(v0); v1 = gelu_tanh4(v1); }
                        *(v4u*)(dst + (size_t)(row0 + ai * 128 + m * 16) * DR + pc + bj * 128) = pack8(v0, v1); } }
        }
    }
};

__device__ __forceinline__ void p0_gemv(LAS unsigned char* lds, const float* c, const float* W, int NC, const float* bias, float* out, int j0, int tid) {
    LAS float* ca = (LAS float*)lds; LAS float* part = (LAS float*)(lds + 32768);
    for (int i = tid; i < NB * D; i += 512) { const float v = c[i]; ca[i] = v / (1.f + expf(-v)); }
    __syncthreads();
    const int cg = tid & 31, ks = tid >> 5;
    const float* wp = W + (size_t)(64 * ks) * NC + j0 + 4 * cg;
    f32x4 acc[NB];
#pragma unroll
    for (int b = 0; b < NB; ++b) acc[b] = (f32x4){0.f, 0.f, 0.f, 0.f};
#pragma unroll 4
    for (int kk = 0; kk < 64; ++kk) { const f32x4 w = *(const f32x4*)(wp + (size_t)kk * NC);
#pragma unroll
        for (int b = 0; b < NB; ++b) acc[b] += w * ca[b * D + 64 * ks + kk]; }
#pragma unroll
    for (int b = 0; b < NB; ++b) *(LAS f32x4*)(part + (ks * NB + b) * 128 + 4 * cg) = acc[b];
    __syncthreads();
#pragma unroll
    for (int r = 0; r < 2; ++r) { const int o = tid + 512 * r, b = o >> 7, col = o & 127; float s = 0.f;
#pragma unroll
        for (int k2 = 0; k2 < 16; ++k2) s += part[(k2 * NB + b) * 128 + col];
        out[(size_t)b * LDM + j0 + col] = s + bias[j0 + col]; }
    __syncthreads();
}
__device__ __forceinline__ int rowmap(int kind, int n0) {
    if (kind == 1) { const int half = n0 / FF, f = n0 - half * FF; return 256 * (f >> 7) + 128 * half + (f & 127); }
    if (kind == 2 && n0 < 1024) { const int half = n0 >> 9, f = n0 & 511; return 256 * (f >> 7) + 128 * half + (f & 127); }
    return n0;
}
__device__ __forceinline__ void p0_transpose_item(const float* W, int K, int N, bf16* WT, int kind, LAS float* scr, int item, int lane) {
    const int nblk = N / 32, kb = item / nblk, nb = item % nblk, k0 = 64 * kb, n0 = 32 * nb, r0 = rowmap(kind, n0);
#pragma unroll 8
    for (int i = 0; i < 32; ++i) { const int kk = 2 * i + (lane >> 5); scr[kk * 33 + (lane & 31)] = W[(size_t)(k0 + kk) * N + n0 + (lane & 31)]; }
    LDS_WAIT(); asm volatile("" ::: "memory");
    const int c = lane & 7;
#pragma unroll
    for (int j = 0; j < 4; ++j) { const int n = (lane >> 3) + 8 * j; const LAS float* s = scr + (8 * c) * 33 + n;
        v4u o; o.x = pk2(s[0 * 33], s[1 * 33]); o.y = pk2(s[2 * 33], s[3 * 33]); o.z = pk2(s[4 * 33], s[5 * 33]); o.w = pk2(s[6 * 33], s[7 * 33]);
        *(GAS v4u*)(WT + (size_t)(r0 + n) * K + k0 + 8 * c) = o; }
    LDS_WAIT(); asm volatile("" ::: "memory");
}

__device__ __forceinline__ void p0_transpose8_item(const float* W, int K, int N, unsigned char* WT, LAS float* scr, int item, int lane) {
    const int nblk = N / 32, kb = item / nblk, nb = item % nblk, k0 = 64 * kb, n0 = 32 * nb;
#pragma unroll 8
    for (int i = 0; i < 32; ++i) { const int kk = 2 * i + (lane >> 5); scr[kk * 33 + (lane & 31)] = W[(size_t)(k0 + kk) * N + n0 + (lane & 31)]; }
    LDS_WAIT(); asm volatile("" ::: "memory");
    const int n = lane >> 1, kh = (lane & 1) * 32; const LAS float* sp = scr + n;
#pragma unroll
    for (int hq = 0; hq < 2; ++hq) { v4u o;
#pragma unroll
        for (int dq = 0; dq < 4; ++dq) { const int k = kh + 16 * hq + 4 * dq;
            const unsigned w4 = f8x4((f32x4){sp[(k + 0) * 33], sp[(k + 1) * 33], sp[(k + 2) * 33], sp[(k + 3) * 33]} * F8_W_SCALE);
            if (dq == 0) o.x = w4; else if (dq == 1) o.y = w4; else if (dq == 2) o.z = w4; else o.w = w4; }
        *(GAS v4u*)(WT + (size_t)(n0 + n) * K + k0 + kh + 16 * hq) = o; }
    LDS_WAIT(); asm volatile("" ::: "memory");
}
__device__ __forceinline__ void p0_quant_item(LAS unsigned char* lds, const float* W, int N, int kind, unsigned char* W8, float* cs, int nb, int lane, int wave) {
    LAS float* scr = (LAS float*)(lds + wave * 16896);
    LAS float* cm = (LAS float*)(lds + 8 * 16896);
    const int n0 = 32 * nb, r0 = rowmap(kind, n0);
#pragma unroll
    for (int tl = 0; tl < 2; ++tl) { const int k0 = 64 * (2 * wave + tl);
#pragma unroll 8
        for (int i = 0; i < 32; ++i) { const int kk = 2 * i + (lane >> 5); scr[tl * 2112 + kk * 33 + (lane & 31)] = W[(size_t)(k0 + kk) * N + n0 + (lane & 31)]; } }
    LDS_WAIT(); asm volatile("" ::: "memory");
    float mx = 0.f;
#pragma unroll
    for (int tl = 0; tl < 2; ++tl)
#pragma unroll 8
        for (int r = 0; r < 32; ++r) mx = fmaxf(mx, fabsf(scr[tl * 2112 + ((lane >> 5) * 32 + r) * 33 + (lane & 31)]));
    mx = fmaxf(mx, __shfl_xor(mx, 32));
    if (lane < 32) cm[wave * 32 + lane] = mx;
    __syncthreads();
    float cmax = 0.f;
#pragma unroll
    for (int w = 0; w < 8; ++w) cmax = fmaxf(cmax, cm[w * 32 + (lane & 31)]);
    const float sc = cmax > 0.f ? 127.0f / cmax : 0.f;
    if (wave == 0 && lane < 32) cs[r0 + lane] = cmax * (1.0f / 127.0f);
    const int n = lane >> 1, kh = (lane & 1) * 32;
    const float sn = __shfl(sc, n);
#pragma unroll
    for (int tl = 0; tl < 2; ++tl) { const int k0 = 64 * (2 * wave + tl); const LAS float* sp = scr + tl * 2112 + n;
#pragma unroll
        for (int hq = 0; hq < 2; ++hq) { v4u o;
#pragma unroll
            for (int dq = 0; dq < 4; ++dq) { const int k = kh + 16 * hq + 4 * dq;
                const unsigned w4 = q8(sp[(k + 0) * 33] * sn) | (q8(sp[(k + 1) * 33] * sn) << 8) | (q8(sp[(k + 2) * 33] * sn) << 16) | (q8(sp[(k + 3) * 33] * sn) << 24);
                if (dq == 0) o.x = w4; else if (dq == 1) o.y = w4; else if (dq == 2) o.z = w4; else o.w = w4; }
            *(GAS v4u*)(W8 + (size_t)(r0 + n) * D + k0 + kh + 16 * hq) = o; } }
    __syncthreads();
}

__device__ __forceinline__ void mix_conv(LAS unsigned char* lds, const bf16* U, const float* conv_w, const float* conv_b, const float* ln_g, const float* ln_b, bf16* YMIX, int G, int bx, int tid, int lane, int wave) {
    LAS unsigned char* IN = lds;
    LAS f32x4* WA = (LAS f32x4*)(lds + 63488);
    LAS f32x4* WB = WA + 31 * 64;
    for (int i = tid; i < 31 * 64; i += 512) { const int k = i >> 6, l = i & 63; WA[i] = *(const f32x4*)(conv_w + k * DC + 8 * l); WB[i] = *(const f32x4*)(conv_w + k * DC + 8 * l + 4); }
    const f32x4 cb0 = *(const f32x4*)(conv_b + 8 * lane), cb1 = *(const f32x4*)(conv_b + 8 * lane + 4);
    const f32x4 lg0 = *(const f32x4*)(ln_g + 8 * lane), lg1 = *(const f32x4*)(ln_g + 8 * lane + 4);
    const f32x4 lb0 = *(const f32x4*)(ln_b + 8 * lane), lb1 = *(const f32x4*)(ln_b + 8 * lane + 4);
    v4u pre[8];
#pragma unroll
    for (int i = 0; i < 8; ++i) { const int q = tid + 512 * i, row = q >> 6, ch = q & 63, tok = (bx & 127) * 32 - 30 + row; pre[i] = (v4u){0u, 0u, 0u, 0u};
        if (bx < NB * (SEQ / 32) && q < 62 * 64 && tok >= 0) pre[i] = *(const v4u*)(U + ((size_t)((bx >> 7) * SEQ + tok)) * DC + 8 * ch); }
    for (int item = bx; item < NB * (SEQ / 32); item += G) {
        const int b = item >> 7, t0 = (item & 127) * 32;
        __syncthreads();
#pragma unroll
        for (int i = 0; i < 8; ++i) { const int q = tid + 512 * i; if (q < 62 * 64) *(LAS v4u*)(IN + (q >> 6) * 1024 + (q & 63) * 16) = pre[i]; }
        { const int nitem = item + G, nb = nitem >> 7, nt0 = (nitem & 127) * 32;
#pragma unroll
            for (int i = 0; i < 8; ++i) { const int q = tid + 512 * i, row = q >> 6, ch = q & 63, tok = nt0 - 30 + row; pre[i] = (v4u){0u, 0u, 0u, 0u};
                if (nitem < NB * (SEQ / 32) && q < 62 * 64 && tok >= 0) pre[i] = *(const v4u*)(U + ((size_t)(nb * SEQ + tok)) * DC + 8 * ch); } }
        __syncthreads();
        f32x4 a0[4], a1[4];
#pragma unroll
        for (int tt = 0; tt < 4; ++tt) { a0[tt] = cb0; a1[tt] = cb1; }
        f32x4 wa0 = {0.f, 0.f, 0.f, 0.f}, wa1 = wa0, wa2 = wa0, wa3 = wa0, wb0 = wa0, wb1 = wa0, wb2 = wa0, wb3 = wa0;
#pragma unroll
        for (int kk = 0; kk < 34; ++kk) {
            const v4u v = *(const LAS v4u*)(IN + (4 * wave + kk) * 1024 + lane * 16);
            const f32x4 x0 = {bflo(v.x), bfhi(v.x), bflo(v.y), bfhi(v.y)}, x1 = {bflo(v.z), bfhi(v.z), bflo(v.w), bfhi(v.w)};
            wa3 = wa2; wa2 = wa1; wa1 = wa0; wb3 = wb2; wb2 = wb1; wb1 = wb0;
            if (kk <= 30) { wa0 = WA[kk * 64 + lane]; wb0 = WB[kk * 64 + lane]; } else { wa0 = (f32x4){0.f, 0.f, 0.f, 0.f}; wb0 = wa0; }
            a0[0] += wa0 * x0; a1[0] += wb0 * x1; a0[1] += wa1 * x0; a1[1] += wb1 * x1; a0[2] += wa2 * x0; a1[2] += wb2 * x1; a0[3] += wa3 * x0; a1[3] += wb3 * x1;
        }
#pragma unroll
        for (int tt = 0; tt < 4; ++tt) {
            float s = (a0[tt][0] + a0[tt][1]) + (a0[tt][2] + a0[tt][3]) + (a1[tt][0] + a1[tt][1]) + (a1[tt][2] + a1[tt][3]);
            const float mean = wave_sum(s) * (1.0f / DC);
            const f32x4 d0 = a0[tt] - mean, d1 = a1[tt] - mean;
            float q = (d0[0] * d0[0] + d0[1] * d0[1]) + (d0[2] * d0[2] + d0[3] * d0[3]) + (d1[0] * d1[0] + d1[1] * d1[1]) + (d1[2] * d1[2] + d1[3] * d1[3]);
            const float rstd = rsqrtf(wave_sum(q) * (1.0f / DC) + EPS);
            f32x4 y0 = d0 * rstd * lg0 + lb0, y1 = d1 * rstd * lg1 + lb1;
#pragma unroll
            for (int j = 0; j < 4; ++j) { y0[j] = silu_fast(y0[j]); y1[j] = silu_fast(y1[j]); }
            *(v4u*)(YMIX + ((size_t)(b * SEQ + t0 + 4 * wave + tt)) * D + 8 * lane) = pack8(y0, y1);
        }
    }
    __syncthreads();
}

__device__ __forceinline__ void scan_decode(int it, int& b, int& c) { if (it < 256) { b = it >> 6; c = it & 63; } else { b = 4 + ((it - 256) >> 6); c = 63 - ((it - 256) & 63); } }
__device__ __forceinline__ float neg_expm1(float x, float a) {
    float p = -1.0f / 5040.0f; p = p * x - 1.0f / 720.0f; p = p * x - 1.0f / 120.0f; p = p * x - 1.0f / 24.0f; p = p * x - 1.0f / 6.0f; p = p * x - 0.5f; p = p * x - 1.0f;
    float q = p * x, w = 1.0f - a * a; asm volatile("" : "+v"(q), "+v"(w));
    return x > -0.5f ? q : w;
}
__device__ __forceinline__ void gate_math16(const f32x16 pa, const f32x16 pi, float ba, float bi, float c8, f32x16& av, f32x16& bv) {
#pragma unroll
    for (int g4 = 0; g4 < 4; ++g4) {
        const f32x4 pa4 = {pa[4 * g4], pa[4 * g4 + 1], pa[4 * g4 + 2], pa[4 * g4 + 3]}, pi4 = {pi[4 * g4], pi[4 * g4 + 1], pi[4 * g4 + 2], pi[4 * g4 + 3]};
        const f32x4 rg = sigmoid4(pa4 + ba), ig = sigmoid4(pi4 + bi);
        const f32x4 l2 = rg * c8;
        const f32x4 a = {__builtin_amdgcn_exp2f(l2[0]), __builtin_amdgcn_exp2f(l2[1]), __builtin_amdgcn_exp2f(l2[2]), __builtin_amdgcn_exp2f(l2[3])};
        const f32x4 x = l2 * 1.3862943611198906f;
        f32x4 p = x * (-1.0f / 5040.0f) - 1.0f / 720.0f; p = p * x - 1.0f / 120.0f; p = p * x - 1.0f / 24.0f; p = p * x - 1.0f / 6.0f; p = p * x - 0.5f; p = p * x - 1.0f;
        const f32x4 q = p * x, w = 1.0f - a * a;
        f32x4 m2;
#pragma unroll
        for (int e = 0; e < 4; ++e) m2[e] = __builtin_amdgcn_sqrtf(x[e] > -0.5f ? q[e] : w[e]);
        const f32x4 bb = m2 * ig;
#pragma unroll
        for (int e = 0; e < 4; ++e) { av[4 * g4 + e] = a[e]; bv[4 * g4 + e] = bb[e]; }
        __builtin_amdgcn_sched_barrier(0);
    }
}
template <bool FINAL>
__device__ __forceinline__ void mix_scan(LAS unsigned char* lds, const bf16* UX, const bf16* GY, const bf16* WGT, const float* rw, const float* rb, const float* b_a, const float* b_i, const float* lam,
                                         f32x2* TOT, bf16* YMIX, int G, int bx, int lane, int wave) {
    LAS unsigned char* UXT = lds + wave * 16896;
    LAS unsigned char* XRT = UXT + 8704;
    const int h = wave, j = lane & 31, hh = lane >> 5, dg = lane & 7, tg = lane >> 3;
    float c8v[2], bav[2], biv[2];
#pragma unroll
    for (int ec = 0; ec < 2; ++ec) { const int ch = 64 * h + 32 * ec + j; c8v[ec] = -8.0f * 1.4426950408889634f * log1pf(expf(-lam[ch]));   bav[ec] = b_a[ch]; biv[ec] = b_i[ch]; }
    for (int it = bx; it < 512; it += G) {
        asm volatile("" ::: "memory");
        int b, c; scan_decode(it, b, c);
        const size_t mrow0 = (size_t)b * SEQ + 64 * c;
#pragma unroll
        for (int i = 0; i < 9; ++i) { const int row = i * 8 + tg, tok = 64 * c - 3 + row; v4u v = {0u, 0u, 0u, 0u};
            if (row < 67 && tok >= 0) v = *(const v4u*)(UX + ((size_t)b * SEQ + tok) * DR + 64 * h + 8 * dg);
            if (row < 68) *(LAS v4u*)(UXT + row * 128 + dg * 16) = v; }
        pg8::bf16x8 bfr[2][4];
#pragma unroll
        for (int g = 0; g < 2; ++g)
#pragma unroll
            for (int ks = 0; ks < 4; ++ks) bfr[g][ks] = *(const pg8::bf16x8*)(WGT + ((size_t)(h * 128 + 64 * g + j)) * 64 + 16 * ks + 8 * hh);
        v4u gyv[8];
        if (FINAL) {
#pragma unroll
            for (int i = 0; i < 8; ++i) gyv[i] = *(const v4u*)(GY + (mrow0 + i * 8 + tg) * DR + 64 * h + 8 * dg);
        }
        float Hc = 0.f;
        if (FINAL) { const f32x2* tp = TOT + ((size_t)b * 64) * DR + 64 * h + lane; int cc = 0;
            for (; cc + 8 <= c; cc += 8) { f32x2 t8[8];
#pragma unroll
                for (int u = 0; u < 8; ++u) t8[u] = tp[(size_t)(cc + u) * DR];
#pragma unroll
                for (int u = 0; u < 8; ++u) Hc = Hc * t8[u].x + t8[u].y; }
            for (; cc < c; ++cc) { const f32x2 ab = tp[(size_t)cc * DR]; Hc = Hc * ab.x + ab.y; } }
        {
            f32x4 w4a[4], w4b[4];
#pragma unroll
            for (int k = 0; k < 4; ++k) { w4a[k] = *(const f32x4*)(rw + k * DR + 64 * h + 8 * dg); w4b[k] = *(const f32x4*)(rw + k * DR + 64 * h + 8 * dg + 4); }
            const f32x4 rb0 = *(const f32x4*)(rb + 64 * h + 8 * dg), rb1 = *(const f32x4*)(rb + 64 * h + 8 * dg + 4);
#pragma unroll
            for (int th = 0; th < 2; ++th) {
                f32x4 o0[4], o1[4];
#pragma unroll
                for (int t = 0; t < 4; ++t) { o0[t] = rb0; o1[t] = rb1; }
#pragma unroll
                for (int i = 0; i < 7; ++i) { const v4u v = *(const LAS v4u*)(UXT + (8 * tg + 4 * th + i) * 128 + dg * 16);
                    const f32x4 x0 = {bflo(v.x), bfhi(v.x), bflo(v.y), bfhi(v.y)}, x1 = {bflo(v.z), bfhi(v.z), bflo(v.w), bfhi(v.w)};
#pragma unroll
                    for (int k = 0; k < 4; ++k) { const int t = i - k; if (t >= 0 && t < 4) { o0[t] += w4a[k] * x0; o1[t] += w4b[k] * x1; } } }
#pragma unroll
                for (int t = 0; t < 4; ++t) *(LAS v4u*)(XRT + (8 * tg + 4 * th + t) * 128 + dg * 16) = pack8(o0[t], o1[t]);
            }
        }
        if (FINAL) {
#pragma unroll
            for (int i = 0; i < 8; ++i) *(LAS v4u*)(UXT + (i * 8 + tg) * 128 + dg * 16) = gyv[i];
        }
#pragma unroll
        for (int ec = 0; ec < 2; ++ec) {
            const int ch = 64 * h + 32 * ec + j;
            const float c8 = c8v[ec], ba = bav[ec], bi = biv[ec];
            f32x16 av[2], bv[2];
#pragma unroll
            for (int tt = 0; tt < 2; ++tt) {
                pg8::bf16x8 afr[4];
#pragma unroll
                for (int ks = 0; ks < 4; ++ks) afr[ks] = *(const LAS pg8::bf16x8*)(XRT + (32 * tt + j) * 128 + (16 * ks + 8 * hh) * 2);
                f32x16 pa, pi;
#pragma unroll
                for (int r = 0; r < 16; ++r) { pa[r] = 0.f; pi[r] = 0.f; }
#pragma unroll
                for (int ks = 0; ks < 4; ++ks) {
                    pa = __builtin_amdgcn_mfma_f32_32x32x16_bf16(afr[ks], bfr[0][ks], pa, 0, 0, 0);
                    pi = __builtin_amdgcn_mfma_f32_32x32x16_bf16(afr[ks], bfr[1][ks], pi, 0, 0, 0); }
                if (ec == 0 && tt == 1) {
#pragma unroll
                    for (int g = 0; g < 2; ++g)
#pragma unroll
                        for (int ks = 0; ks < 4; ++ks) bfr[g][ks] = *(const pg8::bf16x8*)(WGT + ((size_t)(h * 128 + 64 * g + 32 + j)) * 64 + 16 * ks + 8 * hh);
                }
                gate_math16(pa, pi, ba, bi, c8, av[tt], bv[tt]);
                {
                    f32x16 px;
#pragma unroll
                    for (int r = 0; r < 16; ++r) px[r] = bv[tt][r] * 0.f;
                    int dd = 32 * ec + j - 8 * hh; asm volatile("" : "+v"(dd));
                    const unsigned one = (dd & 1) ? 0x3F800000u : 0x00003F80u;
#pragma unroll
                    for (int ks = 0; ks < 4; ++ks) {
                        const int dw = (dd - 16 * ks) >> 1;
                        v4u idw; idw.x = dw == 0 ? one : 0u; idw.y = dw == 1 ? one : 0u; idw.z = dw == 2 ? one : 0u; idw.w = dw == 3 ? one : 0u;
                        px = __builtin_amdgcn_mfma_f32_32x32x16_bf16(afr[ks], __builtin_bit_cast(pg8::bf16x8, idw), px, 0, 0, 0); }
#pragma unroll
                    for (int r = 0; r < 16; ++r) bv[tt][r] *= px[r];
                }
            }
            float GA[2][4], GB[2][4], PA[2][4], PB[2][4];
#pragma unroll
            for (int tt = 0; tt < 2; ++tt)
#pragma unroll
                for (int q = 0; q < 4; ++q) { const float a0 = av[tt][4 * q], a1 = av[tt][4 * q + 1], a2 = av[tt][4 * q + 2], a3 = av[tt][4 * q + 3];
                    const float b0 = bv[tt][4 * q], b1 = bv[tt][4 * q + 1], b2 = bv[tt][4 * q + 2], b3 = bv[tt][4 * q + 3];
                    GA[tt][q] = (a0 * a1) * (a2 * a3); GB[tt][q] = ((b0 * a1 + b1) * a2 + b2) * a3 + b3;
                    PA[tt][q] = __shfl_xor(GA[tt][q], 32); PB[tt][q] = __shfl_xor(GB[tt][q], 32); }
            if (!FINAL) {
                float At = 1.f, Bt = 0.f;
#pragma unroll
                for (int tt = 0; tt < 2; ++tt)
#pragma unroll
                    for (int q = 0; q < 4; ++q) { const float A0 = hh ? PA[tt][q] : GA[tt][q], B0 = hh ? PB[tt][q] : GB[tt][q], A1 = hh ? GA[tt][q] : PA[tt][q], B1 = hh ? GB[tt][q] : PB[tt][q];
                        Bt = (Bt * A0 + B0) * A1 + B1; At = (At * A0) * A1; }
                if (hh == 0) TOT[((size_t)b * 64 + c) * DR + ch] = (f32x2){At, Bt};
            } else {
                float hc = __shfl(Hc, 32 * ec + j);
#pragma unroll
                for (int tt = 0; tt < 2; ++tt)
#pragma unroll
                    for (int q = 0; q < 4; ++q) { const float A0 = hh ? PA[tt][q] : GA[tt][q], B0 = hh ? PB[tt][q] : GB[tt][q], A1 = hh ? GA[tt][q] : PA[tt][q], B1 = hh ? GB[tt][q] : PB[tt][q];
                        const float mid = hc * A0 + B0; float hv = hh ? mid : hc; hc = mid * A1 + B1;
#pragma unroll
                        for (int i = 0; i < 4; ++i) { hv = av[tt][4 * q + i] * hv + bv[tt][4 * q + i]; av[tt][4 * q + i] = hv; } }
#pragma unroll
                for (int tt = 0; tt < 2; ++tt)
#pragma unroll
                    for (int r = 0; r < 16; ++r) { const int tk = 32 * tt + (r & 3) + 8 * (r >> 2) + 4 * hh;
                        LAS u16* p = (LAS u16*)(UXT + tk * 128 + (32 * ec + j) * 2);
                        const float gy = __uint_as_float((unsigned)(*p) << 16);
                        *p = (u16)f2bf(gy * av[tt][r]); }
            }
        }
        if (FINAL) {
#pragma unroll
            for (int i = 0; i < 8; ++i) { const int row = i * 8 + tg; *(v4u*)(YMIX + (mrow0 + row) * D + DC + 64 * h + 8 * dg) = *(const LAS v4u*)(UXT + row * 128 + dg * 16); }
        }
    }
    __syncthreads();
}

__device__ __forceinline__ void fold_chunks(const gu64* tp, int c0, int c1, int hh, float& A, float& B) {
    const int mid = (c0 + c1 + 1) >> 1, lo = hh ? mid : c0, hi2 = hh ? c1 : mid;
    float Ar = 1.f, Br = 0.f;
    for (int cc = lo; cc < hi2; cc += 4) { unsigned long long t8[4];
#pragma unroll
        for (int u = 0; u < 4; ++u) t8[u] = __hip_atomic_load(tp + (size_t)(cc + u < 63 ? cc + u : 63) * DR, RLX_AGENT);
#pragma unroll
        for (int u = 0; u < 4; ++u) { const bool ok = cc + u < hi2; const float ta = ok ? __uint_as_float((unsigned)t8[u]) : 1.f, tb = ok ? __uint_as_float((unsigned)(t8[u] >> 32)) : 0.f; Br = Br * ta + tb; Ar = Ar * ta; } }
    const float Ap = __shfl_xor(Ar, 32), Bp = __shfl_xor(Br, 32);
    A = Ar * Ap; B = hh ? (Bp * Ar + Br) : (Br * Ap + Bp);
}
__device__ __forceinline__ void mix_scan1(LAS unsigned char* lds, const bf16* UX, const bf16* GY, const bf16* WGT, const float* rw, const float* rb, const float* b_a, const float* b_i, const float* lam,
                                          f32x2* TOT, unsigned* cnt, bf16* YMIX, int G, int bx, int lane, int wave) {
    LAS unsigned char* UXT = lds + wave * 16896;
    LAS unsigned char* XRT = UXT + 8704;
    const int h = wave, j = lane & 31, hh = lane >> 5, dg = lane & 7, tg = lane >> 3;
    const int gs = G >> 3, b = bx / gs, idx = bx - b * gs;
    float c8v[2], bav[2], biv[2];
#pragma unroll
    for (int ec = 0; ec < 2; ++ec) { const int ch = 64 * h + 32 * ec + j; c8v[ec] = -8.0f * 1.4426950408889634f * log1pf(expf(-lam[ch])); bav[ec] = b_a[ch]; biv[ec] = b_i[ch]; }
    for (int c = idx, round = 0; c < 64; c += gs, ++round) {
        asm volatile("" ::: "memory");
        const size_t mrow0 = (size_t)b * SEQ + 64 * c;
#pragma unroll
        for (int i = 0; i < 9; ++i) { const int row = i * 8 + tg, tok = 64 * c - 3 + row; v4u v = {0u, 0u, 0u, 0u};
            if (row < 67 && tok >= 0) v = *(const v4u*)(UX + ((size_t)b * SEQ + tok) * DR + 64 * h + 8 * dg);
            if (row < 68) *(LAS v4u*)(UXT + row * 128 + dg * 16) = v; }
        pg8::bf16x8 bfr[2][4];
#pragma unroll
        for (int g = 0; g < 2; ++g)
#pragma unroll
            for (int ks = 0; ks < 4; ++ks) bfr[g][ks] = *(const pg8::bf16x8*)(WGT + ((size_t)(h * 128 + 64 * g + j)) * 64 + 16 * ks + 8 * hh);
        {
            f32x4 w4a[4], w4b[4];
#pragma unroll
            for (int k = 0; k < 4; ++k) { w4a[k] = *(const f32x4*)(rw + k * DR + 64 * h + 8 * dg); w4b[k] = *(const f32x4*)(rw + k * DR + 64 * h + 8 * dg + 4); }
            const f32x4 rb0 = *(const f32x4*)(rb + 64 * h + 8 * dg), rb1 = *(const f32x4*)(rb + 64 * h + 8 * dg + 4);
#pragma unroll
            for (int th = 0; th < 2; ++th) {
                f32x4 o0[4], o1[4];
#pragma unroll
                for (int t = 0; t < 4; ++t) { o0[t] = rb0; o1[t] = rb1; }
#pragma unroll
                for (int i = 0; i < 7; ++i) { const v4u v = *(const LAS v4u*)(UXT + (8 * tg + 4 * th + i) * 128 + dg * 16);
                    const f32x4 x0 = {bflo(v.x), bfhi(v.x), bflo(v.y), bfhi(v.y)}, x1 = {bflo(v.z), bfhi(v.z), bflo(v.w), bfhi(v.w)};
#pragma unroll
                    for (int k = 0; k < 4; ++k) { const int t = i - k; if (t >= 0 && t < 4) { o0[t] += w4a[k] * x0; o1[t] += w4b[k] * x1; } } }
#pragma unroll
                for (int t = 0; t < 4; ++t) *(LAS v4u*)(XRT + (8 * tg + 4 * th + t) * 128 + dg * 16) = pack8(o0[t], o1[t]);
            }
        }
#pragma unroll
        for (int ec = 0; ec < 2; ++ec) {
            const int ch = 64 * h + 32 * ec + j;
            const float c8 = c8v[ec], ba = bav[ec], bi = biv[ec];
            unsigned* cw = cnt + 64 * (8 * ec + b);
            f32x16 av[2], bv[2];
#pragma unroll
            for (int tt = 0; tt < 2; ++tt) {
                pg8::bf16x8 afr[4];
#pragma unroll
                for (int ks = 0; ks < 4; ++ks) afr[ks] = *(const LAS pg8::bf16x8*)(XRT + (32 * tt + j) * 128 + (16 * ks + 8 * hh) * 2);
                f32x16 pa, pi;
#pragma unroll
                for (int r = 0; r < 16; ++r) { pa[r] = 0.f; pi[r] = 0.f; }
#pragma unroll
                for (int ks = 0; ks < 4; ++ks) {
                    pa = __builtin_amdgcn_mfma_f32_32x32x16_bf16(afr[ks], bfr[0][ks], pa, 0, 0, 0);
                    pi = __builtin_amdgcn_mfma_f32_32x32x16_bf16(afr[ks], bfr[1][ks], pi, 0, 0, 0); }
                if (ec == 0 && tt == 1) {
#pragma unroll
                    for (int g = 0; g < 2; ++g)
#pragma unroll
                        for (int ks = 0; ks < 4; ++ks) bfr[g][ks] = *(const pg8::bf16x8*)(WGT + ((size_t)(h * 128 + 64 * g + 32 + j)) * 64 + 16 * ks + 8 * hh);
                }
                gate_math16(pa, pi, ba, bi, c8, av[tt], bv[tt]);
                {
                    f32x16 px;
#pragma unroll
                    for (int r = 0; r < 16; ++r) px[r] = bv[tt][r] * 0.f;
                    int dd = 32 * ec + j - 8 * hh; asm volatile("" : "+v"(dd));
                    const unsigned one = (dd & 1) ? 0x3F800000u : 0x00003F80u;
#pragma unroll
                    for (int ks = 0; ks < 4; ++ks) {
                        const int dw = (dd - 16 * ks) >> 1;
                        v4u idw; idw.x = dw == 0 ? one : 0u; idw.y = dw == 1 ? one : 0u; idw.z = dw == 2 ? one : 0u; idw.w = dw == 3 ? one : 0u;
                        px = __builtin_amdgcn_mfma_f32_32x32x16_bf16(afr[ks], __builtin_bit_cast(pg8::bf16x8, idw), px, 0, 0, 0); }
#pragma unroll
                    for (int r = 0; r < 16; ++r) bv[tt][r] *= px[r];
                }
            }
            float GA[2][4], GB[2][4], PA[2][4], PB[2][4];
            float At = 1.f, Bt = 0.f;
#pragma unroll
            for (int tt = 0; tt < 2; ++tt)
#pragma unroll
                for (int q = 0; q < 4; ++q) { const float a0 = av[tt][4 * q], a1 = av[tt][4 * q + 1], a2 = av[tt][4 * q + 2], a3 = av[tt][4 * q + 3];
                    const float b0 = bv[tt][4 * q], b1 = bv[tt][4 * q + 1], b2 = bv[tt][4 * q + 2], b3 = bv[tt][4 * q + 3];
                    GA[tt][q] = (a0 * a1) * (a2 * a3); GB[tt][q] = ((b0 * a1 + b1) * a2 + b2) * a3 + b3;
                    PA[tt][q] = __shfl_xor(GA[tt][q], 32); PB[tt][q] = __shfl_xor(GB[tt][q], 32);
                    const float A0 = hh ? PA[tt][q] : GA[tt][q], B0 = hh ? PB[tt][q] : GB[tt][q], A1 = hh ? GA[tt][q] : PA[tt][q], B1 = hh ? GB[tt][q] : PB[tt][q];
                    Bt = (Bt * A0 + B0) * A1 + B1; At = (At * A0) * A1; }
            if (hh == 0) __hip_atomic_store((gu64*)(TOT + ((size_t)b * 64 + c) * DR + ch), ((unsigned long long)__float_as_uint(Bt) << 32) | __float_as_uint(At), RLX_AGENT);
            asm volatile("s_waitcnt vmcnt(0)" ::: "memory");
            if (lane == 0) __hip_atomic_fetch_add(cw, 1u, __ATOMIC_RELAXED, __HIP_MEMORY_SCOPE_AGENT);
            if (ec == 0) {
#pragma unroll
                for (int i = 0; i < 8; ++i) *(LAS v4u*)(UXT + (i * 8 + tg) * 128 + dg * 16) = *(const v4u*)(GY + (mrow0 + i * 8 + tg) * DR + 64 * h + 8 * dg);
            }
            const gu64* tp = (const gu64*)(TOT + ((size_t)b * 64) * DR + ch); const int cpre = round * gs < c ? round * gs : c;
            float Apre = 1.f, Bpre = 0.f;
            if (cpre > 0) fold_chunks(tp, 0, cpre, hh, Apre, Bpre);
            if (wave == 0) { const int upto = (round + 1) * gs < 64 ? (round + 1) * gs : 64; const unsigned need = 8u * (unsigned)upto; unsigned sp = 0;
                while ((unsigned)__builtin_amdgcn_readfirstlane(__hip_atomic_load(cw, __ATOMIC_RELAXED, __HIP_MEMORY_SCOPE_AGENT)) < need) { __builtin_amdgcn_s_sleep(1); if (++sp > (1u << 20)) break; }
                __builtin_amdgcn_fence(__ATOMIC_ACQUIRE, "agent");
                asm volatile("s_waitcnt vmcnt(0)" ::: "memory"); }
            asm volatile("" ::: "memory"); __builtin_amdgcn_s_barrier(); asm volatile("" ::: "memory");
            float hc;
            { float Aq, Bq; fold_chunks(tp, cpre, c, hh, Aq, Bq); hc = Bpre * Aq + Bq; (void)Apre; }
#pragma unroll
            for (int tt = 0; tt < 2; ++tt)
#pragma unroll
                for (int q = 0; q < 4; ++q) { const float A0 = hh ? PA[tt][q] : GA[tt][q], B0 = hh ? PB[tt][q] : GB[tt][q], A1 = hh ? GA[tt][q] : PA[tt][q], B1 = hh ? GB[tt][q] : PB[tt][q];
                    const float mid = hc * A0 + B0; float hv = hh ? mid : hc; hc = mid * A1 + B1;
#pragma unroll
                    for (int i = 0; i < 4; ++i) { hv = av[tt][4 * q + i] * hv + bv[tt][4 * q + i]; av[tt][4 * q + i] = hv; } }
#pragma unroll
            for (int tt = 0; tt < 2; ++tt)
#pragma unroll
                for (int r = 0; r < 16; ++r) { const int tk = 32 * tt + (r & 3) + 8 * (r >> 2) + 4 * hh;
                    LAS u16* p = (LAS u16*)(UXT + tk * 128 + (32 * ec + j) * 2);
                    const float gy = __uint_as_float((unsigned)(*p) << 16);
                    *p = (u16)f2bf(gy * av[tt][r]); }
        }
#pragma unroll
        for (int i = 0; i < 8; ++i) { const int row = i * 8 + tg; *(v4u*)(YMIX + (mrow0 + row) * D + DC + 64 * h + 8 * dg) = *(const LAS v4u*)(UXT + row * 128 + dg * 16); }
    }
    __syncthreads();
}

struct Args { const float* in[27]; float* out; unsigned char* ws; int ph_lo, ph_hi; };
constexpr int NPH = 10;
#ifndef MK_PER_PHASE
#define MK_PER_PHASE 0
#endif
#ifndef MK_REP_LO
#define MK_REP_LO 0
#define MK_REP_HI 0
#endif

__global__ void __launch_bounds__(NWAVES * 64, 2) mk_fwd(Args args) {
    extern __shared__ __attribute__((aligned(16))) unsigned char lds_raw[];
    LAS unsigned char* lds = (LAS unsigned char*)lds_raw;
    const int tid = threadIdx.x, lane = tid & 63, wave = __builtin_amdgcn_readfirstlane(tid >> 6);
    const int G = gridDim.x, bx = blockIdx.x;
    const int vcu = (G % 8 == 0) ? (bx % 8) * (G / 8) + bx / 8 : bx;
    const int gw = vcu * NWAVES + wave, NGW = G * NWAVES;
    unsigned char* ws = args.ws;
    gu32* ctl = (gu32*)(ws + WS_CTL);
    const float* x = args.in[0]; const float* cvec = args.in[1]; const float* w_mod = args.in[2]; const float* b_mod = args.in[3];
    const float* g1 = args.in[4]; const float* w1i = args.in[5]; const float* w1o = args.in[6]; const float* gm = args.in[7];
    const float* w_in = args.in[8]; const float* conv_w = args.in[9]; const float* conv_b = args.in[10]; const float* ln_g = args.in[11]; const float* ln_b = args.in[12];
    const float* rw = args.in[13]; const float* rb = args.in[14]; const float* wa = args.in[15]; const float* b_a = args.in[16];
    const float* wi = args.in[17]; const float* b_i = args.in[18]; const float* lam = args.in[19]; const float* w_out = args.in[20];
    const float* g2 = args.in[21]; const float* w2i = args.in[22]; const float* w2o = args.in[23]; const float* w_fmod = args.in[24];
    const float* b_fmod = args.in[25]; const float* gf = args.in[26];
    float* out = args.out;
    float* MOD = (float*)(ws + WS_MOD); float* BIAS1 = (float*)(ws + WS_BIAS1); float* BIAS2 = (float*)(ws + WS_BIAS2); float* BIAS3 = (float*)(ws + WS_BIAS3);
    bf16* WGT = (bf16*)(ws + WS_WGT); f32x2* TOT = (f32x2*)(ws + WS_TOT); float* SSP = (float*)(ws + WS_SSP);
    bf16 *W1O = (bf16*)(ws + WS_W1O), *WIN = (bf16*)(ws + WS_WIN), *WOUT = (bf16*)(ws + WS_WOUT), *W2O = (bf16*)(ws + WS_W2O);
    unsigned char *W2O8F = ws + WS_W2O, *W1I8 = ws + WS_W1I, *W2I8 = ws + WS_W2I, *WIN8 = ws + WS_WIN, *A8 = ws + WS_Y;
    float *CS1 = (float*)(ws + WS_CS1), *CS3 = (float*)(ws + WS_CS3), *CS2 = (float*)(ws + WS_CS2), *RS1 = (float*)(ws + WS_RS1), *RS3 = (float*)(ws + WS_RS3), *RS2 = (float*)(ws + WS_RS2);
    bf16 *Y = (bf16*)(ws + WS_Y), *ACT = (bf16*)(ws + WS_ACT), *U = (bf16*)(ws + WS_U), *UXB = (bf16*)(ws + WS_UX), *GYB = (bf16*)(ws + WS_GY), *YMIX = (bf16*)(ws + WS_YMIX);
    bf16* X1 = (bf16*)(ws + WS_X1);

    for (int u = tid; u < (LDS_BYTES - LDSCTL_OFF) / 4; u += NWAVES * 64) ((LAS unsigned*)(lds + LDSCTL_OFF))[u] = 0u;
    __syncthreads();
    const int lo = args.ph_lo, hi = args.ph_hi;
    const bool use_bar = (hi - lo) > 1;
    XcdBarrier bar; bar.bar = (unsigned*)(ctl + CW_BAR); bar.x = 0; bar.st = nullptr;
    if (use_bar) bar = xcd_barrier_post((unsigned*)(ctl + CW_BAR), (volatile LAS unsigned*)(lds + LDSCTL_OFF) + 8);
#define IN(k) (lo <= (k) && (k) < hi)
#define REPS(k) ((MK_REP_LO <= (k) && (k) < MK_REP_HI) ? 2 : 1)
#define AGAIN(k, rr) do { if ((rr) + 1 < REPS(k)) xcd_barrier(bar); } while (0)
#define SEAM(k) do { if (IN(k) && IN((k) + 1)) xcd_barrier(bar); } while (0)

    if (IN(0))
_Pragma("unroll")
    for (int rr = 0; rr < REPS(0); ++rr) {
        constexpr int NGEMV = 88;
        const int nt_wg = G > NGEMV ? G - NGEMV : G;
        if (bx < NGEMV || G <= NGEMV) {
            for (int it = bx; it < NGEMV; it += G) {
                if (it < 72) p0_gemv(lds, cvec, w_mod, 9 * D, b_mod, MOD, 128 * it, tid);
                else p0_gemv(lds, cvec, w_fmod, 2 * D, b_fmod, MOD + 9 * D, 128 * (it - 72), tid);
            }
        }
        if (bx >= NGEMV || G <= NGEMV) {
            const int tb = G > NGEMV ? bx - NGEMV : bx;
            for (int it = tb; it < 2 * (FF2 / 32); it += nt_wg) {
                if (it < FF2 / 32) p0_quant_item(lds, w1i, FF2, 1, W1I8, CS1, it, lane, wave);
                else p0_quant_item(lds, w2i, FF2, 1, W2I8, CS3, it - FF2 / 32, lane, wave);
            }
            LAS float* scr = (LAS float*)(lds + wave * 16384);
            constexpr int I_1O = (FF / 64) * (D / 32), I_IN = (D / 64) * (NMIX / 32), I_OUT = (D / 64) * (D / 32);
            constexpr int NITEMS = 2 * I_1O + I_IN + I_OUT;
            for (int it = tb * NWAVES + wave; it < NITEMS; it += nt_wg * NWAVES) {
                int r = it;
                if (r < I_1O) { p0_transpose_item(w1o, FF, D, W1O, 0, scr, r, lane); continue; } r -= I_1O;
                if (r < I_1O) { p0_transpose8_item(w2o, FF, D, W2O8F, scr, r, lane); continue; } r -= I_1O;
                if (r < I_IN) { p0_transpose_item(w_in, D, NMIX, WIN, 2, scr, r, lane); continue; } r -= I_IN;
                p0_transpose_item(w_out, D, D, WOUT, 0, scr, r, lane);
            }
        }
        for (int i = bx * 512 + tid; i < NH * 128 * HD; i += G * 512) { const int d = i & 63, e2 = (i >> 6) & 127, hd = i >> 13;
            const float v = e2 < 64 ? wa[(hd * 64 + d) * 64 + e2] : wi[(hd * 64 + d) * 64 + (e2 - 64)]; WGT[i] = (bf16)f2bf(v); }
        AGAIN(0, rr);
    }
    SEAM(0);
    if (IN(1))
_Pragma("unroll")
    for (int rr = 0; rr < REPS(1); ++rr) {
        LAS float* shl = (LAS float*)lds;
        for (int i = tid * 4; i < 3 * NB * D; i += 2048) { const int t = i >> 13, r = i & 8191, b = r >> 10, k = r & 1023; *(LAS f32x4*)(shl + i) = *(const f32x4*)(MOD + (size_t)b * LDM + 3 * t * D + k); }
        __syncthreads();
        for (int m0 = gw; m0 < M; m0 += 2 * NGW) {
            f32x4 v[2][4];
#pragma unroll
            for (int rr2 = 0; rr2 < 2; ++rr2) { const int m = (m0 + rr2 * NGW < M) ? m0 + rr2 * NGW : m0; const f32x4* xr = (const f32x4*)(x + (size_t)m * D) + lane;
#pragma unroll
                for (int jj = 0; jj < 4; ++jj) v[rr2][jj] = xr[64 * jj]; }
#pragma unroll
            for (int rr2 = 0; rr2 < 2; ++rr2) { const int m = m0 + rr2 * NGW; if (m < M) { const int b = m >> 12;
                float s = 0.f, am = 0.f;
#pragma unroll
                for (int jj = 0; jj < 4; ++jj) { const int k = 4 * lane + 256 * jj;
                    s += (v[rr2][jj][0] * v[rr2][jj][0] + v[rr2][jj][1] * v[rr2][jj][1]) + (v[rr2][jj][2] * v[rr2][jj][2] + v[rr2][jj][3] * v[rr2][jj][3]);
                    v[rr2][jj] = v[rr2][jj] * *(const f32x4*)(g1 + k) * (*(const f32x4*)(MOD + (size_t)b * LDM + 1 * D + k) + 1.0f);
                    const f32x4 t = __builtin_elementwise_abs(v[rr2][jj]); am = fmaxf(am, fmaxf(fmaxf(t[0], t[1]), fmaxf(t[2], t[3]))); }
                s = wave_sum(s); am = wave_max(am);
                const float q = am > 0.f ? 127.0f / am : 0.f;
#pragma unroll
                for (int jj = 0; jj < 4; ++jj) *(unsigned*)(A8 + (size_t)m * D + 4 * lane + 256 * jj) = q8x4(v[rr2][jj] * q);
                if (lane == 0) RS1[m] = rsqrtf(s * (1.0f / D) + EPS) * am * (1.0f / 127.0f); } }
        }
        for (int it = gw; it < FF2 + NMIX + FF2; it += NGW) {
            if (it >= FF2 && it < FF2 + NMIX) {
                const bf16* wrow = WIN + (size_t)(it - FF2) * D; float* op = BIAS2 + (it - FF2);
                const v4u wA = *(const v4u*)(wrow + 8 * lane), wB = *(const v4u*)(wrow + 512 + 8 * lane);
                f32x4 a0, a1, c0, c1; unpack8(wA, a0, a1); unpack8(wB, c0, c1);
#pragma unroll
                for (int b = 0; b < NB; ++b) { const LAS float* sp = shl + (1 * NB + b) * D + 8 * lane;
                    const f32x4 p = a0 * *(const LAS f32x4*)(sp) + a1 * *(const LAS f32x4*)(sp + 4) + c0 * *(const LAS f32x4*)(sp + 512) + c1 * *(const LAS f32x4*)(sp + 516);
                    const float tot = wave_sum((p[0] + p[1]) + (p[2] + p[3]));
                    if (lane == 0) op[(size_t)b * NMIX] = tot; }
            } else {
                const int t = it < FF2 ? 0 : 2, n = it < FF2 ? it : it - FF2 - NMIX;
                const unsigned char* wrow = (t == 0 ? W1I8 : W2I8) + (size_t)n * D; float* op = (t == 0 ? BIAS1 : BIAS3) + n; const float csn = (t == 0 ? CS1 : CS3)[n];
                const v4u w16 = *(const v4u*)(wrow + 16 * lane);
                f32x4 wf[4];
#pragma unroll
                for (int d4 = 0; d4 < 4; ++d4) { const int wv = (int)(d4 == 0 ? w16.x : d4 == 1 ? w16.y : d4 == 2 ? w16.z : w16.w);
                    wf[d4] = (f32x4){(float)((wv << 24) >> 24), (float)((wv << 16) >> 24), (float)((wv << 8) >> 24), (float)(wv >> 24)}; }
#pragma unroll
                for (int b = 0; b < NB; ++b) { const LAS float* sp = shl + (t * NB + b) * D + 16 * lane;
                    const f32x4 p = wf[0] * *(const LAS f32x4*)(sp) + wf[1] * *(const LAS f32x4*)(sp + 4) + wf[2] * *(const LAS f32x4*)(sp + 8) + wf[3] * *(const LAS f32x4*)(sp + 12);
                    const float tot = wave_sum((p[0] + p[1]) + (p[2] + p[3]));
                    if (lane == 0) op[(size_t)b * FF2] = tot * csn; }
            }
        }
        __syncthreads();
        AGAIN(1, rr);
    }
    SEAM(1);
    if (IN(2))
_Pragma("unroll")
    for (int rr = 0; rr < REPS(2); ++rr) {
        pg8::Gemm g{(const pg8::bf16_t*)A8, (const pg8::bf16_t*)W1I8, M, FF2, D / 2}; pg8::StaticOrder S; S.init(M, FF2, G, bx);
        EpiSwiglu8<false> E{ACT, RS1, CS1, BIAS1};
        pg8::gemm_phase<EpiSwiglu8<false>, pg8::StaticOrder, true, true, 1>(lds, g, S, E);
        AGAIN(2, rr);
    }
    SEAM(2);
    if (IN(3))
_Pragma("unroll")
    for (int rr = 0; rr < REPS(3); ++rr) {
        pg8::Gemm g{ACT, W1O, M, D, FF}; pg8::StaticOrder S; S.init(M, D, G, bx);
        EpiResid<1, true, false> E{x, X1, Y, SSP, MOD + 2 * D, gm, MOD + 4 * D};
        pg8::gemm_phase<EpiResid<1, true, false>, pg8::StaticOrder, true, true>(lds, g, S, E);
        AGAIN(3, rr);
    }
    SEAM(3);
    if (IN(4))
_Pragma("unroll")
    for (int rr = 0; rr < REPS(4); ++rr) {
        pg8::Gemm g{Y, WIN, M, NMIX, D}; pg8::StaticOrder S; S.init(M, NMIX, G, bx);
        EpiMixIn E{U, UXB, GYB, SSP, BIAS2};
        pg8::gemm_phase<EpiMixIn, pg8::StaticOrder, true, true>(lds, g, S, E);
        AGAIN(4, rr);
    }
    SEAM(4);
    if (IN(5))
_Pragma("unroll")
    for (int rr = 0; rr < REPS(5); ++rr) {
        mix_conv(lds, U, conv_w, conv_b, ln_g, ln_b, YMIX, G, bx, tid, lane, wave);
#ifdef MK_REP_CONV
        mix_conv(lds, U, conv_w, conv_b, ln_g, ln_b, YMIX, G, bx, tid, lane, wave);
#endif
        mix_scan1(lds, UXB, GYB, WGT, rw, rb, b_a, b_i, lam, TOT, (unsigned*)(ctl + CW_SCAN), YMIX, G, bx, lane, wave);
        AGAIN(5, rr);
    }
    SEAM(5);
    if (IN(7))
_Pragma("unroll")
    for (int rr = 0; rr < REPS(7); ++rr) {
        pg8::Gemm g{YMIX, WOUT, M, D, D}; pg8::StaticOrder S; S.init(M, D, G, bx);
        EpiResidQ<0, true> E{X1, X1, A8, RS3, (f32x2*)(ws + WS_SSPX), MOD + 5 * D, g2, MOD + 7 * D, (unsigned*)(ctl + CW_SEAM7)};
        pg8::gemm_phase<EpiResidQ<0, true>, pg8::StaticOrder, true, true>(lds, g, S, E);
        AGAIN(7, rr);
    }
    SEAM(7);
    if (IN(8))
_Pragma("unroll")
    for (int rr = 0; rr < REPS(8); ++rr) {
        pg8::Gemm g{(const pg8::bf16_t*)A8, (const pg8::bf16_t*)W2I8, M, FF2, D / 2}; pg8::StaticOrder S; S.init(M, FF2, G, bx);
        EpiSwiglu8<true> E{ACT, RS3, CS3, BIAS3};
        pg8::gemm_phase<EpiSwiglu8<true>, pg8::StaticOrder, true, true, 1>(lds, g, S, E);
        AGAIN(8, rr);
    }
    SEAM(8);
    if (IN(9))
_Pragma("unroll")
    for (int rr = 0; rr < REPS(9); ++rr) {
        pg8::Gemm g{ACT, (const pg8::bf16_t*)W2O8F, M, D, FF / 2}; pg8::StaticOrder S; S.init(M, D, G, bx);
        EpiResidFinal<true> E{X1, out, (float*)(ws + WS_SSPF), MOD + 8 * D, gf, MOD + 10 * D, MOD + 9 * D, (unsigned*)(ctl + CW_SEAM)};
        pg8::gemm_phase<EpiResidFinal<true>, pg8::StaticOrder, true, true, 2>(lds, g, S, E);
    }
#undef IN
#undef SEAM
#undef REPS
#undef AGAIN
}

extern "C" void kernel_launch(void* const* d_in, const int* in_sizes, int n_in, void* d_out, int out_size, void* d_ws, size_t ws_size, hipStream_t stream) {
    static int grid = 0;
    if (grid == 0) {
        if (n_in != 27 || in_sizes[0] != M * D || out_size != M * D || ws_size < WS_END) { fprintf(stderr, "kernel_launch: unexpected shapes (n_in %d, in0 %d, out %d, ws %zu)\n", n_in, n_in > 0 ? in_sizes[0] : -1, out_size, ws_size); grid = -1; return; }
        int dev = 0, cus = 0, per_cu = 0;
        if (hipGetDevice(&dev) != hipSuccess || hipDeviceGetAttribute(&cus, hipDeviceAttributeMultiprocessorCount, dev) != hipSuccess) { grid = -1; return; }
        if (hipFuncSetAttribute((const void*)mk_fwd, hipFuncAttributeMaxDynamicSharedMemorySize, LDS_BYTES) != hipSuccess) { fprintf(stderr, "kernel_launch: hipFuncSetAttribute failed\n"); grid = -1; return; }
        if (hipOccupancyMaxActiveBlocksPerMultiprocessor(&per_cu, (const void*)mk_fwd, NWAVES * 64, LDS_BYTES) != hipSuccess || per_cu < 1) fprintf(stderr, "kernel_launch: occupancy query reports %d blocks per CU\n", per_cu);
        (void)hipGetLastError();
        grid = cus;
        if (grid % 8 != 0 || grid < 8) { fprintf(stderr, "kernel_launch: %d CUs: the scan's chunk rounds need a multiple of 8 workgroups\n", grid); grid = -1; return; }
    }
    if (grid < 0) return;
    if (hipMemsetAsync((char*)d_ws + WS_CTL, 0, CTL_ZERO_BYTES, stream) != hipSuccess) return;
    Args a{};
    for (int i = 0; i < 27; ++i) a.in[i] = (const float*)d_in[i];
    a.out = (float*)d_out; a.ws = (unsigned char*)d_ws;
#if MK_PER_PHASE
    for (int p = 0; p < NPH; ++p) { a.ph_lo = p; a.ph_hi = p + 1; hipLaunchKernelGGL(mk_fwd, dim3(grid), dim3(NWAVES * 64), LDS_BYTES, stream, a); }
#else
    a.ph_lo = 0; a.ph_hi = NPH; hipLaunchKernelGGL(mk_fwd, dim3(grid), dim3(NWAVES * 64), LDS_BYTES, stream, a);
#endif
}
```

```cpp
#include <hip/hip_runtime.h>
#include <cstdio>
#include <cstdint>
namespace pg8 {
#define PG8_LAS __attribute__((address_space(3)))
typedef unsigned short bf16_t;
typedef short bf16x8 __attribute__((ext_vector_type(8)));
typedef float f32x4 __attribute__((ext_vector_type(4)));
typedef unsigned u32x4 __attribute__((ext_vector_type(4)));
constexpr int BM = 256, BK = 64, HALF = 128, HTB = HALF * BK * 2  , STAGE_BYTES = 8 * HTB, NXCD = 8, WGM = 8;

__host__ __device__ __forceinline__ int lds_byte(int r, int c) { const int st = (r >> 4) * 2 + (c >> 5), rr = r & 15, cc = c & 31, ob = rr * 64 + cc * 2; return st * 1024 + (ob ^ (((ob >> 9) & 1) << 5)); }
__host__ __device__ __forceinline__ void stage_rc(int b, int& R, int& C) { const int st = b / 1024, sb = b % 1024, swz = sb ^ (((sb >> 9) & 1) << 5); R = (st >> 1) * 16 + swz / 64; C = (st & 1) * 32 + (swz % 64) / 2; }
__host__ __device__ __forceinline__ int perm32(int rho) { const int n = rho >> 4, i = rho & 15; return 8 * (i >> 2) + 4 * n + (i & 3); }

struct Unit { int pm, pn; };
struct Gemm { const bf16_t* A; const bf16_t* Bt; int M, N, K; };

struct StaticOrder {
    int nM, nN, nwg, G, c;
    __host__ __device__ void init(int M, int N, int G_, int c_) { nM = M / BM; nN = N / BM; nwg = nM * nN; G = G_; c = c_; }
    __host__ __device__ bool next(int i, Unit& u) const {
        const long L = (long)i * G + c; if (L >= nwg) return false;
        int wgid = (int)L; { const int q = nwg / NXCD, r = nwg % NXCD, xcd = wgid % NXCD, off = wgid / NXCD; wgid = (xcd < r ? xcd * (q + 1) : r * (q + 1) + (xcd - r) * q) + off; }
        const int nig = WGM * nN, gid = wgid / nig, fm = gid * WGM, gsz = (nM - fm) < WGM ? (nM - fm) : WGM;
        u.pm = fm + ((wgid % nig) % gsz); u.pn = (wgid % nig) / gsz; return true;
    }
    __device__ __forceinline__ void a_ready(const Unit&) const {}
    __device__ __forceinline__ void done(const Unit&) const {}
};

__device__ __forceinline__ unsigned cvt_pk_bf16(float lo, float hi) { unsigned r; asm volatile("v_cvt_pk_bf16_f32 %0, %1, %2" : "=v"(r) : "v"(lo), "v"(hi)); return r; }
#ifndef PG8_STAGE_IN_MMA
#define PG8_STAGE_IN_MMA 0
#endif
typedef int i32x4 __attribute__((ext_vector_type(4)));
typedef int i32x8 __attribute__((ext_vector_type(8)));
__device__ __forceinline__ i32x8 cat32(const bf16x8 lo, const bf16x8 hi) { const i32x4 p = __builtin_bit_cast(i32x4, lo), q = __builtin_bit_cast(i32x4, hi); return (i32x8){p.x, p.y, p.z, p.w, q.x, q.y, q.z, q.w}; }
__device__ __forceinline__ f32x4 mma_mx8(const i32x8 B, const i32x8 A, const f32x4 c) { return __builtin_amdgcn_mfma_scale_f32_16x16x128_f8f6f4(B, A, c, 0, 0, 0, 0x7F7F7F7F, 0, 0x7F7F7F7F); }
template <int I8> __device__ __forceinline__ f32x4 mma16(const bf16x8 b, const bf16x8 a, const f32x4 c) {
    if constexpr (I8 == 1) return __builtin_bit_cast(f32x4, __builtin_amdgcn_mfma_i32_16x16x64_i8(__builtin_bit_cast(i32x4, b), __builtin_bit_cast(i32x4, a), __builtin_bit_cast(i32x4, c), 0, 0, 0));
    else return __builtin_amdgcn_mfma_f32_16x16x32_bf16(b, a, c, 0, 0, 0);
}
template <class Epi, class Sched, bool ALIGN_EPI = false, bool SP2 = false, int I8 = 0>
__device__ __forceinline__ void gemm_phase(PG8_LAS unsigned char* lds, const Gemm g, const Sched& S, const Epi& E) {
    const int tid = threadIdx.x, wid = __builtin_amdgcn_readfirstlane(tid >> 6), lane = tid & 63, wr = wid >> 2, wc = wid & 3, fr = lane & 15, fq = lane >> 4;
    const int K = g.K, nt = K / BK;
    unsigned voffA[1], voffB[1];
    { int R, C; stage_rc(tid * 16, R, C); const int Rb = Epi::PERM ? ((R & ~31) + perm32(R & 31)) : R;
        voffA[0] = (unsigned)(R * K + C) * 2u; voffB[0] = (unsigned)(Rb * K + C) * 2u; }
    const size_t r64 = (size_t)64 * K * 2;
    const size_t kstep = (size_t)(BK * 2);
    const size_t hstep = (size_t)HALF * K * 2;
    const size_t tstep = 2 * hstep;
    const unsigned ldsw = (unsigned)wid * 1024u;
    const int aoff = lds_byte(wr * 64 + fr, fq * 8), boff = lds_byte(wc * 32 + fr, fq * 8);
#define PG8_SA(b, h) (((b) * 2 + (h)) * HTB)
#define PG8_SB(b, h) ((4 + (b) * 2 + (h)) * HTB)
#define PG8_STAGE(bufoff, gbase, voff) do { _Pragma("unroll") for (int _i = 0; _i < 2; ++_i) \
        __builtin_amdgcn_global_load_lds((const unsigned*)((const char*)(gbase) + _i * r64 + (voff)[0]), (PG8_LAS unsigned*)(lds + (bufoff) + ldsw + _i * 8192), 16, 0, 0); } while (0)
#define PG8_LDA(dst, b, h) do { _Pragma("unroll") for (int m = 0; m < 4; ++m) { if constexpr (I8 == 2) dst##8[m] = cat32(*(const PG8_LAS bf16x8*)(lds + PG8_SA(b, h) + aoff + m * 2048), *(const PG8_LAS bf16x8*)(lds + PG8_SA(b, h) + aoff + m * 2048 + 1024)); \
        else { _Pragma("unroll") for (int k = 0; k < 2; ++k) dst[m][k] = *(const PG8_LAS bf16x8*)(lds + PG8_SA(b, h) + aoff + m * 2048 + k * 1024); } } } while (0)
#define PG8_LDB(dst, b, h) do { _Pragma("unroll") for (int n = 0; n < 2; ++n) { if constexpr (I8 == 2) dst##8[n] = cat32(*(const PG8_LAS bf16x8*)(lds + PG8_SB(b, h) + boff + n * 2048), *(const PG8_LAS bf16x8*)(lds + PG8_SB(b, h) + boff + n * 2048 + 1024)); \
        else { _Pragma("unroll") for (int k = 0; k < 2; ++k) dst[n][k] = *(const PG8_LAS bf16x8*)(lds + PG8_SB(b, h) + boff + n * 2048 + k * 1024); } } } while (0)
#define PG8_MMA(ai, bj, At, Bt) do { __builtin_amdgcn_s_setprio(1); _Pragma("unroll") for (int m = 0; m < 4; ++m) _Pragma("unroll") for (int n = 0; n < 2; ++n) { \
        if constexpr (I8 == 2) acc[ai][bj][m][n] = mma_mx8(Bt##8[n], At##8[m], acc[ai][bj][m][n]); \
        else { _Pragma("unroll") for (int k = 0; k < 2; ++k) acc[ai][bj][m][n] = mma16<I8>(Bt[n][k], At[m][k], acc[ai][bj][m][n]); } } __builtin_amdgcn_s_setprio(0); } while (0)
#define PG8_WAIT_V(n) asm volatile("s_waitcnt vmcnt(" #n ")" ::: "memory")
#define PG8_WAIT_L(n) asm volatile("s_waitcnt lgkmcnt(" #n ")" ::: "memory")
#define PG8_BAR __builtin_amdgcn_s_barrier()
#define PG8_SCHED __builtin_amdgcn_sched_barrier(0)
    Unit cur, nxt; int ui = 0;
    if (!S.next(0, cur)) return;
    f32x4 acc[2][2][4][2];
#pragma unroll
    for (int a = 0; a < 2; ++a)
#pragma unroll
        for (int b = 0; b < 2; ++b)
#pragma unroll
            for (int m = 0; m < 4; ++m)
#pragma unroll
                for (int n = 0; n < 2; ++n) acc[a][b][m][n] = (f32x4){0.f, 0.f, 0.f, 0.f};
    bf16x8 At[4][2], B0[2][2], B1[2][2]; i32x8 At8[4], B08[2], B18[2];
    const char* cA = (const char*)g.A + (size_t)cur.pm * tstep; const char* cB = (const char*)g.Bt + (size_t)cur.pn * tstep;
    S.a_ready(cur);
    if constexpr (SP2) {
        PG8_STAGE(PG8_SB(0, 0), cB, voffB); PG8_STAGE(PG8_SB(0, 1), cB + hstep, voffB); PG8_STAGE(PG8_SA(0, 0), cA, voffA); PG8_STAGE(PG8_SA(0, 1), cA + hstep, voffA);
        if (wr == 1) PG8_BAR;
        PG8_WAIT_V(2); PG8_BAR;
        PG8_STAGE(PG8_SB(1, 0), cB + kstep, voffB); PG8_STAGE(PG8_SA(1, 0), cA + kstep, voffA); PG8_STAGE(PG8_SB(1, 1), cB + hstep + kstep, voffB);
        PG8_WAIT_V(6); PG8_BAR;
    } else {
        PG8_STAGE(PG8_SB(0, 0), cB, voffB); PG8_STAGE(PG8_SA(0, 0), cA, voffA); PG8_STAGE(PG8_SB(0, 1), cB + hstep, voffB); PG8_STAGE(PG8_SA(0, 1), cA + hstep, voffA);
        if (wr == 1) PG8_BAR;
        PG8_WAIT_V(4); PG8_BAR;
        PG8_STAGE(PG8_SB(1, 0), cB + kstep, voffB); PG8_STAGE(PG8_SA(1, 0), cA + kstep, voffA); PG8_STAGE(PG8_SB(1, 1), cB + hstep + kstep, voffB);
        PG8_WAIT_V(6); PG8_BAR;
    }
    for (;;) {
        const bool has_next = S.next(ui + 1, nxt);
        const char* nA = has_next ? (const char*)g.A + (size_t)nxt.pm * tstep : cA; const char* nB = has_next ? (const char*)g.Bt + (size_t)nxt.pn * tstep : cB;
        asm volatile(".p2align 8" ::: "memory");
        for (int t = 0; t < nt; t += 2) {
            const bool last = (t == nt - 2);
            const char* a1 = cA + (size_t)(t + 1) * kstep;
            const char* a2 = last ? nA : cA + (size_t)(t + 2) * kstep; const char* b2 = last ? nB : cB + (size_t)(t + 2) * kstep;
            const char* a3 = a2 + kstep; const char* b3 = b2 + kstep;
            if (last && has_next) S.a_ready(nxt);
            if constexpr (SP2) {
#if PG8_STAGE_IN_MMA
            PG8_LDB(B0, 0, 0); PG8_LDB(B1, 0, 1); PG8_SCHED; PG8_LDA(At, 0, 0);
            PG8_WAIT_V(6); PG8_WAIT_L(0); PG8_BAR; PG8_MMA(0, 0, At, B0); PG8_SCHED; PG8_STAGE(PG8_SA(1, 1), a1 + hstep, voffA); PG8_SCHED; PG8_MMA(0, 1, At, B1); PG8_BAR; PG8_SCHED;
            PG8_LDA(At, 0, 1);
            PG8_WAIT_V(2); PG8_WAIT_L(0); PG8_BAR; PG8_STAGE(PG8_SB(0, 0), b2, voffB); PG8_SCHED; PG8_MMA(1, 0, At, B0); PG8_SCHED; PG8_STAGE(PG8_SB(0, 1), b2 + hstep, voffB); PG8_SCHED; PG8_MMA(1, 1, At, B1); PG8_SCHED; PG8_STAGE(PG8_SA(0, 0), a2, voffA); PG8_BAR; PG8_SCHED;
            PG8_LDB(B0, 1, 0); PG8_LDB(B1, 1, 1); PG8_SCHED; PG8_LDA(At, 1, 0);
            PG8_WAIT_V(6); PG8_WAIT_L(0); PG8_BAR; PG8_MMA(0, 0, At, B0); PG8_SCHED; PG8_STAGE(PG8_SA(0, 1), a2 + hstep, voffA); PG8_SCHED; PG8_MMA(0, 1, At, B1); PG8_BAR; PG8_SCHED;
            PG8_LDA(At, 1, 1);
            PG8_WAIT_V(2); PG8_WAIT_L(0); PG8_BAR; PG8_STAGE(PG8_SB(1, 0), b3, voffB); PG8_SCHED; PG8_MMA(1, 0, At, B0); PG8_SCHED; PG8_STAGE(PG8_SB(1, 1), b3 + hstep, voffB); PG8_SCHED; PG8_MMA(1, 1, At, B1); PG8_SCHED; PG8_STAGE(PG8_SA(1, 0), a3, voffA); PG8_BAR; PG8_SCHED;
#else
            PG8_LDB(B0, 0, 0); PG8_LDB(B1, 0, 1); PG8_SCHED; PG8_LDA(At, 0, 0); PG8_STAGE(PG8_SA(1, 1), a1 + hstep, voffA);
            PG8_WAIT_V(8); PG8_WAIT_L(0); PG8_BAR; PG8_MMA(0, 0, At, B0); PG8_MMA(0, 1, At, B1); PG8_BAR; PG8_SCHED;
            PG8_LDA(At, 0, 1); PG8_STAGE(PG8_SB(0, 0), b2, voffB); PG8_STAGE(PG8_SB(0, 1), b2 + hstep, voffB); PG8_STAGE(PG8_SA(0, 0), a2, voffA);
            PG8_WAIT_V(8); PG8_WAIT_L(0); PG8_BAR; PG8_MMA(1, 0, At, B0); PG8_MMA(1, 1, At, B1); PG8_BAR; PG8_SCHED;
            PG8_LDB(B0, 1, 0); PG8_LDB(B1, 1, 1); PG8_SCHED; PG8_LDA(At, 1, 0); PG8_STAGE(PG8_SA(0, 1), a2 + hstep, voffA);
            PG8_WAIT_V(8); PG8_WAIT_L(0); PG8_BAR; PG8_MMA(0, 0, At, B0); PG8_MMA(0, 1, At, B1); PG8_BAR; PG8_SCHED;
            PG8_LDA(At, 1, 1); PG8_STAGE(PG8_SB(1, 0), b3, voffB); PG8_STAGE(PG8_SB(1, 1), b3 + hstep, voffB); PG8_STAGE(PG8_SA(1, 0), a3, voffA);
            PG8_WAIT_V(8); PG8_WAIT_L(0); PG8_BAR; PG8_MMA(1, 0, At, B0); PG8_MMA(1, 1, At, B1); PG8_BAR; PG8_SCHED;
#endif
            } else {
            PG8_LDB(B0, 0, 0); PG8_SCHED; PG8_LDA(At, 0, 0); PG8_STAGE(PG8_SA(1, 1), a1 + hstep, voffA);
            PG8_WAIT_L(8); PG8_BAR; PG8_WAIT_L(0); PG8_MMA(0, 0, At, B0); PG8_BAR; PG8_SCHED;
            PG8_LDB(B1, 0, 1); PG8_STAGE(PG8_SB(0, 0), b2, voffB);
            PG8_BAR; PG8_WAIT_L(0); PG8_MMA(0, 1, At, B1); PG8_BAR;
            PG8_LDA(At, 0, 1); PG8_STAGE(PG8_SA(0, 0), a2, voffA);
            PG8_BAR; PG8_WAIT_L(0); PG8_MMA(1, 0, At, B0); PG8_BAR; PG8_SCHED;
            PG8_STAGE(PG8_SB(0, 1), b2 + hstep, voffB);
            PG8_WAIT_V(6); PG8_BAR; PG8_MMA(1, 1, At, B1); PG8_BAR;
            PG8_LDB(B0, 1, 0); PG8_SCHED; PG8_LDA(At, 1, 0); PG8_STAGE(PG8_SA(0, 1), a2 + hstep, voffA);
            PG8_WAIT_L(8); PG8_BAR; PG8_WAIT_L(0); PG8_MMA(0, 0, At, B0); PG8_BAR; PG8_SCHED;
            PG8_LDB(B1, 1, 1); PG8_STAGE(PG8_SB(1, 0), b3, voffB);
            PG8_BAR; PG8_WAIT_L(0); PG8_MMA(0, 1, At, B1); PG8_BAR;
            PG8_LDA(At, 1, 1); PG8_STAGE(PG8_SA(1, 0), a3, voffA);
            PG8_BAR; PG8_WAIT_L(0); PG8_MMA(1, 0, At, B0); PG8_BAR; PG8_SCHED;
            PG8_STAGE(PG8_SB(1, 1), b3 + hstep, voffB);
            PG8_WAIT_V(6); PG8_BAR; PG8_MMA(1, 1, At, B1); PG8_BAR;
            }
        }
        if constexpr (ALIGN_EPI) { if (wr == 0) PG8_BAR; }
        if constexpr (!Epi::AFTER_DRAIN) { int ln; asm volatile("v_mbcnt_lo_u32_b32 %0, -1, 0\n\tv_mbcnt_hi_u32_b32 %0, -1, %0" : "=v"(ln));     const int fr2 = ln & 15, fq2 = ln >> 4; _Pragma("unroll") for (int er = 0; er < Epi::REPS; ++er) { E(acc, cur, wr, wc, fr2, fq2); if (er + 1 < Epi::REPS) asm volatile("" ::: "memory"); } S.done(cur); }
        if (!has_next) break;
#pragma unroll
        for (int a = 0; a < 2; ++a)
#pragma unroll
            for (int b = 0; b < 2; ++b)
#pragma unroll
                for (int m = 0; m < 4; ++m)
#pragma unroll
                    for (int n = 0; n < 2; ++n) acc[a][b][m][n] = (f32x4){0.f, 0.f, 0.f, 0.f};
        cur = nxt; cA = nA; cB = nB; ++ui;
        if constexpr (ALIGN_EPI) { if (wr == 1) PG8_BAR; }
    }
    PG8_WAIT_V(0);
    if constexpr (!ALIGN_EPI) { if (wr == 0) PG8_BAR; }
    PG8_BAR;
    if constexpr (Epi::AFTER_DRAIN) { E.fused(acc, cur, wr, wc, fr, fq, lds, wid, lane); S.done(cur); }
#undef PG8_SA
#undef PG8_SB
#undef PG8_STAGE
#undef PG8_LDA
#undef PG8_LDB
#undef PG8_MMA
#undef PG8_WAIT_V
#undef PG8_WAIT_L
#undef PG8_BAR
#undef PG8_SCHED
}
}
#define GAS __attribute__((address_space(1)))
#define LAS __attribute__((address_space(3)))
typedef unsigned short bf16;
typedef unsigned v4u __attribute__((ext_vector_type(4)));
typedef float f32x4 __attribute__((ext_vector_type(4)));
typedef short bf16x8 __attribute__((ext_vector_type(8)));
typedef GAS unsigned gu32;
typedef GAS unsigned long long gu64;
#define RLX_AGENT __ATOMIC_RELAXED, __HIP_MEMORY_SCOPE_AGENT
#define LDS_WAIT() asm volatile("s_waitcnt lgkmcnt(0)" ::: "memory")
#define VM_WAIT() asm volatile("s_waitcnt vmcnt(0)" ::: "memory")
__device__ __forceinline__ unsigned long long rt() { return __builtin_amdgcn_s_memrealtime(); }
__device__ __forceinline__ unsigned f2bf(float f) { unsigned u = __builtin_bit_cast(unsigned, f); return (u + 0x7fffu + ((u >> 16) & 1u)) >> 16; }
__device__ __forceinline__ unsigned pk2(float lo, float hi) { return f2bf(lo) | (f2bf(hi) << 16); }

#define XB_TMO      128
#define XB_XCNT(j)  (256  + 64 * (j))
#define XB_XSUB(j)  (1280 + 64 * (j))
#define XB_XGEN(j)  (2304 + 64 * (j))
#define XB_TOP      3328
#define XB_TOPGEN   3392
#define XCD_BAR_WORDS 3456
#define XB_SPIN_CAP (1u << 18)

__device__ __forceinline__ unsigned xb_ld(unsigned* p)              { return __hip_atomic_load(p, __ATOMIC_RELAXED, __HIP_MEMORY_SCOPE_AGENT); }
__device__ __forceinline__ unsigned xb_add(unsigned* p, unsigned v) { return __hip_atomic_fetch_add(p, v, __ATOMIC_RELAXED, __HIP_MEMORY_SCOPE_AGENT); }
__device__ __forceinline__ unsigned xb_xcc_id() { return (unsigned)__builtin_amdgcn_s_getreg((3 << 11) | 20) & 0xFu; }
#define XB_SPIN(cond, bar) do { unsigned _sp = 0; while (cond) { __builtin_amdgcn_s_sleep(1); \
    if ((++_sp & 255u) == 0u) { if (xb_ld(&(bar)[XB_TMO])) break; if (_sp > XB_SPIN_CAP) { atomicAdd(&(bar)[XB_TMO], 1u); break; } } } } while (0)

struct XcdBarrier {
    unsigned* bar; unsigned x;
    volatile LAS unsigned* st;
};

__device__ __forceinline__ XcdBarrier xcd_barrier_post(unsigned* bar, volatile LAS unsigned* st) {
    XcdBarrier b; b.bar = bar; b.x = xb_xcc_id(); b.st = st;
    if (threadIdx.x == 0) (void)xb_add(&bar[XB_XCNT(b.x)], 1u);
    return b;
}
__device__ __forceinline__ void xcd_barrier_complete(unsigned* bar, unsigned x, unsigned& nloc, unsigned& nx) {
    const unsigned G = gridDim.x * gridDim.y * gridDim.z;
    unsigned sum, cnt, mine, sp = 0u;
    for (;;) {
        sum = 0u; cnt = 0u; mine = 0u;
#pragma unroll
        for (unsigned j = 0; j < 16; ++j) { const unsigned c = xb_ld(&bar[XB_XCNT(j)]); sum += c; cnt += (c > 0u) ? 1u : 0u; mine = (j == x) ? c : mine; }
        if (sum == G) break;
        __builtin_amdgcn_s_sleep(1);
        if ((++sp & 255u) == 0u) { if (xb_ld(&bar[XB_TMO])) break; if (sp > XB_SPIN_CAP) { atomicAdd(&bar[XB_TMO], 1u); break; } }
    }
    nloc = mine > 0u ? mine : 1u; nx = cnt > 0u ? cnt : 1u;
}

__device__ __forceinline__ void xcd_barrier(const XcdBarrier& b) {
    asm volatile("s_waitcnt vmcnt(0)" ::: "memory");
    __syncthreads();
    if (threadIdx.x == 0) {
        unsigned* bar = b.bar;
        __builtin_amdgcn_s_waitcnt(0);
        unsigned nloc = b.st[0], nx = b.st[1];
        if (nloc == 0u) { xcd_barrier_complete(bar, b.x, nloc, nx); b.st[0] = nloc; b.st[1] = nx; }
        const unsigned old = xb_add(&bar[XB_XSUB(b.x)], 1u);
        const unsigned gen = old / nloc;
        if (old + 1u == (gen + 1u) * nloc) {
            __builtin_amdgcn_fence(__ATOMIC_RELEASE, "agent");
            asm volatile("s_waitcnt vmcnt(0)" ::: "memory");
            const unsigned og = xb_add(&bar[XB_TOP], 1u);
            const unsigned tg = og / nx;
            if (og + 1u == (tg + 1u) * nx) xb_add(&bar[XB_TOPGEN], 1u);
            else XB_SPIN(xb_ld(&bar[XB_TOPGEN]) == tg, bar);
            __builtin_amdgcn_fence(__ATOMIC_ACQUIRE, "agent");
            xb_add(&bar[XB_XGEN(b.x)], 1u);
            asm volatile("s_waitcnt vmcnt(0)" ::: "memory");
        } else {
            XB_SPIN(xb_ld(&bar[XB_XGEN(b.x)]) == gen, bar);
            __builtin_amdgcn_fence(__ATOMIC_ACQUIRE, "agent");
            asm volatile("s_waitcnt vmcnt(0)" ::: "memory");
        }
    }
    __syncthreads();
}

constexpr int NWAVES = 8;
constexpr int NB = 8, SEQ = 4096, D = 1024, M = NB * SEQ, FF = 2816, FF2 = 2 * FF, DC = 512, DR = 512, NH = 8, HD = 64, CW = 31, RW = 4, NMIX = 2048;
constexpr float EPS = 1e-6f;
constexpr int LDM = 11 * D;
constexpr size_t MiB = 1u << 20;
constexpr size_t WS_CTL = 0, CTL_ZERO_BYTES = 1 * MiB;
constexpr size_t WS_MOD = 1 * MiB;
constexpr size_t WS_BIAS1 = 1 * MiB + 512 * 1024;
constexpr size_t WS_BIAS3 = 1 * MiB + 768 * 1024;
constexpr size_t WS_BIAS2 = 2 * MiB;
constexpr size_t WS_WGT = 2 * MiB + 128 * 1024;
constexpr size_t WS_CS1 = 2 * MiB + 384 * 1024, WS_CS3 = 2 * MiB + 448 * 1024;
constexpr size_t WS_RS1 = 2 * MiB + 512 * 1024, WS_RS3 = 2 * MiB + 640 * 1024;
constexpr size_t WS_CS2 = 2 * MiB + 480 * 1024, WS_RS2 = 2 * MiB + 768 * 1024;
constexpr size_t WS_TOT = 3 * MiB;
constexpr size_t WS_SSP = 5 * MiB;
constexpr size_t WS_W1I = 8 * MiB, WS_W1O = 19 * MiB, WS_WIN = 25 * MiB, WS_WOUT = 29 * MiB, WS_W2I = 31 * MiB, WS_W2O = 42 * MiB;
constexpr size_t WS_Y = 48 * MiB;
constexpr size_t WS_X1 = 112 * MiB;
constexpr size_t WS_ACT = 240 * MiB;
constexpr size_t WS_U = WS_ACT, WS_UX = WS_ACT + 32 * MiB, WS_GY = WS_ACT + 64 * MiB, WS_YMIX = WS_ACT + 96 * MiB;
constexpr size_t WS_SSPF = 416 * MiB;
constexpr size_t WS_SSPX = 418 * MiB;
constexpr size_t WS_SSPX3 = 422 * MiB;
constexpr size_t WS_END = 426 * MiB;
constexpr int CW_BAR = 4096, CW_SEAM = 16384, CW_SCAN = 32768, CW_SEAM7 = 49152, CW_SEAM3 = 65536;
constexpr int LDS_BYTES = 147456;
constexpr int LDSCTL_OFF = LDS_BYTES - 256;

typedef unsigned short u16;
typedef float f32x16 __attribute__((ext_vector_type(16)));
typedef float f32x2 __attribute__((ext_vector_type(2)));

__device__ __forceinline__ float wave_sum(float v) {
#pragma unroll
    for (int o = 1; o < 64; o <<= 1) v += __shfl_xor(v, o);
    return v;
}
__device__ __forceinline__ float sigmoid_fast(float x) { return __builtin_amdgcn_rcpf(1.f + __builtin_amdgcn_exp2f(-1.4426950408889634f * x)); }
__device__ __forceinline__ float silu_fast(float x) { return x * sigmoid_fast(x); }
__device__ __forceinline__ float gelu_tanh_fast(float x) { const float z = 0.7978845608028654f * (x + 0.044715f * x * x * x); return x * sigmoid_fast(2.f * z); }
__device__ __forceinline__ f32x4 sigmoid4(const f32x4 x) { const f32x4 t = x * -1.4426950408889634f; f32x4 e = {__builtin_amdgcn_exp2f(t[0]), __builtin_amdgcn_exp2f(t[1]), __builtin_amdgcn_exp2f(t[2]), __builtin_amdgcn_exp2f(t[3])};
    e = e + 1.0f; return (f32x4){__builtin_amdgcn_rcpf(e[0]), __builtin_amdgcn_rcpf(e[1]), __builtin_amdgcn_rcpf(e[2]), __builtin_amdgcn_rcpf(e[3])}; }
__device__ __forceinline__ f32x4 gelu_tanh4(const f32x4 x) { const f32x4 z2 = (x + (x * x) * x * 0.044715f) * (2.0f * 0.7978845608028654f); return x * sigmoid4(z2); }
__device__ __forceinline__ float bflo(unsigned w) { return __uint_as_float(w << 16); }
__device__ __forceinline__ float bfhi(unsigned w) { return __uint_as_float(w & 0xffff0000u); }
__device__ __forceinline__ unsigned cvtpk(float lo, float hi) { return pg8::cvt_pk_bf16(lo, hi); }
__device__ __forceinline__ v4u pack8(const f32x4 a, const f32x4 b) { v4u w; w.x = cvtpk(a[0], a[1]); w.y = cvtpk(a[2], a[3]); w.z = cvtpk(b[0], b[1]); w.w = cvtpk(b[2], b[3]); return w; }

__device__ __forceinline__ void unpack8(const v4u w, f32x4& a, f32x4& b) { a = (f32x4){bflo(w.x), bfhi(w.x), bflo(w.y), bfhi(w.y)}; b = (f32x4){bflo(w.z), bfhi(w.z), bflo(w.w), bfhi(w.w)}; }
__device__ __forceinline__ unsigned q8(float v) { int q = (int)__builtin_rintf(v); q = q < -127 ? -127 : (q > 127 ? 127 : q); return (unsigned)q & 0xffu; }
__device__ __forceinline__ unsigned q8x4(const f32x4 v) { return q8(v[0]) | (q8(v[1]) << 8) | (q8(v[2]) << 16) | (q8(v[3]) << 24); }
__device__ __forceinline__ float wave_max(float v) {
#pragma unroll
    for (int o = 1; o < 64; o <<= 1) v = fmaxf(v, __shfl_xor(v, o));
    return v;
}
typedef int i32x4v __attribute__((ext_vector_type(4)));
__device__ __forceinline__ f32x4 acc_i2f(const f32x4 a) { return __builtin_convertvector(__builtin_bit_cast(i32x4v, a), f32x4); }
__device__ __forceinline__ float clamp448(float v) { return __builtin_fminf(__builtin_fmaxf(v, -448.0f), 448.0f); }
__device__ __forceinline__ unsigned f8x4(const f32x4 v) { int w = __builtin_amdgcn_cvt_pk_fp8_f32(clamp448(v[0]), clamp448(v[1]), 0, false); w = __builtin_amdgcn_cvt_pk_fp8_f32(clamp448(v[2]), clamp448(v[3]), w, true); return (unsigned)w; }
constexpr float F8_ACT_SCALE = 8.0f, F8_W_SCALE = 2048.0f;
__device__ __forceinline__ void load_rstd(const float* ssp, int row0, int fq, float (&rs)[2][4]) {
#pragma unroll
    for (int ai = 0; ai < 2; ++ai)
#pragma unroll
        for (int m = 0; m < 4; ++m) { const f32x4 p = *(const f32x4*)(ssp + (size_t)(row0 + ai * 128 + m * 16) * 16 + 4 * fq);
            float s = (p[0] + p[1]) + (p[2] + p[3]); s += __shfl_xor(s, 16); s += __shfl_xor(s, 32); rs[ai][m] = rsqrtf(s * (1.0f / D) + EPS); }
}
__device__ __forceinline__ void load_rstd_sc1(const float* ssp, int row0, int fq, float (&rs)[2][4]) {
#pragma unroll
    for (int ai = 0; ai < 2; ++ai)
#pragma unroll
        for (int m = 0; m < 4; ++m) { const gu32* p = (const gu32*)(ssp + (size_t)(row0 + ai * 128 + m * 16) * 16 + 4 * fq);
            const float p0 = __uint_as_float(__hip_atomic_load(p, RLX_AGENT)), p1 = __uint_as_float(__hip_atomic_load(p + 1, RLX_AGENT)), p2 = __uint_as_float(__hip_atomic_load(p + 2, RLX_AGENT)), p3 = __uint_as_float(__hip_atomic_load(p + 3, RLX_AGENT));
            float s = (p0 + p1) + (p2 + p3); s += __shfl_xor(s, 16); s += __shfl_xor(s, 32); rs[ai][m] = rsqrtf(s * (1.0f / D) + EPS); }
}
#ifndef MK_EPI_SWIGLU_REPS
#define MK_EPI_SWIGLU_REPS 1
#endif
#ifndef MK_EPI_RESID_REPS
#define MK_EPI_RESID_REPS 1
#endif
struct EpiSwiglu {
    static constexpr bool PERM = true, AFTER_DRAIN = false; static constexpr int REPS = MK_EPI_SWIGLU_REPS;
    pg8::bf16_t* act; const float* ssp; const float* bias;
    __device__ __forceinline__ void operator()(const f32x4 (&acc)[2][2][4][2], const pg8::Unit& u, int wr, int wc, int fr, int fq) const {
        const int row0 = u.pm * 256 + wr * 64 + fr, b = u.pm >> 4;
        float rs[2][4]; load_rstd(ssp, row0, fq, rs);
        const float* bp = bias + (size_t)b * FF2 + u.pn * 256 + wc * 32 + 8 * fq;
        const f32x4 bg0 = *(const f32x4*)(bp), bg1 = *(const f32x4*)(bp + 4), bu0 = *(const f32x4*)(bp + 128), bu1 = *(const f32x4*)(bp + 132);
        const int oc = u.pn * 128 + wc * 32 + 8 * fq;
#pragma unroll
        for (int ai = 0; ai < 2; ++ai)
#pragma unroll
            for (int m = 0; m < 4; ++m) { const float r = rs[ai][m];
                const f32x4 g0 = acc[ai][0][m][0] * r + bg0, g1 = acc[ai][0][m][1] * r + bg1, u0 = acc[ai][1][m][0] * r + bu0, u1 = acc[ai][1][m][1] * r + bu1;
                const f32x4 a0 = (g0 * sigmoid4(g0)) * u0, a1 = (g1 * sigmoid4(g1)) * u1;
                *(v4u*)(act + (size_t)(row0 + ai * 128 + m * 16) * FF + oc) = pack8(a0, a1); }
    }
};
template <bool OUT8> struct EpiSwiglu8 {
    static constexpr bool PERM = true, AFTER_DRAIN = false; static constexpr int REPS = 1;
    pg8::bf16_t* act; const float* rs; const float* cs; const float* bias;
    __device__ __forceinline__ void operator()(const f32x4 (&acc)[2][2][4][2], const pg8::Unit& u, int wr, int wc, int fr, int fq) const {
        const int row0 = u.pm * 256 + wr * 64 + fr, b = u.pm >> 4;
        float rv[2][4];
#pragma unroll
        for (int ai = 0; ai < 2; ++ai)
#pragma unroll
            for (int m = 0; m < 4; ++m) rv[ai][m] = rs[row0 + ai * 128 + m * 16];
        const int cb = u.pn * 256 + wc * 32 + 8 * fq;
        const float* bp = bias + (size_t)b * FF2 + cb; const float* cp = cs + cb;
        const f32x4 bg0 = *(const f32x4*)(bp), bg1 = *(const f32x4*)(bp + 4), bu0 = *(const f32x4*)(bp + 128), bu1 = *(const f32x4*)(bp + 132);
        const f32x4 cg0 = *(const f32x4*)(cp), cg1 = *(const f32x4*)(cp + 4), cu0 = *(const f32x4*)(cp + 128), cu1 = *(const f32x4*)(cp + 132);
        const int oc = u.pn * 128 + wc * 32 + 8 * fq;
#pragma unroll
        for (int ai = 0; ai < 2; ++ai)
#pragma unroll
            for (int m = 0; m < 4; ++m) { const float r = rv[ai][m];
                const f32x4 g0 = acc_i2f(acc[ai][0][m][0]) * (cg0 * r) + bg0, g1 = acc_i2f(acc[ai][0][m][1]) * (cg1 * r) + bg1;
                const f32x4 u0 = acc_i2f(acc[ai][1][m][0]) * (cu0 * r) + bu0, u1 = acc_i2f(acc[ai][1][m][1]) * (cu1 * r) + bu1;
                const f32x4 a0 = (g0 * sigmoid4(g0)) * u0, a1 = (g1 * sigmoid4(g1)) * u1;
                if (OUT8) *(unsigned long long*)((unsigned char*)act + (size_t)(row0 + ai * 128 + m * 16) * FF + oc) = (unsigned long long)f8x4(a0 * F8_ACT_SCALE) | ((unsigned long long)f8x4(a1 * F8_ACT_SCALE) << 32);
                else *(v4u*)(act + (size_t)(row0 + ai * 128 + m * 16) * FF + oc) = pack8(a0, a1); }
    }
};
template <int WHALF, bool HASY, bool IN16, bool F8 = false> struct EpiResid {
    static constexpr bool PERM = true, AFTER_DRAIN = false; static constexpr int REPS = (IN16 ? 1 : MK_EPI_RESID_REPS);
    static constexpr float w = (WHALF ? 0.5f : 1.0f) * (F8 ? 1.0f / (F8_ACT_SCALE * F8_W_SCALE) : 1.0f);
    const void* xin; pg8::bf16_t* xout; pg8::bf16_t* y; float* ssp; const float* gt; const float* gnext; const float* scnext;
    __device__ __forceinline__ void operator()(const f32x4 (&acc)[2][2][4][2], const pg8::Unit& u, int wr, int wc, int fr, int fq) const {
        const int row0 = u.pm * 256 + wr * 64 + fr, b = u.pm >> 4;
        float ss[2][4];
#pragma unroll
        for (int ai = 0; ai < 2; ++ai)
#pragma unroll
            for (int m = 0; m < 4; ++m) ss[ai][m] = 0.f;
#pragma unroll
        for (int bj = 0; bj < 2; ++bj) { const int c0 = u.pn * 256 + bj * 128 + wc * 32 + 8 * fq;
            const f32x4 gt0 = *(const f32x4*)(gt + (size_t)b * LDM + c0) * w, gt1 = *(const f32x4*)(gt + (size_t)b * LDM + c0 + 4) * w;
            f32x4 gs0 = {0.f, 0.f, 0.f, 0.f}, gs1 = gs0;
            if (HASY) { gs0 = *(const f32x4*)(gnext + c0) * (*(const f32x4*)(scnext + (size_t)b * LDM + c0) + 1.0f); gs1 = *(const f32x4*)(gnext + c0 + 4) * (*(const f32x4*)(scnext + (size_t)b * LDM + c0 + 4) + 1.0f); }
#pragma unroll
            for (int ai = 0; ai < 2; ++ai)
#pragma unroll
                for (int m = 0; m < 4; ++m) { const size_t off = (size_t)(row0 + ai * 128 + m * 16) * D + c0;
                    f32x4 x0, x1;
                    if (IN16) unpack8(*(const v4u*)((const pg8::bf16_t*)xin + off), x0, x1); else { x0 = *(const f32x4*)((const float*)xin + off); x1 = *(const f32x4*)((const float*)xin + off + 4); }
                    const f32x4 o0 = x0 + gt0 * acc[ai][bj][m][0], o1 = x1 + gt1 * acc[ai][bj][m][1];
                    *(v4u*)(xout + off) = pack8(o0, o1);
                    ss[ai][m] += (o0[0] * o0[0] + o0[1] * o0[1]) + (o0[2] * o0[2] + o0[3] * o0[3]) + (o1[0] * o1[0] + o1[1] * o1[1]) + (o1[2] * o1[2] + o1[3] * o1[3]);
                    if (HASY) *(v4u*)(y + off) = pack8(o0 * gs0, o1 * gs1); } }
#pragma unroll
        for (int ai = 0; ai < 2; ++ai)
#pragma unroll
            for (int m = 0; m < 4; ++m) { float s = ss[ai][m]; s += __shfl_xor(s, 16); s += __shfl_xor(s, 32);
                if (fq == 0) ssp[(size_t)(row0 + ai * 128 + m * 16) * 16 + u.pn * 4 + wc] = s; }
    }
};
template <int WHALF, bool IN16> struct EpiResidQ {
    static constexpr bool PERM = true, AFTER_DRAIN = false; static constexpr int REPS = 1;
    static constexpr float w = WHALF ? 0.5f : 1.0f;
    const void* xin; pg8::bf16_t* xout; unsigned char* a8; float* rs; f32x2* sspx; const float* gt; const float* gnext; const float* scnext; unsigned* cnt;
    __device__ __forceinline__ void operator()(f32x4 (&acc)[2][2][4][2], const pg8::Unit& u, int wr, int wc, int fr, int fq) const {
        const int row0 = u.pm * 256 + wr * 64 + fr, b = u.pm >> 4;
        float ss[2][4], am[2][4];
#pragma unroll
        for (int ai = 0; ai < 2; ++ai)
#pragma unroll
            for (int m = 0; m < 4; ++m) { ss[ai][m] = 0.f; am[ai][m] = 0.f; }
        const unsigned voff = (unsigned)((row0 * D + u.pn * 256 + wc * 32 + 8 * fq) * 2);
        unsigned vo[4] = {voff, voff, voff, voff};
#pragma unroll
        for (int bj = 0; bj < 2; ++bj) { const int c0 = u.pn * 256 + bj * 128 + wc * 32 + 8 * fq;
            const f32x4 gt0 = *(const f32x4*)(gt + (size_t)b * LDM + c0) * w, gt1 = *(const f32x4*)(gt + (size_t)b * LDM + c0 + 4) * w;
            const f32x4 gs0 = *(const f32x4*)(gnext + c0) * (*(const f32x4*)(scnext + (size_t)b * LDM + c0) + 1.0f), gs1 = *(const f32x4*)(gnext + c0 + 4) * (*(const f32x4*)(scnext + (size_t)b * LDM + c0 + 4) + 1.0f);
#pragma unroll
            for (int ai = 0; ai < 2; ++ai)
#pragma unroll
                for (int m = 0; m < 4; ++m) { const unsigned so = (unsigned)(((ai * 128 + m * 16) * D + bj * 128) * 2); const int g = m & 3;
                    f32x4 x0, x1;
                    if (IN16) unpack8(*(const v4u*)((const char*)xin + (size_t)(vo[g] + so)), x0, x1);
                    else { const char* p = (const char*)xin + 2 * (size_t)(vo[g] + so); x0 = *(const f32x4*)p; x1 = *(const f32x4*)(p + 16); }
                    const f32x4 o0 = x0 + gt0 * acc[ai][bj][m][0], o1 = x1 + gt1 * acc[ai][bj][m][1];
                    *(v4u*)((char*)xout + (size_t)(vo[g] + so)) = pack8(o0, o1);
                    acc[ai][bj][m][0] = o0; acc[ai][bj][m][1] = o1;
                    ss[ai][m] += (o0[0] * o0[0] + o0[1] * o0[1]) + (o0[2] * o0[2] + o0[3] * o0[3]) + (o1[0] * o1[0] + o1[1] * o1[1]) + (o1[2] * o1[2] + o1[3] * o1[3]);
                    const f32x4 t0 = __builtin_elementwise_abs(o0 * gs0), t1 = __builtin_elementwise_abs(o1 * gs1);
                    am[ai][m] = fmaxf(am[ai][m], fmaxf(fmaxf(fmaxf(t0[0], t0[1]), fmaxf(t0[2], t0[3])), fmaxf(fmaxf(t1[0], t1[1]), fmaxf(t1[2], t1[3]))));
                    asm volatile("" : "+v"(vo[g]) : "v"(ss[ai][m])); } }
#pragma unroll
        for (int ai = 0; ai < 2; ++ai)
#pragma unroll
            for (int m = 0; m < 4; ++m) { float s = ss[ai][m], a = am[ai][m]; s += __shfl_xor(s, 16); s += __shfl_xor(s, 32); a = fmaxf(a, __shfl_xor(a, 16)); a = fmaxf(a, __shfl_xor(a, 32));
                if (fq == 0) __hip_atomic_store((gu64*)(sspx + (size_t)(row0 + ai * 128 + m * 16) * 16 + u.pn * 4 + wc), ((unsigned long long)__float_as_uint(a) << 32) | __float_as_uint(s), RLX_AGENT); }
        asm volatile("s_waitcnt vmcnt(0)" ::: "memory");
        unsigned* cw = cnt + 64 * u.pm;
        if ((threadIdx.x & 63) == 0) __hip_atomic_fetch_add(cw, 1u, __ATOMIC_RELAXED, __HIP_MEMORY_SCOPE_AGENT);
        if (threadIdx.x < 64) {
            unsigned sp = 0;
            while ((unsigned)__builtin_amdgcn_readfirstlane(__hip_atomic_load(cw, __ATOMIC_RELAXED, __HIP_MEMORY_SCOPE_AGENT)) < 32u) { __builtin_amdgcn_s_sleep(1); if (++sp > (1u << 20)) break; }
            __builtin_amdgcn_fence(__ATOMIC_ACQUIRE, "agent");
            asm volatile("s_waitcnt vmcnt(0)" ::: "memory");
        }
        asm volatile("" ::: "memory"); __builtin_amdgcn_s_barrier(); asm volatile("" ::: "memory");
        float qs[2][4];
#pragma unroll
        for (int ai = 0; ai < 2; ++ai)
#pragma unroll
            for (int m = 0; m < 4; ++m) { const int row = row0 + ai * 128 + m * 16; const gu64* p = (const gu64*)(sspx + (size_t)row * 16 + 4 * fq);
                float s = 0.f, a = 0.f;
#pragma unroll
                for (int e = 0; e < 4; ++e) { const unsigned long long t = __hip_atomic_load(p + e, RLX_AGENT); s += __uint_as_float((unsigned)t); a = fmaxf(a, __uint_as_float((unsigned)(t >> 32))); }
                s += __shfl_xor(s, 16); s += __shfl_xor(s, 32); a = fmaxf(a, __shfl_xor(a, 16)); a = fmaxf(a, __shfl_xor(a, 32));
                qs[ai][m] = a > 0.f ? 127.0f / a : 0.f;
                if (u.pn == 0 && wc == 0 && fq == 0) rs[row] = rsqrtf(s * (1.0f / D) + EPS) * a * (1.0f / 127.0f); }
        const unsigned voff8 = (unsigned)(row0 * D + u.pn * 256 + wc * 32 + 8 * fq);
#pragma unroll
        for (int bj = 0; bj < 2; ++bj) { const int c0 = u.pn * 256 + bj * 128 + wc * 32 + 8 * fq;
            const f32x4 gs0 = *(const f32x4*)(gnext + c0) * (*(const f32x4*)(scnext + (size_t)b * LDM + c0) + 1.0f), gs1 = *(const f32x4*)(gnext + c0 + 4) * (*(const f32x4*)(scnext + (size_t)b * LDM + c0 + 4) + 1.0f);
#pragma unroll
            for (int ai = 0; ai < 2; ++ai)
#pragma unroll
                for (int m = 0; m < 4; ++m) { const float q = qs[ai][m]; const unsigned so = (unsigned)((ai * 128 + m * 16) * D + bj * 128);
                    *(unsigned long long*)(a8 + (size_t)(voff8 + so)) = (unsigned long long)q8x4(acc[ai][bj][m][0] * gs0 * q) | ((unsigned long long)q8x4(acc[ai][bj][m][1] * gs1 * q) << 32); } }
    }
};
template <bool F8> struct EpiResidFinal {
    static constexpr bool PERM = true, AFTER_DRAIN = false; static constexpr int REPS = 1;
    static constexpr float ascale = F8 ? 1.0f / (F8_ACT_SCALE * F8_W_SCALE) : 1.0f;
    const pg8::bf16_t* xin; float* out; float* ssp; const float* gt; const float* gf; const float* fsc; const float* fsh; unsigned* cnt;
    __device__ __forceinline__ void operator()(f32x4 (&acc)[2][2][4][2], const pg8::Unit& u, int wr, int wc, int fr, int fq) const {
        const int row0 = u.pm * 256 + wr * 64 + fr, b = u.pm >> 4;
        const __amdgpu_buffer_rsrc_t rx = __builtin_amdgcn_make_buffer_rsrc((void*)xin, 0, M * D * 4, 0x00020000), ro = __builtin_amdgcn_make_buffer_rsrc((void*)out, 0, M * D * 4, 0x00020000);
        const unsigned voff = (unsigned)((row0 * D + u.pn * 256 + wc * 32 + 8 * fq) * 4);
        float ss[2][4];
#pragma unroll
        for (int ai = 0; ai < 2; ++ai)
#pragma unroll
            for (int m = 0; m < 4; ++m) ss[ai][m] = 0.f;
        unsigned vo[4] = {voff, voff, voff, voff};
#pragma unroll
        for (int bj = 0; bj < 2; ++bj) { const int c0 = u.pn * 256 + bj * 128 + wc * 32 + 8 * fq;
            const float hw = 0.5f * ascale; const f32x4 gt0 = *(const f32x4*)(gt + (size_t)b * LDM + c0) * hw, gt1 = *(const f32x4*)(gt + (size_t)b * LDM + c0 + 4) * hw;
#pragma unroll
            for (int ai = 0; ai < 2; ++ai)
#pragma unroll
                for (int m = 0; m < 4; ++m) { const unsigned so = (unsigned)(((ai * 128 + m * 16) * D + bj * 128) * 4); const int g = m & 3;
                    f32x4 x0, x1; unpack8(*(const v4u*)((const char*)xin + (size_t)((vo[g] + so) >> 1)), x0, x1);
                    const f32x4 o0 = x0 + gt0 * acc[ai][bj][m][0], o1 = x1 + gt1 * acc[ai][bj][m][1];
                    acc[ai][bj][m][0] = o0; acc[ai][bj][m][1] = o1;
                    ss[ai][m] += (o0[0] * o0[0] + o0[1] * o0[1]) + (o0[2] * o0[2] + o0[3] * o0[3]) + (o1[0] * o1[0] + o1[1] * o1[1]) + (o1[2] * o1[2] + o1[3] * o1[3]);
                    asm volatile("" : "+v"(vo[g]) : "v"(ss[ai][m])); } }
#pragma unroll
        for (int ai = 0; ai < 2; ++ai)
#pragma unroll
            for (int m = 0; m < 4; ++m) { float s = ss[ai][m]; s += __shfl_xor(s, 16); s += __shfl_xor(s, 32);
                if (fq == 0) __hip_atomic_store((gu32*)(ssp + (size_t)(row0 + ai * 128 + m * 16) * 16 + u.pn * 4 + wc), __float_as_uint(s), RLX_AGENT); }
        asm volatile("s_waitcnt vmcnt(0)" ::: "memory");
        unsigned* cw = cnt + 64 * u.pm;
        if ((threadIdx.x & 63) == 0) __hip_atomic_fetch_add(cw, 1u, __ATOMIC_RELAXED, __HIP_MEMORY_SCOPE_AGENT);
        if (threadIdx.x < 64) {
            unsigned sp = 0;
            while ((unsigned)__builtin_amdgcn_readfirstlane(__hip_atomic_load(cw, __ATOMIC_RELAXED, __HIP_MEMORY_SCOPE_AGENT)) < 32u) { __builtin_amdgcn_s_sleep(1); if (++sp > (1u << 20)) break; }
            __builtin_amdgcn_fence(__ATOMIC_ACQUIRE, "agent");
            asm volatile("s_waitcnt vmcnt(0)" ::: "memory");
        }
        asm volatile("" ::: "memory"); __builtin_amdgcn_s_barrier(); asm volatile("" ::: "memory");
        float rs[2][4]; load_rstd_sc1(ssp, row0, fq, rs);
#pragma unroll
        for (int bj = 0; bj < 2; ++bj) { const int c0 = u.pn * 256 + bj * 128 + wc * 32 + 8 * fq;
            const f32x4 gs0 = *(const f32x4*)(gf + c0) * (*(const f32x4*)(fsc + (size_t)b * LDM + c0) + 1.0f), gs1 = *(const f32x4*)(gf + c0 + 4) * (*(const f32x4*)(fsc + (size_t)b * LDM + c0 + 4) + 1.0f);
            const f32x4 sh0 = *(const f32x4*)(fsh + (size_t)b * LDM + c0), sh1 = *(const f32x4*)(fsh + (size_t)b * LDM + c0 + 4);
#pragma unroll
            for (int ai = 0; ai < 2; ++ai)
#pragma unroll
                for (int m = 0; m < 4; ++m) { const unsigned so = (unsigned)(((ai * 128 + m * 16) * D + bj * 128) * 4); const float r = rs[ai][m];
                    *(f32x4*)((char*)out + (size_t)voff + so) = acc[ai][bj][m][0] * r * gs0 + sh0;
                    *(f32x4*)((char*)out + (size_t)voff + so + 16) = acc[ai][bj][m][1] * r * gs1 + sh1; } }
    }
};
struct EpiMixIn {
    static constexpr bool PERM = true, AFTER_DRAIN = false; static constexpr int REPS = 1;
    pg8::bf16_t *U, *UX, *GY; const float* ssp; const float* bias;
    __device__ __forceinline__ void operator()(const f32x4 (&acc)[2][2][4][2], const pg8::Unit& u, int wr, int wc, int fr, int fq) const {
        const int row0 = u.pm * 256 + wr * 64 + fr, b = u.pm >> 4;
        float rs[2][4]; load_rstd(ssp, row0, fq, rs);
        const float* bp = bias + (size_t)b * NMIX + u.pn * 256 + wc * 32 + 8 * fq;
        const f32x4 b00 = *(const f32x4*)(bp), b01 = *(const f32x4*)(bp + 4), b10 = *(const f32x4*)(bp + 128), b11 = *(const f32x4*)(bp + 132);
        if (u.pn < 4) {
            const int oc = u.pn * 128 + wc * 32 + 8 * fq;
#pragma unroll
            for (int ai = 0; ai < 2; ++ai)
#pragma unroll
                for (int m = 0; m < 4; ++m) { const float r = rs[ai][m];
                    const f32x4 v0 = acc[ai][0][m][0] * r + b00, v1 = acc[ai][0][m][1] * r + b01, g0 = acc[ai][1][m][0] * r + b10, g1 = acc[ai][1][m][1] * r + b11;
                    const f32x4 a0 = v0 * sigmoid4(g0), a1 = v1 * sigmoid4(g1);
                    *(v4u*)(U + (size_t)(row0 + ai * 128 + m * 16) * DC + oc) = pack8(a0, a1); }
        } else {
            pg8::bf16_t* dst = (u.pn < 6) ? UX : GY; const bool gel = u.pn >= 6; const int pc = (u.pn & 1) * 256 + wc * 32 + 8 * fq;
#pragma unroll
            for (int ai = 0; ai < 2; ++ai)
#pragma unroll
                for (int m = 0; m < 4; ++m) { const float r = rs[ai][m];
#pragma unroll
                    for (int bj = 0; bj < 2; ++bj) { f32x4 v0 = acc[ai][bj][m][0] * r + (bj ? b10 : b00), v1 = acc[ai][bj][m][1] * r + (bj ? b11 : b01);
                        if (gel) { v0 = gelu_tanh4(v0); v1 = gelu_tanh4(v1); }
                        *(v4u*)(dst + (size_t)(row0 + ai * 128 + m * 16) * DR + pc + bj * 128) = pack8(v0, v1); } }
        }
    }
};

struct EpiMixIn8 {
    static constexpr bool PERM = true, AFTER_DRAIN = false; static constexpr int REPS = 1;
    pg8::bf16_t *U, *UX, *GY; const float* rs; const float* cs; const float* bias;
    __device__ __forceinline__ void operator()(const f32x4 (&acc)[2][2][4][2], const pg8::Unit& u, int wr, int wc, int fr, int fq) const {
        const int row0 = u.pm * 256 + wr * 64 + fr, b = u.pm >> 4;
        float rv[2][4];
#pragma unroll
        for (int ai = 0; ai < 2; ++ai)
#pragma unroll
            for (int m = 0; m < 4; ++m) rv[ai][m] = rs[row0 + ai * 128 + m * 16];
        const int cb = u.pn * 256 + wc * 32 + 8 * fq;
        const float* bp = bias + (size_t)b * NMIX + cb; const float* cp = cs + cb;
        const f32x4 b00 = *(const f32x4*)(bp), b01 = *(const f32x4*)(bp + 4), b10 = *(const f32x4*)(bp + 128), b11 = *(const f32x4*)(bp + 132);
        const f32x4 c00 = *(const f32x4*)(cp), c01 = *(const f32x4*)(cp + 4), c10 = *(const f32x4*)(cp + 128), c11 = *(const f32x4*)(cp + 132);
        if (u.pn < 4) {
            const int oc = u.pn * 128 + wc * 32 + 8 * fq;
#pragma unroll
            for (int ai = 0; ai < 2; ++ai)
#pragma unroll
                for (int m = 0; m < 4; ++m) { const float r = rv[ai][m];
                    const f32x4 v0 = acc_i2f(acc[ai][0][m][0]) * (c00 * r) + b00, v1 = acc_i2f(acc[ai][0][m][1]) * (c01 * r) + b01;
                    const f32x4 g0 = acc_i2f(acc[ai][1][m][0]) * (c10 * r) + b10, g1 = acc_i2f(acc[ai][1][m][1]) * (c11 * r) + b11;
                    const f32x4 a0 = v0 * sigmoid4(g0), a1 = v1 * sigmoid4(g1);
                    *(v4u*)(U + (size_t)(row0 + ai * 128 + m * 16) * DC + oc) = pack8(a0, a1); }
        } else {
            pg8::bf16_t* dst = (u.pn < 6) ? UX : GY; const bool gel = u.pn >= 6; const int pc = (u.pn & 1) * 256 + wc * 32 + 8 * fq;
#pragma unroll
            for (int ai = 0; ai < 2; ++ai)
#pragma unroll
                for (int m = 0; m < 4; ++m) { const float r = rv[ai][m];
#pragma unroll
                    for (int bj = 0; bj < 2; ++bj) { f32x4 v0 = acc_i2f(acc[ai][bj][m][0]) * ((bj ? c10 : c00) * r) + (bj ? b10 : b00), v1 = acc_i2f(acc[ai][bj][m][1]) * ((bj ? c11 : c01) * r) + (bj ? b11 : b01);
                        if (gel) { v0 = gelu_tanh4(v0); v1 = gelu_tanh4(v1); }
                        *(v4u*)(dst + (size_t)(row0 + ai * 128 + m * 16) * DR + pc + bj * 128) = pack8(v0, v1); } }
        }
    }
};

__device__ __forceinline__ void p0_gemv(LAS unsigned char* lds, const float* c, const float* W, int NC, const float* bias, float* out, int j0, int tid) {
    LAS float* ca = (LAS float*)lds; LAS float* part = (LAS float*)(lds + 32768);
    for (int i = tid; i < NB * D; i += 512) { const float v = c[i]; ca[i] = v / (1.f + expf(-v)); }
    __syncthreads();
    const int cg = tid & 31, ks = tid >> 5;
    const float* wp = W + (size_t)(64 * ks) * NC + j0 + 4 * cg;
    f32x4 acc[NB];
#pragma unroll
    for (int b = 0; b < NB; ++b) acc[b] = (f32x4){0.f, 0.f, 0.f, 0.f};
#pragma unroll 4
    for (int kk = 0; kk < 64; ++kk) { const f32x4 w = *(const f32x4*)(wp + (size_t)kk * NC);
#pragma unroll
        for (int b = 0; b < NB; ++b) acc[b] += w * ca[b * D + 64 * ks + kk]; }
#pragma unroll
    for (int b = 0; b < NB; ++b) *(LAS f32x4*)(part + (ks * NB + b) * 128 + 4 * cg) = acc[b];
    __syncthreads();
#pragma unroll
    for (int r = 0; r < 2; ++r) { const int o = tid + 512 * r, b = o >> 7, col = o & 127; float s = 0.f;
#pragma unroll
        for (int k2 = 0; k2 < 16; ++k2) s += part[(k2 * NB + b) * 128 + col];
        out[(size_t)b * LDM + j0 + col] = s + bias[j0 + col]; }
    __syncthreads();
}
__device__ __forceinline__ int rowmap(int kind, int n0) {
    if (kind == 1) { const int half = n0 / FF, f = n0 - half * FF; return 256 * (f >> 7) + 128 * half + (f & 127); }
    if (kind == 2 && n0 < 1024) { const int half = n0 >> 9, f = n0 & 511; return 256 * (f >> 7) + 128 * half + (f & 127); }
    return n0;
}
__device__ __forceinline__ void p0_transpose_item(const float* W, int K, int N, bf16* WT, int kind, LAS float* scr, int item, int lane) {
    const int nblk = N / 32, kb = item / nblk, nb = item % nblk, k0 = 64 * kb, n0 = 32 * nb, r0 = rowmap(kind, n0);
#pragma unroll 8
    for (int i = 0; i < 32; ++i) { const int kk = 2 * i + (lane >> 5); scr[kk * 33 + (lane & 31)] = W[(size_t)(k0 + kk) * N + n0 + (lane & 31)]; }
    LDS_WAIT(); asm volatile("" ::: "memory");
    const int c = lane & 7;
#pragma unroll
    for (int j = 0; j < 4; ++j) { const int n = (lane >> 3) + 8 * j; const LAS float* s = scr + (8 * c) * 33 + n;
        v4u o; o.x = pk2(s[0 * 33], s[1 * 33]); o.y = pk2(s[2 * 33], s[3 * 33]); o.z = pk2(s[4 * 33], s[5 * 33]); o.w = pk2(s[6 * 33], s[7 * 33]);
        *(GAS v4u*)(WT + (size_t)(r0 + n) * K + k0 + 8 * c) = o; }
    LDS_WAIT(); asm volatile("" ::: "memory");
}

__device__ __forceinline__ void p0_transpose8_item(const float* W, int K, int N, unsigned char* WT, LAS float* scr, int item, int lane) {
    const int nblk = N / 32, kb = item / nblk, nb = item % nblk, k0 = 64 * kb, n0 = 32 * nb;
#pragma unroll 8
    for (int i = 0; i < 32; ++i) { const int kk = 2 * i + (lane >> 5); scr[kk * 33 + (lane & 31)] = W[(size_t)(k0 + kk) * N + n0 + (lane & 31)]; }
    LDS_WAIT(); asm volatile("" ::: "memory");
    const int n = lane >> 1, kh = (lane & 1) * 32; const LAS float* sp = scr + n;
#pragma unroll
    for (int hq = 0; hq < 2; ++hq) { v4u o;
#pragma unroll
        for (int dq = 0; dq < 4; ++dq) { const int k = kh + 16 * hq + 4 * dq;
            const unsigned w4 = f8x4((f32x4){sp[(k + 0) * 33], sp[(k + 1) * 33], sp[(k + 2) * 33], sp[(k + 3) * 33]} * F8_W_SCALE);
            if (dq == 0) o.x = w4; else if (dq == 1) o.y = w4; else if (dq == 2) o.z = w4; else o.w = w4; }
        *(GAS v4u*)(WT + (size_t)(n0 + n) * K + k0 + kh + 16 * hq) = o; }
    LDS_WAIT(); asm volatile("" ::: "memory");
}
__device__ __forceinline__ void p0_quant_item(LAS unsigned char* lds, const float* W, int N, int kind, unsigned char* W8, float* cs, int nb, int lane, int wave) {
    LAS float* scr = (LAS float*)(lds + wave * 16896);
    LAS float* cm = (LAS float*)(lds + 8 * 16896);
    const int n0 = 32 * nb, r0 = rowmap(kind, n0);
#pragma unroll
    for (int tl = 0; tl < 2; ++tl) { const int k0 = 64 * (2 * wave + tl);
#pragma unroll 8
        for (int i = 0; i < 32; ++i) { const int kk = 2 * i + (lane >> 5); scr[tl * 2112 + kk * 33 + (lane & 31)] = W[(size_t)(k0 + kk) * N + n0 + (lane & 31)]; } }
    LDS_WAIT(); asm volatile("" ::: "memory");
    float mx = 0.f;
#pragma unroll
    for (int tl = 0; tl < 2; ++tl)
#pragma unroll 8
        for (int r = 0; r < 32; ++r) mx = fmaxf(mx, fabsf(scr[tl * 2112 + ((lane >> 5) * 32 + r) * 33 + (lane & 31)]));
    mx = fmaxf(mx, __shfl_xor(mx, 32));
    if (lane < 32) cm[wave * 32 + lane] = mx;
    __syncthreads();
    float cmax = 0.f;
#pragma unroll
    for (int w = 0; w < 8; ++w) cmax = fmaxf(cmax, cm[w * 32 + (lane & 31)]);
    const float sc = cmax > 0.f ? 127.0f / cmax : 0.f;
    if (wave == 0 && lane < 32) cs[r0 + lane] = cmax * (1.0f / 127.0f);
    const int n = lane >> 1, kh = (lane & 1) * 32;
    const float sn = __shfl(sc, n);
#pragma unroll
    for (int tl = 0; tl < 2; ++tl) { const int k0 = 64 * (2 * wave + tl); const LAS float* sp = scr + tl * 2112 + n;
#pragma unroll
        for (int hq = 0; hq < 2; ++hq) { v4u o;
#pragma unroll
            for (int dq = 0; dq < 4; ++dq) { const int k = kh + 16 * hq + 4 * dq;
                const unsigned w4 = q8(sp[(k + 0) * 33] * sn) | (q8(sp[(k + 1) * 33] * sn) << 8) | (q8(sp[(k + 2) * 33] * sn) << 16) | (q8(sp[(k + 3) * 33] * sn) << 24);
                if (dq == 0) o.x = w4; else if (dq == 1) o.y = w4; else if (dq == 2) o.z = w4; else o.w = w4; }
            *(GAS v4u*)(W8 + (size_t)(r0 + n) * D + k0 + kh + 16 * hq) = o; } }
    __syncthreads();
}

__device__ __forceinline__ void mix_conv(LAS unsigned char* lds, const bf16* U, const float* conv_w, const float* conv_b, const float* ln_g, const float* ln_b, bf16* YMIX, int G, int bx, int tid, int lane, int wave) {
    LAS unsigned char* IN = lds;
    LAS f32x4* WA = (LAS f32x4*)(lds + 63488);
    LAS f32x4* WB = WA + 31 * 64;
    for (int i = tid; i < 31 * 64; i += 512) { const int k = i >> 6, l = i & 63; WA[i] = *(const f32x4*)(conv_w + k * DC + 8 * l); WB[i] = *(const f32x4*)(conv_w + k * DC + 8 * l + 4); }
    const f32x4 cb0 = *(const f32x4*)(conv_b + 8 * lane), cb1 = *(const f32x4*)(conv_b + 8 * lane + 4);
    const f32x4 lg0 = *(const f32x4*)(ln_g + 8 * lane), lg1 = *(const f32x4*)(ln_g + 8 * lane + 4);
    const f32x4 lb0 = *(const f32x4*)(ln_b + 8 * lane), lb1 = *(const f32x4*)(ln_b + 8 * lane + 4);
    v4u pre[8];
#pragma unroll
    for (int i = 0; i < 8; ++i) { const int q = tid + 512 * i, row = q >> 6, ch = q & 63, tok = (bx & 127) * 32 - 30 + row; pre[i] = (v4u){0u, 0u, 0u, 0u};
        if (bx < NB * (SEQ / 32) && q < 62 * 64 && tok >= 0) pre[i] = *(const v4u*)(U + ((size_t)((bx >> 7) * SEQ + tok)) * DC + 8 * ch); }
    for (int item = bx; item < NB * (SEQ / 32); item += G) {
        const int b = item >> 7, t0 = (item & 127) * 32;
        __syncthreads();
#pragma unroll
        for (int i = 0; i < 8; ++i) { const int q = tid + 512 * i; if (q < 62 * 64) *(LAS v4u*)(IN + (q >> 6) * 1024 + (q & 63) * 16) = pre[i]; }
        { const int nitem = item + G, nb = nitem >> 7, nt0 = (nitem & 127) * 32;
#pragma unroll
            for (int i = 0; i < 8; ++i) { const int q = tid + 512 * i, row = q >> 6, ch = q & 63, tok = nt0 - 30 + row; pre[i] = (v4u){0u, 0u, 0u, 0u};
                if (nitem < NB * (SEQ / 32) && q < 62 * 64 && tok >= 0) pre[i] = *(const v4u*)(U + ((size_t)(nb * SEQ + tok)) * DC + 8 * ch); } }
        __syncthreads();
        f32x4 a0[4], a1[4];
#pragma unroll
        for (int tt = 0; tt < 4; ++tt) { a0[tt] = cb0; a1[tt] = cb1; }
        f32x4 wa0 = {0.f, 0.f, 0.f, 0.f}, wa1 = wa0, wa2 = wa0, wa3 = wa0, wb0 = wa0, wb1 = wa0, wb2 = wa0, wb3 = wa0;
#pragma unroll
        for (int kk = 0; kk < 34; ++kk) {
            const v4u v = *(const LAS v4u*)(IN + (4 * wave + kk) * 1024 + lane * 16);
            const f32x4 x0 = {bflo(v.x), bfhi(v.x), bflo(v.y), bfhi(v.y)}, x1 = {bflo(v.z), bfhi(v.z), bflo(v.w), bfhi(v.w)};
            wa3 = wa2; wa2 = wa1; wa1 = wa0; wb3 = wb2; wb2 = wb1; wb1 = wb0;
            if (kk <= 30) { wa0 = WA[kk * 64 + lane]; wb0 = WB[kk * 64 + lane]; } else { wa0 = (f32x4){0.f, 0.f, 0.f, 0.f}; wb0 = wa0; }
            a0[0] += wa0 * x0; a1[0] += wb0 * x1; a0[1] += wa1 * x0; a1[1] += wb1 * x1; a0[2] += wa2 * x0; a1[2] += wb2 * x1; a0[3] += wa3 * x0; a1[3] += wb3 * x1;
        }
#pragma unroll
        for (int tt = 0; tt < 4; ++tt) {
            float s = (a0[tt][0] + a0[tt][1]) + (a0[tt][2] + a0[tt][3]) + (a1[tt][0] + a1[tt][1]) + (a1[tt][2] + a1[tt][3]);
            const float mean = wave_sum(s) * (1.0f / DC);
            const f32x4 d0 = a0[tt] - mean, d1 = a1[tt] - mean;
            float q = (d0[0] * d0[0] + d0[1] * d0[1]) + (d0[2] * d0[2] + d0[3] * d0[3]) + (d1[0] * d1[0] + d1[1] * d1[1]) + (d1[2] * d1[2] + d1[3] * d1[3]);
            const float rstd = rsqrtf(wave_sum(q) * (1.0f / DC) + EPS);
            f32x4 y0 = d0 * rstd * lg0 + lb0, y1 = d1 * rstd * lg1 + lb1;
#pragma unroll
            for (int j = 0; j < 4; ++j) { y0[j] = silu_fast(y0[j]); y1[j] = silu_fast(y1[j]); }
            *(v4u*)(YMIX + ((size_t)(b * SEQ + t0 + 4 * wave + tt)) * D + 8 * lane) = pack8(y0, y1);
        }
    }
    __syncthreads();
}

__device__ __forceinline__ void scan_decode(int it, int& b, int& c) { if (it < 256) { b = it >> 6; c = it & 63; } else { b = 4 + ((it - 256) >> 6); c = 63 - ((it - 256) & 63); } }
__device__ __forceinline__ float neg_expm1(float x, float a) {
    float p = -1.0f / 5040.0f; p = p * x - 1.0f / 720.0f; p = p * x - 1.0f / 120.0f; p = p * x - 1.0f / 24.0f; p = p * x - 1.0f / 6.0f; p = p * x - 0.5f; p = p * x - 1.0f;
    float q = p * x, w = 1.0f - a * a; asm volatile("" : "+v"(q), "+v"(w));
    return x > -0.5f ? q : w;
}
__device__ __forceinline__ void gate_math16(const f32x16 pa, const f32x16 pi, float ba, float bi, float c8, f32x16& av, f32x16& bv) {
#pragma unroll
    for (int g4 = 0; g4 < 4; ++g4) {
        const f32x4 pa4 = {pa[4 * g4], pa[4 * g4 + 1], pa[4 * g4 + 2], pa[4 * g4 + 3]}, pi4 = {pi[4 * g4], pi[4 * g4 + 1], pi[4 * g4 + 2], pi[4 * g4 + 3]};
        const f32x4 rg = sigmoid4(pa4 + ba), ig = sigmoid4(pi4 + bi);
        const f32x4 l2 = rg * c8;
        const f32x4 a = {__builtin_amdgcn_exp2f(l2[0]), __builtin_amdgcn_exp2f(l2[1]), __builtin_amdgcn_exp2f(l2[2]), __builtin_amdgcn_exp2f(l2[3])};
        const f32x4 x = l2 * 1.3862943611198906f;
        f32x4 p = x * (-1.0f / 5040.0f) - 1.0f / 720.0f; p = p * x - 1.0f / 120.0f; p = p * x - 1.0f / 24.0f; p = p * x - 1.0f / 6.0f; p = p * x - 0.5f; p = p * x - 1.0f;
        const f32x4 q = p * x, w = 1.0f - a * a;
        f32x4 m2;
#pragma unroll
        for (int e = 0; e < 4; ++e) m2[e] = __builtin_amdgcn_sqrtf(x[e] > -0.5f ? q[e] : w[e]);
        const f32x4 bb = m2 * ig;
#pragma unroll
        for (int e = 0; e < 4; ++e) { av[4 * g4 + e] = a[e]; bv[4 * g4 + e] = bb[e]; }
        __builtin_amdgcn_sched_barrier(0);
    }
}
template <bool FINAL>
__device__ __forceinline__ void mix_scan(LAS unsigned char* lds, const bf16* UX, const bf16* GY, const bf16* WGT, const float* rw, const float* rb, const float* b_a, const float* b_i, const float* lam,
                                         f32x2* TOT, bf16* YMIX, int G, int bx, int lane, int wave) {
    LAS unsigned char* UXT = lds + wave * 16896;
    LAS unsigned char* XRT = UXT + 8704;
    const int h = wave, j = lane & 31, hh = lane >> 5, dg = lane & 7, tg = lane >> 3;
    float c8v[2], bav[2], biv[2];
#pragma unroll
    for (int ec = 0; ec < 2; ++ec) { const int ch = 64 * h + 32 * ec + j; c8v[ec] = -8.0f * 1.4426950408889634f * log1pf(expf(-lam[ch]));   bav[ec] = b_a[ch]; biv[ec] = b_i[ch]; }
    for (int it = bx; it < 512; it += G) {
        asm volatile("" ::: "memory");
        int b, c; scan_decode(it, b, c);
        const size_t mrow0 = (size_t)b * SEQ + 64 * c;
#pragma unroll
        for (int i = 0; i < 9; ++i) { const int row = i * 8 + tg, tok = 64 * c - 3 + row; v4u v = {0u, 0u, 0u, 0u};
            if (row < 67 && tok >= 0) v = *(const v4u*)(UX + ((size_t)b * SEQ + tok) * DR + 64 * h + 8 * dg);
            if (row < 68) *(LAS v4u*)(UXT + row * 128 + dg * 16) = v; }
        pg8::bf16x8 bfr[2][4];
#pragma unroll
        for (int g = 0; g < 2; ++g)
#pragma unroll
            for (int ks = 0; ks < 4; ++ks) bfr[g][ks] = *(const pg8::bf16x8*)(WGT + ((size_t)(h * 128 + 64 * g + j)) * 64 + 16 * ks + 8 * hh);
        v4u gyv[8];
        if (FINAL) {
#pragma unroll
            for (int i = 0; i < 8; ++i) gyv[i] = *(const v4u*)(GY + (mrow0 + i * 8 + tg) * DR + 64 * h + 8 * dg);
        }
        float Hc = 0.f;
        if (FINAL) { const f32x2* tp = TOT + ((size_t)b * 64) * DR + 64 * h + lane; int cc = 0;
            for (; cc + 8 <= c; cc += 8) { f32x2 t8[8];
#pragma unroll
                for (int u = 0; u < 8; ++u) t8[u] = tp[(size_t)(cc + u) * DR];
#pragma unroll
                for (int u = 0; u < 8; ++u) Hc = Hc * t8[u].x + t8[u].y; }
            for (; cc < c; ++cc) { const f32x2 ab = tp[(size_t)cc * DR]; Hc = Hc * ab.x + ab.y; } }
        {
            f32x4 w4a[4], w4b[4];
#pragma unroll
            for (int k = 0; k < 4; ++k) { w4a[k] = *(const f32x4*)(rw + k * DR + 64 * h + 8 * dg); w4b[k] = *(const f32x4*)(rw + k * DR + 64 * h + 8 * dg + 4); }
            const f32x4 rb0 = *(const f32x4*)(rb + 64 * h + 8 * dg), rb1 = *(const f32x4*)(rb + 64 * h + 8 * dg + 4);
#pragma unroll
            for (int th = 0; th < 2; ++th) {
                f32x4 o0[4], o1[4];
#pragma unroll
                for (int t = 0; t < 4; ++t) { o0[t] = rb0; o1[t] = rb1; }
#pragma unroll
                for (int i = 0; i < 7; ++i) { const v4u v = *(const LAS v4u*)(UXT + (8 * tg + 4 * th + i) * 128 + dg * 16);
                    const f32x4 x0 = {bflo(v.x), bfhi(v.x), bflo(v.y), bfhi(v.y)}, x1 = {bflo(v.z), bfhi(v.z), bflo(v.w), bfhi(v.w)};
#pragma unroll
                    for (int k = 0; k < 4; ++k) { const int t = i - k; if (t >= 0 && t < 4) { o0[t] += w4a[k] * x0; o1[t] += w4b[k] * x1; } } }
#pragma unroll
                for (int t = 0; t < 4; ++t) *(LAS v4u*)(XRT + (8 * tg + 4 * th + t) * 128 + dg * 16) = pack8(o0[t], o1[t]);
            }
        }
        if (FINAL) {
#pragma unroll
            for (int i = 0; i < 8; ++i) *(LAS v4u*)(UXT + (i * 8 + tg) * 128 + dg * 16) = gyv[i];
        }
#pragma unroll
        for (int ec = 0; ec < 2; ++ec) {
            const int ch = 64 * h + 32 * ec + j;
            const float c8 = c8v[ec], ba = bav[ec], bi = biv[ec];
            f32x16 av[2], bv[2];
#pragma unroll
            for (int tt = 0; tt < 2; ++tt) {
                pg8::bf16x8 afr[4];
#pragma unroll
                for (int ks = 0; ks < 4; ++ks) afr[ks] = *(const LAS pg8::bf16x8*)(XRT + (32 * tt + j) * 128 + (16 * ks + 8 * hh) * 2);
                f32x16 pa, pi;
#pragma unroll
                for (int r = 0; r < 16; ++r) { pa[r] = 0.f; pi[r] = 0.f; }
#pragma unroll
                for (int ks = 0; ks < 4; ++ks) {
                    pa = __builtin_amdgcn_mfma_f32_32x32x16_bf16(afr[ks], bfr[0][ks], pa, 0, 0, 0);
                    pi = __builtin_amdgcn_mfma_f32_32x32x16_bf16(afr[ks], bfr[1][ks], pi, 0, 0, 0); }
                if (ec == 0 && tt == 1) {
#pragma unroll
                    for (int g = 0; g < 2; ++g)
#pragma unroll
                        for (int ks = 0; ks < 4; ++ks) bfr[g][ks] = *(const pg8::bf16x8*)(WGT + ((size_t)(h * 128 + 64 * g + 32 + j)) * 64 + 16 * ks + 8 * hh);
                }
                gate_math16(pa, pi, ba, bi, c8, av[tt], bv[tt]);
                {
                    f32x16 px;
#pragma unroll
                    for (int r = 0; r < 16; ++r) px[r] = bv[tt][r] * 0.f;
                    int dd = 32 * ec + j - 8 * hh; asm volatile("" : "+v"(dd));
                    const unsigned one = (dd & 1) ? 0x3F800000u : 0x00003F80u;
#pragma unroll
                    for (int ks = 0; ks < 4; ++ks) {
                        const int dw = (dd - 16 * ks) >> 1;
                        v4u idw; idw.x = dw == 0 ? one : 0u; idw.y = dw == 1 ? one : 0u; idw.z = dw == 2 ? one : 0u; idw.w = dw == 3 ? one : 0u;
                        px = __builtin_amdgcn_mfma_f32_32x32x16_bf16(afr[ks], __builtin_bit_cast(pg8::bf16x8, idw), px, 0, 0, 0); }
#pragma unroll
                    for (int r = 0; r < 16; ++r) bv[tt][r] *= px[r];
                }
            }
            float GA[2][4], GB[2][4], PA[2][4], PB[2][4];
#pragma unroll
            for (int tt = 0; tt < 2; ++tt)
#pragma unroll
                for (int q = 0; q < 4; ++q) { const float a0 = av[tt][4 * q], a1 = av[tt][4 * q + 1], a2 = av[tt][4 * q + 2], a3 = av[tt][4 * q + 3];
                    const float b0 = bv[tt][4 * q], b1 = bv[tt][4 * q + 1], b2 = bv[tt][4 * q + 2], b3 = bv[tt][4 * q + 3];
                    GA[tt][q] = (a0 * a1) * (a2 * a3); GB[tt][q] = ((b0 * a1 + b1) * a2 + b2) * a3 + b3;
                    PA[tt][q] = __shfl_xor(GA[tt][q], 32); PB[tt][q] = __shfl_xor(GB[tt][q], 32); }
            if (!FINAL) {
                float At = 1.f, Bt = 0.f;
#pragma unroll
                for (int tt = 0; tt < 2; ++tt)
#pragma unroll
                    for (int q = 0; q < 4; ++q) { const float A0 = hh ? PA[tt][q] : GA[tt][q], B0 = hh ? PB[tt][q] : GB[tt][q], A1 = hh ? GA[tt][q] : PA[tt][q], B1 = hh ? GB[tt][q] : PB[tt][q];
                        Bt = (Bt * A0 + B0) * A1 + B1; At = (At * A0) * A1; }
                if (hh == 0) TOT[((size_t)b * 64 + c) * DR + ch] = (f32x2){At, Bt};
            } else {
                float hc = __shfl(Hc, 32 * ec + j);
#pragma unroll
                for (int tt = 0; tt < 2; ++tt)
#pragma unroll
                    for (int q = 0; q < 4; ++q) { const float A0 = hh ? PA[tt][q] : GA[tt][q], B0 = hh ? PB[tt][q] : GB[tt][q], A1 = hh ? GA[tt][q] : PA[tt][q], B1 = hh ? GB[tt][q] : PB[tt][q];
                        const float mid = hc * A0 + B0; float hv = hh ? mid : hc; hc = mid * A1 + B1;
#pragma unroll
                        for (int i = 0; i < 4; ++i) { hv = av[tt][4 * q + i] * hv + bv[tt][4 * q + i]; av[tt][4 * q + i] = hv; } }
#pragma unroll
                for (int tt = 0; tt < 2; ++tt)
#pragma unroll
                    for (int r = 0; r < 16; ++r) { const int tk = 32 * tt + (r & 3) + 8 * (r >> 2) + 4 * hh;
                        LAS u16* p = (LAS u16*)(UXT + tk * 128 + (32 * ec + j) * 2);
                        const float gy = __uint_as_float((unsigned)(*p) << 16);
                        *p = (u16)f2bf(gy * av[tt][r]); }
            }
        }
        if (FINAL) {
#pragma unroll
            for (int i = 0; i < 8; ++i) { const int row = i * 8 + tg; *(v4u*)(YMIX + (mrow0 + row) * D + DC + 64 * h + 8 * dg) = *(const LAS v4u*)(UXT + row * 128 + dg * 16); }
        }
    }
    __syncthreads();
}

__device__ __forceinline__ void fold_chunks(const gu64* tp, int c0, int c1, int hh, float& A, float& B) {
    const int mid = (c0 + c1 + 1) >> 1, lo = hh ? mid : c0, hi2 = hh ? c1 : mid;
    float Ar = 1.f, Br = 0.f;
    for (int cc = lo; cc < hi2; cc += 4) { unsigned long long t8[4];
#pragma unroll
        for (int u = 0; u < 4; ++u) t8[u] = __hip_atomic_load(tp + (size_t)(cc + u < 63 ? cc + u : 63) * DR, RLX_AGENT);
#pragma unroll
        for (int u = 0; u < 4; ++u) { const bool ok = cc + u < hi2; const float ta = ok ? __uint_as_float((unsigned)t8[u]) : 1.f, tb = ok ? __uint_as_float((unsigned)(t8[u] >> 32)) : 0.f; Br = Br * ta + tb; Ar = Ar * ta; } }
    const float Ap = __shfl_xor(Ar, 32), Bp = __shfl_xor(Br, 32);
    A = Ar * Ap; B = hh ? (Bp * Ar + Br) : (Br * Ap + Bp);
}
__device__ __forceinline__ void mix_scan1(LAS unsigned char* lds, const bf16* UX, const bf16* GY, const bf16* WGT, const float* rw, const float* rb, const float* b_a, const float* b_i, const float* lam,
                                          f32x2* TOT, unsigned* cnt, bf16* YMIX, int G, int bx, int lane, int wave) {
    LAS unsigned char* UXT = lds + wave * 16896;
    LAS unsigned char* XRT = UXT + 8704;
    const int h = wave, j = lane & 31, hh = lane >> 5, dg = lane & 7, tg = lane >> 3;
    const int gs = G >> 3, b = bx / gs, idx = bx - b * gs;
    float c8v[2], bav[2], biv[2];
#pragma unroll
    for (int ec = 0; ec < 2; ++ec) { const int ch = 64 * h + 32 * ec + j; c8v[ec] = -8.0f * 1.4426950408889634f * log1pf(expf(-lam[ch])); bav[ec] = b_a[ch]; biv[ec] = b_i[ch]; }
    for (int c = idx, round = 0; c < 64; c += gs, ++round) {
        asm volatile("" ::: "memory");
        const size_t mrow0 = (size_t)b * SEQ + 64 * c;
#pragma unroll
        for (int i = 0; i < 9; ++i) { const int row = i * 8 + tg, tok = 64 * c - 3 + row; v4u v = {0u, 0u, 0u, 0u};
            if (row < 67 && tok >= 0) v = *(const v4u*)(UX + ((size_t)b * SEQ + tok) * DR + 64 * h + 8 * dg);
            if (row < 68) *(LAS v4u*)(UXT + row * 128 + dg * 16) = v; }
        pg8::bf16x8 bfr[2][4];
#pragma unroll
        for (int g = 0; g < 2; ++g)
#pragma unroll
            for (int ks = 0; ks < 4; ++ks) bfr[g][ks] = *(const pg8::bf16x8*)(WGT + ((size_t)(h * 128 + 64 * g + j)) * 64 + 16 * ks + 8 * hh);
        {
            f32x4 w4a[4], w4b[4];
#pragma unroll
            for (int k = 0; k < 4; ++k) { w4a[k] = *(const f32x4*)(rw + k * DR + 64 * h + 8 * dg); w4b[k] = *(const f32x4*)(rw + k * DR + 64 * h + 8 * dg + 4); }
            const f32x4 rb0 = *(const f32x4*)(rb + 64 * h + 8 * dg), rb1 = *(const f32x4*)(rb + 64 * h + 8 * dg + 4);
#pragma unroll
            for (int th = 0; th < 2; ++th) {
                f32x4 o0[4], o1[4];
#pragma unroll
                for (int t = 0; t < 4; ++t) { o0[t] = rb0; o1[t] = rb1; }
#pragma unroll
                for (int i = 0; i < 7; ++i) { const v4u v = *(const LAS v4u*)(UXT + (8 * tg + 4 * th + i) * 128 + dg * 16);
                    const f32x4 x0 = {bflo(v.x), bfhi(v.x), bflo(v.y), bfhi(v.y)}, x1 = {bflo(v.z), bfhi(v.z), bflo(v.w), bfhi(v.w)};
#pragma unroll
                    for (int k = 0; k < 4; ++k) { const int t = i - k; if (t >= 0 && t < 4) { o0[t] += w4a[k] * x0; o1[t] += w4b[k] * x1; } } }
#pragma unroll
                for (int t = 0; t < 4; ++t) *(LAS v4u*)(XRT + (8 * tg + 4 * th + t) * 128 + dg * 16) = pack8(o0[t], o1[t]);
            }
        }
#pragma unroll
        for (int ec = 0; ec < 2; ++ec) {
            const int ch = 64 * h + 32 * ec + j;
            const float c8 = c8v[ec], ba = bav[ec], bi = biv[ec];
            unsigned* cw = cnt + 64 * (8 * ec + b);
            f32x16 av[2], bv[2];
#pragma unroll
            for (int tt = 0; tt < 2; ++tt) {
                pg8::bf16x8 afr[4];
#pragma unroll
                for (int ks = 0; ks < 4; ++ks) afr[ks] = *(const LAS pg8::bf16x8*)(XRT + (32 * tt + j) * 128 + (16 * ks + 8 * hh) * 2);
                f32x16 pa, pi;
#pragma unroll
                for (int r = 0; r < 16; ++r) { pa[r] = 0.f; pi[r] = 0.f; }
#pragma unroll
                for (int ks = 0; ks < 4; ++ks) {
                    pa = __builtin_amdgcn_mfma_f32_32x32x16_bf16(afr[ks], bfr[0][ks], pa, 0, 0, 0);
                    pi = __builtin_amdgcn_mfma_f32_32x32x16_bf16(afr[ks], bfr[1][ks], pi, 0, 0, 0); }
                if (ec == 0 && tt == 1) {
#pragma unroll
                    for (int g = 0; g < 2; ++g)
#pragma unroll
                        for (int ks = 0; ks < 4; ++ks) bfr[g][ks] = *(const pg8::bf16x8*)(WGT + ((size_t)(h * 128 + 64 * g + 32 + j)) * 64 + 16 * ks + 8 * hh);
                }
                gate_math16(pa, pi, ba, bi, c8, av[tt], bv[tt]);
                {
                    f32x16 px;
#pragma unroll
                    for (int r = 0; r < 16; ++r) px[r] = bv[tt][r] * 0.f;
                    int dd = 32 * ec + j - 8 * hh; asm volatile("" : "+v"(dd));
                    const unsigned one = (dd & 1) ? 0x3F800000u : 0x00003F80u;
#pragma unroll
                    for (int ks = 0; ks < 4; ++ks) {
                        const int dw = (dd - 16 * ks) >> 1;
                        v4u idw; idw.x = dw == 0 ? one : 0u; idw.y = dw == 1 ? one : 0u; idw.z = dw == 2 ? one : 0u; idw.w = dw == 3 ? one : 0u;
                        px = __builtin_amdgcn_mfma_f32_32x32x16_bf16(afr[ks], __builtin_bit_cast(pg8::bf16x8, idw), px, 0, 0, 0); }
#pragma unroll
                    for (int r = 0; r < 16; ++r) bv[tt][r] *= px[r];
                }
            }
            float GA[2][4], GB[2][4], PA[2][4], PB[2][4];
            float At = 1.f, Bt = 0.f;
#pragma unroll
            for (int tt = 0; tt < 2; ++tt)
#pragma unroll
                for (int q = 0; q < 4; ++q) { const float a0 = av[tt][4 * q], a1 = av[tt][4 * q + 1], a2 = av[tt][4 * q + 2], a3 = av[tt][4 * q + 3];
                    const float b0 = bv[tt][4 * q], b1 = bv[tt][4 * q + 1], b2 = bv[tt][4 * q + 2], b3 = bv[tt][4 * q + 3];
                    GA[tt][q] = (a0 * a1) * (a2 * a3); GB[tt][q] = ((b0 * a1 + b1) * a2 + b2) * a3 + b3;
                    PA[tt][q] = __shfl_xor(GA[tt][q], 32); PB[tt][q] = __shfl_xor(GB[tt][q], 32);
                    const float A0 = hh ? PA[tt][q] : GA[tt][q], B0 = hh ? PB[tt][q] : GB[tt][q], A1 = hh ? GA[tt][q] : PA[tt][q], B1 = hh ? GB[tt][q] : PB[tt][q];
                    Bt = (Bt * A0 + B0) * A1 + B1; At = (At * A0) * A1; }
            if (hh == 0) __hip_atomic_store((gu64*)(TOT + ((size_t)b * 64 + c) * DR + ch), ((unsigned long long)__float_as_uint(Bt) << 32) | __float_as_uint(At), RLX_AGENT);
            asm volatile("s_waitcnt vmcnt(0)" ::: "memory");
            if (lane == 0) __hip_atomic_fetch_add(cw, 1u, __ATOMIC_RELAXED, __HIP_MEMORY_SCOPE_AGENT);
            if (ec == 0) {
#pragma unroll
                for (int i = 0; i < 8; ++i) *(LAS v4u*)(UXT + (i * 8 + tg) * 128 + dg * 16) = *(const v4u*)(GY + (mrow0 + i * 8 + tg) * DR + 64 * h + 8 * dg);
            }
            const gu64* tp = (const gu64*)(TOT + ((size_t)b * 64) * DR + ch); const int cpre = round * gs < c ? round * gs : c;
            float Apre = 1.f, Bpre = 0.f;
            if (cpre > 0) fold_chunks(tp, 0, cpre, hh, Apre, Bpre);
            if (wave == 0) { const int upto = (round + 1) * gs < 64 ? (round + 1) * gs : 64; const unsigned need = 8u * (unsigned)upto; unsigned sp = 0;
                while ((unsigned)__builtin_amdgcn_readfirstlane(__hip_atomic_load(cw, __ATOMIC_RELAXED, __HIP_MEMORY_SCOPE_AGENT)) < need) { __builtin_amdgcn_s_sleep(1); if (++sp > (1u << 20)) break; }
                __builtin_amdgcn_fence(__ATOMIC_ACQUIRE, "agent");
                asm volatile("s_waitcnt vmcnt(0)" ::: "memory"); }
            asm volatile("" ::: "memory"); __builtin_amdgcn_s_barrier(); asm volatile("" ::: "memory");
            float hc;
            { float Aq, Bq; fold_chunks(tp, cpre, c, hh, Aq, Bq); hc = Bpre * Aq + Bq; (void)Apre; }
#pragma unroll
            for (int tt = 0; tt < 2; ++tt)
#pragma unroll
                for (int q = 0; q < 4; ++q) { const float A0 = hh ? PA[tt][q] : GA[tt][q], B0 = hh ? PB[tt][q] : GB[tt][q], A1 = hh ? GA[tt][q] : PA[tt][q], B1 = hh ? GB[tt][q] : PB[tt][q];
                    const float mid = hc * A0 + B0; float hv = hh ? mid : hc; hc = mid * A1 + B1;
#pragma unroll
                    for (int i = 0; i < 4; ++i) { hv = av[tt][4 * q + i] * hv + bv[tt][4 * q + i]; av[tt][4 * q + i] = hv; } }
#pragma unroll
            for (int tt = 0; tt < 2; ++tt)
#pragma unroll
                for (int r = 0; r < 16; ++r) { const int tk = 32 * tt + (r & 3) + 8 * (r >> 2) + 4 * hh;
                    LAS u16* p = (LAS u16*)(UXT + tk * 128 + (32 * ec + j) * 2);
                    const float gy = __uint_as_float((unsigned)(*p) << 16);
                    *p = (u16)f2bf(gy * av[tt][r]); }
        }
#pragma unroll
        for (int i = 0; i < 8; ++i) { const int row = i * 8 + tg; *(v4u*)(YMIX + (mrow0 + row) * D + DC + 64 * h + 8 * dg) = *(const LAS v4u*)(UXT + row * 128 + dg * 16); }
    }
    __syncthreads();
}

struct Args { const float* in[27]; float* out; unsigned char* ws; int ph_lo, ph_hi; };
constexpr int NPH = 10;
#ifndef MK_PER_PHASE
#define MK_PER_PHASE 0
#endif
#ifndef MK_REP_LO
#define MK_REP_LO 0
#define MK_REP_HI 0
#endif

__global__ void __launch_bounds__(NWAVES * 64, 2) mk_fwd(Args args) {
    extern __shared__ __attribute__((aligned(16))) unsigned char lds_raw[];
    LAS unsigned char* lds = (LAS unsigned char*)lds_raw;
    const int tid = threadIdx.x, wave = __builtin_amdgcn_readfirstlane(tid >> 6);
#define LANE_HERE int lane; asm volatile("v_mbcnt_lo_u32_b32 %0, -1, 0\n\tv_mbcnt_hi_u32_b32 %0, -1, %0" : "=v"(lane))
    const int G = gridDim.x, bx = blockIdx.x;
    const int vcu = (G % 8 == 0) ? (bx % 8) * (G / 8) + bx / 8 : bx;
    const int gw = vcu * NWAVES + wave, NGW = G * NWAVES;
    unsigned char* ws = args.ws;
    gu32* ctl = (gu32*)(ws + WS_CTL);
    const float* x = args.in[0]; const float* cvec = args.in[1]; const float* w_mod = args.in[2]; const float* b_mod = args.in[3];
    const float* g1 = args.in[4]; const float* w1i = args.in[5]; const float* w1o = args.in[6]; const float* gm = args.in[7];
    const float* w_in = args.in[8]; const float* conv_w = args.in[9]; const float* conv_b = args.in[10]; const float* ln_g = args.in[11]; const float* ln_b = args.in[12];
    const float* rw = args.in[13]; const float* rb = args.in[14]; const float* wa = args.in[15]; const float* b_a = args.in[16];
    const float* wi = args.in[17]; const float* b_i = args.in[18]; const float* lam = args.in[19]; const float* w_out = args.in[20];
    const float* g2 = args.in[21]; const float* w2i = args.in[22]; const float* w2o = args.in[23]; const float* w_fmod = args.in[24];
    const float* b_fmod = args.in[25]; const float* gf = args.in[26];
    float* out = args.out;
    float* MOD = (float*)(ws + WS_MOD); float* BIAS1 = (float*)(ws + WS_BIAS1); float* BIAS2 = (float*)(ws + WS_BIAS2); float* BIAS3 = (float*)(ws + WS_BIAS3);
    bf16* WGT = (bf16*)(ws + WS_WGT); f32x2* TOT = (f32x2*)(ws + WS_TOT); float* SSP = (float*)(ws + WS_SSP);
    bf16 *W1O = (bf16*)(ws + WS_W1O), *WIN = (bf16*)(ws + WS_WIN), *WOUT = (bf16*)(ws + WS_WOUT), *W2O = (bf16*)(ws + WS_W2O);
    unsigned char *W1O8F = ws + WS_W1O, *W2O8F = ws + WS_W2O, *W1I8 = ws + WS_W1I, *W2I8 = ws + WS_W2I, *WIN8 = ws + WS_WIN, *A8 = ws + WS_Y;
    float *CS1 = (float*)(ws + WS_CS1), *CS3 = (float*)(ws + WS_CS3), *CS2 = (float*)(ws + WS_CS2), *RS1 = (float*)(ws + WS_RS1), *RS3 = (float*)(ws + WS_RS3), *RS2 = (float*)(ws + WS_RS2);
    bf16 *Y = (bf16*)(ws + WS_Y), *ACT = (bf16*)(ws + WS_ACT), *U = (bf16*)(ws + WS_U), *UXB = (bf16*)(ws + WS_UX), *GYB = (bf16*)(ws + WS_GY), *YMIX = (bf16*)(ws + WS_YMIX);
    bf16* X1 = (bf16*)(ws + WS_X1);

    for (int u = tid; u < (LDS_BYTES - LDSCTL_OFF) / 4; u += NWAVES * 64) ((LAS unsigned*)(lds + LDSCTL_OFF))[u] = 0u;
    __syncthreads();
    const int lo = args.ph_lo, hi = args.ph_hi;
    const bool use_bar = (hi - lo) > 1;
    XcdBarrier bar; bar.bar = (unsigned*)(ctl + CW_BAR); bar.x = 0; bar.st = nullptr;
    if (use_bar) bar = xcd_barrier_post((unsigned*)(ctl + CW_BAR), (volatile LAS unsigned*)(lds + LDSCTL_OFF) + 8);
#define IN(k) (lo <= (k) && (k) < hi)
#define REPS(k) ((MK_REP_LO <= (k) && (k) < MK_REP_HI) ? 2 : 1)
#define AGAIN(k, rr) do { if ((rr) + 1 < REPS(k)) xcd_barrier(bar); } while (0)
#define SEAM(k) do { if (IN(k) && IN((k) + 1)) xcd_barrier(bar); } while (0)

    if (IN(0))
_Pragma("unroll")
    for (int rr = 0; rr < REPS(0); ++rr) { LANE_HERE;
        constexpr int NGEMV = 88;
        const int nt_wg = G > NGEMV ? G - NGEMV : G;
        if (bx < NGEMV || G <= NGEMV) {
            for (int it = bx; it < NGEMV; it += G) {
                if (it < 72) p0_gemv(lds, cvec, w_mod, 9 * D, b_mod, MOD, 128 * it, tid);
                else p0_gemv(lds, cvec, w_fmod, 2 * D, b_fmod, MOD + 9 * D, 128 * (it - 72), tid);
            }
        }
        if (bx >= NGEMV || G <= NGEMV) {
            const int tb = G > NGEMV ? bx - NGEMV : bx;
            for (int it = tb; it < 2 * (FF2 / 32); it += nt_wg) {
                if (it < FF2 / 32) p0_quant_item(lds, w1i, FF2, 1, W1I8, CS1, it, lane, wave);
                else p0_quant_item(lds, w2i, FF2, 1, W2I8, CS3, it - FF2 / 32, lane, wave);
            }
            LAS float* scr = (LAS float*)(lds + wave * 16384);
            constexpr int I_1O = (FF / 64) * (D / 32), I_IN = (D / 64) * (NMIX / 32), I_OUT = (D / 64) * (D / 32);
            constexpr int NITEMS = 2 * I_1O + I_IN + I_OUT;
            for (int it = tb * NWAVES + wave; it < NITEMS; it += nt_wg * NWAVES) {
                int r = it;
                if (r < I_1O) { p0_transpose8_item(w1o, FF, D, W1O8F, scr, r, lane); continue; } r -= I_1O;
                if (r < I_1O) { p0_transpose8_item(w2o, FF, D, W2O8F, scr, r, lane); continue; } r -= I_1O;
                if (r < I_IN) { p0_transpose_item(w_in, D, NMIX, WIN, 2, scr, r, lane); continue; } r -= I_IN;
                p0_transpose_item(w_out, D, D, WOUT, 0, scr, r, lane);
            }
        }
        for (int i = bx * 512 + tid; i < NH * 128 * HD; i += G * 512) { const int d = i & 63, e2 = (i >> 6) & 127, hd = i >> 13;
            const float v = e2 < 64 ? wa[(hd * 64 + d) * 64 + e2] : wi[(hd * 64 + d) * 64 + (e2 - 64)]; WGT[i] = (bf16)f2bf(v); }
        AGAIN(0, rr);
    }
    SEAM(0);
    if (IN(1))
_Pragma("unroll")
    for (int rr = 0; rr < REPS(1); ++rr) { LANE_HERE;
        LAS float* shl = (LAS float*)lds;
        for (int i = tid * 4; i < 3 * NB * D; i += 2048) { const int t = i >> 13, r = i & 8191, b = r >> 10, k = r & 1023; *(LAS f32x4*)(shl + i) = *(const f32x4*)(MOD + (size_t)b * LDM + 3 * t * D + k); }
        __syncthreads();
        for (int m0 = gw; m0 < M; m0 += 2 * NGW) {
            f32x4 v[2][4];
#pragma unroll
            for (int rr2 = 0; rr2 < 2; ++rr2) { const int m = (m0 + rr2 * NGW < M) ? m0 + rr2 * NGW : m0; const f32x4* xr = (const f32x4*)(x + (size_t)m * D) + lane;
#pragma unroll
                for (int jj = 0; jj < 4; ++jj) v[rr2][jj] = xr[64 * jj]; }
#pragma unroll
            for (int rr2 = 0; rr2 < 2; ++rr2) { const int m = m0 + rr2 * NGW; if (m < M) { const int b = m >> 12;
                float s = 0.f, am = 0.f;
#pragma unroll
                for (int jj = 0; jj < 4; ++jj) { const int k = 4 * lane + 256 * jj;
                    s += (v[rr2][jj][0] * v[rr2][jj][0] + v[rr2][jj][1] * v[rr2][jj][1]) + (v[rr2][jj][2] * v[rr2][jj][2] + v[rr2][jj][3] * v[rr2][jj][3]);
                    v[rr2][jj] = v[rr2][jj] * *(const f32x4*)(g1 + k) * (*(const f32x4*)(MOD + (size_t)b * LDM + 1 * D + k) + 1.0f);
                    const f32x4 t = __builtin_elementwise_abs(v[rr2][jj]); am = fmaxf(am, fmaxf(fmaxf(t[0], t[1]), fmaxf(t[2], t[3]))); }
                s = wave_sum(s); am = wave_max(am);
                const float q = am > 0.f ? 127.0f / am : 0.f;
#pragma unroll
                for (int jj = 0; jj < 4; ++jj) *(unsigned*)(A8 + (size_t)m * D + 4 * lane + 256 * jj) = q8x4(v[rr2][jj] * q);
                if (lane == 0) RS1[m] = rsqrtf(s * (1.0f / D) + EPS) * am * (1.0f / 127.0f); } }
        }
        for (int it = gw; it < FF2 + NMIX + FF2; it += NGW) {
            if (it >= FF2 && it < FF2 + NMIX) {
                const bf16* wrow = WIN + (size_t)(it - FF2) * D; float* op = BIAS2 + (it - FF2);
                const v4u wA = *(const v4u*)(wrow + 8 * lane), wB = *(const v4u*)(wrow + 512 + 8 * lane);
                f32x4 a0, a1, c0, c1; unpack8(wA, a0, a1); unpack8(wB, c0, c1);
#pragma unroll
                for (int b = 0; b < NB; ++b) { const LAS float* sp = shl + (1 * NB + b) * D + 8 * lane;
                    const f32x4 p = a0 * *(const LAS f32x4*)(sp) + a1 * *(const LAS f32x4*)(sp + 4) + c0 * *(const LAS f32x4*)(sp + 512) + c1 * *(const LAS f32x4*)(sp + 516);
                    const float tot = wave_sum((p[0] + p[1]) + (p[2] + p[3]));
                    if (lane == 0) op[(size_t)b * NMIX] = tot; }
            } else {
                const int t = it < FF2 ? 0 : 2, n = it < FF2 ? it : it - FF2 - NMIX;
                const unsigned char* wrow = (t == 0 ? W1I8 : W2I8) + (size_t)n * D; float* op = (t == 0 ? BIAS1 : BIAS3) + n; const float csn = (t == 0 ? CS1 : CS3)[n];
                const v4u w16 = *(const v4u*)(wrow + 16 * lane);
                f32x4 wf[4];
#pragma unroll
                for (int d4 = 0; d4 < 4; ++d4) { const int wv = (int)(d4 == 0 ? w16.x : d4 == 1 ? w16.y : d4 == 2 ? w16.z : w16.w);
                    wf[d4] = (f32x4){(float)((wv << 24) >> 24), (float)((wv << 16) >> 24), (float)((wv << 8) >> 24), (float)(wv >> 24)}; }
#pragma unroll
                for (int b = 0; b < NB; ++b) { const LAS float* sp = shl + (t * NB + b) * D + 16 * lane;
                    const f32x4 p = wf[0] * *(const LAS f32x4*)(sp) + wf[1] * *(const LAS f32x4*)(sp + 4) + wf[2] * *(const LAS f32x4*)(sp + 8) + wf[3] * *(const LAS f32x4*)(sp + 12);
                    const float tot = wave_sum((p[0] + p[1]) + (p[2] + p[3]));
                    if (lane == 0) op[(size_t)b * FF2] = tot * csn; }
            }
        }
        __syncthreads();
        AGAIN(1, rr);
    }
    SEAM(1);
    if (IN(2))
_Pragma("unroll")
    for (int rr = 0; rr < REPS(2); ++rr) {
        pg8::Gemm g{(const pg8::bf16_t*)A8, (const pg8::bf16_t*)W1I8, M, FF2, D / 2}; pg8::StaticOrder S; S.init(M, FF2, G, bx);
        EpiSwiglu8<true> E{ACT, RS1, CS1, BIAS1};
        pg8::gemm_phase<EpiSwiglu8<true>, pg8::StaticOrder, true, true, 1>(lds, g, S, E);
        AGAIN(2, rr);
    }
    SEAM(2);
    if (IN(3))
_Pragma("unroll")
    for (int rr = 0; rr < REPS(3); ++rr) {
        pg8::Gemm g{ACT, (const pg8::bf16_t*)W1O8F, M, D, FF / 2}; pg8::StaticOrder S; S.init(M, D, G, bx);
        EpiResid<1, true, false, true> E{x, X1, Y, SSP, MOD + 2 * D, gm, MOD + 4 * D};
        pg8::gemm_phase<EpiResid<1, true, false, true>, pg8::StaticOrder, true, true, 2>(lds, g, S, E);
        AGAIN(3, rr);
    }
    SEAM(3);
    if (IN(4))
_Pragma("unroll")
    for (int rr = 0; rr < REPS(4); ++rr) {
        pg8::Gemm g{Y, WIN, M, NMIX, D}; pg8::StaticOrder S; S.init(M, NMIX, G, bx);
        EpiMixIn E{U, UXB, GYB, SSP, BIAS2};
        pg8::gemm_phase<EpiMixIn, pg8::StaticOrder, true, true>(lds, g, S, E);
        AGAIN(4, rr);
    }
    SEAM(4);
    if (IN(5))
_Pragma("unroll")
    for (int rr = 0; rr < REPS(5); ++rr) { LANE_HERE;
        mix_conv(lds, U, conv_w, conv_b, ln_g, ln_b, YMIX, G, bx, tid, lane, wave);
#ifdef MK_REP_CONV
        mix_conv(lds, U, conv_w, conv_b, ln_g, ln_b, YMIX, G, bx, tid, lane, wave);
#endif
        mix_scan1(lds, UXB, GYB, WGT, rw, rb, b_a, b_i, lam, TOT, (unsigned*)(ctl + CW_SCAN), YMIX, G, bx, lane, wave);
        AGAIN(5, rr);
    }
    SEAM(5);
    if (IN(7))
_Pragma("unroll")
    for (int rr = 0; rr < REPS(7); ++rr) {
        pg8::Gemm g{YMIX, WOUT, M, D, D}; pg8::StaticOrder S; S.init(M, D, G, bx);
        EpiResidQ<0, true> E{X1, X1, A8, RS3, (f32x2*)(ws + WS_SSPX), MOD + 5 * D, g2, MOD + 7 * D, (unsigned*)(ctl + CW_SEAM7)};
        pg8::gemm_phase<EpiResidQ<0, true>, pg8::StaticOrder, true, true>(lds, g, S, E);
        AGAIN(7, rr);
    }
    SEAM(7);
    if (IN(8))
_Pragma("unroll")
    for (int rr = 0; rr < REPS(8); ++rr) {
        pg8::Gemm g{(const pg8::bf16_t*)A8, (const pg8::bf16_t*)W2I8, M, FF2, D / 2}; pg8::StaticOrder S; S.init(M, FF2, G, bx);
        EpiSwiglu8<true> E{ACT, RS3, CS3, BIAS3};
        pg8::gemm_phase<EpiSwiglu8<true>, pg8::StaticOrder, true, true, 1>(lds, g, S, E);
        AGAIN(8, rr);
    }
    SEAM(8);
    if (IN(9))
_Pragma("unroll")
    for (int rr = 0; rr < REPS(9); ++rr) {
        pg8::Gemm g{ACT, (const pg8::bf16_t*)W2O8F, M, D, FF / 2}; pg8::StaticOrder S; S.init(M, D, G, bx);
        EpiResidFinal<true> E{X1, out, (float*)(ws + WS_SSPF), MOD + 8 * D, gf, MOD + 10 * D, MOD + 9 * D, (unsigned*)(ctl + CW_SEAM)};
        pg8::gemm_phase<EpiResidFinal<true>, pg8::StaticOrder, true, true, 2>(lds, g, S, E);
    }
#undef IN
#undef SEAM
#undef REPS
#undef AGAIN
}

extern "C" void kernel_launch(void* const* d_in, const int* in_sizes, int n_in, void* d_out, int out_size, void* d_ws, size_t ws_size, hipStream_t stream) {
    static int grid = 0;
    if (grid == 0) {
        if (n_in != 27 || in_sizes[0] != M * D || out_size != M * D || ws_size < WS_END) { fprintf(stderr, "kernel_launch: unexpected shapes (n_in %d, in0 %d, out %d, ws %zu)\n", n_in, n_in > 0 ? in_sizes[0] : -1, out_size, ws_size); grid = -1; return; }
        int dev = 0, cus = 0, per_cu = 0;
        if (hipGetDevice(&dev) != hipSuccess || hipDeviceGetAttribute(&cus, hipDeviceAttributeMultiprocessorCount, dev) != hipSuccess) { grid = -1; return; }
        if (hipFuncSetAttribute((const void*)mk_fwd, hipFuncAttributeMaxDynamicSharedMemorySize, LDS_BYTES) != hipSuccess) { fprintf(stderr, "kernel_launch: hipFuncSetAttribute failed\n"); grid = -1; return; }
        if (hipOccupancyMaxActiveBlocksPerMultiprocessor(&per_cu, (const void*)mk_fwd, NWAVES * 64, LDS_BYTES) != hipSuccess || per_cu < 1) fprintf(stderr, "kernel_launch: occupancy query reports %d blocks per CU\n", per_cu);
        (void)hipGetLastError();
        grid = cus;
        if (grid % 8 != 0 || grid < 8) { fprintf(stderr, "kernel_launch: %d CUs: the scan's chunk rounds need a multiple of 8 workgroups\n", grid); grid = -1; return; }
    }
    if (grid < 0) return;
    if (hipMemsetAsync((char*)d_ws + WS_CTL, 0, CTL_ZERO_BYTES, stream) != hipSuccess) return;
    Args a{};
    for (int i = 0; i < 27; ++i) a.in[i] = (const float*)d_in[i];
    a.out = (float*)d_out; a.ws = (unsigned char*)d_ws;
#if MK_PER_PHASE
    for (int p = 0; p < NPH; ++p) { a.ph_lo = p; a.ph_hi = p + 1; hipLaunchKernelGGL(mk_fwd, dim3(grid), dim3(NWAVES * 64), LDS_BYTES, stream, a); }
#else
    a.ph_lo = 0; a.ph_hi = NPH; hipLaunchKernelGGL(mk_fwd, dim3(grid), dim3(NWAVES * 64), LDS_BYTES, stream, a);
#endif
}
```

```cpp
#include <hip/hip_runtime.h>
#include <cstdio>
#include <cstdint>
namespace pg8 {
#define PG8_LAS __attribute__((address_space(3)))
typedef unsigned short bf16_t;
typedef short bf16x8 __attribute__((ext_vector_type(8)));
typedef float f32x4 __attribute__((ext_vector_type(4)));
typedef unsigned u32x4 __attribute__((ext_vector_type(4)));
constexpr int BM = 256, BK = 64, HALF = 128, HTB = HALF * BK * 2  , STAGE_BYTES = 8 * HTB, NXCD = 8, WGM = 8;

__host__ __device__ __forceinline__ int lds_byte(int r, int c) { const int st = (r >> 4) * 2 + (c >> 5), rr = r & 15, cc = c & 31, ob = rr * 64 + cc * 2; return st * 1024 + (ob ^ (((ob >> 9) & 1) << 5)); }
__host__ __device__ __forceinline__ void stage_rc(int b, int& R, int& C) { const int st = b / 1024, sb = b % 1024, swz = sb ^ (((sb >> 9) & 1) << 5); R = (st >> 1) * 16 + swz / 64; C = (st & 1) * 32 + (swz % 64) / 2; }
__host__ __device__ __forceinline__ int perm32(int rho) { const int n = rho >> 4, i = rho & 15; return 8 * (i >> 2) + 4 * n + (i & 3); }

struct Unit { int pm, pn; };
struct Gemm { const bf16_t* A; const bf16_t* Bt; int M, N, K; };

struct StaticOrder {
    int nM, nN, nwg, G, c;
    __host__ __device__ void init(int M, int N, int G_, int c_) { nM = M / BM; nN = N / BM; nwg = nM * nN; G = G_; c = c_; }
    __host__ __device__ bool next(int i, Unit& u) const {
        const long L = (long)i * G + c; if (L >= nwg) return false;
        int wgid = (int)L; { const int q = nwg / NXCD, r = nwg % NXCD, xcd = wgid % NXCD, off = wgid / NXCD; wgid = (xcd < r ? xcd * (q + 1) : r * (q + 1) + (xcd - r) * q) + off; }
        const int nig = WGM * nN, gid = wgid / nig, fm = gid * WGM, gsz = (nM - fm) < WGM ? (nM - fm) : WGM;
        u.pm = fm + ((wgid % nig) % gsz); u.pn = (wgid % nig) / gsz; return true;
    }
    __device__ __forceinline__ void a_ready(const Unit&) const {}
    __device__ __forceinline__ void done(const Unit&) const {}
};

__device__ __forceinline__ unsigned cvt_pk_bf16(float lo, float hi) { unsigned r; asm volatile("v_cvt_pk_bf16_f32 %0, %1, %2" : "=v"(r) : "v"(lo), "v"(hi)); return r; }
#ifndef PG8_STAGE_IN_MMA
#define PG8_STAGE_IN_MMA 0
#endif
typedef int i32x4 __attribute__((ext_vector_type(4)));
typedef int i32x8 __attribute__((ext_vector_type(8)));
__device__ __forceinline__ i32x8 cat32(const bf16x8 lo, const bf16x8 hi) { const i32x4 p = __builtin_bit_cast(i32x4, lo), q = __builtin_bit_cast(i32x4, hi); return (i32x8){p.x, p.y, p.z, p.w, q.x, q.y, q.z, q.w}; }
__device__ __forceinline__ f32x4 mma_mx8(const i32x8 B, const i32x8 A, const f32x4 c) { return __builtin_amdgcn_mfma_scale_f32_16x16x128_f8f6f4(B, A, c, 0, 0, 0, 0x7F7F7F7F, 0, 0x7F7F7F7F); }
template <int I8> __device__ __forceinline__ f32x4 mma16(const bf16x8 b, const bf16x8 a, const f32x4 c) {
    if constexpr (I8 == 1) return __builtin_bit_cast(f32x4, __builtin_amdgcn_mfma_i32_16x16x64_i8(__builtin_bit_cast(i32x4, b), __builtin_bit_cast(i32x4, a), __builtin_bit_cast(i32x4, c), 0, 0, 0));
    else return __builtin_amdgcn_mfma_f32_16x16x32_bf16(b, a, c, 0, 0, 0);
}
template <class Epi, class Sched, bool ALIGN_EPI = false, bool SP2 = false, int I8 = 0>
__device__ __forceinline__ void gemm_phase(PG8_LAS unsigned char* lds, const Gemm g, const Sched& S, const Epi& E) {
    const int tid = threadIdx.x, wid = __builtin_amdgcn_readfirstlane(tid >> 6), lane = tid & 63, wr = wid >> 2, wc = wid & 3, fr = lane & 15, fq = lane >> 4;
    const int K = g.K, nt = K / BK;
    unsigned voffA[1], voffB[1];
    { int R, C; stage_rc(tid * 16, R, C); const int Rb = Epi::PERM ? ((R & ~31) + perm32(R & 31)) : R;
        voffA[0] = (unsigned)(R * K + C) * 2u; voffB[0] = (unsigned)(Rb * K + C) * 2u; }
    const size_t r64 = (size_t)64 * K * 2;
    const size_t kstep = (size_t)(BK * 2);
    const size_t hstep = (size_t)HALF * K * 2;
    const size_t tstep = 2 * hstep;
    const unsigned ldsw = (unsigned)wid * 1024u;
    const int aoff = lds_byte(wr * 64 + fr, fq * 8), boff = lds_byte(wc * 32 + fr, fq * 8);
#define PG8_SA(b, h) (((b) * 2 + (h)) * HTB)
#define PG8_SB(b, h) ((4 + (b) * 2 + (h)) * HTB)
#define PG8_STAGE(bufoff, gbase, voff) do { _Pragma("unroll") for (int _i = 0; _i < 2; ++_i) \
        __builtin_amdgcn_global_load_lds((const unsigned*)((const char*)(gbase) + _i * r64 + (voff)[0]), (PG8_LAS unsigned*)(lds + (bufoff) + ldsw + _i * 8192), 16, 0, 0); } while (0)
#define PG8_LDA(dst, b, h) do { _Pragma("unroll") for (int m = 0; m < 4; ++m) { if constexpr (I8 == 2) dst##8[m] = cat32(*(const PG8_LAS bf16x8*)(lds + PG8_SA(b, h) + aoff + m * 2048), *(const PG8_LAS bf16x8*)(lds + PG8_SA(b, h) + aoff + m * 2048 + 1024)); \
        else { _Pragma("unroll") for (int k = 0; k < 2; ++k) dst[m][k] = *(const PG8_LAS bf16x8*)(lds + PG8_SA(b, h) + aoff + m * 2048 + k * 1024); } } } while (0)
#define PG8_LDB(dst, b, h) do { _Pragma("unroll") for (int n = 0; n < 2; ++n) { if constexpr (I8 == 2) dst##8[n] = cat32(*(const PG8_LAS bf16x8*)(lds + PG8_SB(b, h) + boff + n * 2048), *(const PG8_LAS bf16x8*)(lds + PG8_SB(b, h) + boff + n * 2048 + 1024)); \
        else { _Pragma("unroll") for (int k = 0; k < 2; ++k) dst[n][k] = *(const PG8_LAS bf16x8*)(lds + PG8_SB(b, h) + boff + n * 2048 + k * 1024); } } } while (0)
#define PG8_MMA(ai, bj, At, Bt) do { __builtin_amdgcn_s_setprio(1); _Pragma("unroll") for (int m = 0; m < 4; ++m) _Pragma("unroll") for (int n = 0; n < 2; ++n) { \
        if constexpr (I8 == 2) acc[ai][bj][m][n] = mma_mx8(Bt##8[n], At##8[m], acc[ai][bj][m][n]); \
        else { _Pragma("unroll") for (int k = 0; k < 2; ++k) acc[ai][bj][m][n] = mma16<I8>(Bt[n][k], At[m][k], acc[ai][bj][m][n]); } } __builtin_amdgcn_s_setprio(0); } while (0)
#define PG8_WAIT_V(n) asm volatile("s_waitcnt vmcnt(" #n ")" ::: "memory")
#define PG8_WAIT_L(n) asm volatile("s_waitcnt lgkmcnt(" #n ")" ::: "memory")
#define PG8_BAR __builtin_amdgcn_s_barrier()
#define PG8_SCHED __builtin_amdgcn_sched_barrier(0)
    Unit cur, nxt; int ui = 0;
    if (!S.next(0, cur)) return;
    f32x4 acc[2][2][4][2];
#pragma unroll
    for (int a = 0; a < 2; ++a)
#pragma unroll
        for (int b = 0; b < 2; ++b)
#pragma unroll
            for (int m = 0; m < 4; ++m)
#pragma unroll
                for (int n = 0; n < 2; ++n) acc[a][b][m][n] = (f32x4){0.f, 0.f, 0.f, 0.f};
    bf16x8 At[4][2], B0[2][2], B1[2][2]; i32x8 At8[4], B08[2], B18[2];
    const char* cA = (const char*)g.A + (size_t)cur.pm * tstep; const char* cB = (const char*)g.Bt + (size_t)cur.pn * tstep;
    S.a_ready(cur);
    if constexpr (SP2) {
        PG8_STAGE(PG8_SB(0, 0), cB, voffB); PG8_STAGE(PG8_SB(0, 1), cB + hstep, voffB); PG8_STAGE(PG8_SA(0, 0), cA, voffA); PG8_STAGE(PG8_SA(0, 1), cA + hstep, voffA);
        if (wr == 1) PG8_BAR;
        PG8_WAIT_V(2); PG8_BAR;
        PG8_STAGE(PG8_SB(1, 0), cB + kstep, voffB); PG8_STAGE(PG8_SA(1, 0), cA + kstep, voffA); PG8_STAGE(PG8_SB(1, 1), cB + hstep + kstep, voffB);
        PG8_WAIT_V(6); PG8_BAR;
    } else {
        PG8_STAGE(PG8_SB(0, 0), cB, voffB); PG8_STAGE(PG8_SA(0, 0), cA, voffA); PG8_STAGE(PG8_SB(0, 1), cB + hstep, voffB); PG8_STAGE(PG8_SA(0, 1), cA + hstep, voffA);
        if (wr == 1) PG8_BAR;
        PG8_WAIT_V(4); PG8_BAR;
        PG8_STAGE(PG8_SB(1, 0), cB + kstep, voffB); PG8_STAGE(PG8_SA(1, 0), cA + kstep, voffA); PG8_STAGE(PG8_SB(1, 1), cB + hstep + kstep, voffB);
        PG8_WAIT_V(6); PG8_BAR;
    }
    for (;;) {
        const bool has_next = S.next(ui + 1, nxt);
        const char* nA = has_next ? (const char*)g.A + (size_t)nxt.pm * tstep : cA; const char* nB = has_next ? (const char*)g.Bt + (size_t)nxt.pn * tstep : cB;
        asm volatile(".p2align 8" ::: "memory");
        for (int t = 0; t < nt; t += 2) {
            const bool last = (t == nt - 2);
            const char* a1 = cA + (size_t)(t + 1) * kstep;
            const char* a2 = last ? nA : cA + (size_t)(t + 2) * kstep; const char* b2 = last ? nB : cB + (size_t)(t + 2) * kstep;
            const char* a3 = a2 + kstep; const char* b3 = b2 + kstep;
            if (last && has_next) S.a_ready(nxt);
            if constexpr (SP2) {
#if PG8_STAGE_IN_MMA
            PG8_LDB(B0, 0, 0); PG8_LDB(B1, 0, 1); PG8_SCHED; PG8_LDA(At, 0, 0);
            PG8_WAIT_V(6); PG8_WAIT_L(0); PG8_BAR; PG8_MMA(0, 0, At, B0); PG8_SCHED; PG8_STAGE(PG8_SA(1, 1), a1 + hstep, voffA); PG8_SCHED; PG8_MMA(0, 1, At, B1); PG8_BAR; PG8_SCHED;
            PG8_LDA(At, 0, 1);
            PG8_WAIT_V(2); PG8_WAIT_L(0); PG8_BAR; PG8_STAGE(PG8_SB(0, 0), b2, voffB); PG8_SCHED; PG8_MMA(1, 0, At, B0); PG8_SCHED; PG8_STAGE(PG8_SB(0, 1), b2 + hstep, voffB); PG8_SCHED; PG8_MMA(1, 1, At, B1); PG8_SCHED; PG8_STAGE(PG8_SA(0, 0), a2, voffA); PG8_BAR; PG8_SCHED;
            PG8_LDB(B0, 1, 0); PG8_LDB(B1, 1, 1); PG8_SCHED; PG8_LDA(At, 1, 0);
            PG8_WAIT_V(6); PG8_WAIT_L(0); PG8_BAR; PG8_MMA(0, 0, At, B0); PG8_SCHED; PG8_STAGE(PG8_SA(0, 1), a2 + hstep, voffA); PG8_SCHED; PG8_MMA(0, 1, At, B1); PG8_BAR; PG8_SCHED;
            PG8_LDA(At, 1, 1);
            PG8_WAIT_V(2); PG8_WAIT_L(0); PG8_BAR; PG8_STAGE(PG8_SB(1, 0), b3, voffB); PG8_SCHED; PG8_MMA(1, 0, At, B0); PG8_SCHED; PG8_STAGE(PG8_SB(1, 1), b3 + hstep, voffB); PG8_SCHED; PG8_MMA(1, 1, At, B1); PG8_SCHED; PG8_STAGE(PG8_SA(1, 0), a3, voffA); PG8_BAR; PG8_SCHED;
#else
            PG8_LDB(B0, 0, 0); PG8_LDB(B1, 0, 1); PG8_SCHED; PG8_LDA(At, 0, 0); PG8_STAGE(PG8_SA(1, 1), a1 + hstep, voffA);
            PG8_WAIT_V(8); PG8_WAIT_L(0); PG8_BAR; PG8_MMA(0, 0, At, B0); PG8_MMA(0, 1, At, B1); PG8_BAR; PG8_SCHED;
            PG8_LDA(At, 0, 1); PG8_STAGE(PG8_SB(0, 0), b2, voffB); PG8_STAGE(PG8_SB(0, 1), b2 + hstep, voffB); PG8_STAGE(PG8_SA(0, 0), a2, voffA);
            PG8_WAIT_V(8); PG8_WAIT_L(0); PG8_BAR; PG8_MMA(1, 0, At, B0); PG8_MMA(1, 1, At, B1); PG8_BAR; PG8_SCHED;
            PG8_LDB(B0, 1, 0); PG8_LDB(B1, 1, 1); PG8_SCHED; PG8_LDA(At, 1, 0); PG8_STAGE(PG8_SA(0, 1), a2 + hstep, voffA);
            PG8_WAIT_V(8); PG8_WAIT_L(0); PG8_BAR; PG8_MMA(0, 0, At, B0); PG8_MMA(0, 1, At, B1); PG8_BAR; PG8_SCHED;
            PG8_LDA(At, 1, 1); PG8_STAGE(PG8_SB(1, 0), b3, voffB); PG8_STAGE(PG8_SB(1, 1), b3 + hstep, voffB); PG8_STAGE(PG8_SA(1, 0), a3, voffA);
            PG8_WAIT_V(8); PG8_WAIT_L(0); PG8_BAR; PG8_MMA(1, 0, At, B0); PG8_MMA(1, 1, At, B1); PG8_BAR; PG8_SCHED;
#endif
            } else {
            PG8_LDB(B0, 0, 0); PG8_SCHED; PG8_LDA(At, 0, 0); PG8_STAGE(PG8_SA(1, 1), a1 + hstep, voffA);
            PG8_WAIT_L(8); PG8_BAR; PG8_WAIT_L(0); PG8_MMA(0, 0, At, B0); PG8_BAR; PG8_SCHED;
            PG8_LDB(B1, 0, 1); PG8_STAGE(PG8_SB(0, 0), b2, voffB);
            PG8_BAR; PG8_WAIT_L(0); PG8_MMA(0, 1, At, B1); PG8_BAR;
            PG8_LDA(At, 0, 1); PG8_STAGE(PG8_SA(0, 0), a2, voffA);
            PG8_BAR; PG8_WAIT_L(0); PG8_MMA(1, 0, At, B0); PG8_BAR; PG8_SCHED;
            PG8_STAGE(PG8_SB(0, 1), b2 + hstep, voffB);
            PG8_WAIT_V(6); PG8_BAR; PG8_MMA(1, 1, At, B1); PG8_BAR;
            PG8_LDB(B0, 1, 0); PG8_SCHED; PG8_LDA(At, 1, 0); PG8_STAGE(PG8_SA(0, 1), a2 + hstep, voffA);
            PG8_WAIT_L(8); PG8_BAR; PG8_WAIT_L(0); PG8_MMA(0, 0, At, B0); PG8_BAR; PG8_SCHED;
            PG8_LDB(B1, 1, 1); PG8_STAGE(PG8_SB(1, 0), b3, voffB);
            PG8_BAR; PG8_WAIT_L(0); PG8_MMA(0, 1, At, B1); PG8_BAR;
            PG8_LDA(At, 1, 1); PG8_STAGE(PG8_SA(1, 0), a3, voffA);
            PG8_BAR; PG8_WAIT_L(0); PG8_MMA(1, 0, At, B0); PG8_BAR; PG8_SCHED;
            PG8_STAGE(PG8_SB(1, 1), b3 + hstep, voffB);
            PG8_WAIT_V(6); PG8_BAR; PG8_MMA(1, 1, At, B1); PG8_BAR;
            }
        }
        if constexpr (ALIGN_EPI) { if (wr == 0) PG8_BAR; }
        if constexpr (!Epi::AFTER_DRAIN) { int ln; asm volatile("v_mbcnt_lo_u32_b32 %0, -1, 0\n\tv_mbcnt_hi_u32_b32 %0, -1, %0" : "=v"(ln));     const int fr2 = ln & 15, fq2 = ln >> 4; _Pragma("unroll") for (int er = 0; er < Epi::REPS; ++er) { E(acc, cur, wr, wc, fr2, fq2); if (er + 1 < Epi::REPS) asm volatile("" ::: "memory"); } S.done(cur); }
        if (!has_next) break;
#pragma unroll
        for (int a = 0; a < 2; ++a)
#pragma unroll
            for (int b = 0; b < 2; ++b)
#pragma unroll
                for (int m = 0; m < 4; ++m)
#pragma unroll
                    for (int n = 0; n < 2; ++n) acc[a][b][m][n] = (f32x4){0.f, 0.f, 0.f, 0.f};
        cur = nxt; cA = nA; cB = nB; ++ui;
        if constexpr (ALIGN_EPI) { if (wr == 1) PG8_BAR; }
    }
    PG8_WAIT_V(0);
    if constexpr (!ALIGN_EPI) { if (wr == 0) PG8_BAR; }
    PG8_BAR;
    if constexpr (Epi::AFTER_DRAIN) { E.fused(acc, cur, wr, wc, fr, fq, lds, wid, lane); S.done(cur); }
#undef PG8_SA
#undef PG8_SB
#undef PG8_STAGE
#undef PG8_LDA
#undef PG8_LDB
#undef PG8_MMA
#undef PG8_WAIT_V
#undef PG8_WAIT_L
#undef PG8_BAR
#undef PG8_SCHED
}
}
#define GAS __attribute__((address_space(1)))
#define LAS __attribute__((address_space(3)))
typedef unsigned short bf16;
typedef unsigned v4u __attribute__((ext_vector_type(4)));
typedef float f32x4 __attribute__((ext_vector_type(4)));
typedef short bf16x8 __attribute__((ext_vector_type(8)));
typedef GAS unsigned gu32;
typedef GAS unsigned long long gu64;
#define RLX_AGENT __ATOMIC_RELAXED, __HIP_MEMORY_SCOPE_AGENT
#define LDS_WAIT() asm volatile("s_waitcnt lgkmcnt(0)" ::: "memory")
#define VM_WAIT() asm volatile("s_waitcnt vmcnt(0)" ::: "memory")
__device__ __forceinline__ unsigned long long rt() { return __builtin_amdgcn_s_memrealtime(); }
__device__ __forceinline__ unsigned f2bf(float f) { unsigned u = __builtin_bit_cast(unsigned, f); return (u + 0x7fffu + ((u >> 16) & 1u)) >> 16; }
__device__ __forceinline__ unsigned pk2(float lo, float hi) { return f2bf(lo) | (f2bf(hi) << 16); }

#define XB_TMO      128
#define XB_XCNT(j)  (256  + 64 * (j))
#define XB_XSUB(j)  (1280 + 64 * (j))
#define XB_XGEN(j)  (2304 + 64 * (j))
#define XB_TOP      3328
#define XB_TOPGEN   3392
#define XCD_BAR_WORDS 3456
#define XB_SPIN_CAP (1u << 18)

__device__ __forceinline__ unsigned xb_ld(unsigned* p)              { return __hip_atomic_load(p, __ATOMIC_RELAXED, __HIP_MEMORY_SCOPE_AGENT); }
__device__ __forceinline__ unsigned xb_add(unsigned* p, unsigned v) { return __hip_atomic_fetch_add(p, v, __ATOMIC_RELAXED, __HIP_MEMORY_SCOPE_AGENT); }
__device__ __forceinline__ unsigned xb_xcc_id() { return (unsigned)__builtin_amdgcn_s_getreg((3 << 11) | 20) & 0xFu; }
#define XB_SPIN(cond, bar) do { unsigned _sp = 0; while (cond) { __builtin_amdgcn_s_sleep(1); \
    if ((++_sp & 255u) == 0u) { if (xb_ld(&(bar)[XB_TMO])) break; if (_sp > XB_SPIN_CAP) { atomicAdd(&(bar)[XB_TMO], 1u); break; } } } } while (0)

struct XcdBarrier {
    unsigned* bar; unsigned x;
    volatile LAS unsigned* st;
};

__device__ __forceinline__ XcdBarrier xcd_barrier_post(unsigned* bar, volatile LAS unsigned* st) {
    XcdBarrier b; b.bar = bar; b.x = xb_xcc_id(); b.st = st;
    if (threadIdx.x == 0) (void)xb_add(&bar[XB_XCNT(b.x)], 1u);
    return b;
}
__device__ __forceinline__ void xcd_barrier_complete(unsigned* bar, unsigned x, unsigned& nloc, unsigned& nx) {
    const unsigned G = gridDim.x * gridDim.y * gridDim.z;
    unsigned sum, cnt, mine, sp = 0u;
    for (;;) {
        sum = 0u; cnt = 0u; mine = 0u;
#pragma unroll
        for (unsigned j = 0; j < 16; ++j) { const unsigned c = xb_ld(&bar[XB_XCNT(j)]); sum += c; cnt += (c > 0u) ? 1u : 0u; mine = (j == x) ? c : mine; }
        if (sum == G) break;
        __builtin_amdgcn_s_sleep(1);
        if ((++sp & 255u) == 0u) { if (xb_ld(&bar[XB_TMO])) break; if (sp > XB_SPIN_CAP) { atomicAdd(&bar[XB_TMO], 1u); break; } }
    }
    nloc = mine > 0u ? mine : 1u; nx = cnt > 0u ? cnt : 1u;
}

__device__ __forceinline__ void xcd_barrier(const XcdBarrier& b) {
    asm volatile("s_waitcnt vmcnt(0)" ::: "memory");
    __syncthreads();
    if (threadIdx.x == 0) {
        unsigned* bar = b.bar;
        __builtin_amdgcn_s_waitcnt(0);
        unsigned nloc = b.st[0], nx = b.st[1];
        if (nloc == 0u) { xcd_barrier_complete(bar, b.x, nloc, nx); b.st[0] = nloc; b.st[1] = nx; }
        const unsigned old = xb_add(&bar[XB_XSUB(b.x)], 1u);
        const unsigned gen = old / nloc;
        if (old + 1u == (gen + 1u) * nloc) {
            __builtin_amdgcn_fence(__ATOMIC_RELEASE, "agent");
            asm volatile("s_waitcnt vmcnt(0)" ::: "memory");
            const unsigned og = xb_add(&bar[XB_TOP], 1u);
            const unsigned tg = og / nx;
            if (og + 1u == (tg + 1u) * nx) xb_add(&bar[XB_TOPGEN], 1u);
            else XB_SPIN(xb_ld(&bar[XB_TOPGEN]) == tg, bar);
            __builtin_amdgcn_fence(__ATOMIC_ACQUIRE, "agent");
            xb_add(&bar[XB_XGEN(b.x)], 1u);
            asm volatile("s_waitcnt vmcnt(0)" ::: "memory");
        } else {
            XB_SPIN(xb_ld(&bar[XB_XGEN(b.x)]) == gen, bar);
            __builtin_amdgcn_fence(__ATOMIC_ACQUIRE, "agent");
            asm volatile("s_waitcnt vmcnt(0)" ::: "memory");
        }
    }
    __syncthreads();
}

constexpr int NWAVES = 8;
constexpr int NB = 8, SEQ = 4096, D = 1024, M = NB * SEQ, FF = 2816, FF2 = 2 * FF, DC = 512, DR = 512, NH = 8, HD = 64, CW = 31, RW = 4, NMIX = 2048;
constexpr float EPS = 1e-6f;
constexpr int LDM = 11 * D;
constexpr size_t MiB = 1u << 20;
constexpr size_t WS_CTL = 0, CTL_ZERO_BYTES = 1 * MiB;
constexpr size_t WS_MOD = 1 * MiB;
constexpr size_t WS_BIAS1 = 1 * MiB + 512 * 1024;
constexpr size_t WS_BIAS2 = 2 * MiB;
constexpr size_t WS_WGT = 2 * MiB + 128 * 1024;
constexpr size_t WS_CS1 = 2 * MiB + 384 * 1024, WS_CS3 = 2 * MiB + 448 * 1024;
constexpr size_t WS_RS1 = 2 * MiB + 512 * 1024, WS_RS3 = 2 * MiB + 640 * 1024;
constexpr size_t WS_CS2 = 2 * MiB + 480 * 1024, WS_RS2 = 2 * MiB + 768 * 1024;
constexpr size_t WS_TOT = 3 * MiB;
constexpr size_t WS_SSP = 5 * MiB;
constexpr size_t WS_W1I = 8 * MiB, WS_W1O = 19 * MiB, WS_WIN = 25 * MiB, WS_WOUT = 29 * MiB, WS_W2I = 31 * MiB, WS_W2O = 42 * MiB;
constexpr size_t WS_Y = 48 * MiB;
constexpr size_t WS_X1 = 112 * MiB;
constexpr size_t WS_ACT = 240 * MiB;
constexpr size_t WS_U = WS_ACT, WS_UX = WS_ACT + 32 * MiB, WS_GY = WS_ACT + 64 * MiB, WS_YMIX = WS_ACT + 96 * MiB;
constexpr size_t WS_SSPF = 416 * MiB;
constexpr size_t WS_SSPX = 418 * MiB;
constexpr size_t WS_SSPX3 = 422 * MiB;
constexpr size_t WS_END = 426 * MiB;
constexpr int CW_BAR = 4096, CW_SEAM = 16384, CW_SCAN = 32768, CW_SEAM7 = 49152, CW_SEAM3 = 65536;
constexpr int LDS_BYTES = 147456;
constexpr int LDSCTL_OFF = LDS_BYTES - 256;

typedef unsigned short u16;
typedef float f32x16 __attribute__((ext_vector_type(16)));
typedef float f32x2 __attribute__((ext_vector_type(2)));

__device__ __forceinline__ float wave_sum(float v) {
#pragma unroll
    for (int o = 1; o < 64; o <<= 1) v += __shfl_xor(v, o);
    return v;
}
__device__ __forceinline__ float sigmoid_fast(float x) { return __builtin_amdgcn_rcpf(1.f + __builtin_amdgcn_exp2f(-1.4426950408889634f * x)); }
__device__ __forceinline__ float silu_fast(float x) { return x * sigmoid_fast(x); }
__device__ __forceinline__ float gelu_tanh_fast(float x) { const float z = 0.7978845608028654f * (x + 0.044715f * x * x * x); return x * sigmoid_fast(2.f * z); }
__device__ __forceinline__ f32x4 sigmoid4(const f32x4 x) { const f32x4 t = x * -1.4426950408889634f; f32x4 e = {__builtin_amdgcn_exp2f(t[0]), __builtin_amdgcn_exp2f(t[1]), __builtin_amdgcn_exp2f(t[2]), __builtin_amdgcn_exp2f(t[3])};
    e = e + 1.0f; return (f32x4){__builtin_amdgcn_rcpf(e[0]), __builtin_amdgcn_rcpf(e[1]), __builtin_amdgcn_rcpf(e[2]), __builtin_amdgcn_rcpf(e[3])}; }
__device__ __forceinline__ f32x4 gelu_tanh4(const f32x4 x) { const f32x4 z2 = (x + (x * x) * x * 0.044715f) * (2.0f * 0.7978845608028654f); return x * sigmoid4(z2); }
__device__ __forceinline__ float bflo(unsigned w) { return __uint_as_float(w << 16); }
__device__ __forceinline__ float bfhi(unsigned w) { return __uint_as_float(w & 0xffff0000u); }
__device__ __forceinline__ unsigned cvtpk(float lo, float hi) { return pg8::cvt_pk_bf16(lo, hi); }
__device__ __forceinline__ v4u pack8(const f32x4 a, const f32x4 b) { v4u w; w.x = cvtpk(a[0], a[1]); w.y = cvtpk(a[2], a[3]); w.z = cvtpk(b[0], b[1]); w.w = cvtpk(b[2], b[3]); return w; }

__device__ __forceinline__ void unpack8(const v4u w, f32x4& a, f32x4& b) { a = (f32x4){bflo(w.x), bfhi(w.x), bflo(w.y), bfhi(w.y)}; b = (f32x4){bflo(w.z), bfhi(w.z), bflo(w.w), bfhi(w.w)}; }
__device__ __forceinline__ unsigned q8(float v) { int q = (int)__builtin_rintf(v); q = q < -127 ? -127 : (q > 127 ? 127 : q); return (unsigned)q & 0xffu; }
__device__ __forceinline__ unsigned q8x4(const f32x4 v) { return q8(v[0]) | (q8(v[1]) << 8) | (q8(v[2]) << 16) | (q8(v[3]) << 24); }
__device__ __forceinline__ float wave_max(float v) {
#pragma unroll
    for (int o = 1; o < 64; o <<= 1) v = fmaxf(v, __shfl_xor(v, o));
    return v;
}
typedef int i32x4v __attribute__((ext_vector_type(4)));
__device__ __forceinline__ f32x4 acc_i2f(const f32x4 a) { return __builtin_convertvector(__builtin_bit_cast(i32x4v, a), f32x4); }
__device__ __forceinline__ float clamp448(float v) { return __builtin_fminf(__builtin_fmaxf(v, -448.0f), 448.0f); }
__device__ __forceinline__ unsigned f8x4(const f32x4 v) { int w = __builtin_amdgcn_cvt_pk_fp8_f32(clamp448(v[0]), clamp448(v[1]), 0, false); w = __builtin_amdgcn_cvt_pk_fp8_f32(clamp448(v[2]), clamp448(v[3]), w, true); return (unsigned)w; }
constexpr float F8_ACT_SCALE = 8.0f, F8_W_SCALE = 2048.0f;
__device__ __forceinline__ void load_rstd(const float* ssp, int row0, int fq, float (&rs)[2][4]) {
#pragma unroll
    for (int ai = 0; ai < 2; ++ai)
#pragma unroll
        for (int m = 0; m < 4; ++m) { const f32x4 p = *(const f32x4*)(ssp + (size_t)(row0 + ai * 128 + m * 16) * 16 + 4 * fq);
            float s = (p[0] + p[1]) + (p[2] + p[3]); s += __shfl_xor(s, 16); s += __shfl_xor(s, 32); rs[ai][m] = rsqrtf(s * (1.0f / D) + EPS); }
}
__device__ __forceinline__ void load_rstd_sc1(const float* ssp, int row0, int fq, float (&rs)[2][4]) {
#pragma unroll
    for (int ai = 0; ai < 2; ++ai)
#pragma unroll
        for (int m = 0; m < 4; ++m) { const gu32* p = (const gu32*)(ssp + (size_t)(row0 + ai * 128 + m * 16) * 16 + 4 * fq);
            const float p0 = __uint_as_float(__hip_atomic_load(p, RLX_AGENT)), p1 = __uint_as_float(__hip_atomic_load(p + 1, RLX_AGENT)), p2 = __uint_as_float(__hip_atomic_load(p + 2, RLX_AGENT)), p3 = __uint_as_float(__hip_atomic_load(p + 3, RLX_AGENT));
            float s = (p0 + p1) + (p2 + p3); s += __shfl_xor(s, 16); s += __shfl_xor(s, 32); rs[ai][m] = rsqrtf(s * (1.0f / D) + EPS); }
}
#ifndef MK_EPI_SWIGLU_REPS
#define MK_EPI_SWIGLU_REPS 1
#endif
#ifndef MK_EPI_RESID_REPS
#define MK_EPI_RESID_REPS 1
#endif
struct EpiSwiglu {
    static constexpr bool PERM = true, AFTER_DRAIN = false; static constexpr int REPS = MK_EPI_SWIGLU_REPS;
    pg8::bf16_t* act; const float* ssp; const float* bias;
    __device__ __forceinline__ void operator()(const f32x4 (&acc)[2][2][4][2], const pg8::Unit& u, int wr, int wc, int fr, int fq) const {
        const int row0 = u.pm * 256 + wr * 64 + fr, b = u.pm >> 4;
        float rs[2][4]; load_rstd(ssp, row0, fq, rs);
        const float* bp = bias + (size_t)b * FF2 + u.pn * 256 + wc * 32 + 8 * fq;
        const f32x4 bg0 = *(const f32x4*)(bp), bg1 = *(const f32x4*)(bp + 4), bu0 = *(const f32x4*)(bp + 128), bu1 = *(const f32x4*)(bp + 132);
        const int oc = u.pn * 128 + wc * 32 + 8 * fq;
#pragma unroll
        for (int ai = 0; ai < 2; ++ai)
#pragma unroll
            for (int m = 0; m < 4; ++m) { const float r = rs[ai][m];
                const f32x4 g0 = acc[ai][0][m][0] * r + bg0, g1 = acc[ai][0][m][1] * r + bg1, u0 = acc[ai][1][m][0] * r + bu0, u1 = acc[ai][1][m][1] * r + bu1;
                const f32x4 a0 = (g0 * sigmoid4(g0)) * u0, a1 = (g1 * sigmoid4(g1)) * u1;
                *(v4u*)(act + (size_t)(row0 + ai * 128 + m * 16) * FF + oc) = pack8(a0, a1); }
    }
};
template <bool OUT8> struct EpiSwiglu8 {
    static constexpr bool PERM = true, AFTER_DRAIN = false; static constexpr int REPS = 1;
    pg8::bf16_t* act; const float* rs; const float* cs;
    __device__ __forceinline__ void operator()(const f32x4 (&acc)[2][2][4][2], const pg8::Unit& u, int wr, int wc, int fr, int fq) const {
        const int row0 = u.pm * 256 + wr * 64 + fr;
        float rv[2][4];
#pragma unroll
        for (int ai = 0; ai < 2; ++ai)
#pragma unroll
            for (int m = 0; m < 4; ++m) rv[ai][m] = rs[row0 + ai * 128 + m * 16];
        const int cb = u.pn * 256 + wc * 32 + 8 * fq;
        const float* cp = cs + cb;
        const f32x4 cg0 = *(const f32x4*)(cp), cg1 = *(const f32x4*)(cp + 4), cu0 = *(const f32x4*)(cp + 128), cu1 = *(const f32x4*)(cp + 132);
        const int oc = u.pn * 128 + wc * 32 + 8 * fq;
#pragma unroll
        for (int ai = 0; ai < 2; ++ai)
#pragma unroll
            for (int m = 0; m < 4; ++m) { const float r = rv[ai][m];
                const f32x4 g0 = acc_i2f(acc[ai][0][m][0]) * (cg0 * r), g1 = acc_i2f(acc[ai][0][m][1]) * (cg1 * r);
                const f32x4 u0 = acc_i2f(acc[ai][1][m][0]) * (cu0 * r), u1 = acc_i2f(acc[ai][1][m][1]) * (cu1 * r);
                const f32x4 a0 = (g0 * sigmoid4(g0)) * u0, a1 = (g1 * sigmoid4(g1)) * u1;
                if (OUT8) *(unsigned long long*)((unsigned char*)act + (size_t)(row0 + ai * 128 + m * 16) * FF + oc) = (unsigned long long)f8x4(a0 * F8_ACT_SCALE) | ((unsigned long long)f8x4(a1 * F8_ACT_SCALE) << 32);
                else *(v4u*)(act + (size_t)(row0 + ai * 128 + m * 16) * FF + oc) = pack8(a0, a1); }
    }
};
template <int WHALF, bool HASY, bool IN16, bool F8 = false> struct EpiResid {
    static constexpr bool PERM = true, AFTER_DRAIN = false; static constexpr int REPS = (IN16 ? 1 : MK_EPI_RESID_REPS);
    static constexpr float w = (WHALF ? 0.5f : 1.0f) * (F8 ? 1.0f / (F8_ACT_SCALE * F8_W_SCALE) : 1.0f);
    const void* xin; pg8::bf16_t* xout; pg8::bf16_t* y; float* ssp; const float* gt; const float* gnext; const float* scnext;
    __device__ __forceinline__ void operator()(const f32x4 (&acc)[2][2][4][2], const pg8::Unit& u, int wr, int wc, int fr, int fq) const {
        const int row0 = u.pm * 256 + wr * 64 + fr, b = u.pm >> 4;
        float ss[2][4];
#pragma unroll
        for (int ai = 0; ai < 2; ++ai)
#pragma unroll
            for (int m = 0; m < 4; ++m) ss[ai][m] = 0.f;
#pragma unroll
        for (int bj = 0; bj < 2; ++bj) { const int c0 = u.pn * 256 + bj * 128 + wc * 32 + 8 * fq;
            const f32x4 gt0 = *(const f32x4*)(gt + (size_t)b * LDM + c0) * w, gt1 = *(const f32x4*)(gt + (size_t)b * LDM + c0 + 4) * w;
            f32x4 gs0 = {0.f, 0.f, 0.f, 0.f}, gs1 = gs0;
            if (HASY) { gs0 = *(const f32x4*)(gnext + c0) * (*(const f32x4*)(scnext + (size_t)b * LDM + c0) + 1.0f); gs1 = *(const f32x4*)(gnext + c0 + 4) * (*(const f32x4*)(scnext + (size_t)b * LDM + c0 + 4) + 1.0f); }
#pragma unroll
            for (int ai = 0; ai < 2; ++ai)
#pragma unroll
                for (int m = 0; m < 4; ++m) { const size_t off = (size_t)(row0 + ai * 128 + m * 16) * D + c0;
                    f32x4 x0, x1;
                    if (IN16) unpack8(*(const v4u*)((const pg8::bf16_t*)xin + off), x0, x1); else { x0 = *(const f32x4*)((const float*)xin + off); x1 = *(const f32x4*)((const float*)xin + off + 4); }
                    const f32x4 o0 = x0 + gt0 * acc[ai][bj][m][0], o1 = x1 + gt1 * acc[ai][bj][m][1];
                    *(v4u*)(xout + off) = pack8(o0, o1);
                    ss[ai][m] += (o0[0] * o0[0] + o0[1] * o0[1]) + (o0[2] * o0[2] + o0[3] * o0[3]) + (o1[0] * o1[0] + o1[1] * o1[1]) + (o1[2] * o1[2] + o1[3] * o1[3]);
                    if (HASY) *(v4u*)(y + off) = pack8(o0 * gs0, o1 * gs1); } }
#pragma unroll
        for (int ai = 0; ai < 2; ++ai)
#pragma unroll
            for (int m = 0; m < 4; ++m) { float s = ss[ai][m]; s += __shfl_xor(s, 16); s += __shfl_xor(s, 32);
                if (fq == 0) ssp[(size_t)(row0 + ai * 128 + m * 16) * 16 + u.pn * 4 + wc] = s; }
    }
};
template <int WHALF, bool IN16> struct EpiResidQ {
    static constexpr bool PERM = true, AFTER_DRAIN = false; static constexpr int REPS = 1;
    static constexpr float w = WHALF ? 0.5f : 1.0f;
    const void* xin; pg8::bf16_t* xout; unsigned char* a8; float* rs; f32x2* sspx; const float* gt; const float* gnext; const float* scnext; const float* shnext; const float* shmax; unsigned* cnt;
    __device__ __forceinline__ void operator()(f32x4 (&acc)[2][2][4][2], const pg8::Unit& u, int wr, int wc, int fr, int fq) const {
        const int row0 = u.pm * 256 + wr * 64 + fr, b = u.pm >> 4;
        float ss[2][4], am[2][4];
#pragma unroll
        for (int ai = 0; ai < 2; ++ai)
#pragma unroll
            for (int m = 0; m < 4; ++m) { ss[ai][m] = 0.f; am[ai][m] = 0.f; }
        const unsigned voff = (unsigned)((row0 * D + u.pn * 256 + wc * 32 + 8 * fq) * 2);
        unsigned vo[4] = {voff, voff, voff, voff};
#pragma unroll
        for (int bj = 0; bj < 2; ++bj) { const int c0 = u.pn * 256 + bj * 128 + wc * 32 + 8 * fq;
            const f32x4 gt0 = *(const f32x4*)(gt + (size_t)b * LDM + c0) * w, gt1 = *(const f32x4*)(gt + (size_t)b * LDM + c0 + 4) * w;
            const f32x4 gs0 = *(const f32x4*)(gnext + c0) * (*(const f32x4*)(scnext + (size_t)b * LDM + c0) + 1.0f), gs1 = *(const f32x4*)(gnext + c0 + 4) * (*(const f32x4*)(scnext + (size_t)b * LDM + c0 + 4) + 1.0f);
#pragma unroll
            for (int ai = 0; ai < 2; ++ai)
#pragma unroll
                for (int m = 0; m < 4; ++m) { const unsigned so = (unsigned)(((ai * 128 + m * 16) * D + bj * 128) * 2); const int g = m & 3;
                    f32x4 x0, x1;
                    if (IN16) unpack8(*(const v4u*)((const char*)xin + (size_t)(vo[g] + so)), x0, x1);
                    else { const char* p = (const char*)xin + 2 * (size_t)(vo[g] + so); x0 = *(const f32x4*)p; x1 = *(const f32x4*)(p + 16); }
                    const f32x4 o0 = x0 + gt0 * acc[ai][bj][m][0], o1 = x1 + gt1 * acc[ai][bj][m][1];
                    *(v4u*)((char*)xout + (size_t)(vo[g] + so)) = pack8(o0, o1);
                    acc[ai][bj][m][0] = o0; acc[ai][bj][m][1] = o1;
                    ss[ai][m] += (o0[0] * o0[0] + o0[1] * o0[1]) + (o0[2] * o0[2] + o0[3] * o0[3]) + (o1[0] * o1[0] + o1[1] * o1[1]) + (o1[2] * o1[2] + o1[3] * o1[3]);
                    const f32x4 t0 = __builtin_elementwise_abs(o0 * gs0), t1 = __builtin_elementwise_abs(o1 * gs1);
                    am[ai][m] = fmaxf(am[ai][m], fmaxf(fmaxf(fmaxf(t0[0], t0[1]), fmaxf(t0[2], t0[3])), fmaxf(fmaxf(t1[0], t1[1]), fmaxf(t1[2], t1[3]))));
                    asm volatile("" : "+v"(vo[g]) : "v"(ss[ai][m])); } }
#pragma unroll
        for (int ai = 0; ai < 2; ++ai)
#pragma unroll
            for (int m = 0; m < 4; ++m) { float s = ss[ai][m], a = am[ai][m]; s += __shfl_xor(s, 16); s += __shfl_xor(s, 32); a = fmaxf(a, __shfl_xor(a, 16)); a = fmaxf(a, __shfl_xor(a, 32));
                if (fq == 0) __hip_atomic_store((gu64*)(sspx + (size_t)(row0 + ai * 128 + m * 16) * 16 + u.pn * 4 + wc), ((unsigned long long)__float_as_uint(a) << 32) | __float_as_uint(s), RLX_AGENT); }
        asm volatile("s_waitcnt vmcnt(0)" ::: "memory");
        unsigned* cw = cnt + 64 * u.pm;
        if ((threadIdx.x & 63) == 0) __hip_atomic_fetch_add(cw, 1u, __ATOMIC_RELAXED, __HIP_MEMORY_SCOPE_AGENT);
        if (threadIdx.x < 64) {
            unsigned sp = 0;
            while ((unsigned)__builtin_amdgcn_readfirstlane(__hip_atomic_load(cw, __ATOMIC_RELAXED, __HIP_MEMORY_SCOPE_AGENT)) < 32u) { __builtin_amdgcn_s_sleep(1); if (++sp > (1u << 20)) break; }
            __builtin_amdgcn_fence(__ATOMIC_ACQUIRE, "agent");
            asm volatile("s_waitcnt vmcnt(0)" ::: "memory");
        }
        asm volatile("" ::: "memory"); __builtin_amdgcn_s_barrier(); asm volatile("" ::: "memory");
        float qs[2][4], qr[2][4];
        const float shm = shmax[b];
#pragma unroll
        for (int ai = 0; ai < 2; ++ai)
#pragma unroll
            for (int m = 0; m < 4; ++m) { const int row = row0 + ai * 128 + m * 16; const gu64* p = (const gu64*)(sspx + (size_t)row * 16 + 4 * fq);
                float s = 0.f, a = 0.f;
#pragma unroll
                for (int e = 0; e < 4; ++e) { const unsigned long long t = __hip_atomic_load(p + e, RLX_AGENT); s += __uint_as_float((unsigned)t); a = fmaxf(a, __uint_as_float((unsigned)(t >> 32))); }
                s += __shfl_xor(s, 16); s += __shfl_xor(s, 32); a = fmaxf(a, __shfl_xor(a, 16)); a = fmaxf(a, __shfl_xor(a, 32));
                const float rstd = rsqrtf(s * (1.0f / D) + EPS), S = rstd * a + shm;
                qs[ai][m] = S > 0.f ? 127.0f / S : 0.f; qr[ai][m] = rstd * qs[ai][m];
                if (u.pn == 0 && wc == 0 && fq == 0) rs[row] = S * (1.0f / 127.0f); }
        const unsigned voff8 = (unsigned)(row0 * D + u.pn * 256 + wc * 32 + 8 * fq);
#pragma unroll
        for (int bj = 0; bj < 2; ++bj) { const int c0 = u.pn * 256 + bj * 128 + wc * 32 + 8 * fq;
            const f32x4 gs0 = *(const f32x4*)(gnext + c0) * (*(const f32x4*)(scnext + (size_t)b * LDM + c0) + 1.0f), gs1 = *(const f32x4*)(gnext + c0 + 4) * (*(const f32x4*)(scnext + (size_t)b * LDM + c0 + 4) + 1.0f);
            const f32x4 sh0 = *(const f32x4*)(shnext + (size_t)b * LDM + c0), sh1 = *(const f32x4*)(shnext + (size_t)b * LDM + c0 + 4);
#pragma unroll
            for (int ai = 0; ai < 2; ++ai)
#pragma unroll
                for (int m = 0; m < 4; ++m) { const float q = qs[ai][m], r = qr[ai][m]; const unsigned so = (unsigned)((ai * 128 + m * 16) * D + bj * 128);
                    *(unsigned long long*)(a8 + (size_t)(voff8 + so)) = (unsigned long long)q8x4(acc[ai][bj][m][0] * (gs0 * r) + sh0 * q) | ((unsigned long long)q8x4(acc[ai][bj][m][1] * (gs1 * r) + sh1 * q) << 32); } }
    }
};
template <bool F8> struct EpiResidFinal {
    static constexpr bool PERM = true, AFTER_DRAIN = false; static constexpr int REPS = 1;
    static constexpr float ascale = F8 ? 1.0f / (F8_ACT_SCALE * F8_W_SCALE) : 1.0f;
    const pg8::bf16_t* xin; float* out; float* ssp; const float* gt; const float* gf; const float* fsc; const float* fsh; unsigned* cnt;
    __device__ __forceinline__ void operator()(f32x4 (&acc)[2][2][4][2], const pg8::Unit& u, int wr, int wc, int fr, int fq) const {
        const int row0 = u.pm * 256 + wr * 64 + fr, b = u.pm >> 4;
        const __amdgpu_buffer_rsrc_t rx = __builtin_amdgcn_make_buffer_rsrc((void*)xin, 0, M * D * 4, 0x00020000), ro = __builtin_amdgcn_make_buffer_rsrc((void*)out, 0, M * D * 4, 0x00020000);
        const unsigned voff = (unsigned)((row0 * D + u.pn * 256 + wc * 32 + 8 * fq) * 4);
        float ss[2][4];
#pragma unroll
        for (int ai = 0; ai < 2; ++ai)
#pragma unroll
            for (int m = 0; m < 4; ++m) ss[ai][m] = 0.f;
        unsigned vo[4] = {voff, voff, voff, voff};
#pragma unroll
        for (int bj = 0; bj < 2; ++bj) { const int c0 = u.pn * 256 + bj * 128 + wc * 32 + 8 * fq;
            const float hw = 0.5f * ascale; const f32x4 gt0 = *(const f32x4*)(gt + (size_t)b * LDM + c0) * hw, gt1 = *(const f32x4*)(gt + (size_t)b * LDM + c0 + 4) * hw;
#pragma unroll
            for (int ai = 0; ai < 2; ++ai)
#pragma unroll
                for (int m = 0; m < 4; ++m) { const unsigned so = (unsigned)(((ai * 128 + m * 16) * D + bj * 128) * 4); const int g = m & 3;
                    f32x4 x0, x1; unpack8(*(const v4u*)((const char*)xin + (size_t)((vo[g] + so) >> 1)), x0, x1);
                    const f32x4 o0 = x0 + gt0 * acc[ai][bj][m][0], o1 = x1 + gt1 * acc[ai][bj][m][1];
                    acc[ai][bj][m][0] = o0; acc[ai][bj][m][1] = o1;
                    ss[ai][m] += (o0[0] * o0[0] + o0[1] * o0[1]) + (o0[2] * o0[2] + o0[3] * o0[3]) + (o1[0] * o1[0] + o1[1] * o1[1]) + (o1[2] * o1[2] + o1[3] * o1[3]);
                    asm volatile("" : "+v"(vo[g]) : "v"(ss[ai][m])); } }
#pragma unroll
        for (int ai = 0; ai < 2; ++ai)
#pragma unroll
            for (int m = 0; m < 4; ++m) { float s = ss[ai][m]; s += __shfl_xor(s, 16); s += __shfl_xor(s, 32);
                if (fq == 0) __hip_atomic_store((gu32*)(ssp + (size_t)(row0 + ai * 128 + m * 16) * 16 + u.pn * 4 + wc), __float_as_uint(s), RLX_AGENT); }
        asm volatile("s_waitcnt vmcnt(0)" ::: "memory");
        unsigned* cw = cnt + 64 * u.pm;
        if ((threadIdx.x & 63) == 0) __hip_atomic_fetch_add(cw, 1u, __ATOMIC_RELAXED, __HIP_MEMORY_SCOPE_AGENT);
        if (threadIdx.x < 64) {
            unsigned sp = 0;
            while ((unsigned)__builtin_amdgcn_readfirstlane(__hip_atomic_load(cw, __ATOMIC_RELAXED, __HIP_MEMORY_SCOPE_AGENT)) < 32u) { __builtin_amdgcn_s_sleep(1); if (++sp > (1u << 20)) break; }
            __builtin_amdgcn_fence(__ATOMIC_ACQUIRE, "agent");
            asm volatile("s_waitcnt vmcnt(0)" ::: "memory");
        }
        asm volatile("" ::: "memory"); __builtin_amdgcn_s_barrier(); asm volatile("" ::: "memory");
        float rs[2][4]; load_rstd_sc1(ssp, row0, fq, rs);
#pragma unroll
        for (int bj = 0; bj < 2; ++bj) { const int c0 = u.pn * 256 + bj * 128 + wc * 32 + 8 * fq;
            const f32x4 gs0 = *(const f32x4*)(gf + c0) * (*(const f32x4*)(fsc + (size_t)b * LDM + c0) + 1.0f), gs1 = *(const f32x4*)(gf + c0 + 4) * (*(const f32x4*)(fsc + (size_t)b * LDM + c0 + 4) + 1.0f);
            const f32x4 sh0 = *(const f32x4*)(fsh + (size_t)b * LDM + c0), sh1 = *(const f32x4*)(fsh + (size_t)b * LDM + c0 + 4);
#pragma unroll
            for (int ai = 0; ai < 2; ++ai)
#pragma unroll
                for (int m = 0; m < 4; ++m) { const unsigned so = (unsigned)(((ai * 128 + m * 16) * D + bj * 128) * 4); const float r = rs[ai][m];
                    *(f32x4*)((char*)out + (size_t)voff + so) = acc[ai][bj][m][0] * r * gs0 + sh0;
                    *(f32x4*)((char*)out + (size_t)voff + so + 16) = acc[ai][bj][m][1] * r * gs1 + sh1; } }
    }
};
struct EpiMixIn {
    static constexpr bool PERM = true, AFTER_DRAIN = false; static constexpr int REPS = 1;
    pg8::bf16_t *U, *UX, *GY; const float* ssp; const float* bias;
    __device__ __forceinline__ void operator()(const f32x4 (&acc)[2][2][4][2], const pg8::Unit& u, int wr, int wc, int fr, int fq) const {
        const int row0 = u.pm * 256 + wr * 64 + fr, b = u.pm >> 4;
        float rs[2][4]; load_rstd(ssp, row0, fq, rs);
        const float* bp = bias + (size_t)b * NMIX + u.pn * 256 + wc * 32 + 8 * fq;
        const f32x4 b00 = *(const f32x4*)(bp), b01 = *(const f32x4*)(bp + 4), b10 = *(const f32x4*)(bp + 128), b11 = *(const f32x4*)(bp + 132);
        if (u.pn < 4) {
            const int oc = u.pn * 128 + wc * 32 + 8 * fq;
#pragma unroll
            for (int ai = 0; ai < 2; ++ai)
#pragma unroll
                for (int m = 0; m < 4; ++m) { const float r = rs[ai][m];
                    const f32x4 v0 = acc[ai][0][m][0] * r + b00, v1 = acc[ai][0][m][1] * r + b01, g0 = acc[ai][1][m][0] * r + b10, g1 = acc[ai][1][m][1] * r + b11;
                    const f32x4 a0 = v0 * sigmoid4(g0), a1 = v1 * sigmoid4(g1);
                    *(v4u*)(U + (size_t)(row0 + ai * 128 + m * 16) * DC + oc) = pack8(a0, a1); }
        } else {
            pg8::bf16_t* dst = (u.pn < 6) ? UX : GY; const bool gel = u.pn >= 6; const int pc = (u.pn & 1) * 256 + wc * 32 + 8 * fq;
#pragma unroll
            for (int ai = 0; ai < 2; ++ai)
#pragma unroll
                for (int m = 0; m < 4; ++m) { const float r = rs[ai][m];
#pragma unroll
                    for (int bj = 0; bj < 2; ++bj) { f32x4 v0 = acc[ai][bj][m][0] * r + (bj ? b10 : b00), v1 = acc[ai][bj][m][1] * r + (bj ? b11 : b01);
                        if (gel) { v0 = gelu_tanh4(v0); v1 = gelu_tanh4(v1); }
                        *(v4u*)(dst + (size_t)(row0 + ai * 128 + m * 16) * DR + pc + bj * 128) = pack8(v0, v1); } }
        }
    }
};

struct EpiMixIn8 {
    static constexpr bool PERM = true, AFTER_DRAIN = false; static constexpr int REPS = 1;
    pg8::bf16_t *U, *UX, *GY; const float* rs; const float* cs; const float* bias;
    __device__ __forceinline__ void operator()(const f32x4 (&acc)[2][2][4][2], const pg8::Unit& u, int wr, int wc, int fr, int fq) const {
        const int row0 = u.pm * 256 + wr * 64 + fr, b = u.pm >> 4;
        float rv[2][4];
#pragma unroll
        for (int ai = 0; ai < 2; ++ai)
#pragma unroll
            for (int m = 0; m < 4; ++m) rv[ai][m] = rs[row0 + ai * 128 + m * 16];
        const int cb = u.pn * 256 + wc * 32 + 8 * fq;
        const float* bp = bias + (size_t)b * NMIX + cb; const float* cp = cs + cb;
        const f32x4 b00 = *(const f32x4*)(bp), b01 = *(const f32x4*)(bp + 4), b10 = *(const f32x4*)(bp + 128), b11 = *(const f32x4*)(bp + 132);
        const f32x4 c00 = *(const f32x4*)(cp), c01 = *(const f32x4*)(cp + 4), c10 = *(const f32x4*)(cp + 128), c11 = *(const f32x4*)(cp + 132);
        if (u.pn < 4) {
            const int oc = u.pn * 128 + wc * 32 + 8 * fq;
#pragma unroll
            for (int ai = 0; ai < 2; ++ai)
#pragma unroll
                for (int m = 0; m < 4; ++m) { const float r = rv[ai][m];
                    const f32x4 v0 = acc_i2f(acc[ai][0][m][0]) * (c00 * r) + b00, v1 = acc_i2f(acc[ai][0][m][1]) * (c01 * r) + b01;
                    const f32x4 g0 = acc_i2f(acc[ai][1][m][0]) * (c10 * r) + b10, g1 = acc_i2f(acc[ai][1][m][1]) * (c11 * r) + b11;
                    const f32x4 a0 = v0 * sigmoid4(g0), a1 = v1 * sigmoid4(g1);
                    *(v4u*)(U + (size_t)(row0 + ai * 128 + m * 16) * DC + oc) = pack8(a0, a1); }
        } else {
            pg8::bf16_t* dst = (u.pn < 6) ? UX : GY; const bool gel = u.pn >= 6; const int pc = (u.pn & 1) * 256 + wc * 32 + 8 * fq;
#pragma unroll
            for (int ai = 0; ai < 2; ++ai)
#pragma unroll
                for (int m = 0; m < 4; ++m) { const float r = rv[ai][m];
#pragma unroll
                    for (int bj = 0; bj < 2; ++bj) { f32x4 v0 = acc_i2f(acc[ai][bj][m][0]) * ((bj ? c10 : c00) * r) + (bj ? b10 : b00), v1 = acc_i2f(acc[ai][bj][m][1]) * ((bj ? c11 : c01) * r) + (bj ? b11 : b01);
                        if (gel) { v0 = gelu_tanh4(v0); v1 = gelu_tanh4(v1); }
                        *(v4u*)(dst + (size_t)(row0 + ai * 128 + m * 16) * DR + pc + bj * 128) = pack8(v0, v1); } }
        }
    }
};

__device__ __forceinline__ void p0_gemv(LAS unsigned char* lds, const float* c, const float* W, int NC, const float* bias, float* out, int j0, int tid) {
    LAS float* ca = (LAS float*)lds; LAS float* part = (LAS float*)(lds + 32768);
    for (int i = tid; i < NB * D; i += 512) { const float v = c[i]; ca[i] = v / (1.f + expf(-v)); }
    __syncthreads();
    const int cg = tid & 31, ks = tid >> 5;
    const float* wp = W + (size_t)(64 * ks) * NC + j0 + 4 * cg;
    f32x4 acc[NB];
#pragma unroll
    for (int b = 0; b < NB; ++b) acc[b] = (f32x4){0.f, 0.f, 0.f, 0.f};
#pragma unroll 4
    for (int kk = 0; kk < 64; ++kk) { const f32x4 w = *(const f32x4*)(wp + (size_t)kk * NC);
#pragma unroll
        for (int b = 0; b < NB; ++b) acc[b] += w * ca[b * D + 64 * ks + kk]; }
#pragma unroll
    for (int b = 0; b < NB; ++b) *(LAS f32x4*)(part + (ks * NB + b) * 128 + 4 * cg) = acc[b];
    __syncthreads();
#pragma unroll
    for (int r = 0; r < 2; ++r) { const int o = tid + 512 * r, b = o >> 7, col = o & 127; float s = 0.f;
#pragma unroll
        for (int k2 = 0; k2 < 16; ++k2) s += part[(k2 * NB + b) * 128 + col];
        out[(size_t)b * LDM + j0 + col] = s + bias[j0 + col]; }
    __syncthreads();
}
__device__ __forceinline__ int rowmap(int kind, int n0) {
    if (kind == 1) { const int half = n0 / FF, f = n0 - half * FF; return 256 * (f >> 7) + 128 * half + (f & 127); }
    if (kind == 2 && n0 < 1024) { const int half = n0 >> 9, f = n0 & 511; return 256 * (f >> 7) + 128 * half + (f & 127); }
    return n0;
}
__device__ __forceinline__ void p0_transpose_item(const float* W, int K, int N, bf16* WT, int kind, LAS float* scr, int item, int lane) {
    const int nblk = N / 32, kb = item / nblk, nb = item % nblk, k0 = 64 * kb, n0 = 32 * nb, r0 = rowmap(kind, n0);
#pragma unroll 8
    for (int i = 0; i < 32; ++i) { const int kk = 2 * i + (lane >> 5); scr[kk * 33 + (lane & 31)] = W[(size_t)(k0 + kk) * N + n0 + (lane & 31)]; }
    LDS_WAIT(); asm volatile("" ::: "memory");
    const int c = lane & 7;
#pragma unroll
    for (int j = 0; j < 4; ++j) { const int n = (lane >> 3) + 8 * j; const LAS float* s = scr + (8 * c) * 33 + n;
        v4u o; o.x = pk2(s[0 * 33], s[1 * 33]); o.y = pk2(s[2 * 33], s[3 * 33]); o.z = pk2(s[4 * 33], s[5 * 33]); o.w = pk2(s[6 * 33], s[7 * 33]);
        *(GAS v4u*)(WT + (size_t)(r0 + n) * K + k0 + 8 * c) = o; }
    LDS_WAIT(); asm volatile("" ::: "memory");
}

__device__ __forceinline__ void p0_transpose8_item(const float* W, int K, int N, unsigned char* WT, LAS float* scr, int item, int lane) {
    const int nblk = N / 32, kb = item / nblk, nb = item % nblk, k0 = 64 * kb, n0 = 32 * nb;
#pragma unroll 8
    for (int i = 0; i < 32; ++i) { const int kk = 2 * i + (lane >> 5); scr[kk * 33 + (lane & 31)] = W[(size_t)(k0 + kk) * N + n0 + (lane & 31)]; }
    LDS_WAIT(); asm volatile("" ::: "memory");
    const int n = lane >> 1, kh = (lane & 1) * 32; const LAS float* sp = scr + n;
#pragma unroll
    for (int hq = 0; hq < 2; ++hq) { v4u o;
#pragma unroll
        for (int dq = 0; dq < 4; ++dq) { const int k = kh + 16 * hq + 4 * dq;
            const unsigned w4 = f8x4((f32x4){sp[(k + 0) * 33], sp[(k + 1) * 33], sp[(k + 2) * 33], sp[(k + 3) * 33]} * F8_W_SCALE);
            if (dq == 0) o.x = w4; else if (dq == 1) o.y = w4; else if (dq == 2) o.z = w4; else o.w = w4; }
        *(GAS v4u*)(WT + (size_t)(n0 + n) * K + k0 + kh + 16 * hq) = o; }
    LDS_WAIT(); asm volatile("" ::: "memory");
}
__device__ __forceinline__ void p0_quant_item(LAS unsigned char* lds, const float* W, int N, int kind, unsigned char* W8, float* cs, int nb, int lane, int wave) {
    LAS float* scr = (LAS float*)(lds + wave * 16896);
    LAS float* cm = (LAS float*)(lds + 8 * 16896);
    const int n0 = 32 * nb, r0 = rowmap(kind, n0);
#pragma unroll
    for (int tl = 0; tl < 2; ++tl) { const int k0 = 64 * (2 * wave + tl);
#pragma unroll 8
        for (int i = 0; i < 32; ++i) { const int kk = 2 * i + (lane >> 5); scr[tl * 2112 + kk * 33 + (lane & 31)] = W[(size_t)(k0 + kk) * N + n0 + (lane & 31)]; } }
    LDS_WAIT(); asm volatile("" ::: "memory");
    float mx = 0.f;
#pragma unroll
    for (int tl = 0; tl < 2; ++tl)
#pragma unroll 8
        for (int r = 0; r < 32; ++r) mx = fmaxf(mx, fabsf(scr[tl * 2112 + ((lane >> 5) * 32 + r) * 33 + (lane & 31)]));
    mx = fmaxf(mx, __shfl_xor(mx, 32));
    if (lane < 32) cm[wave * 32 + lane] = mx;
    __syncthreads();
    float cmax = 0.f;
#pragma unroll
    for (int w = 0; w < 8; ++w) cmax = fmaxf(cmax, cm[w * 32 + (lane & 31)]);
    const float sc = cmax > 0.f ? 127.0f / cmax : 0.f;
    if (wave == 0 && lane < 32) cs[r0 + lane] = cmax * (1.0f / 127.0f);
    const int n = lane >> 1, kh = (lane & 1) * 32;
    const float sn = __shfl(sc, n);
#pragma unroll
    for (int tl = 0; tl < 2; ++tl) { const int k0 = 64 * (2 * wave + tl); const LAS float* sp = scr + tl * 2112 + n;
#pragma unroll
        for (int hq = 0; hq < 2; ++hq) { v4u o;
#pragma unroll
            for (int dq = 0; dq < 4; ++dq) { const int k = kh + 16 * hq + 4 * dq;
                const unsigned w4 = q8(sp[(k + 0) * 33] * sn) | (q8(sp[(k + 1) * 33] * sn) << 8) | (q8(sp[(k + 2) * 33] * sn) << 16) | (q8(sp[(k + 3) * 33] * sn) << 24);
                if (dq == 0) o.x = w4; else if (dq == 1) o.y = w4; else if (dq == 2) o.z = w4; else o.w = w4; }
            *(GAS v4u*)(W8 + (size_t)(r0 + n) * D + k0 + kh + 16 * hq) = o; } }
    __syncthreads();
}

__device__ __forceinline__ void mix_conv(LAS unsigned char* lds, const bf16* U, const float* conv_w, const float* conv_b, const float* ln_g, const float* ln_b, bf16* YMIX, int G, int bx, int tid, int lane, int wave) {
    LAS unsigned char* IN = lds;
    LAS f32x4* WA = (LAS f32x4*)(lds + 63488);
    LAS f32x4* WB = WA + 31 * 64;
    for (int i = tid; i < 31 * 64; i += 512) { const int k = i >> 6, l = i & 63; WA[i] = *(const f32x4*)(conv_w + k * DC + 8 * l); WB[i] = *(const f32x4*)(conv_w + k * DC + 8 * l + 4); }
    const f32x4 cb0 = *(const f32x4*)(conv_b + 8 * lane), cb1 = *(const f32x4*)(conv_b + 8 * lane + 4);
    const f32x4 lg0 = *(const f32x4*)(ln_g + 8 * lane), lg1 = *(const f32x4*)(ln_g + 8 * lane + 4);
    const f32x4 lb0 = *(const f32x4*)(ln_b + 8 * lane), lb1 = *(const f32x4*)(ln_b + 8 * lane + 4);
    v4u pre[8];
#pragma unroll
    for (int i = 0; i < 8; ++i) { const int q = tid + 512 * i, row = q >> 6, ch = q & 63, tok = (bx & 127) * 32 - 30 + row; pre[i] = (v4u){0u, 0u, 0u, 0u};
        if (bx < NB * (SEQ / 32) && q < 62 * 64 && tok >= 0) pre[i] = *(const v4u*)(U + ((size_t)((bx >> 7) * SEQ + tok)) * DC + 8 * ch); }
    for (int item = bx; item < NB * (SEQ / 32); item += G) {
        const int b = item >> 7, t0 = (item & 127) * 32;
        __syncthreads();
#pragma unroll
        for (int i = 0; i < 8; ++i) { const int q = tid + 512 * i; if (q < 62 * 64) *(LAS v4u*)(IN + (q >> 6) * 1024 + (q & 63) * 16) = pre[i]; }
        { const int nitem = item + G, nb = nitem >> 7, nt0 = (nitem & 127) * 32;
#pragma unroll
            for (int i = 0; i < 8; ++i) { const int q = tid + 512 * i, row = q >> 6, ch = q & 63, tok = nt0 - 30 + row; pre[i] = (v4u){0u, 0u, 0u, 0u};
                if (nitem < NB * (SEQ / 32) && q < 62 * 64 && tok >= 0) pre[i] = *(const v4u*)(U + ((size_t)(nb * SEQ + tok)) * DC + 8 * ch); } }
        __syncthreads();
        f32x4 a0[4], a1[4];
#pragma unroll
        for (int tt = 0; tt < 4; ++tt) { a0[tt] = cb0; a1[tt] = cb1; }
        f32x4 wa0 = {0.f, 0.f, 0.f, 0.f}, wa1 = wa0, wa2 = wa0, wa3 = wa0, wb0 = wa0, wb1 = wa0, wb2 = wa0, wb3 = wa0;
#pragma unroll
        for (int kk = 0; kk < 34; ++kk) {
            const v4u v = *(const LAS v4u*)(IN + (4 * wave + kk) * 1024 + lane * 16);
            const f32x4 x0 = {bflo(v.x), bfhi(v.x), bflo(v.y), bfhi(v.y)}, x1 = {bflo(v.z), bfhi(v.z), bflo(v.w), bfhi(v.w)};
            wa3 = wa2; wa2 = wa1; wa1 = wa0; wb3 = wb2; wb2 = wb1; wb1 = wb0;
            if (kk <= 30) { wa0 = WA[kk * 64 + lane]; wb0 = WB[kk * 64 + lane]; } else { wa0 = (f32x4){0.f, 0.f, 0.f, 0.f}; wb0 = wa0; }
            a0[0] += wa0 * x0; a1[0] += wb0 * x1; a0[1] += wa1 * x0; a1[1] += wb1 * x1; a0[2] += wa2 * x0; a1[2] += wb2 * x1; a0[3] += wa3 * x0; a1[3] += wb3 * x1;
        }
#pragma unroll
        for (int tt = 0; tt < 4; ++tt) {
            float s = (a0[tt][0] + a0[tt][1]) + (a0[tt][2] + a0[tt][3]) + (a1[tt][0] + a1[tt][1]) + (a1[tt][2] + a1[tt][3]);
            const float mean = wave_sum(s) * (1.0f / DC);
            const f32x4 d0 = a0[tt] - mean, d1 = a1[tt] - mean;
            float q = (d0[0] * d0[0] + d0[1] * d0[1]) + (d0[2] * d0[2] + d0[3] * d0[3]) + (d1[0] * d1[0] + d1[1] * d1[1]) + (d1[2] * d1[2] + d1[3] * d1[3]);
            const float rstd = rsqrtf(wave_sum(q) * (1.0f / DC) + EPS);
            f32x4 y0 = d0 * rstd * lg0 + lb0, y1 = d1 * rstd * lg1 + lb1;
#pragma unroll
            for (int j = 0; j < 4; ++j) { y0[j] = silu_fast(y0[j]); y1[j] = silu_fast(y1[j]); }
            *(v4u*)(YMIX + ((size_t)(b * SEQ + t0 + 4 * wave + tt)) * D + 8 * lane) = pack8(y0, y1);
        }
    }
    __syncthreads();
}

__device__ __forceinline__ void scan_decode(int it, int& b, int& c) { if (it < 256) { b = it >> 6; c = it & 63; } else { b = 4 + ((it - 256) >> 6); c = 63 - ((it - 256) & 63); } }
__device__ __forceinline__ float neg_expm1(float x, float a) {
    float p = -1.0f / 5040.0f; p = p * x - 1.0f / 720.0f; p = p * x - 1.0f / 120.0f; p = p * x - 1.0f / 24.0f; p = p * x - 1.0f / 6.0f; p = p * x - 0.5f; p = p * x - 1.0f;
    float q = p * x, w = 1.0f - a * a; asm volatile("" : "+v"(q), "+v"(w));
    return x > -0.5f ? q : w;
}
__device__ __forceinline__ void gate_math16(const f32x16 pa, const f32x16 pi, float ba, float bi, float c8, f32x16& av, f32x16& bv) {
#pragma unroll
    for (int g4 = 0; g4 < 4; ++g4) {
        const f32x4 pa4 = {pa[4 * g4], pa[4 * g4 + 1], pa[4 * g4 + 2], pa[4 * g4 + 3]}, pi4 = {pi[4 * g4], pi[4 * g4 + 1], pi[4 * g4 + 2], pi[4 * g4 + 3]};
        const f32x4 rg = sigmoid4(pa4 + ba), ig = sigmoid4(pi4 + bi);
        const f32x4 l2 = rg * c8;
        const f32x4 a = {__builtin_amdgcn_exp2f(l2[0]), __builtin_amdgcn_exp2f(l2[1]), __builtin_amdgcn_exp2f(l2[2]), __builtin_amdgcn_exp2f(l2[3])};
        const f32x4 x = l2 * 1.3862943611198906f;
        f32x4 p = x * (-1.0f / 5040.0f) - 1.0f / 720.0f; p = p * x - 1.0f / 120.0f; p = p * x - 1.0f / 24.0f; p = p * x - 1.0f / 6.0f; p = p * x - 0.5f; p = p * x - 1.0f;
        const f32x4 q = p * x, w = 1.0f - a * a;
        f32x4 m2;
#pragma unroll
        for (int e = 0; e < 4; ++e) m2[e] = __builtin_amdgcn_sqrtf(x[e] > -0.5f ? q[e] : w[e]);
        const f32x4 bb = m2 * ig;
#pragma unroll
        for (int e = 0; e < 4; ++e) { av[4 * g4 + e] = a[e]; bv[4 * g4 + e] = bb[e]; }
        __builtin_amdgcn_sched_barrier(0);
    }
}
template <bool FINAL>
__device__ __forceinline__ void mix_scan(LAS unsigned char* lds, const bf16* UX, const bf16* GY, const bf16* WGT, const float* rw, const float* rb, const float* b_a, const float* b_i, const float* lam,
                                         f32x2* TOT, bf16* YMIX, int G, int bx, int lane, int wave) {
    LAS unsigned char* UXT = lds + wave * 16896;
    LAS unsigned char* XRT = UXT + 8704;
    const int h = wave, j = lane & 31, hh = lane >> 5, dg = lane & 7, tg = lane >> 3;
    float c8v[2], bav[2], biv[2];
#pragma unroll
    for (int ec = 0; ec < 2; ++ec) { const int ch = 64 * h + 32 * ec + j; c8v[ec] = -8.0f * 1.4426950408889634f * log1pf(expf(-lam[ch]));   bav[ec] = b_a[ch]; biv[ec] = b_i[ch]; }
    for (int it = bx; it < 512; it += G) {
        asm volatile("" ::: "memory");
        int b, c; scan_decode(it, b, c);
        const size_t mrow0 = (size_t)b * SEQ + 64 * c;
#pragma unroll
        for (int i = 0; i < 9; ++i) { const int row = i * 8 + tg, tok = 64 * c - 3 + row; v4u v = {0u, 0u, 0u, 0u};
            if (row < 67 && tok >= 0) v = *(const v4u*)(UX + ((size_t)b * SEQ + tok) * DR + 64 * h + 8 * dg);
            if (row < 68) *(LAS v4u*)(UXT + row * 128 + dg * 16) = v; }
        pg8::bf16x8 bfr[2][4];
#pragma unroll
        for (int g = 0; g < 2; ++g)
#pragma unroll
            for (int ks = 0; ks < 4; ++ks) bfr[g][ks] = *(const pg8::bf16x8*)(WGT + ((size_t)(h * 128 + 64 * g + j)) * 64 + 16 * ks + 8 * hh);
        v4u gyv[8];
        if (FINAL) {
#pragma unroll
            for (int i = 0; i < 8; ++i) gyv[i] = *(const v4u*)(GY + (mrow0 + i * 8 + tg) * DR + 64 * h + 8 * dg);
        }
        float Hc = 0.f;
        if (FINAL) { const f32x2* tp = TOT + ((size_t)b * 64) * DR + 64 * h + lane; int cc = 0;
            for (; cc + 8 <= c; cc += 8) { f32x2 t8[8];
#pragma unroll
                for (int u = 0; u < 8; ++u) t8[u] = tp[(size_t)(cc + u) * DR];
#pragma unroll
                for (int u = 0; u < 8; ++u) Hc = Hc * t8[u].x + t8[u].y; }
            for (; cc < c; ++cc) { const f32x2 ab = tp[(size_t)cc * DR]; Hc = Hc * ab.x + ab.y; } }
        {
            f32x4 w4a[4], w4b[4];
#pragma unroll
            for (int k = 0; k < 4; ++k) { w4a[k] = *(const f32x4*)(rw + k * DR + 64 * h + 8 * dg); w4b[k] = *(const f32x4*)(rw + k * DR + 64 * h + 8 * dg + 4); }
            const f32x4 rb0 = *(const f32x4*)(rb + 64 * h + 8 * dg), rb1 = *(const f32x4*)(rb + 64 * h + 8 * dg + 4);
#pragma unroll
            for (int th = 0; th < 2; ++th) {
                f32x4 o0[4], o1[4];
#pragma unroll
                for (int t = 0; t < 4; ++t) { o0[t] = rb0; o1[t] = rb1; }
#pragma unroll
                for (int i = 0; i < 7; ++i) { const v4u v = *(const LAS v4u*)(UXT + (8 * tg + 4 * th + i) * 128 + dg * 16);
                    const f32x4 x0 = {bflo(v.x), bfhi(v.x), bflo(v.y), bfhi(v.y)}, x1 = {bflo(v.z), bfhi(v.z), bflo(v.w), bfhi(v.w)};
#pragma unroll
                    for (int k = 0; k < 4; ++k) { const int t = i - k; if (t >= 0 && t < 4) { o0[t] += w4a[k] * x0; o1[t] += w4b[k] * x1; } } }
#pragma unroll
                for (int t = 0; t < 4; ++t) *(LAS v4u*)(XRT + (8 * tg + 4 * th + t) * 128 + dg * 16) = pack8(o0[t], o1[t]);
            }
        }
        if (FINAL) {
#pragma unroll
            for (int i = 0; i < 8; ++i) *(LAS v4u*)(UXT + (i * 8 + tg) * 128 + dg * 16) = gyv[i];
        }
#pragma unroll
        for (int ec = 0; ec < 2; ++ec) {
            const int ch = 64 * h + 32 * ec + j;
            const float c8 = c8v[ec], ba = bav[ec], bi = biv[ec];
            f32x16 av[2], bv[2];
#pragma unroll
            for (int tt = 0; tt < 2; ++tt) {
                pg8::bf16x8 afr[4];
#pragma unroll
                for (int ks = 0; ks < 4; ++ks) afr[ks] = *(const LAS pg8::bf16x8*)(XRT + (32 * tt + j) * 128 + (16 * ks + 8 * hh) * 2);
                f32x16 pa, pi;
#pragma unroll
                for (int r = 0; r < 16; ++r) { pa[r] = 0.f; pi[r] = 0.f; }
#pragma unroll
                for (int ks = 0; ks < 4; ++ks) {
                    pa = __builtin_amdgcn_mfma_f32_32x32x16_bf16(afr[ks], bfr[0][ks], pa, 0, 0, 0);
                    pi = __builtin_amdgcn_mfma_f32_32x32x16_bf16(afr[ks], bfr[1][ks], pi, 0, 0, 0); }
                if (ec == 0 && tt == 1) {
#pragma unroll
                    for (int g = 0; g < 2; ++g)
#pragma unroll
                        for (int ks = 0; ks < 4; ++ks) bfr[g][ks] = *(const pg8::bf16x8*)(WGT + ((size_t)(h * 128 + 64 * g + 32 + j)) * 64 + 16 * ks + 8 * hh);
                }
                gate_math16(pa, pi, ba, bi, c8, av[tt], bv[tt]);
                {
                    f32x16 px;
#pragma unroll
                    for (int r = 0; r < 16; ++r) px[r] = bv[tt][r] * 0.f;
                    int dd = 32 * ec + j - 8 * hh; asm volatile("" : "+v"(dd));
                    const unsigned one = (dd & 1) ? 0x3F800000u : 0x00003F80u;
#pragma unroll
                    for (int ks = 0; ks < 4; ++ks) {
                        const int dw = (dd - 16 * ks) >> 1;
                        v4u idw; idw.x = dw == 0 ? one : 0u; idw.y = dw == 1 ? one : 0u; idw.z = dw == 2 ? one : 0u; idw.w = dw == 3 ? one : 0u;
                        px = __builtin_amdgcn_mfma_f32_32x32x16_bf16(afr[ks], __builtin_bit_cast(pg8::bf16x8, idw), px, 0, 0, 0); }
#pragma unroll
                    for (int r = 0; r < 16; ++r) bv[tt][r] *= px[r];
                }
            }
            float GA[2][4], GB[2][4], PA[2][4], PB[2][4];
#pragma unroll
            for (int tt = 0; tt < 2; ++tt)
#pragma unroll
                for (int q = 0; q < 4; ++q) { const float a0 = av[tt][4 * q], a1 = av[tt][4 * q + 1], a2 = av[tt][4 * q + 2], a3 = av[tt][4 * q + 3];
                    const float b0 = bv[tt][4 * q], b1 = bv[tt][4 * q + 1], b2 = bv[tt][4 * q + 2], b3 = bv[tt][4 * q + 3];
                    GA[tt][q] = (a0 * a1) * (a2 * a3); GB[tt][q] = ((b0 * a1 + b1) * a2 + b2) * a3 + b3;
                    PA[tt][q] = __shfl_xor(GA[tt][q], 32); PB[tt][q] = __shfl_xor(GB[tt][q], 32); }
            if (!FINAL) {
                float At = 1.f, Bt = 0.f;
#pragma unroll
                for (int tt = 0; tt < 2; ++tt)
#pragma unroll
                    for (int q = 0; q < 4; ++q) { const float A0 = hh ? PA[tt][q] : GA[tt][q], B0 = hh ? PB[tt][q] : GB[tt][q], A1 = hh ? GA[tt][q] : PA[tt][q], B1 = hh ? GB[tt][q] : PB[tt][q];
                        Bt = (Bt * A0 + B0) * A1 + B1; At = (At * A0) * A1; }
                if (hh == 0) TOT[((size_t)b * 64 + c) * DR + ch] = (f32x2){At, Bt};
            } else {
                float hc = __shfl(Hc, 32 * ec + j);
#pragma unroll
                for (int tt = 0; tt < 2; ++tt)
#pragma unroll
                    for (int q = 0; q < 4; ++q) { const float A0 = hh ? PA[tt][q] : GA[tt][q], B0 = hh ? PB[tt][q] : GB[tt][q], A1 = hh ? GA[tt][q] : PA[tt][q], B1 = hh ? GB[tt][q] : PB[tt][q];
                        const float mid = hc * A0 + B0; float hv = hh ? mid : hc; hc = mid * A1 + B1;
#pragma unroll
                        for (int i = 0; i < 4; ++i) { hv = av[tt][4 * q + i] * hv + bv[tt][4 * q + i]; av[tt][4 * q + i] = hv; } }
#pragma unroll
                for (int tt = 0; tt < 2; ++tt)
#pragma unroll
                    for (int r = 0; r < 16; ++r) { const int tk = 32 * tt + (r & 3) + 8 * (r >> 2) + 4 * hh;
                        LAS u16* p = (LAS u16*)(UXT + tk * 128 + (32 * ec + j) * 2);
                        const float gy = __uint_as_float((unsigned)(*p) << 16);
                        *p = (u16)f2bf(gy * av[tt][r]); }
            }
        }
        if (FINAL) {
#pragma unroll
            for (int i = 0; i < 8; ++i) { const int row = i * 8 + tg; *(v4u*)(YMIX + (mrow0 + row) * D + DC + 64 * h + 8 * dg) = *(const LAS v4u*)(UXT + row * 128 + dg * 16); }
        }
    }
    __syncthreads();
}

__device__ __forceinline__ void fold_chunks(const gu64* tp, int c0, int c1, int hh, float& A, float& B) {
    const int mid = (c0 + c1 + 1) >> 1, lo = hh ? mid : c0, hi2 = hh ? c1 : mid;
    float Ar = 1.f, Br = 0.f;
    for (int cc = lo; cc < hi2; cc += 4) { unsigned long long t8[4];
#pragma unroll
        for (int u = 0; u < 4; ++u) t8[u] = __hip_atomic_load(tp + (size_t)(cc + u < 63 ? cc + u : 63) * DR, RLX_AGENT);
#pragma unroll
        for (int u = 0; u < 4; ++u) { const bool ok = cc + u < hi2; const float ta = ok ? __uint_as_float((unsigned)t8[u]) : 1.f, tb = ok ? __uint_as_float((unsigned)(t8[u] >> 32)) : 0.f; Br = Br * ta + tb; Ar = Ar * ta; } }
    const float Ap = __shfl_xor(Ar, 32), Bp = __shfl_xor(Br, 32);
    A = Ar * Ap; B = hh ? (Bp * Ar + Br) : (Br * Ap + Bp);
}
__device__ __forceinline__ void mix_scan1(LAS unsigned char* lds, const bf16* UX, const bf16* GY, const bf16* WGT, const float* rw, const float* rb, const float* b_a, const float* b_i, const float* lam,
                                          f32x2* TOT, unsigned* cnt, bf16* YMIX, int G, int bx, int lane, int wave) {
    LAS unsigned char* UXT = lds + wave * 16896;
    LAS unsigned char* XRT = UXT + 8704;
    const int h = wave, j = lane & 31, hh = lane >> 5, dg = lane & 7, tg = lane >> 3;
    const int gs = G >> 3, b = bx / gs, idx = bx - b * gs;
    float c8v[2], bav[2], biv[2];
#pragma unroll
    for (int ec = 0; ec < 2; ++ec) { const int ch = 64 * h + 32 * ec + j; c8v[ec] = -8.0f * 1.4426950408889634f * log1pf(expf(-lam[ch])); bav[ec] = b_a[ch]; biv[ec] = b_i[ch]; }
    for (int c = idx, round = 0; c < 64; c += gs, ++round) {
        asm volatile("" ::: "memory");
        const size_t mrow0 = (size_t)b * SEQ + 64 * c;
#pragma unroll
        for (int i = 0; i < 9; ++i) { const int row = i * 8 + tg, tok = 64 * c - 3 + row; v4u v = {0u, 0u, 0u, 0u};
            if (row < 67 && tok >= 0) v = *(const v4u*)(UX + ((size_t)b * SEQ + tok) * DR + 64 * h + 8 * dg);
            if (row < 68) *(LAS v4u*)(UXT + row * 128 + dg * 16) = v; }
        pg8::bf16x8 bfr[2][4];
#pragma unroll
        for (int g = 0; g < 2; ++g)
#pragma unroll
            for (int ks = 0; ks < 4; ++ks) bfr[g][ks] = *(const pg8::bf16x8*)(WGT + ((size_t)(h * 128 + 64 * g + j)) * 64 + 16 * ks + 8 * hh);
        {
            f32x4 w4a[4], w4b[4];
#pragma unroll
            for (int k = 0; k < 4; ++k) { w4a[k] = *(const f32x4*)(rw + k * DR + 64 * h + 8 * dg); w4b[k] = *(const f32x4*)(rw + k * DR + 64 * h + 8 * dg + 4); }
            const f32x4 rb0 = *(const f32x4*)(rb + 64 * h + 8 * dg), rb1 = *(const f32x4*)(rb + 64 * h + 8 * dg + 4);
#pragma unroll
            for (int th = 0; th < 2; ++th) {
                f32x4 o0[4], o1[4];
#pragma unroll
                for (int t = 0; t < 4; ++t) { o0[t] = rb0; o1[t] = rb1; }
#pragma unroll
                for (int i = 0; i < 7; ++i) { const v4u v = *(const LAS v4u*)(UXT + (8 * tg + 4 * th + i) * 128 + dg * 16);
                    const f32x4 x0 = {bflo(v.x), bfhi(v.x), bflo(v.y), bfhi(v.y)}, x1 = {bflo(v.z), bfhi(v.z), bflo(v.w), bfhi(v.w)};
#pragma unroll
                    for (int k = 0; k < 4; ++k) { const int t = i - k; if (t >= 0 && t < 4) { o0[t] += w4a[k] * x0; o1[t] += w4b[k] * x1; } } }
#pragma unroll
                for (int t = 0; t < 4; ++t) *(LAS v4u*)(XRT + (8 * tg + 4 * th + t) * 128 + dg * 16) = pack8(o0[t], o1[t]);
            }
        }
#pragma unroll
        for (int ec = 0; ec < 2; ++ec) {
            const int ch = 64 * h + 32 * ec + j;
            const float c8 = c8v[ec], ba = bav[ec], bi = biv[ec];
            unsigned* cw = cnt + 64 * (8 * ec + b);
            f32x16 av[2], bv[2];
#pragma unroll
            for (int tt = 0; tt < 2; ++tt) {
                pg8::bf16x8 afr[4];
#pragma unroll
                for (int ks = 0; ks < 4; ++ks) afr[ks] = *(const LAS pg8::bf16x8*)(XRT + (32 * tt + j) * 128 + (16 * ks + 8 * hh) * 2);
                f32x16 pa, pi;
#pragma unroll
                for (int r = 0; r < 16; ++r) { pa[r] = 0.f; pi[r] = 0.f; }
#pragma unroll
                for (int ks = 0; ks < 4; ++ks) {
                    pa = __builtin_amdgcn_mfma_f32_32x32x16_bf16(afr[ks], bfr[0][ks], pa, 0, 0, 0);
                    pi = __builtin_amdgcn_mfma_f32_32x32x16_bf16(afr[ks], bfr[1][ks], pi, 0, 0, 0); }
                if (ec == 0 && tt == 1) {
#pragma unroll
                    for (int g = 0; g < 2; ++g)
#pragma unroll
                        for (int ks = 0; ks < 4; ++ks) bfr[g][ks] = *(const pg8::bf16x8*)(WGT + ((size_t)(h * 128 + 64 * g + 32 + j)) * 64 + 16 * ks + 8 * hh);
                }
                gate_math16(pa, pi, ba, bi, c8, av[tt], bv[tt]);
                {
                    f32x16 px;
#pragma unroll
                    for (int r = 0; r < 16; ++r) px[r] = bv[tt][r] * 0.f;
                    int dd = 32 * ec + j - 8 * hh; asm volatile("" : "+v"(dd));
                    const unsigned one = (dd & 1) ? 0x3F800000u : 0x00003F80u;
#pragma unroll
                    for (int ks = 0; ks < 4; ++ks) {
                        const int dw = (dd - 16 * ks) >> 1;
                        v4u idw; idw.x = dw == 0 ? one : 0u; idw.y = dw == 1 ? one : 0u; idw.z = dw == 2 ? one : 0u; idw.w = dw == 3 ? one : 0u;
                        px = __builtin_amdgcn_mfma_f32_32x32x16_bf16(afr[ks], __builtin_bit_cast(pg8::bf16x8, idw), px, 0, 0, 0); }
#pragma unroll
                    for (int r = 0; r < 16; ++r) bv[tt][r] *= px[r];
                }
            }
            float GA[2][4], GB[2][4], PA[2][4], PB[2][4];
            float At = 1.f, Bt = 0.f;
#pragma unroll
            for (int tt = 0; tt < 2; ++tt)
#pragma unroll
                for (int q = 0; q < 4; ++q) { const float a0 = av[tt][4 * q], a1 = av[tt][4 * q + 1], a2 = av[tt][4 * q + 2], a3 = av[tt][4 * q + 3];
                    const float b0 = bv[tt][4 * q], b1 = bv[tt][4 * q + 1], b2 = bv[tt][4 * q + 2], b3 = bv[tt][4 * q + 3];
                    GA[tt][q] = (a0 * a1) * (a2 * a3); GB[tt][q] = ((b0 * a1 + b1) * a2 + b2) * a3 + b3;
                    PA[tt][q] = __shfl_xor(GA[tt][q], 32); PB[tt][q] = __shfl_xor(GB[tt][q], 32);
                    const float A0 = hh ? PA[tt][q] : GA[tt][q], B0 = hh ? PB[tt][q] : GB[tt][q], A1 = hh ? GA[tt][q] : PA[tt][q], B1 = hh ? GB[tt][q] : PB[tt][q];
                    Bt = (Bt * A0 + B0) * A1 + B1; At = (At * A0) * A1; }
            if (hh == 0) __hip_atomic_store((gu64*)(TOT + ((size_t)b * 64 + c) * DR + ch), ((unsigned long long)__float_as_uint(Bt) << 32) | __float_as_uint(At), RLX_AGENT);
            asm volatile("s_waitcnt vmcnt(0)" ::: "memory");
            if (lane == 0) __hip_atomic_fetch_add(cw, 1u, __ATOMIC_RELAXED, __HIP_MEMORY_SCOPE_AGENT);
            if (ec == 0) {
#pragma unroll
                for (int i = 0; i < 8; ++i) *(LAS v4u*)(UXT + (i * 8 + tg) * 128 + dg * 16) = *(const v4u*)(GY + (mrow0 + i * 8 + tg) * DR + 64 * h + 8 * dg);
            }
            const gu64* tp = (const gu64*)(TOT + ((size_t)b * 64) * DR + ch); const int cpre = round * gs < c ? round * gs : c;
            float Apre = 1.f, Bpre = 0.f;
            if (cpre > 0) fold_chunks(tp, 0, cpre, hh, Apre, Bpre);
            if (wave == 0) { const int upto = (round + 1) * gs < 64 ? (round + 1) * gs : 64; const unsigned need = 8u * (unsigned)upto; unsigned sp = 0;
                while ((unsigned)__builtin_amdgcn_readfirstlane(__hip_atomic_load(cw, __ATOMIC_RELAXED, __HIP_MEMORY_SCOPE_AGENT)) < need) { __builtin_amdgcn_s_sleep(1); if (++sp > (1u << 20)) break; }
                __builtin_amdgcn_fence(__ATOMIC_ACQUIRE, "agent");
                asm volatile("s_waitcnt vmcnt(0)" ::: "memory"); }
            asm volatile("" ::: "memory"); __builtin_amdgcn_s_barrier(); asm volatile("" ::: "memory");
            float hc;
            { float Aq, Bq; fold_chunks(tp, cpre, c, hh, Aq, Bq); hc = Bpre * Aq + Bq; (void)Apre; }
#pragma unroll
            for (int tt = 0; tt < 2; ++tt)
#pragma unroll
                for (int q = 0; q < 4; ++q) { const float A0 = hh ? PA[tt][q] : GA[tt][q], B0 = hh ? PB[tt][q] : GB[tt][q], A1 = hh ? GA[tt][q] : PA[tt][q], B1 = hh ? GB[tt][q] : PB[tt][q];
                    const float mid = hc * A0 + B0; float hv = hh ? mid : hc; hc = mid * A1 + B1;
#pragma unroll
                    for (int i = 0; i < 4; ++i) { hv = av[tt][4 * q + i] * hv + bv[tt][4 * q + i]; av[tt][4 * q + i] = hv; } }
#pragma unroll
            for (int tt = 0; tt < 2; ++tt)
#pragma unroll
                for (int r = 0; r < 16; ++r) { const int tk = 32 * tt + (r & 3) + 8 * (r >> 2) + 4 * hh;
                    LAS u16* p = (LAS u16*)(UXT + tk * 128 + (32 * ec + j) * 2);
                    const float gy = __uint_as_float((unsigned)(*p) << 16);
                    *p = (u16)f2bf(gy * av[tt][r]); }
        }
#pragma unroll
        for (int i = 0; i < 8; ++i) { const int row = i * 8 + tg; *(v4u*)(YMIX + (mrow0 + row) * D + DC + 64 * h + 8 * dg) = *(const LAS v4u*)(UXT + row * 128 + dg * 16); }
    }
    __syncthreads();
}

struct Args { const float* in[27]; float* out; unsigned char* ws; int ph_lo, ph_hi; };
constexpr int NPH = 10;
#ifndef MK_PER_PHASE
#define MK_PER_PHASE 0
#endif
#define MK_STR2(x) #x
#define MK_STR(x) MK_STR2(x)
#ifndef MK_REP_P1X
#define MK_REP_P1X 1
#endif
#ifndef MK_REP_P1B
#define MK_REP_P1B 1
#endif
#ifndef MK_REP_GEMV
#define MK_REP_GEMV 1
#endif
#ifndef MK_REP_QUANT
#define MK_REP_QUANT 1
#endif
#ifndef MK_REP_TRANS
#define MK_REP_TRANS 1
#endif
#ifndef MK_REP_LO
#define MK_REP_LO 0
#define MK_REP_HI 0
#endif

__global__ void __launch_bounds__(NWAVES * 64, 2) mk_fwd(Args args) {
    extern __shared__ __attribute__((aligned(16))) unsigned char lds_raw[];
    LAS unsigned char* lds = (LAS unsigned char*)lds_raw;
    const int tid = threadIdx.x, wave = __builtin_amdgcn_readfirstlane(tid >> 6);
#define LANE_HERE int lane; asm volatile("v_mbcnt_lo_u32_b32 %0, -1, 0\n\tv_mbcnt_hi_u32_b32 %0, -1, %0" : "=v"(lane))
    const int G = gridDim.x, bx = blockIdx.x;
    const int vcu = (G % 8 == 0) ? (bx % 8) * (G / 8) + bx / 8 : bx;
    const int gw = vcu * NWAVES + wave, NGW = G * NWAVES;
    unsigned char* ws = args.ws;
    gu32* ctl = (gu32*)(ws + WS_CTL);
    const float* x = args.in[0]; const float* cvec = args.in[1]; const float* w_mod = args.in[2]; const float* b_mod = args.in[3];
    const float* g1 = args.in[4]; const float* w1i = args.in[5]; const float* w1o = args.in[6]; const float* gm = args.in[7];
    const float* w_in = args.in[8]; const float* conv_w = args.in[9]; const float* conv_b = args.in[10]; const float* ln_g = args.in[11]; const float* ln_b = args.in[12];
    const float* rw = args.in[13]; const float* rb = args.in[14]; const float* wa = args.in[15]; const float* b_a = args.in[16];
    const float* wi = args.in[17]; const float* b_i = args.in[18]; const float* lam = args.in[19]; const float* w_out = args.in[20];
    const float* g2 = args.in[21]; const float* w2i = args.in[22]; const float* w2o = args.in[23]; const float* w_fmod = args.in[24];
    const float* b_fmod = args.in[25]; const float* gf = args.in[26];
    float* out = args.out;
    float* MOD = (float*)(ws + WS_MOD); float* SHMAX3 = (float*)(ws + WS_BIAS1); float* BIAS2 = (float*)(ws + WS_BIAS2);
    bf16* WGT = (bf16*)(ws + WS_WGT); f32x2* TOT = (f32x2*)(ws + WS_TOT); float* SSP = (float*)(ws + WS_SSP);
    bf16 *W1O = (bf16*)(ws + WS_W1O), *WIN = (bf16*)(ws + WS_WIN), *WOUT = (bf16*)(ws + WS_WOUT), *W2O = (bf16*)(ws + WS_W2O);
    unsigned char *W1O8F = ws + WS_W1O, *W2O8F = ws + WS_W2O, *W1I8 = ws + WS_W1I, *W2I8 = ws + WS_W2I, *WIN8 = ws + WS_WIN, *A8 = ws + WS_Y;
    float *CS1 = (float*)(ws + WS_CS1), *CS3 = (float*)(ws + WS_CS3), *CS2 = (float*)(ws + WS_CS2), *RS1 = (float*)(ws + WS_RS1), *RS3 = (float*)(ws + WS_RS3), *RS2 = (float*)(ws + WS_RS2);
    bf16 *Y = (bf16*)(ws + WS_Y), *ACT = (bf16*)(ws + WS_ACT), *U = (bf16*)(ws + WS_U), *UXB = (bf16*)(ws + WS_UX), *GYB = (bf16*)(ws + WS_GY), *YMIX = (bf16*)(ws + WS_YMIX);
    bf16* X1 = (bf16*)(ws + WS_X1);

    for (int u = tid; u < (LDS_BYTES - LDSCTL_OFF) / 4; u += NWAVES * 64) ((LAS unsigned*)(lds + LDSCTL_OFF))[u] = 0u;
    __syncthreads();
    const int lo = args.ph_lo, hi = args.ph_hi;
    const bool use_bar = (hi - lo) > 1;
    XcdBarrier bar; bar.bar = (unsigned*)(ctl + CW_BAR); bar.x = 0; bar.st = nullptr;
    if (use_bar) bar = xcd_barrier_post((unsigned*)(ctl + CW_BAR), (volatile LAS unsigned*)(lds + LDSCTL_OFF) + 8);
#define IN(k) (lo <= (k) && (k) < hi)
#define REPS(k) ((MK_REP_LO <= (k) && (k) < MK_REP_HI) ? 2 : 1)
#define AGAIN(k, rr) do { if ((rr) + 1 < REPS(k)) xcd_barrier(bar); } while (0)
#define SEAM(k) do { if (IN(k) && IN((k) + 1)) xcd_barrier(bar); } while (0)

    if (IN(0))
_Pragma("unroll")
    for (int rr = 0; rr < REPS(0); ++rr) { LANE_HERE;
#ifdef MK_PAD
        asm volatile(".rept " MK_STR(MK_PAD) "\n\ts_nop 0\n\t.endr" ::: "memory");
#endif
        constexpr int NGEMV = 88;
        const int nt_wg = G > NGEMV ? G - NGEMV : G;
        if (bx < NGEMV || G <= NGEMV) {
            for (int rp = 0; rp < MK_REP_GEMV; ++rp)
            for (int it = bx; it < NGEMV; it += G) {
                if (it < 72) p0_gemv(lds, cvec, w_mod, 9 * D, b_mod, MOD, 128 * it, tid);
                else p0_gemv(lds, cvec, w_fmod, 2 * D, b_fmod, MOD + 9 * D, 128 * (it - 72), tid);
            }
        }
        if (bx >= NGEMV || G <= NGEMV) {
            const int tb = G > NGEMV ? bx - NGEMV : bx;
            for (int rp = 0; rp < MK_REP_QUANT; ++rp)
            for (int it = tb; it < 2 * (FF2 / 32); it += nt_wg) {
                if (it < FF2 / 32) p0_quant_item(lds, w1i, FF2, 1, W1I8, CS1, it, lane, wave);
                else p0_quant_item(lds, w2i, FF2, 1, W2I8, CS3, it - FF2 / 32, lane, wave);
            }
            LAS float* scr = (LAS float*)(lds + wave * 16384);
            constexpr int I_1O = (FF / 64) * (D / 32), I_IN = (D / 64) * (NMIX / 32), I_OUT = (D / 64) * (D / 32);
            constexpr int NITEMS = 2 * I_1O + I_IN + I_OUT;
            for (int rp = 0; rp < MK_REP_TRANS; ++rp)
            for (int it = tb * NWAVES + wave; it < NITEMS; it += nt_wg * NWAVES) {
                int r = it;
                if (r < I_1O) { p0_transpose8_item(w1o, FF, D, W1O8F, scr, r, lane); continue; } r -= I_1O;
                if (r < I_1O) { p0_transpose8_item(w2o, FF, D, W2O8F, scr, r, lane); continue; } r -= I_1O;
                if (r < I_IN) { p0_transpose_item(w_in, D, NMIX, WIN, 2, scr, r, lane); continue; } r -= I_IN;
                p0_transpose_item(w_out, D, D, WOUT, 0, scr, r, lane);
            }
        }
        for (int i = bx * 512 + tid; i < NH * 128 * HD; i += G * 512) { const int d = i & 63, e2 = (i >> 6) & 127, hd = i >> 13;
            const float v = e2 < 64 ? wa[(hd * 64 + d) * 64 + e2] : wi[(hd * 64 + d) * 64 + (e2 - 64)]; WGT[i] = (bf16)f2bf(v); }
        AGAIN(0, rr);
    }
    SEAM(0);
    if (IN(1))
_Pragma("unroll")
    for (int rr = 0; rr < REPS(1); ++rr) { LANE_HERE;
        LAS float* shl = (LAS float*)lds;
        for (int i = tid * 4; i < 3 * NB * D; i += 2048) { const int t = i >> 13, r = i & 8191, b = r >> 10, k = r & 1023; *(LAS f32x4*)(shl + i) = *(const f32x4*)(MOD + (size_t)b * LDM + 3 * t * D + k); }
        __syncthreads();
        for (int rp = 0; rp < MK_REP_P1X; ++rp)
        for (int m0 = gw; m0 < M; m0 += 2 * NGW) {
            f32x4 v[2][4];
#pragma unroll
            for (int rr2 = 0; rr2 < 2; ++rr2) { const int m = (m0 + rr2 * NGW < M) ? m0 + rr2 * NGW : m0; const f32x4* xr = (const f32x4*)(x + (size_t)m * D) + lane;
#pragma unroll
                for (int jj = 0; jj < 4; ++jj) v[rr2][jj] = xr[64 * jj]; }
#pragma unroll
            for (int rr2 = 0; rr2 < 2; ++rr2) { const int m = m0 + rr2 * NGW; if (m < M) { const int b = m >> 12;
                float s = 0.f, am = 0.f;
#pragma unroll
                for (int jj = 0; jj < 4; ++jj) s += (v[rr2][jj][0] * v[rr2][jj][0] + v[rr2][jj][1] * v[rr2][jj][1]) + (v[rr2][jj][2] * v[rr2][jj][2] + v[rr2][jj][3] * v[rr2][jj][3]);
                const float rstd = rsqrtf(wave_sum(s) * (1.0f / D) + EPS);
#pragma unroll
                for (int jj = 0; jj < 4; ++jj) { const int k = 4 * lane + 256 * jj;
                    v[rr2][jj] = v[rr2][jj] * (*(const f32x4*)(g1 + k) * (*(const f32x4*)(MOD + (size_t)b * LDM + 1 * D + k) + 1.0f) * rstd) + *(const LAS f32x4*)(shl + (0 * NB + b) * D + k);
                    const f32x4 t = __builtin_elementwise_abs(v[rr2][jj]); am = fmaxf(am, fmaxf(fmaxf(t[0], t[1]), fmaxf(t[2], t[3]))); }
                am = wave_max(am);
                const float q = am > 0.f ? 127.0f / am : 0.f;
#pragma unroll
                for (int jj = 0; jj < 4; ++jj) *(unsigned*)(A8 + (size_t)m * D + 4 * lane + 256 * jj) = q8x4(v[rr2][jj] * q);
                if (lane == 0) RS1[m] = am * (1.0f / 127.0f); } }
        }
        for (int rp = 0; rp < MK_REP_P1B; ++rp)
        if (gw < NB) { float a = 0.f;
            for (int k = lane; k < D; k += 64) a = fmaxf(a, fabsf(shl[(2 * NB + gw) * D + k]));
            a = wave_max(a); if (lane == 0) SHMAX3[gw] = a; }
        for (int it = gw; it < NMIX; it += NGW) {
            {
                const bf16* wrow = WIN + (size_t)it * D; float* op = BIAS2 + it;
                const v4u wA = *(const v4u*)(wrow + 8 * lane), wB = *(const v4u*)(wrow + 512 + 8 * lane);
                f32x4 a0, a1, c0, c1; unpack8(wA, a0, a1); unpack8(wB, c0, c1);
#pragma unroll
                for (int b = 0; b < NB; ++b) { const LAS float* sp = shl + (1 * NB + b) * D + 8 * lane;
                    const f32x4 p = a0 * *(const LAS f32x4*)(sp) + a1 * *(const LAS f32x4*)(sp + 4) + c0 * *(const LAS f32x4*)(sp + 512) + c1 * *(const LAS f32x4*)(sp + 516);
                    const float tot = wave_sum((p[0] + p[1]) + (p[2] + p[3]));
                    if (lane == 0) op[(size_t)b * NMIX] = tot; }
            }
        }
        __syncthreads();
        AGAIN(1, rr);
    }
    SEAM(1);
    if (IN(2))
_Pragma("unroll")
    for (int rr = 0; rr < REPS(2); ++rr) {
        pg8::Gemm g{(const pg8::bf16_t*)A8, (const pg8::bf16_t*)W1I8, M, FF2, D / 2}; pg8::StaticOrder S; S.init(M, FF2, G, bx);
        EpiSwiglu8<true> E{ACT, RS1, CS1};
        pg8::gemm_phase<EpiSwiglu8<true>, pg8::StaticOrder, true, true, 1>(lds, g, S, E);
        AGAIN(2, rr);
    }
    SEAM(2);
    if (IN(3))
_Pragma("unroll")
    for (int rr = 0; rr < REPS(3); ++rr) {
        pg8::Gemm g{ACT, (const pg8::bf16_t*)W1O8F, M, D, FF / 2}; pg8::StaticOrder S; S.init(M, D, G, bx);
        EpiResid<1, true, false, true> E{x, X1, Y, SSP, MOD + 2 * D, gm, MOD + 4 * D};
        pg8::gemm_phase<EpiResid<1, true, false, true>, pg8::StaticOrder, true, true, 2>(lds, g, S, E);
        AGAIN(3, rr);
    }
    SEAM(3);
    if (IN(4))
_Pragma("unroll")
    for (int rr = 0; rr < REPS(4); ++rr) {
        pg8::Gemm g{Y, WIN, M, NMIX, D}; pg8::StaticOrder S; S.init(M, NMIX, G, bx);
        EpiMixIn E{U, UXB, GYB, SSP, BIAS2};
        pg8::gemm_phase<EpiMixIn, pg8::StaticOrder, true, true>(lds, g, S, E);
        AGAIN(4, rr);
    }
    SEAM(4);
    if (IN(5))
_Pragma("unroll")
    for (int rr = 0; rr < REPS(5); ++rr) { LANE_HERE;
        mix_conv(lds, U, conv_w, conv_b, ln_g, ln_b, YMIX, G, bx, tid, lane, wave);
#ifdef MK_REP_CONV
        mix_conv(lds, U, conv_w, conv_b, ln_g, ln_b, YMIX, G, bx, tid, lane, wave);
#endif
        mix_scan1(lds, UXB, GYB, WGT, rw, rb, b_a, b_i, lam, TOT, (unsigned*)(ctl + CW_SCAN), YMIX, G, bx, lane, wave);
        AGAIN(5, rr);
    }
    SEAM(5);
    if (IN(7))
_Pragma("unroll")
    for (int rr = 0; rr < REPS(7); ++rr) {
        pg8::Gemm g{YMIX, WOUT, M, D, D}; pg8::StaticOrder S; S.init(M, D, G, bx);
        EpiResidQ<0, true> E{X1, X1, A8, RS3, (f32x2*)(ws + WS_SSPX), MOD + 5 * D, g2, MOD + 7 * D, MOD + 6 * D, SHMAX3, (unsigned*)(ctl + CW_SEAM7)};
        pg8::gemm_phase<EpiResidQ<0, true>, pg8::StaticOrder, true, true>(lds, g, S, E);
        AGAIN(7, rr);
    }
    SEAM(7);
    if (IN(8))
_Pragma("unroll")
    for (int rr = 0; rr < REPS(8); ++rr) {
        pg8::Gemm g{(const pg8::bf16_t*)A8, (const pg8::bf16_t*)W2I8, M, FF2, D / 2}; pg8::StaticOrder S; S.init(M, FF2, G, bx);
        EpiSwiglu8<true> E{ACT, RS3, CS3};
        pg8::gemm_phase<EpiSwiglu8<true>, pg8::StaticOrder, true, true, 1>(lds, g, S, E);
        AGAIN(8, rr);
    }
    SEAM(8);
    if (IN(9))
_Pragma("unroll")
    for (int rr = 0; rr < REPS(9); ++rr) {
        pg8::Gemm g{ACT, (const pg8::bf16_t*)W2O8F, M, D, FF / 2}; pg8::StaticOrder S; S.init(M, D, G, bx);
        EpiResidFinal<true> E{X1, out, (float*)(ws + WS_SSPF), MOD + 8 * D, gf, MOD + 10 * D, MOD + 9 * D, (unsigned*)(ctl + CW_SEAM)};
        pg8::gemm_phase<EpiResidFinal<true>, pg8::StaticOrder, true, true, 2>(lds, g, S, E);
    }
#undef IN
#undef SEAM
#undef REPS
#undef AGAIN
}

extern "C" void kernel_launch(void* const* d_in, const int* in_sizes, int n_in, void* d_out, int out_size, void* d_ws, size_t ws_size, hipStream_t stream) {
    static int grid = 0;
    if (grid == 0) {
        if (n_in != 27 || in_sizes[0] != M * D || out_size != M * D || ws_size < WS_END) { fprintf(stderr, "kernel_launch: unexpected shapes (n_in %d, in0 %d, out %d, ws %zu)\n", n_in, n_in > 0 ? in_sizes[0] : -1, out_size, ws_size); grid = -1; return; }
        int dev = 0, cus = 0, per_cu = 0;
        if (hipGetDevice(&dev) != hipSuccess || hipDeviceGetAttribute(&cus, hipDeviceAttributeMultiprocessorCount, dev) != hipSuccess) { grid = -1; return; }
        if (hipFuncSetAttribute((const void*)mk_fwd, hipFuncAttributeMaxDynamicSharedMemorySize, LDS_BYTES) != hipSuccess) { fprintf(stderr, "kernel_launch: hipFuncSetAttribute failed\n"); grid = -1; return; }
        if (hipOccupancyMaxActiveBlocksPerMultiprocessor(&per_cu, (const void*)mk_fwd, NWAVES * 64, LDS_BYTES) != hipSuccess || per_cu < 1) fprintf(stderr, "kernel_launch: occupancy query reports %d blocks per CU\n", per_cu);
        (void)hipGetLastError();
        grid = cus;
        if (grid % 8 != 0 || grid < 8) { fprintf(stderr, "kernel_launch: %d CUs: the scan's chunk rounds need a multiple of 8 workgroups\n", grid); grid = -1; return; }
    }
    if (grid < 0) return;
    if (hipMemsetAsync((char*)d_ws + WS_CTL, 0, CTL_ZERO_BYTES, stream) != hipSuccess) return;
    Args a{};
    for (int i = 0; i < 27; ++i) a.in[i] = (const float*)d_in[i];
    a.out = (float*)d_out; a.ws = (unsigned char*)d_ws;
#if MK_PER_PHASE
    for (int p = 0; p < NPH; ++p) { a.ph_lo = p; a.ph_hi = p + 1; hipLaunchKernelGGL(mk_fwd, dim3(grid), dim3(NWAVES * 64), LDS_BYTES, stream, a); }
#else
    a.ph_lo = 0; a.ph_hi = NPH; hipLaunchKernelGGL(mk_fwd, dim3(grid), dim3(NWAVES * 64), LDS_BYTES, stream, a);
#endif
}
```

```cpp
#include <hip/hip_runtime.h>
#include <cstdio>
#include <cstdint>
namespace pg8 {
#define PG8_LAS __attribute__((address_space(3)))
typedef unsigned short bf16_t;
typedef short bf16x8 __attribute__((ext_vector_type(8)));
typedef float f32x4 __attribute__((ext_vector_type(4)));
typedef unsigned u32x4 __attribute__((ext_vector_type(4)));
constexpr int BM = 256, BK = 64, HALF = 128, HTB = HALF * BK * 2  , STAGE_BYTES = 8 * HTB, NXCD = 8, WGM = 8;

__host__ __device__ __forceinline__ int lds_byte(int r, int c) { const int st = (r >> 4) * 2 + (c >> 5), rr = r & 15, cc = c & 31, ob = rr * 64 + cc * 2; return st * 1024 + (ob ^ (((ob >> 9) & 1) << 5)); }
__host__ __device__ __forceinline__ void stage_rc(int b, int& R, int& C) { const int st = b / 1024, sb = b % 1024, swz = sb ^ (((sb >> 9) & 1) << 5); R = (st >> 1) * 16 + swz / 64; C = (st & 1) * 32 + (swz % 64) / 2; }
__host__ __device__ __forceinline__ int perm32(int rho) { const int n = rho >> 4, i = rho & 15; return 8 * (i >> 2) + 4 * n + (i & 3); }

struct Unit { int pm, pn; };
struct Gemm { const bf16_t* A; const bf16_t* Bt; int M, N, K; };

struct StaticOrder {
    int nM, nN, nwg, G, c;
    __host__ __device__ void init(int M, int N, int G_, int c_) { nM = M / BM; nN = N / BM; nwg = nM * nN; G = G_; c = c_; }
    __host__ __device__ bool next(int i, Unit& u) const {
        const long L = (long)i * G + c; if (L >= nwg) return false;
        int wgid = (int)L; { const int q = nwg / NXCD, r = nwg % NXCD, xcd = wgid % NXCD, off = wgid / NXCD; wgid = (xcd < r ? xcd * (q + 1) : r * (q + 1) + (xcd - r) * q) + off; }
        const int nig = WGM * nN, gid = wgid / nig, fm = gid * WGM, gsz = (nM - fm) < WGM ? (nM - fm) : WGM;
        u.pm = fm + ((wgid % nig) % gsz); u.pn = (wgid % nig) / gsz; return true;
    }
    __device__ __forceinline__ void a_ready(const Unit&) const {}
    __device__ __forceinline__ void done(const Unit&) const {}
};

__device__ __forceinline__ unsigned cvt_pk_bf16(float lo, float hi) { unsigned r; asm volatile("v_cvt_pk_bf16_f32 %0, %1, %2" : "=v"(r) : "v"(lo), "v"(hi)); return r; }
#ifndef PG8_STAGE_IN_MMA
#define PG8_STAGE_IN_MMA 0
#endif
typedef int i32x4 __attribute__((ext_vector_type(4)));
typedef int i32x8 __attribute__((ext_vector_type(8)));
__device__ __forceinline__ i32x8 cat32(const bf16x8 lo, const bf16x8 hi) { const i32x4 p = __builtin_bit_cast(i32x4, lo), q = __builtin_bit_cast(i32x4, hi); return (i32x8){p.x, p.y, p.z, p.w, q.x, q.y, q.z, q.w}; }
__device__ __forceinline__ f32x4 mma_mx8(const i32x8 B, const i32x8 A, const f32x4 c) { return __builtin_amdgcn_mfma_scale_f32_16x16x128_f8f6f4(B, A, c, 0, 0, 0, 0x7F7F7F7F, 0, 0x7F7F7F7F); }
template <int I8> __device__ __forceinline__ f32x4 mma16(const bf16x8 b, const bf16x8 a, const f32x4 c) {
    if constexpr (I8 == 1) return __builtin_bit_cast(f32x4, __builtin_amdgcn_mfma_i32_16x16x64_i8(__builtin_bit_cast(i32x4, b), __builtin_bit_cast(i32x4, a), __builtin_bit_cast(i32x4, c), 0, 0, 0));
    else return __builtin_amdgcn_mfma_f32_16x16x32_bf16(b, a, c, 0, 0, 0);
}
template <class Epi, class Sched, bool ALIGN_EPI = false, bool SP2 = false, int I8 = 0>
__device__ __forceinline__ void gemm_phase(PG8_LAS unsigned char* lds, const Gemm g, const Sched& S, const Epi& E) {
    const int tid = threadIdx.x, wid = __builtin_amdgcn_readfirstlane(tid >> 6), lane = tid & 63, wr = wid >> 2, wc = wid & 3, fr = lane & 15, fq = lane >> 4;
    const int K = g.K, nt = K / BK;
    unsigned voffA[1], voffB[1];
    { int R, C; stage_rc(tid * 16, R, C); const int Rb = Epi::PERM ? ((R & ~31) + perm32(R & 31)) : R;
        voffA[0] = (unsigned)(R * K + C) * 2u; voffB[0] = (unsigned)(Rb * K + C) * 2u; }
    const size_t r64 = (size_t)64 * K * 2;
    const size_t kstep = (size_t)(BK * 2);
    const size_t hstep = (size_t)HALF * K * 2;
    const size_t tstep = 2 * hstep;
    const unsigned ldsw = (unsigned)wid * 1024u;
    const int aoff = lds_byte(wr * 64 + fr, fq * 8), boff = lds_byte(wc * 32 + fr, fq * 8);
#define PG8_SA(b, h) (((b) * 2 + (h)) * HTB)
#define PG8_SB(b, h) ((4 + (b) * 2 + (h)) * HTB)
#define PG8_STAGE(bufoff, gbase, voff) do { _Pragma("unroll") for (int _i = 0; _i < 2; ++_i) \
        __builtin_amdgcn_global_load_lds((const unsigned*)((const char*)(gbase) + _i * r64 + (voff)[0]), (PG8_LAS unsigned*)(lds + (bufoff) + ldsw + _i * 8192), 16, 0, 0); } while (0)
#define PG8_LDA(dst, b, h) do { _Pragma("unroll") for (int m = 0; m < 4; ++m) { if constexpr (I8 == 2) dst##8[m] = cat32(*(const PG8_LAS bf16x8*)(lds + PG8_SA(b, h) + aoff + m * 2048), *(const PG8_LAS bf16x8*)(lds + PG8_SA(b, h) + aoff + m * 2048 + 1024)); \
        else { _Pragma("unroll") for (int k = 0; k < 2; ++k) dst[m][k] = *(const PG8_LAS bf16x8*)(lds + PG8_SA(b, h) + aoff + m * 2048 + k * 1024); } } } while (0)
#define PG8_LDB(dst, b, h) do { _Pragma("unroll") for (int n = 0; n < 2; ++n) { if constexpr (I8 == 2) dst##8[n] = cat32(*(const PG8_LAS bf16x8*)(lds + PG8_SB(b, h) + boff + n * 2048), *(const PG8_LAS bf16x8*)(lds + PG8_SB(b, h) + boff + n * 2048 + 1024)); \
        else { _Pragma("unroll") for (int k = 0; k < 2; ++k) dst[n][k] = *(const PG8_LAS bf16x8*)(lds + PG8_SB(b, h) + boff + n * 2048 + k * 1024); } } } while (0)
#define PG8_MMA(ai, bj, At, Bt) do { __builtin_amdgcn_s_setprio(1); _Pragma("unroll") for (int m = 0; m < 4; ++m) _Pragma("unroll") for (int n = 0; n < 2; ++n) { \
        if constexpr (I8 == 2) acc[ai][bj][m][n] = mma_mx8(Bt##8[n], At##8[m], acc[ai][bj][m][n]); \
        else { _Pragma("unroll") for (int k = 0; k < 2; ++k) acc[ai][bj][m][n] = mma16<I8>(Bt[n][k], At[m][k], acc[ai][bj][m][n]); } } __builtin_amdgcn_s_setprio(0); } while (0)
#define PG8_WAIT_V(n) asm volatile("s_waitcnt vmcnt(" #n ")" ::: "memory")
#define PG8_WAIT_L(n) asm volatile("s_waitcnt lgkmcnt(" #n ")" ::: "memory")
#define PG8_BAR __builtin_amdgcn_s_barrier()
#define PG8_SCHED __builtin_amdgcn_sched_barrier(0)
    Unit cur, nxt; int ui = 0;
    if (!S.next(0, cur)) return;
    f32x4 acc[2][2][4][2];
#pragma unroll
    for (int a = 0; a < 2; ++a)
#pragma unroll
        for (int b = 0; b < 2; ++b)
#pragma unroll
            for (int m = 0; m < 4; ++m)
#pragma unroll
                for (int n = 0; n < 2; ++n) acc[a][b][m][n] = (f32x4){0.f, 0.f, 0.f, 0.f};
    bf16x8 At[4][2], B0[2][2], B1[2][2]; i32x8 At8[4], B08[2], B18[2];
    const char* cA = (const char*)g.A + (size_t)cur.pm * tstep; const char* cB = (const char*)g.Bt + (size_t)cur.pn * tstep;
    S.a_ready(cur);
    if constexpr (SP2) {
        PG8_STAGE(PG8_SB(0, 0), cB, voffB); PG8_STAGE(PG8_SB(0, 1), cB + hstep, voffB); PG8_STAGE(PG8_SA(0, 0), cA, voffA); PG8_STAGE(PG8_SA(0, 1), cA + hstep, voffA);
        if (wr == 1) PG8_BAR;
        PG8_WAIT_V(2); PG8_BAR;
        PG8_STAGE(PG8_SB(1, 0), cB + kstep, voffB); PG8_STAGE(PG8_SA(1, 0), cA + kstep, voffA); PG8_STAGE(PG8_SB(1, 1), cB + hstep + kstep, voffB);
        PG8_WAIT_V(6); PG8_BAR;
    } else {
        PG8_STAGE(PG8_SB(0, 0), cB, voffB); PG8_STAGE(PG8_SA(0, 0), cA, voffA); PG8_STAGE(PG8_SB(0, 1), cB + hstep, voffB); PG8_STAGE(PG8_SA(0, 1), cA + hstep, voffA);
        if (wr == 1) PG8_BAR;
        PG8_WAIT_V(4); PG8_BAR;
        PG8_STAGE(PG8_SB(1, 0), cB + kstep, voffB); PG8_STAGE(PG8_SA(1, 0), cA + kstep, voffA); PG8_STAGE(PG8_SB(1, 1), cB + hstep + kstep, voffB);
        PG8_WAIT_V(6); PG8_BAR;
    }
    for (;;) {
        const bool has_next = S.next(ui + 1, nxt);
        const char* nA = has_next ? (const char*)g.A + (size_t)nxt.pm * tstep : cA; const char* nB = has_next ? (const char*)g.Bt + (size_t)nxt.pn * tstep : cB;
        asm volatile(".p2align 8" ::: "memory");
        for (int t = 0; t < nt; t += 2) {
            const bool last = (t == nt - 2);
            const char* a1 = cA + (size_t)(t + 1) * kstep;
            const char* a2 = last ? nA : cA + (size_t)(t + 2) * kstep; const char* b2 = last ? nB : cB + (size_t)(t + 2) * kstep;
            const char* a3 = a2 + kstep; const char* b3 = b2 + kstep;
            if (last && has_next) S.a_ready(nxt);
            if constexpr (SP2) {
#if PG8_STAGE_IN_MMA
            PG8_LDB(B0, 0, 0); PG8_LDB(B1, 0, 1); PG8_SCHED; PG8_LDA(At, 0, 0);
            PG8_WAIT_V(6); PG8_WAIT_L(0); PG8_BAR; PG8_MMA(0, 0, At, B0); PG8_SCHED; PG8_STAGE(PG8_SA(1, 1), a1 + hstep, voffA); PG8_SCHED; PG8_MMA(0, 1, At, B1); PG8_BAR; PG8_SCHED;
            PG8_LDA(At, 0, 1);
            PG8_WAIT_V(2); PG8_WAIT_L(0); PG8_BAR; PG8_STAGE(PG8_SB(0, 0), b2, voffB); PG8_SCHED; PG8_MMA(1, 0, At, B0); PG8_SCHED; PG8_STAGE(PG8_SB(0, 1), b2 + hstep, voffB); PG8_SCHED; PG8_MMA(1, 1, At, B1); PG8_SCHED; PG8_STAGE(PG8_SA(0, 0), a2, voffA); PG8_BAR; PG8_SCHED;
            PG8_LDB(B0, 1, 0); PG8_LDB(B1, 1, 1); PG8_SCHED; PG8_LDA(At, 1, 0);
            PG8_WAIT_V(6); PG8_WAIT_L(0); PG8_BAR; PG8_MMA(0, 0, At, B0); PG8_SCHED; PG8_STAGE(PG8_SA(0, 1), a2 + hstep, voffA); PG8_SCHED; PG8_MMA(0, 1, At, B1); PG8_BAR; PG8_SCHED;
            PG8_LDA(At, 1, 1);
            PG8_WAIT_V(2); PG8_WAIT_L(0); PG8_BAR; PG8_STAGE(PG8_SB(1, 0), b3, voffB); PG8_SCHED; PG8_MMA(1, 0, At, B0); PG8_SCHED; PG8_STAGE(PG8_SB(1, 1), b3 + hstep, voffB); PG8_SCHED; PG8_MMA(1, 1, At, B1); PG8_SCHED; PG8_STAGE(PG8_SA(1, 0), a3, voffA); PG8_BAR; PG8_SCHED;
#else
            PG8_LDB(B0, 0, 0); PG8_LDB(B1, 0, 1); PG8_SCHED; PG8_LDA(At, 0, 0); PG8_STAGE(PG8_SA(1, 1), a1 + hstep, voffA);
            PG8_WAIT_V(8); PG8_WAIT_L(0); PG8_BAR; PG8_MMA(0, 0, At, B0); PG8_MMA(0, 1, At, B1); PG8_BAR; PG8_SCHED;
            PG8_LDA(At, 0, 1); PG8_STAGE(PG8_SB(0, 0), b2, voffB); PG8_STAGE(PG8_SB(0, 1), b2 + hstep, voffB); PG8_STAGE(PG8_SA(0, 0), a2, voffA);
            PG8_WAIT_V(8); PG8_WAIT_L(0); PG8_BAR; PG8_MMA(1, 0, At, B0); PG8_MMA(1, 1, At, B1); PG8_BAR; PG8_SCHED;
            PG8_LDB(B0, 1, 0); PG8_LDB(B1, 1, 1); PG8_SCHED; PG8_LDA(At, 1, 0); PG8_STAGE(PG8_SA(0, 1), a2 + hstep, voffA);
            PG8_WAIT_V(8); PG8_WAIT_L(0); PG8_BAR; PG8_MMA(0, 0, At, B0); PG8_MMA(0, 1, At, B1); PG8_BAR; PG8_SCHED;
            PG8_LDA(At, 1, 1); PG8_STAGE(PG8_SB(1, 0), b3, voffB); PG8_STAGE(PG8_SB(1, 1), b3 + hstep, voffB); PG8_STAGE(PG8_SA(1, 0), a3, voffA);
            PG8_WAIT_V(8); PG8_WAIT_L(0); PG8_BAR; PG8_MMA(1, 0, At, B0); PG8_MMA(1, 1, At, B1); PG8_BAR; PG8_SCHED;
#endif
            } else {
            PG8_LDB(B0, 0, 0); PG8_SCHED; PG8_LDA(At, 0, 0); PG8_STAGE(PG8_SA(1, 1), a1 + hstep, voffA);
            PG8_WAIT_L(8); PG8_BAR; PG8_WAIT_L(0); PG8_MMA(0, 0, At, B0); PG8_BAR; PG8_SCHED;
            PG8_LDB(B1, 0, 1); PG8_STAGE(PG8_SB(0, 0), b2, voffB);
            PG8_BAR; PG8_WAIT_L(0); PG8_MMA(0, 1, At, B1); PG8_BAR;
            PG8_LDA(At, 0, 1); PG8_STAGE(PG8_SA(0, 0), a2, voffA);
            PG8_BAR; PG8_WAIT_L(0); PG8_MMA(1, 0, At, B0); PG8_BAR; PG8_SCHED;
            PG8_STAGE(PG8_SB(0, 1), b2 + hstep, voffB);
            PG8_WAIT_V(6); PG8_BAR; PG8_MMA(1, 1, At, B1); PG8_BAR;
            PG8_LDB(B0, 1, 0); PG8_SCHED; PG8_LDA(At, 1, 0); PG8_STAGE(PG8_SA(0, 1), a2 + hstep, voffA);
            PG8_WAIT_L(8); PG8_BAR; PG8_WAIT_L(0); PG8_MMA(0, 0, At, B0); PG8_BAR; PG8_SCHED;
            PG8_LDB(B1, 1, 1); PG8_STAGE(PG8_SB(1, 0), b3, voffB);
            PG8_BAR; PG8_WAIT_L(0); PG8_MMA(0, 1, At, B1); PG8_BAR;
            PG8_LDA(At, 1, 1); PG8_STAGE(PG8_SA(1, 0), a3, voffA);
            PG8_BAR; PG8_WAIT_L(0); PG8_MMA(1, 0, At, B0); PG8_BAR; PG8_SCHED;
            PG8_STAGE(PG8_SB(1, 1), b3 + hstep, voffB);
            PG8_WAIT_V(6); PG8_BAR; PG8_MMA(1, 1, At, B1); PG8_BAR;
            }
        }
        if constexpr (ALIGN_EPI) { if (wr == 0) PG8_BAR; }
        if constexpr (!Epi::AFTER_DRAIN) { int ln; asm volatile("v_mbcnt_lo_u32_b32 %0, -1, 0\n\tv_mbcnt_hi_u32_b32 %0, -1, %0" : "=v"(ln));     const int fr2 = ln & 15, fq2 = ln >> 4; _Pragma("unroll") for (int er = 0; er < Epi::REPS; ++er) { E(acc, cur, wr, wc, fr2, fq2); if (er + 1 < Epi::REPS) asm volatile("" ::: "memory"); } S.done(cur); }
        if (!has_next) break;
#pragma unroll
        for (int a = 0; a < 2; ++a)
#pragma unroll
            for (int b = 0; b < 2; ++b)
#pragma unroll
                for (int m = 0; m < 4; ++m)
#pragma unroll
                    for (int n = 0; n < 2; ++n) acc[a][b][m][n] = (f32x4){0.f, 0.f, 0.f, 0.f};
        cur = nxt; cA = nA; cB = nB; ++ui;
        if constexpr (ALIGN_EPI) { if (wr == 1) PG8_BAR; }
    }
    PG8_WAIT_V(0);
    if constexpr (!ALIGN_EPI) { if (wr == 0) PG8_BAR; }
    PG8_BAR;
    if constexpr (Epi::AFTER_DRAIN) { E.fused(acc, cur, wr, wc, fr, fq, lds, wid, lane); S.done(cur); }
#undef PG8_SA
#undef PG8_SB
#undef PG8_STAGE
#undef PG8_LDA
#undef PG8_LDB
#undef PG8_MMA
#undef PG8_WAIT_V
#undef PG8_WAIT_L
#undef PG8_BAR
#undef PG8_SCHED
}
}
#define GAS __attribute__((address_space(1)))
#define LAS __attribute__((address_space(3)))
typedef unsigned short bf16;
typedef unsigned v4u __attribute__((ext_vector_type(4)));
typedef float f32x4 __attribute__((ext_vector_type(4)));
typedef short bf16x8 __attribute__((ext_vector_type(8)));
typedef GAS unsigned gu32;
typedef GAS unsigned long long gu64;
#define RLX_AGENT __ATOMIC_RELAXED, __HIP_MEMORY_SCOPE_AGENT
#define LDS_WAIT() asm volatile("s_waitcnt lgkmcnt(0)" ::: "memory")
#define VM_WAIT() asm volatile("s_waitcnt vmcnt(0)" ::: "memory")
__device__ __forceinline__ unsigned long long rt() { return __builtin_amdgcn_s_memrealtime(); }
__device__ __forceinline__ unsigned f2bf(float f) { unsigned u = __builtin_bit_cast(unsigned, f); return (u + 0x7fffu + ((u >> 16) & 1u)) >> 16; }
__device__ __forceinline__ unsigned pk2(float lo, float hi) { return f2bf(lo) | (f2bf(hi) << 16); }

#define XB_TMO      128
#define XB_XCNT(j)  (256  + 64 * (j))
#define XB_XSUB(j)  (1280 + 64 * (j))
#define XB_XGEN(j)  (2304 + 64 * (j))
#define XB_TOP      3328
#define XB_TOPGEN   3392
#define XCD_BAR_WORDS 3456
#define XB_SPIN_CAP (1u << 18)

__device__ __forceinline__ unsigned xb_ld(unsigned* p)              { return __hip_atomic_load(p, __ATOMIC_RELAXED, __HIP_MEMORY_SCOPE_AGENT); }
__device__ __forceinline__ unsigned xb_add(unsigned* p, unsigned v) { return __hip_atomic_fetch_add(p, v, __ATOMIC_RELAXED, __HIP_MEMORY_SCOPE_AGENT); }
__device__ __forceinline__ unsigned xb_xcc_id() { return (unsigned)__builtin_amdgcn_s_getreg((3 << 11) | 20) & 0xFu; }
#define XB_SPIN(cond, bar) do { unsigned _sp = 0; while (cond) { __builtin_amdgcn_s_sleep(1); \
    if ((++_sp & 255u) == 0u) { if (xb_ld(&(bar)[XB_TMO])) break; if (_sp > XB_SPIN_CAP) { atomicAdd(&(bar)[XB_TMO], 1u); break; } } } } while (0)

struct XcdBarrier {
    unsigned* bar; unsigned x;
    volatile LAS unsigned* st;
};

__device__ __forceinline__ XcdBarrier xcd_barrier_post(unsigned* bar, volatile LAS unsigned* st) {
    XcdBarrier b; b.bar = bar; b.x = xb_xcc_id(); b.st = st;
    if (threadIdx.x == 0) (void)xb_add(&bar[XB_XCNT(b.x)], 1u);
    return b;
}
__device__ __forceinline__ void xcd_barrier_complete(unsigned* bar, unsigned x, unsigned& nloc, unsigned& nx) {
    const unsigned G = gridDim.x * gridDim.y * gridDim.z;
    unsigned sum, cnt, mine, sp = 0u;
    for (;;) {
        sum = 0u; cnt = 0u; mine = 0u;
#pragma unroll
        for (unsigned j = 0; j < 16; ++j) { const unsigned c = xb_ld(&bar[XB_XCNT(j)]); sum += c; cnt += (c > 0u) ? 1u : 0u; mine = (j == x) ? c : mine; }
        if (sum == G) break;
        __builtin_amdgcn_s_sleep(1);
        if ((++sp & 255u) == 0u) { if (xb_ld(&bar[XB_TMO])) break; if (sp > XB_SPIN_CAP) { atomicAdd(&bar[XB_TMO], 1u); break; } }
    }
    nloc = mine > 0u ? mine : 1u; nx = cnt > 0u ? cnt : 1u;
}

__device__ __forceinline__ void xcd_barrier(const XcdBarrier& b) {
    asm volatile("s_waitcnt vmcnt(0)" ::: "memory");
    __syncthreads();
    if (threadIdx.x == 0) {
        unsigned* bar = b.bar;
        __builtin_amdgcn_s_waitcnt(0);
        unsigned nloc = b.st[0], nx = b.st[1];
        if (nloc == 0u) { xcd_barrier_complete(bar, b.x, nloc, nx); b.st[0] = nloc; b.st[1] = nx; }
        const unsigned old = xb_add(&bar[XB_XSUB(b.x)], 1u);
        const unsigned gen = old / nloc;
        if (old + 1u == (gen + 1u) * nloc) {
            __builtin_amdgcn_fence(__ATOMIC_RELEASE, "agent");
            asm volatile("s_waitcnt vmcnt(0)" ::: "memory");
            const unsigned og = xb_add(&bar[XB_TOP], 1u);
            const unsigned tg = og / nx;
            if (og + 1u == (tg + 1u) * nx) xb_add(&bar[XB_TOPGEN], 1u);
            else XB_SPIN(xb_ld(&bar[XB_TOPGEN]) == tg, bar);
            __builtin_amdgcn_fence(__ATOMIC_ACQUIRE, "agent");
            xb_add(&bar[XB_XGEN(b.x)], 1u);
            asm volatile("s_waitcnt vmcnt(0)" ::: "memory");
        } else {
            XB_SPIN(xb_ld(&bar[XB_XGEN(b.x)]) == gen, bar);
            __builtin_amdgcn_fence(__ATOMIC_ACQUIRE, "agent");
            asm volatile("s_waitcnt vmcnt(0)" ::: "memory");
        }
    }
    __syncthreads();
}

constexpr int NWAVES = 8;
constexpr int NB = 8, SEQ = 4096, D = 1024, M = NB * SEQ, FF = 2816, FF2 = 2 * FF, DC = 512, DR = 512, NH = 8, HD = 64, CW = 31, RW = 4, NMIX = 2048;
constexpr float EPS = 1e-6f;
constexpr int LDM = 11 * D;
constexpr size_t MiB = 1u << 20;
constexpr size_t WS_CTL = 0, CTL_ZERO_BYTES = 1 * MiB;
constexpr size_t WS_MOD = 1 * MiB;
constexpr size_t WS_BIAS1 = 1 * MiB + 512 * 1024;
constexpr size_t WS_BIAS2 = 2 * MiB;
constexpr size_t WS_WGT = 2 * MiB + 128 * 1024;
constexpr size_t WS_CS1 = 2 * MiB + 384 * 1024, WS_CS3 = 2 * MiB + 448 * 1024;
constexpr size_t WS_RS1 = 2 * MiB + 512 * 1024, WS_RS3 = 2 * MiB + 640 * 1024;
constexpr size_t WS_CS2 = 2 * MiB + 480 * 1024, WS_RS2 = 2 * MiB + 768 * 1024;
constexpr size_t WS_TOT = 3 * MiB;
constexpr size_t WS_SSP = 5 * MiB;
constexpr size_t WS_W1I = 8 * MiB, WS_W1O = 19 * MiB, WS_WIN = 25 * MiB, WS_WOUT = 29 * MiB, WS_W2I = 31 * MiB, WS_W2O = 42 * MiB;
constexpr size_t WS_Y = 48 * MiB;
constexpr size_t WS_X1 = 112 * MiB;
constexpr size_t WS_ACT = 240 * MiB;
constexpr size_t WS_U = WS_ACT, WS_UX = WS_ACT + 32 * MiB, WS_GY = WS_ACT + 64 * MiB, WS_YMIX = WS_ACT + 96 * MiB;
constexpr size_t WS_SSPF = 416 * MiB;
constexpr size_t WS_SSPX = 418 * MiB;
constexpr size_t WS_SSPX3 = 422 * MiB;
constexpr size_t WS_END = 426 * MiB;
constexpr int CW_BAR = 4096, CW_SEAM = 16384, CW_SCAN = 32768, CW_SEAM7 = 49152, CW_SEAM3 = 65536, CW_TICKET = 98304;
constexpr int LDS_BYTES = 147456;
constexpr int LDSCTL_OFF = LDS_BYTES - 256;

typedef unsigned short u16;
typedef float f32x16 __attribute__((ext_vector_type(16)));
typedef float f32x2 __attribute__((ext_vector_type(2)));

template <int OFF> __device__ __forceinline__ float sx(float v) {
    const int i = (int)__float_as_uint(v); int r;
    if constexpr (OFF == 1) r = __builtin_amdgcn_update_dpp(0, i, 0xB1, 0xf, 0xf, true);
    else if constexpr (OFF == 2) r = __builtin_amdgcn_update_dpp(0, i, 0x4E, 0xf, 0xf, true);
    else if constexpr (OFF == 4) r = __builtin_amdgcn_ds_swizzle(i, 0x101F);
    else if constexpr (OFF == 8) r = __builtin_amdgcn_update_dpp(0, i, 0x128, 0xf, 0xf, true);
    else if constexpr (OFF == 16) r = __builtin_amdgcn_ds_swizzle(i, 0x401F);
    else { const auto p = __builtin_amdgcn_permlane32_swap(i, i, false, false); r = (threadIdx.x & 32) ? p[0] : p[1]; }
    return __uint_as_float((unsigned)r);
}
__device__ __forceinline__ float wave_sum(float v) { v += sx<1>(v); v += sx<2>(v); v += sx<4>(v); v += sx<8>(v); v += sx<16>(v); v += sx<32>(v); return v; }
__device__ __forceinline__ float sigmoid_fast(float x) { return __builtin_amdgcn_rcpf(1.f + __builtin_amdgcn_exp2f(-1.4426950408889634f * x)); }
__device__ __forceinline__ float silu_fast(float x) { return x * sigmoid_fast(x); }
__device__ __forceinline__ float gelu_tanh_fast(float x) { const float z = 0.7978845608028654f * (x + 0.044715f * x * x * x); return x * sigmoid_fast(2.f * z); }
__device__ __forceinline__ f32x4 sigmoid4(const f32x4 x) { const f32x4 t = x * -1.4426950408889634f; f32x4 e = {__builtin_amdgcn_exp2f(t[0]), __builtin_amdgcn_exp2f(t[1]), __builtin_amdgcn_exp2f(t[2]), __builtin_amdgcn_exp2f(t[3])};
    e = e + 1.0f; return (f32x4){__builtin_amdgcn_rcpf(e[0]), __builtin_amdgcn_rcpf(e[1]), __builtin_amdgcn_rcpf(e[2]), __builtin_amdgcn_rcpf(e[3])}; }
__device__ __forceinline__ f32x4 gelu_tanh4(const f32x4 x) { const f32x4 z2 = (x + (x * x) * x * 0.044715f) * (2.0f * 0.7978845608028654f); return x * sigmoid4(z2); }
__device__ __forceinline__ float bflo(unsigned w) { return __uint_as_float(w << 16); }
__device__ __forceinline__ float bfhi(unsigned w) { return __uint_as_float(w & 0xffff0000u); }
__device__ __forceinline__ unsigned cvtpk(float lo, float hi) { return pg8::cvt_pk_bf16(lo, hi); }
__device__ __forceinline__ v4u pack8(const f32x4 a, const f32x4 b) { v4u w; w.x = cvtpk(a[0], a[1]); w.y = cvtpk(a[2], a[3]); w.z = cvtpk(b[0], b[1]); w.w = cvtpk(b[2], b[3]); return w; }

__device__ __forceinline__ void unpack8(const v4u w, f32x4& a, f32x4& b) { a = (f32x4){bflo(w.x), bfhi(w.x), bflo(w.y), bfhi(w.y)}; b = (f32x4){bflo(w.z), bfhi(w.z), bflo(w.w), bfhi(w.w)}; }
__device__ __forceinline__ unsigned q8(float v) { int q = (int)__builtin_rintf(v); q = q < -127 ? -127 : (q > 127 ? 127 : q); return (unsigned)q & 0xffu; }
__device__ __forceinline__ unsigned q8x4(const f32x4 v) { return q8(v[0]) | (q8(v[1]) << 8) | (q8(v[2]) << 16) | (q8(v[3]) << 24); }
__device__ __forceinline__ float wave_max(float v) { v = fmaxf(v, sx<1>(v)); v = fmaxf(v, sx<2>(v)); v = fmaxf(v, sx<4>(v)); v = fmaxf(v, sx<8>(v)); v = fmaxf(v, sx<16>(v)); v = fmaxf(v, sx<32>(v)); return v; }
typedef int i32x4v __attribute__((ext_vector_type(4)));
__device__ __forceinline__ f32x4 acc_i2f(const f32x4 a) { return __builtin_convertvector(__builtin_bit_cast(i32x4v, a), f32x4); }
__device__ __forceinline__ float clamp448(float v) { return __builtin_fminf(__builtin_fmaxf(v, -448.0f), 448.0f); }
__device__ __forceinline__ unsigned f8x4(const f32x4 v) { int w = __builtin_amdgcn_cvt_pk_fp8_f32(clamp448(v[0]), clamp448(v[1]), 0, false); w = __builtin_amdgcn_cvt_pk_fp8_f32(clamp448(v[2]), clamp448(v[3]), w, true); return (unsigned)w; }
constexpr float F8_ACT_SCALE = 8.0f, F8_W_SCALE = 2048.0f;
__device__ __forceinline__ void load_rstd(const float* ssp, int row0, int fq, float (&rs)[2][4]) {
#pragma unroll
    for (int ai = 0; ai < 2; ++ai)
#pragma unroll
        for (int m = 0; m < 4; ++m) { const f32x4 p = *(const f32x4*)(ssp + (size_t)(row0 + ai * 128 + m * 16) * 16 + 4 * fq);
            float s = (p[0] + p[1]) + (p[2] + p[3]); s += __shfl_xor(s, 16); s += __shfl_xor(s, 32); rs[ai][m] = rsqrtf(s * (1.0f / D) + EPS); }
}
__device__ __forceinline__ void load_rstd_sc1(const float* ssp, int row0, int fq, float (&rs)[2][4]) {
#pragma unroll
    for (int ai = 0; ai < 2; ++ai)
#pragma unroll
        for (int m = 0; m < 4; ++m) { const gu32* p = (const gu32*)(ssp + (size_t)(row0 + ai * 128 + m * 16) * 16 + 4 * fq);
            const float p0 = __uint_as_float(__hip_atomic_load(p, RLX_AGENT)), p1 = __uint_as_float(__hip_atomic_load(p + 1, RLX_AGENT)), p2 = __uint_as_float(__hip_atomic_load(p + 2, RLX_AGENT)), p3 = __uint_as_float(__hip_atomic_load(p + 3, RLX_AGENT));
            float s = (p0 + p1) + (p2 + p3); s += __shfl_xor(s, 16); s += __shfl_xor(s, 32); rs[ai][m] = rsqrtf(s * (1.0f / D) + EPS); }
}
#ifndef MK_EPI_SWIGLU_REPS
#define MK_EPI_SWIGLU_REPS 1
#endif
#ifndef MK_EPI_RESID_REPS
#define MK_EPI_RESID_REPS 1
#endif
struct EpiSwiglu {
    static constexpr bool PERM = true, AFTER_DRAIN = false; static constexpr int REPS = MK_EPI_SWIGLU_REPS;
    pg8::bf16_t* act; const float* ssp; const float* bias;
    __device__ __forceinline__ void operator()(const f32x4 (&acc)[2][2][4][2], const pg8::Unit& u, int wr, int wc, int fr, int fq) const {
        const int row0 = u.pm * 256 + wr * 64 + fr, b = u.pm >> 4;
        float rs[2][4]; load_rstd(ssp, row0, fq, rs);
        const float* bp = bias + (size_t)b * FF2 + u.pn * 256 + wc * 32 + 8 * fq;
        const f32x4 bg0 = *(const f32x4*)(bp), bg1 = *(const f32x4*)(bp + 4), bu0 = *(const f32x4*)(bp + 128), bu1 = *(const f32x4*)(bp + 132);
        const int oc = u.pn * 128 + wc * 32 + 8 * fq;
#pragma unroll
        for (int ai = 0; ai < 2; ++ai)
#pragma unroll
            for (int m = 0; m < 4; ++m) { const float r = rs[ai][m];
                const f32x4 g0 = acc[ai][0][m][0] * r + bg0, g1 = acc[ai][0][m][1] * r + bg1, u0 = acc[ai][1][m][0] * r + bu0, u1 = acc[ai][1][m][1] * r + bu1;
                const f32x4 a0 = (g0 * sigmoid4(g0)) * u0, a1 = (g1 * sigmoid4(g1)) * u1;
                *(v4u*)(act + (size_t)(row0 + ai * 128 + m * 16) * FF + oc) = pack8(a0, a1); }
    }
};
template <bool OUT8> struct EpiSwiglu8 {
    static constexpr bool PERM = true, AFTER_DRAIN = false; static constexpr int REPS = 1;
    pg8::bf16_t* act; const float* rs; const float* cs;
    __device__ __forceinline__ void operator()(const f32x4 (&acc)[2][2][4][2], const pg8::Unit& u, int wr, int wc, int fr, int fq) const {
        const int row0 = u.pm * 256 + wr * 64 + fr;
        float rv[2][4];
#pragma unroll
        for (int ai = 0; ai < 2; ++ai)
#pragma unroll
            for (int m = 0; m < 4; ++m) rv[ai][m] = rs[row0 + ai * 128 + m * 16];
        const int cb = u.pn * 256 + wc * 32 + 8 * fq;
        const float* cp = cs + cb;
        const f32x4 cg0 = *(const f32x4*)(cp), cg1 = *(const f32x4*)(cp + 4), cu0 = *(const f32x4*)(cp + 128), cu1 = *(const f32x4*)(cp + 132);
        const int oc = u.pn * 128 + wc * 32 + 8 * fq;
#pragma unroll
        for (int ai = 0; ai < 2; ++ai)
#pragma unroll
            for (int m = 0; m < 4; ++m) { const float r = rv[ai][m];
                const f32x4 g0 = acc_i2f(acc[ai][0][m][0]) * (cg0 * r), g1 = acc_i2f(acc[ai][0][m][1]) * (cg1 * r);
                const f32x4 u0 = acc_i2f(acc[ai][1][m][0]) * (cu0 * r), u1 = acc_i2f(acc[ai][1][m][1]) * (cu1 * r);
                const f32x4 a0 = (g0 * sigmoid4(g0)) * u0, a1 = (g1 * sigmoid4(g1)) * u1;
                if (OUT8) *(unsigned long long*)((unsigned char*)act + (size_t)(row0 + ai * 128 + m * 16) * FF + oc) = (unsigned long long)f8x4(a0 * F8_ACT_SCALE) | ((unsigned long long)f8x4(a1 * F8_ACT_SCALE) << 32);
                else *(v4u*)(act + (size_t)(row0 + ai * 128 + m * 16) * FF + oc) = pack8(a0, a1); }
    }
};
template <int WHALF, bool HASY, bool IN16, bool F8 = false> struct EpiResid {
    static constexpr bool PERM = true, AFTER_DRAIN = false; static constexpr int REPS = (IN16 ? 1 : MK_EPI_RESID_REPS);
    static constexpr float w = (WHALF ? 0.5f : 1.0f) * (F8 ? 1.0f / (F8_ACT_SCALE * F8_W_SCALE) : 1.0f);
    const void* xin; pg8::bf16_t* xout; pg8::bf16_t* y; float* ssp; const float* gt; const float* gnext; const float* scnext;
    __device__ __forceinline__ void operator()(const f32x4 (&acc)[2][2][4][2], const pg8::Unit& u, int wr, int wc, int fr, int fq) const {
        const int row0 = u.pm * 256 + wr * 64 + fr, b = u.pm >> 4;
        float ss[2][4];
#pragma unroll
        for (int ai = 0; ai < 2; ++ai)
#pragma unroll
            for (int m = 0; m < 4; ++m) ss[ai][m] = 0.f;
#pragma unroll
        for (int bj = 0; bj < 2; ++bj) { const int c0 = u.pn * 256 + bj * 128 + wc * 32 + 8 * fq;
            const f32x4 gt0 = *(const f32x4*)(gt + (size_t)b * LDM + c0) * w, gt1 = *(const f32x4*)(gt + (size_t)b * LDM + c0 + 4) * w;
            f32x4 gs0 = {0.f, 0.f, 0.f, 0.f}, gs1 = gs0;
            if (HASY) { gs0 = *(const f32x4*)(gnext + c0) * (*(const f32x4*)(scnext + (size_t)b * LDM + c0) + 1.0f); gs1 = *(const f32x4*)(gnext + c0 + 4) * (*(const f32x4*)(scnext + (size_t)b * LDM + c0 + 4) + 1.0f); }
#pragma unroll
            for (int ai = 0; ai < 2; ++ai)
#pragma unroll
                for (int m = 0; m < 4; ++m) { const size_t off = (size_t)(row0 + ai * 128 + m * 16) * D + c0;
                    f32x4 x0, x1;
                    if (IN16) unpack8(*(const v4u*)((const pg8::bf16_t*)xin + off), x0, x1); else { x0 = *(const f32x4*)((const float*)xin + off); x1 = *(const f32x4*)((const float*)xin + off + 4); }
                    const f32x4 o0 = x0 + gt0 * acc[ai][bj][m][0], o1 = x1 + gt1 * acc[ai][bj][m][1];
                    *(v4u*)(xout + off) = pack8(o0, o1);
                    ss[ai][m] += (o0[0] * o0[0] + o0[1] * o0[1]) + (o0[2] * o0[2] + o0[3] * o0[3]) + (o1[0] * o1[0] + o1[1] * o1[1]) + (o1[2] * o1[2] + o1[3] * o1[3]);
                    if (HASY) *(v4u*)(y + off) = pack8(o0 * gs0, o1 * gs1); } }
#pragma unroll
        for (int ai = 0; ai < 2; ++ai)
#pragma unroll
            for (int m = 0; m < 4; ++m) { float s = ss[ai][m]; s += __shfl_xor(s, 16); s += __shfl_xor(s, 32);
                if (fq == 0) ssp[(size_t)(row0 + ai * 128 + m * 16) * 16 + u.pn * 4 + wc] = s; }
    }
};
template <int WHALF, bool IN16> struct EpiResidQ {
    static constexpr bool PERM = true, AFTER_DRAIN = false; static constexpr int REPS = 1;
    static constexpr float w = WHALF ? 0.5f : 1.0f;
    const void* xin; pg8::bf16_t* xout; unsigned char* a8; float* rs; f32x2* sspx; const float* gt; const float* gnext; const float* scnext; const float* shnext; const float* shmax; unsigned* cnt;
    __device__ __forceinline__ void operator()(f32x4 (&acc)[2][2][4][2], const pg8::Unit& u, int wr, int wc, int fr, int fq) const {
        const int row0 = u.pm * 256 + wr * 64 + fr, b = u.pm >> 4;
        float ss[2][4], am[2][4];
#pragma unroll
        for (int ai = 0; ai < 2; ++ai)
#pragma unroll
            for (int m = 0; m < 4; ++m) { ss[ai][m] = 0.f; am[ai][m] = 0.f; }
        const unsigned voff = (unsigned)((row0 * D + u.pn * 256 + wc * 32 + 8 * fq) * 2);
        unsigned vo[4] = {voff, voff, voff, voff};
#pragma unroll
        for (int bj = 0; bj < 2; ++bj) { const int c0 = u.pn * 256 + bj * 128 + wc * 32 + 8 * fq;
            const f32x4 gt0 = *(const f32x4*)(gt + (size_t)b * LDM + c0) * w, gt1 = *(const f32x4*)(gt + (size_t)b * LDM + c0 + 4) * w;
            const f32x4 gs0 = *(const f32x4*)(gnext + c0) * (*(const f32x4*)(scnext + (size_t)b * LDM + c0) + 1.0f), gs1 = *(const f32x4*)(gnext + c0 + 4) * (*(const f32x4*)(scnext + (size_t)b * LDM + c0 + 4) + 1.0f);
#pragma unroll
            for (int ai = 0; ai < 2; ++ai)
#pragma unroll
                for (int m = 0; m < 4; ++m) { const unsigned so = (unsigned)(((ai * 128 + m * 16) * D + bj * 128) * 2); const int g = m & 3;
                    f32x4 x0, x1;
                    if (IN16) unpack8(*(const v4u*)((const char*)xin + (size_t)(vo[g] + so)), x0, x1);
                    else { const char* p = (const char*)xin + 2 * (size_t)(vo[g] + so); x0 = *(const f32x4*)p; x1 = *(const f32x4*)(p + 16); }
                    const f32x4 o0 = x0 + gt0 * acc[ai][bj][m][0], o1 = x1 + gt1 * acc[ai][bj][m][1];
                    *(v4u*)((char*)xout + (size_t)(vo[g] + so)) = pack8(o0, o1);
                    acc[ai][bj][m][0] = o0; acc[ai][bj][m][1] = o1;
                    ss[ai][m] += (o0[0] * o0[0] + o0[1] * o0[1]) + (o0[2] * o0[2] + o0[3] * o0[3]) + (o1[0] * o1[0] + o1[1] * o1[1]) + (o1[2] * o1[2] + o1[3] * o1[3]);
                    const f32x4 t0 = __builtin_elementwise_abs(o0 * gs0), t1 = __builtin_elementwise_abs(o1 * gs1);
                    am[ai][m] = fmaxf(am[ai][m], fmaxf(fmaxf(fmaxf(t0[0], t0[1]), fmaxf(t0[2], t0[3])), fmaxf(fmaxf(t1[0], t1[1]), fmaxf(t1[2], t1[3]))));
                    asm volatile("" : "+v"(vo[g]) : "v"(ss[ai][m])); } }
#pragma unroll
        for (int ai = 0; ai < 2; ++ai)
#pragma unroll
            for (int m = 0; m < 4; ++m) { float s = ss[ai][m], a = am[ai][m]; s += __shfl_xor(s, 16); s += __shfl_xor(s, 32); a = fmaxf(a, __shfl_xor(a, 16)); a = fmaxf(a, __shfl_xor(a, 32));
                if (fq == 0) __hip_atomic_store((gu64*)(sspx + (size_t)(row0 + ai * 128 + m * 16) * 16 + u.pn * 4 + wc), ((unsigned long long)__float_as_uint(a) << 32) | __float_as_uint(s), RLX_AGENT); }
        asm volatile("s_waitcnt vmcnt(0)" ::: "memory");
        unsigned* cw = cnt + 64 * u.pm;
        if ((threadIdx.x & 63) == 0) __hip_atomic_fetch_add(cw, 1u, __ATOMIC_RELAXED, __HIP_MEMORY_SCOPE_AGENT);
        if (threadIdx.x < 64) {
            unsigned sp = 0;
            while ((unsigned)__builtin_amdgcn_readfirstlane(__hip_atomic_load(cw, __ATOMIC_RELAXED, __HIP_MEMORY_SCOPE_AGENT)) < 32u) { __builtin_amdgcn_s_sleep(1); if (++sp > (1u << 20)) break; }
            __builtin_amdgcn_fence(__ATOMIC_ACQUIRE, "agent");
            asm volatile("s_waitcnt vmcnt(0)" ::: "memory");
        }
        asm volatile("" ::: "memory"); __builtin_amdgcn_s_barrier(); asm volatile("" ::: "memory");
        float qs[2][4], qr[2][4];
        const float shm = shmax[b];
#pragma unroll
        for (int ai = 0; ai < 2; ++ai)
#pragma unroll
            for (int m = 0; m < 4; ++m) { const int row = row0 + ai * 128 + m * 16; const gu64* p = (const gu64*)(sspx + (size_t)row * 16 + 4 * fq);
                float s = 0.f, a = 0.f;
#pragma unroll
                for (int e = 0; e < 4; ++e) { const unsigned long long t = __hip_atomic_load(p + e, RLX_AGENT); s += __uint_as_float((unsigned)t); a = fmaxf(a, __uint_as_float((unsigned)(t >> 32))); }
                s += __shfl_xor(s, 16); s += __shfl_xor(s, 32); a = fmaxf(a, __shfl_xor(a, 16)); a = fmaxf(a, __shfl_xor(a, 32));
                const float rstd = rsqrtf(s * (1.0f / D) + EPS), S = rstd * a + shm;
                qs[ai][m] = S > 0.f ? 127.0f / S : 0.f; qr[ai][m] = rstd * qs[ai][m];
                if (u.pn == 0 && wc == 0 && fq == 0) rs[row] = S * (1.0f / 127.0f); }
        const unsigned voff8 = (unsigned)(row0 * D + u.pn * 256 + wc * 32 + 8 * fq);
#pragma unroll
        for (int bj = 0; bj < 2; ++bj) { const int c0 = u.pn * 256 + bj * 128 + wc * 32 + 8 * fq;
            const f32x4 gs0 = *(const f32x4*)(gnext + c0) * (*(const f32x4*)(scnext + (size_t)b * LDM + c0) + 1.0f), gs1 = *(const f32x4*)(gnext + c0 + 4) * (*(const f32x4*)(scnext + (size_t)b * LDM + c0 + 4) + 1.0f);
            const f32x4 sh0 = *(const f32x4*)(shnext + (size_t)b * LDM + c0), sh1 = *(const f32x4*)(shnext + (size_t)b * LDM + c0 + 4);
#pragma unroll
            for (int ai = 0; ai < 2; ++ai)
#pragma unroll
                for (int m = 0; m < 4; ++m) { const float q = qs[ai][m], r = qr[ai][m]; const unsigned so = (unsigned)((ai * 128 + m * 16) * D + bj * 128);
                    *(unsigned long long*)(a8 + (size_t)(voff8 + so)) = (unsigned long long)q8x4(acc[ai][bj][m][0] * (gs0 * r) + sh0 * q) | ((unsigned long long)q8x4(acc[ai][bj][m][1] * (gs1 * r) + sh1 * q) << 32); } }
    }
};
template <bool F8> struct EpiResidFinal {
    static constexpr bool PERM = true, AFTER_DRAIN = false; static constexpr int REPS = 1;
    static constexpr float ascale = F8 ? 1.0f / (F8_ACT_SCALE * F8_W_SCALE) : 1.0f;
    const pg8::bf16_t* xin; float* out; float* ssp; const float* gt; const float* gf; const float* fsc; const float* fsh; unsigned* cnt;
    __device__ __forceinline__ void operator()(f32x4 (&acc)[2][2][4][2], const pg8::Unit& u, int wr, int wc, int fr, int fq) const {
        const int row0 = u.pm * 256 + wr * 64 + fr, b = u.pm >> 4;
        const __amdgpu_buffer_rsrc_t rx = __builtin_amdgcn_make_buffer_rsrc((void*)xin, 0, M * D * 4, 0x00020000), ro = __builtin_amdgcn_make_buffer_rsrc((void*)out, 0, M * D * 4, 0x00020000);
        const unsigned voff = (unsigned)((row0 * D + u.pn * 256 + wc * 32 + 8 * fq) * 4);
        float ss[2][4];
#pragma unroll
        for (int ai = 0; ai < 2; ++ai)
#pragma unroll
            for (int m = 0; m < 4; ++m) ss[ai][m] = 0.f;
        unsigned vo[4] = {voff, voff, voff, voff};
#pragma unroll
        for (int bj = 0; bj < 2; ++bj) { const int c0 = u.pn * 256 + bj * 128 + wc * 32 + 8 * fq;
            const float hw = 0.5f * ascale; const f32x4 gt0 = *(const f32x4*)(gt + (size_t)b * LDM + c0) * hw, gt1 = *(const f32x4*)(gt + (size_t)b * LDM + c0 + 4) * hw;
#pragma unroll
            for (int ai = 0; ai < 2; ++ai)
#pragma unroll
                for (int m = 0; m < 4; ++m) { const unsigned so = (unsigned)(((ai * 128 + m * 16) * D + bj * 128) * 4); const int g = m & 3;
                    f32x4 x0, x1; unpack8(*(const v4u*)((const char*)xin + (size_t)((vo[g] + so) >> 1)), x0, x1);
                    const f32x4 o0 = x0 + gt0 * acc[ai][bj][m][0], o1 = x1 + gt1 * acc[ai][bj][m][1];
                    acc[ai][bj][m][0] = o0; acc[ai][bj][m][1] = o1;
                    ss[ai][m] += (o0[0] * o0[0] + o0[1] * o0[1]) + (o0[2] * o0[2] + o0[3] * o0[3]) + (o1[0] * o1[0] + o1[1] * o1[1]) + (o1[2] * o1[2] + o1[3] * o1[3]);
                    asm volatile("" : "+v"(vo[g]) : "v"(ss[ai][m])); } }
#pragma unroll
        for (int ai = 0; ai < 2; ++ai)
#pragma unroll
            for (int m = 0; m < 4; ++m) { float s = ss[ai][m]; s += __shfl_xor(s, 16); s += __shfl_xor(s, 32);
                if (fq == 0) __hip_atomic_store((gu32*)(ssp + (size_t)(row0 + ai * 128 + m * 16) * 16 + u.pn * 4 + wc), __float_as_uint(s), RLX_AGENT); }
        asm volatile("s_waitcnt vmcnt(0)" ::: "memory");
        unsigned* cw = cnt + 64 * u.pm;
        if ((threadIdx.x & 63) == 0) __hip_atomic_fetch_add(cw, 1u, __ATOMIC_RELAXED, __HIP_MEMORY_SCOPE_AGENT);
        if (threadIdx.x < 64) {
            unsigned sp = 0;
            while ((unsigned)__builtin_amdgcn_readfirstlane(__hip_atomic_load(cw, __ATOMIC_RELAXED, __HIP_MEMORY_SCOPE_AGENT)) < 32u) { __builtin_amdgcn_s_sleep(1); if (++sp > (1u << 20)) break; }
            __builtin_amdgcn_fence(__ATOMIC_ACQUIRE, "agent");
            asm volatile("s_waitcnt vmcnt(0)" ::: "memory");
        }
        asm volatile("" ::: "memory"); __builtin_amdgcn_s_barrier(); asm volatile("" ::: "memory");
        float rs[2][4]; load_rstd_sc1(ssp, row0, fq, rs);
#pragma unroll
        for (int bj = 0; bj < 2; ++bj) { const int c0 = u.pn * 256 + bj * 128 + wc * 32 + 8 * fq;
            const f32x4 gs0 = *(const f32x4*)(gf + c0) * (*(const f32x4*)(fsc + (size_t)b * LDM + c0) + 1.0f), gs1 = *(const f32x4*)(gf + c0 + 4) * (*(const f32x4*)(fsc + (size_t)b * LDM + c0 + 4) + 1.0f);
            const f32x4 sh0 = *(const f32x4*)(fsh + (size_t)b * LDM + c0), sh1 = *(const f32x4*)(fsh + (size_t)b * LDM + c0 + 4);
#pragma unroll
            for (int ai = 0; ai < 2; ++ai)
#pragma unroll
                for (int m = 0; m < 4; ++m) { const unsigned so = (unsigned)(((ai * 128 + m * 16) * D + bj * 128) * 4); const float r = rs[ai][m];
                    *(f32x4*)((char*)out + (size_t)voff + so) = acc[ai][bj][m][0] * r * gs0 + sh0;
                    *(f32x4*)((char*)out + (size_t)voff + so + 16) = acc[ai][bj][m][1] * r * gs1 + sh1; } }
    }
};
struct EpiMixIn {
    static constexpr bool PERM = true, AFTER_DRAIN = false; static constexpr int REPS = 1;
    pg8::bf16_t *U, *UX, *GY; const float* ssp; const float* bias;
    __device__ __forceinline__ void operator()(const f32x4 (&acc)[2][2][4][2], const pg8::Unit& u, int wr, int wc, int fr, int fq) const {
        const int row0 = u.pm * 256 + wr * 64 + fr, b = u.pm >> 4;
        float rs[2][4]; load_rstd(ssp, row0, fq, rs);
        const float* bp = bias + (size_t)b * NMIX + u.pn * 256 + wc * 32 + 8 * fq;
        const f32x4 b00 = *(const f32x4*)(bp), b01 = *(const f32x4*)(bp + 4), b10 = *(const f32x4*)(bp + 128), b11 = *(const f32x4*)(bp + 132);
        if (u.pn < 4) {
            const int oc = u.pn * 128 + wc * 32 + 8 * fq;
#pragma unroll
            for (int ai = 0; ai < 2; ++ai)
#pragma unroll
                for (int m = 0; m < 4; ++m) { const float r = rs[ai][m];
                    const f32x4 v0 = acc[ai][0][m][0] * r + b00, v1 = acc[ai][0][m][1] * r + b01, g0 = acc[ai][1][m][0] * r + b10, g1 = acc[ai][1][m][1] * r + b11;
                    const f32x4 a0 = v0 * sigmoid4(g0), a1 = v1 * sigmoid4(g1);
                    *(v4u*)(U + (size_t)(row0 + ai * 128 + m * 16) * DC + oc) = pack8(a0, a1); }
        } else {
            pg8::bf16_t* dst = (u.pn < 6) ? UX : GY; const bool gel = u.pn >= 6; const int pc = (u.pn & 1) * 256 + wc * 32 + 8 * fq;
#pragma unroll
            for (int ai = 0; ai < 2; ++ai)
#pragma unroll
                for (int m = 0; m < 4; ++m) { const float r = rs[ai][m];
#pragma unroll
                    for (int bj = 0; bj < 2; ++bj) { f32x4 v0 = acc[ai][bj][m][0] * r + (bj ? b10 : b00), v1 = acc[ai][bj][m][1] * r + (bj ? b11 : b01);
                        if (gel) { v0 = gelu_tanh4(v0); v1 = gelu_tanh4(v1); }
                        *(v4u*)(dst + (size_t)(row0 + ai * 128 + m * 16) * DR + pc + bj * 128) = pack8(v0, v1); } }
        }
    }
};

struct EpiMixIn8 {
    static constexpr bool PERM = true, AFTER_DRAIN = false; static constexpr int REPS = 1;
    pg8::bf16_t *U, *UX, *GY; const float* rs; const float* cs; const float* bias;
    __device__ __forceinline__ void operator()(const f32x4 (&acc)[2][2][4][2], const pg8::Unit& u, int wr, int wc, int fr, int fq) const {
        const int row0 = u.pm * 256 + wr * 64 + fr, b = u.pm >> 4;
        float rv[2][4];
#pragma unroll
        for (int ai = 0; ai < 2; ++ai)
#pragma unroll
            for (int m = 0; m < 4; ++m) rv[ai][m] = rs[row0 + ai * 128 + m * 16];
        const int cb = u.pn * 256 + wc * 32 + 8 * fq;
        const float* bp = bias + (size_t)b * NMIX + cb; const float* cp = cs + cb;
        const f32x4 b00 = *(const f32x4*)(bp), b01 = *(const f32x4*)(bp + 4), b10 = *(const f32x4*)(bp + 128), b11 = *(const f32x4*)(bp + 132);
        const f32x4 c00 = *(const f32x4*)(cp), c01 = *(const f32x4*)(cp + 4), c10 = *(const f32x4*)(cp + 128), c11 = *(const f32x4*)(cp + 132);
        if (u.pn < 4) {
            const int oc = u.pn * 128 + wc * 32 + 8 * fq;
#pragma unroll
            for (int ai = 0; ai < 2; ++ai)
#pragma unroll
                for (int m = 0; m < 4; ++m) { const float r = rv[ai][m];
                    const f32x4 v0 = acc_i2f(acc[ai][0][m][0]) * (c00 * r) + b00, v1 = acc_i2f(acc[ai][0][m][1]) * (c01 * r) + b01;
                    const f32x4 g0 = acc_i2f(acc[ai][1][m][0]) * (c10 * r) + b10, g1 = acc_i2f(acc[ai][1][m][1]) * (c11 * r) + b11;
                    const f32x4 a0 = v0 * sigmoid4(g0), a1 = v1 * sigmoid4(g1);
                    *(v4u*)(U + (size_t)(row0 + ai * 128 + m * 16) * DC + oc) = pack8(a0, a1); }
        } else {
            pg8::bf16_t* dst = (u.pn < 6) ? UX : GY; const bool gel = u.pn >= 6; const int pc = (u.pn & 1) * 256 + wc * 32 + 8 * fq;
#pragma unroll
            for (int ai = 0; ai < 2; ++ai)
#pragma unroll
                for (int m = 0; m < 4; ++m) { const float r = rv[ai][m];
#pragma unroll
                    for (int bj = 0; bj < 2; ++bj) { f32x4 v0 = acc_i2f(acc[ai][bj][m][0]) * ((bj ? c10 : c00) * r) + (bj ? b10 : b00), v1 = acc_i2f(acc[ai][bj][m][1]) * ((bj ? c11 : c01) * r) + (bj ? b11 : b01);
                        if (gel) { v0 = gelu_tanh4(v0); v1 = gelu_tanh4(v1); }
                        *(v4u*)(dst + (size_t)(row0 + ai * 128 + m * 16) * DR + pc + bj * 128) = pack8(v0, v1); } }
        }
    }
};

__device__ __forceinline__ void p0_gemv(LAS unsigned char* lds, const float* c, const float* W, int NC, const float* bias, float* out, int j0, int tid) {
    LAS float* ca = (LAS float*)lds; LAS float* part = (LAS float*)(lds + 32768);
    for (int i = tid; i < NB * D; i += 512) { const float v = c[i]; ca[i] = v / (1.f + expf(-v)); }
    __syncthreads();
    const int cg = tid & 31, ks = tid >> 5;
    const float* wp = W + (size_t)(64 * ks) * NC + j0 + 4 * cg;
    f32x4 acc[NB];
#pragma unroll
    for (int b = 0; b < NB; ++b) acc[b] = (f32x4){0.f, 0.f, 0.f, 0.f};
#pragma unroll 4
    for (int kk = 0; kk < 64; ++kk) { const f32x4 w = *(const f32x4*)(wp + (size_t)kk * NC);
#pragma unroll
        for (int b = 0; b < NB; ++b) acc[b] += w * ca[b * D + 64 * ks + kk]; }
#pragma unroll
    for (int b = 0; b < NB; ++b) *(LAS f32x4*)(part + (ks * NB + b) * 128 + 4 * cg) = acc[b];
    __syncthreads();
#pragma unroll
    for (int r = 0; r < 2; ++r) { const int o = tid + 512 * r, b = o >> 7, col = o & 127; float s = 0.f;
#pragma unroll
        for (int k2 = 0; k2 < 16; ++k2) s += part[(k2 * NB + b) * 128 + col];
        out[(size_t)b * LDM + j0 + col] = s + bias[j0 + col]; }
    __syncthreads();
}
__device__ __forceinline__ int rowmap(int kind, int n0) {
    if (kind == 1) { const int half = n0 / FF, f = n0 - half * FF; return 256 * (f >> 7) + 128 * half + (f & 127); }
    if (kind == 2 && n0 < 1024) { const int half = n0 >> 9, f = n0 & 511; return 256 * (f >> 7) + 128 * half + (f & 127); }
    return n0;
}
__device__ __forceinline__ void p0_transpose_item(const float* W, int K, int N, bf16* WT, int kind, LAS float* scr, int item, int lane) {
    const int nblk = N / 32, kb = item / nblk, nb = item % nblk, k0 = 64 * kb, n0 = 32 * nb, r0 = rowmap(kind, n0);
#pragma unroll 8
    for (int i = 0; i < 32; ++i) { const int kk = 2 * i + (lane >> 5); scr[kk * 33 + (lane & 31)] = W[(size_t)(k0 + kk) * N + n0 + (lane & 31)]; }
    LDS_WAIT(); asm volatile("" ::: "memory");
    const int c = lane & 7;
#pragma unroll
    for (int j = 0; j < 4; ++j) { const int n = (lane >> 3) + 8 * j; const LAS float* s = scr + (8 * c) * 33 + n;
        v4u o; o.x = pk2(s[0 * 33], s[1 * 33]); o.y = pk2(s[2 * 33], s[3 * 33]); o.z = pk2(s[4 * 33], s[5 * 33]); o.w = pk2(s[6 * 33], s[7 * 33]);
        *(GAS v4u*)(WT + (size_t)(r0 + n) * K + k0 + 8 * c) = o; }
    LDS_WAIT(); asm volatile("" ::: "memory");
}

__device__ __forceinline__ void p0_transpose8_item(const float* W, int K, int N, unsigned char* WT, LAS float* scr, int item, int lane) {
    const int nblk = N / 32, kb = item / nblk, nb = item % nblk, k0 = 64 * kb, n0 = 32 * nb;
#pragma unroll 8
    for (int i = 0; i < 32; ++i) { const int kk = 2 * i + (lane >> 5); scr[kk * 33 + (lane & 31)] = W[(size_t)(k0 + kk) * N + n0 + (lane & 31)]; }
    LDS_WAIT(); asm volatile("" ::: "memory");
    const int n = lane >> 1, kh = (lane & 1) * 32; const LAS float* sp = scr + n;
#pragma unroll
    for (int hq = 0; hq < 2; ++hq) { v4u o;
#pragma unroll
        for (int dq = 0; dq < 4; ++dq) { const int k = kh + 16 * hq + 4 * dq;
            const unsigned w4 = f8x4((f32x4){sp[(k + 0) * 33], sp[(k + 1) * 33], sp[(k + 2) * 33], sp[(k + 3) * 33]} * F8_W_SCALE);
            if (dq == 0) o.x = w4; else if (dq == 1) o.y = w4; else if (dq == 2) o.z = w4; else o.w = w4; }
        *(GAS v4u*)(WT + (size_t)(n0 + n) * K + k0 + kh + 16 * hq) = o; }
    LDS_WAIT(); asm volatile("" ::: "memory");
}
__device__ __forceinline__ void p0_quant_item(LAS unsigned char* lds, const float* W, int N, int kind, unsigned char* W8, float* cs, int nb, int lane, int wave) {
    LAS float* scr = (LAS float*)(lds + wave * 16896);
    LAS float* cm = (LAS float*)(lds + 8 * 16896);
    const int n0 = 32 * nb, r0 = rowmap(kind, n0);
#pragma unroll
    for (int tl = 0; tl < 2; ++tl) { const int k0 = 64 * (2 * wave + tl);
#pragma unroll 8
        for (int i = 0; i < 32; ++i) { const int kk = 2 * i + (lane >> 5); scr[tl * 2112 + kk * 33 + (lane & 31)] = W[(size_t)(k0 + kk) * N + n0 + (lane & 31)]; } }
    LDS_WAIT(); asm volatile("" ::: "memory");
    float mx = 0.f;
#pragma unroll
    for (int tl = 0; tl < 2; ++tl)
#pragma unroll 8
        for (int r = 0; r < 32; ++r) mx = fmaxf(mx, fabsf(scr[tl * 2112 + ((lane >> 5) * 32 + r) * 33 + (lane & 31)]));
    mx = fmaxf(mx, __shfl_xor(mx, 32));
    if (lane < 32) cm[wave * 32 + lane] = mx;
    __syncthreads();
    float cmax = 0.f;
#pragma unroll
    for (int w = 0; w < 8; ++w) cmax = fmaxf(cmax, cm[w * 32 + (lane & 31)]);
    const float sc = cmax > 0.f ? 127.0f / cmax : 0.f;
    if (wave == 0 && lane < 32) cs[r0 + lane] = cmax * (1.0f / 127.0f);
    const int n = lane >> 1, kh = (lane & 1) * 32;
    const float sn = __shfl(sc, n);
#pragma unroll
    for (int tl = 0; tl < 2; ++tl) { const int k0 = 64 * (2 * wave + tl); const LAS float* sp = scr + tl * 2112 + n;
#pragma unroll
        for (int hq = 0; hq < 2; ++hq) { v4u o;
#pragma unroll
            for (int dq = 0; dq < 4; ++dq) { const int k = kh + 16 * hq + 4 * dq;
                const unsigned w4 = q8(sp[(k + 0) * 33] * sn) | (q8(sp[(k + 1) * 33] * sn) << 8) | (q8(sp[(k + 2) * 33] * sn) << 16) | (q8(sp[(k + 3) * 33] * sn) << 24);
                if (dq == 0) o.x = w4; else if (dq == 1) o.y = w4; else if (dq == 2) o.z = w4; else o.w = w4; }
            *(GAS v4u*)(W8 + (size_t)(r0 + n) * D + k0 + kh + 16 * hq) = o; } }
    __syncthreads();
}

#ifdef MK_PROF_ID
#define PROF_T() __builtin_amdgcn_s_memrealtime()
#define PROF_BEGIN(id) unsigned long long _pt##id = 0; if (threadIdx.x == 0) _pt##id = PROF_T()
#define PROF_END(id) do { if (threadIdx.x == 0) { LAS unsigned* _pw = (LAS unsigned*)(lds + LDSCTL_OFF) + 40 + (id); *_pw += (unsigned)(PROF_T() - _pt##id); } } while (0)
#else
#define PROF_BEGIN(id)
#define PROF_END(id)
#endif
__device__ __forceinline__ void mix_conv(LAS unsigned char* lds, const bf16* U, const float* conv_w, const float* conv_b, const float* ln_g, const float* ln_b, bf16* YMIX, int G, int bx, int tid, int lane, int wave) {
    LAS unsigned char* IN = lds;
    LAS f32x4* WA = (LAS f32x4*)(lds + 63488);
    LAS f32x4* WB = WA + 31 * 64;
    for (int i = tid; i < 31 * 64; i += 512) { const int k = i >> 6, l = i & 63; WA[i] = *(const f32x4*)(conv_w + k * DC + 8 * l); WB[i] = *(const f32x4*)(conv_w + k * DC + 8 * l + 4); }
    const f32x4 cb0 = *(const f32x4*)(conv_b + 8 * lane), cb1 = *(const f32x4*)(conv_b + 8 * lane + 4);
    const f32x4 lg0 = *(const f32x4*)(ln_g + 8 * lane), lg1 = *(const f32x4*)(ln_g + 8 * lane + 4);
    const f32x4 lb0 = *(const f32x4*)(ln_b + 8 * lane), lb1 = *(const f32x4*)(ln_b + 8 * lane + 4);
    v4u pre[8];
#pragma unroll
    for (int i = 0; i < 8; ++i) { const int q = tid + 512 * i, row = q >> 6, ch = q & 63, tok = (bx & 127) * 32 - 30 + row; pre[i] = (v4u){0u, 0u, 0u, 0u};
        if (bx < NB * (SEQ / 32) && q < 62 * 64 && tok >= 0) pre[i] = *(const v4u*)(U + ((size_t)((bx >> 7) * SEQ + tok)) * DC + 8 * ch); }
    for (int item = bx; item < NB * (SEQ / 32); item += G) {
        const int b = item >> 7, t0 = (item & 127) * 32;
        __syncthreads();
#pragma unroll
        for (int i = 0; i < 8; ++i) { const int q = tid + 512 * i; if (q < 62 * 64) *(LAS v4u*)(IN + (q >> 6) * 1024 + (q & 63) * 16) = pre[i]; }
        { const int nitem = item + G, nb = nitem >> 7, nt0 = (nitem & 127) * 32;
#pragma unroll
            for (int i = 0; i < 8; ++i) { const int q = tid + 512 * i, row = q >> 6, ch = q & 63, tok = nt0 - 30 + row; pre[i] = (v4u){0u, 0u, 0u, 0u};
                if (nitem < NB * (SEQ / 32) && q < 62 * 64 && tok >= 0) pre[i] = *(const v4u*)(U + ((size_t)(nb * SEQ + tok)) * DC + 8 * ch); } }
        __syncthreads();
        f32x4 a0[4], a1[4];
#pragma unroll
        for (int tt = 0; tt < 4; ++tt) { a0[tt] = cb0; a1[tt] = cb1; }
        f32x4 wa0 = {0.f, 0.f, 0.f, 0.f}, wa1 = wa0, wa2 = wa0, wa3 = wa0, wb0 = wa0, wb1 = wa0, wb2 = wa0, wb3 = wa0;
#pragma unroll
        for (int kk = 0; kk < 34; ++kk) {
            const v4u v = *(const LAS v4u*)(IN + (4 * wave + kk) * 1024 + lane * 16);
            const f32x4 x0 = {bflo(v.x), bfhi(v.x), bflo(v.y), bfhi(v.y)}, x1 = {bflo(v.z), bfhi(v.z), bflo(v.w), bfhi(v.w)};
            wa3 = wa2; wa2 = wa1; wa1 = wa0; wb3 = wb2; wb2 = wb1; wb1 = wb0;
            if (kk <= 30) { wa0 = WA[kk * 64 + lane]; wb0 = WB[kk * 64 + lane]; } else { wa0 = (f32x4){0.f, 0.f, 0.f, 0.f}; wb0 = wa0; }
            a0[0] += wa0 * x0; a1[0] += wb0 * x1; a0[1] += wa1 * x0; a1[1] += wb1 * x1; a0[2] += wa2 * x0; a1[2] += wb2 * x1; a0[3] += wa3 * x0; a1[3] += wb3 * x1;
        }
#pragma unroll
        for (int tt = 0; tt < 4; ++tt) {
            float s = (a0[tt][0] + a0[tt][1]) + (a0[tt][2] + a0[tt][3]) + (a1[tt][0] + a1[tt][1]) + (a1[tt][2] + a1[tt][3]);
            const float mean = wave_sum(s) * (1.0f / DC);
            const f32x4 d0 = a0[tt] - mean, d1 = a1[tt] - mean;
            float q = (d0[0] * d0[0] + d0[1] * d0[1]) + (d0[2] * d0[2] + d0[3] * d0[3]) + (d1[0] * d1[0] + d1[1] * d1[1]) + (d1[2] * d1[2] + d1[3] * d1[3]);
            const float rstd = rsqrtf(wave_sum(q) * (1.0f / DC) + EPS);
            f32x4 y0 = d0 * rstd * lg0 + lb0, y1 = d1 * rstd * lg1 + lb1;
#pragma unroll
            for (int j = 0; j < 4; ++j) { y0[j] = silu_fast(y0[j]); y1[j] = silu_fast(y1[j]); }
            *(v4u*)(YMIX + ((size_t)(b * SEQ + t0 + 4 * wave + tt)) * D + 8 * lane) = pack8(y0, y1);
        }
    }
    __syncthreads();
}

__device__ __forceinline__ void mix_conv2(LAS unsigned char* lds, const bf16* U, const float* conv_w, const float* conv_b, const float* ln_g, const float* ln_b, bf16* YMIX, int G, int bx, int tid, int lane, int wave) {
    LAS unsigned char* IN = lds;
    LAS float* RED = (LAS float*)(lds + 63488);
    const int th = wave >> 2, cq = wave & 3, ch = 128 * cq + 2 * lane;
    f32x2 wt[31];
#pragma unroll
    for (int k = 0; k < 31; ++k) wt[k] = *(const f32x2*)(conv_w + k * DC + ch);
    const f32x2 cb = *(const f32x2*)(conv_b + ch), lg = *(const f32x2*)(ln_g + ch), lb = *(const f32x2*)(ln_b + ch);
    v4u pre[8];
#pragma unroll
    for (int i = 0; i < 8; ++i) { const int q = tid + 512 * i, row = q >> 6, c16 = q & 63, tok = (bx & 127) * 32 - 30 + row; pre[i] = (v4u){0u, 0u, 0u, 0u};
        if (bx < NB * (SEQ / 32) && q < 62 * 64 && tok >= 0) pre[i] = *(const v4u*)(U + ((size_t)((bx >> 7) * SEQ + tok)) * DC + 8 * c16); }
    for (int item = bx; item < NB * (SEQ / 32); item += G) {
        const int b = item >> 7, t0 = (item & 127) * 32;
        __syncthreads();
#pragma unroll
        for (int i = 0; i < 8; ++i) { const int q = tid + 512 * i; if (q < 62 * 64) *(LAS v4u*)(IN + (q >> 6) * 1024 + (q & 63) * 16) = pre[i]; }
        { const int nitem = item + G, nb = nitem >> 7, nt0 = (nitem & 127) * 32;
#pragma unroll
            for (int i = 0; i < 8; ++i) { const int q = tid + 512 * i, row = q >> 6, c16 = q & 63, tok = nt0 - 30 + row; pre[i] = (v4u){0u, 0u, 0u, 0u};
                if (nitem < NB * (SEQ / 32) && q < 62 * 64 && tok >= 0) pre[i] = *(const v4u*)(U + ((size_t)(nb * SEQ + tok)) * DC + 8 * c16); } }
        __syncthreads();
        f32x2 acc[16];
#pragma unroll
        for (int tt = 0; tt < 16; ++tt) acc[tt] = cb;
        const LAS unsigned char* ip = IN + (16 * th) * 1024 + ch * 2;
#pragma unroll
        for (int r = 0; r < 46; ++r) {
            const unsigned v = *(const LAS unsigned*)(ip + r * 1024);
            const f32x2 xv = {bflo(v), bfhi(v)};
#pragma unroll
            for (int tt = 0; tt < 16; ++tt) { const int k = r - tt; if (k >= 0 && k <= 30) acc[tt] += wt[k] * xv; }
        }
        float vals[32];
#pragma unroll
        for (int tt = 0; tt < 16; ++tt) { vals[tt] = acc[tt][0] + acc[tt][1]; vals[16 + tt] = acc[tt][0] * acc[tt][0] + acc[tt][1] * acc[tt][1]; }
#pragma unroll
        for (int i = 0; i < 16; ++i) { const auto p = __builtin_amdgcn_permlane32_swap((int)__float_as_uint(vals[i]), (int)__float_as_uint(vals[i + 16]), false, false); vals[i] = __uint_as_float((unsigned)p[0]) + __uint_as_float((unsigned)p[1]); }
#pragma unroll
        for (int i = 0; i < 8; ++i) { const auto p = __builtin_amdgcn_permlane16_swap((int)__float_as_uint(vals[i]), (int)__float_as_uint(vals[i + 8]), false, false); vals[i] = __uint_as_float((unsigned)p[0]) + __uint_as_float((unsigned)p[1]); }
#define CONV_RED_STEP(off, n) { const bool up = (lane & (off)) != 0; _Pragma("unroll") for (int i = 0; i < (n); ++i) { const float keep = up ? vals[i + (n)] : vals[i], send = up ? vals[i] : vals[i + (n)]; vals[i] = keep + sx<(off)>(send); } }
        CONV_RED_STEP(8, 4) CONV_RED_STEP(4, 2) CONV_RED_STEP(2, 1)
#undef CONV_RED_STEP
        vals[0] += sx<1>(vals[0]);
        if ((lane & 1) == 0) RED[wave * 32 + (lane >> 5) * 16 + ((lane >> 1) & 15)] = vals[0];
        __syncthreads();
        float mean_l = 0.f, rstd_l = 0.f;
        if (lane < 16) { float s1 = 0.f, s2 = 0.f;
#pragma unroll
            for (int q4 = 0; q4 < 4; ++q4) { s1 += RED[(4 * th + q4) * 32 + lane]; s2 += RED[(4 * th + q4) * 32 + 16 + lane]; }
            mean_l = s1 * (1.0f / DC); const float var = fmaxf(s2 * (1.0f / DC) - mean_l * mean_l, 0.f); rstd_l = rsqrtf(var + EPS); }
#pragma unroll
        for (int tt = 0; tt < 16; ++tt) {
            const float mean = __uint_as_float((unsigned)__builtin_amdgcn_readlane((int)__float_as_uint(mean_l), tt)), rstd = __uint_as_float((unsigned)__builtin_amdgcn_readlane((int)__float_as_uint(rstd_l), tt));
            f32x2 y = (acc[tt] - mean) * rstd * lg + lb;
            y[0] = silu_fast(y[0]); y[1] = silu_fast(y[1]);
            *(unsigned*)(YMIX + ((size_t)(b * SEQ + t0 + 16 * th + tt)) * D + ch) = cvtpk(y[0], y[1]);
        }
    }
    __syncthreads();
}

__device__ __forceinline__ void scan_decode(int it, int& b, int& c) { if (it < 256) { b = it >> 6; c = it & 63; } else { b = 4 + ((it - 256) >> 6); c = 63 - ((it - 256) & 63); } }
__device__ __forceinline__ float neg_expm1(float x, float a) {
    float p = -1.0f / 5040.0f; p = p * x - 1.0f / 720.0f; p = p * x - 1.0f / 120.0f; p = p * x - 1.0f / 24.0f; p = p * x - 1.0f / 6.0f; p = p * x - 0.5f; p = p * x - 1.0f;
    float q = p * x, w = 1.0f - a * a; asm volatile("" : "+v"(q), "+v"(w));
    return x > -0.5f ? q : w;
}
__device__ __forceinline__ void gate_math16(const f32x16 pa, const f32x16 pi, float ba, float bi, float c8, f32x16& av, f32x16& bv) {
#pragma unroll
    for (int g4 = 0; g4 < 4; ++g4) {
        const f32x4 pa4 = {pa[4 * g4], pa[4 * g4 + 1], pa[4 * g4 + 2], pa[4 * g4 + 3]}, pi4 = {pi[4 * g4], pi[4 * g4 + 1], pi[4 * g4 + 2], pi[4 * g4 + 3]};
        const f32x4 rg = sigmoid4(pa4 + ba), ig = sigmoid4(pi4 + bi);
        const f32x4 l2 = rg * c8;
        const f32x4 a = {__builtin_amdgcn_exp2f(l2[0]), __builtin_amdgcn_exp2f(l2[1]), __builtin_amdgcn_exp2f(l2[2]), __builtin_amdgcn_exp2f(l2[3])};
        const f32x4 x = l2 * 1.3862943611198906f;
        f32x4 p = x * (-1.0f / 5040.0f) - 1.0f / 720.0f; p = p * x - 1.0f / 120.0f; p = p * x - 1.0f / 24.0f; p = p * x - 1.0f / 6.0f; p = p * x - 0.5f; p = p * x - 1.0f;
        f32x4 q = p * x, w = 1.0f - a * a; asm volatile("" : "+v"(q), "+v"(w));
        f32x4 m2;
#pragma unroll
        for (int e = 0; e < 4; ++e) m2[e] = __builtin_amdgcn_sqrtf(x[e] > -0.5f ? q[e] : w[e]);
        const f32x4 bb = m2 * ig;
#pragma unroll
        for (int e = 0; e < 4; ++e) { av[4 * g4 + e] = a[e]; bv[4 * g4 + e] = bb[e]; }
        __builtin_amdgcn_sched_barrier(0);
    }
}
template <bool FINAL>
__device__ __forceinline__ void mix_scan(LAS unsigned char* lds, const bf16* UX, const bf16* GY, const bf16* WGT, const float* rw, const float* rb, const float* b_a, const float* b_i, const float* lam,
                                         f32x2* TOT, bf16* YMIX, int G, int bx, int lane, int wave) {
    LAS unsigned char* UXT = lds + wave * 16896;
    LAS unsigned char* XRT = UXT + 8704;
    const int h = wave, j = lane & 31, hh = lane >> 5, dg = lane & 7, tg = lane >> 3;
    float c8v[2], bav[2], biv[2];
#pragma unroll
    for (int ec = 0; ec < 2; ++ec) { const int ch = 64 * h + 32 * ec + j; c8v[ec] = -8.0f * 1.4426950408889634f * log1pf(expf(-lam[ch]));   bav[ec] = b_a[ch]; biv[ec] = b_i[ch]; }
    for (int it = bx; it < 512; it += G) {
        asm volatile("" ::: "memory");
        int b, c; scan_decode(it, b, c);
        const size_t mrow0 = (size_t)b * SEQ + 64 * c;
#pragma unroll
        for (int i = 0; i < 9; ++i) { const int row = i * 8 + tg, tok = 64 * c - 3 + row; v4u v = {0u, 0u, 0u, 0u};
            if (row < 67 && tok >= 0) v = *(const v4u*)(UX + ((size_t)b * SEQ + tok) * DR + 64 * h + 8 * dg);
            if (row < 68) *(LAS v4u*)(UXT + row * 128 + dg * 16) = v; }
        pg8::bf16x8 bfr[2][4];
#pragma unroll
        for (int g = 0; g < 2; ++g)
#pragma unroll
            for (int ks = 0; ks < 4; ++ks) bfr[g][ks] = *(const pg8::bf16x8*)(WGT + ((size_t)(h * 128 + 64 * g + j)) * 64 + 16 * ks + 8 * hh);
        v4u gyv[8];
        if (FINAL) {
#pragma unroll
            for (int i = 0; i < 8; ++i) gyv[i] = *(const v4u*)(GY + (mrow0 + i * 8 + tg) * DR + 64 * h + 8 * dg);
        }
        float Hc = 0.f;
        if (FINAL) { const f32x2* tp = TOT + ((size_t)b * 64) * DR + 64 * h + lane; int cc = 0;
            for (; cc + 8 <= c; cc += 8) { f32x2 t8[8];
#pragma unroll
                for (int u = 0; u < 8; ++u) t8[u] = tp[(size_t)(cc + u) * DR];
#pragma unroll
                for (int u = 0; u < 8; ++u) Hc = Hc * t8[u].x + t8[u].y; }
            for (; cc < c; ++cc) { const f32x2 ab = tp[(size_t)cc * DR]; Hc = Hc * ab.x + ab.y; } }
        {
            f32x4 w4a[4], w4b[4];
#pragma unroll
            for (int k = 0; k < 4; ++k) { w4a[k] = *(const f32x4*)(rw + k * DR + 64 * h + 8 * dg); w4b[k] = *(const f32x4*)(rw + k * DR + 64 * h + 8 * dg + 4); }
            const f32x4 rb0 = *(const f32x4*)(rb + 64 * h + 8 * dg), rb1 = *(const f32x4*)(rb + 64 * h + 8 * dg + 4);
#pragma unroll
            for (int th = 0; th < 2; ++th) {
                f32x4 o0[4], o1[4];
#pragma unroll
                for (int t = 0; t < 4; ++t) { o0[t] = rb0; o1[t] = rb1; }
#pragma unroll
                for (int i = 0; i < 7; ++i) { const v4u v = *(const LAS v4u*)(UXT + (8 * tg + 4 * th + i) * 128 + dg * 16);
                    const f32x4 x0 = {bflo(v.x), bfhi(v.x), bflo(v.y), bfhi(v.y)}, x1 = {bflo(v.z), bfhi(v.z), bflo(v.w), bfhi(v.w)};
#pragma unroll
                    for (int k = 0; k < 4; ++k) { const int t = i - k; if (t >= 0 && t < 4) { o0[t] += w4a[k] * x0; o1[t] += w4b[k] * x1; } } }
#pragma unroll
                for (int t = 0; t < 4; ++t) *(LAS v4u*)(XRT + (8 * tg + 4 * th + t) * 128 + dg * 16) = pack8(o0[t], o1[t]);
            }
        }
        if (FINAL) {
#pragma unroll
            for (int i = 0; i < 8; ++i) *(LAS v4u*)(UXT + (i * 8 + tg) * 128 + dg * 16) = gyv[i];
        }
#pragma unroll
        for (int ec = 0; ec < 2; ++ec) {
            const int ch = 64 * h + 32 * ec + j;
            const float c8 = c8v[ec], ba = bav[ec], bi = biv[ec];
            f32x16 av[2], bv[2];
#pragma unroll
            for (int tt = 0; tt < 2; ++tt) {
                pg8::bf16x8 afr[4];
#pragma unroll
                for (int ks = 0; ks < 4; ++ks) afr[ks] = *(const LAS pg8::bf16x8*)(XRT + (32 * tt + j) * 128 + (16 * ks + 8 * hh) * 2);
                f32x16 pa, pi;
#pragma unroll
                for (int r = 0; r < 16; ++r) { pa[r] = 0.f; pi[r] = 0.f; }
#pragma unroll
                for (int ks = 0; ks < 4; ++ks) {
                    pa = __builtin_amdgcn_mfma_f32_32x32x16_bf16(afr[ks], bfr[0][ks], pa, 0, 0, 0);
                    pi = __builtin_amdgcn_mfma_f32_32x32x16_bf16(afr[ks], bfr[1][ks], pi, 0, 0, 0); }
                if (ec == 0 && tt == 1) {
#pragma unroll
                    for (int g = 0; g < 2; ++g)
#pragma unroll
                        for (int ks = 0; ks < 4; ++ks) bfr[g][ks] = *(const pg8::bf16x8*)(WGT + ((size_t)(h * 128 + 64 * g + 32 + j)) * 64 + 16 * ks + 8 * hh);
                }
                gate_math16(pa, pi, ba, bi, c8, av[tt], bv[tt]);
                {
                    f32x16 px;
#pragma unroll
                    for (int r = 0; r < 16; ++r) px[r] = bv[tt][r] * 0.f;
                    int dd = 32 * ec + j - 8 * hh; asm volatile("" : "+v"(dd));
                    const unsigned one = (dd & 1) ? 0x3F800000u : 0x00003F80u;
#pragma unroll
                    for (int ks = 0; ks < 4; ++ks) {
                        const int dw = (dd - 16 * ks) >> 1;
                        v4u idw; idw.x = dw == 0 ? one : 0u; idw.y = dw == 1 ? one : 0u; idw.z = dw == 2 ? one : 0u; idw.w = dw == 3 ? one : 0u;
                        px = __builtin_amdgcn_mfma_f32_32x32x16_bf16(afr[ks], __builtin_bit_cast(pg8::bf16x8, idw), px, 0, 0, 0); }
#pragma unroll
                    for (int r = 0; r < 16; ++r) bv[tt][r] *= px[r];
                }
            }
            float GA[2][4], GB[2][4], PA[2][4], PB[2][4];
#pragma unroll
            for (int tt = 0; tt < 2; ++tt)
#pragma unroll
                for (int q = 0; q < 4; ++q) { const float a0 = av[tt][4 * q], a1 = av[tt][4 * q + 1], a2 = av[tt][4 * q + 2], a3 = av[tt][4 * q + 3];
                    const float b0 = bv[tt][4 * q], b1 = bv[tt][4 * q + 1], b2 = bv[tt][4 * q + 2], b3 = bv[tt][4 * q + 3];
                    GA[tt][q] = (a0 * a1) * (a2 * a3); GB[tt][q] = ((b0 * a1 + b1) * a2 + b2) * a3 + b3;
                    PA[tt][q] = __shfl_xor(GA[tt][q], 32); PB[tt][q] = __shfl_xor(GB[tt][q], 32); }
            if (!FINAL) {
                float At = 1.f, Bt = 0.f;
#pragma unroll
                for (int tt = 0; tt < 2; ++tt)
#pragma unroll
                    for (int q = 0; q < 4; ++q) { const float A0 = hh ? PA[tt][q] : GA[tt][q], B0 = hh ? PB[tt][q] : GB[tt][q], A1 = hh ? GA[tt][q] : PA[tt][q], B1 = hh ? GB[tt][q] : PB[tt][q];
                        Bt = (Bt * A0 + B0) * A1 + B1; At = (At * A0) * A1; }
                if (hh == 0) TOT[((size_t)b * 64 + c) * DR + ch] = (f32x2){At, Bt};
            } else {
                float hc = __shfl(Hc, 32 * ec + j);
#pragma unroll
                for (int tt = 0; tt < 2; ++tt)
#pragma unroll
                    for (int q = 0; q < 4; ++q) { const float A0 = hh ? PA[tt][q] : GA[tt][q], B0 = hh ? PB[tt][q] : GB[tt][q], A1 = hh ? GA[tt][q] : PA[tt][q], B1 = hh ? GB[tt][q] : PB[tt][q];
                        const float mid = hc * A0 + B0; float hv = hh ? mid : hc; hc = mid * A1 + B1;
#pragma unroll
                        for (int i = 0; i < 4; ++i) { hv = av[tt][4 * q + i] * hv + bv[tt][4 * q + i]; av[tt][4 * q + i] = hv; } }
#pragma unroll
                for (int tt = 0; tt < 2; ++tt)
#pragma unroll
                    for (int r = 0; r < 16; ++r) { const int tk = 32 * tt + (r & 3) + 8 * (r >> 2) + 4 * hh;
                        LAS u16* p = (LAS u16*)(UXT + tk * 128 + (32 * ec + j) * 2);
                        const float gy = __uint_as_float((unsigned)(*p) << 16);
                        *p = (u16)f2bf(gy * av[tt][r]); }
            }
        }
        if (FINAL) {
#pragma unroll
            for (int i = 0; i < 8; ++i) { const int row = i * 8 + tg; *(v4u*)(YMIX + (mrow0 + row) * D + DC + 64 * h + 8 * dg) = *(const LAS v4u*)(UXT + row * 128 + dg * 16); }
        }
    }
    __syncthreads();
}

#ifndef FOLD_B
#define FOLD_B 4
#endif
__device__ __forceinline__ void fold_chunks(const gu64* tp, int c0, int c1, int hh, float& A, float& B) {
    const int mid = (c0 + c1 + 1) >> 1, lo = hh ? mid : c0, hi2 = hh ? c1 : mid;
    float Ar = 1.f, Br = 0.f;
    for (int cc = lo; cc < hi2; cc += FOLD_B) { unsigned long long t8[FOLD_B];
        for (unsigned sp = 0;; ++sp) { unsigned all = 0x80000000u;
#pragma unroll
            for (int u = 0; u < FOLD_B; ++u) t8[u] = __hip_atomic_load(tp + (size_t)(cc + u < 63 ? cc + u : 63) * DR, RLX_AGENT);
#pragma unroll
            for (int u = 0; u < FOLD_B; ++u) all &= (cc + u < hi2) ? (unsigned)t8[u] : 0x80000000u;
            if (all || sp > (1u << 16)) break;
            __builtin_amdgcn_s_sleep(1); }
#pragma unroll
        for (int u = 0; u < FOLD_B; ++u) { const bool ok = cc + u < hi2; const float ta = ok ? __uint_as_float((unsigned)t8[u] & 0x7fffffffu) : 1.f, tb = ok ? __uint_as_float((unsigned)(t8[u] >> 32)) : 0.f; Br = Br * ta + tb; Ar = Ar * ta; } }
    const float Ap = __shfl_xor(Ar, 32), Bp = __shfl_xor(Br, 32);
    A = Ar * Ap; B = hh ? (Bp * Ar + Br) : (Br * Ap + Bp);
}
__device__ __forceinline__ void mix_scan1(LAS unsigned char* lds, const bf16* UX, const bf16* GY, const bf16* WGT, const float* rw, const float* rb, const float* b_a, const float* b_i, const float* lam,
                                          f32x2* TOT, unsigned* cnt, bf16* YMIX, int G, int bx, int lane, int wave) {
    LAS unsigned char* UXT = lds + wave * 16896;
    LAS unsigned char* XRT = UXT + 8704;
    const int h = wave, j = lane & 31, hh = lane >> 5, dg = lane & 7, tg = lane >> 3;
    const int gs = G >> 3, b = bx / gs, idx = bx - b * gs;
    float c8v[2], bav[2], biv[2];
#pragma unroll
    for (int ec = 0; ec < 2; ++ec) { const int ch = 64 * h + 32 * ec + j; c8v[ec] = -8.0f * 1.4426950408889634f * log1pf(expf(-lam[ch])); bav[ec] = b_a[ch]; biv[ec] = b_i[ch]; }
    for (int c = idx, round = 0; c < 64; c += gs, ++round) {
        asm volatile("" ::: "memory");
        PROF_BEGIN(3);
        const size_t mrow0 = (size_t)b * SEQ + 64 * c;
#pragma unroll
        for (int i = 0; i < 9; ++i) { const int row = i * 8 + tg, tok = 64 * c - 3 + row; v4u v = {0u, 0u, 0u, 0u};
            if (row < 67 && tok >= 0) v = *(const v4u*)(UX + ((size_t)b * SEQ + tok) * DR + 64 * h + 8 * dg);
            if (row < 68) *(LAS v4u*)(UXT + row * 128 + dg * 16) = v; }
        pg8::bf16x8 bfr[2][4];
#pragma unroll
        for (int g = 0; g < 2; ++g)
#pragma unroll
            for (int ks = 0; ks < 4; ++ks) bfr[g][ks] = *(const pg8::bf16x8*)(WGT + ((size_t)(h * 128 + 64 * g + j)) * 64 + 16 * ks + 8 * hh);
        {
            f32x4 w4a[4], w4b[4];
#pragma unroll
            for (int k = 0; k < 4; ++k) { w4a[k] = *(const f32x4*)(rw + k * DR + 64 * h + 8 * dg); w4b[k] = *(const f32x4*)(rw + k * DR + 64 * h + 8 * dg + 4); }
            const f32x4 rb0 = *(const f32x4*)(rb + 64 * h + 8 * dg), rb1 = *(const f32x4*)(rb + 64 * h + 8 * dg + 4);
#pragma unroll
            for (int th = 0; th < 2; ++th) {
                f32x4 o0[4], o1[4];
#pragma unroll
                for (int t = 0; t < 4; ++t) { o0[t] = rb0; o1[t] = rb1; }
#pragma unroll
                for (int i = 0; i < 7; ++i) { const v4u v = *(const LAS v4u*)(UXT + (8 * tg + 4 * th + i) * 128 + dg * 16);
                    const f32x4 x0 = {bflo(v.x), bfhi(v.x), bflo(v.y), bfhi(v.y)}, x1 = {bflo(v.z), bfhi(v.z), bflo(v.w), bfhi(v.w)};
#pragma unroll
                    for (int k = 0; k < 4; ++k) { const int t = i - k; if (t >= 0 && t < 4) { o0[t] += w4a[k] * x0; o1[t] += w4b[k] * x1; } } }
#pragma unroll
                for (int t = 0; t < 4; ++t) *(LAS v4u*)(XRT + (8 * tg + 4 * th + t) * 128 + dg * 16) = pack8(o0[t], o1[t]);
            }
        }
        PROF_END(3);
#pragma unroll
        for (int ec = 0; ec < 2; ++ec) {
            PROF_BEGIN(4);
            const int ch = 64 * h + 32 * ec + j;
            const float c8 = c8v[ec], ba = bav[ec], bi = biv[ec];
            unsigned* cw = cnt + 64 * (8 * ec + b);
            f32x16 av[2], bv[2];
#pragma unroll
            for (int tt = 0; tt < 2; ++tt) {
                pg8::bf16x8 afr[4];
#pragma unroll
                for (int ks = 0; ks < 4; ++ks) afr[ks] = *(const LAS pg8::bf16x8*)(XRT + (32 * tt + j) * 128 + (16 * ks + 8 * hh) * 2);
                f32x16 pa, pi;
#pragma unroll
                for (int r = 0; r < 16; ++r) { pa[r] = 0.f; pi[r] = 0.f; }
#pragma unroll
                for (int ks = 0; ks < 4; ++ks) {
                    pa = __builtin_amdgcn_mfma_f32_32x32x16_bf16(afr[ks], bfr[0][ks], pa, 0, 0, 0);
                    pi = __builtin_amdgcn_mfma_f32_32x32x16_bf16(afr[ks], bfr[1][ks], pi, 0, 0, 0); }
                if (ec == 0 && tt == 1) {
#pragma unroll
                    for (int g = 0; g < 2; ++g)
#pragma unroll
                        for (int ks = 0; ks < 4; ++ks) bfr[g][ks] = *(const pg8::bf16x8*)(WGT + ((size_t)(h * 128 + 64 * g + 32 + j)) * 64 + 16 * ks + 8 * hh);
                }
                gate_math16(pa, pi, ba, bi, c8, av[tt], bv[tt]);
                {
                    f32x16 px;
#pragma unroll
                    for (int r = 0; r < 16; ++r) px[r] = bv[tt][r] * 0.f;
                    int dd = 32 * ec + j - 8 * hh; asm volatile("" : "+v"(dd));
                    const unsigned one = (dd & 1) ? 0x3F800000u : 0x00003F80u;
#pragma unroll
                    for (int ks = 0; ks < 4; ++ks) {
                        const int dw = (dd - 16 * ks) >> 1;
                        v4u idw; idw.x = dw == 0 ? one : 0u; idw.y = dw == 1 ? one : 0u; idw.z = dw == 2 ? one : 0u; idw.w = dw == 3 ? one : 0u;
                        px = __builtin_amdgcn_mfma_f32_32x32x16_bf16(afr[ks], __builtin_bit_cast(pg8::bf16x8, idw), px, 0, 0, 0); }
#pragma unroll
                    for (int r = 0; r < 16; ++r) bv[tt][r] *= px[r];
                }
            }
            float GA[2][4], GB[2][4], PA[2][4], PB[2][4];
            float At = 1.f, Bt = 0.f;
#pragma unroll
            for (int tt = 0; tt < 2; ++tt)
#pragma unroll
                for (int q = 0; q < 4; ++q) { const float a0 = av[tt][4 * q], a1 = av[tt][4 * q + 1], a2 = av[tt][4 * q + 2], a3 = av[tt][4 * q + 3];
                    const float b0 = bv[tt][4 * q], b1 = bv[tt][4 * q + 1], b2 = bv[tt][4 * q + 2], b3 = bv[tt][4 * q + 3];
                    GA[tt][q] = (a0 * a1) * (a2 * a3); GB[tt][q] = ((b0 * a1 + b1) * a2 + b2) * a3 + b3;
                    PA[tt][q] = __shfl_xor(GA[tt][q], 32); PB[tt][q] = __shfl_xor(GB[tt][q], 32);
                    const float A0 = hh ? PA[tt][q] : GA[tt][q], B0 = hh ? PB[tt][q] : GB[tt][q], A1 = hh ? GA[tt][q] : PA[tt][q], B1 = hh ? GB[tt][q] : PB[tt][q];
                    Bt = (Bt * A0 + B0) * A1 + B1; At = (At * A0) * A1; }
            if (hh == 0) __hip_atomic_store((gu64*)(TOT + ((size_t)b * 64 + c) * DR + ch), ((unsigned long long)__float_as_uint(Bt) << 32) | (__float_as_uint(At) | 0x80000000u), RLX_AGENT);
            PROF_END(4); PROF_BEGIN(7);
            if (ec == 0) {
#pragma unroll
                for (int i = 0; i < 8; ++i) *(LAS v4u*)(UXT + (i * 8 + tg) * 128 + dg * 16) = *(const v4u*)(GY + (mrow0 + i * 8 + tg) * DR + 64 * h + 8 * dg);
            }
            PROF_END(7);
            PROF_BEGIN(2);
            const gu64* tp = (const gu64*)(TOT + ((size_t)b * 64) * DR + ch);
            float hc;
            { float Aq, Bq; fold_chunks(tp, 0, c, hh, Aq, Bq); hc = Bq; }
            PROF_END(2); PROF_BEGIN(5);
#pragma unroll
            for (int tt = 0; tt < 2; ++tt)
#pragma unroll
                for (int q = 0; q < 4; ++q) { const float A0 = hh ? PA[tt][q] : GA[tt][q], B0 = hh ? PB[tt][q] : GB[tt][q], A1 = hh ? GA[tt][q] : PA[tt][q], B1 = hh ? GB[tt][q] : PB[tt][q];
                    const float mid = hc * A0 + B0; float hv = hh ? mid : hc; hc = mid * A1 + B1;
#pragma unroll
                    for (int i = 0; i < 4; ++i) { hv = av[tt][4 * q + i] * hv + bv[tt][4 * q + i]; av[tt][4 * q + i] = hv; } }
#pragma unroll
            for (int tt = 0; tt < 2; ++tt)
#pragma unroll
                for (int r = 0; r < 16; ++r) { const int tk = 32 * tt + (r & 3) + 8 * (r >> 2) + 4 * hh;
                    LAS u16* p = (LAS u16*)(UXT + tk * 128 + (32 * ec + j) * 2);
                    const float gy = __uint_as_float((unsigned)(*p) << 16);
                    *p = (u16)f2bf(gy * av[tt][r]); }
            PROF_END(5);
        }
        PROF_BEGIN(6);
#pragma unroll
        for (int i = 0; i < 8; ++i) { const int row = i * 8 + tg; *(v4u*)(YMIX + (mrow0 + row) * D + DC + 64 * h + 8 * dg) = *(const LAS v4u*)(UXT + row * 128 + dg * 16); }
        PROF_END(6);
    }
    __syncthreads();
}

struct Args { const float* in[27]; float* out; unsigned char* ws; int ph_lo, ph_hi; };
constexpr int NPH = 10;
#ifndef MK_PER_PHASE
#define MK_PER_PHASE 0
#endif
#define MK_STR2(x) #x
#define MK_STR(x) MK_STR2(x)
#ifndef MK_REP_P1X
#define MK_REP_P1X 1
#endif
#ifndef MK_REP_P1B
#define MK_REP_P1B 1
#endif
#ifndef MK_REP_GEMV
#define MK_REP_GEMV 1
#endif
#ifndef MK_REP_QUANT
#define MK_REP_QUANT 1
#endif
#ifndef MK_REP_TRANS
#define MK_REP_TRANS 1
#endif
#ifndef MK_REP_LO
#define MK_REP_LO 0
#define MK_REP_HI 0
#endif

__global__ void __launch_bounds__(NWAVES * 64, 2) mk_fwd(Args args) {
    extern __shared__ __attribute__((aligned(16))) unsigned char lds_raw[];
    LAS unsigned char* lds = (LAS unsigned char*)lds_raw;
    const int tid = threadIdx.x, wave = __builtin_amdgcn_readfirstlane(tid >> 6);
#define LANE_HERE int lane; asm volatile("v_mbcnt_lo_u32_b32 %0, -1, 0\n\tv_mbcnt_hi_u32_b32 %0, -1, %0" : "=v"(lane))
    const int G = gridDim.x, bx = blockIdx.x;
    const int vcu = (G % 8 == 0) ? (bx % 8) * (G / 8) + bx / 8 : bx;
    const int gw = vcu * NWAVES + wave, NGW = G * NWAVES;
    unsigned char* ws = args.ws;
    gu32* ctl = (gu32*)(ws + WS_CTL);
    const float* x = args.in[0]; const float* cvec = args.in[1]; const float* w_mod = args.in[2]; const float* b_mod = args.in[3];
    const float* g1 = args.in[4]; const float* w1i = args.in[5]; const float* w1o = args.in[6]; const float* gm = args.in[7];
    const float* w_in = args.in[8]; const float* conv_w = args.in[9]; const float* conv_b = args.in[10]; const float* ln_g = args.in[11]; const float* ln_b = args.in[12];
    const float* rw = args.in[13]; const float* rb = args.in[14]; const float* wa = args.in[15]; const float* b_a = args.in[16];
    const float* wi = args.in[17]; const float* b_i = args.in[18]; const float* lam = args.in[19]; const float* w_out = args.in[20];
    const float* g2 = args.in[21]; const float* w2i = args.in[22]; const float* w2o = args.in[23]; const float* w_fmod = args.in[24];
    const float* b_fmod = args.in[25]; const float* gf = args.in[26];
    float* out = args.out;
    float* MOD = (float*)(ws + WS_MOD); float* SHMAX3 = (float*)(ws + WS_BIAS1); float* BIAS2 = (float*)(ws + WS_BIAS2);
    bf16* WGT = (bf16*)(ws + WS_WGT); f32x2* TOT = (f32x2*)(ws + WS_TOT); float* SSP = (float*)(ws + WS_SSP);
    bf16 *W1O = (bf16*)(ws + WS_W1O), *WIN = (bf16*)(ws + WS_WIN), *WOUT = (bf16*)(ws + WS_WOUT), *W2O = (bf16*)(ws + WS_W2O);
    unsigned char *W1O8F = ws + WS_W1O, *W2O8F = ws + WS_W2O, *W1I8 = ws + WS_W1I, *W2I8 = ws + WS_W2I, *WIN8 = ws + WS_WIN, *A8 = ws + WS_Y;
    float *CS1 = (float*)(ws + WS_CS1), *CS3 = (float*)(ws + WS_CS3), *CS2 = (float*)(ws + WS_CS2), *RS1 = (float*)(ws + WS_RS1), *RS3 = (float*)(ws + WS_RS3), *RS2 = (float*)(ws + WS_RS2);
    bf16 *Y = (bf16*)(ws + WS_Y), *ACT = (bf16*)(ws + WS_ACT), *U = (bf16*)(ws + WS_U), *UXB = (bf16*)(ws + WS_UX), *GYB = (bf16*)(ws + WS_GY), *YMIX = (bf16*)(ws + WS_YMIX);
    bf16* X1 = (bf16*)(ws + WS_X1);

    for (int u = tid; u < (LDS_BYTES - LDSCTL_OFF) / 4; u += NWAVES * 64) ((LAS unsigned*)(lds + LDSCTL_OFF))[u] = 0u;
    __syncthreads();
    const int lo = args.ph_lo, hi = args.ph_hi;
    const bool use_bar = (hi - lo) > 1;
    XcdBarrier bar; bar.bar = (unsigned*)(ctl + CW_BAR); bar.x = 0; bar.st = nullptr;
    if (use_bar) bar = xcd_barrier_post((unsigned*)(ctl + CW_BAR), (volatile LAS unsigned*)(lds + LDSCTL_OFF) + 8);
#define IN(k) (lo <= (k) && (k) < hi)
#define REPS(k) ((MK_REP_LO <= (k) && (k) < MK_REP_HI) ? 2 : 1)
#define AGAIN(k, rr) do { if ((rr) + 1 < REPS(k)) xcd_barrier(bar); } while (0)
#define SEAM(k) do { if (IN(k) && IN((k) + 1)) xcd_barrier(bar); } while (0)

    if (IN(0))
_Pragma("unroll")
    for (int rr = 0; rr < REPS(0); ++rr) { LANE_HERE;
#ifdef MK_PAD
        asm volatile(".rept " MK_STR(MK_PAD) "\n\ts_nop 0\n\t.endr" ::: "memory");
#endif
        constexpr int NGEMV = 88, NQ = 2 * (FF2 / 32);
        constexpr int I_1O = (FF / 64) * (D / 32), I_IN = (D / 64) * (NMIX / 32), I_OUT = (D / 64) * (D / 32);
        constexpr int NITEMS = 2 * I_1O + I_IN + I_OUT, NGRP = NITEMS / NWAVES;
        static_assert(NITEMS % NWAVES == 0, "transpose groups");
        auto quant = [&](int it) { if (it < FF2 / 32) p0_quant_item(lds, w1i, FF2, 1, W1I8, CS1, it, lane, wave); else p0_quant_item(lds, w2i, FF2, 1, W2I8, CS3, it - FF2 / 32, lane, wave); };
        auto group = [&](int gidx) { LAS float* scr = (LAS float*)(lds + wave * 16384); const int r = gidx * NWAVES + wave;
            if (r < I_1O) p0_transpose8_item(w1o, FF, D, W1O8F, scr, r, lane);
            else if (r < 2 * I_1O) p0_transpose8_item(w2o, FF, D, W2O8F, scr, r - I_1O, lane);
            else if (r < 2 * I_1O + I_IN) p0_transpose_item(w_in, D, NMIX, WIN, 2, scr, r - 2 * I_1O, lane);
            else p0_transpose_item(w_out, D, D, WOUT, 0, scr, r - 2 * I_1O - I_IN, lane); };
        if (G == 256) {
            if (bx < NGEMV) {
                if (bx < 72) p0_gemv(lds, cvec, w_mod, 9 * D, b_mod, MOD, 128 * bx, tid); else p0_gemv(lds, cvec, w_fmod, 2 * D, b_fmod, MOD + 9 * D, 128 * (bx - 72), tid);
                quant(bx);
            } else { const int j = bx - NGEMV;
                quant(NGEMV + j);
                if (j < 96) { quant(256 + j); group(2 * j); group(2 * j + 1); }
                else { const int g0 = 192 + 5 * (j - 96);
                    for (int q = 0; q < 5; ++q) if (g0 + q < NGRP) group(g0 + q); }
            }
        } else {
            for (int t = bx; t < NGEMV; t += G) { if (t < 72) p0_gemv(lds, cvec, w_mod, 9 * D, b_mod, MOD, 128 * t, tid); else p0_gemv(lds, cvec, w_fmod, 2 * D, b_fmod, MOD + 9 * D, 128 * (t - 72), tid); }
            for (int t = bx; t < NQ; t += G) quant(t);
            for (int t = bx; t < NGRP; t += G) group(t);
        }
        __syncthreads();
        for (int i = bx * 512 + tid; i < NB * 64 * DR / 2; i += G * 512) ((v4u*)TOT)[i] = (v4u){0u, 0u, 0u, 0u};
        for (int i = bx * 512 + tid; i < NH * 128 * HD; i += G * 512) { const int d = i & 63, e2 = (i >> 6) & 127, hd = i >> 13;
            const float v = e2 < 64 ? wa[(hd * 64 + d) * 64 + e2] : wi[(hd * 64 + d) * 64 + (e2 - 64)]; WGT[i] = (bf16)f2bf(v); }
        AGAIN(0, rr);
    }
    SEAM(0);
    if (IN(1))
_Pragma("unroll")
    for (int rr = 0; rr < REPS(1); ++rr) { LANE_HERE;
        LAS float* shl = (LAS float*)lds;
        for (int i = tid * 4; i < 3 * NB * D; i += 2048) { const int t = i >> 13, r = i & 8191, b = r >> 10, k = r & 1023; *(LAS f32x4*)(shl + i) = *(const f32x4*)(MOD + (size_t)b * LDM + 3 * t * D + k); }
        __syncthreads();
        for (int rp = 0; rp < MK_REP_P1X; ++rp)
        for (int m0 = gw; m0 < M; m0 += 2 * NGW) {
            f32x4 v[2][4];
#pragma unroll
            for (int rr2 = 0; rr2 < 2; ++rr2) { const int m = (m0 + rr2 * NGW < M) ? m0 + rr2 * NGW : m0; const f32x4* xr = (const f32x4*)(x + (size_t)m * D) + lane;
#pragma unroll
                for (int jj = 0; jj < 4; ++jj) v[rr2][jj] = xr[64 * jj]; }
#pragma unroll
            for (int rr2 = 0; rr2 < 2; ++rr2) { const int m = m0 + rr2 * NGW; if (m < M) { const int b = m >> 12;
                float s = 0.f, am = 0.f;
#pragma unroll
                for (int jj = 0; jj < 4; ++jj) s += (v[rr2][jj][0] * v[rr2][jj][0] + v[rr2][jj][1] * v[rr2][jj][1]) + (v[rr2][jj][2] * v[rr2][jj][2] + v[rr2][jj][3] * v[rr2][jj][3]);
                const float rstd = rsqrtf(wave_sum(s) * (1.0f / D) + EPS);
#pragma unroll
                for (int jj = 0; jj < 4; ++jj) { const int k = 4 * lane + 256 * jj;
                    v[rr2][jj] = v[rr2][jj] * (*(const f32x4*)(g1 + k) * (*(const f32x4*)(MOD + (size_t)b * LDM + 1 * D + k) + 1.0f) * rstd) + *(const LAS f32x4*)(shl + (0 * NB + b) * D + k);
                    const f32x4 t = __builtin_elementwise_abs(v[rr2][jj]); am = fmaxf(am, fmaxf(fmaxf(t[0], t[1]), fmaxf(t[2], t[3]))); }
                am = wave_max(am);
                const float q = am > 0.f ? 127.0f / am : 0.f;
#pragma unroll
                for (int jj = 0; jj < 4; ++jj) *(unsigned*)(A8 + (size_t)m * D + 4 * lane + 256 * jj) = q8x4(v[rr2][jj] * q);
                if (lane == 0) RS1[m] = am * (1.0f / 127.0f); } }
        }
        for (int rp = 0; rp < MK_REP_P1B; ++rp)
        if (gw < NB) { float a = 0.f;
            for (int k = lane; k < D; k += 64) a = fmaxf(a, fabsf(shl[(2 * NB + gw) * D + k]));
            a = wave_max(a); if (lane == 0) SHMAX3[gw] = a; }
        for (int it = gw; it < NMIX; it += NGW) {
            {
                const bf16* wrow = WIN + (size_t)it * D; float* op = BIAS2 + it;
                const v4u wA = *(const v4u*)(wrow + 8 * lane), wB = *(const v4u*)(wrow + 512 + 8 * lane);
                f32x4 a0, a1, c0, c1; unpack8(wA, a0, a1); unpack8(wB, c0, c1);
#pragma unroll
                for (int b = 0; b < NB; ++b) { const LAS float* sp = shl + (1 * NB + b) * D + 8 * lane;
                    const f32x4 p = a0 * *(const LAS f32x4*)(sp) + a1 * *(const LAS f32x4*)(sp + 4) + c0 * *(const LAS f32x4*)(sp + 512) + c1 * *(const LAS f32x4*)(sp + 516);
                    const float tot = wave_sum((p[0] + p[1]) + (p[2] + p[3]));
                    if (lane == 0) op[(size_t)b * NMIX] = tot; }
            }
        }
        __syncthreads();
        AGAIN(1, rr);
    }
    SEAM(1);
    if (IN(2))
_Pragma("unroll")
    for (int rr = 0; rr < REPS(2); ++rr) {
        pg8::Gemm g{(const pg8::bf16_t*)A8, (const pg8::bf16_t*)W1I8, M, FF2, D / 2}; pg8::StaticOrder S; S.init(M, FF2, G, bx);
        EpiSwiglu8<true> E{ACT, RS1, CS1};
        pg8::gemm_phase<EpiSwiglu8<true>, pg8::StaticOrder, true, true, 1>(lds, g, S, E);
        AGAIN(2, rr);
    }
    SEAM(2);
    if (IN(3))
_Pragma("unroll")
    for (int rr = 0; rr < REPS(3); ++rr) {
        pg8::Gemm g{ACT, (const pg8::bf16_t*)W1O8F, M, D, FF / 2}; pg8::StaticOrder S; S.init(M, D, G, bx);
        EpiResid<1, true, false, true> E{x, X1, Y, SSP, MOD + 2 * D, gm, MOD + 4 * D};
        pg8::gemm_phase<EpiResid<1, true, false, true>, pg8::StaticOrder, true, true, 2>(lds, g, S, E);
        AGAIN(3, rr);
    }
    SEAM(3);
    if (IN(4))
_Pragma("unroll")
    for (int rr = 0; rr < REPS(4); ++rr) {
        pg8::Gemm g{Y, WIN, M, NMIX, D}; pg8::StaticOrder S; S.init(M, NMIX, G, bx);
        EpiMixIn E{U, UXB, GYB, SSP, BIAS2};
        pg8::gemm_phase<EpiMixIn, pg8::StaticOrder, true, true>(lds, g, S, E);
        AGAIN(4, rr);
    }
    SEAM(4);
    if (IN(5))
_Pragma("unroll")
    for (int rr = 0; rr < REPS(5); ++rr) { LANE_HERE;
        { PROF_BEGIN(0); mix_conv2(lds, U, conv_w, conv_b, ln_g, ln_b, YMIX, G, bx, tid, lane, wave); PROF_END(0); }
#ifdef MK_REP_CONV
        mix_conv2(lds, U, conv_w, conv_b, ln_g, ln_b, YMIX, G, bx, tid, lane, wave);
#endif
        { PROF_BEGIN(1); mix_scan1(lds, UXB, GYB, WGT, rw, rb, b_a, b_i, lam, TOT, (unsigned*)(ctl + CW_SCAN), YMIX, G, bx, lane, wave); PROF_END(1); }
        AGAIN(5, rr);
    }
    SEAM(5);
    if (IN(7))
_Pragma("unroll")
    for (int rr = 0; rr < REPS(7); ++rr) {
        pg8::Gemm g{YMIX, WOUT, M, D, D}; pg8::StaticOrder S; S.init(M, D, G, bx);
        EpiResidQ<0, true> E{X1, X1, A8, RS3, (f32x2*)(ws + WS_SSPX), MOD + 5 * D, g2, MOD + 7 * D, MOD + 6 * D, SHMAX3, (unsigned*)(ctl + CW_SEAM7)};
        pg8::gemm_phase<EpiResidQ<0, true>, pg8::StaticOrder, true, true>(lds, g, S, E);
        AGAIN(7, rr);
    }
    SEAM(7);
    if (IN(8))
_Pragma("unroll")
    for (int rr = 0; rr < REPS(8); ++rr) {
        pg8::Gemm g{(const pg8::bf16_t*)A8, (const pg8::bf16_t*)W2I8, M, FF2, D / 2}; pg8::StaticOrder S; S.init(M, FF2, G, bx);
        EpiSwiglu8<true> E{ACT, RS3, CS3};
        pg8::gemm_phase<EpiSwiglu8<true>, pg8::StaticOrder, true, true, 1>(lds, g, S, E);
        AGAIN(8, rr);
    }
    SEAM(8);
    if (IN(9))
_Pragma("unroll")
    for (int rr = 0; rr < REPS(9); ++rr) {
        pg8::Gemm g{ACT, (const pg8::bf16_t*)W2O8F, M, D, FF / 2}; pg8::StaticOrder S; S.init(M, D, G, bx);
        EpiResidFinal<true> E{X1, out, (float*)(ws + WS_SSPF), MOD + 8 * D, gf, MOD + 10 * D, MOD + 9 * D, (unsigned*)(ctl + CW_SEAM)};
        pg8::gemm_phase<EpiResidFinal<true>, pg8::StaticOrder, true, true, 2>(lds, g, S, E);
    }
#ifdef MK_PROF_ID
    __syncthreads();
    if (bx == MK_PROF_WG && tid == 0) { const unsigned d = ((LAS unsigned*)(lds + LDSCTL_OFF))[40 + MK_PROF_ID]; const unsigned long long t0 = PROF_T(); while (PROF_T() - t0 < (unsigned long long)d * MK_PROF_K) __builtin_amdgcn_s_sleep(8); }
#endif
#undef IN
#undef SEAM
#undef REPS
#undef AGAIN
}

extern "C" void kernel_launch(void* const* d_in, const int* in_sizes, int n_in, void* d_out, int out_size, void* d_ws, size_t ws_size, hipStream_t stream) {
    static int grid = 0;
    if (grid == 0) {
        if (n_in != 27 || in_sizes[0] != M * D || out_size != M * D || ws_size < WS_END) { fprintf(stderr, "kernel_launch: unexpected shapes (n_in %d, in0 %d, out %d, ws %zu)\n", n_in, n_in > 0 ? in_sizes[0] : -1, out_size, ws_size); grid = -1; return; }
        int dev = 0, cus = 0, per_cu = 0;
        if (hipGetDevice(&dev) != hipSuccess || hipDeviceGetAttribute(&cus, hipDeviceAttributeMultiprocessorCount, dev) != hipSuccess) { grid = -1; return; }
        if (hipFuncSetAttribute((const void*)mk_fwd, hipFuncAttributeMaxDynamicSharedMemorySize, LDS_BYTES) != hipSuccess) { fprintf(stderr, "kernel_launch: hipFuncSetAttribute failed\n"); grid = -1; return; }
        if (hipOccupancyMaxActiveBlocksPerMultiprocessor(&per_cu, (const void*)mk_fwd, NWAVES * 64, LDS_BYTES) != hipSuccess || per_cu < 1) fprintf(stderr, "kernel_launch: occupancy query reports %d blocks per CU\n", per_cu);
        (void)hipGetLastError();
        grid = cus;
        if (grid % 8 != 0 || grid < 8) { fprintf(stderr, "kernel_launch: %d CUs: the scan's chunk rounds need a multiple of 8 workgroups\n", grid); grid = -1; return; }
    }
    if (grid < 0) return;
    if (hipMemsetAsync((char*)d_ws + WS_CTL, 0, CTL_ZERO_BYTES, stream) != hipSuccess) return;
    Args a{};
    for (int i = 0; i < 27; ++i) a.in[i] = (const float*)d_in[i];
    a.out = (float*)d_out; a.ws = (unsigned char*)d_ws;
#if MK_PER_PHASE
    for (int p = 0; p < NPH; ++p) { a.ph_lo = p; a.ph_hi = p + 1; hipLaunchKernelGGL(mk_fwd, dim3(grid), dim3(NWAVES * 64), LDS_BYTES, stream, a); }
#else
    a.ph_lo = 0; a.ph_hi = NPH; hipLaunchKernelGGL(mk_fwd, dim3(grid), dim3(NWAVES * 64), LDS_BYTES, stream, a);
#endif
}
```

```cpp
#include <hip/hip_runtime.h>
#include <cstdio>
#include <cstdint>
#ifndef MK_PROF_SEAM
#define MK_PROF_SEAM 99
#endif
#ifndef MK_PROF_PH
#define MK_PROF_PH 99
#endif
#ifdef MK_PROF_ID
#define PROF_W(i) ((__attribute__((address_space(3))) unsigned*)(unsigned)(147200) + (i))
#define PROF_T() __builtin_amdgcn_s_memrealtime()
#define PROF_BEGIN(id) do { if ((id) == MK_PROF_ID && threadIdx.x == 0) *PROF_W(10 + (id)) = (unsigned)PROF_T(); } while (0)
#define PROF_END(id) do { if ((id) == MK_PROF_ID && threadIdx.x == 0) *PROF_W(40 + (id)) += (unsigned)PROF_T() - *PROF_W(10 + (id)); } while (0)
#define PROF_SETPH(k) do { if ((MK_PROF_ID == 15 || MK_PROF_ID == 16) && threadIdx.x == 0) *PROF_W(39) = (k); } while (0)
#define PROF_END_PH(id) do { if ((id) == MK_PROF_ID && threadIdx.x == 0 && *PROF_W(39) == MK_PROF_PH) *PROF_W(40 + (id)) += (unsigned)PROF_T() - *PROF_W(10 + (id)); } while (0)
#else
#define PROF_BEGIN(id)
#define PROF_END(id)
#define PROF_SETPH(k)
#define PROF_END_PH(id)
#endif
#if defined(MK_PROF_ID) && MK_PROF_ID == 16
#define PROF16_BEGIN PROF_BEGIN(16)
#define PROF16_END PROF_END_PH(16)
#else
#define PROF16_BEGIN
#define PROF16_END
#endif
namespace pg8 {
#define PG8_LAS __attribute__((address_space(3)))
typedef unsigned short bf16_t;
typedef short bf16x8 __attribute__((ext_vector_type(8)));
typedef float f32x4 __attribute__((ext_vector_type(4)));
typedef unsigned u32x4 __attribute__((ext_vector_type(4)));
constexpr int BM = 256, BK = 64, HALF = 128, HTB = HALF * BK * 2  , STAGE_BYTES = 8 * HTB, NXCD = 8, WGM = 8;

__host__ __device__ __forceinline__ int lds_byte(int r, int c) { const int st = (r >> 4) * 2 + (c >> 5), rr = r & 15, cc = c & 31, ob = rr * 64 + cc * 2; return st * 1024 + (ob ^ (((ob >> 9) & 1) << 5)); }
__host__ __device__ __forceinline__ void stage_rc(int b, int& R, int& C) { const int st = b / 1024, sb = b % 1024, swz = sb ^ (((sb >> 9) & 1) << 5); R = (st >> 1) * 16 + swz / 64; C = (st & 1) * 32 + (swz % 64) / 2; }
__host__ __device__ __forceinline__ int perm32(int rho) { const int n = rho >> 4, i = rho & 15; return 8 * (i >> 2) + 4 * n + (i & 3); }

struct Unit { int pm, pn; };
struct Gemm { const bf16_t* A; const bf16_t* Bt; int M, N, K; };

struct StaticOrder {
    int nM, nN, nwg, G, c;
    __host__ __device__ void init(int M, int N, int G_, int c_) { nM = M / BM; nN = N / BM; nwg = nM * nN; G = G_; c = c_; }
    __host__ __device__ bool next(int i, Unit& u) const {
        const long L = (long)i * G + c; if (L >= nwg) return false;
        int wgid = (int)L; { const int q = nwg / NXCD, r = nwg % NXCD, xcd = wgid % NXCD, off = wgid / NXCD; wgid = (xcd < r ? xcd * (q + 1) : r * (q + 1) + (xcd - r) * q) + off; }
        const int nig = WGM * nN, gid = wgid / nig, fm = gid * WGM, gsz = (nM - fm) < WGM ? (nM - fm) : WGM;
        u.pm = fm + ((wgid % nig) % gsz); u.pn = (wgid % nig) / gsz; return true;
    }
    __device__ __forceinline__ void a_ready(const Unit&) const {}
    __device__ __forceinline__ void done(const Unit&) const {}
};

__device__ __forceinline__ unsigned cvt_pk_bf16(float lo, float hi) { unsigned r; asm volatile("v_cvt_pk_bf16_f32 %0, %1, %2" : "=v"(r) : "v"(lo), "v"(hi)); return r; }
#ifndef PG8_STAGE_IN_MMA
#define PG8_STAGE_IN_MMA 0
#endif
typedef int i32x4 __attribute__((ext_vector_type(4)));
typedef int i32x8 __attribute__((ext_vector_type(8)));
__device__ __forceinline__ i32x8 cat32(const bf16x8 lo, const bf16x8 hi) { const i32x4 p = __builtin_bit_cast(i32x4, lo), q = __builtin_bit_cast(i32x4, hi); return (i32x8){p.x, p.y, p.z, p.w, q.x, q.y, q.z, q.w}; }
__device__ __forceinline__ f32x4 mma_mx8(const i32x8 B, const i32x8 A, const f32x4 c) { return __builtin_amdgcn_mfma_scale_f32_16x16x128_f8f6f4(B, A, c, 0, 0, 0, 0x7F7F7F7F, 0, 0x7F7F7F7F); }
template <int I8> __device__ __forceinline__ f32x4 mma16(const bf16x8 b, const bf16x8 a, const f32x4 c) {
    if constexpr (I8 == 1) return __builtin_bit_cast(f32x4, __builtin_amdgcn_mfma_i32_16x16x64_i8(__builtin_bit_cast(i32x4, b), __builtin_bit_cast(i32x4, a), __builtin_bit_cast(i32x4, c), 0, 0, 0));
    else return __builtin_amdgcn_mfma_f32_16x16x32_bf16(b, a, c, 0, 0, 0);
}
template <class Epi, class Sched, bool ALIGN_EPI = false, bool SP2 = false, int I8 = 0>
__device__ __forceinline__ void gemm_phase(PG8_LAS unsigned char* lds, const Gemm g, const Sched& S, const Epi& E) {
    const int tid = threadIdx.x, wid = __builtin_amdgcn_readfirstlane(tid >> 6), lane = tid & 63, wr = wid >> 2, wc = wid & 3, fr = lane & 15, fq = lane >> 4;
    const int K = g.K, nt = K / BK;
    unsigned voffA[1], voffB[1];
    { int R, C; stage_rc(tid * 16, R, C); const int Rb = Epi::PERM ? ((R & ~31) + perm32(R & 31)) : R;
        voffA[0] = (unsigned)(R * K + C) * 2u; voffB[0] = (unsigned)(Rb * K + C) * 2u; }
    const size_t r64 = (size_t)64 * K * 2;
    const size_t kstep = (size_t)(BK * 2);
    const size_t hstep = (size_t)HALF * K * 2;
    const size_t tstep = 2 * hstep;
    const unsigned ldsw = (unsigned)wid * 1024u;
    const int aoff = lds_byte(wr * 64 + fr, fq * 8), boff = lds_byte(wc * 32 + fr, fq * 8);
#define PG8_SA(b, h) (((b) * 2 + (h)) * HTB)
#define PG8_SB(b, h) ((4 + (b) * 2 + (h)) * HTB)
#define PG8_STAGE(bufoff, gbase, voff) do { _Pragma("unroll") for (int _i = 0; _i < 2; ++_i) \
        __builtin_amdgcn_global_load_lds((const unsigned*)((const char*)(gbase) + _i * r64 + (voff)[0]), (PG8_LAS unsigned*)(lds + (bufoff) + ldsw + _i * 8192), 16, 0, 0); } while (0)
#define PG8_LDA(dst, b, h) do { _Pragma("unroll") for (int m = 0; m < 4; ++m) { if constexpr (I8 == 2) dst##8[m] = cat32(*(const PG8_LAS bf16x8*)(lds + PG8_SA(b, h) + aoff + m * 2048), *(const PG8_LAS bf16x8*)(lds + PG8_SA(b, h) + aoff + m * 2048 + 1024)); \
        else { _Pragma("unroll") for (int k = 0; k < 2; ++k) dst[m][k] = *(const PG8_LAS bf16x8*)(lds + PG8_SA(b, h) + aoff + m * 2048 + k * 1024); } } } while (0)
#define PG8_LDB(dst, b, h) do { _Pragma("unroll") for (int n = 0; n < 2; ++n) { if constexpr (I8 == 2) dst##8[n] = cat32(*(const PG8_LAS bf16x8*)(lds + PG8_SB(b, h) + boff + n * 2048), *(const PG8_LAS bf16x8*)(lds + PG8_SB(b, h) + boff + n * 2048 + 1024)); \
        else { _Pragma("unroll") for (int k = 0; k < 2; ++k) dst[n][k] = *(const PG8_LAS bf16x8*)(lds + PG8_SB(b, h) + boff + n * 2048 + k * 1024); } } } while (0)
#define PG8_MMA(ai, bj, At, Bt) do { __builtin_amdgcn_s_setprio(1); _Pragma("unroll") for (int m = 0; m < 4; ++m) _Pragma("unroll") for (int n = 0; n < 2; ++n) { \
        if constexpr (I8 == 2) acc[ai][bj][m][n] = mma_mx8(Bt##8[n], At##8[m], acc[ai][bj][m][n]); \
        else { _Pragma("unroll") for (int k = 0; k < 2; ++k) acc[ai][bj][m][n] = mma16<I8>(Bt[n][k], At[m][k], acc[ai][bj][m][n]); } } __builtin_amdgcn_s_setprio(0); } while (0)
#define PG8_WAIT_V(n) asm volatile("s_waitcnt vmcnt(" #n ")" ::: "memory")
#define PG8_WAIT_L(n) asm volatile("s_waitcnt lgkmcnt(" #n ")" ::: "memory")
#define PG8_BAR __builtin_amdgcn_s_barrier()
#define PG8_SCHED __builtin_amdgcn_sched_barrier(0)
    Unit cur, nxt; int ui = 0;
    if (!S.next(0, cur)) return;
    f32x4 acc[2][2][4][2];
#pragma unroll
    for (int a = 0; a < 2; ++a)
#pragma unroll
        for (int b = 0; b < 2; ++b)
#pragma unroll
            for (int m = 0; m < 4; ++m)
#pragma unroll
                for (int n = 0; n < 2; ++n) acc[a][b][m][n] = (f32x4){0.f, 0.f, 0.f, 0.f};
    bf16x8 At[4][2], B0[2][2], B1[2][2]; i32x8 At8[4], B08[2], B18[2];
    const char* cA = (const char*)g.A + (size_t)cur.pm * tstep; const char* cB = (const char*)g.Bt + (size_t)cur.pn * tstep;
    S.a_ready(cur);
    if constexpr (SP2) {
        PG8_STAGE(PG8_SB(0, 0), cB, voffB); PG8_STAGE(PG8_SB(0, 1), cB + hstep, voffB); PG8_STAGE(PG8_SA(0, 0), cA, voffA); PG8_STAGE(PG8_SA(0, 1), cA + hstep, voffA);
        if (wr == 1) PG8_BAR;
        PG8_WAIT_V(2); PG8_BAR;
        PG8_STAGE(PG8_SB(1, 0), cB + kstep, voffB); PG8_STAGE(PG8_SA(1, 0), cA + kstep, voffA); PG8_STAGE(PG8_SB(1, 1), cB + hstep + kstep, voffB);
        PG8_WAIT_V(6); PG8_BAR;
    } else {
        PG8_STAGE(PG8_SB(0, 0), cB, voffB); PG8_STAGE(PG8_SA(0, 0), cA, voffA); PG8_STAGE(PG8_SB(0, 1), cB + hstep, voffB); PG8_STAGE(PG8_SA(0, 1), cA + hstep, voffA);
        if (wr == 1) PG8_BAR;
        PG8_WAIT_V(4); PG8_BAR;
        PG8_STAGE(PG8_SB(1, 0), cB + kstep, voffB); PG8_STAGE(PG8_SA(1, 0), cA + kstep, voffA); PG8_STAGE(PG8_SB(1, 1), cB + hstep + kstep, voffB);
        PG8_WAIT_V(6); PG8_BAR;
    }
    for (;;) {
        const bool has_next = S.next(ui + 1, nxt);
        const char* nA = has_next ? (const char*)g.A + (size_t)nxt.pm * tstep : cA; const char* nB = has_next ? (const char*)g.Bt + (size_t)nxt.pn * tstep : cB;
        asm volatile(".p2align 8" ::: "memory");
        for (int t = 0; t < nt; t += 2) {
            const bool last = (t == nt - 2);
            const char* a1 = cA + (size_t)(t + 1) * kstep;
            const char* a2 = last ? nA : cA + (size_t)(t + 2) * kstep; const char* b2 = last ? nB : cB + (size_t)(t + 2) * kstep;
            const char* a3 = a2 + kstep; const char* b3 = b2 + kstep;
            if (last && has_next) S.a_ready(nxt);
            if constexpr (SP2) {
#if PG8_STAGE_IN_MMA
            PG8_LDB(B0, 0, 0); PG8_LDB(B1, 0, 1); PG8_SCHED; PG8_LDA(At, 0, 0);
            PG8_WAIT_V(6); PG8_WAIT_L(0); PG8_BAR; PG8_MMA(0, 0, At, B0); PG8_SCHED; PG8_STAGE(PG8_SA(1, 1), a1 + hstep, voffA); PG8_SCHED; PG8_MMA(0, 1, At, B1); PG8_BAR; PG8_SCHED;
            PG8_LDA(At, 0, 1);
            PG8_WAIT_V(2); PG8_WAIT_L(0); PG8_BAR; PG8_STAGE(PG8_SB(0, 0), b2, voffB); PG8_SCHED; PG8_MMA(1, 0, At, B0); PG8_SCHED; PG8_STAGE(PG8_SB(0, 1), b2 + hstep, voffB); PG8_SCHED; PG8_MMA(1, 1, At, B1); PG8_SCHED; PG8_STAGE(PG8_SA(0, 0), a2, voffA); PG8_BAR; PG8_SCHED;
            PG8_LDB(B0, 1, 0); PG8_LDB(B1, 1, 1); PG8_SCHED; PG8_LDA(At, 1, 0);
            PG8_WAIT_V(6); PG8_WAIT_L(0); PG8_BAR; PG8_MMA(0, 0, At, B0); PG8_SCHED; PG8_STAGE(PG8_SA(0, 1), a2 + hstep, voffA); PG8_SCHED; PG8_MMA(0, 1, At, B1); PG8_BAR; PG8_SCHED;
            PG8_LDA(At, 1, 1);
            PG8_WAIT_V(2); PG8_WAIT_L(0); PG8_BAR; PG8_STAGE(PG8_SB(1, 0), b3, voffB); PG8_SCHED; PG8_MMA(1, 0, At, B0); PG8_SCHED; PG8_STAGE(PG8_SB(1, 1), b3 + hstep, voffB); PG8_SCHED; PG8_MMA(1, 1, At, B1); PG8_SCHED; PG8_STAGE(PG8_SA(1, 0), a3, voffA); PG8_BAR; PG8_SCHED;
#else
            PG8_LDB(B0, 0, 0); PG8_LDB(B1, 0, 1); PG8_SCHED; PG8_LDA(At, 0, 0); PG8_STAGE(PG8_SA(1, 1), a1 + hstep, voffA);
            PG8_WAIT_V(8); PG8_WAIT_L(0); PG8_BAR; PG8_MMA(0, 0, At, B0); PG8_MMA(0, 1, At, B1); PG8_BAR; PG8_SCHED;
            PG8_LDA(At, 0, 1); PG8_STAGE(PG8_SB(0, 0), b2, voffB); PG8_STAGE(PG8_SB(0, 1), b2 + hstep, voffB); PG8_STAGE(PG8_SA(0, 0), a2, voffA);
            PG8_WAIT_V(8); PG8_WAIT_L(0); PG8_BAR; PG8_MMA(1, 0, At, B0); PG8_MMA(1, 1, At, B1); PG8_BAR; PG8_SCHED;
            PG8_LDB(B0, 1, 0); PG8_LDB(B1, 1, 1); PG8_SCHED; PG8_LDA(At, 1, 0); PG8_STAGE(PG8_SA(0, 1), a2 + hstep, voffA);
            PG8_WAIT_V(8); PG8_WAIT_L(0); PG8_BAR; PG8_MMA(0, 0, At, B0); PG8_MMA(0, 1, At, B1); PG8_BAR; PG8_SCHED;
            PG8_LDA(At, 1, 1); PG8_STAGE(PG8_SB(1, 0), b3, voffB); PG8_STAGE(PG8_SB(1, 1), b3 + hstep, voffB); PG8_STAGE(PG8_SA(1, 0), a3, voffA);
            PG8_WAIT_V(8); PG8_WAIT_L(0); PG8_BAR; PG8_MMA(1, 0, At, B0); PG8_MMA(1, 1, At, B1); PG8_BAR; PG8_SCHED;
#endif
            } else {
            PG8_LDB(B0, 0, 0); PG8_SCHED; PG8_LDA(At, 0, 0); PG8_STAGE(PG8_SA(1, 1), a1 + hstep, voffA);
            PG8_WAIT_L(8); PG8_BAR; PG8_WAIT_L(0); PG8_MMA(0, 0, At, B0); PG8_BAR; PG8_SCHED;
            PG8_LDB(B1, 0, 1); PG8_STAGE(PG8_SB(0, 0), b2, voffB);
            PG8_BAR; PG8_WAIT_L(0); PG8_MMA(0, 1, At, B1); PG8_BAR;
            PG8_LDA(At, 0, 1); PG8_STAGE(PG8_SA(0, 0), a2, voffA);
            PG8_BAR; PG8_WAIT_L(0); PG8_MMA(1, 0, At, B0); PG8_BAR; PG8_SCHED;
            PG8_STAGE(PG8_SB(0, 1), b2 + hstep, voffB);
            PG8_WAIT_V(6); PG8_BAR; PG8_MMA(1, 1, At, B1); PG8_BAR;
            PG8_LDB(B0, 1, 0); PG8_SCHED; PG8_LDA(At, 1, 0); PG8_STAGE(PG8_SA(0, 1), a2 + hstep, voffA);
            PG8_WAIT_L(8); PG8_BAR; PG8_WAIT_L(0); PG8_MMA(0, 0, At, B0); PG8_BAR; PG8_SCHED;
            PG8_LDB(B1, 1, 1); PG8_STAGE(PG8_SB(1, 0), b3, voffB);
            PG8_BAR; PG8_WAIT_L(0); PG8_MMA(0, 1, At, B1); PG8_BAR;
            PG8_LDA(At, 1, 1); PG8_STAGE(PG8_SA(1, 0), a3, voffA);
            PG8_BAR; PG8_WAIT_L(0); PG8_MMA(1, 0, At, B0); PG8_BAR; PG8_SCHED;
            PG8_STAGE(PG8_SB(1, 1), b3 + hstep, voffB);
            PG8_WAIT_V(6); PG8_BAR; PG8_MMA(1, 1, At, B1); PG8_BAR;
            }
        }
        if constexpr (ALIGN_EPI) { if (wr == 0) PG8_BAR; }
        if constexpr (!Epi::AFTER_DRAIN) { int ln; asm volatile("v_mbcnt_lo_u32_b32 %0, -1, 0\n\tv_mbcnt_hi_u32_b32 %0, -1, %0" : "=v"(ln));     const int fr2 = ln & 15, fq2 = ln >> 4; _Pragma("unroll") for (int er = 0; er < Epi::REPS; ++er) { PROF16_BEGIN; E(acc, cur, wr, wc, fr2, fq2); PROF16_END; if (er + 1 < Epi::REPS) asm volatile("" ::: "memory"); } S.done(cur); }
        if (!has_next) break;
#pragma unroll
        for (int a = 0; a < 2; ++a)
#pragma unroll
            for (int b = 0; b < 2; ++b)
#pragma unroll
                for (int m = 0; m < 4; ++m)
#pragma unroll
                    for (int n = 0; n < 2; ++n) acc[a][b][m][n] = (f32x4){0.f, 0.f, 0.f, 0.f};
        cur = nxt; cA = nA; cB = nB; ++ui;
        if constexpr (ALIGN_EPI) { if (wr == 1) PG8_BAR; }
    }
    PG8_WAIT_V(0);
    if constexpr (!ALIGN_EPI) { if (wr == 0) PG8_BAR; }
    PG8_BAR;
    if constexpr (Epi::AFTER_DRAIN) { E.fused(acc, cur, wr, wc, fr, fq, lds, wid, lane); S.done(cur); }
#undef PG8_SA
#undef PG8_SB
#undef PG8_STAGE
#undef PG8_LDA
#undef PG8_LDB
#undef PG8_MMA
#undef PG8_WAIT_V
#undef PG8_WAIT_L
#undef PG8_BAR
#undef PG8_SCHED
}
}
#define GAS __attribute__((address_space(1)))
#define LAS __attribute__((address_space(3)))
typedef unsigned short bf16;
typedef unsigned v4u __attribute__((ext_vector_type(4)));
typedef float f32x4 __attribute__((ext_vector_type(4)));
typedef short bf16x8 __attribute__((ext_vector_type(8)));
typedef GAS unsigned gu32;
typedef GAS unsigned long long gu64;
#define RLX_AGENT __ATOMIC_RELAXED, __HIP_MEMORY_SCOPE_AGENT
#define LDS_WAIT() asm volatile("s_waitcnt lgkmcnt(0)" ::: "memory")
#define VM_WAIT() asm volatile("s_waitcnt vmcnt(0)" ::: "memory")
__device__ __forceinline__ unsigned long long rt() { return __builtin_amdgcn_s_memrealtime(); }
__device__ __forceinline__ unsigned f2bf(float f) { unsigned u = __builtin_bit_cast(unsigned, f); return (u + 0x7fffu + ((u >> 16) & 1u)) >> 16; }
__device__ __forceinline__ unsigned pk2(float lo, float hi) { return f2bf(lo) | (f2bf(hi) << 16); }

#define XB_TMO      128
#define XB_XCNT(j)  (256  + 64 * (j))
#define XB_XSUB(j)  (1280 + 64 * (j))
#define XB_XGEN(j)  (2304 + 64 * (j))
#define XB_TOP      3328
#define XB_TOPGEN   3392
#define XCD_BAR_WORDS 3456
#define XB_SPIN_CAP (1u << 18)

__device__ __forceinline__ unsigned xb_ld(unsigned* p)              { return __hip_atomic_load(p, __ATOMIC_RELAXED, __HIP_MEMORY_SCOPE_AGENT); }
__device__ __forceinline__ unsigned xb_add(unsigned* p, unsigned v) { return __hip_atomic_fetch_add(p, v, __ATOMIC_RELAXED, __HIP_MEMORY_SCOPE_AGENT); }
__device__ __forceinline__ unsigned xb_xcc_id() { return (unsigned)__builtin_amdgcn_s_getreg((3 << 11) | 20) & 0xFu; }
#define XB_SPIN(cond, bar) do { unsigned _sp = 0; while (cond) { __builtin_amdgcn_s_sleep(1); \
    if ((++_sp & 255u) == 0u) { if (xb_ld(&(bar)[XB_TMO])) break; if (_sp > XB_SPIN_CAP) { atomicAdd(&(bar)[XB_TMO], 1u); break; } } } } while (0)

struct XcdBarrier {
    unsigned* bar; unsigned x;
    volatile LAS unsigned* st;
};

__device__ __forceinline__ XcdBarrier xcd_barrier_post(unsigned* bar, volatile LAS unsigned* st) {
    XcdBarrier b; b.bar = bar; b.x = xb_xcc_id(); b.st = st;
    if (threadIdx.x == 0) (void)xb_add(&bar[XB_XCNT(b.x)], 1u);
    return b;
}
__device__ __forceinline__ void xcd_barrier_complete(unsigned* bar, unsigned x, unsigned& nloc, unsigned& nx) {
    const unsigned G = gridDim.x * gridDim.y * gridDim.z;
    unsigned sum, cnt, mine, sp = 0u;
    for (;;) {
        sum = 0u; cnt = 0u; mine = 0u;
#pragma unroll
        for (unsigned j = 0; j < 16; ++j) { const unsigned c = xb_ld(&bar[XB_XCNT(j)]); sum += c; cnt += (c > 0u) ? 1u : 0u; mine = (j == x) ? c : mine; }
        if (sum == G) break;
        __builtin_amdgcn_s_sleep(1);
        if ((++sp & 255u) == 0u) { if (xb_ld(&bar[XB_TMO])) break; if (sp > XB_SPIN_CAP) { atomicAdd(&bar[XB_TMO], 1u); break; } }
    }
    nloc = mine > 0u ? mine : 1u; nx = cnt > 0u ? cnt : 1u;
}

__device__ __forceinline__ void xcd_barrier(const XcdBarrier& b) {
    asm volatile("s_waitcnt vmcnt(0)" ::: "memory");
    __syncthreads();
    if (threadIdx.x == 0) {
        unsigned* bar = b.bar;
        __builtin_amdgcn_s_waitcnt(0);
        unsigned nloc = b.st[0], nx = b.st[1];
        if (nloc == 0u) { xcd_barrier_complete(bar, b.x, nloc, nx); b.st[0] = nloc; b.st[1] = nx; }
        const unsigned old = xb_add(&bar[XB_XSUB(b.x)], 1u);
        const unsigned gen = old / nloc;
        if (old + 1u == (gen + 1u) * nloc) {
            __builtin_amdgcn_fence(__ATOMIC_RELEASE, "agent");
            asm volatile("s_waitcnt vmcnt(0)" ::: "memory");
            const unsigned og = xb_add(&bar[XB_TOP], 1u);
            const unsigned tg = og / nx;
            if (og + 1u == (tg + 1u) * nx) xb_add(&bar[XB_TOPGEN], 1u);
            else XB_SPIN(xb_ld(&bar[XB_TOPGEN]) == tg, bar);
            __builtin_amdgcn_fence(__ATOMIC_ACQUIRE, "agent");
            xb_add(&bar[XB_XGEN(b.x)], 1u);
            asm volatile("s_waitcnt vmcnt(0)" ::: "memory");
        } else {
            XB_SPIN(xb_ld(&bar[XB_XGEN(b.x)]) == gen, bar);
            __builtin_amdgcn_fence(__ATOMIC_ACQUIRE, "agent");
            asm volatile("s_waitcnt vmcnt(0)" ::: "memory");
        }
    }
    __syncthreads();
}

constexpr int NWAVES = 8;
constexpr int NB = 8, SEQ = 4096, D = 1024, M = NB * SEQ, FF = 2816, FF2 = 2 * FF, DC = 512, DR = 512, NH = 8, HD = 64, CW = 31, RW = 4, NMIX = 2048;
constexpr float EPS = 1e-6f;
constexpr int LDM = 11 * D;
constexpr size_t MiB = 1u << 20;
constexpr size_t WS_CTL = 0, CTL_ZERO_BYTES = 1 * MiB;
constexpr size_t WS_MOD = 1 * MiB;
constexpr size_t WS_BIAS1 = 1 * MiB + 512 * 1024;
constexpr size_t WS_BIAS2 = 2 * MiB;
constexpr size_t WS_WGT = 2 * MiB + 128 * 1024;
constexpr size_t WS_CS1 = 2 * MiB + 384 * 1024, WS_CS3 = 2 * MiB + 448 * 1024;
constexpr size_t WS_RS1 = 2 * MiB + 512 * 1024, WS_RS3 = 2 * MiB + 640 * 1024;
constexpr size_t WS_CS2 = 2 * MiB + 480 * 1024, WS_RS2 = 2 * MiB + 768 * 1024;
constexpr size_t WS_TOT = 3 * MiB;
constexpr size_t WS_SSP = 5 * MiB;
constexpr size_t WS_W1I = 8 * MiB, WS_W1O = 19 * MiB, WS_WIN = 25 * MiB, WS_WOUT = 29 * MiB, WS_W2I = 31 * MiB, WS_W2O = 42 * MiB;
constexpr size_t WS_Y = 48 * MiB;
constexpr size_t WS_X1 = 112 * MiB;
constexpr size_t WS_ACT = 240 * MiB;
constexpr size_t WS_U = WS_ACT, WS_UX = WS_ACT + 32 * MiB, WS_GY = WS_ACT + 64 * MiB, WS_YMIX = WS_ACT + 96 * MiB;
constexpr size_t WS_SSPF = 416 * MiB;
constexpr size_t WS_SSPX = 418 * MiB;
constexpr size_t WS_SSPX3 = 422 * MiB;
constexpr size_t WS_END = 426 * MiB;
constexpr int CW_BAR = 4096, CW_SEAM = 16384, CW_SCAN = 32768, CW_SEAM7 = 49152, CW_SEAM3 = 65536, CW_TICKET = 98304;
constexpr int LDS_BYTES = 147456;
constexpr int LDSCTL_OFF = LDS_BYTES - 256;

typedef unsigned short u16;
typedef float f32x16 __attribute__((ext_vector_type(16)));
typedef float f32x2 __attribute__((ext_vector_type(2)));

template <int OFF> __device__ __forceinline__ float sx(float v) {
    const int i = (int)__float_as_uint(v); int r;
    if constexpr (OFF == 1) r = __builtin_amdgcn_update_dpp(0, i, 0xB1, 0xf, 0xf, true);
    else if constexpr (OFF == 2) r = __builtin_amdgcn_update_dpp(0, i, 0x4E, 0xf, 0xf, true);
    else if constexpr (OFF == 4) r = __builtin_amdgcn_ds_swizzle(i, 0x101F);
    else if constexpr (OFF == 8) r = __builtin_amdgcn_update_dpp(0, i, 0x128, 0xf, 0xf, true);
    else if constexpr (OFF == 16) r = __builtin_amdgcn_ds_swizzle(i, 0x401F);
    else { const auto p = __builtin_amdgcn_permlane32_swap(i, i, false, false); r = (threadIdx.x & 32) ? p[0] : p[1]; }
    return __uint_as_float((unsigned)r);
}
__device__ __forceinline__ float wave_sum(float v) { v += sx<1>(v); v += sx<2>(v); v += sx<4>(v); v += sx<8>(v); v += sx<16>(v); v += sx<32>(v); return v; }
__device__ __forceinline__ float sigmoid_fast(float x) { return __builtin_amdgcn_rcpf(1.f + __builtin_amdgcn_exp2f(-1.4426950408889634f * x)); }
__device__ __forceinline__ float silu_fast(float x) { return x * sigmoid_fast(x); }
__device__ __forceinline__ float gelu_tanh_fast(float x) { const float z = 0.7978845608028654f * (x + 0.044715f * x * x * x); return x * sigmoid_fast(2.f * z); }
__device__ __forceinline__ f32x4 sigmoid4(const f32x4 x) { const f32x4 t = x * -1.4426950408889634f; f32x4 e = {__builtin_amdgcn_exp2f(t[0]), __builtin_amdgcn_exp2f(t[1]), __builtin_amdgcn_exp2f(t[2]), __builtin_amdgcn_exp2f(t[3])};
    e = e + 1.0f; return (f32x4){__builtin_amdgcn_rcpf(e[0]), __builtin_amdgcn_rcpf(e[1]), __builtin_amdgcn_rcpf(e[2]), __builtin_amdgcn_rcpf(e[3])}; }
__device__ __forceinline__ f32x4 gelu_tanh4(const f32x4 x) { const f32x4 z2 = (x + (x * x) * x * 0.044715f) * (2.0f * 0.7978845608028654f); return x * sigmoid4(z2); }
__device__ __forceinline__ float bflo(unsigned w) { return __uint_as_float(w << 16); }
__device__ __forceinline__ float bfhi(unsigned w) { return __uint_as_float(w & 0xffff0000u); }
__device__ __forceinline__ unsigned cvtpk(float lo, float hi) { return pg8::cvt_pk_bf16(lo, hi); }
__device__ __forceinline__ v4u pack8(const f32x4 a, const f32x4 b) { v4u w; w.x = cvtpk(a[0], a[1]); w.y = cvtpk(a[2], a[3]); w.z = cvtpk(b[0], b[1]); w.w = cvtpk(b[2], b[3]); return w; }

__device__ __forceinline__ void unpack8(const v4u w, f32x4& a, f32x4& b) { a = (f32x4){bflo(w.x), bfhi(w.x), bflo(w.y), bfhi(w.y)}; b = (f32x4){bflo(w.z), bfhi(w.z), bflo(w.w), bfhi(w.w)}; }
__device__ __forceinline__ unsigned q8(float v) { int q = (int)__builtin_rintf(v); q = q < -127 ? -127 : (q > 127 ? 127 : q); return (unsigned)q & 0xffu; }
__device__ __forceinline__ unsigned q8x4(const f32x4 v) { return q8(v[0]) | (q8(v[1]) << 8) | (q8(v[2]) << 16) | (q8(v[3]) << 24); }
__device__ __forceinline__ float wave_max(float v) { v = fmaxf(v, sx<1>(v)); v = fmaxf(v, sx<2>(v)); v = fmaxf(v, sx<4>(v)); v = fmaxf(v, sx<8>(v)); v = fmaxf(v, sx<16>(v)); v = fmaxf(v, sx<32>(v)); return v; }
typedef int i32x4v __attribute__((ext_vector_type(4)));
__device__ __forceinline__ f32x4 acc_i2f(const f32x4 a) { return __builtin_convertvector(__builtin_bit_cast(i32x4v, a), f32x4); }
__device__ __forceinline__ float clamp448(float v) { return __builtin_fminf(__builtin_fmaxf(v, -448.0f), 448.0f); }
__device__ __forceinline__ unsigned f8x4(const f32x4 v) { int w = __builtin_amdgcn_cvt_pk_fp8_f32(clamp448(v[0]), clamp448(v[1]), 0, false); w = __builtin_amdgcn_cvt_pk_fp8_f32(clamp448(v[2]), clamp448(v[3]), w, true); return (unsigned)w; }
constexpr float F8_ACT_SCALE = 8.0f, F8_W_SCALE = 2048.0f;
__device__ __forceinline__ void load_rstd(const float* ssp, int row0, int fq, float (&rs)[2][4]) {
#pragma unroll
    for (int ai = 0; ai < 2; ++ai)
#pragma unroll
        for (int m = 0; m < 4; ++m) { const f32x4 p = *(const f32x4*)(ssp + (size_t)(row0 + ai * 128 + m * 16) * 16 + 4 * fq);
            float s = (p[0] + p[1]) + (p[2] + p[3]); s += __shfl_xor(s, 16); s += __shfl_xor(s, 32); rs[ai][m] = rsqrtf(s * (1.0f / D) + EPS); }
}
__device__ __forceinline__ void load_rstd_sc1(const float* ssp, int row0, int fq, float (&rs)[2][4]) {
#pragma unroll
    for (int ai = 0; ai < 2; ++ai)
#pragma unroll
        for (int m = 0; m < 4; ++m) { const gu32* p = (const gu32*)(ssp + (size_t)(row0 + ai * 128 + m * 16) * 16 + 4 * fq);
            const float p0 = __uint_as_float(__hip_atomic_load(p, RLX_AGENT)), p1 = __uint_as_float(__hip_atomic_load(p + 1, RLX_AGENT)), p2 = __uint_as_float(__hip_atomic_load(p + 2, RLX_AGENT)), p3 = __uint_as_float(__hip_atomic_load(p + 3, RLX_AGENT));
            float s = (p0 + p1) + (p2 + p3); s += __shfl_xor(s, 16); s += __shfl_xor(s, 32); rs[ai][m] = rsqrtf(s * (1.0f / D) + EPS); }
}
#ifndef MK_EPI_SWIGLU_REPS
#define MK_EPI_SWIGLU_REPS 1
#endif
#ifndef MK_EPI_RESID_REPS
#define MK_EPI_RESID_REPS 1
#endif
struct EpiSwiglu {
    static constexpr bool PERM = true, AFTER_DRAIN = false; static constexpr int REPS = MK_EPI_SWIGLU_REPS;
    pg8::bf16_t* act; const float* ssp; const float* bias;
    __device__ __forceinline__ void operator()(const f32x4 (&acc)[2][2][4][2], const pg8::Unit& u, int wr, int wc, int fr, int fq) const {
        const int row0 = u.pm * 256 + wr * 64 + fr, b = u.pm >> 4;
        float rs[2][4]; load_rstd(ssp, row0, fq, rs);
        const float* bp = bias + (size_t)b * FF2 + u.pn * 256 + wc * 32 + 8 * fq;
        const f32x4 bg0 = *(const f32x4*)(bp), bg1 = *(const f32x4*)(bp + 4), bu0 = *(const f32x4*)(bp + 128), bu1 = *(const f32x4*)(bp + 132);
        const int oc = u.pn * 128 + wc * 32 + 8 * fq;
#pragma unroll
        for (int ai = 0; ai < 2; ++ai)
#pragma unroll
            for (int m = 0; m < 4; ++m) { const float r = rs[ai][m];
                const f32x4 g0 = acc[ai][0][m][0] * r + bg0, g1 = acc[ai][0][m][1] * r + bg1, u0 = acc[ai][1][m][0] * r + bu0, u1 = acc[ai][1][m][1] * r + bu1;
                const f32x4 a0 = (g0 * sigmoid4(g0)) * u0, a1 = (g1 * sigmoid4(g1)) * u1;
                *(v4u*)(act + (size_t)(row0 + ai * 128 + m * 16) * FF + oc) = pack8(a0, a1); }
    }
};
template <bool OUT8> struct EpiSwiglu8 {
    static constexpr bool PERM = true, AFTER_DRAIN = false; static constexpr int REPS = 1;
    pg8::bf16_t* act; const float* rs; const float* cs;
    __device__ __forceinline__ void operator()(const f32x4 (&acc)[2][2][4][2], const pg8::Unit& u, int wr, int wc, int fr, int fq) const {
        const int row0 = u.pm * 256 + wr * 64 + fr;
        float rv[2][4];
#pragma unroll
        for (int ai = 0; ai < 2; ++ai)
#pragma unroll
            for (int m = 0; m < 4; ++m) rv[ai][m] = rs[row0 + ai * 128 + m * 16];
        const int cb = u.pn * 256 + wc * 32 + 8 * fq;
        const float* cp = cs + cb;
        const f32x4 cg0 = *(const f32x4*)(cp), cg1 = *(const f32x4*)(cp + 4), cu0 = *(const f32x4*)(cp + 128), cu1 = *(const f32x4*)(cp + 132);
        const int oc = u.pn * 128 + wc * 32 + 8 * fq;
#pragma unroll
        for (int ai = 0; ai < 2; ++ai)
#pragma unroll
            for (int m = 0; m < 4; ++m) { const float r = rv[ai][m];
                const f32x4 g0 = acc_i2f(acc[ai][0][m][0]) * (cg0 * r), g1 = acc_i2f(acc[ai][0][m][1]) * (cg1 * r);
                const f32x4 u0 = acc_i2f(acc[ai][1][m][0]) * (cu0 * r), u1 = acc_i2f(acc[ai][1][m][1]) * (cu1 * r);
                const f32x4 a0 = (g0 * sigmoid4(g0)) * u0, a1 = (g1 * sigmoid4(g1)) * u1;
                if (OUT8) *(unsigned long long*)((unsigned char*)act + (size_t)(row0 + ai * 128 + m * 16) * FF + oc) = (unsigned long long)f8x4(a0 * F8_ACT_SCALE) | ((unsigned long long)f8x4(a1 * F8_ACT_SCALE) << 32);
                else *(v4u*)(act + (size_t)(row0 + ai * 128 + m * 16) * FF + oc) = pack8(a0, a1); }
    }
};
template <int WHALF, bool HASY, bool IN16, bool F8 = false> struct EpiResid {
    static constexpr bool PERM = true, AFTER_DRAIN = false; static constexpr int REPS = (IN16 ? 1 : MK_EPI_RESID_REPS);
    static constexpr float w = (WHALF ? 0.5f : 1.0f) * (F8 ? 1.0f / (F8_ACT_SCALE * F8_W_SCALE) : 1.0f);
    const void* xin; pg8::bf16_t* xout; pg8::bf16_t* y; float* ssp; const float* gt; const float* gnext; const float* scnext;
    __device__ __forceinline__ void operator()(const f32x4 (&acc)[2][2][4][2], const pg8::Unit& u, int wr, int wc, int fr, int fq) const {
        const int row0 = u.pm * 256 + wr * 64 + fr, b = u.pm >> 4;
        float ss[2][4];
#pragma unroll
        for (int ai = 0; ai < 2; ++ai)
#pragma unroll
            for (int m = 0; m < 4; ++m) ss[ai][m] = 0.f;
#pragma unroll
        for (int bj = 0; bj < 2; ++bj) { const int c0 = u.pn * 256 + bj * 128 + wc * 32 + 8 * fq;
            const f32x4 gt0 = *(const f32x4*)(gt + (size_t)b * LDM + c0) * w, gt1 = *(const f32x4*)(gt + (size_t)b * LDM + c0 + 4) * w;
            f32x4 gs0 = {0.f, 0.f, 0.f, 0.f}, gs1 = gs0;
            if (HASY) { gs0 = *(const f32x4*)(gnext + c0) * (*(const f32x4*)(scnext + (size_t)b * LDM + c0) + 1.0f); gs1 = *(const f32x4*)(gnext + c0 + 4) * (*(const f32x4*)(scnext + (size_t)b * LDM + c0 + 4) + 1.0f); }
#pragma unroll
            for (int ai = 0; ai < 2; ++ai)
#pragma unroll
                for (int m = 0; m < 4; ++m) { const size_t off = (size_t)(row0 + ai * 128 + m * 16) * D + c0;
                    f32x4 x0, x1;
                    if (IN16) unpack8(*(const v4u*)((const pg8::bf16_t*)xin + off), x0, x1); else { x0 = *(const f32x4*)((const float*)xin + off); x1 = *(const f32x4*)((const float*)xin + off + 4); }
                    const f32x4 o0 = x0 + gt0 * acc[ai][bj][m][0], o1 = x1 + gt1 * acc[ai][bj][m][1];
                    *(v4u*)(xout + off) = pack8(o0, o1);
                    ss[ai][m] += (o0[0] * o0[0] + o0[1] * o0[1]) + (o0[2] * o0[2] + o0[3] * o0[3]) + (o1[0] * o1[0] + o1[1] * o1[1]) + (o1[2] * o1[2] + o1[3] * o1[3]);
                    if (HASY) *(v4u*)(y + off) = pack8(o0 * gs0, o1 * gs1); } }
#pragma unroll
        for (int ai = 0; ai < 2; ++ai)
#pragma unroll
            for (int m = 0; m < 4; ++m) { float s = ss[ai][m]; s += __shfl_xor(s, 16); s += __shfl_xor(s, 32);
                if (fq == 0) ssp[(size_t)(row0 + ai * 128 + m * 16) * 16 + u.pn * 4 + wc] = s; }
    }
};
template <int WHALF, bool IN16> struct EpiResidQ {
    static constexpr bool PERM = true, AFTER_DRAIN = false; static constexpr int REPS = 1;
    static constexpr float w = WHALF ? 0.5f : 1.0f;
    const void* xin; pg8::bf16_t* xout; unsigned char* a8; float* rs; f32x2* sspx; const float* gt; const float* gnext; const float* scnext; const float* shnext; const float* shmax; unsigned* cnt;
    __device__ __forceinline__ void operator()(f32x4 (&acc)[2][2][4][2], const pg8::Unit& u, int wr, int wc, int fr, int fq) const {
        const int row0 = u.pm * 256 + wr * 64 + fr, b = u.pm >> 4;
        float ss[2][4], am[2][4];
#pragma unroll
        for (int ai = 0; ai < 2; ++ai)
#pragma unroll
            for (int m = 0; m < 4; ++m) { ss[ai][m] = 0.f; am[ai][m] = 0.f; }
        const unsigned voff = (unsigned)((row0 * D + u.pn * 256 + wc * 32 + 8 * fq) * 2);
        unsigned vo[4] = {voff, voff, voff, voff};
#pragma unroll
        for (int bj = 0; bj < 2; ++bj) { const int c0 = u.pn * 256 + bj * 128 + wc * 32 + 8 * fq;
            const f32x4 gt0 = *(const f32x4*)(gt + (size_t)b * LDM + c0) * w, gt1 = *(const f32x4*)(gt + (size_t)b * LDM + c0 + 4) * w;
            const f32x4 gs0 = *(const f32x4*)(gnext + c0) * (*(const f32x4*)(scnext + (size_t)b * LDM + c0) + 1.0f), gs1 = *(const f32x4*)(gnext + c0 + 4) * (*(const f32x4*)(scnext + (size_t)b * LDM + c0 + 4) + 1.0f);
#pragma unroll
            for (int ai = 0; ai < 2; ++ai)
#pragma unroll
                for (int m = 0; m < 4; ++m) { const unsigned so = (unsigned)(((ai * 128 + m * 16) * D + bj * 128) * 2); const int g = m & 3;
                    f32x4 x0, x1;
                    if (IN16) unpack8(*(const v4u*)((const char*)xin + (size_t)(vo[g] + so)), x0, x1);
                    else { const char* p = (const char*)xin + 2 * (size_t)(vo[g] + so); x0 = *(const f32x4*)p; x1 = *(const f32x4*)(p + 16); }
                    const f32x4 o0 = x0 + gt0 * acc[ai][bj][m][0], o1 = x1 + gt1 * acc[ai][bj][m][1];
                    *(v4u*)((char*)xout + (size_t)(vo[g] + so)) = pack8(o0, o1);
                    acc[ai][bj][m][0] = o0; acc[ai][bj][m][1] = o1;
                    ss[ai][m] += (o0[0] * o0[0] + o0[1] * o0[1]) + (o0[2] * o0[2] + o0[3] * o0[3]) + (o1[0] * o1[0] + o1[1] * o1[1]) + (o1[2] * o1[2] + o1[3] * o1[3]);
                    const f32x4 t0 = __builtin_elementwise_abs(o0 * gs0), t1 = __builtin_elementwise_abs(o1 * gs1);
                    am[ai][m] = fmaxf(am[ai][m], fmaxf(fmaxf(fmaxf(t0[0], t0[1]), fmaxf(t0[2], t0[3])), fmaxf(fmaxf(t1[0], t1[1]), fmaxf(t1[2], t1[3]))));
                    asm volatile("" : "+v"(vo[g]) : "v"(ss[ai][m])); } }
#pragma unroll
        for (int ai = 0; ai < 2; ++ai)
#pragma unroll
            for (int m = 0; m < 4; ++m) { float s = ss[ai][m], a = am[ai][m]; s += __shfl_xor(s, 16); s += __shfl_xor(s, 32); a = fmaxf(a, __shfl_xor(a, 16)); a = fmaxf(a, __shfl_xor(a, 32));
                if (fq == 0) __hip_atomic_store((gu64*)(sspx + (size_t)(row0 + ai * 128 + m * 16) * 16 + u.pn * 4 + wc), ((unsigned long long)__float_as_uint(a) << 32) | __float_as_uint(s), RLX_AGENT); }
        PROF_BEGIN(13);
        asm volatile("s_waitcnt vmcnt(0)" ::: "memory");
        unsigned* cw = cnt + 64 * u.pm;
        if ((threadIdx.x & 63) == 0) __hip_atomic_fetch_add(cw, 1u, __ATOMIC_RELAXED, __HIP_MEMORY_SCOPE_AGENT);
        if (threadIdx.x < 64) {
            unsigned sp = 0;
            while ((unsigned)__builtin_amdgcn_readfirstlane(__hip_atomic_load(cw, __ATOMIC_RELAXED, __HIP_MEMORY_SCOPE_AGENT)) < 32u) { __builtin_amdgcn_s_sleep(1); if (++sp > (1u << 20)) break; }
            __builtin_amdgcn_fence(__ATOMIC_ACQUIRE, "agent");
            asm volatile("s_waitcnt vmcnt(0)" ::: "memory");
        }
        asm volatile("" ::: "memory"); __builtin_amdgcn_s_barrier(); asm volatile("" ::: "memory");
        PROF_END(13);
        float qs[2][4], qr[2][4];
        const float shm = shmax[b];
#pragma unroll
        for (int ai = 0; ai < 2; ++ai)
#pragma unroll
            for (int m = 0; m < 4; ++m) { const int row = row0 + ai * 128 + m * 16; const gu64* p = (const gu64*)(sspx + (size_t)row * 16 + 4 * fq);
                float s = 0.f, a = 0.f;
#pragma unroll
                for (int e = 0; e < 4; ++e) { const unsigned long long t = __hip_atomic_load(p + e, RLX_AGENT); s += __uint_as_float((unsigned)t); a = fmaxf(a, __uint_as_float((unsigned)(t >> 32))); }
                s += __shfl_xor(s, 16); s += __shfl_xor(s, 32); a = fmaxf(a, __shfl_xor(a, 16)); a = fmaxf(a, __shfl_xor(a, 32));
                const float rstd = rsqrtf(s * (1.0f / D) + EPS), S = rstd * a + shm;
                qs[ai][m] = S > 0.f ? 127.0f / S : 0.f; qr[ai][m] = rstd * qs[ai][m];
                if (u.pn == 0 && wc == 0 && fq == 0) rs[row] = S * (1.0f / 127.0f); }
        const unsigned voff8 = (unsigned)(row0 * D + u.pn * 256 + wc * 32 + 8 * fq);
#pragma unroll
        for (int bj = 0; bj < 2; ++bj) { const int c0 = u.pn * 256 + bj * 128 + wc * 32 + 8 * fq;
            const f32x4 gs0 = *(const f32x4*)(gnext + c0) * (*(const f32x4*)(scnext + (size_t)b * LDM + c0) + 1.0f), gs1 = *(const f32x4*)(gnext + c0 + 4) * (*(const f32x4*)(scnext + (size_t)b * LDM + c0 + 4) + 1.0f);
            const f32x4 sh0 = *(const f32x4*)(shnext + (size_t)b * LDM + c0), sh1 = *(const f32x4*)(shnext + (size_t)b * LDM + c0 + 4);
#pragma unroll
            for (int ai = 0; ai < 2; ++ai)
#pragma unroll
                for (int m = 0; m < 4; ++m) { const float q = qs[ai][m], r = qr[ai][m]; const unsigned so = (unsigned)((ai * 128 + m * 16) * D + bj * 128);
                    *(unsigned long long*)(a8 + (size_t)(voff8 + so)) = (unsigned long long)q8x4(acc[ai][bj][m][0] * (gs0 * r) + sh0 * q) | ((unsigned long long)q8x4(acc[ai][bj][m][1] * (gs1 * r) + sh1 * q) << 32); } }
    }
};
template <bool F8> struct EpiResidFinal {
    static constexpr bool PERM = true, AFTER_DRAIN = false; static constexpr int REPS = 1;
    static constexpr float ascale = F8 ? 1.0f / (F8_ACT_SCALE * F8_W_SCALE) : 1.0f;
    const pg8::bf16_t* xin; float* out; float* ssp; const float* gt; const float* gf; const float* fsc; const float* fsh; unsigned* cnt;
    __device__ __forceinline__ void operator()(f32x4 (&acc)[2][2][4][2], const pg8::Unit& u, int wr, int wc, int fr, int fq) const {
        const int row0 = u.pm * 256 + wr * 64 + fr, b = u.pm >> 4;
        const __amdgpu_buffer_rsrc_t rx = __builtin_amdgcn_make_buffer_rsrc((void*)xin, 0, M * D * 4, 0x00020000), ro = __builtin_amdgcn_make_buffer_rsrc((void*)out, 0, M * D * 4, 0x00020000);
        const unsigned voff = (unsigned)((row0 * D + u.pn * 256 + wc * 32 + 8 * fq) * 4);
        float ss[2][4];
#pragma unroll
        for (int ai = 0; ai < 2; ++ai)
#pragma unroll
            for (int m = 0; m < 4; ++m) ss[ai][m] = 0.f;
        unsigned vo[4] = {voff, voff, voff, voff};
#pragma unroll
        for (int bj = 0; bj < 2; ++bj) { const int c0 = u.pn * 256 + bj * 128 + wc * 32 + 8 * fq;
            const float hw = 0.5f * ascale; const f32x4 gt0 = *(const f32x4*)(gt + (size_t)b * LDM + c0) * hw, gt1 = *(const f32x4*)(gt + (size_t)b * LDM + c0 + 4) * hw;
#pragma unroll
            for (int ai = 0; ai < 2; ++ai)
#pragma unroll
                for (int m = 0; m < 4; ++m) { const unsigned so = (unsigned)(((ai * 128 + m * 16) * D + bj * 128) * 4); const int g = m & 3;
                    f32x4 x0, x1; unpack8(*(const v4u*)((const char*)xin + (size_t)((vo[g] + so) >> 1)), x0, x1);
                    const f32x4 o0 = x0 + gt0 * acc[ai][bj][m][0], o1 = x1 + gt1 * acc[ai][bj][m][1];
                    acc[ai][bj][m][0] = o0; acc[ai][bj][m][1] = o1;
                    ss[ai][m] += (o0[0] * o0[0] + o0[1] * o0[1]) + (o0[2] * o0[2] + o0[3] * o0[3]) + (o1[0] * o1[0] + o1[1] * o1[1]) + (o1[2] * o1[2] + o1[3] * o1[3]);
                    asm volatile("" : "+v"(vo[g]) : "v"(ss[ai][m])); } }
#pragma unroll
        for (int ai = 0; ai < 2; ++ai)
#pragma unroll
            for (int m = 0; m < 4; ++m) { float s = ss[ai][m]; s += __shfl_xor(s, 16); s += __shfl_xor(s, 32);
                if (fq == 0) __hip_atomic_store((gu32*)(ssp + (size_t)(row0 + ai * 128 + m * 16) * 16 + u.pn * 4 + wc), __float_as_uint(s), RLX_AGENT); }
        PROF_BEGIN(14);
        asm volatile("s_waitcnt vmcnt(0)" ::: "memory");
        unsigned* cw = cnt + 64 * u.pm;
        if ((threadIdx.x & 63) == 0) __hip_atomic_fetch_add(cw, 1u, __ATOMIC_RELAXED, __HIP_MEMORY_SCOPE_AGENT);
        if (threadIdx.x < 64) {
            unsigned sp = 0;
            while ((unsigned)__builtin_amdgcn_readfirstlane(__hip_atomic_load(cw, __ATOMIC_RELAXED, __HIP_MEMORY_SCOPE_AGENT)) < 32u) { __builtin_amdgcn_s_sleep(1); if (++sp > (1u << 20)) break; }
            __builtin_amdgcn_fence(__ATOMIC_ACQUIRE, "agent");
            asm volatile("s_waitcnt vmcnt(0)" ::: "memory");
        }
        asm volatile("" ::: "memory"); __builtin_amdgcn_s_barrier(); asm volatile("" ::: "memory");
        PROF_END(14);
        float rs[2][4]; load_rstd_sc1(ssp, row0, fq, rs);
#pragma unroll
        for (int bj = 0; bj < 2; ++bj) { const int c0 = u.pn * 256 + bj * 128 + wc * 32 + 8 * fq;
            const f32x4 gs0 = *(const f32x4*)(gf + c0) * (*(const f32x4*)(fsc + (size_t)b * LDM + c0) + 1.0f), gs1 = *(const f32x4*)(gf + c0 + 4) * (*(const f32x4*)(fsc + (size_t)b * LDM + c0 + 4) + 1.0f);
            const f32x4 sh0 = *(const f32x4*)(fsh + (size_t)b * LDM + c0), sh1 = *(const f32x4*)(fsh + (size_t)b * LDM + c0 + 4);
#pragma unroll
            for (int ai = 0; ai < 2; ++ai)
#pragma unroll
                for (int m = 0; m < 4; ++m) { const unsigned so = (unsigned)(((ai * 128 + m * 16) * D + bj * 128) * 4); const float r = rs[ai][m];
                    *(f32x4*)((char*)out + (size_t)voff + so) = acc[ai][bj][m][0] * r * gs0 + sh0;
                    *(f32x4*)((char*)out + (size_t)voff + so + 16) = acc[ai][bj][m][1] * r * gs1 + sh1; } }
    }
};
struct EpiMixIn {
    static constexpr bool PERM = true, AFTER_DRAIN = false; static constexpr int REPS = 1;
    pg8::bf16_t *U, *UX, *GY; const float* ssp; const float* bias;
    __device__ __forceinline__ void operator()(const f32x4 (&acc)[2][2][4][2], const pg8::Unit& u, int wr, int wc, int fr, int fq) const {
        const int row0 = u.pm * 256 + wr * 64 + fr, b = u.pm >> 4;
        float rs[2][4]; load_rstd(ssp, row0, fq, rs);
        const float* bp = bias + (size_t)b * NMIX + u.pn * 256 + wc * 32 + 8 * fq;
        const f32x4 b00 = *(const f32x4*)(bp), b01 = *(const f32x4*)(bp + 4), b10 = *(const f32x4*)(bp + 128), b11 = *(const f32x4*)(bp + 132);
        if (u.pn < 4) {
            const int oc = u.pn * 128 + wc * 32 + 8 * fq;
#pragma unroll
            for (int ai = 0; ai < 2; ++ai)
#pragma unroll
                for (int m = 0; m < 4; ++m) { const float r = rs[ai][m];
                    const f32x4 v0 = acc[ai][0][m][0] * r + b00, v1 = acc[ai][0][m][1] * r + b01, g0 = acc[ai][1][m][0] * r + b10, g1 = acc[ai][1][m][1] * r + b11;
                    const f32x4 a0 = v0 * sigmoid4(g0), a1 = v1 * sigmoid4(g1);
                    *(v4u*)(U + (size_t)(row0 + ai * 128 + m * 16) * DC + oc) = pack8(a0, a1); }
        } else {
            pg8::bf16_t* dst = (u.pn < 6) ? UX : GY; const bool gel = u.pn >= 6; const int pc = (u.pn & 1) * 256 + wc * 32 + 8 * fq;
#pragma unroll
            for (int ai = 0; ai < 2; ++ai)
#pragma unroll
                for (int m = 0; m < 4; ++m) { const float r = rs[ai][m];
#pragma unroll
                    for (int bj = 0; bj < 2; ++bj) { f32x4 v0 = acc[ai][bj][m][0] * r + (bj ? b10 : b00), v1 = acc[ai][bj][m][1] * r + (bj ? b11 : b01);
                        if (gel) { v0 = gelu_tanh4(v0); v1 = gelu_tanh4(v1); }
                        *(v4u*)(dst + (size_t)(row0 + ai * 128 + m * 16) * DR + pc + bj * 128) = pack8(v0, v1); } }
        }
    }
};

struct EpiMixIn8 {
    static constexpr bool PERM = true, AFTER_DRAIN = false; static constexpr int REPS = 1;
    pg8::bf16_t *U, *UX, *GY; const float* rs; const float* cs; const float* bias;
    __device__ __forceinline__ void operator()(const f32x4 (&acc)[2][2][4][2], const pg8::Unit& u, int wr, int wc, int fr, int fq) const {
        const int row0 = u.pm * 256 + wr * 64 + fr, b = u.pm >> 4;
        float rv[2][4];
#pragma unroll
        for (int ai = 0; ai < 2; ++ai)
#pragma unroll
            for (int m = 0; m < 4; ++m) rv[ai][m] = rs[row0 + ai * 128 + m * 16];
        const int cb = u.pn * 256 + wc * 32 + 8 * fq;
        const float* bp = bias + (size_t)b * NMIX + cb; const float* cp = cs + cb;
        const f32x4 b00 = *(const f32x4*)(bp), b01 = *(const f32x4*)(bp + 4), b10 = *(const f32x4*)(bp + 128), b11 = *(const f32x4*)(bp + 132);
        const f32x4 c00 = *(const f32x4*)(cp), c01 = *(const f32x4*)(cp + 4), c10 = *(const f32x4*)(cp + 128), c11 = *(const f32x4*)(cp + 132);
        if (u.pn < 4) {
            const int oc = u.pn * 128 + wc * 32 + 8 * fq;
#pragma unroll
            for (int ai = 0; ai < 2; ++ai)
#pragma unroll
                for (int m = 0; m < 4; ++m) { const float r = rv[ai][m];
                    const f32x4 v0 = acc_i2f(acc[ai][0][m][0]) * (c00 * r) + b00, v1 = acc_i2f(acc[ai][0][m][1]) * (c01 * r) + b01;
                    const f32x4 g0 = acc_i2f(acc[ai][1][m][0]) * (c10 * r) + b10, g1 = acc_i2f(acc[ai][1][m][1]) * (c11 * r) + b11;
                    const f32x4 a0 = v0 * sigmoid4(g0), a1 = v1 * sigmoid4(g1);
                    *(v4u*)(U + (size_t)(row0 + ai * 128 + m * 16) * DC + oc) = pack8(a0, a1); }
        } else {
            pg8::bf16_t* dst = (u.pn < 6) ? UX : GY; const bool gel = u.pn >= 6; const int pc = (u.pn & 1) * 256 + wc * 32 + 8 * fq;
#pragma unroll
            for (int ai = 0; ai < 2; ++ai)
#pragma unroll
                for (int m = 0; m < 4; ++m) { const float r = rv[ai][m];
#pragma unroll
                    for (int bj = 0; bj < 2; ++bj) { f32x4 v0 = acc_i2f(acc[ai][bj][m][0]) * ((bj ? c10 : c00) * r) + (bj ? b10 : b00), v1 = acc_i2f(acc[ai][bj][m][1]) * ((bj ? c11 : c01) * r) + (bj ? b11 : b01);
                        if (gel) { v0 = gelu_tanh4(v0); v1 = gelu_tanh4(v1); }
                        *(v4u*)(dst + (size_t)(row0 + ai * 128 + m * 16) * DR + pc + bj * 128) = pack8(v0, v1); } }
        }
    }
};

__device__ __forceinline__ void p0_gemv(LAS unsigned char* lds, const float* c, const float* W, int NC, const float* bias, float* out, int j0, int tid) {
    LAS float* ca = (LAS float*)lds; LAS float* part = (LAS float*)(lds + 32768);
    for (int i = tid; i < NB * D; i += 512) { const float v = c[i]; ca[i] = v / (1.f + expf(-v)); }
    __syncthreads();
    const int cg = tid & 31, ks = tid >> 5;
    const float* wp = W + (size_t)(64 * ks) * NC + j0 + 4 * cg;
    f32x4 acc[NB];
#pragma unroll
    for (int b = 0; b < NB; ++b) acc[b] = (f32x4){0.f, 0.f, 0.f, 0.f};
#pragma unroll 4
    for (int kk = 0; kk < 64; ++kk) { const f32x4 w = *(const f32x4*)(wp + (size_t)kk * NC);
#pragma unroll
        for (int b = 0; b < NB; ++b) acc[b] += w * ca[b * D + 64 * ks + kk]; }
#pragma unroll
    for (int b = 0; b < NB; ++b) *(LAS f32x4*)(part + (ks * NB + b) * 128 + 4 * cg) = acc[b];
    __syncthreads();
#pragma unroll
    for (int r = 0; r < 2; ++r) { const int o = tid + 512 * r, b = o >> 7, col = o & 127; float s = 0.f;
#pragma unroll
        for (int k2 = 0; k2 < 16; ++k2) s += part[(k2 * NB + b) * 128 + col];
        out[(size_t)b * LDM + j0 + col] = s + bias[j0 + col]; }
    __syncthreads();
}
__device__ __forceinline__ int rowmap(int kind, int n0) {
    if (kind == 1) { const int half = n0 / FF, f = n0 - half * FF; return 256 * (f >> 7) + 128 * half + (f & 127); }
    if (kind == 2 && n0 < 1024) { const int half = n0 >> 9, f = n0 & 511; return 256 * (f >> 7) + 128 * half + (f & 127); }
    return n0;
}
__device__ __forceinline__ void p0_transpose_item(const float* W, int K, int N, bf16* WT, int kind, LAS float* scr, int item, int lane) {
    const int nblk = N / 32, kb = item / nblk, nb = item % nblk, k0 = 64 * kb, n0 = 32 * nb, r0 = rowmap(kind, n0);
#pragma unroll 8
    for (int i = 0; i < 32; ++i) { const int kk = 2 * i + (lane >> 5); scr[kk * 33 + (lane & 31)] = W[(size_t)(k0 + kk) * N + n0 + (lane & 31)]; }
    LDS_WAIT(); asm volatile("" ::: "memory");
    const int c = lane & 7;
#pragma unroll
    for (int j = 0; j < 4; ++j) { const int n = (lane >> 3) + 8 * j; const LAS float* s = scr + (8 * c) * 33 + n;
        v4u o; o.x = pk2(s[0 * 33], s[1 * 33]); o.y = pk2(s[2 * 33], s[3 * 33]); o.z = pk2(s[4 * 33], s[5 * 33]); o.w = pk2(s[6 * 33], s[7 * 33]);
        *(GAS v4u*)(WT + (size_t)(r0 + n) * K + k0 + 8 * c) = o; }
    LDS_WAIT(); asm volatile("" ::: "memory");
}

__device__ __forceinline__ void p0_transpose8_item(const float* W, int K, int N, unsigned char* WT, LAS float* scr, int item, int lane) {
    const int nblk = N / 32, kb = item / nblk, nb = item % nblk, k0 = 64 * kb, n0 = 32 * nb;
#pragma unroll 8
    for (int i = 0; i < 32; ++i) { const int kk = 2 * i + (lane >> 5); scr[kk * 33 + (lane & 31)] = W[(size_t)(k0 + kk) * N + n0 + (lane & 31)]; }
    LDS_WAIT(); asm volatile("" ::: "memory");
    const int n = lane >> 1, kh = (lane & 1) * 32; const LAS float* sp = scr + n;
#pragma unroll
    for (int hq = 0; hq < 2; ++hq) { v4u o;
#pragma unroll
        for (int dq = 0; dq < 4; ++dq) { const int k = kh + 16 * hq + 4 * dq;
            const unsigned w4 = f8x4((f32x4){sp[(k + 0) * 33], sp[(k + 1) * 33], sp[(k + 2) * 33], sp[(k + 3) * 33]} * F8_W_SCALE);
            if (dq == 0) o.x = w4; else if (dq == 1) o.y = w4; else if (dq == 2) o.z = w4; else o.w = w4; }
        *(GAS v4u*)(WT + (size_t)(n0 + n) * K + k0 + kh + 16 * hq) = o; }
    LDS_WAIT(); asm volatile("" ::: "memory");
}
__device__ __forceinline__ void p0_quant_item(LAS unsigned char* lds, const float* W, int N, int kind, unsigned char* W8, float* cs, int nb, int lane, int wave) {
    LAS float* scr = (LAS float*)(lds + wave * 16896);
    LAS float* cm = (LAS float*)(lds + 8 * 16896);
    const int n0 = 32 * nb, r0 = rowmap(kind, n0);
#pragma unroll
    for (int tl = 0; tl < 2; ++tl) { const int k0 = 64 * (2 * wave + tl);
#pragma unroll 8
        for (int i = 0; i < 32; ++i) { const int kk = 2 * i + (lane >> 5); scr[tl * 2112 + kk * 33 + (lane & 31)] = W[(size_t)(k0 + kk) * N + n0 + (lane & 31)]; } }
    LDS_WAIT(); asm volatile("" ::: "memory");
    float mx = 0.f;
#pragma unroll
    for (int tl = 0; tl < 2; ++tl)
#pragma unroll 8
        for (int r = 0; r < 32; ++r) mx = fmaxf(mx, fabsf(scr[tl * 2112 + ((lane >> 5) * 32 + r) * 33 + (lane & 31)]));
    mx = fmaxf(mx, __shfl_xor(mx, 32));
    if (lane < 32) cm[wave * 32 + lane] = mx;
    __syncthreads();
    float cmax = 0.f;
#pragma unroll
    for (int w = 0; w < 8; ++w) cmax = fmaxf(cmax, cm[w * 32 + (lane & 31)]);
    const float sc = cmax > 0.f ? 127.0f / cmax : 0.f;
    if (wave == 0 && lane < 32) cs[r0 + lane] = cmax * (1.0f / 127.0f);
    const int n = lane >> 1, kh = (lane & 1) * 32;
    const float sn = __shfl(sc, n);
#pragma unroll
    for (int tl = 0; tl < 2; ++tl) { const int k0 = 64 * (2 * wave + tl); const LAS float* sp = scr + tl * 2112 + n;
#pragma unroll
        for (int hq = 0; hq < 2; ++hq) { v4u o;
#pragma unroll
            for (int dq = 0; dq < 4; ++dq) { const int k = kh + 16 * hq + 4 * dq;
                const unsigned w4 = q8(sp[(k + 0) * 33] * sn) | (q8(sp[(k + 1) * 33] * sn) << 8) | (q8(sp[(k + 2) * 33] * sn) << 16) | (q8(sp[(k + 3) * 33] * sn) << 24);
                if (dq == 0) o.x = w4; else if (dq == 1) o.y = w4; else if (dq == 2) o.z = w4; else o.w = w4; }
            *(GAS v4u*)(W8 + (size_t)(r0 + n) * D + k0 + kh + 16 * hq) = o; } }
    __syncthreads();
}

__device__ __forceinline__ void mix_conv(LAS unsigned char* lds, const bf16* U, const float* conv_w, const float* conv_b, const float* ln_g, const float* ln_b, bf16* YMIX, int G, int bx, int tid, int lane, int wave) {
    LAS unsigned char* IN = lds;
    LAS f32x4* WA = (LAS f32x4*)(lds + 63488);
    LAS f32x4* WB = WA + 31 * 64;
    for (int i = tid; i < 31 * 64; i += 512) { const int k = i >> 6, l = i & 63; WA[i] = *(const f32x4*)(conv_w + k * DC + 8 * l); WB[i] = *(const f32x4*)(conv_w + k * DC + 8 * l + 4); }
    const f32x4 cb0 = *(const f32x4*)(conv_b + 8 * lane), cb1 = *(const f32x4*)(conv_b + 8 * lane + 4);
    const f32x4 lg0 = *(const f32x4*)(ln_g + 8 * lane), lg1 = *(const f32x4*)(ln_g + 8 * lane + 4);
    const f32x4 lb0 = *(const f32x4*)(ln_b + 8 * lane), lb1 = *(const f32x4*)(ln_b + 8 * lane + 4);
    v4u pre[8];
#pragma unroll
    for (int i = 0; i < 8; ++i) { const int q = tid + 512 * i, row = q >> 6, ch = q & 63, tok = (bx & 127) * 32 - 30 + row; pre[i] = (v4u){0u, 0u, 0u, 0u};
        if (bx < NB * (SEQ / 32) && q < 62 * 64 && tok >= 0) pre[i] = *(const v4u*)(U + ((size_t)((bx >> 7) * SEQ + tok)) * DC + 8 * ch); }
    for (int item = bx; item < NB * (SEQ / 32); item += G) {
        const int b = item >> 7, t0 = (item & 127) * 32;
        __syncthreads();
#pragma unroll
        for (int i = 0; i < 8; ++i) { const int q = tid + 512 * i; if (q < 62 * 64) *(LAS v4u*)(IN + (q >> 6) * 1024 + (q & 63) * 16) = pre[i]; }
        { const int nitem = item + G, nb = nitem >> 7, nt0 = (nitem & 127) * 32;
#pragma unroll
            for (int i = 0; i < 8; ++i) { const int q = tid + 512 * i, row = q >> 6, ch = q & 63, tok = nt0 - 30 + row; pre[i] = (v4u){0u, 0u, 0u, 0u};
                if (nitem < NB * (SEQ / 32) && q < 62 * 64 && tok >= 0) pre[i] = *(const v4u*)(U + ((size_t)(nb * SEQ + tok)) * DC + 8 * ch); } }
        __syncthreads();
        f32x4 a0[4], a1[4];
#pragma unroll
        for (int tt = 0; tt < 4; ++tt) { a0[tt] = cb0; a1[tt] = cb1; }
        f32x4 wa0 = {0.f, 0.f, 0.f, 0.f}, wa1 = wa0, wa2 = wa0, wa3 = wa0, wb0 = wa0, wb1 = wa0, wb2 = wa0, wb3 = wa0;
#pragma unroll
        for (int kk = 0; kk < 34; ++kk) {
            const v4u v = *(const LAS v4u*)(IN + (4 * wave + kk) * 1024 + lane * 16);
            const f32x4 x0 = {bflo(v.x), bfhi(v.x), bflo(v.y), bfhi(v.y)}, x1 = {bflo(v.z), bfhi(v.z), bflo(v.w), bfhi(v.w)};
            wa3 = wa2; wa2 = wa1; wa1 = wa0; wb3 = wb2; wb2 = wb1; wb1 = wb0;
            if (kk <= 30) { wa0 = WA[kk * 64 + lane]; wb0 = WB[kk * 64 + lane]; } else { wa0 = (f32x4){0.f, 0.f, 0.f, 0.f}; wb0 = wa0; }
            a0[0] += wa0 * x0; a1[0] += wb0 * x1; a0[1] += wa1 * x0; a1[1] += wb1 * x1; a0[2] += wa2 * x0; a1[2] += wb2 * x1; a0[3] += wa3 * x0; a1[3] += wb3 * x1;
        }
#pragma unroll
        for (int tt = 0; tt < 4; ++tt) {
            float s = (a0[tt][0] + a0[tt][1]) + (a0[tt][2] + a0[tt][3]) + (a1[tt][0] + a1[tt][1]) + (a1[tt][2] + a1[tt][3]);
            const float mean = wave_sum(s) * (1.0f / DC);
            const f32x4 d0 = a0[tt] - mean, d1 = a1[tt] - mean;
            float q = (d0[0] * d0[0] + d0[1] * d0[1]) + (d0[2] * d0[2] + d0[3] * d0[3]) + (d1[0] * d1[0] + d1[1] * d1[1]) + (d1[2] * d1[2] + d1[3] * d1[3]);
            const float rstd = rsqrtf(wave_sum(q) * (1.0f / DC) + EPS);
            f32x4 y0 = d0 * rstd * lg0 + lb0, y1 = d1 * rstd * lg1 + lb1;
#pragma unroll
            for (int j = 0; j < 4; ++j) { y0[j] = silu_fast(y0[j]); y1[j] = silu_fast(y1[j]); }
            *(v4u*)(YMIX + ((size_t)(b * SEQ + t0 + 4 * wave + tt)) * D + 8 * lane) = pack8(y0, y1);
        }
    }
    __syncthreads();
}

__device__ __forceinline__ void mix_conv2(LAS unsigned char* lds, const bf16* U, const float* conv_w, const float* conv_b, const float* ln_g, const float* ln_b, bf16* YMIX, int G, int bx, int tid, int lane, int wave) {
    LAS unsigned char* IN = lds;
    LAS float* RED = (LAS float*)(lds + 63488);
    const int th = wave >> 2, cq = wave & 3, ch = 128 * cq + 2 * lane;
    f32x2 wt[31];
#pragma unroll
    for (int k = 0; k < 31; ++k) wt[k] = *(const f32x2*)(conv_w + k * DC + ch);
    const f32x2 cb = *(const f32x2*)(conv_b + ch), lg = *(const f32x2*)(ln_g + ch), lb = *(const f32x2*)(ln_b + ch);
    v4u pre[8];
#pragma unroll
    for (int i = 0; i < 8; ++i) { const int q = tid + 512 * i, row = q >> 6, c16 = q & 63, tok = (bx & 127) * 32 - 30 + row; pre[i] = (v4u){0u, 0u, 0u, 0u};
        if (bx < NB * (SEQ / 32) && q < 62 * 64 && tok >= 0) pre[i] = *(const v4u*)(U + ((size_t)((bx >> 7) * SEQ + tok)) * DC + 8 * c16); }
    for (int item = bx; item < NB * (SEQ / 32); item += G) {
        const int b = item >> 7, t0 = (item & 127) * 32;
        PROF_BEGIN(10);
        __syncthreads();
#pragma unroll
        for (int i = 0; i < 8; ++i) { const int q = tid + 512 * i; if (q < 62 * 64) *(LAS v4u*)(IN + (q >> 6) * 1024 + (q & 63) * 16) = pre[i]; }
        { const int nitem = item + G, nb = nitem >> 7, nt0 = (nitem & 127) * 32;
#pragma unroll
            for (int i = 0; i < 8; ++i) { const int q = tid + 512 * i, row = q >> 6, c16 = q & 63, tok = nt0 - 30 + row; pre[i] = (v4u){0u, 0u, 0u, 0u};
                if (nitem < NB * (SEQ / 32) && q < 62 * 64 && tok >= 0) pre[i] = *(const v4u*)(U + ((size_t)(nb * SEQ + tok)) * DC + 8 * c16); } }
        __syncthreads();
        PROF_END(10); PROF_BEGIN(11);
        f32x2 acc[16];
#pragma unroll
        for (int tt = 0; tt < 16; ++tt) acc[tt] = cb;
        const LAS unsigned char* ip = IN + (16 * th) * 1024 + ch * 2;
#pragma unroll
        for (int r = 0; r < 46; ++r) {
            const unsigned v = *(const LAS unsigned*)(ip + r * 1024);
            const f32x2 xv = {bflo(v), bfhi(v)};
#pragma unroll
            for (int tt = 0; tt < 16; ++tt) { const int k = r - tt; if (k >= 0 && k <= 30) acc[tt] += wt[k] * xv; }
        }
        PROF_END(11); PROF_BEGIN(12);
        float vals[32];
#pragma unroll
        for (int tt = 0; tt < 16; ++tt) { vals[tt] = acc[tt][0] + acc[tt][1]; vals[16 + tt] = acc[tt][0] * acc[tt][0] + acc[tt][1] * acc[tt][1]; }
#pragma unroll
        for (int i = 0; i < 16; ++i) { const auto p = __builtin_amdgcn_permlane32_swap((int)__float_as_uint(vals[i]), (int)__float_as_uint(vals[i + 16]), false, false); vals[i] = __uint_as_float((unsigned)p[0]) + __uint_as_float((unsigned)p[1]); }
#pragma unroll
        for (int i = 0; i < 8; ++i) { const auto p = __builtin_amdgcn_permlane16_swap((int)__float_as_uint(vals[i]), (int)__float_as_uint(vals[i + 8]), false, false); vals[i] = __uint_as_float((unsigned)p[0]) + __uint_as_float((unsigned)p[1]); }
#define CONV_RED_STEP(off, n) { const bool up = (lane & (off)) != 0; _Pragma("unroll") for (int i = 0; i < (n); ++i) { const float keep = up ? vals[i + (n)] : vals[i], send = up ? vals[i] : vals[i + (n)]; vals[i] = keep + sx<(off)>(send); } }
        CONV_RED_STEP(8, 4) CONV_RED_STEP(4, 2) CONV_RED_STEP(2, 1)
#undef CONV_RED_STEP
        vals[0] += sx<1>(vals[0]);
        if ((lane & 1) == 0) RED[wave * 32 + (lane >> 5) * 16 + ((lane >> 1) & 15)] = vals[0];
        __syncthreads();
        float mean_l = 0.f, rstd_l = 0.f;
        if (lane < 16) { float s1 = 0.f, s2 = 0.f;
#pragma unroll
            for (int q4 = 0; q4 < 4; ++q4) { s1 += RED[(4 * th + q4) * 32 + lane]; s2 += RED[(4 * th + q4) * 32 + 16 + lane]; }
            mean_l = s1 * (1.0f / DC); const float var = fmaxf(s2 * (1.0f / DC) - mean_l * mean_l, 0.f); rstd_l = rsqrtf(var + EPS); }
#pragma unroll
        for (int tt = 0; tt < 16; ++tt) {
            const float mean = __uint_as_float((unsigned)__builtin_amdgcn_readlane((int)__float_as_uint(mean_l), tt)), rstd = __uint_as_float((unsigned)__builtin_amdgcn_readlane((int)__float_as_uint(rstd_l), tt));
            f32x2 y = (acc[tt] - mean) * rstd * lg + lb;
            y[0] = silu_fast(y[0]); y[1] = silu_fast(y[1]);
            *(unsigned*)(YMIX + ((size_t)(b * SEQ + t0 + 16 * th + tt)) * D + ch) = cvtpk(y[0], y[1]);
        }
        PROF_END(12);
    }
    __syncthreads();
}

__device__ __forceinline__ void scan_decode(int it, int& b, int& c) { if (it < 256) { b = it >> 6; c = it & 63; } else { b = 4 + ((it - 256) >> 6); c = 63 - ((it - 256) & 63); } }
__device__ __forceinline__ float neg_expm1(float x, float a) {
    float p = -1.0f / 5040.0f; p = p * x - 1.0f / 720.0f; p = p * x - 1.0f / 120.0f; p = p * x - 1.0f / 24.0f; p = p * x - 1.0f / 6.0f; p = p * x - 0.5f; p = p * x - 1.0f;
    float q = p * x, w = 1.0f - a * a; asm volatile("" : "+v"(q), "+v"(w));
    return x > -0.5f ? q : w;
}
__device__ __forceinline__ void gate_math16(const f32x16 pa, const f32x16 pi, float ba, float bi, float c8, f32x16& av, f32x16& bv) {
#pragma unroll
    for (int g4 = 0; g4 < 4; ++g4) {
        const f32x4 pa4 = {pa[4 * g4], pa[4 * g4 + 1], pa[4 * g4 + 2], pa[4 * g4 + 3]}, pi4 = {pi[4 * g4], pi[4 * g4 + 1], pi[4 * g4 + 2], pi[4 * g4 + 3]};
        const f32x4 rg = sigmoid4(pa4 + ba), ig = sigmoid4(pi4 + bi);
        const f32x4 l2 = rg * c8;
        const f32x4 a = {__builtin_amdgcn_exp2f(l2[0]), __builtin_amdgcn_exp2f(l2[1]), __builtin_amdgcn_exp2f(l2[2]), __builtin_amdgcn_exp2f(l2[3])};
        const f32x4 x = l2 * 1.3862943611198906f;
        f32x4 p = x * (-1.0f / 5040.0f) - 1.0f / 720.0f; p = p * x - 1.0f / 120.0f; p = p * x - 1.0f / 24.0f; p = p * x - 1.0f / 6.0f; p = p * x - 0.5f; p = p * x - 1.0f;
        f32x4 q = p * x, w = 1.0f - a * a; asm volatile("" : "+v"(q), "+v"(w));
        f32x4 m2;
#pragma unroll
        for (int e = 0; e < 4; ++e) m2[e] = __builtin_amdgcn_sqrtf(x[e] > -0.5f ? q[e] : w[e]);
        const f32x4 bb = m2 * ig;
#pragma unroll
        for (int e = 0; e < 4; ++e) { av[4 * g4 + e] = a[e]; bv[4 * g4 + e] = bb[e]; }
        __builtin_amdgcn_sched_barrier(0);
    }
}
template <bool FINAL>
__device__ __forceinline__ void mix_scan(LAS unsigned char* lds, const bf16* UX, const bf16* GY, const bf16* WGT, const float* rw, const float* rb, const float* b_a, const float* b_i, const float* lam,
                                         f32x2* TOT, bf16* YMIX, int G, int bx, int lane, int wave) {
    LAS unsigned char* UXT = lds + wave * 16896;
    LAS unsigned char* XRT = UXT + 8704;
    const int h = wave, j = lane & 31, hh = lane >> 5, dg = lane & 7, tg = lane >> 3;
    float c8v[2], bav[2], biv[2];
#pragma unroll
    for (int ec = 0; ec < 2; ++ec) { const int ch = 64 * h + 32 * ec + j; c8v[ec] = -8.0f * 1.4426950408889634f * log1pf(expf(-lam[ch]));   bav[ec] = b_a[ch]; biv[ec] = b_i[ch]; }
    for (int it = bx; it < 512; it += G) {
        asm volatile("" ::: "memory");
        int b, c; scan_decode(it, b, c);
        const size_t mrow0 = (size_t)b * SEQ + 64 * c;
#pragma unroll
        for (int i = 0; i < 9; ++i) { const int row = i * 8 + tg, tok = 64 * c - 3 + row; v4u v = {0u, 0u, 0u, 0u};
            if (row < 67 && tok >= 0) v = *(const v4u*)(UX + ((size_t)b * SEQ + tok) * DR + 64 * h + 8 * dg);
            if (row < 68) *(LAS v4u*)(UXT + row * 128 + dg * 16) = v; }
        pg8::bf16x8 bfr[2][4];
#pragma unroll
        for (int g = 0; g < 2; ++g)
#pragma unroll
            for (int ks = 0; ks < 4; ++ks) bfr[g][ks] = *(const pg8::bf16x8*)(WGT + ((size_t)(h * 128 + 64 * g + j)) * 64 + 16 * ks + 8 * hh);
        v4u gyv[8];
        if (FINAL) {
#pragma unroll
            for (int i = 0; i < 8; ++i) gyv[i] = *(const v4u*)(GY + (mrow0 + i * 8 + tg) * DR + 64 * h + 8 * dg);
        }
        float Hc = 0.f;
        if (FINAL) { const f32x2* tp = TOT + ((size_t)b * 64) * DR + 64 * h + lane; int cc = 0;
            for (; cc + 8 <= c; cc += 8) { f32x2 t8[8];
#pragma unroll
                for (int u = 0; u < 8; ++u) t8[u] = tp[(size_t)(cc + u) * DR];
#pragma unroll
                for (int u = 0; u < 8; ++u) Hc = Hc * t8[u].x + t8[u].y; }
            for (; cc < c; ++cc) { const f32x2 ab = tp[(size_t)cc * DR]; Hc = Hc * ab.x + ab.y; } }
        {
            f32x4 w4a[4], w4b[4];
#pragma unroll
            for (int k = 0; k < 4; ++k) { w4a[k] = *(const f32x4*)(rw + k * DR + 64 * h + 8 * dg); w4b[k] = *(const f32x4*)(rw + k * DR + 64 * h + 8 * dg + 4); }
            const f32x4 rb0 = *(const f32x4*)(rb + 64 * h + 8 * dg), rb1 = *(const f32x4*)(rb + 64 * h + 8 * dg + 4);
#pragma unroll
            for (int th = 0; th < 2; ++th) {
                f32x4 o0[4], o1[4];
#pragma unroll
                for (int t = 0; t < 4; ++t) { o0[t] = rb0; o1[t] = rb1; }
#pragma unroll
                for (int i = 0; i < 7; ++i) { const v4u v = *(const LAS v4u*)(UXT + (8 * tg + 4 * th + i) * 128 + dg * 16);
                    const f32x4 x0 = {bflo(v.x), bfhi(v.x), bflo(v.y), bfhi(v.y)}, x1 = {bflo(v.z), bfhi(v.z), bflo(v.w), bfhi(v.w)};
#pragma unroll
                    for (int k = 0; k < 4; ++k) { const int t = i - k; if (t >= 0 && t < 4) { o0[t] += w4a[k] * x0; o1[t] += w4b[k] * x1; } } }
#pragma unroll
                for (int t = 0; t < 4; ++t) *(LAS v4u*)(XRT + (8 * tg + 4 * th + t) * 128 + dg * 16) = pack8(o0[t], o1[t]);
            }
        }
        if (FINAL) {
#pragma unroll
            for (int i = 0; i < 8; ++i) *(LAS v4u*)(UXT + (i * 8 + tg) * 128 + dg * 16) = gyv[i];
        }
#pragma unroll
        for (int ec = 0; ec < 2; ++ec) {
            const int ch = 64 * h + 32 * ec + j;
            const float c8 = c8v[ec], ba = bav[ec], bi = biv[ec];
            f32x16 av[2], bv[2];
#pragma unroll
            for (int tt = 0; tt < 2; ++tt) {
                pg8::bf16x8 afr[4];
#pragma unroll
                for (int ks = 0; ks < 4; ++ks) afr[ks] = *(const LAS pg8::bf16x8*)(XRT + (32 * tt + j) * 128 + (16 * ks + 8 * hh) * 2);
                f32x16 pa, pi;
#pragma unroll
                for (int r = 0; r < 16; ++r) { pa[r] = 0.f; pi[r] = 0.f; }
#pragma unroll
                for (int ks = 0; ks < 4; ++ks) {
                    pa = __builtin_amdgcn_mfma_f32_32x32x16_bf16(afr[ks], bfr[0][ks], pa, 0, 0, 0);
                    pi = __builtin_amdgcn_mfma_f32_32x32x16_bf16(afr[ks], bfr[1][ks], pi, 0, 0, 0); }
                if (ec == 0 && tt == 1) {
#pragma unroll
                    for (int g = 0; g < 2; ++g)
#pragma unroll
                        for (int ks = 0; ks < 4; ++ks) bfr[g][ks] = *(const pg8::bf16x8*)(WGT + ((size_t)(h * 128 + 64 * g + 32 + j)) * 64 + 16 * ks + 8 * hh);
                }
                gate_math16(pa, pi, ba, bi, c8, av[tt], bv[tt]);
                {
                    f32x16 px;
#pragma unroll
                    for (int r = 0; r < 16; ++r) px[r] = bv[tt][r] * 0.f;
                    int dd = 32 * ec + j - 8 * hh; asm volatile("" : "+v"(dd));
                    const unsigned one = (dd & 1) ? 0x3F800000u : 0x00003F80u;
#pragma unroll
                    for (int ks = 0; ks < 4; ++ks) {
                        const int dw = (dd - 16 * ks) >> 1;
                        v4u idw; idw.x = dw == 0 ? one : 0u; idw.y = dw == 1 ? one : 0u; idw.z = dw == 2 ? one : 0u; idw.w = dw == 3 ? one : 0u;
                        px = __builtin_amdgcn_mfma_f32_32x32x16_bf16(afr[ks], __builtin_bit_cast(pg8::bf16x8, idw), px, 0, 0, 0); }
#pragma unroll
                    for (int r = 0; r < 16; ++r) bv[tt][r] *= px[r];
                }
            }
            float GA[2][4], GB[2][4], PA[2][4], PB[2][4];
#pragma unroll
            for (int tt = 0; tt < 2; ++tt)
#pragma unroll
                for (int q = 0; q < 4; ++q) { const float a0 = av[tt][4 * q], a1 = av[tt][4 * q + 1], a2 = av[tt][4 * q + 2], a3 = av[tt][4 * q + 3];
                    const float b0 = bv[tt][4 * q], b1 = bv[tt][4 * q + 1], b2 = bv[tt][4 * q + 2], b3 = bv[tt][4 * q + 3];
                    GA[tt][q] = (a0 * a1) * (a2 * a3); GB[tt][q] = ((b0 * a1 + b1) * a2 + b2) * a3 + b3;
                    PA[tt][q] = __shfl_xor(GA[tt][q], 32); PB[tt][q] = __shfl_xor(GB[tt][q], 32); }
            if (!FINAL) {
                float At = 1.f, Bt = 0.f;
#pragma unroll
                for (int tt = 0; tt < 2; ++tt)
#pragma unroll
                    for (int q = 0; q < 4; ++q) { const float A0 = hh ? PA[tt][q] : GA[tt][q], B0 = hh ? PB[tt][q] : GB[tt][q], A1 = hh ? GA[tt][q] : PA[tt][q], B1 = hh ? GB[tt][q] : PB[tt][q];
                        Bt = (Bt * A0 + B0) * A1 + B1; At = (At * A0) * A1; }
                if (hh == 0) TOT[((size_t)b * 64 + c) * DR + ch] = (f32x2){At, Bt};
            } else {
                float hc = __shfl(Hc, 32 * ec + j);
#pragma unroll
                for (int tt = 0; tt < 2; ++tt)
#pragma unroll
                    for (int q = 0; q < 4; ++q) { const float A0 = hh ? PA[tt][q] : GA[tt][q], B0 = hh ? PB[tt][q] : GB[tt][q], A1 = hh ? GA[tt][q] : PA[tt][q], B1 = hh ? GB[tt][q] : PB[tt][q];
                        const float mid = hc * A0 + B0; float hv = hh ? mid : hc; hc = mid * A1 + B1;
#pragma unroll
                        for (int i = 0; i < 4; ++i) { hv = av[tt][4 * q + i] * hv + bv[tt][4 * q + i]; av[tt][4 * q + i] = hv; } }
#pragma unroll
                for (int tt = 0; tt < 2; ++tt)
#pragma unroll
                    for (int r = 0; r < 16; ++r) { const int tk = 32 * tt + (r & 3) + 8 * (r >> 2) + 4 * hh;
                        LAS u16* p = (LAS u16*)(UXT + tk * 128 + (32 * ec + j) * 2);
                        const float gy = __uint_as_float((unsigned)(*p) << 16);
                        *p = (u16)f2bf(gy * av[tt][r]); }
            }
        }
        if (FINAL) {
#pragma unroll
            for (int i = 0; i < 8; ++i) { const int row = i * 8 + tg; *(v4u*)(YMIX + (mrow0 + row) * D + DC + 64 * h + 8 * dg) = *(const LAS v4u*)(UXT + row * 128 + dg * 16); }
        }
    }
    __syncthreads();
}

#ifndef FOLD_B
#define FOLD_B 4
#endif
__device__ __forceinline__ void fold_chunks(const gu64* tp, int c0, int c1, int hh, float& A, float& B) {
    const int mid = (c0 + c1 + 1) >> 1, lo = hh ? mid : c0, hi2 = hh ? c1 : mid;
    float Ar = 1.f, Br = 0.f;
    for (int cc = lo; cc < hi2; cc += FOLD_B) { unsigned long long t8[FOLD_B];
        for (unsigned sp = 0;; ++sp) { unsigned all = 0x80000000u;
#pragma unroll
            for (int u = 0; u < FOLD_B; ++u) t8[u] = __hip_atomic_load(tp + (size_t)(cc + u < 63 ? cc + u : 63) * DR, RLX_AGENT);
#pragma unroll
            for (int u = 0; u < FOLD_B; ++u) all &= (cc + u < hi2) ? (unsigned)t8[u] : 0x80000000u;
            if (all || sp > (1u << 16)) break;
            __builtin_amdgcn_s_sleep(1); }
#pragma unroll
        for (int u = 0; u < FOLD_B; ++u) { const bool ok = cc + u < hi2; const float ta = ok ? __uint_as_float((unsigned)t8[u] & 0x7fffffffu) : 1.f, tb = ok ? __uint_as_float((unsigned)(t8[u] >> 32)) : 0.f; Br = Br * ta + tb; Ar = Ar * ta; } }
    const float Ap = __shfl_xor(Ar, 32), Bp = __shfl_xor(Br, 32);
    A = Ar * Ap; B = hh ? (Bp * Ar + Br) : (Br * Ap + Bp);
}
__device__ __forceinline__ void mix_scan1(LAS unsigned char* lds, const bf16* UX, const bf16* GY, const bf16* WGT, const float* rw, const float* rb, const float* b_a, const float* b_i, const float* lam,
                                          f32x2* TOT, unsigned* cnt, bf16* YMIX, int G, int bx, int lane, int wave) {
    LAS unsigned char* UXT = lds + wave * 16896;
    LAS unsigned char* XRT = UXT + 8704;
    const int h = wave, j = lane & 31, hh = lane >> 5, dg = lane & 7, tg = lane >> 3;
    const int gs = G >> 3, b = bx / gs, idx = bx - b * gs;
    float c8v[2], bav[2], biv[2];
#pragma unroll
    for (int ec = 0; ec < 2; ++ec) { const int ch = 64 * h + 32 * ec + j; c8v[ec] = -8.0f * 1.4426950408889634f * log1pf(expf(-lam[ch])); bav[ec] = b_a[ch]; biv[ec] = b_i[ch]; }
    for (int c = idx, round = 0; c < 64; c += gs, ++round) {
        asm volatile("" ::: "memory");
        PROF_BEGIN(3);
        const size_t mrow0 = (size_t)b * SEQ + 64 * c;
#pragma unroll
        for (int i = 0; i < 9; ++i) { const int row = i * 8 + tg, tok = 64 * c - 3 + row; v4u v = {0u, 0u, 0u, 0u};
            if (row < 67 && tok >= 0) v = *(const v4u*)(UX + ((size_t)b * SEQ + tok) * DR + 64 * h + 8 * dg);
            if (row < 68) *(LAS v4u*)(UXT + row * 128 + dg * 16) = v; }
        pg8::bf16x8 bfr[2][4];
#pragma unroll
        for (int g = 0; g < 2; ++g)
#pragma unroll
            for (int ks = 0; ks < 4; ++ks) bfr[g][ks] = *(const pg8::bf16x8*)(WGT + ((size_t)(h * 128 + 64 * g + j)) * 64 + 16 * ks + 8 * hh);
        {
            f32x4 w4a[4], w4b[4];
#pragma unroll
            for (int k = 0; k < 4; ++k) { w4a[k] = *(const f32x4*)(rw + k * DR + 64 * h + 8 * dg); w4b[k] = *(const f32x4*)(rw + k * DR + 64 * h + 8 * dg + 4); }
            const f32x4 rb0 = *(const f32x4*)(rb + 64 * h + 8 * dg), rb1 = *(const f32x4*)(rb + 64 * h + 8 * dg + 4);
#pragma unroll
            for (int th = 0; th < 2; ++th) {
                f32x4 o0[4], o1[4];
#pragma unroll
                for (int t = 0; t < 4; ++t) { o0[t] = rb0; o1[t] = rb1; }
#pragma unroll
                for (int i = 0; i < 7; ++i) { const v4u v = *(const LAS v4u*)(UXT + (8 * tg + 4 * th + i) * 128 + dg * 16);
                    const f32x4 x0 = {bflo(v.x), bfhi(v.x), bflo(v.y), bfhi(v.y)}, x1 = {bflo(v.z), bfhi(v.z), bflo(v.w), bfhi(v.w)};
#pragma unroll
                    for (int k = 0; k < 4; ++k) { const int t = i - k; if (t >= 0 && t < 4) { o0[t] += w4a[k] * x0; o1[t] += w4b[k] * x1; } } }
#pragma unroll
                for (int t = 0; t < 4; ++t) *(LAS v4u*)(XRT + (8 * tg + 4 * th + t) * 128 + dg * 16) = pack8(o0[t], o1[t]);
            }
        }
        PROF_END(3);
#pragma unroll
        for (int ec = 0; ec < 2; ++ec) {
            PROF_BEGIN(4);
            const int ch = 64 * h + 32 * ec + j;
            const float c8 = c8v[ec], ba = bav[ec], bi = biv[ec];
            unsigned* cw = cnt + 64 * (8 * ec + b);
            f32x16 av[2], bv[2];
#pragma unroll
            for (int tt = 0; tt < 2; ++tt) {
                pg8::bf16x8 afr[4];
#pragma unroll
                for (int ks = 0; ks < 4; ++ks) afr[ks] = *(const LAS pg8::bf16x8*)(XRT + (32 * tt + j) * 128 + (16 * ks + 8 * hh) * 2);
                f32x16 pa, pi;
#pragma unroll
                for (int r = 0; r < 16; ++r) { pa[r] = 0.f; pi[r] = 0.f; }
#pragma unroll
                for (int ks = 0; ks < 4; ++ks) {
                    pa = __builtin_amdgcn_mfma_f32_32x32x16_bf16(afr[ks], bfr[0][ks], pa, 0, 0, 0);
                    pi = __builtin_amdgcn_mfma_f32_32x32x16_bf16(afr[ks], bfr[1][ks], pi, 0, 0, 0); }
                if (ec == 0 && tt == 1) {
#pragma unroll
                    for (int g = 0; g < 2; ++g)
#pragma unroll
                        for (int ks = 0; ks < 4; ++ks) bfr[g][ks] = *(const pg8::bf16x8*)(WGT + ((size_t)(h * 128 + 64 * g + 32 + j)) * 64 + 16 * ks + 8 * hh);
                }
                gate_math16(pa, pi, ba, bi, c8, av[tt], bv[tt]);
                {
                    f32x16 px;
#pragma unroll
                    for (int r = 0; r < 16; ++r) px[r] = bv[tt][r] * 0.f;
                    int dd = 32 * ec + j - 8 * hh; asm volatile("" : "+v"(dd));
                    const unsigned one = (dd & 1) ? 0x3F800000u : 0x00003F80u;
#pragma unroll
                    for (int ks = 0; ks < 4; ++ks) {
                        const int dw = (dd - 16 * ks) >> 1;
                        v4u idw; idw.x = dw == 0 ? one : 0u; idw.y = dw == 1 ? one : 0u; idw.z = dw == 2 ? one : 0u; idw.w = dw == 3 ? one : 0u;
                        px = __builtin_amdgcn_mfma_f32_32x32x16_bf16(afr[ks], __builtin_bit_cast(pg8::bf16x8, idw), px, 0, 0, 0); }
#pragma unroll
                    for (int r = 0; r < 16; ++r) bv[tt][r] *= px[r];
                }
            }
            float GA[2][4], GB[2][4], PA[2][4], PB[2][4];
            float At = 1.f, Bt = 0.f;
#pragma unroll
            for (int tt = 0; tt < 2; ++tt)
#pragma unroll
                for (int q = 0; q < 4; ++q) { const float a0 = av[tt][4 * q], a1 = av[tt][4 * q + 1], a2 = av[tt][4 * q + 2], a3 = av[tt][4 * q + 3];
                    const float b0 = bv[tt][4 * q], b1 = bv[tt][4 * q + 1], b2 = bv[tt][4 * q + 2], b3 = bv[tt][4 * q + 3];
                    GA[tt][q] = (a0 * a1) * (a2 * a3); GB[tt][q] = ((b0 * a1 + b1) * a2 + b2) * a3 + b3;
                    PA[tt][q] = __shfl_xor(GA[tt][q], 32); PB[tt][q] = __shfl_xor(GB[tt][q], 32);
                    const float A0 = hh ? PA[tt][q] : GA[tt][q], B0 = hh ? PB[tt][q] : GB[tt][q], A1 = hh ? GA[tt][q] : PA[tt][q], B1 = hh ? GB[tt][q] : PB[tt][q];
                    Bt = (Bt * A0 + B0) * A1 + B1; At = (At * A0) * A1; }
            if (hh == 0) __hip_atomic_store((gu64*)(TOT + ((size_t)b * 64 + c) * DR + ch), ((unsigned long long)__float_as_uint(Bt) << 32) | (__float_as_uint(At) | 0x80000000u), RLX_AGENT);
            PROF_END(4); PROF_BEGIN(7);
            if (ec == 0) {
#pragma unroll
                for (int i = 0; i < 8; ++i) *(LAS v4u*)(UXT + (i * 8 + tg) * 128 + dg * 16) = *(const v4u*)(GY + (mrow0 + i * 8 + tg) * DR + 64 * h + 8 * dg);
            }
            PROF_END(7);
            PROF_BEGIN(2);
            const gu64* tp = (const gu64*)(TOT + ((size_t)b * 64) * DR + ch);
            float hc;
            { float Aq, Bq; fold_chunks(tp, 0, c, hh, Aq, Bq); hc = Bq; }
            PROF_END(2); PROF_BEGIN(5);
#pragma unroll
            for (int tt = 0; tt < 2; ++tt)
#pragma unroll
                for (int q = 0; q < 4; ++q) { const float A0 = hh ? PA[tt][q] : GA[tt][q], B0 = hh ? PB[tt][q] : GB[tt][q], A1 = hh ? GA[tt][q] : PA[tt][q], B1 = hh ? GB[tt][q] : PB[tt][q];
                    const float mid = hc * A0 + B0; float hv = hh ? mid : hc; hc = mid * A1 + B1;
#pragma unroll
                    for (int i = 0; i < 4; ++i) { hv = av[tt][4 * q + i] * hv + bv[tt][4 * q + i]; av[tt][4 * q + i] = hv; } }
#pragma unroll
            for (int tt = 0; tt < 2; ++tt)
#pragma unroll
                for (int r = 0; r < 16; ++r) { const int tk = 32 * tt + (r & 3) + 8 * (r >> 2) + 4 * hh;
                    LAS u16* p = (LAS u16*)(UXT + tk * 128 + (32 * ec + j) * 2);
                    const float gy = __uint_as_float((unsigned)(*p) << 16);
                    *p = (u16)f2bf(gy * av[tt][r]); }
            PROF_END(5);
        }
        PROF_BEGIN(6);
#pragma unroll
        for (int i = 0; i < 8; ++i) { const int row = i * 8 + tg; *(v4u*)(YMIX + (mrow0 + row) * D + DC + 64 * h + 8 * dg) = *(const LAS v4u*)(UXT + row * 128 + dg * 16); }
        PROF_END(6);
    }
    __syncthreads();
}

struct Args { const float* in[27]; float* out; unsigned char* ws; int ph_lo, ph_hi; };
constexpr int NPH = 10;
#ifndef MK_PER_PHASE
#define MK_PER_PHASE 0
#endif
#define MK_STR2(x) #x
#define MK_STR(x) MK_STR2(x)
#ifndef MK_REP_P1X
#define MK_REP_P1X 1
#endif
#ifndef MK_REP_P1B
#define MK_REP_P1B 1
#endif
#ifndef MK_REP_GEMV
#define MK_REP_GEMV 1
#endif
#ifndef MK_REP_QUANT
#define MK_REP_QUANT 1
#endif
#ifndef MK_REP_TRANS
#define MK_REP_TRANS 1
#endif
#ifndef MK_REP_LO
#define MK_REP_LO 0
#define MK_REP_HI 0
#endif

__global__ void __launch_bounds__(NWAVES * 64, 2) mk_fwd(Args args) {
    extern __shared__ __attribute__((aligned(16))) unsigned char lds_raw[];
    LAS unsigned char* lds = (LAS unsigned char*)lds_raw;
    const int tid = threadIdx.x, wave = __builtin_amdgcn_readfirstlane(tid >> 6);
#define LANE_HERE int lane; asm volatile("v_mbcnt_lo_u32_b32 %0, -1, 0\n\tv_mbcnt_hi_u32_b32 %0, -1, %0" : "=v"(lane))
    const int G = gridDim.x, bx = blockIdx.x;
    const int vcu = (G % 8 == 0) ? (bx % 8) * (G / 8) + bx / 8 : bx;
    const int gw = vcu * NWAVES + wave, NGW = G * NWAVES;
    unsigned char* ws = args.ws;
    gu32* ctl = (gu32*)(ws + WS_CTL);
    const float* x = args.in[0]; const float* cvec = args.in[1]; const float* w_mod = args.in[2]; const float* b_mod = args.in[3];
    const float* g1 = args.in[4]; const float* w1i = args.in[5]; const float* w1o = args.in[6]; const float* gm = args.in[7];
    const float* w_in = args.in[8]; const float* conv_w = args.in[9]; const float* conv_b = args.in[10]; const float* ln_g = args.in[11]; const float* ln_b = args.in[12];
    const float* rw = args.in[13]; const float* rb = args.in[14]; const float* wa = args.in[15]; const float* b_a = args.in[16];
    const float* wi = args.in[17]; const float* b_i = args.in[18]; const float* lam = args.in[19]; const float* w_out = args.in[20];
    const float* g2 = args.in[21]; const float* w2i = args.in[22]; const float* w2o = args.in[23]; const float* w_fmod = args.in[24];
    const float* b_fmod = args.in[25]; const float* gf = args.in[26];
    float* out = args.out;
    float* MOD = (float*)(ws + WS_MOD); float* SHMAX3 = (float*)(ws + WS_BIAS1); float* BIAS2 = (float*)(ws + WS_BIAS2);
    bf16* WGT = (bf16*)(ws + WS_WGT); f32x2* TOT = (f32x2*)(ws + WS_TOT); float* SSP = (float*)(ws + WS_SSP);
    bf16 *W1O = (bf16*)(ws + WS_W1O), *WIN = (bf16*)(ws + WS_WIN), *WOUT = (bf16*)(ws + WS_WOUT), *W2O = (bf16*)(ws + WS_W2O);
    unsigned char *W1O8F = ws + WS_W1O, *W2O8F = ws + WS_W2O, *W1I8 = ws + WS_W1I, *W2I8 = ws + WS_W2I, *WIN8 = ws + WS_WIN, *A8 = ws + WS_Y;
    float *CS1 = (float*)(ws + WS_CS1), *CS3 = (float*)(ws + WS_CS3), *CS2 = (float*)(ws + WS_CS2), *RS1 = (float*)(ws + WS_RS1), *RS3 = (float*)(ws + WS_RS3), *RS2 = (float*)(ws + WS_RS2);
    bf16 *Y = (bf16*)(ws + WS_Y), *ACT = (bf16*)(ws + WS_ACT), *U = (bf16*)(ws + WS_U), *UXB = (bf16*)(ws + WS_UX), *GYB = (bf16*)(ws + WS_GY), *YMIX = (bf16*)(ws + WS_YMIX);
    bf16* X1 = (bf16*)(ws + WS_X1);

    for (int u = tid; u < (LDS_BYTES - LDSCTL_OFF) / 4; u += NWAVES * 64) ((LAS unsigned*)(lds + LDSCTL_OFF))[u] = 0u;
    __syncthreads();
    const int lo = args.ph_lo, hi = args.ph_hi;
    const bool use_bar = (hi - lo) > 1;
    XcdBarrier bar; bar.bar = (unsigned*)(ctl + CW_BAR); bar.x = 0; bar.st = nullptr;
    if (use_bar) bar = xcd_barrier_post((unsigned*)(ctl + CW_BAR), (volatile LAS unsigned*)(lds + LDSCTL_OFF) + 8);
#define IN(k) (lo <= (k) && (k) < hi)
#define REPS(k) ((MK_REP_LO <= (k) && (k) < MK_REP_HI) ? 2 : 1)
#define AGAIN(k, rr) do { if ((rr) + 1 < REPS(k)) xcd_barrier(bar); } while (0)
#define SEAM(k) do { if (IN(k) && IN((k) + 1)) { PROF_BEGIN(8); PROF_BEGIN(9); xcd_barrier(bar); PROF_END(8); if ((k) == MK_PROF_SEAM) { PROF_END(9); } } } while (0)

    if (IN(0))
_Pragma("unroll")
    for (int rr = 0; rr < REPS(0); ++rr) { PROF_SETPH(0); PROF_BEGIN(15); LANE_HERE;
#ifdef MK_PAD
        asm volatile(".rept " MK_STR(MK_PAD) "\n\ts_nop 0\n\t.endr" ::: "memory");
#endif
        constexpr int NGEMV = 88, NQ = 2 * (FF2 / 32);
        constexpr int I_1O = (FF / 64) * (D / 32), I_IN = (D / 64) * (NMIX / 32), I_OUT = (D / 64) * (D / 32);
        constexpr int NITEMS = 2 * I_1O + I_IN + I_OUT, NGRP = NITEMS / NWAVES;
        static_assert(NITEMS % NWAVES == 0, "transpose groups");
        auto quant = [&](int it) { if (it < FF2 / 32) p0_quant_item(lds, w1i, FF2, 1, W1I8, CS1, it, lane, wave); else p0_quant_item(lds, w2i, FF2, 1, W2I8, CS3, it - FF2 / 32, lane, wave); };
        auto group = [&](int gidx) { LAS float* scr = (LAS float*)(lds + wave * 16384); const int r = gidx * NWAVES + wave;
            if (r < I_1O) p0_transpose8_item(w1o, FF, D, W1O8F, scr, r, lane);
            else if (r < 2 * I_1O) p0_transpose8_item(w2o, FF, D, W2O8F, scr, r - I_1O, lane);
            else if (r < 2 * I_1O + I_IN) p0_transpose_item(w_in, D, NMIX, WIN, 2, scr, r - 2 * I_1O, lane);
            else p0_transpose_item(w_out, D, D, WOUT, 0, scr, r - 2 * I_1O - I_IN, lane); };
        if (G == 256) {
            if (bx < NGEMV) {
                if (bx < 72) p0_gemv(lds, cvec, w_mod, 9 * D, b_mod, MOD, 128 * bx, tid); else p0_gemv(lds, cvec, w_fmod, 2 * D, b_fmod, MOD + 9 * D, 128 * (bx - 72), tid);
                quant(bx);
            } else { const int j = bx - NGEMV;
                quant(NGEMV + j);
                if (j < 96) { quant(256 + j); group(2 * j); group(2 * j + 1); }
                else { const int g0 = 192 + 5 * (j - 96);
                    for (int q = 0; q < 5; ++q) if (g0 + q < NGRP) group(g0 + q); }
            }
        } else {
            for (int t = bx; t < NGEMV; t += G) { if (t < 72) p0_gemv(lds, cvec, w_mod, 9 * D, b_mod, MOD, 128 * t, tid); else p0_gemv(lds, cvec, w_fmod, 2 * D, b_fmod, MOD + 9 * D, 128 * (t - 72), tid); }
            for (int t = bx; t < NQ; t += G) quant(t);
            for (int t = bx; t < NGRP; t += G) group(t);
        }
        __syncthreads();
        for (int i = bx * 512 + tid; i < NB * 64 * DR / 2; i += G * 512) ((v4u*)TOT)[i] = (v4u){0u, 0u, 0u, 0u};
        for (int i = bx * 512 + tid; i < NH * 128 * HD; i += G * 512) { const int d = i & 63, e2 = (i >> 6) & 127, hd = i >> 13;
            const float v = e2 < 64 ? wa[(hd * 64 + d) * 64 + e2] : wi[(hd * 64 + d) * 64 + (e2 - 64)]; WGT[i] = (bf16)f2bf(v); }
        PROF_END_PH(15);
        AGAIN(0, rr);
    }
    SEAM(0);
    if (IN(1))
_Pragma("unroll")
    for (int rr = 0; rr < REPS(1); ++rr) { PROF_SETPH(1); PROF_BEGIN(15); LANE_HERE;
        LAS float* shl = (LAS float*)lds;
        for (int i = tid * 4; i < 3 * NB * D; i += 2048) { const int t = i >> 13, r = i & 8191, b = r >> 10, k = r & 1023; *(LAS f32x4*)(shl + i) = *(const f32x4*)(MOD + (size_t)b * LDM + 3 * t * D + k); }
        __syncthreads();
        for (int rp = 0; rp < MK_REP_P1X; ++rp)
        for (int m0 = gw; m0 < M; m0 += 2 * NGW) {
            f32x4 v[2][4];
#pragma unroll
            for (int rr2 = 0; rr2 < 2; ++rr2) { const int m = (m0 + rr2 * NGW < M) ? m0 + rr2 * NGW : m0; const f32x4* xr = (const f32x4*)(x + (size_t)m * D) + lane;
#pragma unroll
                for (int jj = 0; jj < 4; ++jj) v[rr2][jj] = xr[64 * jj]; }
#pragma unroll
            for (int rr2 = 0; rr2 < 2; ++rr2) { const int m = m0 + rr2 * NGW; if (m < M) { const int b = m >> 12;
                float s = 0.f, am = 0.f;
#pragma unroll
                for (int jj = 0; jj < 4; ++jj) s += (v[rr2][jj][0] * v[rr2][jj][0] + v[rr2][jj][1] * v[rr2][jj][1]) + (v[rr2][jj][2] * v[rr2][jj][2] + v[rr2][jj][3] * v[rr2][jj][3]);
                const float rstd = rsqrtf(wave_sum(s) * (1.0f / D) + EPS);
#pragma unroll
                for (int jj = 0; jj < 4; ++jj) { const int k = 4 * lane + 256 * jj;
                    v[rr2][jj] = v[rr2][jj] * (*(const f32x4*)(g1 + k) * (*(const f32x4*)(MOD + (size_t)b * LDM + 1 * D + k) + 1.0f) * rstd) + *(const LAS f32x4*)(shl + (0 * NB + b) * D + k);
                    const f32x4 t = __builtin_elementwise_abs(v[rr2][jj]); am = fmaxf(am, fmaxf(fmaxf(t[0], t[1]), fmaxf(t[2], t[3]))); }
                am = wave_max(am);
                const float q = am > 0.f ? 127.0f / am : 0.f;
#pragma unroll
                for (int jj = 0; jj < 4; ++jj) *(unsigned*)(A8 + (size_t)m * D + 4 * lane + 256 * jj) = q8x4(v[rr2][jj] * q);
                if (lane == 0) RS1[m] = am * (1.0f / 127.0f); } }
        }
        for (int rp = 0; rp < MK_REP_P1B; ++rp)
        if (gw < NB) { float a = 0.f;
            for (int k = lane; k < D; k += 64) a = fmaxf(a, fabsf(shl[(2 * NB + gw) * D + k]));
            a = wave_max(a); if (lane == 0) SHMAX3[gw] = a; }
        for (int it = gw; it < NMIX; it += NGW) {
            {
                const bf16* wrow = WIN + (size_t)it * D; float* op = BIAS2 + it;
                const v4u wA = *(const v4u*)(wrow + 8 * lane), wB = *(const v4u*)(wrow + 512 + 8 * lane);
                f32x4 a0, a1, c0, c1; unpack8(wA, a0, a1); unpack8(wB, c0, c1);
#pragma unroll
                for (int b = 0; b < NB; ++b) { const LAS float* sp = shl + (1 * NB + b) * D + 8 * lane;
                    const f32x4 p = a0 * *(const LAS f32x4*)(sp) + a1 * *(const LAS f32x4*)(sp + 4) + c0 * *(const LAS f32x4*)(sp + 512) + c1 * *(const LAS f32x4*)(sp + 516);
                    const float tot = wave_sum((p[0] + p[1]) + (p[2] + p[3]));
                    if (lane == 0) op[(size_t)b * NMIX] = tot; }
            }
        }
        __syncthreads();
        PROF_END_PH(15);
        AGAIN(1, rr);
    }
    SEAM(1);
    if (IN(2))
_Pragma("unroll")
    for (int rr = 0; rr < REPS(2); ++rr) { PROF_SETPH(2); PROF_BEGIN(15);
        pg8::Gemm g{(const pg8::bf16_t*)A8, (const pg8::bf16_t*)W1I8, M, FF2, D / 2}; pg8::StaticOrder S; S.init(M, FF2, G, bx);
        EpiSwiglu8<true> E{ACT, RS1, CS1};
        pg8::gemm_phase<EpiSwiglu8<true>, pg8::StaticOrder, true, true, 1>(lds, g, S, E);
        PROF_END_PH(15);
        AGAIN(2, rr);
    }
    SEAM(2);
    if (IN(3))
_Pragma("unroll")
    for (int rr = 0; rr < REPS(3); ++rr) { PROF_SETPH(3); PROF_BEGIN(15);
        pg8::Gemm g{ACT, (const pg8::bf16_t*)W1O8F, M, D, FF / 2}; pg8::StaticOrder S; S.init(M, D, G, bx);
        EpiResid<1, true, false, true> E{x, X1, Y, SSP, MOD + 2 * D, gm, MOD + 4 * D};
        pg8::gemm_phase<EpiResid<1, true, false, true>, pg8::StaticOrder, true, true, 2>(lds, g, S, E);
        PROF_END_PH(15);
        AGAIN(3, rr);
    }
    SEAM(3);
    if (IN(4))
_Pragma("unroll")
    for (int rr = 0; rr < REPS(4); ++rr) { PROF_SETPH(4); PROF_BEGIN(15);
        pg8::Gemm g{Y, WIN, M, NMIX, D}; pg8::StaticOrder S; S.init(M, NMIX, G, bx);
        EpiMixIn E{U, UXB, GYB, SSP, BIAS2};
        pg8::gemm_phase<EpiMixIn, pg8::StaticOrder, true, true>(lds, g, S, E);
        PROF_END_PH(15);
        AGAIN(4, rr);
    }
    SEAM(4);
    if (IN(5))
_Pragma("unroll")
    for (int rr = 0; rr < REPS(5); ++rr) { PROF_SETPH(5); PROF_BEGIN(15); LANE_HERE;
        { PROF_BEGIN(0); mix_conv2(lds, U, conv_w, conv_b, ln_g, ln_b, YMIX, G, bx, tid, lane, wave); PROF_END(0); }
#ifdef MK_REP_CONV
        mix_conv2(lds, U, conv_w, conv_b, ln_g, ln_b, YMIX, G, bx, tid, lane, wave);
#endif
        { PROF_BEGIN(1); mix_scan1(lds, UXB, GYB, WGT, rw, rb, b_a, b_i, lam, TOT, (unsigned*)(ctl + CW_SCAN), YMIX, G, bx, lane, wave); PROF_END(1); }
        PROF_END_PH(15);
        AGAIN(5, rr);
    }
    SEAM(5);
    if (IN(7))
_Pragma("unroll")
    for (int rr = 0; rr < REPS(7); ++rr) { PROF_SETPH(7); PROF_BEGIN(15);
        pg8::Gemm g{YMIX, WOUT, M, D, D}; pg8::StaticOrder S; S.init(M, D, G, bx);
        EpiResidQ<0, true> E{X1, X1, A8, RS3, (f32x2*)(ws + WS_SSPX), MOD + 5 * D, g2, MOD + 7 * D, MOD + 6 * D, SHMAX3, (unsigned*)(ctl + CW_SEAM7)};
        pg8::gemm_phase<EpiResidQ<0, true>, pg8::StaticOrder, true, true>(lds, g, S, E);
        PROF_END_PH(15);
        AGAIN(7, rr);
    }
    SEAM(7);
    if (IN(8))
_Pragma("unroll")
    for (int rr = 0; rr < REPS(8); ++rr) { PROF_SETPH(8); PROF_BEGIN(15);
        pg8::Gemm g{(const pg8::bf16_t*)A8, (const pg8::bf16_t*)W2I8, M, FF2, D / 2}; pg8::StaticOrder S; S.init(M, FF2, G, bx);
        EpiSwiglu8<true> E{ACT, RS3, CS3};
        pg8::gemm_phase<EpiSwiglu8<true>, pg8::StaticOrder, true, true, 1>(lds, g, S, E);
        PROF_END_PH(15);
        AGAIN(8, rr);
    }
    SEAM(8);
    if (IN(9))
_Pragma("unroll")
    for (int rr = 0; rr < REPS(9); ++rr) { PROF_SETPH(9); PROF_BEGIN(15);
        pg8::Gemm g{ACT, (const pg8::bf16_t*)W2O8F, M, D, FF / 2}; pg8::StaticOrder S; S.init(M, D, G, bx);
        EpiResidFinal<true> E{X1, out, (float*)(ws + WS_SSPF), MOD + 8 * D, gf, MOD + 10 * D, MOD + 9 * D, (unsigned*)(ctl + CW_SEAM)};
        pg8::gemm_phase<EpiResidFinal<true>, pg8::StaticOrder, true, true, 2>(lds, g, S, E);
        PROF_END_PH(15);
    }
#ifdef MK_PROF_ID
    __syncthreads();
    if (bx == MK_PROF_WG && tid == 0) { const unsigned d = ((LAS unsigned*)(lds + LDSCTL_OFF))[40 + MK_PROF_ID]; const unsigned long long t0 = PROF_T(); while (PROF_T() - t0 < (unsigned long long)d * MK_PROF_K) __builtin_amdgcn_s_sleep(8); }
#endif
#undef IN
#undef SEAM
#undef REPS
#undef AGAIN
}

extern "C" void kernel_launch(void* const* d_in, const int* in_sizes, int n_in, void* d_out, int out_size, void* d_ws, size_t ws_size, hipStream_t stream) {
    static int grid = 0;
    if (grid == 0) {
        if (n_in != 27 || in_sizes[0] != M * D || out_size != M * D || ws_size < WS_END) { fprintf(stderr, "kernel_launch: unexpected shapes (n_in %d, in0 %d, out %d, ws %zu)\n", n_in, n_in > 0 ? in_sizes[0] : -1, out_size, ws_size); grid = -1; return; }
        int dev = 0, cus = 0, per_cu = 0;
        if (hipGetDevice(&dev) != hipSuccess || hipDeviceGetAttribute(&cus, hipDeviceAttributeMultiprocessorCount, dev) != hipSuccess) { grid = -1; return; }
        if (hipFuncSetAttribute((const void*)mk_fwd, hipFuncAttributeMaxDynamicSharedMemorySize, LDS_BYTES) != hipSuccess) { fprintf(stderr, "kernel_launch: hipFuncSetAttribute failed\n"); grid = -1; return; }
        if (hipOccupancyMaxActiveBlocksPerMultiprocessor(&per_cu, (const void*)mk_fwd, NWAVES * 64, LDS_BYTES) != hipSuccess || per_cu < 1) fprintf(stderr, "kernel_launch: occupancy query reports %d blocks per CU\n", per_cu);
        (void)hipGetLastError();
        grid = cus;
        if (grid % 8 != 0 || grid < 8) { fprintf(stderr, "kernel_launch: %d CUs: the scan's chunk rounds need a multiple of 8 workgroups\n", grid); grid = -1; return; }
    }
    if (grid < 0) return;
    if (hipMemsetAsync((char*)d_ws + WS_CTL, 0, CTL_ZERO_BYTES, stream) != hipSuccess) return;
    Args a{};
    for (int i = 0; i < 27; ++i) a.in[i] = (const float*)d_in[i];
    a.out = (float*)d_out; a.ws = (unsigned char*)d_ws;
#if MK_PER_PHASE
    for (int p = 0; p < NPH; ++p) { a.ph_lo = p; a.ph_hi = p + 1; hipLaunchKernelGGL(mk_fwd, dim3(grid), dim3(NWAVES * 64), LDS_BYTES, stream, a); }
#else
    a.ph_lo = 0; a.ph_hi = NPH; hipLaunchKernelGGL(mk_fwd, dim3(grid), dim3(NWAVES * 64), LDS_BYTES, stream, a);
#endif
}
```

```cpp
#include <hip/hip_runtime.h>
#include <cstdio>
#include <cstdint>
#ifndef MK_PROF_SEAM
#define MK_PROF_SEAM 99
#endif
#ifndef MK_PROF_PH
#define MK_PROF_PH 99
#endif
#ifdef MK_PROF_ID
#define PROF_W(i) ((__attribute__((address_space(3))) unsigned*)(unsigned)(147200) + (i))
#define PROF_T() __builtin_amdgcn_s_memrealtime()
#define PROF_BEGIN(id) do { if ((id) == MK_PROF_ID && threadIdx.x == 0) *PROF_W(10 + (id)) = (unsigned)PROF_T(); } while (0)
#define PROF_END(id) do { if ((id) == MK_PROF_ID && threadIdx.x == 0) *PROF_W(40 + (id)) += (unsigned)PROF_T() - *PROF_W(10 + (id)); } while (0)
#define PROF_SETPH(k) do { if ((MK_PROF_ID == 15 || MK_PROF_ID == 16) && threadIdx.x == 0) *PROF_W(39) = (k); } while (0)
#define PROF_END_PH(id) do { if ((id) == MK_PROF_ID && threadIdx.x == 0 && *PROF_W(39) == MK_PROF_PH) *PROF_W(40 + (id)) += (unsigned)PROF_T() - *PROF_W(10 + (id)); } while (0)
#else
#define PROF_BEGIN(id)
#define PROF_END(id)
#define PROF_SETPH(k)
#define PROF_END_PH(id)
#endif
#if defined(MK_PROF_ID) && MK_PROF_ID == 16
#define PROF16_DECL unsigned long long _p16t = 0; unsigned _p16a = 0
#define PROF16_BEGIN _p16t = PROF_T()
#define PROF16_END _p16a += (unsigned)(PROF_T() - _p16t)
#define PROF16_FLUSH do { if (threadIdx.x == 0 && *PROF_W(39) == MK_PROF_PH) *PROF_W(40 + 16) += _p16a; } while (0)
#else
#define PROF16_DECL
#define PROF16_BEGIN
#define PROF16_END
#define PROF16_FLUSH
#endif
namespace pg8 {
#define PG8_LAS __attribute__((address_space(3)))
typedef unsigned short bf16_t;
typedef short bf16x8 __attribute__((ext_vector_type(8)));
typedef float f32x4 __attribute__((ext_vector_type(4)));
typedef unsigned u32x4 __attribute__((ext_vector_type(4)));
constexpr int BM = 256, BK = 64, HALF = 128, HTB = HALF * BK * 2  , STAGE_BYTES = 8 * HTB, NXCD = 8, WGM = 8;

__host__ __device__ __forceinline__ int lds_byte(int r, int c) { const int st = (r >> 4) * 2 + (c >> 5), rr = r & 15, cc = c & 31, ob = rr * 64 + cc * 2; return st * 1024 + (ob ^ (((ob >> 9) & 1) << 5)); }
__host__ __device__ __forceinline__ void stage_rc(int b, int& R, int& C) { const int st = b / 1024, sb = b % 1024, swz = sb ^ (((sb >> 9) & 1) << 5); R = (st >> 1) * 16 + swz / 64; C = (st & 1) * 32 + (swz % 64) / 2; }
__host__ __device__ __forceinline__ int perm32(int rho) { const int n = rho >> 4, i = rho & 15; return 8 * (i >> 2) + 4 * n + (i & 3); }

struct Unit { int pm, pn; };
struct Gemm { const bf16_t* A; const bf16_t* Bt; int M, N, K; };

struct StaticOrder {
    int nM, nN, nwg, G, c;
    __host__ __device__ void init(int M, int N, int G_, int c_) { nM = M / BM; nN = N / BM; nwg = nM * nN; G = G_; c = c_; }
    __host__ __device__ bool next(int i, Unit& u) const {
        const long L = (long)i * G + c; if (L >= nwg) return false;
        int wgid = (int)L; { const int q = nwg / NXCD, r = nwg % NXCD, xcd = wgid % NXCD, off = wgid / NXCD; wgid = (xcd < r ? xcd * (q + 1) : r * (q + 1) + (xcd - r) * q) + off; }
        const int nig = WGM * nN, gid = wgid / nig, fm = gid * WGM, gsz = (nM - fm) < WGM ? (nM - fm) : WGM;
        u.pm = fm + ((wgid % nig) % gsz); u.pn = (wgid % nig) / gsz; return true;
    }
    __device__ __forceinline__ void a_ready(const Unit&) const {}
    __device__ __forceinline__ void done(const Unit&) const {}
};

__device__ __forceinline__ unsigned cvt_pk_bf16(float lo, float hi) { unsigned r; asm volatile("v_cvt_pk_bf16_f32 %0, %1, %2" : "=v"(r) : "v"(lo), "v"(hi)); return r; }
#ifndef PG8_STAGE_IN_MMA
#define PG8_STAGE_IN_MMA 0
#endif
typedef int i32x4 __attribute__((ext_vector_type(4)));
typedef int i32x8 __attribute__((ext_vector_type(8)));
__device__ __forceinline__ i32x8 cat32(const bf16x8 lo, const bf16x8 hi) { const i32x4 p = __builtin_bit_cast(i32x4, lo), q = __builtin_bit_cast(i32x4, hi); return (i32x8){p.x, p.y, p.z, p.w, q.x, q.y, q.z, q.w}; }
__device__ __forceinline__ f32x4 mma_mx8(const i32x8 B, const i32x8 A, const f32x4 c) { return __builtin_amdgcn_mfma_scale_f32_16x16x128_f8f6f4(B, A, c, 0, 0, 0, 0x7F7F7F7F, 0, 0x7F7F7F7F); }
template <int I8> __device__ __forceinline__ f32x4 mma16(const bf16x8 b, const bf16x8 a, const f32x4 c) {
    if constexpr (I8 == 1) return __builtin_bit_cast(f32x4, __builtin_amdgcn_mfma_i32_16x16x64_i8(__builtin_bit_cast(i32x4, b), __builtin_bit_cast(i32x4, a), __builtin_bit_cast(i32x4, c), 0, 0, 0));
    else return __builtin_amdgcn_mfma_f32_16x16x32_bf16(b, a, c, 0, 0, 0);
}
template <class Epi, class Sched, bool ALIGN_EPI = false, bool SP2 = false, int I8 = 0>
__device__ __forceinline__ void gemm_phase(PG8_LAS unsigned char* lds, const Gemm g, const Sched& S, const Epi& E) {
    const int tid = threadIdx.x, wid = __builtin_amdgcn_readfirstlane(tid >> 6), lane = tid & 63, wr = wid >> 2, wc = wid & 3, fr = lane & 15, fq = lane >> 4;
    const int K = g.K, nt = K / BK;
    unsigned voffA[1], voffB[1];
    { int R, C; stage_rc(tid * 16, R, C); const int Rb = Epi::PERM ? ((R & ~31) + perm32(R & 31)) : R;
        voffA[0] = (unsigned)(R * K + C) * 2u; voffB[0] = (unsigned)(Rb * K + C) * 2u; }
    const size_t r64 = (size_t)64 * K * 2;
    const size_t kstep = (size_t)(BK * 2);
    const size_t hstep = (size_t)HALF * K * 2;
    const size_t tstep = 2 * hstep;
    const unsigned ldsw = (unsigned)wid * 1024u;
    const int aoff = lds_byte(wr * 64 + fr, fq * 8), boff = lds_byte(wc * 32 + fr, fq * 8);
#define PG8_SA(b, h) (((b) * 2 + (h)) * HTB)
#define PG8_SB(b, h) ((4 + (b) * 2 + (h)) * HTB)
#define PG8_STAGE(bufoff, gbase, voff) do { _Pragma("unroll") for (int _i = 0; _i < 2; ++_i) \
        __builtin_amdgcn_global_load_lds((const unsigned*)((const char*)(gbase) + _i * r64 + (voff)[0]), (PG8_LAS unsigned*)(lds + (bufoff) + ldsw + _i * 8192), 16, 0, 0); } while (0)
#define PG8_LDA(dst, b, h) do { _Pragma("unroll") for (int m = 0; m < 4; ++m) { if constexpr (I8 == 2) dst##8[m] = cat32(*(const PG8_LAS bf16x8*)(lds + PG8_SA(b, h) + aoff + m * 2048), *(const PG8_LAS bf16x8*)(lds + PG8_SA(b, h) + aoff + m * 2048 + 1024)); \
        else { _Pragma("unroll") for (int k = 0; k < 2; ++k) dst[m][k] = *(const PG8_LAS bf16x8*)(lds + PG8_SA(b, h) + aoff + m * 2048 + k * 1024); } } } while (0)
#define PG8_LDB(dst, b, h) do { _Pragma("unroll") for (int n = 0; n < 2; ++n) { if constexpr (I8 == 2) dst##8[n] = cat32(*(const PG8_LAS bf16x8*)(lds + PG8_SB(b, h) + boff + n * 2048), *(const PG8_LAS bf16x8*)(lds + PG8_SB(b, h) + boff + n * 2048 + 1024)); \
        else { _Pragma("unroll") for (int k = 0; k < 2; ++k) dst[n][k] = *(const PG8_LAS bf16x8*)(lds + PG8_SB(b, h) + boff + n * 2048 + k * 1024); } } } while (0)
#define PG8_MMA(ai, bj, At, Bt) do { __builtin_amdgcn_s_setprio(1); _Pragma("unroll") for (int m = 0; m < 4; ++m) _Pragma("unroll") for (int n = 0; n < 2; ++n) { \
        if constexpr (I8 == 2) acc[ai][bj][m][n] = mma_mx8(Bt##8[n], At##8[m], acc[ai][bj][m][n]); \
        else { _Pragma("unroll") for (int k = 0; k < 2; ++k) acc[ai][bj][m][n] = mma16<I8>(Bt[n][k], At[m][k], acc[ai][bj][m][n]); } } __builtin_amdgcn_s_setprio(0); } while (0)
#define PG8_WAIT_V(n) asm volatile("s_waitcnt vmcnt(" #n ")" ::: "memory")
#define PG8_WAIT_L(n) asm volatile("s_waitcnt lgkmcnt(" #n ")" ::: "memory")
#define PG8_BAR __builtin_amdgcn_s_barrier()
#define PG8_SCHED __builtin_amdgcn_sched_barrier(0)
    Unit cur, nxt; int ui = 0;
    if (!S.next(0, cur)) return;
    f32x4 acc[2][2][4][2];
#pragma unroll
    for (int a = 0; a < 2; ++a)
#pragma unroll
        for (int b = 0; b < 2; ++b)
#pragma unroll
            for (int m = 0; m < 4; ++m)
#pragma unroll
                for (int n = 0; n < 2; ++n) acc[a][b][m][n] = (f32x4){0.f, 0.f, 0.f, 0.f};
    bf16x8 At[4][2], B0[2][2], B1[2][2]; i32x8 At8[4], B08[2], B18[2];
    const char* cA = (const char*)g.A + (size_t)cur.pm * tstep; const char* cB = (const char*)g.Bt + (size_t)cur.pn * tstep;
    S.a_ready(cur);
    if constexpr (SP2) {
        PG8_STAGE(PG8_SB(0, 0), cB, voffB); PG8_STAGE(PG8_SB(0, 1), cB + hstep, voffB); PG8_STAGE(PG8_SA(0, 0), cA, voffA); PG8_STAGE(PG8_SA(0, 1), cA + hstep, voffA);
        if (wr == 1) PG8_BAR;
        PG8_WAIT_V(2); PG8_BAR;
        PG8_STAGE(PG8_SB(1, 0), cB + kstep, voffB); PG8_STAGE(PG8_SA(1, 0), cA + kstep, voffA); PG8_STAGE(PG8_SB(1, 1), cB + hstep + kstep, voffB);
        PG8_WAIT_V(6); PG8_BAR;
    } else {
        PG8_STAGE(PG8_SB(0, 0), cB, voffB); PG8_STAGE(PG8_SA(0, 0), cA, voffA); PG8_STAGE(PG8_SB(0, 1), cB + hstep, voffB); PG8_STAGE(PG8_SA(0, 1), cA + hstep, voffA);
        if (wr == 1) PG8_BAR;
        PG8_WAIT_V(4); PG8_BAR;
        PG8_STAGE(PG8_SB(1, 0), cB + kstep, voffB); PG8_STAGE(PG8_SA(1, 0), cA + kstep, voffA); PG8_STAGE(PG8_SB(1, 1), cB + hstep + kstep, voffB);
        PG8_WAIT_V(6); PG8_BAR;
    }
    PROF16_DECL;
    for (;;) {
        const bool has_next = S.next(ui + 1, nxt);
        const char* nA = has_next ? (const char*)g.A + (size_t)nxt.pm * tstep : cA; const char* nB = has_next ? (const char*)g.Bt + (size_t)nxt.pn * tstep : cB;
        asm volatile(".p2align 8" ::: "memory");
        for (int t = 0; t < nt; t += 2) {
            const bool last = (t == nt - 2);
            const char* a1 = cA + (size_t)(t + 1) * kstep;
            const char* a2 = last ? nA : cA + (size_t)(t + 2) * kstep; const char* b2 = last ? nB : cB + (size_t)(t + 2) * kstep;
            const char* a3 = a2 + kstep; const char* b3 = b2 + kstep;
            if (last && has_next) S.a_ready(nxt);
            if constexpr (SP2) {
#if PG8_STAGE_IN_MMA
            PG8_LDB(B0, 0, 0); PG8_LDB(B1, 0, 1); PG8_SCHED; PG8_LDA(At, 0, 0);
            PG8_WAIT_V(6); PG8_WAIT_L(0); PG8_BAR; PG8_MMA(0, 0, At, B0); PG8_SCHED; PG8_STAGE(PG8_SA(1, 1), a1 + hstep, voffA); PG8_SCHED; PG8_MMA(0, 1, At, B1); PG8_BAR; PG8_SCHED;
            PG8_LDA(At, 0, 1);
            PG8_WAIT_V(2); PG8_WAIT_L(0); PG8_BAR; PG8_STAGE(PG8_SB(0, 0), b2, voffB); PG8_SCHED; PG8_MMA(1, 0, At, B0); PG8_SCHED; PG8_STAGE(PG8_SB(0, 1), b2 + hstep, voffB); PG8_SCHED; PG8_MMA(1, 1, At, B1); PG8_SCHED; PG8_STAGE(PG8_SA(0, 0), a2, voffA); PG8_BAR; PG8_SCHED;
            PG8_LDB(B0, 1, 0); PG8_LDB(B1, 1, 1); PG8_SCHED; PG8_LDA(At, 1, 0);
            PG8_WAIT_V(6); PG8_WAIT_L(0); PG8_BAR; PG8_MMA(0, 0, At, B0); PG8_SCHED; PG8_STAGE(PG8_SA(0, 1), a2 + hstep, voffA); PG8_SCHED; PG8_MMA(0, 1, At, B1); PG8_BAR; PG8_SCHED;
            PG8_LDA(At, 1, 1);
            PG8_WAIT_V(2); PG8_WAIT_L(0); PG8_BAR; PG8_STAGE(PG8_SB(1, 0), b3, voffB); PG8_SCHED; PG8_MMA(1, 0, At, B0); PG8_SCHED; PG8_STAGE(PG8_SB(1, 1), b3 + hstep, voffB); PG8_SCHED; PG8_MMA(1, 1, At, B1); PG8_SCHED; PG8_STAGE(PG8_SA(1, 0), a3, voffA); PG8_BAR; PG8_SCHED;
#else
            PG8_LDB(B0, 0, 0); PG8_LDB(B1, 0, 1); PG8_SCHED; PG8_LDA(At, 0, 0); PG8_STAGE(PG8_SA(1, 1), a1 + hstep, voffA);
            PG8_WAIT_V(8); PG8_WAIT_L(0); PG8_BAR; PG8_MMA(0, 0, At, B0); PG8_MMA(0, 1, At, B1); PG8_BAR; PG8_SCHED;
            PG8_LDA(At, 0, 1); PG8_STAGE(PG8_SB(0, 0), b2, voffB); PG8_STAGE(PG8_SB(0, 1), b2 + hstep, voffB); PG8_STAGE(PG8_SA(0, 0), a2, voffA);
            PG8_WAIT_V(8); PG8_WAIT_L(0); PG8_BAR; PG8_MMA(1, 0, At, B0); PG8_MMA(1, 1, At, B1); PG8_BAR; PG8_SCHED;
            PG8_LDB(B0, 1, 0); PG8_LDB(B1, 1, 1); PG8_SCHED; PG8_LDA(At, 1, 0); PG8_STAGE(PG8_SA(0, 1), a2 + hstep, voffA);
            PG8_WAIT_V(8); PG8_WAIT_L(0); PG8_BAR; PG8_MMA(0, 0, At, B0); PG8_MMA(0, 1, At, B1); PG8_BAR; PG8_SCHED;
            PG8_LDA(At, 1, 1); PG8_STAGE(PG8_SB(1, 0), b3, voffB); PG8_STAGE(PG8_SB(1, 1), b3 + hstep, voffB); PG8_STAGE(PG8_SA(1, 0), a3, voffA);
            PG8_WAIT_V(8); PG8_WAIT_L(0); PG8_BAR; PG8_MMA(1, 0, At, B0); PG8_MMA(1, 1, At, B1); PG8_BAR; PG8_SCHED;
#endif
            } else {
            PG8_LDB(B0, 0, 0); PG8_SCHED; PG8_LDA(At, 0, 0); PG8_STAGE(PG8_SA(1, 1), a1 + hstep, voffA);
            PG8_WAIT_L(8); PG8_BAR; PG8_WAIT_L(0); PG8_MMA(0, 0, At, B0); PG8_BAR; PG8_SCHED;
            PG8_LDB(B1, 0, 1); PG8_STAGE(PG8_SB(0, 0), b2, voffB);
            PG8_BAR; PG8_WAIT_L(0); PG8_MMA(0, 1, At, B1); PG8_BAR;
            PG8_LDA(At, 0, 1); PG8_STAGE(PG8_SA(0, 0), a2, voffA);
            PG8_BAR; PG8_WAIT_L(0); PG8_MMA(1, 0, At, B0); PG8_BAR; PG8_SCHED;
            PG8_STAGE(PG8_SB(0, 1), b2 + hstep, voffB);
            PG8_WAIT_V(6); PG8_BAR; PG8_MMA(1, 1, At, B1); PG8_BAR;
            PG8_LDB(B0, 1, 0); PG8_SCHED; PG8_LDA(At, 1, 0); PG8_STAGE(PG8_SA(0, 1), a2 + hstep, voffA);
            PG8_WAIT_L(8); PG8_BAR; PG8_WAIT_L(0); PG8_MMA(0, 0, At, B0); PG8_BAR; PG8_SCHED;
            PG8_LDB(B1, 1, 1); PG8_STAGE(PG8_SB(1, 0), b3, voffB);
            PG8_BAR; PG8_WAIT_L(0); PG8_MMA(0, 1, At, B1); PG8_BAR;
            PG8_LDA(At, 1, 1); PG8_STAGE(PG8_SA(1, 0), a3, voffA);
            PG8_BAR; PG8_WAIT_L(0); PG8_MMA(1, 0, At, B0); PG8_BAR; PG8_SCHED;
            PG8_STAGE(PG8_SB(1, 1), b3 + hstep, voffB);
            PG8_WAIT_V(6); PG8_BAR; PG8_MMA(1, 1, At, B1); PG8_BAR;
            }
        }
        if constexpr (ALIGN_EPI) { if (wr == 0) PG8_BAR; }
        if constexpr (!Epi::AFTER_DRAIN) { int ln; asm volatile("v_mbcnt_lo_u32_b32 %0, -1, 0\n\tv_mbcnt_hi_u32_b32 %0, -1, %0" : "=v"(ln));     const int fr2 = ln & 15, fq2 = ln >> 4; _Pragma("unroll") for (int er = 0; er < Epi::REPS; ++er) { PROF16_BEGIN; E(acc, cur, wr, wc, fr2, fq2); PROF16_END; if (er + 1 < Epi::REPS) asm volatile("" ::: "memory"); } S.done(cur); }
        if (!has_next) break;
#pragma unroll
        for (int a = 0; a < 2; ++a)
#pragma unroll
            for (int b = 0; b < 2; ++b)
#pragma unroll
                for (int m = 0; m < 4; ++m)
#pragma unroll
                    for (int n = 0; n < 2; ++n) acc[a][b][m][n] = (f32x4){0.f, 0.f, 0.f, 0.f};
        cur = nxt; cA = nA; cB = nB; ++ui;
        if constexpr (ALIGN_EPI) { if (wr == 1) PG8_BAR; }
    }
    PG8_WAIT_V(0);
    if constexpr (!ALIGN_EPI) { if (wr == 0) PG8_BAR; }
    PG8_BAR;
    if constexpr (Epi::AFTER_DRAIN) { E.fused(acc, cur, wr, wc, fr, fq, lds, wid, lane); S.done(cur); }
    PROF16_FLUSH;
#undef PG8_SA
#undef PG8_SB
#undef PG8_STAGE
#undef PG8_LDA
#undef PG8_LDB
#undef PG8_MMA
#undef PG8_WAIT_V
#undef PG8_WAIT_L
#undef PG8_BAR
#undef PG8_SCHED
}
}
#define GAS __attribute__((address_space(1)))
#define LAS __attribute__((address_space(3)))
typedef unsigned short bf16;
typedef unsigned v4u __attribute__((ext_vector_type(4)));
typedef float f32x4 __attribute__((ext_vector_type(4)));
typedef short bf16x8 __attribute__((ext_vector_type(8)));
typedef GAS unsigned gu32;
typedef GAS unsigned long long gu64;
#define RLX_AGENT __ATOMIC_RELAXED, __HIP_MEMORY_SCOPE_AGENT
#define LDS_WAIT() asm volatile("s_waitcnt lgkmcnt(0)" ::: "memory")
#define VM_WAIT() asm volatile("s_waitcnt vmcnt(0)" ::: "memory")
__device__ __forceinline__ unsigned long long rt() { return __builtin_amdgcn_s_memrealtime(); }
__device__ __forceinline__ unsigned f2bf(float f) { unsigned u = __builtin_bit_cast(unsigned, f); return (u + 0x7fffu + ((u >> 16) & 1u)) >> 16; }
__device__ __forceinline__ unsigned pk2(float lo, float hi) { return f2bf(lo) | (f2bf(hi) << 16); }

#define XB_TMO      128
#define XB_XCNT(j)  (256  + 64 * (j))
#define XB_XSUB(j)  (1280 + 64 * (j))
#define XB_XGEN(j)  (2304 + 64 * (j))
#define XB_TOP      3328
#define XB_TOPGEN   3392
#define XCD_BAR_WORDS 3456
#define XB_SPIN_CAP (1u << 18)

__device__ __forceinline__ unsigned xb_ld(unsigned* p)              { return __hip_atomic_load(p, __ATOMIC_RELAXED, __HIP_MEMORY_SCOPE_AGENT); }
__device__ __forceinline__ unsigned xb_add(unsigned* p, unsigned v) { return __hip_atomic_fetch_add(p, v, __ATOMIC_RELAXED, __HIP_MEMORY_SCOPE_AGENT); }
__device__ __forceinline__ unsigned xb_xcc_id() { return (unsigned)__builtin_amdgcn_s_getreg((3 << 11) | 20) & 0xFu; }
#define XB_SPIN(cond, bar) do { unsigned _sp = 0; while (cond) { __builtin_amdgcn_s_sleep(1); \
    if ((++_sp & 255u) == 0u) { if (xb_ld(&(bar)[XB_TMO])) break; if (_sp > XB_SPIN_CAP) { atomicAdd(&(bar)[XB_TMO], 1u); break; } } } } while (0)

struct XcdBarrier {
    unsigned* bar; unsigned x;
    volatile LAS unsigned* st;
};

__device__ __forceinline__ XcdBarrier xcd_barrier_post(unsigned* bar, volatile LAS unsigned* st) {
    XcdBarrier b; b.bar = bar; b.x = xb_xcc_id(); b.st = st;
    if (threadIdx.x == 0) (void)xb_add(&bar[XB_XCNT(b.x)], 1u);
    return b;
}
__device__ __forceinline__ void xcd_barrier_complete(unsigned* bar, unsigned x, unsigned& nloc, unsigned& nx) {
    const unsigned G = gridDim.x * gridDim.y * gridDim.z;
    unsigned sum, cnt, mine, sp = 0u;
    for (;;) {
        sum = 0u; cnt = 0u; mine = 0u;
#pragma unroll
        for (unsigned j = 0; j < 16; ++j) { const unsigned c = xb_ld(&bar[XB_XCNT(j)]); sum += c; cnt += (c > 0u) ? 1u : 0u; mine = (j == x) ? c : mine; }
        if (sum == G) break;
        __builtin_amdgcn_s_sleep(1);
        if ((++sp & 255u) == 0u) { if (xb_ld(&bar[XB_TMO])) break; if (sp > XB_SPIN_CAP) { atomicAdd(&bar[XB_TMO], 1u); break; } }
    }
    nloc = mine > 0u ? mine : 1u; nx = cnt > 0u ? cnt : 1u;
}

__device__ __forceinline__ void xcd_barrier(const XcdBarrier& b) {
    asm volatile("s_waitcnt vmcnt(0)" ::: "memory");
    __syncthreads();
    if (threadIdx.x == 0) {
        unsigned* bar = b.bar;
        __builtin_amdgcn_s_waitcnt(0);
        unsigned nloc = b.st[0], nx = b.st[1];
        if (nloc == 0u) { xcd_barrier_complete(bar, b.x, nloc, nx); b.st[0] = nloc; b.st[1] = nx; }
        const unsigned old = xb_add(&bar[XB_XSUB(b.x)], 1u);
        const unsigned gen = old / nloc;
        if (old + 1u == (gen + 1u) * nloc) {
            __builtin_amdgcn_fence(__ATOMIC_RELEASE, "agent");
            asm volatile("s_waitcnt vmcnt(0)" ::: "memory");
            (void)xb_add(&bar[XB_TOP], 1u);
        }
        XB_SPIN(xb_ld(&bar[XB_TOP]) < (gen + 1u) * nx, bar);
        __builtin_amdgcn_fence(__ATOMIC_ACQUIRE, "agent");
        asm volatile("s_waitcnt vmcnt(0)" ::: "memory");
    }
    __syncthreads();
}

constexpr int NWAVES = 8;
constexpr int NB = 8, SEQ = 4096, D = 1024, M = NB * SEQ, FF = 2816, FF2 = 2 * FF, DC = 512, DR = 512, NH = 8, HD = 64, CW = 31, RW = 4, NMIX = 2048;
constexpr float EPS = 1e-6f;
constexpr int LDM = 11 * D;
constexpr size_t MiB = 1u << 20;
constexpr size_t WS_CTL = 0, CTL_ZERO_BYTES = 1 * MiB;
constexpr size_t WS_MOD = 1 * MiB;
constexpr size_t WS_BIAS1 = 1 * MiB + 512 * 1024;
constexpr size_t WS_BIAS2 = 2 * MiB;
constexpr size_t WS_WGT = 2 * MiB + 128 * 1024;
constexpr size_t WS_CS1 = 2 * MiB + 384 * 1024, WS_CS3 = 2 * MiB + 448 * 1024;
constexpr size_t WS_RS1 = 2 * MiB + 512 * 1024, WS_RS3 = 2 * MiB + 640 * 1024;
constexpr size_t WS_CS2 = 2 * MiB + 480 * 1024, WS_RS2 = 2 * MiB + 768 * 1024;
constexpr size_t WS_TOT = 3 * MiB;
constexpr size_t WS_SSP = 5 * MiB;
constexpr size_t WS_W1I = 8 * MiB, WS_W1O = 19 * MiB, WS_WIN = 25 * MiB, WS_WOUT = 29 * MiB, WS_W2I = 31 * MiB, WS_W2O = 42 * MiB;
constexpr size_t WS_Y = 48 * MiB;
constexpr size_t WS_X1 = 112 * MiB;
constexpr size_t WS_ACT = 240 * MiB;
constexpr size_t WS_U = WS_ACT, WS_UX = WS_ACT + 32 * MiB, WS_GY = WS_ACT + 64 * MiB, WS_YMIX = WS_ACT + 96 * MiB;
constexpr size_t WS_SSPF = 416 * MiB;
constexpr size_t WS_SSPX = 418 * MiB;
constexpr size_t WS_SSPX3 = 422 * MiB;
constexpr size_t WS_END = 426 * MiB;
constexpr int CW_BAR = 4096, CW_SEAM = 16384, CW_SCAN = 32768, CW_SEAM7 = 49152, CW_SEAM3 = 65536, CW_TICKET = 98304;
constexpr int LDS_BYTES = 147456;
constexpr int LDSCTL_OFF = LDS_BYTES - 256;

typedef unsigned short u16;
typedef float f32x16 __attribute__((ext_vector_type(16)));
typedef float f32x2 __attribute__((ext_vector_type(2)));

template <int OFF> __device__ __forceinline__ float sx(float v) {
    const int i = (int)__float_as_uint(v); int r;
    if constexpr (OFF == 1) r = __builtin_amdgcn_update_dpp(0, i, 0xB1, 0xf, 0xf, true);
    else if constexpr (OFF == 2) r = __builtin_amdgcn_update_dpp(0, i, 0x4E, 0xf, 0xf, true);
    else if constexpr (OFF == 4) r = __builtin_amdgcn_ds_swizzle(i, 0x101F);
    else if constexpr (OFF == 8) r = __builtin_amdgcn_update_dpp(0, i, 0x128, 0xf, 0xf, true);
    else if constexpr (OFF == 16) r = __builtin_amdgcn_ds_swizzle(i, 0x401F);
    else { const auto p = __builtin_amdgcn_permlane32_swap(i, i, false, false); r = (threadIdx.x & 32) ? p[0] : p[1]; }
    return __uint_as_float((unsigned)r);
}
__device__ __forceinline__ float wave_sum(float v) { v += sx<1>(v); v += sx<2>(v); v += sx<4>(v); v += sx<8>(v); v += sx<16>(v); v += sx<32>(v); return v; }
__device__ __forceinline__ float sigmoid_fast(float x) { return __builtin_amdgcn_rcpf(1.f + __builtin_amdgcn_exp2f(-1.4426950408889634f * x)); }
__device__ __forceinline__ float silu_fast(float x) { return x * sigmoid_fast(x); }
__device__ __forceinline__ float gelu_tanh_fast(float x) { const float z = 0.7978845608028654f * (x + 0.044715f * x * x * x); return x * sigmoid_fast(2.f * z); }
__device__ __forceinline__ f32x4 sigmoid4(const f32x4 x) { const f32x4 t = x * -1.4426950408889634f; f32x4 e = {__builtin_amdgcn_exp2f(t[0]), __builtin_amdgcn_exp2f(t[1]), __builtin_amdgcn_exp2f(t[2]), __builtin_amdgcn_exp2f(t[3])};
    e = e + 1.0f; return (f32x4){__builtin_amdgcn_rcpf(e[0]), __builtin_amdgcn_rcpf(e[1]), __builtin_amdgcn_rcpf(e[2]), __builtin_amdgcn_rcpf(e[3])}; }
__device__ __forceinline__ f32x4 gelu_tanh4(const f32x4 x) { const f32x4 z2 = (x + (x * x) * x * 0.044715f) * (2.0f * 0.7978845608028654f); return x * sigmoid4(z2); }
__device__ __forceinline__ float bflo(unsigned w) { return __uint_as_float(w << 16); }
__device__ __forceinline__ float bfhi(unsigned w) { return __uint_as_float(w & 0xffff0000u); }
__device__ __forceinline__ unsigned cvtpk(float lo, float hi) { return pg8::cvt_pk_bf16(lo, hi); }
__device__ __forceinline__ v4u pack8(const f32x4 a, const f32x4 b) { v4u w; w.x = cvtpk(a[0], a[1]); w.y = cvtpk(a[2], a[3]); w.z = cvtpk(b[0], b[1]); w.w = cvtpk(b[2], b[3]); return w; }

__device__ __forceinline__ void unpack8(const v4u w, f32x4& a, f32x4& b) { a = (f32x4){bflo(w.x), bfhi(w.x), bflo(w.y), bfhi(w.y)}; b = (f32x4){bflo(w.z), bfhi(w.z), bflo(w.w), bfhi(w.w)}; }
__device__ __forceinline__ unsigned q8(float v) { int q = (int)__builtin_rintf(v); q = q < -127 ? -127 : (q > 127 ? 127 : q); return (unsigned)q & 0xffu; }
__device__ __forceinline__ unsigned q8x4(const f32x4 v) { return q8(v[0]) | (q8(v[1]) << 8) | (q8(v[2]) << 16) | (q8(v[3]) << 24); }
__device__ __forceinline__ float wave_max(float v) { v = fmaxf(v, sx<1>(v)); v = fmaxf(v, sx<2>(v)); v = fmaxf(v, sx<4>(v)); v = fmaxf(v, sx<8>(v)); v = fmaxf(v, sx<16>(v)); v = fmaxf(v, sx<32>(v)); return v; }
typedef int i32x4v __attribute__((ext_vector_type(4)));
__device__ __forceinline__ f32x4 acc_i2f(const f32x4 a) { return __builtin_convertvector(__builtin_bit_cast(i32x4v, a), f32x4); }
__device__ __forceinline__ float clamp448(float v) { return __builtin_fminf(__builtin_fmaxf(v, -448.0f), 448.0f); }
__device__ __forceinline__ unsigned f8x4(const f32x4 v) { int w = __builtin_amdgcn_cvt_pk_fp8_f32(clamp448(v[0]), clamp448(v[1]), 0, false); w = __builtin_amdgcn_cvt_pk_fp8_f32(clamp448(v[2]), clamp448(v[3]), w, true); return (unsigned)w; }
constexpr float F8_ACT_SCALE = 8.0f, F8_W_SCALE = 2048.0f;
__device__ __forceinline__ void load_rstd(const float* ssp, int row0, int fq, float (&rs)[2][4]) {
#pragma unroll
    for (int ai = 0; ai < 2; ++ai)
#pragma unroll
        for (int m = 0; m < 4; ++m) { const f32x4 p = *(const f32x4*)(ssp + (size_t)(row0 + ai * 128 + m * 16) * 16 + 4 * fq);
            float s = (p[0] + p[1]) + (p[2] + p[3]); s += __shfl_xor(s, 16); s += __shfl_xor(s, 32); rs[ai][m] = rsqrtf(s * (1.0f / D) + EPS); }
}
__device__ __forceinline__ void load_rstd_sc1(const float* ssp, int row0, int fq, float (&rs)[2][4]) {
#pragma unroll
    for (int ai = 0; ai < 2; ++ai)
#pragma unroll
        for (int m = 0; m < 4; ++m) { const gu32* p = (const gu32*)(ssp + (size_t)(row0 + ai * 128 + m * 16) * 16 + 4 * fq);
            const float p0 = __uint_as_float(__hip_atomic_load(p, RLX_AGENT)), p1 = __uint_as_float(__hip_atomic_load(p + 1, RLX_AGENT)), p2 = __uint_as_float(__hip_atomic_load(p + 2, RLX_AGENT)), p3 = __uint_as_float(__hip_atomic_load(p + 3, RLX_AGENT));
            float s = (p0 + p1) + (p2 + p3); s += __shfl_xor(s, 16); s += __shfl_xor(s, 32); rs[ai][m] = rsqrtf(s * (1.0f / D) + EPS); }
}
#ifndef MK_EPI_SWIGLU_REPS
#define MK_EPI_SWIGLU_REPS 1
#endif
#ifndef MK_EPI_RESID_REPS
#define MK_EPI_RESID_REPS 1
#endif
struct EpiSwiglu {
    static constexpr bool PERM = true, AFTER_DRAIN = false; static constexpr int REPS = MK_EPI_SWIGLU_REPS;
    pg8::bf16_t* act; const float* ssp; const float* bias;
    __device__ __forceinline__ void operator()(const f32x4 (&acc)[2][2][4][2], const pg8::Unit& u, int wr, int wc, int fr, int fq) const {
        const int row0 = u.pm * 256 + wr * 64 + fr, b = u.pm >> 4;
        float rs[2][4]; load_rstd(ssp, row0, fq, rs);
        const float* bp = bias + (size_t)b * FF2 + u.pn * 256 + wc * 32 + 8 * fq;
        const f32x4 bg0 = *(const f32x4*)(bp), bg1 = *(const f32x4*)(bp + 4), bu0 = *(const f32x4*)(bp + 128), bu1 = *(const f32x4*)(bp + 132);
        const int oc = u.pn * 128 + wc * 32 + 8 * fq;
#pragma unroll
        for (int ai = 0; ai < 2; ++ai)
#pragma unroll
            for (int m = 0; m < 4; ++m) { const float r = rs[ai][m];
                const f32x4 g0 = acc[ai][0][m][0] * r + bg0, g1 = acc[ai][0][m][1] * r + bg1, u0 = acc[ai][1][m][0] * r + bu0, u1 = acc[ai][1][m][1] * r + bu1;
                const f32x4 a0 = (g0 * sigmoid4(g0)) * u0, a1 = (g1 * sigmoid4(g1)) * u1;
                *(v4u*)(act + (size_t)(row0 + ai * 128 + m * 16) * FF + oc) = pack8(a0, a1); }
    }
};
template <bool OUT8> struct EpiSwiglu8 {
    static constexpr bool PERM = true, AFTER_DRAIN = false; static constexpr int REPS = 1;
    pg8::bf16_t* act; const float* rs; const float* cs;
    __device__ __forceinline__ void operator()(const f32x4 (&acc)[2][2][4][2], const pg8::Unit& u, int wr, int wc, int fr, int fq) const {
        const int row0 = u.pm * 256 + wr * 64 + fr;
        float rv[2][4];
#pragma unroll
        for (int ai = 0; ai < 2; ++ai)
#pragma unroll
            for (int m = 0; m < 4; ++m) rv[ai][m] = rs[row0 + ai * 128 + m * 16];
        const int cb = u.pn * 256 + wc * 32 + 8 * fq;
        const float* cp = cs + cb;
        const f32x4 cg0 = *(const f32x4*)(cp), cg1 = *(const f32x4*)(cp + 4), cu0 = *(const f32x4*)(cp + 128), cu1 = *(const f32x4*)(cp + 132);
        const int oc = u.pn * 128 + wc * 32 + 8 * fq;
#pragma unroll
        for (int ai = 0; ai < 2; ++ai)
#pragma unroll
            for (int m = 0; m < 4; ++m) { const float r = rv[ai][m];
                const f32x4 g0 = acc_i2f(acc[ai][0][m][0]) * (cg0 * r), g1 = acc_i2f(acc[ai][0][m][1]) * (cg1 * r);
                const f32x4 u0 = acc_i2f(acc[ai][1][m][0]) * (cu0 * r), u1 = acc_i2f(acc[ai][1][m][1]) * (cu1 * r);
                const f32x4 a0 = (g0 * sigmoid4(g0)) * u0, a1 = (g1 * sigmoid4(g1)) * u1;
                if (OUT8) *(unsigned long long*)((unsigned char*)act + (size_t)(row0 + ai * 128 + m * 16) * FF + oc) = (unsigned long long)f8x4(a0 * F8_ACT_SCALE) | ((unsigned long long)f8x4(a1 * F8_ACT_SCALE) << 32);
                else *(v4u*)(act + (size_t)(row0 + ai * 128 + m * 16) * FF + oc) = pack8(a0, a1); }
    }
};
template <int WHALF, bool HASY, bool IN16, bool F8 = false> struct EpiResid {
    static constexpr bool PERM = true, AFTER_DRAIN = false; static constexpr int REPS = (IN16 ? 1 : MK_EPI_RESID_REPS);
    static constexpr float w = (WHALF ? 0.5f : 1.0f) * (F8 ? 1.0f / (F8_ACT_SCALE * F8_W_SCALE) : 1.0f);
    const void* xin; pg8::bf16_t* xout; pg8::bf16_t* y; float* ssp; const float* gt; const float* gnext; const float* scnext;
    __device__ __forceinline__ void operator()(const f32x4 (&acc)[2][2][4][2], const pg8::Unit& u, int wr, int wc, int fr, int fq) const {
        const int row0 = u.pm * 256 + wr * 64 + fr, b = u.pm >> 4;
        float ss[2][4];
#pragma unroll
        for (int ai = 0; ai < 2; ++ai)
#pragma unroll
            for (int m = 0; m < 4; ++m) ss[ai][m] = 0.f;
#pragma unroll
        for (int bj = 0; bj < 2; ++bj) { const int c0 = u.pn * 256 + bj * 128 + wc * 32 + 8 * fq;
            const f32x4 gt0 = *(const f32x4*)(gt + (size_t)b * LDM + c0) * w, gt1 = *(const f32x4*)(gt + (size_t)b * LDM + c0 + 4) * w;
            f32x4 gs0 = {0.f, 0.f, 0.f, 0.f}, gs1 = gs0;
            if (HASY) { gs0 = *(const f32x4*)(gnext + c0) * (*(const f32x4*)(scnext + (size_t)b * LDM + c0) + 1.0f); gs1 = *(const f32x4*)(gnext + c0 + 4) * (*(const f32x4*)(scnext + (size_t)b * LDM + c0 + 4) + 1.0f); }
#pragma unroll
            for (int ai = 0; ai < 2; ++ai)
#pragma unroll
                for (int m = 0; m < 4; ++m) { const size_t off = (size_t)(row0 + ai * 128 + m * 16) * D + c0;
                    f32x4 x0, x1;
                    if (IN16) unpack8(*(const v4u*)((const pg8::bf16_t*)xin + off), x0, x1); else { x0 = *(const f32x4*)((const float*)xin + off); x1 = *(const f32x4*)((const float*)xin + off + 4); }
                    const f32x4 o0 = x0 + gt0 * acc[ai][bj][m][0], o1 = x1 + gt1 * acc[ai][bj][m][1];
                    *(v4u*)(xout + off) = pack8(o0, o1);
                    ss[ai][m] += (o0[0] * o0[0] + o0[1] * o0[1]) + (o0[2] * o0[2] + o0[3] * o0[3]) + (o1[0] * o1[0] + o1[1] * o1[1]) + (o1[2] * o1[2] + o1[3] * o1[3]);
                    if (HASY) *(v4u*)(y + off) = pack8(o0 * gs0, o1 * gs1); } }
#pragma unroll
        for (int ai = 0; ai < 2; ++ai)
#pragma unroll
            for (int m = 0; m < 4; ++m) { float s = ss[ai][m]; s += __shfl_xor(s, 16); s += __shfl_xor(s, 32);
                if (fq == 0) ssp[(size_t)(row0 + ai * 128 + m * 16) * 16 + u.pn * 4 + wc] = s; }
    }
};
template <int WHALF, bool IN16> struct EpiResidQ {
    static constexpr bool PERM = true, AFTER_DRAIN = false; static constexpr int REPS = 1;
    static constexpr float w = WHALF ? 0.5f : 1.0f;
    const void* xin; pg8::bf16_t* xout; unsigned char* a8; float* rs; f32x2* sspx; const float* gt; const float* gnext; const float* scnext; const float* shnext; const float* shmax; unsigned* cnt;
    __device__ __forceinline__ void operator()(f32x4 (&acc)[2][2][4][2], const pg8::Unit& u, int wr, int wc, int fr, int fq) const {
        const int row0 = u.pm * 256 + wr * 64 + fr, b = u.pm >> 4;
        float ss[2][4], am[2][4];
#pragma unroll
        for (int ai = 0; ai < 2; ++ai)
#pragma unroll
            for (int m = 0; m < 4; ++m) { ss[ai][m] = 0.f; am[ai][m] = 0.f; }
        const unsigned voff = (unsigned)((row0 * D + u.pn * 256 + wc * 32 + 8 * fq) * 2);
        unsigned vo[4] = {voff, voff, voff, voff};
#pragma unroll
        for (int bj = 0; bj < 2; ++bj) { const int c0 = u.pn * 256 + bj * 128 + wc * 32 + 8 * fq;
            const f32x4 gt0 = *(const f32x4*)(gt + (size_t)b * LDM + c0) * w, gt1 = *(const f32x4*)(gt + (size_t)b * LDM + c0 + 4) * w;
            const f32x4 gs0 = *(const f32x4*)(gnext + c0) * (*(const f32x4*)(scnext + (size_t)b * LDM + c0) + 1.0f), gs1 = *(const f32x4*)(gnext + c0 + 4) * (*(const f32x4*)(scnext + (size_t)b * LDM + c0 + 4) + 1.0f);
#pragma unroll
            for (int ai = 0; ai < 2; ++ai)
#pragma unroll
                for (int m = 0; m < 4; ++m) { const unsigned so = (unsigned)(((ai * 128 + m * 16) * D + bj * 128) * 2); const int g = m & 3;
                    f32x4 x0, x1;
                    if (IN16) unpack8(*(const v4u*)((const char*)xin + (size_t)(vo[g] + so)), x0, x1);
                    else { const char* p = (const char*)xin + 2 * (size_t)(vo[g] + so); x0 = *(const f32x4*)p; x1 = *(const f32x4*)(p + 16); }
                    const f32x4 o0 = x0 + gt0 * acc[ai][bj][m][0], o1 = x1 + gt1 * acc[ai][bj][m][1];
                    *(v4u*)((char*)xout + (size_t)(vo[g] + so)) = pack8(o0, o1);
                    acc[ai][bj][m][0] = o0; acc[ai][bj][m][1] = o1;
                    ss[ai][m] += (o0[0] * o0[0] + o0[1] * o0[1]) + (o0[2] * o0[2] + o0[3] * o0[3]) + (o1[0] * o1[0] + o1[1] * o1[1]) + (o1[2] * o1[2] + o1[3] * o1[3]);
                    const f32x4 t0 = __builtin_elementwise_abs(o0 * gs0), t1 = __builtin_elementwise_abs(o1 * gs1);
                    am[ai][m] = fmaxf(am[ai][m], fmaxf(fmaxf(fmaxf(t0[0], t0[1]), fmaxf(t0[2], t0[3])), fmaxf(fmaxf(t1[0], t1[1]), fmaxf(t1[2], t1[3]))));
                    asm volatile("" : "+v"(vo[g]) : "v"(ss[ai][m])); } }
#pragma unroll
        for (int ai = 0; ai < 2; ++ai)
#pragma unroll
            for (int m = 0; m < 4; ++m) { float s = ss[ai][m], a = am[ai][m]; s += __shfl_xor(s, 16); s += __shfl_xor(s, 32); a = fmaxf(a, __shfl_xor(a, 16)); a = fmaxf(a, __shfl_xor(a, 32));
                if (fq == 0) __hip_atomic_store((gu64*)(sspx + (size_t)(row0 + ai * 128 + m * 16) * 16 + u.pn * 4 + wc), ((unsigned long long)__float_as_uint(a) << 32) | __float_as_uint(s), RLX_AGENT); }
        PROF_BEGIN(13);
        asm volatile("s_waitcnt vmcnt(0)" ::: "memory");
        unsigned* cw = cnt + 64 * u.pm;
        if ((threadIdx.x & 63) == 0) __hip_atomic_fetch_add(cw, 1u, __ATOMIC_RELAXED, __HIP_MEMORY_SCOPE_AGENT);
        if (threadIdx.x < 64) {
            unsigned sp = 0;
            while ((unsigned)__builtin_amdgcn_readfirstlane(__hip_atomic_load(cw, __ATOMIC_RELAXED, __HIP_MEMORY_SCOPE_AGENT)) < 32u) { __builtin_amdgcn_s_sleep(1); if (++sp > (1u << 20)) break; }
            __builtin_amdgcn_fence(__ATOMIC_ACQUIRE, "agent");
            asm volatile("s_waitcnt vmcnt(0)" ::: "memory");
        }
        asm volatile("" ::: "memory"); __builtin_amdgcn_s_barrier(); asm volatile("" ::: "memory");
        PROF_END(13);
        float qs[2][4], qr[2][4];
        const float shm = shmax[b];
#pragma unroll
        for (int ai = 0; ai < 2; ++ai)
#pragma unroll
            for (int m = 0; m < 4; ++m) { const int row = row0 + ai * 128 + m * 16; const gu64* p = (const gu64*)(sspx + (size_t)row * 16 + 4 * fq);
                float s = 0.f, a = 0.f;
#pragma unroll
                for (int e = 0; e < 4; ++e) { const unsigned long long t = __hip_atomic_load(p + e, RLX_AGENT); s += __uint_as_float((unsigned)t); a = fmaxf(a, __uint_as_float((unsigned)(t >> 32))); }
                s += __shfl_xor(s, 16); s += __shfl_xor(s, 32); a = fmaxf(a, __shfl_xor(a, 16)); a = fmaxf(a, __shfl_xor(a, 32));
                const float rstd = rsqrtf(s * (1.0f / D) + EPS), S = rstd * a + shm;
                qs[ai][m] = S > 0.f ? 127.0f / S : 0.f; qr[ai][m] = rstd * qs[ai][m];
                if (u.pn == 0 && wc == 0 && fq == 0) rs[row] = S * (1.0f / 127.0f); }
        const unsigned voff8 = (unsigned)(row0 * D + u.pn * 256 + wc * 32 + 8 * fq);
#pragma unroll
        for (int bj = 0; bj < 2; ++bj) { const int c0 = u.pn * 256 + bj * 128 + wc * 32 + 8 * fq;
            const f32x4 gs0 = *(const f32x4*)(gnext + c0) * (*(const f32x4*)(scnext + (size_t)b * LDM + c0) + 1.0f), gs1 = *(const f32x4*)(gnext + c0 + 4) * (*(const f32x4*)(scnext + (size_t)b * LDM + c0 + 4) + 1.0f);
            const f32x4 sh0 = *(const f32x4*)(shnext + (size_t)b * LDM + c0), sh1 = *(const f32x4*)(shnext + (size_t)b * LDM + c0 + 4);
#pragma unroll
            for (int ai = 0; ai < 2; ++ai)
#pragma unroll
                for (int m = 0; m < 4; ++m) { const float q = qs[ai][m], r = qr[ai][m]; const unsigned so = (unsigned)((ai * 128 + m * 16) * D + bj * 128);
                    *(unsigned long long*)(a8 + (size_t)(voff8 + so)) = (unsigned long long)q8x4(acc[ai][bj][m][0] * (gs0 * r) + sh0 * q) | ((unsigned long long)q8x4(acc[ai][bj][m][1] * (gs1 * r) + sh1 * q) << 32); } }
    }
};
template <bool F8> struct EpiResidFinal {
    static constexpr bool PERM = true, AFTER_DRAIN = false; static constexpr int REPS = 1;
    static constexpr float ascale = F8 ? 1.0f / (F8_ACT_SCALE * F8_W_SCALE) : 1.0f;
    const pg8::bf16_t* xin; float* out; float* ssp; const float* gt; const float* gf; const float* fsc; const float* fsh; unsigned* cnt;
    __device__ __forceinline__ void operator()(f32x4 (&acc)[2][2][4][2], const pg8::Unit& u, int wr, int wc, int fr, int fq) const {
        const int row0 = u.pm * 256 + wr * 64 + fr, b = u.pm >> 4;
        const __amdgpu_buffer_rsrc_t rx = __builtin_amdgcn_make_buffer_rsrc((void*)xin, 0, M * D * 4, 0x00020000), ro = __builtin_amdgcn_make_buffer_rsrc((void*)out, 0, M * D * 4, 0x00020000);
        const unsigned voff = (unsigned)((row0 * D + u.pn * 256 + wc * 32 + 8 * fq) * 4);
        float ss[2][4];
#pragma unroll
        for (int ai = 0; ai < 2; ++ai)
#pragma unroll
            for (int m = 0; m < 4; ++m) ss[ai][m] = 0.f;
        unsigned vo[4] = {voff, voff, voff, voff};
#pragma unroll
        for (int bj = 0; bj < 2; ++bj) { const int c0 = u.pn * 256 + bj * 128 + wc * 32 + 8 * fq;
            const float hw = 0.5f * ascale; const f32x4 gt0 = *(const f32x4*)(gt + (size_t)b * LDM + c0) * hw, gt1 = *(const f32x4*)(gt + (size_t)b * LDM + c0 + 4) * hw;
#pragma unroll
            for (int ai = 0; ai < 2; ++ai)
#pragma unroll
                for (int m = 0; m < 4; ++m) { const unsigned so = (unsigned)(((ai * 128 + m * 16) * D + bj * 128) * 4); const int g = m & 3;
                    f32x4 x0, x1; unpack8(*(const v4u*)((const char*)xin + (size_t)((vo[g] + so) >> 1)), x0, x1);
                    const f32x4 o0 = x0 + gt0 * acc[ai][bj][m][0], o1 = x1 + gt1 * acc[ai][bj][m][1];
                    acc[ai][bj][m][0] = o0; acc[ai][bj][m][1] = o1;
                    ss[ai][m] += (o0[0] * o0[0] + o0[1] * o0[1]) + (o0[2] * o0[2] + o0[3] * o0[3]) + (o1[0] * o1[0] + o1[1] * o1[1]) + (o1[2] * o1[2] + o1[3] * o1[3]);
                    asm volatile("" : "+v"(vo[g]) : "v"(ss[ai][m])); } }
#pragma unroll
        for (int ai = 0; ai < 2; ++ai)
#pragma unroll
            for (int m = 0; m < 4; ++m) { float s = ss[ai][m]; s += __shfl_xor(s, 16); s += __shfl_xor(s, 32);
                if (fq == 0) __hip_atomic_store((gu32*)(ssp + (size_t)(row0 + ai * 128 + m * 16) * 16 + u.pn * 4 + wc), __float_as_uint(s), RLX_AGENT); }
        PROF_BEGIN(14);
        asm volatile("s_waitcnt vmcnt(0)" ::: "memory");
        unsigned* cw = cnt + 64 * u.pm;
        if ((threadIdx.x & 63) == 0) __hip_atomic_fetch_add(cw, 1u, __ATOMIC_RELAXED, __HIP_MEMORY_SCOPE_AGENT);
        if (threadIdx.x < 64) {
            unsigned sp = 0;
            while ((unsigned)__builtin_amdgcn_readfirstlane(__hip_atomic_load(cw, __ATOMIC_RELAXED, __HIP_MEMORY_SCOPE_AGENT)) < 32u) { __builtin_amdgcn_s_sleep(1); if (++sp > (1u << 20)) break; }
            __builtin_amdgcn_fence(__ATOMIC_ACQUIRE, "agent");
            asm volatile("s_waitcnt vmcnt(0)" ::: "memory");
        }
        asm volatile("" ::: "memory"); __builtin_amdgcn_s_barrier(); asm volatile("" ::: "memory");
        PROF_END(14);
        float rs[2][4]; load_rstd_sc1(ssp, row0, fq, rs);
#pragma unroll
        for (int bj = 0; bj < 2; ++bj) { const int c0 = u.pn * 256 + bj * 128 + wc * 32 + 8 * fq;
            const f32x4 gs0 = *(const f32x4*)(gf + c0) * (*(const f32x4*)(fsc + (size_t)b * LDM + c0) + 1.0f), gs1 = *(const f32x4*)(gf + c0 + 4) * (*(const f32x4*)(fsc + (size_t)b * LDM + c0 + 4) + 1.0f);
            const f32x4 sh0 = *(const f32x4*)(fsh + (size_t)b * LDM + c0), sh1 = *(const f32x4*)(fsh + (size_t)b * LDM + c0 + 4);
#pragma unroll
            for (int ai = 0; ai < 2; ++ai)
#pragma unroll
                for (int m = 0; m < 4; ++m) { const unsigned so = (unsigned)(((ai * 128 + m * 16) * D + bj * 128) * 4); const float r = rs[ai][m];
                    *(f32x4*)((char*)out + (size_t)voff + so) = acc[ai][bj][m][0] * r * gs0 + sh0;
                    *(f32x4*)((char*)out + (size_t)voff + so + 16) = acc[ai][bj][m][1] * r * gs1 + sh1; } }
    }
};
struct EpiMixIn {
    static constexpr bool PERM = true, AFTER_DRAIN = false; static constexpr int REPS = 1;
    pg8::bf16_t *U, *UX, *GY; const float* ssp; const float* bias;
    __device__ __forceinline__ void operator()(const f32x4 (&acc)[2][2][4][2], const pg8::Unit& u, int wr, int wc, int fr, int fq) const {
        const int row0 = u.pm * 256 + wr * 64 + fr, b = u.pm >> 4;
        float rs[2][4]; load_rstd(ssp, row0, fq, rs);
        const float* bp = bias + (size_t)b * NMIX + u.pn * 256 + wc * 32 + 8 * fq;
        const f32x4 b00 = *(const f32x4*)(bp), b01 = *(const f32x4*)(bp + 4), b10 = *(const f32x4*)(bp + 128), b11 = *(const f32x4*)(bp + 132);
        if (u.pn < 4) {
            const int oc = u.pn * 128 + wc * 32 + 8 * fq;
#pragma unroll
            for (int ai = 0; ai < 2; ++ai)
#pragma unroll
                for (int m = 0; m < 4; ++m) { const float r = rs[ai][m];
                    const f32x4 v0 = acc[ai][0][m][0] * r + b00, v1 = acc[ai][0][m][1] * r + b01, g0 = acc[ai][1][m][0] * r + b10, g1 = acc[ai][1][m][1] * r + b11;
                    const f32x4 a0 = v0 * sigmoid4(g0), a1 = v1 * sigmoid4(g1);
                    *(v4u*)(U + (size_t)(row0 + ai * 128 + m * 16) * DC + oc) = pack8(a0, a1); }
        } else {
            pg8::bf16_t* dst = (u.pn < 6) ? UX : GY; const bool gel = u.pn >= 6; const int pc = (u.pn & 1) * 256 + wc * 32 + 8 * fq;
#pragma unroll
            for (int ai = 0; ai < 2; ++ai)
#pragma unroll
                for (int m = 0; m < 4; ++m) { const float r = rs[ai][m];
#pragma unroll
                    for (int bj = 0; bj < 2; ++bj) { f32x4 v0 = acc[ai][bj][m][0] * r + (bj ? b10 : b00), v1 = acc[ai][bj][m][1] * r + (bj ? b11 : b01);
                        if (gel) { v0 = gelu_tanh4(v0); v1 = gelu_tanh4(v1); }
                        *(v4u*)(dst + (size_t)(row0 + ai * 128 + m * 16) * DR + pc + bj * 128) = pack8(v0, v1); } }
        }
    }
};

struct EpiMixIn8 {
    static constexpr bool PERM = true, AFTER_DRAIN = false; static constexpr int REPS = 1;
    pg8::bf16_t *U, *UX, *GY; const float* rs; const float* cs; const float* bias;
    __device__ __forceinline__ void operator()(const f32x4 (&acc)[2][2][4][2], const pg8::Unit& u, int wr, int wc, int fr, int fq) const {
        const int row0 = u.pm * 256 + wr * 64 + fr, b = u.pm >> 4;
        float rv[2][4];
#pragma unroll
        for (int ai = 0; ai < 2; ++ai)
#pragma unroll
            for (int m = 0; m < 4; ++m) rv[ai][m] = rs[row0 + ai * 128 + m * 16];
        const int cb = u.pn * 256 + wc * 32 + 8 * fq;
        const float* bp = bias + (size_t)b * NMIX + cb; const float* cp = cs + cb;
        const f32x4 b00 = *(const f32x4*)(bp), b01 = *(const f32x4*)(bp + 4), b10 = *(const f32x4*)(bp + 128), b11 = *(const f32x4*)(bp + 132);
        const f32x4 c00 = *(const f32x4*)(cp), c01 = *(const f32x4*)(cp + 4), c10 = *(const f32x4*)(cp + 128), c11 = *(const f32x4*)(cp + 132);
        if (u.pn < 4) {
            const int oc = u.pn * 128 + wc * 32 + 8 * fq;
#pragma unroll
            for (int ai = 0; ai < 2; ++ai)
#pragma unroll
                for (int m = 0; m < 4; ++m) { const float r = rv[ai][m];
                    const f32x4 v0 = acc_i2f(acc[ai][0][m][0]) * (c00 * r) + b00, v1 = acc_i2f(acc[ai][0][m][1]) * (c01 * r) + b01;
                    const f32x4 g0 = acc_i2f(acc[ai][1][m][0]) * (c10 * r) + b10, g1 = acc_i2f(acc[ai][1][m][1]) * (c11 * r) + b11;
                    const f32x4 a0 = v0 * sigmoid4(g0), a1 = v1 * sigmoid4(g1);
                    *(v4u*)(U + (size_t)(row0 + ai * 128 + m * 16) * DC + oc) = pack8(a0, a1); }
        } else {
            pg8::bf16_t* dst = (u.pn < 6) ? UX : GY; const bool gel = u.pn >= 6; const int pc = (u.pn & 1) * 256 + wc * 32 + 8 * fq;
#pragma unroll
            for (int ai = 0; ai < 2; ++ai)
#pragma unroll
                for (int m = 0; m < 4; ++m) { const float r = rv[ai][m];
#pragma unroll
                    for (int bj = 0; bj < 2; ++bj) { f32x4 v0 = acc_i2f(acc[ai][bj][m][0]) * ((bj ? c10 : c00) * r) + (bj ? b10 : b00), v1 = acc_i2f(acc[ai][bj][m][1]) * ((bj ? c11 : c01) * r) + (bj ? b11 : b01);
                        if (gel) { v0 = gelu_tanh4(v0); v1 = gelu_tanh4(v1); }
                        *(v4u*)(dst + (size_t)(row0 + ai * 128 + m * 16) * DR + pc + bj * 128) = pack8(v0, v1); } }
        }
    }
};

__device__ __forceinline__ void p0_gemv(LAS unsigned char* lds, const float* c, const float* W, int NC, const float* bias, float* out, int j0, int tid) {
    LAS float* ca = (LAS float*)lds; LAS float* part = (LAS float*)(lds + 32768);
    for (int i = tid; i < NB * D; i += 512) { const float v = c[i]; ca[i] = v / (1.f + expf(-v)); }
    __syncthreads();
    const int cg = tid & 31, ks = tid >> 5;
    const float* wp = W + (size_t)(64 * ks) * NC + j0 + 4 * cg;
    f32x4 acc[NB];
#pragma unroll
    for (int b = 0; b < NB; ++b) acc[b] = (f32x4){0.f, 0.f, 0.f, 0.f};
#pragma unroll 4
    for (int kk = 0; kk < 64; ++kk) { const f32x4 w = *(const f32x4*)(wp + (size_t)kk * NC);
#pragma unroll
        for (int b = 0; b < NB; ++b) acc[b] += w * ca[b * D + 64 * ks + kk]; }
#pragma unroll
    for (int b = 0; b < NB; ++b) *(LAS f32x4*)(part + (ks * NB + b) * 128 + 4 * cg) = acc[b];
    __syncthreads();
#pragma unroll
    for (int r = 0; r < 2; ++r) { const int o = tid + 512 * r, b = o >> 7, col = o & 127; float s = 0.f;
#pragma unroll
        for (int k2 = 0; k2 < 16; ++k2) s += part[(k2 * NB + b) * 128 + col];
        out[(size_t)b * LDM + j0 + col] = s + bias[j0 + col]; }
    __syncthreads();
}
__device__ __forceinline__ int rowmap(int kind, int n0) {
    if (kind == 1) { const int half = n0 / FF, f = n0 - half * FF; return 256 * (f >> 7) + 128 * half + (f & 127); }
    if (kind == 2 && n0 < 1024) { const int half = n0 >> 9, f = n0 & 511; return 256 * (f >> 7) + 128 * half + (f & 127); }
    return n0;
}
__device__ __forceinline__ void p0_transpose_item(const float* W, int K, int N, bf16* WT, int kind, LAS float* scr, int item, int lane) {
    const int nblk = N / 32, kb = item / nblk, nb = item % nblk, k0 = 64 * kb, n0 = 32 * nb, r0 = rowmap(kind, n0);
#pragma unroll 8
    for (int i = 0; i < 32; ++i) { const int kk = 2 * i + (lane >> 5); scr[kk * 33 + (lane & 31)] = W[(size_t)(k0 + kk) * N + n0 + (lane & 31)]; }
    LDS_WAIT(); asm volatile("" ::: "memory");
    const int c = lane & 7;
#pragma unroll
    for (int j = 0; j < 4; ++j) { const int n = (lane >> 3) + 8 * j; const LAS float* s = scr + (8 * c) * 33 + n;
        v4u o; o.x = pk2(s[0 * 33], s[1 * 33]); o.y = pk2(s[2 * 33], s[3 * 33]); o.z = pk2(s[4 * 33], s[5 * 33]); o.w = pk2(s[6 * 33], s[7 * 33]);
        *(GAS v4u*)(WT + (size_t)(r0 + n) * K + k0 + 8 * c) = o; }
    LDS_WAIT(); asm volatile("" ::: "memory");
}

__device__ __forceinline__ void p0_transpose8_item(const float* W, int K, int N, unsigned char* WT, LAS float* scr, int item, int lane) {
    const int nblk = N / 32, kb = item / nblk, nb = item % nblk, k0 = 64 * kb, n0 = 32 * nb;
#pragma unroll 8
    for (int i = 0; i < 32; ++i) { const int kk = 2 * i + (lane >> 5); scr[kk * 33 + (lane & 31)] = W[(size_t)(k0 + kk) * N + n0 + (lane & 31)]; }
    LDS_WAIT(); asm volatile("" ::: "memory");
    const int n = lane >> 1, kh = (lane & 1) * 32; const LAS float* sp = scr + n;
#pragma unroll
    for (int hq = 0; hq < 2; ++hq) { v4u o;
#pragma unroll
        for (int dq = 0; dq < 4; ++dq) { const int k = kh + 16 * hq + 4 * dq;
            const unsigned w4 = f8x4((f32x4){sp[(k + 0) * 33], sp[(k + 1) * 33], sp[(k + 2) * 33], sp[(k + 3) * 33]} * F8_W_SCALE);
            if (dq == 0) o.x = w4; else if (dq == 1) o.y = w4; else if (dq == 2) o.z = w4; else o.w = w4; }
        *(GAS v4u*)(WT + (size_t)(n0 + n) * K + k0 + kh + 16 * hq) = o; }
    LDS_WAIT(); asm volatile("" ::: "memory");
}
__device__ __forceinline__ void p0_quant_item(LAS unsigned char* lds, const float* W, int N, int kind, unsigned char* W8, float* cs, int nb, int lane, int wave) {
    LAS float* scr = (LAS float*)(lds + wave * 16896);
    LAS float* cm = (LAS float*)(lds + 8 * 16896);
    const int n0 = 32 * nb, r0 = rowmap(kind, n0);
#pragma unroll
    for (int tl = 0; tl < 2; ++tl) { const int k0 = 64 * (2 * wave + tl);
#pragma unroll 8
        for (int i = 0; i < 32; ++i) { const int kk = 2 * i + (lane >> 5); scr[tl * 2112 + kk * 33 + (lane & 31)] = W[(size_t)(k0 + kk) * N + n0 + (lane & 31)]; } }
    LDS_WAIT(); asm volatile("" ::: "memory");
    float mx = 0.f;
#pragma unroll
    for (int tl = 0; tl < 2; ++tl)
#pragma unroll 8
        for (int r = 0; r < 32; ++r) mx = fmaxf(mx, fabsf(scr[tl * 2112 + ((lane >> 5) * 32 + r) * 33 + (lane & 31)]));
    mx = fmaxf(mx, __shfl_xor(mx, 32));
    if (lane < 32) cm[wave * 32 + lane] = mx;
    __syncthreads();
    float cmax = 0.f;
#pragma unroll
    for (int w = 0; w < 8; ++w) cmax = fmaxf(cmax, cm[w * 32 + (lane & 31)]);
    const float sc = cmax > 0.f ? 127.0f / cmax : 0.f;
    if (wave == 0 && lane < 32) cs[r0 + lane] = cmax * (1.0f / 127.0f);
    const int n = lane >> 1, kh = (lane & 1) * 32;
    const float sn = __shfl(sc, n);
#pragma unroll
    for (int tl = 0; tl < 2; ++tl) { const int k0 = 64 * (2 * wave + tl); const LAS float* sp = scr + tl * 2112 + n;
#pragma unroll
        for (int hq = 0; hq < 2; ++hq) { v4u o;
#pragma unroll
            for (int dq = 0; dq < 4; ++dq) { const int k = kh + 16 * hq + 4 * dq;
                const unsigned w4 = q8(sp[(k + 0) * 33] * sn) | (q8(sp[(k + 1) * 33] * sn) << 8) | (q8(sp[(k + 2) * 33] * sn) << 16) | (q8(sp[(k + 3) * 33] * sn) << 24);
                if (dq == 0) o.x = w4; else if (dq == 1) o.y = w4; else if (dq == 2) o.z = w4; else o.w = w4; }
            *(GAS v4u*)(W8 + (size_t)(r0 + n) * D + k0 + kh + 16 * hq) = o; } }
    __syncthreads();
}

__device__ __forceinline__ void mix_conv(LAS unsigned char* lds, const bf16* U, const float* conv_w, const float* conv_b, const float* ln_g, const float* ln_b, bf16* YMIX, int G, int bx, int tid, int lane, int wave) {
    LAS unsigned char* IN = lds;
    LAS f32x4* WA = (LAS f32x4*)(lds + 63488);
    LAS f32x4* WB = WA + 31 * 64;
    for (int i = tid; i < 31 * 64; i += 512) { const int k = i >> 6, l = i & 63; WA[i] = *(const f32x4*)(conv_w + k * DC + 8 * l); WB[i] = *(const f32x4*)(conv_w + k * DC + 8 * l + 4); }
    const f32x4 cb0 = *(const f32x4*)(conv_b + 8 * lane), cb1 = *(const f32x4*)(conv_b + 8 * lane + 4);
    const f32x4 lg0 = *(const f32x4*)(ln_g + 8 * lane), lg1 = *(const f32x4*)(ln_g + 8 * lane + 4);
    const f32x4 lb0 = *(const f32x4*)(ln_b + 8 * lane), lb1 = *(const f32x4*)(ln_b + 8 * lane + 4);
    v4u pre[8];
#pragma unroll
    for (int i = 0; i < 8; ++i) { const int q = tid + 512 * i, row = q >> 6, ch = q & 63, tok = (bx & 127) * 32 - 30 + row; pre[i] = (v4u){0u, 0u, 0u, 0u};
        if (bx < NB * (SEQ / 32) && q < 62 * 64 && tok >= 0) pre[i] = *(const v4u*)(U + ((size_t)((bx >> 7) * SEQ + tok)) * DC + 8 * ch); }
    for (int item = bx; item < NB * (SEQ / 32); item += G) {
        const int b = item >> 7, t0 = (item & 127) * 32;
        __syncthreads();
#pragma unroll
        for (int i = 0; i < 8; ++i) { const int q = tid + 512 * i; if (q < 62 * 64) *(LAS v4u*)(IN + (q >> 6) * 1024 + (q & 63) * 16) = pre[i]; }
        { const int nitem = item + G, nb = nitem >> 7, nt0 = (nitem & 127) * 32;
#pragma unroll
            for (int i = 0; i < 8; ++i) { const int q = tid + 512 * i, row = q >> 6, ch = q & 63, tok = nt0 - 30 + row; pre[i] = (v4u){0u, 0u, 0u, 0u};
                if (nitem < NB * (SEQ / 32) && q < 62 * 64 && tok >= 0) pre[i] = *(const v4u*)(U + ((size_t)(nb * SEQ + tok)) * DC + 8 * ch); } }
        __syncthreads();
        f32x4 a0[4], a1[4];
#pragma unroll
        for (int tt = 0; tt < 4; ++tt) { a0[tt] = cb0; a1[tt] = cb1; }
        f32x4 wa0 = {0.f, 0.f, 0.f, 0.f}, wa1 = wa0, wa2 = wa0, wa3 = wa0, wb0 = wa0, wb1 = wa0, wb2 = wa0, wb3 = wa0;
#pragma unroll
        for (int kk = 0; kk < 34; ++kk) {
            const v4u v = *(const LAS v4u*)(IN + (4 * wave + kk) * 1024 + lane * 16);
            const f32x4 x0 = {bflo(v.x), bfhi(v.x), bflo(v.y), bfhi(v.y)}, x1 = {bflo(v.z), bfhi(v.z), bflo(v.w), bfhi(v.w)};
            wa3 = wa2; wa2 = wa1; wa1 = wa0; wb3 = wb2; wb2 = wb1; wb1 = wb0;
            if (kk <= 30) { wa0 = WA[kk * 64 + lane]; wb0 = WB[kk * 64 + lane]; } else { wa0 = (f32x4){0.f, 0.f, 0.f, 0.f}; wb0 = wa0; }
            a0[0] += wa0 * x0; a1[0] += wb0 * x1; a0[1] += wa1 * x0; a1[1] += wb1 * x1; a0[2] += wa2 * x0; a1[2] += wb2 * x1; a0[3] += wa3 * x0; a1[3] += wb3 * x1;
        }
#pragma unroll
        for (int tt = 0; tt < 4; ++tt) {
            float s = (a0[tt][0] + a0[tt][1]) + (a0[tt][2] + a0[tt][3]) + (a1[tt][0] + a1[tt][1]) + (a1[tt][2] + a1[tt][3]);
            const float mean = wave_sum(s) * (1.0f / DC);
            const f32x4 d0 = a0[tt] - mean, d1 = a1[tt] - mean;
            float q = (d0[0] * d0[0] + d0[1] * d0[1]) + (d0[2] * d0[2] + d0[3] * d0[3]) + (d1[0] * d1[0] + d1[1] * d1[1]) + (d1[2] * d1[2] + d1[3] * d1[3]);
            const float rstd = rsqrtf(wave_sum(q) * (1.0f / DC) + EPS);
            f32x4 y0 = d0 * rstd * lg0 + lb0, y1 = d1 * rstd * lg1 + lb1;
#pragma unroll
            for (int j = 0; j < 4; ++j) { y0[j] = silu_fast(y0[j]); y1[j] = silu_fast(y1[j]); }
            *(v4u*)(YMIX + ((size_t)(b * SEQ + t0 + 4 * wave + tt)) * D + 8 * lane) = pack8(y0, y1);
        }
    }
    __syncthreads();
}

__device__ __forceinline__ void mix_conv2(LAS unsigned char* lds, const bf16* U, const float* conv_w, const float* conv_b, const float* ln_g, const float* ln_b, bf16* YMIX, int G, int bx, int tid, int lane, int wave) {
    LAS unsigned char* IN = lds;
    LAS float* RED = (LAS float*)(lds + 63488);
    const int th = wave >> 2, cq = wave & 3, ch = 128 * cq + 2 * lane;
    f32x2 wt[31];
#pragma unroll
    for (int k = 0; k < 31; ++k) wt[k] = *(const f32x2*)(conv_w + k * DC + ch);
    const f32x2 cb = *(const f32x2*)(conv_b + ch), lg = *(const f32x2*)(ln_g + ch), lb = *(const f32x2*)(ln_b + ch);
    v4u pre[8];
#pragma unroll
    for (int i = 0; i < 8; ++i) { const int q = tid + 512 * i, row = q >> 6, c16 = q & 63, tok = (bx & 127) * 32 - 30 + row; pre[i] = (v4u){0u, 0u, 0u, 0u};
        if (bx < NB * (SEQ / 32) && q < 62 * 64 && tok >= 0) pre[i] = *(const v4u*)(U + ((size_t)((bx >> 7) * SEQ + tok)) * DC + 8 * c16); }
    for (int item = bx; item < NB * (SEQ / 32); item += G) {
        const int b = item >> 7, t0 = (item & 127) * 32;
        PROF_BEGIN(10);
        __syncthreads();
#pragma unroll
        for (int i = 0; i < 8; ++i) { const int q = tid + 512 * i; if (q < 62 * 64) *(LAS v4u*)(IN + (q >> 6) * 1024 + (q & 63) * 16) = pre[i]; }
        { const int nitem = item + G, nb = nitem >> 7, nt0 = (nitem & 127) * 32;
#pragma unroll
            for (int i = 0; i < 8; ++i) { const int q = tid + 512 * i, row = q >> 6, c16 = q & 63, tok = nt0 - 30 + row; pre[i] = (v4u){0u, 0u, 0u, 0u};
                if (nitem < NB * (SEQ / 32) && q < 62 * 64 && tok >= 0) pre[i] = *(const v4u*)(U + ((size_t)(nb * SEQ + tok)) * DC + 8 * c16); } }
        __syncthreads();
        PROF_END(10); PROF_BEGIN(11);
        f32x2 acc[16];
#pragma unroll
        for (int tt = 0; tt < 16; ++tt) acc[tt] = cb;
        const LAS unsigned char* ip = IN + (16 * th) * 1024 + ch * 2;
#pragma unroll
        for (int r = 0; r < 46; ++r) {
            const unsigned v = *(const LAS unsigned*)(ip + r * 1024);
            const f32x2 xv = {bflo(v), bfhi(v)};
#pragma unroll
            for (int tt = 0; tt < 16; ++tt) { const int k = r - tt; if (k >= 0 && k <= 30) acc[tt] += wt[k] * xv; }
        }
        PROF_END(11); PROF_BEGIN(12);
        float vals[32];
#pragma unroll
        for (int tt = 0; tt < 16; ++tt) { vals[tt] = acc[tt][0] + acc[tt][1]; vals[16 + tt] = acc[tt][0] * acc[tt][0] + acc[tt][1] * acc[tt][1]; }
#pragma unroll
        for (int i = 0; i < 16; ++i) { const auto p = __builtin_amdgcn_permlane32_swap((int)__float_as_uint(vals[i]), (int)__float_as_uint(vals[i + 16]), false, false); vals[i] = __uint_as_float((unsigned)p[0]) + __uint_as_float((unsigned)p[1]); }
#pragma unroll
        for (int i = 0; i < 8; ++i) { const auto p = __builtin_amdgcn_permlane16_swap((int)__float_as_uint(vals[i]), (int)__float_as_uint(vals[i + 8]), false, false); vals[i] = __uint_as_float((unsigned)p[0]) + __uint_as_float((unsigned)p[1]); }
#define CONV_RED_STEP(off, n) { const bool up = (lane & (off)) != 0; _Pragma("unroll") for (int i = 0; i < (n); ++i) { const float keep = up ? vals[i + (n)] : vals[i], send = up ? vals[i] : vals[i + (n)]; vals[i] = keep + sx<(off)>(send); } }
        CONV_RED_STEP(8, 4) CONV_RED_STEP(4, 2) CONV_RED_STEP(2, 1)
#undef CONV_RED_STEP
        vals[0] += sx<1>(vals[0]);
        if ((lane & 1) == 0) RED[wave * 32 + (lane >> 5) * 16 + ((lane >> 1) & 15)] = vals[0];
        __syncthreads();
        float mean_l = 0.f, rstd_l = 0.f;
        if (lane < 16) { float s1 = 0.f, s2 = 0.f;
#pragma unroll
            for (int q4 = 0; q4 < 4; ++q4) { s1 += RED[(4 * th + q4) * 32 + lane]; s2 += RED[(4 * th + q4) * 32 + 16 + lane]; }
            mean_l = s1 * (1.0f / DC); const float var = fmaxf(s2 * (1.0f / DC) - mean_l * mean_l, 0.f); rstd_l = rsqrtf(var + EPS); }
#pragma unroll
        for (int tt = 0; tt < 16; ++tt) {
            const float mean = __uint_as_float((unsigned)__builtin_amdgcn_readlane((int)__float_as_uint(mean_l), tt)), rstd = __uint_as_float((unsigned)__builtin_amdgcn_readlane((int)__float_as_uint(rstd_l), tt));
            f32x2 y = (acc[tt] - mean) * rstd * lg + lb;
            y[0] = silu_fast(y[0]); y[1] = silu_fast(y[1]);
            *(unsigned*)(YMIX + ((size_t)(b * SEQ + t0 + 16 * th + tt)) * D + ch) = cvtpk(y[0], y[1]);
        }
        PROF_END(12);
    }
    __syncthreads();
}

__device__ __forceinline__ void scan_decode(int it, int& b, int& c) { if (it < 256) { b = it >> 6; c = it & 63; } else { b = 4 + ((it - 256) >> 6); c = 63 - ((it - 256) & 63); } }
__device__ __forceinline__ float neg_expm1(float x, float a) {
    float p = -1.0f / 5040.0f; p = p * x - 1.0f / 720.0f; p = p * x - 1.0f / 120.0f; p = p * x - 1.0f / 24.0f; p = p * x - 1.0f / 6.0f; p = p * x - 0.5f; p = p * x - 1.0f;
    float q = p * x, w = 1.0f - a * a; asm volatile("" : "+v"(q), "+v"(w));
    return x > -0.5f ? q : w;
}
__device__ __forceinline__ void gate_math16(const f32x16 pa, const f32x16 pi, float ba, float bi, float c8, f32x16& av, f32x16& bv) {
#pragma unroll
    for (int g4 = 0; g4 < 4; ++g4) {
        const f32x4 pa4 = {pa[4 * g4], pa[4 * g4 + 1], pa[4 * g4 + 2], pa[4 * g4 + 3]}, pi4 = {pi[4 * g4], pi[4 * g4 + 1], pi[4 * g4 + 2], pi[4 * g4 + 3]};
        const f32x4 rg = sigmoid4(pa4 + ba), ig = sigmoid4(pi4 + bi);
        const f32x4 l2 = rg * c8;
        const f32x4 a = {__builtin_amdgcn_exp2f(l2[0]), __builtin_amdgcn_exp2f(l2[1]), __builtin_amdgcn_exp2f(l2[2]), __builtin_amdgcn_exp2f(l2[3])};
        const f32x4 x = l2 * 1.3862943611198906f;
        f32x4 p = x * (-1.0f / 5040.0f) - 1.0f / 720.0f; p = p * x - 1.0f / 120.0f; p = p * x - 1.0f / 24.0f; p = p * x - 1.0f / 6.0f; p = p * x - 0.5f; p = p * x - 1.0f;
        f32x4 q = p * x, w = 1.0f - a * a; asm volatile("" : "+v"(q), "+v"(w));
        f32x4 m2;
#pragma unroll
        for (int e = 0; e < 4; ++e) m2[e] = __builtin_amdgcn_sqrtf(x[e] > -0.5f ? q[e] : w[e]);
        const f32x4 bb = m2 * ig;
#pragma unroll
        for (int e = 0; e < 4; ++e) { av[4 * g4 + e] = a[e]; bv[4 * g4 + e] = bb[e]; }
        __builtin_amdgcn_sched_barrier(0);
    }
}
template <bool FINAL>
__device__ __forceinline__ void mix_scan(LAS unsigned char* lds, const bf16* UX, const bf16* GY, const bf16* WGT, const float* rw, const float* rb, const float* b_a, const float* b_i, const float* lam,
                                         f32x2* TOT, bf16* YMIX, int G, int bx, int lane, int wave) {
    LAS unsigned char* UXT = lds + wave * 16896;
    LAS unsigned char* XRT = UXT + 8704;
    const int h = wave, j = lane & 31, hh = lane >> 5, dg = lane & 7, tg = lane >> 3;
    float c8v[2], bav[2], biv[2];
#pragma unroll
    for (int ec = 0; ec < 2; ++ec) { const int ch = 64 * h + 32 * ec + j; c8v[ec] = -8.0f * 1.4426950408889634f * log1pf(expf(-lam[ch]));   bav[ec] = b_a[ch]; biv[ec] = b_i[ch]; }
    for (int it = bx; it < 512; it += G) {
        asm volatile("" ::: "memory");
        int b, c; scan_decode(it, b, c);
        const size_t mrow0 = (size_t)b * SEQ + 64 * c;
#pragma unroll
        for (int i = 0; i < 9; ++i) { const int row = i * 8 + tg, tok = 64 * c - 3 + row; v4u v = {0u, 0u, 0u, 0u};
            if (row < 67 && tok >= 0) v = *(const v4u*)(UX + ((size_t)b * SEQ + tok) * DR + 64 * h + 8 * dg);
            if (row < 68) *(LAS v4u*)(UXT + row * 128 + dg * 16) = v; }
        pg8::bf16x8 bfr[2][4];
#pragma unroll
        for (int g = 0; g < 2; ++g)
#pragma unroll
            for (int ks = 0; ks < 4; ++ks) bfr[g][ks] = *(const pg8::bf16x8*)(WGT + ((size_t)(h * 128 + 64 * g + j)) * 64 + 16 * ks + 8 * hh);
        v4u gyv[8];
        if (FINAL) {
#pragma unroll
            for (int i = 0; i < 8; ++i) gyv[i] = *(const v4u*)(GY + (mrow0 + i * 8 + tg) * DR + 64 * h + 8 * dg);
        }
        float Hc = 0.f;
        if (FINAL) { const f32x2* tp = TOT + ((size_t)b * 64) * DR + 64 * h + lane; int cc = 0;
            for (; cc + 8 <= c; cc += 8) { f32x2 t8[8];
#pragma unroll
                for (int u = 0; u < 8; ++u) t8[u] = tp[(size_t)(cc + u) * DR];
#pragma unroll
                for (int u = 0; u < 8; ++u) Hc = Hc * t8[u].x + t8[u].y; }
            for (; cc < c; ++cc) { const f32x2 ab = tp[(size_t)cc * DR]; Hc = Hc * ab.x + ab.y; } }
        {
            f32x4 w4a[4], w4b[4];
#pragma unroll
            for (int k = 0; k < 4; ++k) { w4a[k] = *(const f32x4*)(rw + k * DR + 64 * h + 8 * dg); w4b[k] = *(const f32x4*)(rw + k * DR + 64 * h + 8 * dg + 4); }
            const f32x4 rb0 = *(const f32x4*)(rb + 64 * h + 8 * dg), rb1 = *(const f32x4*)(rb + 64 * h + 8 * dg + 4);
#pragma unroll
            for (int th = 0; th < 2; ++th) {
                f32x4 o0[4], o1[4];
#pragma unroll
                for (int t = 0; t < 4; ++t) { o0[t] = rb0; o1[t] = rb1; }
#pragma unroll
                for (int i = 0; i < 7; ++i) { const v4u v = *(const LAS v4u*)(UXT + (8 * tg + 4 * th + i) * 128 + dg * 16);
                    const f32x4 x0 = {bflo(v.x), bfhi(v.x), bflo(v.y), bfhi(v.y)}, x1 = {bflo(v.z), bfhi(v.z), bflo(v.w), bfhi(v.w)};
#pragma unroll
                    for (int k = 0; k < 4; ++k) { const int t = i - k; if (t >= 0 && t < 4) { o0[t] += w4a[k] * x0; o1[t] += w4b[k] * x1; } } }
#pragma unroll
                for (int t = 0; t < 4; ++t) *(LAS v4u*)(XRT + (8 * tg + 4 * th + t) * 128 + dg * 16) = pack8(o0[t], o1[t]);
            }
        }
        if (FINAL) {
#pragma unroll
            for (int i = 0; i < 8; ++i) *(LAS v4u*)(UXT + (i * 8 + tg) * 128 + dg * 16) = gyv[i];
        }
#pragma unroll
        for (int ec = 0; ec < 2; ++ec) {
            const int ch = 64 * h + 32 * ec + j;
            const float c8 = c8v[ec], ba = bav[ec], bi = biv[ec];
            f32x16 av[2], bv[2];
#pragma unroll
            for (int tt = 0; tt < 2; ++tt) {
                pg8::bf16x8 afr[4];
#pragma unroll
                for (int ks = 0; ks < 4; ++ks) afr[ks] = *(const LAS pg8::bf16x8*)(XRT + (32 * tt + j) * 128 + (16 * ks + 8 * hh) * 2);
                f32x16 pa, pi;
#pragma unroll
                for (int r = 0; r < 16; ++r) { pa[r] = 0.f; pi[r] = 0.f; }
#pragma unroll
                for (int ks = 0; ks < 4; ++ks) {
                    pa = __builtin_amdgcn_mfma_f32_32x32x16_bf16(afr[ks], bfr[0][ks], pa, 0, 0, 0);
                    pi = __builtin_amdgcn_mfma_f32_32x32x16_bf16(afr[ks], bfr[1][ks], pi, 0, 0, 0); }
                if (ec == 0 && tt == 1) {
#pragma unroll
                    for (int g = 0; g < 2; ++g)
#pragma unroll
                        for (int ks = 0; ks < 4; ++ks) bfr[g][ks] = *(const pg8::bf16x8*)(WGT + ((size_t)(h * 128 + 64 * g + 32 + j)) * 64 + 16 * ks + 8 * hh);
                }
                gate_math16(pa, pi, ba, bi, c8, av[tt], bv[tt]);
                {
                    f32x16 px;
#pragma unroll
                    for (int r = 0; r < 16; ++r) px[r] = bv[tt][r] * 0.f;
                    int dd = 32 * ec + j - 8 * hh; asm volatile("" : "+v"(dd));
                    const unsigned one = (dd & 1) ? 0x3F800000u : 0x00003F80u;
#pragma unroll
                    for (int ks = 0; ks < 4; ++ks) {
                        const int dw = (dd - 16 * ks) >> 1;
                        v4u idw; idw.x = dw == 0 ? one : 0u; idw.y = dw == 1 ? one : 0u; idw.z = dw == 2 ? one : 0u; idw.w = dw == 3 ? one : 0u;
                        px = __builtin_amdgcn_mfma_f32_32x32x16_bf16(afr[ks], __builtin_bit_cast(pg8::bf16x8, idw), px, 0, 0, 0); }
#pragma unroll
                    for (int r = 0; r < 16; ++r) bv[tt][r] *= px[r];
                }
            }
            float GA[2][4], GB[2][4], PA[2][4], PB[2][4];
#pragma unroll
            for (int tt = 0; tt < 2; ++tt)
#pragma unroll
                for (int q = 0; q < 4; ++q) { const float a0 = av[tt][4 * q], a1 = av[tt][4 * q + 1], a2 = av[tt][4 * q + 2], a3 = av[tt][4 * q + 3];
                    const float b0 = bv[tt][4 * q], b1 = bv[tt][4 * q + 1], b2 = bv[tt][4 * q + 2], b3 = bv[tt][4 * q + 3];
                    GA[tt][q] = (a0 * a1) * (a2 * a3); GB[tt][q] = ((b0 * a1 + b1) * a2 + b2) * a3 + b3;
                    PA[tt][q] = __shfl_xor(GA[tt][q], 32); PB[tt][q] = __shfl_xor(GB[tt][q], 32); }
            if (!FINAL) {
                float At = 1.f, Bt = 0.f;
#pragma unroll
                for (int tt = 0; tt < 2; ++tt)
#pragma unroll
                    for (int q = 0; q < 4; ++q) { const float A0 = hh ? PA[tt][q] : GA[tt][q], B0 = hh ? PB[tt][q] : GB[tt][q], A1 = hh ? GA[tt][q] : PA[tt][q], B1 = hh ? GB[tt][q] : PB[tt][q];
                        Bt = (Bt * A0 + B0) * A1 + B1; At = (At * A0) * A1; }
                if (hh == 0) TOT[((size_t)b * 64 + c) * DR + ch] = (f32x2){At, Bt};
            } else {
                float hc = __shfl(Hc, 32 * ec + j);
#pragma unroll
                for (int tt = 0; tt < 2; ++tt)
#pragma unroll
                    for (int q = 0; q < 4; ++q) { const float A0 = hh ? PA[tt][q] : GA[tt][q], B0 = hh ? PB[tt][q] : GB[tt][q], A1 = hh ? GA[tt][q] : PA[tt][q], B1 = hh ? GB[tt][q] : PB[tt][q];
                        const float mid = hc * A0 + B0; float hv = hh ? mid : hc; hc = mid * A1 + B1;
#pragma unroll
                        for (int i = 0; i < 4; ++i) { hv = av[tt][4 * q + i] * hv + bv[tt][4 * q + i]; av[tt][4 * q + i] = hv; } }
#pragma unroll
                for (int tt = 0; tt < 2; ++tt)
#pragma unroll
                    for (int r = 0; r < 16; ++r) { const int tk = 32 * tt + (r & 3) + 8 * (r >> 2) + 4 * hh;
                        LAS u16* p = (LAS u16*)(UXT + tk * 128 + (32 * ec + j) * 2);
                        const float gy = __uint_as_float((unsigned)(*p) << 16);
                        *p = (u16)f2bf(gy * av[tt][r]); }
            }
        }
        if (FINAL) {
#pragma unroll
            for (int i = 0; i < 8; ++i) { const int row = i * 8 + tg; *(v4u*)(YMIX + (mrow0 + row) * D + DC + 64 * h + 8 * dg) = *(const LAS v4u*)(UXT + row * 128 + dg * 16); }
        }
    }
    __syncthreads();
}

#ifndef FOLD_B
#define FOLD_B 4
#endif
__device__ __forceinline__ void fold_chunks(const gu64* tp, int c0, int c1, int hh, float& A, float& B) {
    const int mid = (c0 + c1 + 1) >> 1, lo = hh ? mid : c0, hi2 = hh ? c1 : mid;
    float Ar = 1.f, Br = 0.f;
    for (int cc = lo; cc < hi2; cc += FOLD_B) { unsigned long long t8[FOLD_B];
        for (unsigned sp = 0;; ++sp) { unsigned all = 0x80000000u;
#pragma unroll
            for (int u = 0; u < FOLD_B; ++u) t8[u] = __hip_atomic_load(tp + (size_t)(cc + u < 63 ? cc + u : 63) * DR, RLX_AGENT);
#pragma unroll
            for (int u = 0; u < FOLD_B; ++u) all &= (cc + u < hi2) ? (unsigned)t8[u] : 0x80000000u;
            if (all || sp > (1u << 16)) break;
            __builtin_amdgcn_s_sleep(1); }
#pragma unroll
        for (int u = 0; u < FOLD_B; ++u) { const bool ok = cc + u < hi2; const float ta = ok ? __uint_as_float((unsigned)t8[u] & 0x7fffffffu) : 1.f, tb = ok ? __uint_as_float((unsigned)(t8[u] >> 32)) : 0.f; Br = Br * ta + tb; Ar = Ar * ta; } }
    const float Ap = __shfl_xor(Ar, 32), Bp = __shfl_xor(Br, 32);
    A = Ar * Ap; B = hh ? (Bp * Ar + Br) : (Br * Ap + Bp);
}
__device__ __forceinline__ void mix_scan1(LAS unsigned char* lds, const bf16* UX, const bf16* GY, const bf16* WGT, const float* rw, const float* rb, const float* b_a, const float* b_i, const float* lam,
                                          f32x2* TOT, unsigned* cnt, bf16* YMIX, int G, int bx, int lane, int wave) {
    LAS unsigned char* UXT = lds + wave * 16896;
    LAS unsigned char* XRT = UXT + 8704;
    const int h = wave, j = lane & 31, hh = lane >> 5, dg = lane & 7, tg = lane >> 3;
    const int gs = G >> 3, b = bx / gs, idx = bx - b * gs;
    float c8v[2], bav[2], biv[2];
#pragma unroll
    for (int ec = 0; ec < 2; ++ec) { const int ch = 64 * h + 32 * ec + j; c8v[ec] = -8.0f * 1.4426950408889634f * log1pf(expf(-lam[ch])); bav[ec] = b_a[ch]; biv[ec] = b_i[ch]; }
    for (int c = idx, round = 0; c < 64; c += gs, ++round) {
        asm volatile("" ::: "memory");
        PROF_BEGIN(3);
        const size_t mrow0 = (size_t)b * SEQ + 64 * c;
#pragma unroll
        for (int i = 0; i < 9; ++i) { const int row = i * 8 + tg, tok = 64 * c - 3 + row; v4u v = {0u, 0u, 0u, 0u};
            if (row < 67 && tok >= 0) v = *(const v4u*)(UX + ((size_t)b * SEQ + tok) * DR + 64 * h + 8 * dg);
            if (row < 68) *(LAS v4u*)(UXT + row * 128 + dg * 16) = v; }
        pg8::bf16x8 bfr[2][4];
#pragma unroll
        for (int g = 0; g < 2; ++g)
#pragma unroll
            for (int ks = 0; ks < 4; ++ks) bfr[g][ks] = *(const pg8::bf16x8*)(WGT + ((size_t)(h * 128 + 64 * g + j)) * 64 + 16 * ks + 8 * hh);
        {
            f32x4 w4a[4], w4b[4];
#pragma unroll
            for (int k = 0; k < 4; ++k) { w4a[k] = *(const f32x4*)(rw + k * DR + 64 * h + 8 * dg); w4b[k] = *(const f32x4*)(rw + k * DR + 64 * h + 8 * dg + 4); }
            const f32x4 rb0 = *(const f32x4*)(rb + 64 * h + 8 * dg), rb1 = *(const f32x4*)(rb + 64 * h + 8 * dg + 4);
#pragma unroll
            for (int th = 0; th < 2; ++th) {
                f32x4 o0[4], o1[4];
#pragma unroll
                for (int t = 0; t < 4; ++t) { o0[t] = rb0; o1[t] = rb1; }
#pragma unroll
                for (int i = 0; i < 7; ++i) { const v4u v = *(const LAS v4u*)(UXT + (8 * tg + 4 * th + i) * 128 + dg * 16);
                    const f32x4 x0 = {bflo(v.x), bfhi(v.x), bflo(v.y), bfhi(v.y)}, x1 = {bflo(v.z), bfhi(v.z), bflo(v.w), bfhi(v.w)};
#pragma unroll
                    for (int k = 0; k < 4; ++k) { const int t = i - k; if (t >= 0 && t < 4) { o0[t] += w4a[k] * x0; o1[t] += w4b[k] * x1; } } }
#pragma unroll
                for (int t = 0; t < 4; ++t) *(LAS v4u*)(XRT + (8 * tg + 4 * th + t) * 128 + dg * 16) = pack8(o0[t], o1[t]);
            }
        }
        PROF_END(3);
#pragma unroll
        for (int ec = 0; ec < 2; ++ec) {
            PROF_BEGIN(4);
            const int ch = 64 * h + 32 * ec + j;
            const float c8 = c8v[ec], ba = bav[ec], bi = biv[ec];
            unsigned* cw = cnt + 64 * (8 * ec + b);
            f32x16 av[2], bv[2];
#pragma unroll
            for (int tt = 0; tt < 2; ++tt) {
                pg8::bf16x8 afr[4];
#pragma unroll
                for (int ks = 0; ks < 4; ++ks) afr[ks] = *(const LAS pg8::bf16x8*)(XRT + (32 * tt + j) * 128 + (16 * ks + 8 * hh) * 2);
                f32x16 pa, pi;
#pragma unroll
                for (int r = 0; r < 16; ++r) { pa[r] = 0.f; pi[r] = 0.f; }
#pragma unroll
                for (int ks = 0; ks < 4; ++ks) {
                    pa = __builtin_amdgcn_mfma_f32_32x32x16_bf16(afr[ks], bfr[0][ks], pa, 0, 0, 0);
                    pi = __builtin_amdgcn_mfma_f32_32x32x16_bf16(afr[ks], bfr[1][ks], pi, 0, 0, 0); }
                if (ec == 0 && tt == 1) {
#pragma unroll
                    for (int g = 0; g < 2; ++g)
#pragma unroll
                        for (int ks = 0; ks < 4; ++ks) bfr[g][ks] = *(const pg8::bf16x8*)(WGT + ((size_t)(h * 128 + 64 * g + 32 + j)) * 64 + 16 * ks + 8 * hh);
                }
                gate_math16(pa, pi, ba, bi, c8, av[tt], bv[tt]);
                {
                    f32x16 px;
#pragma unroll
                    for (int r = 0; r < 16; ++r) px[r] = bv[tt][r] * 0.f;
                    int dd = 32 * ec + j - 8 * hh; asm volatile("" : "+v"(dd));
                    const unsigned one = (dd & 1) ? 0x3F800000u : 0x00003F80u;
#pragma unroll
                    for (int ks = 0; ks < 4; ++ks) {
                        const int dw = (dd - 16 * ks) >> 1;
                        v4u idw; idw.x = dw == 0 ? one : 0u; idw.y = dw == 1 ? one : 0u; idw.z = dw == 2 ? one : 0u; idw.w = dw == 3 ? one : 0u;
                        px = __builtin_amdgcn_mfma_f32_32x32x16_bf16(afr[ks], __builtin_bit_cast(pg8::bf16x8, idw), px, 0, 0, 0); }
#pragma unroll
                    for (int r = 0; r < 16; ++r) bv[tt][r] *= px[r];
                }
            }
            float GA[2][4], GB[2][4], PA[2][4], PB[2][4];
            float At = 1.f, Bt = 0.f;
#pragma unroll
            for (int tt = 0; tt < 2; ++tt)
#pragma unroll
                for (int q = 0; q < 4; ++q) { const float a0 = av[tt][4 * q], a1 = av[tt][4 * q + 1], a2 = av[tt][4 * q + 2], a3 = av[tt][4 * q + 3];
                    const float b0 = bv[tt][4 * q], b1 = bv[tt][4 * q + 1], b2 = bv[tt][4 * q + 2], b3 = bv[tt][4 * q + 3];
                    GA[tt][q] = (a0 * a1) * (a2 * a3); GB[tt][q] = ((b0 * a1 + b1) * a2 + b2) * a3 + b3;
                    PA[tt][q] = __shfl_xor(GA[tt][q], 32); PB[tt][q] = __shfl_xor(GB[tt][q], 32);
                    const float A0 = hh ? PA[tt][q] : GA[tt][q], B0 = hh ? PB[tt][q] : GB[tt][q], A1 = hh ? GA[tt][q] : PA[tt][q], B1 = hh ? GB[tt][q] : PB[tt][q];
                    Bt = (Bt * A0 + B0) * A1 + B1; At = (At * A0) * A1; }
            if (hh == 0) __hip_atomic_store((gu64*)(TOT + ((size_t)b * 64 + c) * DR + ch), ((unsigned long long)__float_as_uint(Bt) << 32) | (__float_as_uint(At) | 0x80000000u), RLX_AGENT);
            PROF_END(4); PROF_BEGIN(7);
            if (ec == 0) {
#pragma unroll
                for (int i = 0; i < 8; ++i) *(LAS v4u*)(UXT + (i * 8 + tg) * 128 + dg * 16) = *(const v4u*)(GY + (mrow0 + i * 8 + tg) * DR + 64 * h + 8 * dg);
            }
            PROF_END(7);
            PROF_BEGIN(2);
            const gu64* tp = (const gu64*)(TOT + ((size_t)b * 64) * DR + ch);
            float hc;
            { float Aq, Bq; fold_chunks(tp, 0, c, hh, Aq, Bq); hc = Bq; }
            PROF_END(2); PROF_BEGIN(5);
#pragma unroll
            for (int tt = 0; tt < 2; ++tt)
#pragma unroll
                for (int q = 0; q < 4; ++q) { const float A0 = hh ? PA[tt][q] : GA[tt][q], B0 = hh ? PB[tt][q] : GB[tt][q], A1 = hh ? GA[tt][q] : PA[tt][q], B1 = hh ? GB[tt][q] : PB[tt][q];
                    const float mid = hc * A0 + B0; float hv = hh ? mid : hc; hc = mid * A1 + B1;
#pragma unroll
                    for (int i = 0; i < 4; ++i) { hv = av[tt][4 * q + i] * hv + bv[tt][4 * q + i]; av[tt][4 * q + i] = hv; } }
#pragma unroll
            for (int tt = 0; tt < 2; ++tt)
#pragma unroll
                for (int r = 0; r < 16; ++r) { const int tk = 32 * tt + (r & 3) + 8 * (r >> 2) + 4 * hh;
                    LAS u16* p = (LAS u16*)(UXT + tk * 128 + (32 * ec + j) * 2);
                    const float gy = __uint_as_float((unsigned)(*p) << 16);
                    *p = (u16)f2bf(gy * av[tt][r]); }
            PROF_END(5);
        }
        PROF_BEGIN(6);
#pragma unroll
        for (int i = 0; i < 8; ++i) { const int row = i * 8 + tg; *(v4u*)(YMIX + (mrow0 + row) * D + DC + 64 * h + 8 * dg) = *(const LAS v4u*)(UXT + row * 128 + dg * 16); }
        PROF_END(6);
    }
    __syncthreads();
}

struct Args { const float* in[27]; float* out; unsigned char* ws; int ph_lo, ph_hi; };
constexpr int NPH = 10;
#ifndef MK_PER_PHASE
#define MK_PER_PHASE 0
#endif
#define MK_STR2(x) #x
#define MK_STR(x) MK_STR2(x)
#ifndef MK_REP_P1X
#define MK_REP_P1X 1
#endif
#ifndef MK_REP_P1B
#define MK_REP_P1B 1
#endif
#ifndef MK_REP_GEMV
#define MK_REP_GEMV 1
#endif
#ifndef MK_REP_QUANT
#define MK_REP_QUANT 1
#endif
#ifndef MK_REP_TRANS
#define MK_REP_TRANS 1
#endif
#ifndef MK_REP_LO
#define MK_REP_LO 0
#define MK_REP_HI 0
#endif

__global__ void __launch_bounds__(NWAVES * 64, 2) mk_fwd(Args args) {
    extern __shared__ __attribute__((aligned(16))) unsigned char lds_raw[];
    LAS unsigned char* lds = (LAS unsigned char*)lds_raw;
    const int tid = threadIdx.x, wave = __builtin_amdgcn_readfirstlane(tid >> 6);
#define LANE_HERE int lane; asm volatile("v_mbcnt_lo_u32_b32 %0, -1, 0\n\tv_mbcnt_hi_u32_b32 %0, -1, %0" : "=v"(lane))
    const int G = gridDim.x, bx = blockIdx.x;
    const int vcu = (G % 8 == 0) ? (bx % 8) * (G / 8) + bx / 8 : bx;
    const int gw = vcu * NWAVES + wave, NGW = G * NWAVES;
    unsigned char* ws = args.ws;
    gu32* ctl = (gu32*)(ws + WS_CTL);
    const float* x = args.in[0]; const float* cvec = args.in[1]; const float* w_mod = args.in[2]; const float* b_mod = args.in[3];
    const float* g1 = args.in[4]; const float* w1i = args.in[5]; const float* w1o = args.in[6]; const float* gm = args.in[7];
    const float* w_in = args.in[8]; const float* conv_w = args.in[9]; const float* conv_b = args.in[10]; const float* ln_g = args.in[11]; const float* ln_b = args.in[12];
    const float* rw = args.in[13]; const float* rb = args.in[14]; const float* wa = args.in[15]; const float* b_a = args.in[16];
    const float* wi = args.in[17]; const float* b_i = args.in[18]; const float* lam = args.in[19]; const float* w_out = args.in[20];
    const float* g2 = args.in[21]; const float* w2i = args.in[22]; const float* w2o = args.in[23]; const float* w_fmod = args.in[24];
    const float* b_fmod = args.in[25]; const float* gf = args.in[26];
    float* out = args.out;
    float* MOD = (float*)(ws + WS_MOD); float* SHMAX3 = (float*)(ws + WS_BIAS1); float* BIAS2 = (float*)(ws + WS_BIAS2);
    bf16* WGT = (bf16*)(ws + WS_WGT); f32x2* TOT = (f32x2*)(ws + WS_TOT); float* SSP = (float*)(ws + WS_SSP);
    bf16 *W1O = (bf16*)(ws + WS_W1O), *WIN = (bf16*)(ws + WS_WIN), *WOUT = (bf16*)(ws + WS_WOUT), *W2O = (bf16*)(ws + WS_W2O);
    unsigned char *W1O8F = ws + WS_W1O, *W2O8F = ws + WS_W2O, *W1I8 = ws + WS_W1I, *W2I8 = ws + WS_W2I, *WIN8 = ws + WS_WIN, *A8 = ws + WS_Y;
    float *CS1 = (float*)(ws + WS_CS1), *CS3 = (float*)(ws + WS_CS3), *CS2 = (float*)(ws + WS_CS2), *RS1 = (float*)(ws + WS_RS1), *RS3 = (float*)(ws + WS_RS3), *RS2 = (float*)(ws + WS_RS2);
    bf16 *Y = (bf16*)(ws + WS_Y), *ACT = (bf16*)(ws + WS_ACT), *U = (bf16*)(ws + WS_U), *UXB = (bf16*)(ws + WS_UX), *GYB = (bf16*)(ws + WS_GY), *YMIX = (bf16*)(ws + WS_YMIX);
    bf16* X1 = (bf16*)(ws + WS_X1);

    for (int u = tid; u < (LDS_BYTES - LDSCTL_OFF) / 4; u += NWAVES * 64) ((LAS unsigned*)(lds + LDSCTL_OFF))[u] = 0u;
    __syncthreads();
    const int lo = args.ph_lo, hi = args.ph_hi;
    const bool use_bar = (hi - lo) > 1;
    XcdBarrier bar; bar.bar = (unsigned*)(ctl + CW_BAR); bar.x = 0; bar.st = nullptr;
    if (use_bar) bar = xcd_barrier_post((unsigned*)(ctl + CW_BAR), (volatile LAS unsigned*)(lds + LDSCTL_OFF) + 8);
#define IN(k) (lo <= (k) && (k) < hi)
#define REPS(k) ((MK_REP_LO <= (k) && (k) < MK_REP_HI) ? 2 : 1)
#define AGAIN(k, rr) do { if ((rr) + 1 < REPS(k)) xcd_barrier(bar); } while (0)
#define SEAM(k) do { if (IN(k) && IN((k) + 1)) { PROF_BEGIN(8); PROF_BEGIN(9); xcd_barrier(bar); PROF_END(8); if ((k) == MK_PROF_SEAM) { PROF_END(9); } } } while (0)

    if (IN(0))
_Pragma("unroll")
    for (int rr = 0; rr < REPS(0); ++rr) { PROF_SETPH(0); PROF_BEGIN(15); LANE_HERE;
#ifdef MK_PAD
        asm volatile(".rept " MK_STR(MK_PAD) "\n\ts_nop 0\n\t.endr" ::: "memory");
#endif
        constexpr int NGEMV = 88, NQ = 2 * (FF2 / 32);
        constexpr int I_1O = (FF / 64) * (D / 32), I_IN = (D / 64) * (NMIX / 32), I_OUT = (D / 64) * (D / 32);
        constexpr int NITEMS = 2 * I_1O + I_IN + I_OUT, NGRP = NITEMS / NWAVES;
        static_assert(NITEMS % NWAVES == 0, "transpose groups");
        auto quant = [&](int it) { if (it < FF2 / 32) p0_quant_item(lds, w1i, FF2, 1, W1I8, CS1, it, lane, wave); else p0_quant_item(lds, w2i, FF2, 1, W2I8, CS3, it - FF2 / 32, lane, wave); };
        auto group = [&](int gidx) { LAS float* scr = (LAS float*)(lds + wave * 16384); const int r = gidx * NWAVES + wave;
            if (r < I_1O) p0_transpose8_item(w1o, FF, D, W1O8F, scr, r, lane);
            else if (r < 2 * I_1O) p0_transpose8_item(w2o, FF, D, W2O8F, scr, r - I_1O, lane);
            else if (r < 2 * I_1O + I_IN) p0_transpose_item(w_in, D, NMIX, WIN, 2, scr, r - 2 * I_1O, lane);
            else p0_transpose_item(w_out, D, D, WOUT, 0, scr, r - 2 * I_1O - I_IN, lane); };
        if (G == 256) {
            if (bx < NGEMV) {
                if (bx < 72) p0_gemv(lds, cvec, w_mod, 9 * D, b_mod, MOD, 128 * bx, tid); else p0_gemv(lds, cvec, w_fmod, 2 * D, b_fmod, MOD + 9 * D, 128 * (bx - 72), tid);
                quant(bx);
            } else { const int j = bx - NGEMV;
                quant(NGEMV + j);
                if (j < 96) { quant(256 + j); group(2 * j); group(2 * j + 1); }
                else { const int g0 = 192 + 5 * (j - 96);
                    for (int q = 0; q < 5; ++q) if (g0 + q < NGRP) group(g0 + q); }
            }
        } else {
            for (int t = bx; t < NGEMV; t += G) { if (t < 72) p0_gemv(lds, cvec, w_mod, 9 * D, b_mod, MOD, 128 * t, tid); else p0_gemv(lds, cvec, w_fmod, 2 * D, b_fmod, MOD + 9 * D, 128 * (t - 72), tid); }
            for (int t = bx; t < NQ; t += G) quant(t);
            for (int t = bx; t < NGRP; t += G) group(t);
        }
        __syncthreads();
        for (int i = bx * 512 + tid; i < NB * 64 * DR / 2; i += G * 512) ((v4u*)TOT)[i] = (v4u){0u, 0u, 0u, 0u};
        for (int i = bx * 512 + tid; i < NH * 128 * HD; i += G * 512) { const int d = i & 63, e2 = (i >> 6) & 127, hd = i >> 13;
            const float v = e2 < 64 ? wa[(hd * 64 + d) * 64 + e2] : wi[(hd * 64 + d) * 64 + (e2 - 64)]; WGT[i] = (bf16)f2bf(v); }
        PROF_END_PH(15);
        AGAIN(0, rr);
    }
    SEAM(0);
    if (IN(1))
_Pragma("unroll")
    for (int rr = 0; rr < REPS(1); ++rr) { PROF_SETPH(1); PROF_BEGIN(15); LANE_HERE;
        LAS float* shl = (LAS float*)lds;
        for (int i = tid * 4; i < 3 * NB * D; i += 2048) { const int t = i >> 13, r = i & 8191, b = r >> 10, k = r & 1023; *(LAS f32x4*)(shl + i) = *(const f32x4*)(MOD + (size_t)b * LDM + 3 * t * D + k); }
        __syncthreads();
        for (int rp = 0; rp < MK_REP_P1X; ++rp)
        for (int m0 = gw; m0 < M; m0 += 2 * NGW) {
            f32x4 v[2][4];
#pragma unroll
            for (int rr2 = 0; rr2 < 2; ++rr2) { const int m = (m0 + rr2 * NGW < M) ? m0 + rr2 * NGW : m0; const f32x4* xr = (const f32x4*)(x + (size_t)m * D) + lane;
#pragma unroll
                for (int jj = 0; jj < 4; ++jj) v[rr2][jj] = xr[64 * jj]; }
#pragma unroll
            for (int rr2 = 0; rr2 < 2; ++rr2) { const int m = m0 + rr2 * NGW; if (m < M) { const int b = m >> 12;
                float s = 0.f, am = 0.f;
#pragma unroll
                for (int jj = 0; jj < 4; ++jj) s += (v[rr2][jj][0] * v[rr2][jj][0] + v[rr2][jj][1] * v[rr2][jj][1]) + (v[rr2][jj][2] * v[rr2][jj][2] + v[rr2][jj][3] * v[rr2][jj][3]);
                const float rstd = rsqrtf(wave_sum(s) * (1.0f / D) + EPS);
#pragma unroll
                for (int jj = 0; jj < 4; ++jj) { const int k = 4 * lane + 256 * jj;
                    v[rr2][jj] = v[rr2][jj] * (*(const f32x4*)(g1 + k) * (*(const f32x4*)(MOD + (size_t)b * LDM + 1 * D + k) + 1.0f) * rstd) + *(const LAS f32x4*)(shl + (0 * NB + b) * D + k);
                    const f32x4 t = __builtin_elementwise_abs(v[rr2][jj]); am = fmaxf(am, fmaxf(fmaxf(t[0], t[1]), fmaxf(t[2], t[3]))); }
                am = wave_max(am);
                const float q = am > 0.f ? 127.0f / am : 0.f;
#pragma unroll
                for (int jj = 0; jj < 4; ++jj) *(unsigned*)(A8 + (size_t)m * D + 4 * lane + 256 * jj) = q8x4(v[rr2][jj] * q);
                if (lane == 0) RS1[m] = am * (1.0f / 127.0f); } }
        }
        for (int rp = 0; rp < MK_REP_P1B; ++rp)
        if (gw < NB) { float a = 0.f;
            for (int k = lane; k < D; k += 64) a = fmaxf(a, fabsf(shl[(2 * NB + gw) * D + k]));
            a = wave_max(a); if (lane == 0) SHMAX3[gw] = a; }
        for (int it = gw; it < NMIX; it += NGW) {
            {
                const bf16* wrow = WIN + (size_t)it * D; float* op = BIAS2 + it;
                const v4u wA = *(const v4u*)(wrow + 8 * lane), wB = *(const v4u*)(wrow + 512 + 8 * lane);
                f32x4 a0, a1, c0, c1; unpack8(wA, a0, a1); unpack8(wB, c0, c1);
#pragma unroll
                for (int b = 0; b < NB; ++b) { const LAS float* sp = shl + (1 * NB + b) * D + 8 * lane;
                    const f32x4 p = a0 * *(const LAS f32x4*)(sp) + a1 * *(const LAS f32x4*)(sp + 4) + c0 * *(const LAS f32x4*)(sp + 512) + c1 * *(const LAS f32x4*)(sp + 516);
                    const float tot = wave_sum((p[0] + p[1]) + (p[2] + p[3]));
                    if (lane == 0) op[(size_t)b * NMIX] = tot; }
            }
        }
        __syncthreads();
        PROF_END_PH(15);
        AGAIN(1, rr);
    }
    SEAM(1);
    if (IN(2))
_Pragma("unroll")
    for (int rr = 0; rr < REPS(2); ++rr) { PROF_SETPH(2); PROF_BEGIN(15);
        pg8::Gemm g{(const pg8::bf16_t*)A8, (const pg8::bf16_t*)W1I8, M, FF2, D / 2}; pg8::StaticOrder S; S.init(M, FF2, G, bx);
        EpiSwiglu8<true> E{ACT, RS1, CS1};
        pg8::gemm_phase<EpiSwiglu8<true>, pg8::StaticOrder, true, true, 1>(lds, g, S, E);
        PROF_END_PH(15);
        AGAIN(2, rr);
    }
    SEAM(2);
    if (IN(3))
_Pragma("unroll")
    for (int rr = 0; rr < REPS(3); ++rr) { PROF_SETPH(3); PROF_BEGIN(15);
        pg8::Gemm g{ACT, (const pg8::bf16_t*)W1O8F, M, D, FF / 2}; pg8::StaticOrder S; S.init(M, D, G, bx);
        EpiResid<1, true, false, true> E{x, X1, Y, SSP, MOD + 2 * D, gm, MOD + 4 * D};
        pg8::gemm_phase<EpiResid<1, true, false, true>, pg8::StaticOrder, true, true, 2>(lds, g, S, E);
        PROF_END_PH(15);
        AGAIN(3, rr);
    }
    SEAM(3);
    if (IN(4))
_Pragma("unroll")
    for (int rr = 0; rr < REPS(4); ++rr) { PROF_SETPH(4); PROF_BEGIN(15);
        pg8::Gemm g{Y, WIN, M, NMIX, D}; pg8::StaticOrder S; S.init(M, NMIX, G, bx);
        EpiMixIn E{U, UXB, GYB, SSP, BIAS2};
        pg8::gemm_phase<EpiMixIn, pg8::StaticOrder, true, true>(lds, g, S, E);
        PROF_END_PH(15);
        AGAIN(4, rr);
    }
    SEAM(4);
    if (IN(5))
_Pragma("unroll")
    for (int rr = 0; rr < REPS(5); ++rr) { PROF_SETPH(5); PROF_BEGIN(15); LANE_HERE;
        { PROF_BEGIN(0); mix_conv2(lds, U, conv_w, conv_b, ln_g, ln_b, YMIX, G, bx, tid, lane, wave); PROF_END(0); }
#ifdef MK_REP_CONV
        mix_conv2(lds, U, conv_w, conv_b, ln_g, ln_b, YMIX, G, bx, tid, lane, wave);
#endif
        { PROF_BEGIN(1); mix_scan1(lds, UXB, GYB, WGT, rw, rb, b_a, b_i, lam, TOT, (unsigned*)(ctl + CW_SCAN), YMIX, G, bx, lane, wave); PROF_END(1); }
        PROF_END_PH(15);
        AGAIN(5, rr);
    }
    SEAM(5);
    if (IN(7))
_Pragma("unroll")
    for (int rr = 0; rr < REPS(7); ++rr) { PROF_SETPH(7); PROF_BEGIN(15);
        pg8::Gemm g{YMIX, WOUT, M, D, D}; pg8::StaticOrder S; S.init(M, D, G, bx);
        EpiResidQ<0, true> E{X1, X1, A8, RS3, (f32x2*)(ws + WS_SSPX), MOD + 5 * D, g2, MOD + 7 * D, MOD + 6 * D, SHMAX3, (unsigned*)(ctl + CW_SEAM7)};
        pg8::gemm_phase<EpiResidQ<0, true>, pg8::StaticOrder, true, true>(lds, g, S, E);
        PROF_END_PH(15);
        AGAIN(7, rr);
    }
    SEAM(7);
    if (IN(8))
_Pragma("unroll")
    for (int rr = 0; rr < REPS(8); ++rr) { PROF_SETPH(8); PROF_BEGIN(15);
        pg8::Gemm g{(const pg8::bf16_t*)A8, (const pg8::bf16_t*)W2I8, M, FF2, D / 2}; pg8::StaticOrder S; S.init(M, FF2, G, bx);
        EpiSwiglu8<true> E{ACT, RS3, CS3};
        pg8::gemm_phase<EpiSwiglu8<true>, pg8::StaticOrder, true, true, 1>(lds, g, S, E);
        PROF_END_PH(15);
        AGAIN(8, rr);
    }
    SEAM(8);
    if (IN(9))
_Pragma("unroll")
    for (int rr = 0; rr < REPS(9); ++rr) { PROF_SETPH(9); PROF_BEGIN(15);
        pg8::Gemm g{ACT, (const pg8::bf16_t*)W2O8F, M, D, FF / 2}; pg8::StaticOrder S; S.init(M, D, G, bx);
        EpiResidFinal<true> E{X1, out, (float*)(ws + WS_SSPF), MOD + 8 * D, gf, MOD + 10 * D, MOD + 9 * D, (unsigned*)(ctl + CW_SEAM)};
        pg8::gemm_phase<EpiResidFinal<true>, pg8::StaticOrder, true, true, 2>(lds, g, S, E);
        PROF_END_PH(15);
    }
#ifdef MK_PROF_ID
    __syncthreads();
    if (bx == MK_PROF_WG && tid == 0) { const unsigned d = ((LAS unsigned*)(lds + LDSCTL_OFF))[40 + MK_PROF_ID]; const unsigned long long t0 = PROF_T(); while (PROF_T() - t0 < (unsigned long long)d * MK_PROF_K) __builtin_amdgcn_s_sleep(8); }
#endif
#undef IN
#undef SEAM
#undef REPS
#undef AGAIN
}

extern "C" void kernel_launch(void* const* d_in, const int* in_sizes, int n_in, void* d_out, int out_size, void* d_ws, size_t ws_size, hipStream_t stream) {
    static int grid = 0;
    if (grid == 0) {
        if (n_in != 27 || in_sizes[0] != M * D || out_size != M * D || ws_size < WS_END) { fprintf(stderr, "kernel_launch: unexpected shapes (n_in %d, in0 %d, out %d, ws %zu)\n", n_in, n_in > 0 ? in_sizes[0] : -1, out_size, ws_size); grid = -1; return; }
        int dev = 0, cus = 0, per_cu = 0;
        if (hipGetDevice(&dev) != hipSuccess || hipDeviceGetAttribute(&cus, hipDeviceAttributeMultiprocessorCount, dev) != hipSuccess) { grid = -1; return; }
        if (hipFuncSetAttribute((const void*)mk_fwd, hipFuncAttributeMaxDynamicSharedMemorySize, LDS_BYTES) != hipSuccess) { fprintf(stderr, "kernel_launch: hipFuncSetAttribute failed\n"); grid = -1; return; }
        if (hipOccupancyMaxActiveBlocksPerMultiprocessor(&per_cu, (const void*)mk_fwd, NWAVES * 64, LDS_BYTES) != hipSuccess || per_cu < 1) fprintf(stderr, "kernel_launch: occupancy query reports %d blocks per CU\n", per_cu);
        (void)hipGetLastError();
        grid = cus;
        if (grid % 8 != 0 || grid < 8) { fprintf(stderr, "kernel_launch: %d CUs: the scan's chunk rounds need a multiple of 8 workgroups\n", grid); grid = -1; return; }
    }
    if (grid < 0) return;
    if (hipMemsetAsync((char*)d_ws + WS_CTL, 0, CTL_ZERO_BYTES, stream) != hipSuccess) return;
    Args a{};
    for (int i = 0; i < 27; ++i) a.in[i] = (const float*)d_in[i];
    a.out = (float*)d_out; a.ws = (unsigned char*)d_ws;
#if MK_PER_PHASE
    for (int p = 0; p < NPH; ++p) { a.ph_lo = p; a.ph_hi = p + 1; hipLaunchKernelGGL(mk_fwd, dim3(grid), dim3(NWAVES * 64), LDS_BYTES, stream, a); }
#else
    a.ph_lo = 0; a.ph_hi = NPH; hipLaunchKernelGGL(mk_fwd, dim3(grid), dim3(NWAVES * 64), LDS_BYTES, stream, a);
#endif
}
```

```cpp
#include <hip/hip_runtime.h>
#include <cstdio>
#include <cstdint>
#ifndef MK_PROF_SEAM
#define MK_PROF_SEAM 99
#endif
#ifndef MK_PROF_PH
#define MK_PROF_PH 99
#endif
#ifdef MK_PROF_ID
#define PROF_W(i) ((__attribute__((address_space(3))) unsigned*)(unsigned)(147200) + (i))
#define PROF_T() __builtin_amdgcn_s_memrealtime()
#define PROF_BEGIN(id) do { if ((id) == MK_PROF_ID && threadIdx.x == 0) *PROF_W(10 + (id)) = (unsigned)PROF_T(); } while (0)
#define PROF_END(id) do { if ((id) == MK_PROF_ID && threadIdx.x == 0) *PROF_W(40 + (id)) += (unsigned)PROF_T() - *PROF_W(10 + (id)); } while (0)
#define PROF_SETPH(k) do { if ((MK_PROF_ID == 15 || MK_PROF_ID == 16) && threadIdx.x == 0) *PROF_W(39) = (k); } while (0)
#define PROF_END_PH(id) do { if ((id) == MK_PROF_ID && threadIdx.x == 0 && *PROF_W(39) == MK_PROF_PH) *PROF_W(40 + (id)) += (unsigned)PROF_T() - *PROF_W(10 + (id)); } while (0)
#else
#define PROF_BEGIN(id)
#define PROF_END(id)
#define PROF_SETPH(k)
#define PROF_END_PH(id)
#endif
#if defined(MK_PROF_ID) && MK_PROF_ID == 16
#define PROF16_DECL unsigned long long _p16t = 0; unsigned _p16a = 0
#define PROF16_BEGIN _p16t = PROF_T()
#define PROF16_END _p16a += (unsigned)(PROF_T() - _p16t)
#define PROF16_FLUSH do { if (threadIdx.x == 0 && *PROF_W(39) == MK_PROF_PH) *PROF_W(40 + 16) += _p16a; } while (0)
#else
#define PROF16_DECL
#define PROF16_BEGIN
#define PROF16_END
#define PROF16_FLUSH
#endif
namespace pg8 {
#define PG8_LAS __attribute__((address_space(3)))
typedef unsigned short bf16_t;
typedef short bf16x8 __attribute__((ext_vector_type(8)));
typedef float f32x4 __attribute__((ext_vector_type(4)));
typedef unsigned u32x4 __attribute__((ext_vector_type(4)));
constexpr int BM = 256, BK = 64, HALF = 128, HTB = HALF * BK * 2  , STAGE_BYTES = 8 * HTB, NXCD = 8, WGM = 8;

__host__ __device__ __forceinline__ int lds_byte(int r, int c) { const int st = (r >> 4) * 2 + (c >> 5), rr = r & 15, cc = c & 31, ob = rr * 64 + cc * 2; return st * 1024 + (ob ^ (((ob >> 9) & 1) << 5)); }
__host__ __device__ __forceinline__ void stage_rc(int b, int& R, int& C) { const int st = b / 1024, sb = b % 1024, swz = sb ^ (((sb >> 9) & 1) << 5); R = (st >> 1) * 16 + swz / 64; C = (st & 1) * 32 + (swz % 64) / 2; }
__host__ __device__ __forceinline__ int perm32(int rho) { const int n = rho >> 4, i = rho & 15; return 8 * (i >> 2) + 4 * n + (i & 3); }

struct Unit { int pm, pn; };
struct Gemm { const bf16_t* A; const bf16_t* Bt; int M, N, K; };

struct StaticOrder {
    int nM, nN, nwg, G, c;
    __host__ __device__ void init(int M, int N, int G_, int c_) { nM = M / BM; nN = N / BM; nwg = nM * nN; G = G_; c = c_; }
    __host__ __device__ bool next(int i, Unit& u) const {
        const long L = (long)i * G + c; if (L >= nwg) return false;
        int wgid = (int)L; { const int q = nwg / NXCD, r = nwg % NXCD, xcd = wgid % NXCD, off = wgid / NXCD; wgid = (xcd < r ? xcd * (q + 1) : r * (q + 1) + (xcd - r) * q) + off; }
        const int nig = WGM * nN, gid = wgid / nig, fm = gid * WGM, gsz = (nM - fm) < WGM ? (nM - fm) : WGM;
        u.pm = fm + ((wgid % nig) % gsz); u.pn = (wgid % nig) / gsz; return true;
    }
    __device__ __forceinline__ void a_ready(const Unit&) const {}
    __device__ __forceinline__ void done(const Unit&) const {}
};

__device__ __forceinline__ unsigned cvt_pk_bf16(float lo, float hi) { unsigned r; asm volatile("v_cvt_pk_bf16_f32 %0, %1, %2" : "=v"(r) : "v"(lo), "v"(hi)); return r; }
#ifndef PG8_STAGE_IN_MMA
#define PG8_STAGE_IN_MMA 0
#endif
typedef int i32x4 __attribute__((ext_vector_type(4)));
typedef int i32x8 __attribute__((ext_vector_type(8)));
__device__ __forceinline__ i32x8 cat32(const bf16x8 lo, const bf16x8 hi) { const i32x4 p = __builtin_bit_cast(i32x4, lo), q = __builtin_bit_cast(i32x4, hi); return (i32x8){p.x, p.y, p.z, p.w, q.x, q.y, q.z, q.w}; }
__device__ __forceinline__ f32x4 mma_mx8(const i32x8 B, const i32x8 A, const f32x4 c) { return __builtin_amdgcn_mfma_scale_f32_16x16x128_f8f6f4(B, A, c, 0, 0, 0, 0x7F7F7F7F, 0, 0x7F7F7F7F); }
template <int I8> __device__ __forceinline__ f32x4 mma16(const bf16x8 b, const bf16x8 a, const f32x4 c) {
    if constexpr (I8 == 1) return __builtin_bit_cast(f32x4, __builtin_amdgcn_mfma_i32_16x16x64_i8(__builtin_bit_cast(i32x4, b), __builtin_bit_cast(i32x4, a), __builtin_bit_cast(i32x4, c), 0, 0, 0));
    else return __builtin_amdgcn_mfma_f32_16x16x32_bf16(b, a, c, 0, 0, 0);
}
template <class Epi, class Sched, bool ALIGN_EPI = false, bool SP2 = false, int I8 = 0>
__device__ __forceinline__ void gemm_phase(PG8_LAS unsigned char* lds, const Gemm g, const Sched& S, const Epi& E) {
    const int tid = threadIdx.x, wid = __builtin_amdgcn_readfirstlane(tid >> 6), lane = tid & 63, wr = wid >> 2, wc = wid & 3, fr = lane & 15, fq = lane >> 4;
    const int K = g.K, nt = K / BK;
    unsigned voffA[1], voffB[1];
    { int R, C; stage_rc(tid * 16, R, C); const int Rb = Epi::PERM ? ((R & ~31) + perm32(R & 31)) : R;
        voffA[0] = (unsigned)(R * K + C) * 2u; voffB[0] = (unsigned)(Rb * K + C) * 2u; }
    const size_t r64 = (size_t)64 * K * 2;
    const size_t kstep = (size_t)(BK * 2);
    const size_t hstep = (size_t)HALF * K * 2;
    const size_t tstep = 2 * hstep;
    const unsigned ldsw = (unsigned)wid * 1024u;
    const int aoff = lds_byte(wr * 64 + fr, fq * 8), boff = lds_byte(wc * 32 + fr, fq * 8);
#define PG8_SA(b, h) (((b) * 2 + (h)) * HTB)
#define PG8_SB(b, h) ((4 + (b) * 2 + (h)) * HTB)
#define PG8_STAGE(bufoff, gbase, voff) do { _Pragma("unroll") for (int _i = 0; _i < 2; ++_i) \
        __builtin_amdgcn_global_load_lds((const unsigned*)((const char*)(gbase) + _i * r64 + (voff)[0]), (PG8_LAS unsigned*)(lds + (bufoff) + ldsw + _i * 8192), 16, 0, 0); } while (0)
#define PG8_LDA(dst, b, h) do { _Pragma("unroll") for (int m = 0; m < 4; ++m) { if constexpr (I8 == 2) dst##8[m] = cat32(*(const PG8_LAS bf16x8*)(lds + PG8_SA(b, h) + aoff + m * 2048), *(const PG8_LAS bf16x8*)(lds + PG8_SA(b, h) + aoff + m * 2048 + 1024)); \
        else { _Pragma("unroll") for (int k = 0; k < 2; ++k) dst[m][k] = *(const PG8_LAS bf16x8*)(lds + PG8_SA(b, h) + aoff + m * 2048 + k * 1024); } } } while (0)
#define PG8_LDB(dst, b, h) do { _Pragma("unroll") for (int n = 0; n < 2; ++n) { if constexpr (I8 == 2) dst##8[n] = cat32(*(const PG8_LAS bf16x8*)(lds + PG8_SB(b, h) + boff + n * 2048), *(const PG8_LAS bf16x8*)(lds + PG8_SB(b, h) + boff + n * 2048 + 1024)); \
        else { _Pragma("unroll") for (int k = 0; k < 2; ++k) dst[n][k] = *(const PG8_LAS bf16x8*)(lds + PG8_SB(b, h) + boff + n * 2048 + k * 1024); } } } while (0)
#define PG8_MMA(ai, bj, At, Bt) do { __builtin_amdgcn_s_setprio(1); _Pragma("unroll") for (int m = 0; m < 4; ++m) _Pragma("unroll") for (int n = 0; n < 2; ++n) { \
        if constexpr (I8 == 2) acc[ai][bj][m][n] = mma_mx8(Bt##8[n], At##8[m], acc[ai][bj][m][n]); \
        else { _Pragma("unroll") for (int k = 0; k < 2; ++k) acc[ai][bj][m][n] = mma16<I8>(Bt[n][k], At[m][k], acc[ai][bj][m][n]); } } __builtin_amdgcn_s_setprio(0); } while (0)
#define PG8_WAIT_V(n) asm volatile("s_waitcnt vmcnt(" #n ")" ::: "memory")
#define PG8_WAIT_L(n) asm volatile("s_waitcnt lgkmcnt(" #n ")" ::: "memory")
#define PG8_BAR __builtin_amdgcn_s_barrier()
#define PG8_SCHED __builtin_amdgcn_sched_barrier(0)
    Unit cur, nxt; int ui = 0;
    if (!S.next(0, cur)) return;
    f32x4 acc[2][2][4][2];
#pragma unroll
    for (int a = 0; a < 2; ++a)
#pragma unroll
        for (int b = 0; b < 2; ++b)
#pragma unroll
            for (int m = 0; m < 4; ++m)
#pragma unroll
                for (int n = 0; n < 2; ++n) acc[a][b][m][n] = (f32x4){0.f, 0.f, 0.f, 0.f};
    bf16x8 At[4][2], B0[2][2], B1[2][2]; i32x8 At8[4], B08[2], B18[2];
    const char* cA = (const char*)g.A + (size_t)cur.pm * tstep; const char* cB = (const char*)g.Bt + (size_t)cur.pn * tstep;
    S.a_ready(cur);
    if constexpr (SP2) {
        PG8_STAGE(PG8_SB(0, 0), cB, voffB); PG8_STAGE(PG8_SB(0, 1), cB + hstep, voffB); PG8_STAGE(PG8_SA(0, 0), cA, voffA); PG8_STAGE(PG8_SA(0, 1), cA + hstep, voffA);
        if (wr == 1) PG8_BAR;
        PG8_WAIT_V(2); PG8_BAR;
        PG8_STAGE(PG8_SB(1, 0), cB + kstep, voffB); PG8_STAGE(PG8_SA(1, 0), cA + kstep, voffA); PG8_STAGE(PG8_SB(1, 1), cB + hstep + kstep, voffB);
        PG8_WAIT_V(6); PG8_BAR;
    } else {
        PG8_STAGE(PG8_SB(0, 0), cB, voffB); PG8_STAGE(PG8_SA(0, 0), cA, voffA); PG8_STAGE(PG8_SB(0, 1), cB + hstep, voffB); PG8_STAGE(PG8_SA(0, 1), cA + hstep, voffA);
        if (wr == 1) PG8_BAR;
        PG8_WAIT_V(4); PG8_BAR;
        PG8_STAGE(PG8_SB(1, 0), cB + kstep, voffB); PG8_STAGE(PG8_SA(1, 0), cA + kstep, voffA); PG8_STAGE(PG8_SB(1, 1), cB + hstep + kstep, voffB);
        PG8_WAIT_V(6); PG8_BAR;
    }
    PROF16_DECL;
    for (;;) {
        const bool has_next = S.next(ui + 1, nxt);
        const char* nA = has_next ? (const char*)g.A + (size_t)nxt.pm * tstep : cA; const char* nB = has_next ? (const char*)g.Bt + (size_t)nxt.pn * tstep : cB;
        asm volatile(".p2align 8" ::: "memory");
        for (int t = 0; t < nt; t += 2) {
            const bool last = (t == nt - 2);
            const char* a1 = cA + (size_t)(t + 1) * kstep;
            const char* a2 = last ? nA : cA + (size_t)(t + 2) * kstep; const char* b2 = last ? nB : cB + (size_t)(t + 2) * kstep;
            const char* a3 = a2 + kstep; const char* b3 = b2 + kstep;
            if (last && has_next) S.a_ready(nxt);
            if constexpr (SP2) {
#if PG8_STAGE_IN_MMA
            PG8_LDB(B0, 0, 0); PG8_LDB(B1, 0, 1); PG8_SCHED; PG8_LDA(At, 0, 0);
            PG8_WAIT_V(6); PG8_WAIT_L(0); PG8_BAR; PG8_MMA(0, 0, At, B0); PG8_SCHED; PG8_STAGE(PG8_SA(1, 1), a1 + hstep, voffA); PG8_SCHED; PG8_MMA(0, 1, At, B1); PG8_BAR; PG8_SCHED;
            PG8_LDA(At, 0, 1);
            PG8_WAIT_V(2); PG8_WAIT_L(0); PG8_BAR; PG8_STAGE(PG8_SB(0, 0), b2, voffB); PG8_SCHED; PG8_MMA(1, 0, At, B0); PG8_SCHED; PG8_STAGE(PG8_SB(0, 1), b2 + hstep, voffB); PG8_SCHED; PG8_MMA(1, 1, At, B1); PG8_SCHED; PG8_STAGE(PG8_SA(0, 0), a2, voffA); PG8_BAR; PG8_SCHED;
            PG8_LDB(B0, 1, 0); PG8_LDB(B1, 1, 1); PG8_SCHED; PG8_LDA(At, 1, 0);
            PG8_WAIT_V(6); PG8_WAIT_L(0); PG8_BAR; PG8_MMA(0, 0, At, B0); PG8_SCHED; PG8_STAGE(PG8_SA(0, 1), a2 + hstep, voffA); PG8_SCHED; PG8_MMA(0, 1, At, B1); PG8_BAR; PG8_SCHED;
            PG8_LDA(At, 1, 1);
            PG8_WAIT_V(2); PG8_WAIT_L(0); PG8_BAR; PG8_STAGE(PG8_SB(1, 0), b3, voffB); PG8_SCHED; PG8_MMA(1, 0, At, B0); PG8_SCHED; PG8_STAGE(PG8_SB(1, 1), b3 + hstep, voffB); PG8_SCHED; PG8_MMA(1, 1, At, B1); PG8_SCHED; PG8_STAGE(PG8_SA(1, 0), a3, voffA); PG8_BAR; PG8_SCHED;
#else
            PG8_LDB(B0, 0, 0); PG8_LDB(B1, 0, 1); PG8_SCHED; PG8_LDA(At, 0, 0); PG8_STAGE(PG8_SA(1, 1), a1 + hstep, voffA);
            PG8_WAIT_V(8); PG8_WAIT_L(0); PG8_BAR; PG8_MMA(0, 0, At, B0); PG8_MMA(0, 1, At, B1); PG8_BAR; PG8_SCHED;
            PG8_LDA(At, 0, 1); PG8_STAGE(PG8_SB(0, 0), b2, voffB); PG8_STAGE(PG8_SB(0, 1), b2 + hstep, voffB); PG8_STAGE(PG8_SA(0, 0), a2, voffA);
            PG8_WAIT_V(8); PG8_WAIT_L(0); PG8_BAR; PG8_MMA(1, 0, At, B0); PG8_MMA(1, 1, At, B1); PG8_BAR; PG8_SCHED;
            PG8_LDB(B0, 1, 0); PG8_LDB(B1, 1, 1); PG8_SCHED; PG8_LDA(At, 1, 0); PG8_STAGE(PG8_SA(0, 1), a2 + hstep, voffA);
            PG8_WAIT_V(8); PG8_WAIT_L(0); PG8_BAR; PG8_MMA(0, 0, At, B0); PG8_MMA(0, 1, At, B1); PG8_BAR; PG8_SCHED;
            PG8_LDA(At, 1, 1); PG8_STAGE(PG8_SB(1, 0), b3, voffB); PG8_STAGE(PG8_SB(1, 1), b3 + hstep, voffB); PG8_STAGE(PG8_SA(1, 0), a3, voffA);
            PG8_WAIT_V(8); PG8_WAIT_L(0); PG8_BAR; PG8_MMA(1, 0, At, B0); PG8_MMA(1, 1, At, B1); PG8_BAR; PG8_SCHED;
#endif
            } else {
            PG8_LDB(B0, 0, 0); PG8_SCHED; PG8_LDA(At, 0, 0); PG8_STAGE(PG8_SA(1, 1), a1 + hstep, voffA);
            PG8_WAIT_L(8); PG8_BAR; PG8_WAIT_L(0); PG8_MMA(0, 0, At, B0); PG8_BAR; PG8_SCHED;
            PG8_LDB(B1, 0, 1); PG8_STAGE(PG8_SB(0, 0), b2, voffB);
            PG8_BAR; PG8_WAIT_L(0); PG8_MMA(0, 1, At, B1); PG8_BAR;
            PG8_LDA(At, 0, 1); PG8_STAGE(PG8_SA(0, 0), a2, voffA);
            PG8_BAR; PG8_WAIT_L(0); PG8_MMA(1, 0, At, B0); PG8_BAR; PG8_SCHED;
            PG8_STAGE(PG8_SB(0, 1), b2 + hstep, voffB);
            PG8_WAIT_V(6); PG8_BAR; PG8_MMA(1, 1, At, B1); PG8_BAR;
            PG8_LDB(B0, 1, 0); PG8_SCHED; PG8_LDA(At, 1, 0); PG8_STAGE(PG8_SA(0, 1), a2 + hstep, voffA);
            PG8_WAIT_L(8); PG8_BAR; PG8_WAIT_L(0); PG8_MMA(0, 0, At, B0); PG8_BAR; PG8_SCHED;
            PG8_LDB(B1, 1, 1); PG8_STAGE(PG8_SB(1, 0), b3, voffB);
            PG8_BAR; PG8_WAIT_L(0); PG8_MMA(0, 1, At, B1); PG8_BAR;
            PG8_LDA(At, 1, 1); PG8_STAGE(PG8_SA(1, 0), a3, voffA);
            PG8_BAR; PG8_WAIT_L(0); PG8_MMA(1, 0, At, B0); PG8_BAR; PG8_SCHED;
            PG8_STAGE(PG8_SB(1, 1), b3 + hstep, voffB);
            PG8_WAIT_V(6); PG8_BAR; PG8_MMA(1, 1, At, B1); PG8_BAR;
            }
        }
        if constexpr (ALIGN_EPI) { if (wr == 0) PG8_BAR; }
        if constexpr (!Epi::AFTER_DRAIN) { int ln; asm volatile("v_mbcnt_lo_u32_b32 %0, -1, 0\n\tv_mbcnt_hi_u32_b32 %0, -1, %0" : "=v"(ln));     const int fr2 = ln & 15, fq2 = ln >> 4; _Pragma("unroll") for (int er = 0; er < Epi::REPS; ++er) { PROF16_BEGIN; E(acc, cur, wr, wc, fr2, fq2); PROF16_END; if (er + 1 < Epi::REPS) asm volatile("" ::: "memory"); } S.done(cur); }
        if (!has_next) break;
#pragma unroll
        for (int a = 0; a < 2; ++a)
#pragma unroll
            for (int b = 0; b < 2; ++b)
#pragma unroll
                for (int m = 0; m < 4; ++m)
#pragma unroll
                    for (int n = 0; n < 2; ++n) acc[a][b][m][n] = (f32x4){0.f, 0.f, 0.f, 0.f};
        cur = nxt; cA = nA; cB = nB; ++ui;
        if constexpr (ALIGN_EPI) { if (wr == 1) PG8_BAR; }
    }
    PG8_WAIT_V(0);
    if constexpr (!ALIGN_EPI) { if (wr == 0) PG8_BAR; }
    PG8_BAR;
    if constexpr (Epi::AFTER_DRAIN) { E.fused(acc, cur, wr, wc, fr, fq, lds, wid, lane); S.done(cur); }
    PROF16_FLUSH;
#undef PG8_SA
#undef PG8_SB
#undef PG8_STAGE
#undef PG8_LDA
#undef PG8_LDB
#undef PG8_MMA
#undef PG8_WAIT_V
#undef PG8_WAIT_L
#undef PG8_BAR
#undef PG8_SCHED
}
}
#define GAS __attribute__((address_space(1)))
#define LAS __attribute__((address_space(3)))
typedef unsigned short bf16;
typedef unsigned v4u __attribute__((ext_vector_type(4)));
typedef float f32x4 __attribute__((ext_vector_type(4)));
typedef short bf16x8 __attribute__((ext_vector_type(8)));
typedef GAS unsigned gu32;
typedef GAS unsigned long long gu64;
#define RLX_AGENT __ATOMIC_RELAXED, __HIP_MEMORY_SCOPE_AGENT
#define LDS_WAIT() asm volatile("s_waitcnt lgkmcnt(0)" ::: "memory")
#define VM_WAIT() asm volatile("s_waitcnt vmcnt(0)" ::: "memory")
__device__ __forceinline__ unsigned long long rt() { return __builtin_amdgcn_s_memrealtime(); }
__device__ __forceinline__ unsigned f2bf(float f) { unsigned u = __builtin_bit_cast(unsigned, f); return (u + 0x7fffu + ((u >> 16) & 1u)) >> 16; }
__device__ __forceinline__ unsigned pk2(float lo, float hi) { return f2bf(lo) | (f2bf(hi) << 16); }

#define XB_TMO      128
#define XB_XCNT(j)  (256  + 64 * (j))
#define XB_XSUB(j)  (1280 + 64 * (j))
#define XB_XGEN(j)  (2304 + 64 * (j))
#define XB_TOP      3328
#define XB_TOPGEN   3392
#define XCD_BAR_WORDS 3456
#define XB_SPIN_CAP (1u << 18)

__device__ __forceinline__ unsigned xb_ld(unsigned* p)              { return __hip_atomic_load(p, __ATOMIC_RELAXED, __HIP_MEMORY_SCOPE_AGENT); }
__device__ __forceinline__ unsigned xb_add(unsigned* p, unsigned v) { return __hip_atomic_fetch_add(p, v, __ATOMIC_RELAXED, __HIP_MEMORY_SCOPE_AGENT); }
__device__ __forceinline__ unsigned xb_xcc_id() { return (unsigned)__builtin_amdgcn_s_getreg((3 << 11) | 20) & 0xFu; }
#define XB_SPIN(cond, bar) do { unsigned _sp = 0; while (cond) { __builtin_amdgcn_s_sleep(1); \
    if ((++_sp & 255u) == 0u) { if (xb_ld(&(bar)[XB_TMO])) break; if (_sp > XB_SPIN_CAP) { atomicAdd(&(bar)[XB_TMO], 1u); break; } } } } while (0)

struct XcdBarrier {
    unsigned* bar; unsigned x;
    volatile LAS unsigned* st;
};

__device__ __forceinline__ XcdBarrier xcd_barrier_post(unsigned* bar, volatile LAS unsigned* st) {
    XcdBarrier b; b.bar = bar; b.x = xb_xcc_id(); b.st = st;
    if (threadIdx.x == 0) (void)xb_add(&bar[XB_XCNT(b.x)], 1u);
    return b;
}
__device__ __forceinline__ void xcd_barrier_complete(unsigned* bar, unsigned x, unsigned& nloc, unsigned& nx) {
    const unsigned G = gridDim.x * gridDim.y * gridDim.z;
    unsigned sum, cnt, mine, sp = 0u;
    for (;;) {
        sum = 0u; cnt = 0u; mine = 0u;
#pragma unroll
        for (unsigned j = 0; j < 16; ++j) { const unsigned c = xb_ld(&bar[XB_XCNT(j)]); sum += c; cnt += (c > 0u) ? 1u : 0u; mine = (j == x) ? c : mine; }
        if (sum == G) break;
        __builtin_amdgcn_s_sleep(1);
        if ((++sp & 255u) == 0u) { if (xb_ld(&bar[XB_TMO])) break; if (sp > XB_SPIN_CAP) { atomicAdd(&bar[XB_TMO], 1u); break; } }
    }
    nloc = mine > 0u ? mine : 1u; nx = cnt > 0u ? cnt : 1u;
}

__device__ __forceinline__ void xcd_barrier(const XcdBarrier& b) {
    asm volatile("s_waitcnt vmcnt(0)" ::: "memory");
    __syncthreads();
    if (threadIdx.x == 0) {
        unsigned* bar = b.bar;
        __builtin_amdgcn_s_waitcnt(0);
        unsigned nloc = b.st[0], nx = b.st[1];
        if (nloc == 0u) { xcd_barrier_complete(bar, b.x, nloc, nx); b.st[0] = nloc; b.st[1] = nx; }
        const unsigned old = xb_add(&bar[XB_XSUB(b.x)], 1u);
        const unsigned gen = old / nloc;
        if (old + 1u == (gen + 1u) * nloc) {
            __builtin_amdgcn_fence(__ATOMIC_RELEASE, "agent");
            asm volatile("s_waitcnt vmcnt(0)" ::: "memory");
            (void)xb_add(&bar[XB_TOP], 1u);
        }
        XB_SPIN(xb_ld(&bar[XB_TOP]) < (gen + 1u) * nx, bar);
        __builtin_amdgcn_fence(__ATOMIC_ACQUIRE, "agent");
        asm volatile("s_waitcnt vmcnt(0)" ::: "memory");
    }
    __syncthreads();
}

constexpr int NWAVES = 8;
constexpr int NB = 8, SEQ = 4096, D = 1024, M = NB * SEQ, FF = 2816, FF2 = 2 * FF, DC = 512, DR = 512, NH = 8, HD = 64, CW = 31, RW = 4, NMIX = 2048;
constexpr float EPS = 1e-6f;
constexpr int LDM = 11 * D;
constexpr size_t MiB = 1u << 20;
constexpr size_t WS_CTL = 0, CTL_ZERO_BYTES = 1 * MiB;
constexpr size_t WS_MOD = 1 * MiB;
constexpr size_t WS_BIAS1 = 1 * MiB + 512 * 1024;
constexpr size_t WS_BIAS2 = 2 * MiB;
constexpr size_t WS_WGT = 2 * MiB + 128 * 1024;
constexpr size_t WS_CS1 = 2 * MiB + 384 * 1024, WS_CS3 = 2 * MiB + 448 * 1024;
constexpr size_t WS_RS1 = 2 * MiB + 512 * 1024, WS_RS3 = 2 * MiB + 640 * 1024;
constexpr size_t WS_CS2 = 2 * MiB + 480 * 1024, WS_RS2 = 2 * MiB + 768 * 1024;
constexpr size_t WS_TOT = 3 * MiB;
constexpr size_t WS_TOTH = 7 * MiB;
constexpr size_t WS_SSP = 5 * MiB;
constexpr size_t WS_W1I = 8 * MiB, WS_W1O = 19 * MiB, WS_WIN = 25 * MiB, WS_WOUT = 29 * MiB, WS_W2I = 31 * MiB, WS_W2O = 42 * MiB;
constexpr size_t WS_Y = 48 * MiB;
constexpr size_t WS_X1 = 112 * MiB;
constexpr size_t WS_ACT = 240 * MiB;
constexpr size_t WS_U = WS_ACT, WS_UX = WS_ACT + 32 * MiB, WS_GY = WS_ACT + 64 * MiB, WS_YMIX = WS_ACT + 96 * MiB;
constexpr size_t WS_SSPF = 416 * MiB;
constexpr size_t WS_SSPX = 418 * MiB;
constexpr size_t WS_SSPX3 = 422 * MiB;
constexpr size_t WS_END = 426 * MiB;
constexpr int CW_BAR = 4096, CW_SEAM = 16384, CW_SCAN = 32768, CW_SEAM7 = 49152, CW_SEAM3 = 65536, CW_TICKET = 98304;
constexpr int LDS_BYTES = 147456;
constexpr int LDSCTL_OFF = LDS_BYTES - 256;

typedef unsigned short u16;
typedef float f32x16 __attribute__((ext_vector_type(16)));
typedef float f32x2 __attribute__((ext_vector_type(2)));

template <int OFF> __device__ __forceinline__ float sx(float v) {
    const int i = (int)__float_as_uint(v); int r;
    if constexpr (OFF == 1) r = __builtin_amdgcn_update_dpp(0, i, 0xB1, 0xf, 0xf, true);
    else if constexpr (OFF == 2) r = __builtin_amdgcn_update_dpp(0, i, 0x4E, 0xf, 0xf, true);
    else if constexpr (OFF == 4) r = __builtin_amdgcn_ds_swizzle(i, 0x101F);
    else if constexpr (OFF == 8) r = __builtin_amdgcn_update_dpp(0, i, 0x128, 0xf, 0xf, true);
    else if constexpr (OFF == 16) r = __builtin_amdgcn_ds_swizzle(i, 0x401F);
    else { const auto p = __builtin_amdgcn_permlane32_swap(i, i, false, false); r = (threadIdx.x & 32) ? p[0] : p[1]; }
    return __uint_as_float((unsigned)r);
}
__device__ __forceinline__ float wave_sum(float v) { v += sx<1>(v); v += sx<2>(v); v += sx<4>(v); v += sx<8>(v); v += sx<16>(v); v += sx<32>(v); return v; }
__device__ __forceinline__ float sigmoid_fast(float x) { return __builtin_amdgcn_rcpf(1.f + __builtin_amdgcn_exp2f(-1.4426950408889634f * x)); }
__device__ __forceinline__ float silu_fast(float x) { return x * sigmoid_fast(x); }
__device__ __forceinline__ float gelu_tanh_fast(float x) { const float z = 0.7978845608028654f * (x + 0.044715f * x * x * x); return x * sigmoid_fast(2.f * z); }
__device__ __forceinline__ f32x4 sigmoid4(const f32x4 x) { const f32x4 t = x * -1.4426950408889634f; f32x4 e = {__builtin_amdgcn_exp2f(t[0]), __builtin_amdgcn_exp2f(t[1]), __builtin_amdgcn_exp2f(t[2]), __builtin_amdgcn_exp2f(t[3])};
    e = e + 1.0f; return (f32x4){__builtin_amdgcn_rcpf(e[0]), __builtin_amdgcn_rcpf(e[1]), __builtin_amdgcn_rcpf(e[2]), __builtin_amdgcn_rcpf(e[3])}; }
__device__ __forceinline__ f32x4 gelu_tanh4(const f32x4 x) { const f32x4 z2 = (x + (x * x) * x * 0.044715f) * (2.0f * 0.7978845608028654f); return x * sigmoid4(z2); }
__device__ __forceinline__ float bflo(unsigned w) { return __uint_as_float(w << 16); }
__device__ __forceinline__ float bfhi(unsigned w) { return __uint_as_float(w & 0xffff0000u); }
__device__ __forceinline__ unsigned cvtpk(float lo, float hi) { return pg8::cvt_pk_bf16(lo, hi); }
__device__ __forceinline__ v4u pack8(const f32x4 a, const f32x4 b) { v4u w; w.x = cvtpk(a[0], a[1]); w.y = cvtpk(a[2], a[3]); w.z = cvtpk(b[0], b[1]); w.w = cvtpk(b[2], b[3]); return w; }

__device__ __forceinline__ void unpack8(const v4u w, f32x4& a, f32x4& b) { a = (f32x4){bflo(w.x), bfhi(w.x), bflo(w.y), bfhi(w.y)}; b = (f32x4){bflo(w.z), bfhi(w.z), bflo(w.w), bfhi(w.w)}; }
__device__ __forceinline__ unsigned q8(float v) { int q = (int)__builtin_rintf(v); q = q < -127 ? -127 : (q > 127 ? 127 : q); return (unsigned)q & 0xffu; }
__device__ __forceinline__ unsigned q8x4(const f32x4 v) { return q8(v[0]) | (q8(v[1]) << 8) | (q8(v[2]) << 16) | (q8(v[3]) << 24); }
__device__ __forceinline__ float wave_max(float v) { v = fmaxf(v, sx<1>(v)); v = fmaxf(v, sx<2>(v)); v = fmaxf(v, sx<4>(v)); v = fmaxf(v, sx<8>(v)); v = fmaxf(v, sx<16>(v)); v = fmaxf(v, sx<32>(v)); return v; }
typedef int i32x4v __attribute__((ext_vector_type(4)));
__device__ __forceinline__ f32x4 acc_i2f(const f32x4 a) { return __builtin_convertvector(__builtin_bit_cast(i32x4v, a), f32x4); }
__device__ __forceinline__ float clamp448(float v) { return __builtin_fminf(__builtin_fmaxf(v, -448.0f), 448.0f); }
__device__ __forceinline__ unsigned f8x4(const f32x4 v) { int w = __builtin_amdgcn_cvt_pk_fp8_f32(clamp448(v[0]), clamp448(v[1]), 0, false); w = __builtin_amdgcn_cvt_pk_fp8_f32(clamp448(v[2]), clamp448(v[3]), w, true); return (unsigned)w; }
constexpr float F8_ACT_SCALE = 8.0f, F8_W_SCALE = 2048.0f;
__device__ __forceinline__ void load_rstd(const float* ssp, int row0, int fq, float (&rs)[2][4]) {
#pragma unroll
    for (int ai = 0; ai < 2; ++ai)
#pragma unroll
        for (int m = 0; m < 4; ++m) { const f32x4 p = *(const f32x4*)(ssp + (size_t)(row0 + ai * 128 + m * 16) * 16 + 4 * fq);
            float s = (p[0] + p[1]) + (p[2] + p[3]); s += __shfl_xor(s, 16); s += __shfl_xor(s, 32); rs[ai][m] = rsqrtf(s * (1.0f / D) + EPS); }
}
__device__ __forceinline__ void load_rstd_sc1(const float* ssp, int row0, int fq, float (&rs)[2][4]) {
#pragma unroll
    for (int ai = 0; ai < 2; ++ai)
#pragma unroll
        for (int m = 0; m < 4; ++m) { const gu32* p = (const gu32*)(ssp + (size_t)(row0 + ai * 128 + m * 16) * 16 + 4 * fq);
            const float p0 = __uint_as_float(__hip_atomic_load(p, RLX_AGENT)), p1 = __uint_as_float(__hip_atomic_load(p + 1, RLX_AGENT)), p2 = __uint_as_float(__hip_atomic_load(p + 2, RLX_AGENT)), p3 = __uint_as_float(__hip_atomic_load(p + 3, RLX_AGENT));
            float s = (p0 + p1) + (p2 + p3); s += __shfl_xor(s, 16); s += __shfl_xor(s, 32); rs[ai][m] = rsqrtf(s * (1.0f / D) + EPS); }
}
#ifndef MK_EPI_SWIGLU_REPS
#define MK_EPI_SWIGLU_REPS 1
#endif
#ifndef MK_EPI_RESID_REPS
#define MK_EPI_RESID_REPS 1
#endif
struct EpiSwiglu {
    static constexpr bool PERM = true, AFTER_DRAIN = false; static constexpr int REPS = MK_EPI_SWIGLU_REPS;
    pg8::bf16_t* act; const float* ssp; const float* bias;
    __device__ __forceinline__ void operator()(const f32x4 (&acc)[2][2][4][2], const pg8::Unit& u, int wr, int wc, int fr, int fq) const {
        const int row0 = u.pm * 256 + wr * 64 + fr, b = u.pm >> 4;
        float rs[2][4]; load_rstd(ssp, row0, fq, rs);
        const float* bp = bias + (size_t)b * FF2 + u.pn * 256 + wc * 32 + 8 * fq;
        const f32x4 bg0 = *(const f32x4*)(bp), bg1 = *(const f32x4*)(bp + 4), bu0 = *(const f32x4*)(bp + 128), bu1 = *(const f32x4*)(bp + 132);
        const int oc = u.pn * 128 + wc * 32 + 8 * fq;
#pragma unroll
        for (int ai = 0; ai < 2; ++ai)
#pragma unroll
            for (int m = 0; m < 4; ++m) { const float r = rs[ai][m];
                const f32x4 g0 = acc[ai][0][m][0] * r + bg0, g1 = acc[ai][0][m][1] * r + bg1, u0 = acc[ai][1][m][0] * r + bu0, u1 = acc[ai][1][m][1] * r + bu1;
                const f32x4 a0 = (g0 * sigmoid4(g0)) * u0, a1 = (g1 * sigmoid4(g1)) * u1;
                *(v4u*)(act + (size_t)(row0 + ai * 128 + m * 16) * FF + oc) = pack8(a0, a1); }
    }
};
template <bool OUT8> struct EpiSwiglu8 {
    static constexpr bool PERM = true, AFTER_DRAIN = false; static constexpr int REPS = 1;
    pg8::bf16_t* act; const float* rs; const float* cs;
    __device__ __forceinline__ void operator()(const f32x4 (&acc)[2][2][4][2], const pg8::Unit& u, int wr, int wc, int fr, int fq) const {
        const int row0 = u.pm * 256 + wr * 64 + fr;
        float rv[2][4];
#pragma unroll
        for (int ai = 0; ai < 2; ++ai)
#pragma unroll
            for (int m = 0; m < 4; ++m) rv[ai][m] = rs[row0 + ai * 128 + m * 16];
        const int cb = u.pn * 256 + wc * 32 + 8 * fq;
        const float* cp = cs + cb;
        const f32x4 cg0 = *(const f32x4*)(cp), cg1 = *(const f32x4*)(cp + 4), cu0 = *(const f32x4*)(cp + 128), cu1 = *(const f32x4*)(cp + 132);
        const int oc = u.pn * 128 + wc * 32 + 8 * fq;
#pragma unroll
        for (int ai = 0; ai < 2; ++ai)
#pragma unroll
            for (int m = 0; m < 4; ++m) { const float r = rv[ai][m];
                const f32x4 g0 = acc_i2f(acc[ai][0][m][0]) * (cg0 * r), g1 = acc_i2f(acc[ai][0][m][1]) * (cg1 * r);
                const f32x4 u0 = acc_i2f(acc[ai][1][m][0]) * (cu0 * r), u1 = acc_i2f(acc[ai][1][m][1]) * (cu1 * r);
                const f32x4 a0 = (g0 * sigmoid4(g0)) * u0, a1 = (g1 * sigmoid4(g1)) * u1;
                if (OUT8) *(unsigned long long*)((unsigned char*)act + (size_t)(row0 + ai * 128 + m * 16) * FF + oc) = (unsigned long long)f8x4(a0 * F8_ACT_SCALE) | ((unsigned long long)f8x4(a1 * F8_ACT_SCALE) << 32);
                else *(v4u*)(act + (size_t)(row0 + ai * 128 + m * 16) * FF + oc) = pack8(a0, a1); }
    }
};
template <int WHALF, bool HASY, bool IN16, bool F8 = false> struct EpiResid {
    static constexpr bool PERM = true, AFTER_DRAIN = false; static constexpr int REPS = (IN16 ? 1 : MK_EPI_RESID_REPS);
    static constexpr float w = (WHALF ? 0.5f : 1.0f) * (F8 ? 1.0f / (F8_ACT_SCALE * F8_W_SCALE) : 1.0f);
    const void* xin; pg8::bf16_t* xout; pg8::bf16_t* y; float* ssp; const float* gt; const float* gnext; const float* scnext;
    __device__ __forceinline__ void operator()(const f32x4 (&acc)[2][2][4][2], const pg8::Unit& u, int wr, int wc, int fr, int fq) const {
        const int row0 = u.pm * 256 + wr * 64 + fr, b = u.pm >> 4;
        float ss[2][4];
#pragma unroll
        for (int ai = 0; ai < 2; ++ai)
#pragma unroll
            for (int m = 0; m < 4; ++m) ss[ai][m] = 0.f;
#pragma unroll
        for (int bj = 0; bj < 2; ++bj) { const int c0 = u.pn * 256 + bj * 128 + wc * 32 + 8 * fq;
            const f32x4 gt0 = *(const f32x4*)(gt + (size_t)b * LDM + c0) * w, gt1 = *(const f32x4*)(gt + (size_t)b * LDM + c0 + 4) * w;
            f32x4 gs0 = {0.f, 0.f, 0.f, 0.f}, gs1 = gs0;
            if (HASY) { gs0 = *(const f32x4*)(gnext + c0) * (*(const f32x4*)(scnext + (size_t)b * LDM + c0) + 1.0f); gs1 = *(const f32x4*)(gnext + c0 + 4) * (*(const f32x4*)(scnext + (size_t)b * LDM + c0 + 4) + 1.0f); }
#pragma unroll
            for (int ai = 0; ai < 2; ++ai)
#pragma unroll
                for (int m = 0; m < 4; ++m) { const size_t off = (size_t)(row0 + ai * 128 + m * 16) * D + c0;
                    f32x4 x0, x1;
                    if (IN16) unpack8(*(const v4u*)((const pg8::bf16_t*)xin + off), x0, x1); else { x0 = *(const f32x4*)((const float*)xin + off); x1 = *(const f32x4*)((const float*)xin + off + 4); }
                    const f32x4 o0 = x0 + gt0 * acc[ai][bj][m][0], o1 = x1 + gt1 * acc[ai][bj][m][1];
                    *(v4u*)(xout + off) = pack8(o0, o1);
                    ss[ai][m] += (o0[0] * o0[0] + o0[1] * o0[1]) + (o0[2] * o0[2] + o0[3] * o0[3]) + (o1[0] * o1[0] + o1[1] * o1[1]) + (o1[2] * o1[2] + o1[3] * o1[3]);
                    if (HASY) *(v4u*)(y + off) = pack8(o0 * gs0, o1 * gs1); } }
#pragma unroll
        for (int ai = 0; ai < 2; ++ai)
#pragma unroll
            for (int m = 0; m < 4; ++m) { float s = ss[ai][m]; s += __shfl_xor(s, 16); s += __shfl_xor(s, 32);
                if (fq == 0) ssp[(size_t)(row0 + ai * 128 + m * 16) * 16 + u.pn * 4 + wc] = s; }
    }
};
template <int WHALF, bool IN16> struct EpiResidQ {
    static constexpr bool PERM = true, AFTER_DRAIN = false; static constexpr int REPS = 1;
    static constexpr float w = WHALF ? 0.5f : 1.0f;
    const void* xin; pg8::bf16_t* xout; unsigned char* a8; float* rs; f32x2* sspx; const float* gt; const float* gnext; const float* scnext; const float* shnext; const float* shmax; unsigned* cnt;
    __device__ __forceinline__ void operator()(f32x4 (&acc)[2][2][4][2], const pg8::Unit& u, int wr, int wc, int fr, int fq) const {
        const int row0 = u.pm * 256 + wr * 64 + fr, b = u.pm >> 4;
        float ss[2][4], am[2][4];
#pragma unroll
        for (int ai = 0; ai < 2; ++ai)
#pragma unroll
            for (int m = 0; m < 4; ++m) { ss[ai][m] = 0.f; am[ai][m] = 0.f; }
        const unsigned voff = (unsigned)((row0 * D + u.pn * 256 + wc * 32 + 8 * fq) * 2);
        unsigned vo[4] = {voff, voff, voff, voff};
#pragma unroll
        for (int bj = 0; bj < 2; ++bj) { const int c0 = u.pn * 256 + bj * 128 + wc * 32 + 8 * fq;
            const f32x4 gt0 = *(const f32x4*)(gt + (size_t)b * LDM + c0) * w, gt1 = *(const f32x4*)(gt + (size_t)b * LDM + c0 + 4) * w;
            const f32x4 gs0 = *(const f32x4*)(gnext + c0) * (*(const f32x4*)(scnext + (size_t)b * LDM + c0) + 1.0f), gs1 = *(const f32x4*)(gnext + c0 + 4) * (*(const f32x4*)(scnext + (size_t)b * LDM + c0 + 4) + 1.0f);
#pragma unroll
            for (int ai = 0; ai < 2; ++ai)
#pragma unroll
                for (int m = 0; m < 4; ++m) { const unsigned so = (unsigned)(((ai * 128 + m * 16) * D + bj * 128) * 2); const int g = m & 3;
                    f32x4 x0, x1;
                    if (IN16) unpack8(*(const v4u*)((const char*)xin + (size_t)(vo[g] + so)), x0, x1);
                    else { const char* p = (const char*)xin + 2 * (size_t)(vo[g] + so); x0 = *(const f32x4*)p; x1 = *(const f32x4*)(p + 16); }
                    const f32x4 o0 = x0 + gt0 * acc[ai][bj][m][0], o1 = x1 + gt1 * acc[ai][bj][m][1];
                    *(v4u*)((char*)xout + (size_t)(vo[g] + so)) = pack8(o0, o1);
                    acc[ai][bj][m][0] = o0; acc[ai][bj][m][1] = o1;
                    ss[ai][m] += (o0[0] * o0[0] + o0[1] * o0[1]) + (o0[2] * o0[2] + o0[3] * o0[3]) + (o1[0] * o1[0] + o1[1] * o1[1]) + (o1[2] * o1[2] + o1[3] * o1[3]);
                    const f32x4 t0 = __builtin_elementwise_abs(o0 * gs0), t1 = __builtin_elementwise_abs(o1 * gs1);
                    am[ai][m] = fmaxf(am[ai][m], fmaxf(fmaxf(fmaxf(t0[0], t0[1]), fmaxf(t0[2], t0[3])), fmaxf(fmaxf(t1[0], t1[1]), fmaxf(t1[2], t1[3]))));
                    asm volatile("" : "+v"(vo[g]) : "v"(ss[ai][m])); } }
#pragma unroll
        for (int ai = 0; ai < 2; ++ai)
#pragma unroll
            for (int m = 0; m < 4; ++m) { float s = ss[ai][m], a = am[ai][m]; s += __shfl_xor(s, 16); s += __shfl_xor(s, 32); a = fmaxf(a, __shfl_xor(a, 16)); a = fmaxf(a, __shfl_xor(a, 32));
                if (fq == 0) __hip_atomic_store((gu64*)(sspx + (size_t)(row0 + ai * 128 + m * 16) * 16 + u.pn * 4 + wc), ((unsigned long long)__float_as_uint(a) << 32) | __float_as_uint(s), RLX_AGENT); }
        PROF_BEGIN(13);
        asm volatile("s_waitcnt vmcnt(0)" ::: "memory");
        unsigned* cw = cnt + 64 * u.pm;
        if ((threadIdx.x & 63) == 0) __hip_atomic_fetch_add(cw, 1u, __ATOMIC_RELAXED, __HIP_MEMORY_SCOPE_AGENT);
        if (threadIdx.x < 64) {
            unsigned sp = 0;
            while ((unsigned)__builtin_amdgcn_readfirstlane(__hip_atomic_load(cw, __ATOMIC_RELAXED, __HIP_MEMORY_SCOPE_AGENT)) < 32u) { __builtin_amdgcn_s_sleep(1); if (++sp > (1u << 20)) break; }
            __builtin_amdgcn_fence(__ATOMIC_ACQUIRE, "agent");
            asm volatile("s_waitcnt vmcnt(0)" ::: "memory");
        }
        asm volatile("" ::: "memory"); __builtin_amdgcn_s_barrier(); asm volatile("" ::: "memory");
        PROF_END(13);
        float qs[2][4], qr[2][4];
        const float shm = shmax[b];
#pragma unroll
        for (int ai = 0; ai < 2; ++ai)
#pragma unroll
            for (int m = 0; m < 4; ++m) { const int row = row0 + ai * 128 + m * 16; const gu64* p = (const gu64*)(sspx + (size_t)row * 16 + 4 * fq);
                float s = 0.f, a = 0.f;
#pragma unroll
                for (int e = 0; e < 4; ++e) { const unsigned long long t = __hip_atomic_load(p + e, RLX_AGENT); s += __uint_as_float((unsigned)t); a = fmaxf(a, __uint_as_float((unsigned)(t >> 32))); }
                s += __shfl_xor(s, 16); s += __shfl_xor(s, 32); a = fmaxf(a, __shfl_xor(a, 16)); a = fmaxf(a, __shfl_xor(a, 32));
                const float rstd = rsqrtf(s * (1.0f / D) + EPS), S = rstd * a + shm;
                qs[ai][m] = S > 0.f ? 127.0f / S : 0.f; qr[ai][m] = rstd * qs[ai][m];
                if (u.pn == 0 && wc == 0 && fq == 0) rs[row] = S * (1.0f / 127.0f); }
        const unsigned voff8 = (unsigned)(row0 * D + u.pn * 256 + wc * 32 + 8 * fq);
#pragma unroll
        for (int bj = 0; bj < 2; ++bj) { const int c0 = u.pn * 256 + bj * 128 + wc * 32 + 8 * fq;
            const f32x4 gs0 = *(const f32x4*)(gnext + c0) * (*(const f32x4*)(scnext + (size_t)b * LDM + c0) + 1.0f), gs1 = *(const f32x4*)(gnext + c0 + 4) * (*(const f32x4*)(scnext + (size_t)b * LDM + c0 + 4) + 1.0f);
            const f32x4 sh0 = *(const f32x4*)(shnext + (size_t)b * LDM + c0), sh1 = *(const f32x4*)(shnext + (size_t)b * LDM + c0 + 4);
#pragma unroll
            for (int ai = 0; ai < 2; ++ai)
#pragma unroll
                for (int m = 0; m < 4; ++m) { const float q = qs[ai][m], r = qr[ai][m]; const unsigned so = (unsigned)((ai * 128 + m * 16) * D + bj * 128);
                    *(unsigned long long*)(a8 + (size_t)(voff8 + so)) = (unsigned long long)q8x4(acc[ai][bj][m][0] * (gs0 * r) + sh0 * q) | ((unsigned long long)q8x4(acc[ai][bj][m][1] * (gs1 * r) + sh1 * q) << 32); } }
    }
};
template <bool F8> struct EpiResidFinal {
    static constexpr bool PERM = true, AFTER_DRAIN = false; static constexpr int REPS = 1;
    static constexpr float ascale = F8 ? 1.0f / (F8_ACT_SCALE * F8_W_SCALE) : 1.0f;
    const pg8::bf16_t* xin; float* out; float* ssp; const float* gt; const float* gf; const float* fsc; const float* fsh; unsigned* cnt;
    __device__ __forceinline__ void operator()(f32x4 (&acc)[2][2][4][2], const pg8::Unit& u, int wr, int wc, int fr, int fq) const {
        const int row0 = u.pm * 256 + wr * 64 + fr, b = u.pm >> 4;
        const __amdgpu_buffer_rsrc_t rx = __builtin_amdgcn_make_buffer_rsrc((void*)xin, 0, M * D * 4, 0x00020000), ro = __builtin_amdgcn_make_buffer_rsrc((void*)out, 0, M * D * 4, 0x00020000);
        const unsigned voff = (unsigned)((row0 * D + u.pn * 256 + wc * 32 + 8 * fq) * 4);
        float ss[2][4];
#pragma unroll
        for (int ai = 0; ai < 2; ++ai)
#pragma unroll
            for (int m = 0; m < 4; ++m) ss[ai][m] = 0.f;
        unsigned vo[4] = {voff, voff, voff, voff};
#pragma unroll
        for (int bj = 0; bj < 2; ++bj) { const int c0 = u.pn * 256 + bj * 128 + wc * 32 + 8 * fq;
            const float hw = 0.5f * ascale; const f32x4 gt0 = *(const f32x4*)(gt + (size_t)b * LDM + c0) * hw, gt1 = *(const f32x4*)(gt + (size_t)b * LDM + c0 + 4) * hw;
#pragma unroll
            for (int ai = 0; ai < 2; ++ai)
#pragma unroll
                for (int m = 0; m < 4; ++m) { const unsigned so = (unsigned)(((ai * 128 + m * 16) * D + bj * 128) * 4); const int g = m & 3;
                    f32x4 x0, x1; unpack8(*(const v4u*)((const char*)xin + (size_t)((vo[g] + so) >> 1)), x0, x1);
                    const f32x4 o0 = x0 + gt0 * acc[ai][bj][m][0], o1 = x1 + gt1 * acc[ai][bj][m][1];
                    acc[ai][bj][m][0] = o0; acc[ai][bj][m][1] = o1;
                    ss[ai][m] += (o0[0] * o0[0] + o0[1] * o0[1]) + (o0[2] * o0[2] + o0[3] * o0[3]) + (o1[0] * o1[0] + o1[1] * o1[1]) + (o1[2] * o1[2] + o1[3] * o1[3]);
                    asm volatile("" : "+v"(vo[g]) : "v"(ss[ai][m])); } }
#pragma unroll
        for (int ai = 0; ai < 2; ++ai)
#pragma unroll
            for (int m = 0; m < 4; ++m) { float s = ss[ai][m]; s += __shfl_xor(s, 16); s += __shfl_xor(s, 32);
                if (fq == 0) __hip_atomic_store((gu32*)(ssp + (size_t)(row0 + ai * 128 + m * 16) * 16 + u.pn * 4 + wc), __float_as_uint(s), RLX_AGENT); }
        PROF_BEGIN(14);
        asm volatile("s_waitcnt vmcnt(0)" ::: "memory");
        unsigned* cw = cnt + 64 * u.pm;
        if ((threadIdx.x & 63) == 0) __hip_atomic_fetch_add(cw, 1u, __ATOMIC_RELAXED, __HIP_MEMORY_SCOPE_AGENT);
        if (threadIdx.x < 64) {
            unsigned sp = 0;
            while ((unsigned)__builtin_amdgcn_readfirstlane(__hip_atomic_load(cw, __ATOMIC_RELAXED, __HIP_MEMORY_SCOPE_AGENT)) < 32u) { __builtin_amdgcn_s_sleep(1); if (++sp > (1u << 20)) break; }
            __builtin_amdgcn_fence(__ATOMIC_ACQUIRE, "agent");
            asm volatile("s_waitcnt vmcnt(0)" ::: "memory");
        }
        asm volatile("" ::: "memory"); __builtin_amdgcn_s_barrier(); asm volatile("" ::: "memory");
        PROF_END(14);
        float rs[2][4]; load_rstd_sc1(ssp, row0, fq, rs);
#pragma unroll
        for (int bj = 0; bj < 2; ++bj) { const int c0 = u.pn * 256 + bj * 128 + wc * 32 + 8 * fq;
            const f32x4 gs0 = *(const f32x4*)(gf + c0) * (*(const f32x4*)(fsc + (size_t)b * LDM + c0) + 1.0f), gs1 = *(const f32x4*)(gf + c0 + 4) * (*(const f32x4*)(fsc + (size_t)b * LDM + c0 + 4) + 1.0f);
            const f32x4 sh0 = *(const f32x4*)(fsh + (size_t)b * LDM + c0), sh1 = *(const f32x4*)(fsh + (size_t)b * LDM + c0 + 4);
#pragma unroll
            for (int ai = 0; ai < 2; ++ai)
#pragma unroll
                for (int m = 0; m < 4; ++m) { const unsigned so = (unsigned)(((ai * 128 + m * 16) * D + bj * 128) * 4); const float r = rs[ai][m];
                    *(f32x4*)((char*)out + (size_t)voff + so) = acc[ai][bj][m][0] * r * gs0 + sh0;
                    *(f32x4*)((char*)out + (size_t)voff + so + 16) = acc[ai][bj][m][1] * r * gs1 + sh1; } }
    }
};
struct EpiMixIn {
    static constexpr bool PERM = true, AFTER_DRAIN = false; static constexpr int REPS = 1;
    pg8::bf16_t *U, *UX, *GY; const float* ssp; const float* bias;
    __device__ __forceinline__ void operator()(const f32x4 (&acc)[2][2][4][2], const pg8::Unit& u, int wr, int wc, int fr, int fq) const {
        const int row0 = u.pm * 256 + wr * 64 + fr, b = u.pm >> 4;
        float rs[2][4]; load_rstd(ssp, row0, fq, rs);
        const float* bp = bias + (size_t)b * NMIX + u.pn * 256 + wc * 32 + 8 * fq;
        const f32x4 b00 = *(const f32x4*)(bp), b01 = *(const f32x4*)(bp + 4), b10 = *(const f32x4*)(bp + 128), b11 = *(const f32x4*)(bp + 132);
        if (u.pn < 4) {
            const int oc = u.pn * 128 + wc * 32 + 8 * fq;
#pragma unroll
            for (int ai = 0; ai < 2; ++ai)
#pragma unroll
                for (int m = 0; m < 4; ++m) { const float r = rs[ai][m];
                    const f32x4 v0 = acc[ai][0][m][0] * r + b00, v1 = acc[ai][0][m][1] * r + b01, g0 = acc[ai][1][m][0] * r + b10, g1 = acc[ai][1][m][1] * r + b11;
                    const f32x4 a0 = v0 * sigmoid4(g0), a1 = v1 * sigmoid4(g1);
                    *(v4u*)(U + (size_t)(row0 + ai * 128 + m * 16) * DC + oc) = pack8(a0, a1); }
        } else {
            pg8::bf16_t* dst = (u.pn < 6) ? UX : GY; const bool gel = u.pn >= 6; const int pc = (u.pn & 1) * 256 + wc * 32 + 8 * fq;
#pragma unroll
            for (int ai = 0; ai < 2; ++ai)
#pragma unroll
                for (int m = 0; m < 4; ++m) { const float r = rs[ai][m];
#pragma unroll
                    for (int bj = 0; bj < 2; ++bj) { f32x4 v0 = acc[ai][bj][m][0] * r + (bj ? b10 : b00), v1 = acc[ai][bj][m][1] * r + (bj ? b11 : b01);
                        if (gel) { v0 = gelu_tanh4(v0); v1 = gelu_tanh4(v1); }
                        *(v4u*)(dst + (size_t)(row0 + ai * 128 + m * 16) * DR + pc + bj * 128) = pack8(v0, v1); } }
        }
    }
};

struct EpiMixIn8 {
    static constexpr bool PERM = true, AFTER_DRAIN = false; static constexpr int REPS = 1;
    pg8::bf16_t *U, *UX, *GY; const float* rs; const float* cs; const float* bias;
    __device__ __forceinline__ void operator()(const f32x4 (&acc)[2][2][4][2], const pg8::Unit& u, int wr, int wc, int fr, int fq) const {
        const int row0 = u.pm * 256 + wr * 64 + fr, b = u.pm >> 4;
        float rv[2][4];
#pragma unroll
        for (int ai = 0; ai < 2; ++ai)
#pragma unroll
            for (int m = 0; m < 4; ++m) rv[ai][m] = rs[row0 + ai * 128 + m * 16];
        const int cb = u.pn * 256 + wc * 32 + 8 * fq;
        const float* bp = bias + (size_t)b * NMIX + cb; const float* cp = cs + cb;
        const f32x4 b00 = *(const f32x4*)(bp), b01 = *(const f32x4*)(bp + 4), b10 = *(const f32x4*)(bp + 128), b11 = *(const f32x4*)(bp + 132);
        const f32x4 c00 = *(const f32x4*)(cp), c01 = *(const f32x4*)(cp + 4), c10 = *(const f32x4*)(cp + 128), c11 = *(const f32x4*)(cp + 132);
        if (u.pn < 4) {
            const int oc = u.pn * 128 + wc * 32 + 8 * fq;
#pragma unroll
            for (int ai = 0; ai < 2; ++ai)
#pragma unroll
                for (int m = 0; m < 4; ++m) { const float r = rv[ai][m];
                    const f32x4 v0 = acc_i2f(acc[ai][0][m][0]) * (c00 * r) + b00, v1 = acc_i2f(acc[ai][0][m][1]) * (c01 * r) + b01;
                    const f32x4 g0 = acc_i2f(acc[ai][1][m][0]) * (c10 * r) + b10, g1 = acc_i2f(acc[ai][1][m][1]) * (c11 * r) + b11;
                    const f32x4 a0 = v0 * sigmoid4(g0), a1 = v1 * sigmoid4(g1);
                    *(v4u*)(U + (size_t)(row0 + ai * 128 + m * 16) * DC + oc) = pack8(a0, a1); }
        } else {
            pg8::bf16_t* dst = (u.pn < 6) ? UX : GY; const bool gel = u.pn >= 6; const int pc = (u.pn & 1) * 256 + wc * 32 + 8 * fq;
#pragma unroll
            for (int ai = 0; ai < 2; ++ai)
#pragma unroll
                for (int m = 0; m < 4; ++m) { const float r = rv[ai][m];
#pragma unroll
                    for (int bj = 0; bj < 2; ++bj) { f32x4 v0 = acc_i2f(acc[ai][bj][m][0]) * ((bj ? c10 : c00) * r) + (bj ? b10 : b00), v1 = acc_i2f(acc[ai][bj][m][1]) * ((bj ? c11 : c01) * r) + (bj ? b11 : b01);
                        if (gel) { v0 = gelu_tanh4(v0); v1 = gelu_tanh4(v1); }
                        *(v4u*)(dst + (size_t)(row0 + ai * 128 + m * 16) * DR + pc + bj * 128) = pack8(v0, v1); } }
        }
    }
};

__device__ __forceinline__ void p0_gemv(LAS unsigned char* lds, const float* c, const float* W, int NC, const float* bias, float* out, int j0, int tid) {
    LAS float* ca = (LAS float*)lds; LAS float* part = (LAS float*)(lds + 32768);
    for (int i = tid; i < NB * D; i += 512) { const float v = c[i]; ca[i] = v / (1.f + expf(-v)); }
    __syncthreads();
    const int cg = tid & 31, ks = tid >> 5;
    const float* wp = W + (size_t)(64 * ks) * NC + j0 + 4 * cg;
    f32x4 acc[NB];
#pragma unroll
    for (int b = 0; b < NB; ++b) acc[b] = (f32x4){0.f, 0.f, 0.f, 0.f};
#pragma unroll 4
    for (int kk = 0; kk < 64; ++kk) { const f32x4 w = *(const f32x4*)(wp + (size_t)kk * NC);
#pragma unroll
        for (int b = 0; b < NB; ++b) acc[b] += w * ca[b * D + 64 * ks + kk]; }
#pragma unroll
    for (int b = 0; b < NB; ++b) *(LAS f32x4*)(part + (ks * NB + b) * 128 + 4 * cg) = acc[b];
    __syncthreads();
#pragma unroll
    for (int r = 0; r < 2; ++r) { const int o = tid + 512 * r, b = o >> 7, col = o & 127; float s = 0.f;
#pragma unroll
        for (int k2 = 0; k2 < 16; ++k2) s += part[(k2 * NB + b) * 128 + col];
        out[(size_t)b * LDM + j0 + col] = s + bias[j0 + col]; }
    __syncthreads();
}
__device__ __forceinline__ int rowmap(int kind, int n0) {
    if (kind == 1) { const int half = n0 / FF, f = n0 - half * FF; return 256 * (f >> 7) + 128 * half + (f & 127); }
    if (kind == 2 && n0 < 1024) { const int half = n0 >> 9, f = n0 & 511; return 256 * (f >> 7) + 128 * half + (f & 127); }
    return n0;
}
__device__ __forceinline__ void p0_transpose_item(const float* W, int K, int N, bf16* WT, int kind, LAS float* scr, int item, int lane) {
    const int nblk = N / 32, kb = item / nblk, nb = item % nblk, k0 = 64 * kb, n0 = 32 * nb, r0 = rowmap(kind, n0);
#pragma unroll 8
    for (int i = 0; i < 32; ++i) { const int kk = 2 * i + (lane >> 5); scr[kk * 33 + (lane & 31)] = W[(size_t)(k0 + kk) * N + n0 + (lane & 31)]; }
    LDS_WAIT(); asm volatile("" ::: "memory");
    const int c = lane & 7;
#pragma unroll
    for (int j = 0; j < 4; ++j) { const int n = (lane >> 3) + 8 * j; const LAS float* s = scr + (8 * c) * 33 + n;
        v4u o; o.x = pk2(s[0 * 33], s[1 * 33]); o.y = pk2(s[2 * 33], s[3 * 33]); o.z = pk2(s[4 * 33], s[5 * 33]); o.w = pk2(s[6 * 33], s[7 * 33]);
        *(GAS v4u*)(WT + (size_t)(r0 + n) * K + k0 + 8 * c) = o; }
    LDS_WAIT(); asm volatile("" ::: "memory");
}

__device__ __forceinline__ void p0_transpose8_item(const float* W, int K, int N, unsigned char* WT, LAS float* scr, int item, int lane) {
    const int nblk = N / 32, kb = item / nblk, nb = item % nblk, k0 = 64 * kb, n0 = 32 * nb;
#pragma unroll 8
    for (int i = 0; i < 32; ++i) { const int kk = 2 * i + (lane >> 5); scr[kk * 33 + (lane & 31)] = W[(size_t)(k0 + kk) * N + n0 + (lane & 31)]; }
    LDS_WAIT(); asm volatile("" ::: "memory");
    const int n = lane >> 1, kh = (lane & 1) * 32; const LAS float* sp = scr + n;
#pragma unroll
    for (int hq = 0; hq < 2; ++hq) { v4u o;
#pragma unroll
        for (int dq = 0; dq < 4; ++dq) { const int k = kh + 16 * hq + 4 * dq;
            const unsigned w4 = f8x4((f32x4){sp[(k + 0) * 33], sp[(k + 1) * 33], sp[(k + 2) * 33], sp[(k + 3) * 33]} * F8_W_SCALE);
            if (dq == 0) o.x = w4; else if (dq == 1) o.y = w4; else if (dq == 2) o.z = w4; else o.w = w4; }
        *(GAS v4u*)(WT + (size_t)(n0 + n) * K + k0 + kh + 16 * hq) = o; }
    LDS_WAIT(); asm volatile("" ::: "memory");
}
__device__ __forceinline__ void p0_quant_item(LAS unsigned char* lds, const float* W, int N, int kind, unsigned char* W8, float* cs, int nb, int lane, int wave) {
    LAS float* scr = (LAS float*)(lds + wave * 16896);
    LAS float* cm = (LAS float*)(lds + 8 * 16896);
    const int n0 = 32 * nb, r0 = rowmap(kind, n0);
#pragma unroll
    for (int tl = 0; tl < 2; ++tl) { const int k0 = 64 * (2 * wave + tl);
#pragma unroll 8
        for (int i = 0; i < 32; ++i) { const int kk = 2 * i + (lane >> 5); scr[tl * 2112 + kk * 33 + (lane & 31)] = W[(size_t)(k0 + kk) * N + n0 + (lane & 31)]; } }
    LDS_WAIT(); asm volatile("" ::: "memory");
    float mx = 0.f;
#pragma unroll
    for (int tl = 0; tl < 2; ++tl)
#pragma unroll 8
        for (int r = 0; r < 32; ++r) mx = fmaxf(mx, fabsf(scr[tl * 2112 + ((lane >> 5) * 32 + r) * 33 + (lane & 31)]));
    mx = fmaxf(mx, __shfl_xor(mx, 32));
    if (lane < 32) cm[wave * 32 + lane] = mx;
    __syncthreads();
    float cmax = 0.f;
#pragma unroll
    for (int w = 0; w < 8; ++w) cmax = fmaxf(cmax, cm[w * 32 + (lane & 31)]);
    const float sc = cmax > 0.f ? 127.0f / cmax : 0.f;
    if (wave == 0 && lane < 32) cs[r0 + lane] = cmax * (1.0f / 127.0f);
    const int n = lane >> 1, kh = (lane & 1) * 32;
    const float sn = __shfl(sc, n);
#pragma unroll
    for (int tl = 0; tl < 2; ++tl) { const int k0 = 64 * (2 * wave + tl); const LAS float* sp = scr + tl * 2112 + n;
#pragma unroll
        for (int hq = 0; hq < 2; ++hq) { v4u o;
#pragma unroll
            for (int dq = 0; dq < 4; ++dq) { const int k = kh + 16 * hq + 4 * dq;
                const unsigned w4 = q8(sp[(k + 0) * 33] * sn) | (q8(sp[(k + 1) * 33] * sn) << 8) | (q8(sp[(k + 2) * 33] * sn) << 16) | (q8(sp[(k + 3) * 33] * sn) << 24);
                if (dq == 0) o.x = w4; else if (dq == 1) o.y = w4; else if (dq == 2) o.z = w4; else o.w = w4; }
            *(GAS v4u*)(W8 + (size_t)(r0 + n) * D + k0 + kh + 16 * hq) = o; } }
    __syncthreads();
}

__device__ __forceinline__ void mix_conv(LAS unsigned char* lds, const bf16* U, const float* conv_w, const float* conv_b, const float* ln_g, const float* ln_b, bf16* YMIX, int G, int bx, int tid, int lane, int wave) {
    LAS unsigned char* IN = lds;
    LAS f32x4* WA = (LAS f32x4*)(lds + 63488);
    LAS f32x4* WB = WA + 31 * 64;
    for (int i = tid; i < 31 * 64; i += 512) { const int k = i >> 6, l = i & 63; WA[i] = *(const f32x4*)(conv_w + k * DC + 8 * l); WB[i] = *(const f32x4*)(conv_w + k * DC + 8 * l + 4); }
    const f32x4 cb0 = *(const f32x4*)(conv_b + 8 * lane), cb1 = *(const f32x4*)(conv_b + 8 * lane + 4);
    const f32x4 lg0 = *(const f32x4*)(ln_g + 8 * lane), lg1 = *(const f32x4*)(ln_g + 8 * lane + 4);
    const f32x4 lb0 = *(const f32x4*)(ln_b + 8 * lane), lb1 = *(const f32x4*)(ln_b + 8 * lane + 4);
    v4u pre[8];
#pragma unroll
    for (int i = 0; i < 8; ++i) { const int q = tid + 512 * i, row = q >> 6, ch = q & 63, tok = (bx & 127) * 32 - 30 + row; pre[i] = (v4u){0u, 0u, 0u, 0u};
        if (bx < NB * (SEQ / 32) && q < 62 * 64 && tok >= 0) pre[i] = *(const v4u*)(U + ((size_t)((bx >> 7) * SEQ + tok)) * DC + 8 * ch); }
    for (int item = bx; item < NB * (SEQ / 32); item += G) {
        const int b = item >> 7, t0 = (item & 127) * 32;
        __syncthreads();
#pragma unroll
        for (int i = 0; i < 8; ++i) { const int q = tid + 512 * i; if (q < 62 * 64) *(LAS v4u*)(IN + (q >> 6) * 1024 + (q & 63) * 16) = pre[i]; }
        { const int nitem = item + G, nb = nitem >> 7, nt0 = (nitem & 127) * 32;
#pragma unroll
            for (int i = 0; i < 8; ++i) { const int q = tid + 512 * i, row = q >> 6, ch = q & 63, tok = nt0 - 30 + row; pre[i] = (v4u){0u, 0u, 0u, 0u};
                if (nitem < NB * (SEQ / 32) && q < 62 * 64 && tok >= 0) pre[i] = *(const v4u*)(U + ((size_t)(nb * SEQ + tok)) * DC + 8 * ch); } }
        __syncthreads();
        f32x4 a0[4], a1[4];
#pragma unroll
        for (int tt = 0; tt < 4; ++tt) { a0[tt] = cb0; a1[tt] = cb1; }
        f32x4 wa0 = {0.f, 0.f, 0.f, 0.f}, wa1 = wa0, wa2 = wa0, wa3 = wa0, wb0 = wa0, wb1 = wa0, wb2 = wa0, wb3 = wa0;
#pragma unroll
        for (int kk = 0; kk < 34; ++kk) {
            const v4u v = *(const LAS v4u*)(IN + (4 * wave + kk) * 1024 + lane * 16);
            const f32x4 x0 = {bflo(v.x), bfhi(v.x), bflo(v.y), bfhi(v.y)}, x1 = {bflo(v.z), bfhi(v.z), bflo(v.w), bfhi(v.w)};
            wa3 = wa2; wa2 = wa1; wa1 = wa0; wb3 = wb2; wb2 = wb1; wb1 = wb0;
            if (kk <= 30) { wa0 = WA[kk * 64 + lane]; wb0 = WB[kk * 64 + lane]; } else { wa0 = (f32x4){0.f, 0.f, 0.f, 0.f}; wb0 = wa0; }
            a0[0] += wa0 * x0; a1[0] += wb0 * x1; a0[1] += wa1 * x0; a1[1] += wb1 * x1; a0[2] += wa2 * x0; a1[2] += wb2 * x1; a0[3] += wa3 * x0; a1[3] += wb3 * x1;
        }
#pragma unroll
        for (int tt = 0; tt < 4; ++tt) {
            float s = (a0[tt][0] + a0[tt][1]) + (a0[tt][2] + a0[tt][3]) + (a1[tt][0] + a1[tt][1]) + (a1[tt][2] + a1[tt][3]);
            const float mean = wave_sum(s) * (1.0f / DC);
            const f32x4 d0 = a0[tt] - mean, d1 = a1[tt] - mean;
            float q = (d0[0] * d0[0] + d0[1] * d0[1]) + (d0[2] * d0[2] + d0[3] * d0[3]) + (d1[0] * d1[0] + d1[1] * d1[1]) + (d1[2] * d1[2] + d1[3] * d1[3]);
            const float rstd = rsqrtf(wave_sum(q) * (1.0f / DC) + EPS);
            f32x4 y0 = d0 * rstd * lg0 + lb0, y1 = d1 * rstd * lg1 + lb1;
#pragma unroll
            for (int j = 0; j < 4; ++j) { y0[j] = silu_fast(y0[j]); y1[j] = silu_fast(y1[j]); }
            *(v4u*)(YMIX + ((size_t)(b * SEQ + t0 + 4 * wave + tt)) * D + 8 * lane) = pack8(y0, y1);
        }
    }
    __syncthreads();
}

__device__ __forceinline__ void mix_conv2(LAS unsigned char* lds, const bf16* U, const float* conv_w, const float* conv_b, const float* ln_g, const float* ln_b, bf16* YMIX, int G, int bx, int tid, int lane, int wave) {
    LAS unsigned char* IN = lds;
    LAS float* RED = (LAS float*)(lds + 63488);
    const int th = wave >> 2, cq = wave & 3, ch = 128 * cq + 2 * lane;
    f32x2 wt[31];
#pragma unroll
    for (int k = 0; k < 31; ++k) wt[k] = *(const f32x2*)(conv_w + k * DC + ch);
    const f32x2 cb = *(const f32x2*)(conv_b + ch), lg = *(const f32x2*)(ln_g + ch), lb = *(const f32x2*)(ln_b + ch);
    v4u pre[8];
#pragma unroll
    for (int i = 0; i < 8; ++i) { const int q = tid + 512 * i, row = q >> 6, c16 = q & 63, tok = (bx & 127) * 32 - 30 + row; pre[i] = (v4u){0u, 0u, 0u, 0u};
        if (bx < NB * (SEQ / 32) && q < 62 * 64 && tok >= 0) pre[i] = *(const v4u*)(U + ((size_t)((bx >> 7) * SEQ + tok)) * DC + 8 * c16); }
    for (int item = bx; item < NB * (SEQ / 32); item += G) {
        const int b = item >> 7, t0 = (item & 127) * 32;
        PROF_BEGIN(10);
        __syncthreads();
#pragma unroll
        for (int i = 0; i < 8; ++i) { const int q = tid + 512 * i; if (q < 62 * 64) *(LAS v4u*)(IN + (q >> 6) * 1024 + (q & 63) * 16) = pre[i]; }
        { const int nitem = item + G, nb = nitem >> 7, nt0 = (nitem & 127) * 32;
#pragma unroll
            for (int i = 0; i < 8; ++i) { const int q = tid + 512 * i, row = q >> 6, c16 = q & 63, tok = nt0 - 30 + row; pre[i] = (v4u){0u, 0u, 0u, 0u};
                if (nitem < NB * (SEQ / 32) && q < 62 * 64 && tok >= 0) pre[i] = *(const v4u*)(U + ((size_t)(nb * SEQ + tok)) * DC + 8 * c16); } }
        __syncthreads();
        PROF_END(10); PROF_BEGIN(11);
        f32x2 acc[16];
#pragma unroll
        for (int tt = 0; tt < 16; ++tt) acc[tt] = cb;
        const LAS unsigned char* ip = IN + (16 * th) * 1024 + ch * 2;
#pragma unroll
        for (int r = 0; r < 46; ++r) {
            const unsigned v = *(const LAS unsigned*)(ip + r * 1024);
            const f32x2 xv = {bflo(v), bfhi(v)};
#pragma unroll
            for (int tt = 0; tt < 16; ++tt) { const int k = r - tt; if (k >= 0 && k <= 30) acc[tt] += wt[k] * xv; }
        }
        PROF_END(11); PROF_BEGIN(12);
        float vals[32];
#pragma unroll
        for (int tt = 0; tt < 16; ++tt) { vals[tt] = acc[tt][0] + acc[tt][1]; vals[16 + tt] = acc[tt][0] * acc[tt][0] + acc[tt][1] * acc[tt][1]; }
#pragma unroll
        for (int i = 0; i < 16; ++i) { const auto p = __builtin_amdgcn_permlane32_swap((int)__float_as_uint(vals[i]), (int)__float_as_uint(vals[i + 16]), false, false); vals[i] = __uint_as_float((unsigned)p[0]) + __uint_as_float((unsigned)p[1]); }
#pragma unroll
        for (int i = 0; i < 8; ++i) { const auto p = __builtin_amdgcn_permlane16_swap((int)__float_as_uint(vals[i]), (int)__float_as_uint(vals[i + 8]), false, false); vals[i] = __uint_as_float((unsigned)p[0]) + __uint_as_float((unsigned)p[1]); }
#define CONV_RED_STEP(off, n) { const bool up = (lane & (off)) != 0; _Pragma("unroll") for (int i = 0; i < (n); ++i) { const float keep = up ? vals[i + (n)] : vals[i], send = up ? vals[i] : vals[i + (n)]; vals[i] = keep + sx<(off)>(send); } }
        CONV_RED_STEP(8, 4) CONV_RED_STEP(4, 2) CONV_RED_STEP(2, 1)
#undef CONV_RED_STEP
        vals[0] += sx<1>(vals[0]);
        if ((lane & 1) == 0) RED[wave * 32 + (lane >> 5) * 16 + ((lane >> 1) & 15)] = vals[0];
        __syncthreads();
        float mean_l = 0.f, rstd_l = 0.f;
        if (lane < 16) { float s1 = 0.f, s2 = 0.f;
#pragma unroll
            for (int q4 = 0; q4 < 4; ++q4) { s1 += RED[(4 * th + q4) * 32 + lane]; s2 += RED[(4 * th + q4) * 32 + 16 + lane]; }
            mean_l = s1 * (1.0f / DC); const float var = fmaxf(s2 * (1.0f / DC) - mean_l * mean_l, 0.f); rstd_l = rsqrtf(var + EPS); }
#pragma unroll
        for (int tt = 0; tt < 16; ++tt) {
            const float mean = __uint_as_float((unsigned)__builtin_amdgcn_readlane((int)__float_as_uint(mean_l), tt)), rstd = __uint_as_float((unsigned)__builtin_amdgcn_readlane((int)__float_as_uint(rstd_l), tt));
            f32x2 y = (acc[tt] - mean) * rstd * lg + lb;
            y[0] = silu_fast(y[0]); y[1] = silu_fast(y[1]);
            *(unsigned*)(YMIX + ((size_t)(b * SEQ + t0 + 16 * th + tt)) * D + ch) = cvtpk(y[0], y[1]);
        }
        PROF_END(12);
    }
    __syncthreads();
}

__device__ __forceinline__ void scan_decode(int it, int& b, int& c) { if (it < 256) { b = it >> 6; c = it & 63; } else { b = 4 + ((it - 256) >> 6); c = 63 - ((it - 256) & 63); } }
__device__ __forceinline__ float neg_expm1(float x, float a) {
    float p = -1.0f / 5040.0f; p = p * x - 1.0f / 720.0f; p = p * x - 1.0f / 120.0f; p = p * x - 1.0f / 24.0f; p = p * x - 1.0f / 6.0f; p = p * x - 0.5f; p = p * x - 1.0f;
    float q = p * x, w = 1.0f - a * a; asm volatile("" : "+v"(q), "+v"(w));
    return x > -0.5f ? q : w;
}
__device__ __forceinline__ void gate_math16(const f32x16 pa, const f32x16 pi, float ba, float bi, float c8, f32x16& av, f32x16& bv) {
#pragma unroll
    for (int g4 = 0; g4 < 4; ++g4) {
        const f32x4 pa4 = {pa[4 * g4], pa[4 * g4 + 1], pa[4 * g4 + 2], pa[4 * g4 + 3]}, pi4 = {pi[4 * g4], pi[4 * g4 + 1], pi[4 * g4 + 2], pi[4 * g4 + 3]};
        const f32x4 rg = sigmoid4(pa4 + ba), ig = sigmoid4(pi4 + bi);
        const f32x4 l2 = rg * c8;
        const f32x4 a = {__builtin_amdgcn_exp2f(l2[0]), __builtin_amdgcn_exp2f(l2[1]), __builtin_amdgcn_exp2f(l2[2]), __builtin_amdgcn_exp2f(l2[3])};
        const f32x4 x = l2 * 1.3862943611198906f;
        f32x4 p = x * (-1.0f / 5040.0f) - 1.0f / 720.0f; p = p * x - 1.0f / 120.0f; p = p * x - 1.0f / 24.0f; p = p * x - 1.0f / 6.0f; p = p * x - 0.5f; p = p * x - 1.0f;
        f32x4 q = p * x, w = 1.0f - a * a; asm volatile("" : "+v"(q), "+v"(w));
        f32x4 m2;
#pragma unroll
        for (int e = 0; e < 4; ++e) m2[e] = __builtin_amdgcn_sqrtf(x[e] > -0.5f ? q[e] : w[e]);
        const f32x4 bb = m2 * ig;
#pragma unroll
        for (int e = 0; e < 4; ++e) { av[4 * g4 + e] = a[e]; bv[4 * g4 + e] = bb[e]; }
        __builtin_amdgcn_sched_barrier(0);
    }
}
template <bool FINAL>
__device__ __forceinline__ void mix_scan(LAS unsigned char* lds, const bf16* UX, const bf16* GY, const bf16* WGT, const float* rw, const float* rb, const float* b_a, const float* b_i, const float* lam,
                                         f32x2* TOT, bf16* YMIX, int G, int bx, int lane, int wave) {
    LAS unsigned char* UXT = lds + wave * 16896;
    LAS unsigned char* XRT = UXT + 8704;
    const int h = wave, j = lane & 31, hh = lane >> 5, dg = lane & 7, tg = lane >> 3;
    float c8v[2], bav[2], biv[2];
#pragma unroll
    for (int ec = 0; ec < 2; ++ec) { const int ch = 64 * h + 32 * ec + j; c8v[ec] = -8.0f * 1.4426950408889634f * log1pf(expf(-lam[ch]));   bav[ec] = b_a[ch]; biv[ec] = b_i[ch]; }
    for (int it = bx; it < 512; it += G) {
        asm volatile("" ::: "memory");
        int b, c; scan_decode(it, b, c);
        const size_t mrow0 = (size_t)b * SEQ + 64 * c;
#pragma unroll
        for (int i = 0; i < 9; ++i) { const int row = i * 8 + tg, tok = 64 * c - 3 + row; v4u v = {0u, 0u, 0u, 0u};
            if (row < 67 && tok >= 0) v = *(const v4u*)(UX + ((size_t)b * SEQ + tok) * DR + 64 * h + 8 * dg);
            if (row < 68) *(LAS v4u*)(UXT + row * 128 + dg * 16) = v; }
        pg8::bf16x8 bfr[2][4];
#pragma unroll
        for (int g = 0; g < 2; ++g)
#pragma unroll
            for (int ks = 0; ks < 4; ++ks) bfr[g][ks] = *(const pg8::bf16x8*)(WGT + ((size_t)(h * 128 + 64 * g + j)) * 64 + 16 * ks + 8 * hh);
        v4u gyv[8];
        if (FINAL) {
#pragma unroll
            for (int i = 0; i < 8; ++i) gyv[i] = *(const v4u*)(GY + (mrow0 + i * 8 + tg) * DR + 64 * h + 8 * dg);
        }
        float Hc = 0.f;
        if (FINAL) { const f32x2* tp = TOT + ((size_t)b * 64) * DR + 64 * h + lane; int cc = 0;
            for (; cc + 8 <= c; cc += 8) { f32x2 t8[8];
#pragma unroll
                for (int u = 0; u < 8; ++u) t8[u] = tp[(size_t)(cc + u) * DR];
#pragma unroll
                for (int u = 0; u < 8; ++u) Hc = Hc * t8[u].x + t8[u].y; }
            for (; cc < c; ++cc) { const f32x2 ab = tp[(size_t)cc * DR]; Hc = Hc * ab.x + ab.y; } }
        {
            f32x4 w4a[4], w4b[4];
#pragma unroll
            for (int k = 0; k < 4; ++k) { w4a[k] = *(const f32x4*)(rw + k * DR + 64 * h + 8 * dg); w4b[k] = *(const f32x4*)(rw + k * DR + 64 * h + 8 * dg + 4); }
            const f32x4 rb0 = *(const f32x4*)(rb + 64 * h + 8 * dg), rb1 = *(const f32x4*)(rb + 64 * h + 8 * dg + 4);
#pragma unroll
            for (int th = 0; th < 2; ++th) {
                f32x4 o0[4], o1[4];
#pragma unroll
                for (int t = 0; t < 4; ++t) { o0[t] = rb0; o1[t] = rb1; }
#pragma unroll
                for (int i = 0; i < 7; ++i) { const v4u v = *(const LAS v4u*)(UXT + (8 * tg + 4 * th + i) * 128 + dg * 16);
                    const f32x4 x0 = {bflo(v.x), bfhi(v.x), bflo(v.y), bfhi(v.y)}, x1 = {bflo(v.z), bfhi(v.z), bflo(v.w), bfhi(v.w)};
#pragma unroll
                    for (int k = 0; k < 4; ++k) { const int t = i - k; if (t >= 0 && t < 4) { o0[t] += w4a[k] * x0; o1[t] += w4b[k] * x1; } } }
#pragma unroll
                for (int t = 0; t < 4; ++t) *(LAS v4u*)(XRT + (8 * tg + 4 * th + t) * 128 + dg * 16) = pack8(o0[t], o1[t]);
            }
        }
        if (FINAL) {
#pragma unroll
            for (int i = 0; i < 8; ++i) *(LAS v4u*)(UXT + (i * 8 + tg) * 128 + dg * 16) = gyv[i];
        }
#pragma unroll
        for (int ec = 0; ec < 2; ++ec) {
            const int ch = 64 * h + 32 * ec + j;
            const float c8 = c8v[ec], ba = bav[ec], bi = biv[ec];
            f32x16 av[2], bv[2];
#pragma unroll
            for (int tt = 0; tt < 2; ++tt) {
                pg8::bf16x8 afr[4];
#pragma unroll
                for (int ks = 0; ks < 4; ++ks) afr[ks] = *(const LAS pg8::bf16x8*)(XRT + (32 * tt + j) * 128 + (16 * ks + 8 * hh) * 2);
                f32x16 pa, pi;
#pragma unroll
                for (int r = 0; r < 16; ++r) { pa[r] = 0.f; pi[r] = 0.f; }
#pragma unroll
                for (int ks = 0; ks < 4; ++ks) {
                    pa = __builtin_amdgcn_mfma_f32_32x32x16_bf16(afr[ks], bfr[0][ks], pa, 0, 0, 0);
                    pi = __builtin_amdgcn_mfma_f32_32x32x16_bf16(afr[ks], bfr[1][ks], pi, 0, 0, 0); }
                if (ec == 0 && tt == 1) {
#pragma unroll
                    for (int g = 0; g < 2; ++g)
#pragma unroll
                        for (int ks = 0; ks < 4; ++ks) bfr[g][ks] = *(const pg8::bf16x8*)(WGT + ((size_t)(h * 128 + 64 * g + 32 + j)) * 64 + 16 * ks + 8 * hh);
                }
                gate_math16(pa, pi, ba, bi, c8, av[tt], bv[tt]);
                {
                    f32x16 px;
#pragma unroll
                    for (int r = 0; r < 16; ++r) px[r] = bv[tt][r] * 0.f;
                    int dd = 32 * ec + j - 8 * hh; asm volatile("" : "+v"(dd));
                    const unsigned one = (dd & 1) ? 0x3F800000u : 0x00003F80u;
#pragma unroll
                    for (int ks = 0; ks < 4; ++ks) {
                        const int dw = (dd - 16 * ks) >> 1;
                        v4u idw; idw.x = dw == 0 ? one : 0u; idw.y = dw == 1 ? one : 0u; idw.z = dw == 2 ? one : 0u; idw.w = dw == 3 ? one : 0u;
                        px = __builtin_amdgcn_mfma_f32_32x32x16_bf16(afr[ks], __builtin_bit_cast(pg8::bf16x8, idw), px, 0, 0, 0); }
#pragma unroll
                    for (int r = 0; r < 16; ++r) bv[tt][r] *= px[r];
                }
            }
            float GA[2][4], GB[2][4], PA[2][4], PB[2][4];
#pragma unroll
            for (int tt = 0; tt < 2; ++tt)
#pragma unroll
                for (int q = 0; q < 4; ++q) { const float a0 = av[tt][4 * q], a1 = av[tt][4 * q + 1], a2 = av[tt][4 * q + 2], a3 = av[tt][4 * q + 3];
                    const float b0 = bv[tt][4 * q], b1 = bv[tt][4 * q + 1], b2 = bv[tt][4 * q + 2], b3 = bv[tt][4 * q + 3];
                    GA[tt][q] = (a0 * a1) * (a2 * a3); GB[tt][q] = ((b0 * a1 + b1) * a2 + b2) * a3 + b3;
                    PA[tt][q] = __shfl_xor(GA[tt][q], 32); PB[tt][q] = __shfl_xor(GB[tt][q], 32); }
            if (!FINAL) {
                float At = 1.f, Bt = 0.f;
#pragma unroll
                for (int tt = 0; tt < 2; ++tt)
#pragma unroll
                    for (int q = 0; q < 4; ++q) { const float A0 = hh ? PA[tt][q] : GA[tt][q], B0 = hh ? PB[tt][q] : GB[tt][q], A1 = hh ? GA[tt][q] : PA[tt][q], B1 = hh ? GB[tt][q] : PB[tt][q];
                        Bt = (Bt * A0 + B0) * A1 + B1; At = (At * A0) * A1; }
                if (hh == 0) TOT[((size_t)b * 64 + c) * DR + ch] = (f32x2){At, Bt};
            } else {
                float hc = __shfl(Hc, 32 * ec + j);
#pragma unroll
                for (int tt = 0; tt < 2; ++tt)
#pragma unroll
                    for (int q = 0; q < 4; ++q) { const float A0 = hh ? PA[tt][q] : GA[tt][q], B0 = hh ? PB[tt][q] : GB[tt][q], A1 = hh ? GA[tt][q] : PA[tt][q], B1 = hh ? GB[tt][q] : PB[tt][q];
                        const float mid = hc * A0 + B0; float hv = hh ? mid : hc; hc = mid * A1 + B1;
#pragma unroll
                        for (int i = 0; i < 4; ++i) { hv = av[tt][4 * q + i] * hv + bv[tt][4 * q + i]; av[tt][4 * q + i] = hv; } }
#pragma unroll
                for (int tt = 0; tt < 2; ++tt)
#pragma unroll
                    for (int r = 0; r < 16; ++r) { const int tk = 32 * tt + (r & 3) + 8 * (r >> 2) + 4 * hh;
                        LAS u16* p = (LAS u16*)(UXT + tk * 128 + (32 * ec + j) * 2);
                        const float gy = __uint_as_float((unsigned)(*p) << 16);
                        *p = (u16)f2bf(gy * av[tt][r]); }
            }
        }
        if (FINAL) {
#pragma unroll
            for (int i = 0; i < 8; ++i) { const int row = i * 8 + tg; *(v4u*)(YMIX + (mrow0 + row) * D + DC + 64 * h + 8 * dg) = *(const LAS v4u*)(UXT + row * 128 + dg * 16); }
        }
    }
    __syncthreads();
}

#ifndef FOLD_B
#define FOLD_B 4
#endif
__device__ __forceinline__ void fold_chunks(const gu64* tp, int c0, int c1, int hh, float& A, float& B) {
    const int mid = (c0 + c1 + 1) >> 1, lo = hh ? mid : c0, hi2 = hh ? c1 : mid;
    float Ar = 1.f, Br = 0.f;
    for (int cc = lo; cc < hi2; cc += FOLD_B) { unsigned long long t8[FOLD_B];
        for (unsigned sp = 0;; ++sp) { unsigned all = 0x80000000u;
#pragma unroll
            for (int u = 0; u < FOLD_B; ++u) t8[u] = __hip_atomic_load(tp + (size_t)(cc + u < 63 ? cc + u : 63) * DR, RLX_AGENT);
#pragma unroll
            for (int u = 0; u < FOLD_B; ++u) all &= (cc + u < hi2) ? (unsigned)t8[u] : 0x80000000u;
            if (all || sp > (1u << 16)) break;
            __builtin_amdgcn_s_sleep(1); }
#pragma unroll
        for (int u = 0; u < FOLD_B; ++u) { const bool ok = cc + u < hi2; const float ta = ok ? __uint_as_float((unsigned)t8[u] & 0x7fffffffu) : 1.f, tb = ok ? __uint_as_float((unsigned)(t8[u] >> 32)) : 0.f; Br = Br * ta + tb; Ar = Ar * ta; } }
    const float Ap = __shfl_xor(Ar, 32), Bp = __shfl_xor(Br, 32);
    A = Ar * Ap; B = hh ? (Bp * Ar + Br) : (Br * Ap + Bp);
}
__device__ __forceinline__ void mix_scan1(LAS unsigned char* lds, const bf16* UX, const bf16* GY, const bf16* WGT, const float* rw, const float* rb, const float* b_a, const float* b_i, const float* lam,
                                          f32x2* TOT, unsigned* cnt, bf16* YMIX, int G, int bx, int lane, int wave) {
    LAS unsigned char* UXT = lds + wave * 16896;
    LAS unsigned char* XRT = UXT + 8704;
    f32x2* TOTH = (f32x2*)((unsigned char*)TOT + (WS_TOTH - WS_TOT));
    const int h = wave, j = lane & 31, hh = lane >> 5, dg = lane & 7, tg = lane >> 3;
    const int gs = G >> 3, b = bx / gs, idx = bx - b * gs;
    float c8v[2], bav[2], biv[2];
#pragma unroll
    for (int ec = 0; ec < 2; ++ec) { const int ch = 64 * h + 32 * ec + j; c8v[ec] = -8.0f * 1.4426950408889634f * log1pf(expf(-lam[ch])); bav[ec] = b_a[ch]; biv[ec] = b_i[ch]; }
    for (int c = idx, round = 0; c < 64; c += gs, ++round) {
        asm volatile("" ::: "memory");
        PROF_BEGIN(3);
        const size_t mrow0 = (size_t)b * SEQ + 64 * c;
#pragma unroll
        for (int i = 0; i < 9; ++i) { const int row = i * 8 + tg, tok = 64 * c - 3 + row; v4u v = {0u, 0u, 0u, 0u};
            if (row < 67 && tok >= 0) v = *(const v4u*)(UX + ((size_t)b * SEQ + tok) * DR + 64 * h + 8 * dg);
            if (row < 68) *(LAS v4u*)(UXT + row * 128 + dg * 16) = v; }
        pg8::bf16x8 bfr[2][4];
#pragma unroll
        for (int g = 0; g < 2; ++g)
#pragma unroll
            for (int ks = 0; ks < 4; ++ks) bfr[g][ks] = *(const pg8::bf16x8*)(WGT + ((size_t)(h * 128 + 64 * g + j)) * 64 + 16 * ks + 8 * hh);
        {
            f32x4 w4a[4], w4b[4];
#pragma unroll
            for (int k = 0; k < 4; ++k) { w4a[k] = *(const f32x4*)(rw + k * DR + 64 * h + 8 * dg); w4b[k] = *(const f32x4*)(rw + k * DR + 64 * h + 8 * dg + 4); }
            const f32x4 rb0 = *(const f32x4*)(rb + 64 * h + 8 * dg), rb1 = *(const f32x4*)(rb + 64 * h + 8 * dg + 4);
#pragma unroll
            for (int th = 0; th < 2; ++th) {
                f32x4 o0[4], o1[4];
#pragma unroll
                for (int t = 0; t < 4; ++t) { o0[t] = rb0; o1[t] = rb1; }
#pragma unroll
                for (int i = 0; i < 7; ++i) { const v4u v = *(const LAS v4u*)(UXT + (8 * tg + 4 * th + i) * 128 + dg * 16);
                    const f32x4 x0 = {bflo(v.x), bfhi(v.x), bflo(v.y), bfhi(v.y)}, x1 = {bflo(v.z), bfhi(v.z), bflo(v.w), bfhi(v.w)};
#pragma unroll
                    for (int k = 0; k < 4; ++k) { const int t = i - k; if (t >= 0 && t < 4) { o0[t] += w4a[k] * x0; o1[t] += w4b[k] * x1; } } }
#pragma unroll
                for (int t = 0; t < 4; ++t) *(LAS v4u*)(XRT + (8 * tg + 4 * th + t) * 128 + dg * 16) = pack8(o0[t], o1[t]);
            }
        }
        PROF_END(3);
#pragma unroll
        for (int ec = 0; ec < 2; ++ec) {
            PROF_BEGIN(4);
            const int ch = 64 * h + 32 * ec + j;
            const float c8 = c8v[ec], ba = bav[ec], bi = biv[ec];
            unsigned* cw = cnt + 64 * (8 * ec + b);
            f32x16 av[2], bv[2];
#pragma unroll
            for (int tt = 0; tt < 2; ++tt) {
                pg8::bf16x8 afr[4];
#pragma unroll
                for (int ks = 0; ks < 4; ++ks) afr[ks] = *(const LAS pg8::bf16x8*)(XRT + (32 * tt + j) * 128 + (16 * ks + 8 * hh) * 2);
                f32x16 pa, pi;
#pragma unroll
                for (int r = 0; r < 16; ++r) { pa[r] = 0.f; pi[r] = 0.f; }
#pragma unroll
                for (int ks = 0; ks < 4; ++ks) {
                    pa = __builtin_amdgcn_mfma_f32_32x32x16_bf16(afr[ks], bfr[0][ks], pa, 0, 0, 0);
                    pi = __builtin_amdgcn_mfma_f32_32x32x16_bf16(afr[ks], bfr[1][ks], pi, 0, 0, 0); }
                if (ec == 0 && tt == 1) {
#pragma unroll
                    for (int g = 0; g < 2; ++g)
#pragma unroll
                        for (int ks = 0; ks < 4; ++ks) bfr[g][ks] = *(const pg8::bf16x8*)(WGT + ((size_t)(h * 128 + 64 * g + 32 + j)) * 64 + 16 * ks + 8 * hh);
                }
                gate_math16(pa, pi, ba, bi, c8, av[tt], bv[tt]);
                {
                    f32x16 px;
#pragma unroll
                    for (int r = 0; r < 16; ++r) px[r] = bv[tt][r] * 0.f;
                    int dd = 32 * ec + j - 8 * hh; asm volatile("" : "+v"(dd));
                    const unsigned one = (dd & 1) ? 0x3F800000u : 0x00003F80u;
#pragma unroll
                    for (int ks = 0; ks < 4; ++ks) {
                        const int dw = (dd - 16 * ks) >> 1;
                        v4u idw; idw.x = dw == 0 ? one : 0u; idw.y = dw == 1 ? one : 0u; idw.z = dw == 2 ? one : 0u; idw.w = dw == 3 ? one : 0u;
                        px = __builtin_amdgcn_mfma_f32_32x32x16_bf16(afr[ks], __builtin_bit_cast(pg8::bf16x8, idw), px, 0, 0, 0); }
#pragma unroll
                    for (int r = 0; r < 16; ++r) bv[tt][r] *= px[r];
                }
            }
            float GA[2][4], GB[2][4], PA[2][4], PB[2][4];
            float At = 1.f, Bt = 0.f;
#pragma unroll
            for (int tt = 0; tt < 2; ++tt)
#pragma unroll
                for (int q = 0; q < 4; ++q) { const float a0 = av[tt][4 * q], a1 = av[tt][4 * q + 1], a2 = av[tt][4 * q + 2], a3 = av[tt][4 * q + 3];
                    const float b0 = bv[tt][4 * q], b1 = bv[tt][4 * q + 1], b2 = bv[tt][4 * q + 2], b3 = bv[tt][4 * q + 3];
                    GA[tt][q] = (a0 * a1) * (a2 * a3); GB[tt][q] = ((b0 * a1 + b1) * a2 + b2) * a3 + b3;
                    PA[tt][q] = __shfl_xor(GA[tt][q], 32); PB[tt][q] = __shfl_xor(GB[tt][q], 32);
                    const float A0 = hh ? PA[tt][q] : GA[tt][q], B0 = hh ? PB[tt][q] : GB[tt][q], A1 = hh ? GA[tt][q] : PA[tt][q], B1 = hh ? GB[tt][q] : PB[tt][q];
                    Bt = (Bt * A0 + B0) * A1 + B1; At = (At * A0) * A1; }
            if (hh == 0) __hip_atomic_store((gu64*)(TOT + ((size_t)b * 64 + c) * DR + ch), ((unsigned long long)__float_as_uint(Bt) << 32) | (__float_as_uint(At) | 0x80000000u), RLX_AGENT);
            PROF_END(4); PROF_BEGIN(7);
            if (ec == 0) {
#pragma unroll
                for (int i = 0; i < 8; ++i) *(LAS v4u*)(UXT + (i * 8 + tg) * 128 + dg * 16) = *(const v4u*)(GY + (mrow0 + i * 8 + tg) * DR + 64 * h + 8 * dg);
            }
            PROF_END(7);
            PROF_BEGIN(2);
            const gu64* tp = (const gu64*)(TOT + ((size_t)b * 64) * DR + ch);
            float hc;
            { const int cpre = round * gs < c ? round * gs : c;
                float Hp = 0.f;
                gu64* hp = (gu64*)(TOTH + ((size_t)b * 8 + (round > 0 ? round - 1 : 0)) * DR + ch);
                if (round > 0) { unsigned long long t = 0; for (unsigned sp = 0;; ++sp) { t = __hip_atomic_load(hp, RLX_AGENT); if ((unsigned)(t >> 32) || sp > (1u << 16)) break; __builtin_amdgcn_s_sleep(1); } Hp = __uint_as_float((unsigned)t); }
                float Aq, Bq; fold_chunks(tp, cpre, c, hh, Aq, Bq); hc = Hp * Aq + Bq; }
            PROF_END(2); PROF_BEGIN(5);
#pragma unroll
            for (int tt = 0; tt < 2; ++tt)
#pragma unroll
                for (int q = 0; q < 4; ++q) { const float A0 = hh ? PA[tt][q] : GA[tt][q], B0 = hh ? PB[tt][q] : GB[tt][q], A1 = hh ? GA[tt][q] : PA[tt][q], B1 = hh ? GB[tt][q] : PB[tt][q];
                    const float mid = hc * A0 + B0; float hv = hh ? mid : hc; hc = mid * A1 + B1;
#pragma unroll
                    for (int i = 0; i < 4; ++i) { hv = av[tt][4 * q + i] * hv + bv[tt][4 * q + i]; av[tt][4 * q + i] = hv; } }
            if (idx == gs - 1 && round < 8 && hh == 0) __hip_atomic_store((gu64*)(TOTH + ((size_t)b * 8 + round) * DR + ch), (0x80000000ull << 32) | __float_as_uint(hc), RLX_AGENT);
#pragma unroll
            for (int tt = 0; tt < 2; ++tt)
#pragma unroll
                for (int r = 0; r < 16; ++r) { const int tk = 32 * tt + (r & 3) + 8 * (r >> 2) + 4 * hh;
                    LAS u16* p = (LAS u16*)(UXT + tk * 128 + (32 * ec + j) * 2);
                    const float gy = __uint_as_float((unsigned)(*p) << 16);
                    *p = (u16)f2bf(gy * av[tt][r]); }
            PROF_END(5);
        }
        PROF_BEGIN(6);
#pragma unroll
        for (int i = 0; i < 8; ++i) { const int row = i * 8 + tg; *(v4u*)(YMIX + (mrow0 + row) * D + DC + 64 * h + 8 * dg) = *(const LAS v4u*)(UXT + row * 128 + dg * 16); }
        PROF_END(6);
    }
    __syncthreads();
}

struct Args { const float* in[27]; float* out; unsigned char* ws; int ph_lo, ph_hi; };
constexpr int NPH = 10;
#ifndef MK_PER_PHASE
#define MK_PER_PHASE 0
#endif
#define MK_STR2(x) #x
#define MK_STR(x) MK_STR2(x)
#ifndef MK_REP_P1X
#define MK_REP_P1X 1
#endif
#ifndef MK_REP_P1B
#define MK_REP_P1B 1
#endif
#ifndef MK_REP_GEMV
#define MK_REP_GEMV 1
#endif
#ifndef MK_REP_QUANT
#define MK_REP_QUANT 1
#endif
#ifndef MK_REP_TRANS
#define MK_REP_TRANS 1
#endif
#ifndef MK_REP_LO
#define MK_REP_LO 0
#define MK_REP_HI 0
#endif

__global__ void __launch_bounds__(NWAVES * 64, 2) mk_fwd(Args args) {
    extern __shared__ __attribute__((aligned(16))) unsigned char lds_raw[];
    LAS unsigned char* lds = (LAS unsigned char*)lds_raw;
    const int tid = threadIdx.x, wave = __builtin_amdgcn_readfirstlane(tid >> 6);
#define LANE_HERE int lane; asm volatile("v_mbcnt_lo_u32_b32 %0, -1, 0\n\tv_mbcnt_hi_u32_b32 %0, -1, %0" : "=v"(lane))
    const int G = gridDim.x, bx = blockIdx.x;
    const int vcu = (G % 8 == 0) ? (bx % 8) * (G / 8) + bx / 8 : bx;
    const int gw = vcu * NWAVES + wave, NGW = G * NWAVES;
    unsigned char* ws = args.ws;
    gu32* ctl = (gu32*)(ws + WS_CTL);
    const float* x = args.in[0]; const float* cvec = args.in[1]; const float* w_mod = args.in[2]; const float* b_mod = args.in[3];
    const float* g1 = args.in[4]; const float* w1i = args.in[5]; const float* w1o = args.in[6]; const float* gm = args.in[7];
    const float* w_in = args.in[8]; const float* conv_w = args.in[9]; const float* conv_b = args.in[10]; const float* ln_g = args.in[11]; const float* ln_b = args.in[12];
    const float* rw = args.in[13]; const float* rb = args.in[14]; const float* wa = args.in[15]; const float* b_a = args.in[16];
    const float* wi = args.in[17]; const float* b_i = args.in[18]; const float* lam = args.in[19]; const float* w_out = args.in[20];
    const float* g2 = args.in[21]; const float* w2i = args.in[22]; const float* w2o = args.in[23]; const float* w_fmod = args.in[24];
    const float* b_fmod = args.in[25]; const float* gf = args.in[26];
    float* out = args.out;
    float* MOD = (float*)(ws + WS_MOD); float* SHMAX3 = (float*)(ws + WS_BIAS1); float* BIAS2 = (float*)(ws + WS_BIAS2);
    bf16* WGT = (bf16*)(ws + WS_WGT); f32x2* TOT = (f32x2*)(ws + WS_TOT); float* SSP = (float*)(ws + WS_SSP);
    bf16 *W1O = (bf16*)(ws + WS_W1O), *WIN = (bf16*)(ws + WS_WIN), *WOUT = (bf16*)(ws + WS_WOUT), *W2O = (bf16*)(ws + WS_W2O);
    unsigned char *W1O8F = ws + WS_W1O, *W2O8F = ws + WS_W2O, *W1I8 = ws + WS_W1I, *W2I8 = ws + WS_W2I, *WIN8 = ws + WS_WIN, *A8 = ws + WS_Y;
    float *CS1 = (float*)(ws + WS_CS1), *CS3 = (float*)(ws + WS_CS3), *CS2 = (float*)(ws + WS_CS2), *RS1 = (float*)(ws + WS_RS1), *RS3 = (float*)(ws + WS_RS3), *RS2 = (float*)(ws + WS_RS2);
    bf16 *Y = (bf16*)(ws + WS_Y), *ACT = (bf16*)(ws + WS_ACT), *U = (bf16*)(ws + WS_U), *UXB = (bf16*)(ws + WS_UX), *GYB = (bf16*)(ws + WS_GY), *YMIX = (bf16*)(ws + WS_YMIX);
    bf16* X1 = (bf16*)(ws + WS_X1);

    for (int u = tid; u < (LDS_BYTES - LDSCTL_OFF) / 4; u += NWAVES * 64) ((LAS unsigned*)(lds + LDSCTL_OFF))[u] = 0u;
    __syncthreads();
    const int lo = args.ph_lo, hi = args.ph_hi;
    const bool use_bar = (hi - lo) > 1;
    XcdBarrier bar; bar.bar = (unsigned*)(ctl + CW_BAR); bar.x = 0; bar.st = nullptr;
    if (use_bar) bar = xcd_barrier_post((unsigned*)(ctl + CW_BAR), (volatile LAS unsigned*)(lds + LDSCTL_OFF) + 8);
#define IN(k) (lo <= (k) && (k) < hi)
#define REPS(k) ((MK_REP_LO <= (k) && (k) < MK_REP_HI) ? 2 : 1)
#define AGAIN(k, rr) do { if ((rr) + 1 < REPS(k)) xcd_barrier(bar); } while (0)
#define SEAM(k) do { if (IN(k) && IN((k) + 1)) { PROF_BEGIN(8); PROF_BEGIN(9); xcd_barrier(bar); PROF_END(8); if ((k) == MK_PROF_SEAM) { PROF_END(9); } } } while (0)

    if (IN(0))
_Pragma("unroll")
    for (int rr = 0; rr < REPS(0); ++rr) { PROF_SETPH(0); PROF_BEGIN(15); LANE_HERE;
#ifdef MK_PAD
        asm volatile(".rept " MK_STR(MK_PAD) "\n\ts_nop 0\n\t.endr" ::: "memory");
#endif
        constexpr int NGEMV = 88, NQ = 2 * (FF2 / 32);
        constexpr int I_1O = (FF / 64) * (D / 32), I_IN = (D / 64) * (NMIX / 32), I_OUT = (D / 64) * (D / 32);
        constexpr int NITEMS = 2 * I_1O + I_IN + I_OUT, NGRP = NITEMS / NWAVES;
        static_assert(NITEMS % NWAVES == 0, "transpose groups");
        auto quant = [&](int it) { if (it < FF2 / 32) p0_quant_item(lds, w1i, FF2, 1, W1I8, CS1, it, lane, wave); else p0_quant_item(lds, w2i, FF2, 1, W2I8, CS3, it - FF2 / 32, lane, wave); };
        auto group = [&](int gidx) { LAS float* scr = (LAS float*)(lds + wave * 16384); const int r = gidx * NWAVES + wave;
            if (r < I_1O) p0_transpose8_item(w1o, FF, D, W1O8F, scr, r, lane);
            else if (r < 2 * I_1O) p0_transpose8_item(w2o, FF, D, W2O8F, scr, r - I_1O, lane);
            else if (r < 2 * I_1O + I_IN) p0_transpose_item(w_in, D, NMIX, WIN, 2, scr, r - 2 * I_1O, lane);
            else p0_transpose_item(w_out, D, D, WOUT, 0, scr, r - 2 * I_1O - I_IN, lane); };
        if (G == 256) {
            if (bx < NGEMV) {
                if (bx < 72) p0_gemv(lds, cvec, w_mod, 9 * D, b_mod, MOD, 128 * bx, tid); else p0_gemv(lds, cvec, w_fmod, 2 * D, b_fmod, MOD + 9 * D, 128 * (bx - 72), tid);
                quant(bx);
            } else { const int j = bx - NGEMV;
                quant(NGEMV + j);
                if (j < 96) { quant(256 + j); group(2 * j); group(2 * j + 1); }
                else { const int g0 = 192 + 5 * (j - 96);
                    for (int q = 0; q < 5; ++q) if (g0 + q < NGRP) group(g0 + q); }
            }
        } else {
            for (int t = bx; t < NGEMV; t += G) { if (t < 72) p0_gemv(lds, cvec, w_mod, 9 * D, b_mod, MOD, 128 * t, tid); else p0_gemv(lds, cvec, w_fmod, 2 * D, b_fmod, MOD + 9 * D, 128 * (t - 72), tid); }
            for (int t = bx; t < NQ; t += G) quant(t);
            for (int t = bx; t < NGRP; t += G) group(t);
        }
        __syncthreads();
        for (int i = bx * 512 + tid; i < NB * 64 * DR / 2; i += G * 512) ((v4u*)TOT)[i] = (v4u){0u, 0u, 0u, 0u};
        for (int i = bx * 512 + tid; i < NB * 8 * DR / 2; i += G * 512) ((v4u*)(ws + WS_TOTH))[i] = (v4u){0u, 0u, 0u, 0u};
        for (int i = bx * 512 + tid; i < NH * 128 * HD; i += G * 512) { const int d = i & 63, e2 = (i >> 6) & 127, hd = i >> 13;
            const float v = e2 < 64 ? wa[(hd * 64 + d) * 64 + e2] : wi[(hd * 64 + d) * 64 + (e2 - 64)]; WGT[i] = (bf16)f2bf(v); }
        PROF_END_PH(15);
        AGAIN(0, rr);
    }
    SEAM(0);
    if (IN(1))
_Pragma("unroll")
    for (int rr = 0; rr < REPS(1); ++rr) { PROF_SETPH(1); PROF_BEGIN(15); LANE_HERE;
        LAS float* shl = (LAS float*)lds;
        for (int i = tid * 4; i < 3 * NB * D; i += 2048) { const int t = i >> 13, r = i & 8191, b = r >> 10, k = r & 1023; *(LAS f32x4*)(shl + i) = *(const f32x4*)(MOD + (size_t)b * LDM + 3 * t * D + k); }
        __syncthreads();
        for (int rp = 0; rp < MK_REP_P1X; ++rp)
        for (int m0 = gw; m0 < M; m0 += 2 * NGW) {
            f32x4 v[2][4];
#pragma unroll
            for (int rr2 = 0; rr2 < 2; ++rr2) { const int m = (m0 + rr2 * NGW < M) ? m0 + rr2 * NGW : m0; const f32x4* xr = (const f32x4*)(x + (size_t)m * D) + lane;
#pragma unroll
                for (int jj = 0; jj < 4; ++jj) v[rr2][jj] = xr[64 * jj]; }
#pragma unroll
            for (int rr2 = 0; rr2 < 2; ++rr2) { const int m = m0 + rr2 * NGW; if (m < M) { const int b = m >> 12;
                float s = 0.f, am = 0.f;
#pragma unroll
                for (int jj = 0; jj < 4; ++jj) s += (v[rr2][jj][0] * v[rr2][jj][0] + v[rr2][jj][1] * v[rr2][jj][1]) + (v[rr2][jj][2] * v[rr2][jj][2] + v[rr2][jj][3] * v[rr2][jj][3]);
                const float rstd = rsqrtf(wave_sum(s) * (1.0f / D) + EPS);
#pragma unroll
                for (int jj = 0; jj < 4; ++jj) { const int k = 4 * lane + 256 * jj;
                    v[rr2][jj] = v[rr2][jj] * (*(const f32x4*)(g1 + k) * (*(const f32x4*)(MOD + (size_t)b * LDM + 1 * D + k) + 1.0f) * rstd) + *(const LAS f32x4*)(shl + (0 * NB + b) * D + k);
                    const f32x4 t = __builtin_elementwise_abs(v[rr2][jj]); am = fmaxf(am, fmaxf(fmaxf(t[0], t[1]), fmaxf(t[2], t[3]))); }
                am = wave_max(am);
                const float q = am > 0.f ? 127.0f / am : 0.f;
#pragma unroll
                for (int jj = 0; jj < 4; ++jj) *(unsigned*)(A8 + (size_t)m * D + 4 * lane + 256 * jj) = q8x4(v[rr2][jj] * q);
                if (lane == 0) RS1[m] = am * (1.0f / 127.0f); } }
        }
        for (int rp = 0; rp < MK_REP_P1B; ++rp)
        if (gw < NB) { float a = 0.f;
            for (int k = lane; k < D; k += 64) a = fmaxf(a, fabsf(shl[(2 * NB + gw) * D + k]));
            a = wave_max(a); if (lane == 0) SHMAX3[gw] = a; }
        for (int it = gw; it < NMIX; it += NGW) {
            {
                const bf16* wrow = WIN + (size_t)it * D; float* op = BIAS2 + it;
                const v4u wA = *(const v4u*)(wrow + 8 * lane), wB = *(const v4u*)(wrow + 512 + 8 * lane);
                f32x4 a0, a1, c0, c1; unpack8(wA, a0, a1); unpack8(wB, c0, c1);
#pragma unroll
                for (int b = 0; b < NB; ++b) { const LAS float* sp = shl + (1 * NB + b) * D + 8 * lane;
                    const f32x4 p = a0 * *(const LAS f32x4*)(sp) + a1 * *(const LAS f32x4*)(sp + 4) + c0 * *(const LAS f32x4*)(sp + 512) + c1 * *(const LAS f32x4*)(sp + 516);
                    const float tot = wave_sum((p[0] + p[1]) + (p[2] + p[3]));
                    if (lane == 0) op[(size_t)b * NMIX] = tot; }
            }
        }
        __syncthreads();
        PROF_END_PH(15);
        AGAIN(1, rr);
    }
    SEAM(1);
    if (IN(2))
_Pragma("unroll")
    for (int rr = 0; rr < REPS(2); ++rr) { PROF_SETPH(2); PROF_BEGIN(15);
        pg8::Gemm g{(const pg8::bf16_t*)A8, (const pg8::bf16_t*)W1I8, M, FF2, D / 2}; pg8::StaticOrder S; S.init(M, FF2, G, bx);
        EpiSwiglu8<true> E{ACT, RS1, CS1};
        pg8::gemm_phase<EpiSwiglu8<true>, pg8::StaticOrder, true, true, 1>(lds, g, S, E);
        PROF_END_PH(15);
        AGAIN(2, rr);
    }
    SEAM(2);
    if (IN(3))
_Pragma("unroll")
    for (int rr = 0; rr < REPS(3); ++rr) { PROF_SETPH(3); PROF_BEGIN(15);
        pg8::Gemm g{ACT, (const pg8::bf16_t*)W1O8F, M, D, FF / 2}; pg8::StaticOrder S; S.init(M, D, G, bx);
        EpiResid<1, true, false, true> E{x, X1, Y, SSP, MOD + 2 * D, gm, MOD + 4 * D};
        pg8::gemm_phase<EpiResid<1, true, false, true>, pg8::StaticOrder, true, true, 2>(lds, g, S, E);
        PROF_END_PH(15);
        AGAIN(3, rr);
    }
    SEAM(3);
    if (IN(4))
_Pragma("unroll")
    for (int rr = 0; rr < REPS(4); ++rr) { PROF_SETPH(4); PROF_BEGIN(15);
        pg8::Gemm g{Y, WIN, M, NMIX, D}; pg8::StaticOrder S; S.init(M, NMIX, G, bx);
        EpiMixIn E{U, UXB, GYB, SSP, BIAS2};
        pg8::gemm_phase<EpiMixIn, pg8::StaticOrder, true, true>(lds, g, S, E);
        PROF_END_PH(15);
        AGAIN(4, rr);
    }
    SEAM(4);
    if (IN(5))
_Pragma("unroll")
    for (int rr = 0; rr < REPS(5); ++rr) { PROF_SETPH(5); PROF_BEGIN(15); LANE_HERE;
        { PROF_BEGIN(0); mix_conv2(lds, U, conv_w, conv_b, ln_g, ln_b, YMIX, G, bx, tid, lane, wave); PROF_END(0); }
#ifdef MK_REP_CONV
        mix_conv2(lds, U, conv_w, conv_b, ln_g, ln_b, YMIX, G, bx, tid, lane, wave);
#endif
        { PROF_BEGIN(1); mix_scan1(lds, UXB, GYB, WGT, rw, rb, b_a, b_i, lam, TOT, (unsigned*)(ctl + CW_SCAN), YMIX, G, bx, lane, wave); PROF_END(1); }
        PROF_END_PH(15);
        AGAIN(5, rr);
    }
    SEAM(5);
    if (IN(7))
_Pragma("unroll")
    for (int rr = 0; rr < REPS(7); ++rr) { PROF_SETPH(7); PROF_BEGIN(15);
        pg8::Gemm g{YMIX, WOUT, M, D, D}; pg8::StaticOrder S; S.init(M, D, G, bx);
        EpiResidQ<0, true> E{X1, X1, A8, RS3, (f32x2*)(ws + WS_SSPX), MOD + 5 * D, g2, MOD + 7 * D, MOD + 6 * D, SHMAX3, (unsigned*)(ctl + CW_SEAM7)};
        pg8::gemm_phase<EpiResidQ<0, true>, pg8::StaticOrder, true, true>(lds, g, S, E);
        PROF_END_PH(15);
        AGAIN(7, rr);
    }
    SEAM(7);
    if (IN(8))
_Pragma("unroll")
    for (int rr = 0; rr < REPS(8); ++rr) { PROF_SETPH(8); PROF_BEGIN(15);
        pg8::Gemm g{(const pg8::bf16_t*)A8, (const pg8::bf16_t*)W2I8, M, FF2, D / 2}; pg8::StaticOrder S; S.init(M, FF2, G, bx);
        EpiSwiglu8<true> E{ACT, RS3, CS3};
        pg8::gemm_phase<EpiSwiglu8<true>, pg8::StaticOrder, true, true, 1>(lds, g, S, E);
        PROF_END_PH(15);
        AGAIN(8, rr);
    }
    SEAM(8);
    if (IN(9))
_Pragma("unroll")
    for (int rr = 0; rr < REPS(9); ++rr) { PROF_SETPH(9); PROF_BEGIN(15);
        pg8::Gemm g{ACT, (const pg8::bf16_t*)W2O8F, M, D, FF / 2}; pg8::StaticOrder S; S.init(M, D, G, bx);
        EpiResidFinal<true> E{X1, out, (float*)(ws + WS_SSPF), MOD + 8 * D, gf, MOD + 10 * D, MOD + 9 * D, (unsigned*)(ctl + CW_SEAM)};
        pg8::gemm_phase<EpiResidFinal<true>, pg8::StaticOrder, true, true, 2>(lds, g, S, E);
        PROF_END_PH(15);
    }
#ifdef MK_PROF_ID
    __syncthreads();
    if (bx == MK_PROF_WG && tid == 0) { const unsigned d = ((LAS unsigned*)(lds + LDSCTL_OFF))[40 + MK_PROF_ID]; const unsigned long long t0 = PROF_T(); while (PROF_T() - t0 < (unsigned long long)d * MK_PROF_K) __builtin_amdgcn_s_sleep(8); }
#endif
#undef IN
#undef SEAM
#undef REPS
#undef AGAIN
}

extern "C" void kernel_launch(void* const* d_in, const int* in_sizes, int n_in, void* d_out, int out_size, void* d_ws, size_t ws_size, hipStream_t stream) {
    static int grid = 0;
    if (grid == 0) {
        if (n_in != 27 || in_sizes[0] != M * D || out_size != M * D || ws_size < WS_END) { fprintf(stderr, "kernel_launch: unexpected shapes (n_in %d, in0 %d, out %d, ws %zu)\n", n_in, n_in > 0 ? in_sizes[0] : -1, out_size, ws_size); grid = -1; return; }
        int dev = 0, cus = 0, per_cu = 0;
        if (hipGetDevice(&dev) != hipSuccess || hipDeviceGetAttribute(&cus, hipDeviceAttributeMultiprocessorCount, dev) != hipSuccess) { grid = -1; return; }
        if (hipFuncSetAttribute((const void*)mk_fwd, hipFuncAttributeMaxDynamicSharedMemorySize, LDS_BYTES) != hipSuccess) { fprintf(stderr, "kernel_launch: hipFuncSetAttribute failed\n"); grid = -1; return; }
        if (hipOccupancyMaxActiveBlocksPerMultiprocessor(&per_cu, (const void*)mk_fwd, NWAVES * 64, LDS_BYTES) != hipSuccess || per_cu < 1) fprintf(stderr, "kernel_launch: occupancy query reports %d blocks per CU\n", per_cu);
        (void)hipGetLastError();
        grid = cus;
        if (grid % 8 != 0 || grid < 8) { fprintf(stderr, "kernel_launch: %d CUs: the scan's chunk rounds need a multiple of 8 workgroups\n", grid); grid = -1; return; }
    }
    if (grid < 0) return;
    if (hipMemsetAsync((char*)d_ws + WS_CTL, 0, CTL_ZERO_BYTES, stream) != hipSuccess) return;
    Args a{};
    for (int i = 0; i < 27; ++i) a.in[i] = (const float*)d_in[i];
    a.out = (float*)d_out; a.ws = (unsigned char*)d_ws;
#if MK_PER_PHASE
    for (int p = 0; p < NPH; ++p) { a.ph_lo = p; a.ph_hi = p + 1; hipLaunchKernelGGL(mk_fwd, dim3(grid), dim3(NWAVES * 64), LDS_BYTES, stream, a); }
#else
    a.ph_lo = 0; a.ph_hi = NPH; hipLaunchKernelGGL(mk_fwd, dim3(grid), dim3(NWAVES * 64), LDS_BYTES, stream, a);
#endif
}
```

```cpp
#include <hip/hip_runtime.h>
#include <cstdio>
#include <cstdint>
#ifndef MK_PROF_SEAM
#define MK_PROF_SEAM 99
#endif
#ifndef MK_PROF_PH
#define MK_PROF_PH 99
#endif
#ifdef MK_PROF_ID
#define PROF_W(i) ((__attribute__((address_space(3))) unsigned*)(unsigned)(147200) + (i))
#define PROF_T() __builtin_amdgcn_s_memrealtime()
#define PROF_BEGIN(id) do { if ((id) == MK_PROF_ID && threadIdx.x == 0) *PROF_W(10 + (id)) = (unsigned)PROF_T(); } while (0)
#define PROF_END(id) do { if ((id) == MK_PROF_ID && threadIdx.x == 0) *PROF_W(40 + (id)) += (unsigned)PROF_T() - *PROF_W(10 + (id)); } while (0)
#define PROF_SETPH(k) do { if ((MK_PROF_ID == 15 || MK_PROF_ID == 16) && threadIdx.x == 0) *PROF_W(39) = (k); } while (0)
#define PROF_END_PH(id) do { if ((id) == MK_PROF_ID && threadIdx.x == 0 && *PROF_W(39) == MK_PROF_PH) *PROF_W(40 + (id)) += (unsigned)PROF_T() - *PROF_W(10 + (id)); } while (0)
#else
#define PROF_BEGIN(id)
#define PROF_END(id)
#define PROF_SETPH(k)
#define PROF_END_PH(id)
#endif
#if defined(MK_PROF_ID) && MK_PROF_ID == 16
#define PROF16_DECL unsigned long long _p16t = 0; unsigned _p16a = 0
#define PROF16_BEGIN _p16t = PROF_T()
#define PROF16_END _p16a += (unsigned)(PROF_T() - _p16t)
#define PROF16_FLUSH do { if (threadIdx.x == 0 && *PROF_W(39) == MK_PROF_PH) *PROF_W(40 + 16) += _p16a; } while (0)
#else
#define PROF16_DECL
#define PROF16_BEGIN
#define PROF16_END
#define PROF16_FLUSH
#endif
namespace pg8 {
#define PG8_LAS __attribute__((address_space(3)))
typedef unsigned short bf16_t;
typedef short bf16x8 __attribute__((ext_vector_type(8)));
typedef float f32x4 __attribute__((ext_vector_type(4)));
typedef unsigned u32x4 __attribute__((ext_vector_type(4)));
constexpr int BM = 256, BK = 64, HALF = 128, HTB = HALF * BK * 2  , STAGE_BYTES = 8 * HTB, NXCD = 8, WGM = 8;

__host__ __device__ __forceinline__ int lds_byte(int r, int c) { const int st = (r >> 4) * 2 + (c >> 5), rr = r & 15, cc = c & 31, ob = rr * 64 + cc * 2; return st * 1024 + (ob ^ (((ob >> 9) & 1) << 5)); }
__host__ __device__ __forceinline__ void stage_rc(int b, int& R, int& C) { const int st = b / 1024, sb = b % 1024, swz = sb ^ (((sb >> 9) & 1) << 5); R = (st >> 1) * 16 + swz / 64; C = (st & 1) * 32 + (swz % 64) / 2; }
__host__ __device__ __forceinline__ int perm32(int rho) { const int n = rho >> 4, i = rho & 15; return 8 * (i >> 2) + 4 * n + (i & 3); }

struct Unit { int pm, pn; };
struct Gemm { const bf16_t* A; const bf16_t* Bt; int M, N, K; };

struct StaticOrder {
    int nM, nN, nwg, G, c;
    __host__ __device__ void init(int M, int N, int G_, int c_) { nM = M / BM; nN = N / BM; nwg = nM * nN; G = G_; c = c_; }
    __host__ __device__ bool next(int i, Unit& u) const {
        const long L = (long)i * G + c; if (L >= nwg) return false;
        int wgid = (int)L; { const int q = nwg / NXCD, r = nwg % NXCD, xcd = wgid % NXCD, off = wgid / NXCD; wgid = (xcd < r ? xcd * (q + 1) : r * (q + 1) + (xcd - r) * q) + off; }
        const int nig = WGM * nN, gid = wgid / nig, fm = gid * WGM, gsz = (nM - fm) < WGM ? (nM - fm) : WGM;
        u.pm = fm + ((wgid % nig) % gsz); u.pn = (wgid % nig) / gsz; return true;
    }
    __device__ __forceinline__ void a_ready(const Unit&) const {}
    __device__ __forceinline__ void done(const Unit&) const {}
};

__device__ __forceinline__ unsigned cvt_pk_bf16(float lo, float hi) { unsigned r; asm volatile("v_cvt_pk_bf16_f32 %0, %1, %2" : "=v"(r) : "v"(lo), "v"(hi)); return r; }
#ifndef PG8_STAGE_IN_MMA
#define PG8_STAGE_IN_MMA 0
#endif
typedef int i32x4 __attribute__((ext_vector_type(4)));
typedef int i32x8 __attribute__((ext_vector_type(8)));
__device__ __forceinline__ i32x8 cat32(const bf16x8 lo, const bf16x8 hi) { const i32x4 p = __builtin_bit_cast(i32x4, lo), q = __builtin_bit_cast(i32x4, hi); return (i32x8){p.x, p.y, p.z, p.w, q.x, q.y, q.z, q.w}; }
__device__ __forceinline__ f32x4 mma_mx8(const i32x8 B, const i32x8 A, const f32x4 c) { return __builtin_amdgcn_mfma_scale_f32_16x16x128_f8f6f4(B, A, c, 0, 0, 0, 0x7F7F7F7F, 0, 0x7F7F7F7F); }
template <int I8> __device__ __forceinline__ f32x4 mma16(const bf16x8 b, const bf16x8 a, const f32x4 c) {
    if constexpr (I8 == 1) return __builtin_bit_cast(f32x4, __builtin_amdgcn_mfma_i32_16x16x64_i8(__builtin_bit_cast(i32x4, b), __builtin_bit_cast(i32x4, a), __builtin_bit_cast(i32x4, c), 0, 0, 0));
    else return __builtin_amdgcn_mfma_f32_16x16x32_bf16(b, a, c, 0, 0, 0);
}
template <class Epi, class Sched, bool ALIGN_EPI = false, bool SP2 = false, int I8 = 0>
__device__ __forceinline__ void gemm_phase(PG8_LAS unsigned char* lds, const Gemm g, const Sched& S, const Epi& E) {
    const int tid = threadIdx.x, wid = __builtin_amdgcn_readfirstlane(tid >> 6), lane = tid & 63, wr = wid >> 2, wc = wid & 3, fr = lane & 15, fq = lane >> 4;
    const int K = g.K, nt = K / BK;
    unsigned voffA[1], voffB[1];
    { int R, C; stage_rc(tid * 16, R, C); const int Rb = Epi::PERM ? ((R & ~31) + perm32(R & 31)) : R;
        voffA[0] = (unsigned)(R * K + C) * 2u; voffB[0] = (unsigned)(Rb * K + C) * 2u; }
    const size_t r64 = (size_t)64 * K * 2;
    const size_t kstep = (size_t)(BK * 2);
    const size_t hstep = (size_t)HALF * K * 2;
    const size_t tstep = 2 * hstep;
    const unsigned ldsw = (unsigned)wid * 1024u;
    const int aoff = lds_byte(wr * 64 + fr, fq * 8), boff = lds_byte(wc * 32 + fr, fq * 8);
#define PG8_SA(b, h) (((b) * 2 + (h)) * HTB)
#define PG8_SB(b, h) ((4 + (b) * 2 + (h)) * HTB)
#define PG8_STAGE(bufoff, gbase, voff) do { _Pragma("unroll") for (int _i = 0; _i < 2; ++_i) \
        __builtin_amdgcn_global_load_lds((const unsigned*)((const char*)(gbase) + _i * r64 + (voff)[0]), (PG8_LAS unsigned*)(lds + (bufoff) + ldsw + _i * 8192), 16, 0, 0); } while (0)
#define PG8_LDA(dst, b, h) do { _Pragma("unroll") for (int m = 0; m < 4; ++m) { if constexpr (I8 == 2) dst##8[m] = cat32(*(const PG8_LAS bf16x8*)(lds + PG8_SA(b, h) + aoff + m * 2048), *(const PG8_LAS bf16x8*)(lds + PG8_SA(b, h) + aoff + m * 2048 + 1024)); \
        else { _Pragma("unroll") for (int k = 0; k < 2; ++k) dst[m][k] = *(const PG8_LAS bf16x8*)(lds + PG8_SA(b, h) + aoff + m * 2048 + k * 1024); } } } while (0)
#define PG8_LDB(dst, b, h) do { _Pragma("unroll") for (int n = 0; n < 2; ++n) { if constexpr (I8 == 2) dst##8[n] = cat32(*(const PG8_LAS bf16x8*)(lds + PG8_SB(b, h) + boff + n * 2048), *(const PG8_LAS bf16x8*)(lds + PG8_SB(b, h) + boff + n * 2048 + 1024)); \
        else { _Pragma("unroll") for (int k = 0; k < 2; ++k) dst[n][k] = *(const PG8_LAS bf16x8*)(lds + PG8_SB(b, h) + boff + n * 2048 + k * 1024); } } } while (0)
#define PG8_MMA(ai, bj, At, Bt) do { __builtin_amdgcn_s_setprio(1); _Pragma("unroll") for (int m = 0; m < 4; ++m) _Pragma("unroll") for (int n = 0; n < 2; ++n) { \
        if constexpr (I8 == 2) acc[ai][bj][m][n] = mma_mx8(Bt##8[n], At##8[m], acc[ai][bj][m][n]); \
        else { _Pragma("unroll") for (int k = 0; k < 2; ++k) acc[ai][bj][m][n] = mma16<I8>(Bt[n][k], At[m][k], acc[ai][bj][m][n]); } } __builtin_amdgcn_s_setprio(0); } while (0)
#define PG8_WAIT_V(n) asm volatile("s_waitcnt vmcnt(" #n ")" ::: "memory")
#define PG8_WAIT_L(n) asm volatile("s_waitcnt lgkmcnt(" #n ")" ::: "memory")
#define PG8_BAR __builtin_amdgcn_s_barrier()
#define PG8_SCHED __builtin_amdgcn_sched_barrier(0)
    Unit cur, nxt; int ui = 0;
    if (!S.next(0, cur)) return;
    f32x4 acc[2][2][4][2];
#pragma unroll
    for (int a = 0; a < 2; ++a)
#pragma unroll
        for (int b = 0; b < 2; ++b)
#pragma unroll
            for (int m = 0; m < 4; ++m)
#pragma unroll
                for (int n = 0; n < 2; ++n) acc[a][b][m][n] = (f32x4){0.f, 0.f, 0.f, 0.f};
    bf16x8 At[4][2], B0[2][2], B1[2][2]; i32x8 At8[4], B08[2], B18[2];
    const char* cA = (const char*)g.A + (size_t)cur.pm * tstep; const char* cB = (const char*)g.Bt + (size_t)cur.pn * tstep;
    S.a_ready(cur);
    if constexpr (SP2) {
        PG8_STAGE(PG8_SB(0, 0), cB, voffB); PG8_STAGE(PG8_SB(0, 1), cB + hstep, voffB); PG8_STAGE(PG8_SA(0, 0), cA, voffA); PG8_STAGE(PG8_SA(0, 1), cA + hstep, voffA);
        if (wr == 1) PG8_BAR;
        PG8_WAIT_V(2); PG8_BAR;
        PG8_STAGE(PG8_SB(1, 0), cB + kstep, voffB); PG8_STAGE(PG8_SA(1, 0), cA + kstep, voffA); PG8_STAGE(PG8_SB(1, 1), cB + hstep + kstep, voffB);
        PG8_WAIT_V(6); PG8_BAR;
    } else {
        PG8_STAGE(PG8_SB(0, 0), cB, voffB); PG8_STAGE(PG8_SA(0, 0), cA, voffA); PG8_STAGE(PG8_SB(0, 1), cB + hstep, voffB); PG8_STAGE(PG8_SA(0, 1), cA + hstep, voffA);
        if (wr == 1) PG8_BAR;
        PG8_WAIT_V(4); PG8_BAR;
        PG8_STAGE(PG8_SB(1, 0), cB + kstep, voffB); PG8_STAGE(PG8_SA(1, 0), cA + kstep, voffA); PG8_STAGE(PG8_SB(1, 1), cB + hstep + kstep, voffB);
        PG8_WAIT_V(6); PG8_BAR;
    }
    PROF16_DECL;
    for (;;) {
        const bool has_next = S.next(ui + 1, nxt);
        const char* nA = has_next ? (const char*)g.A + (size_t)nxt.pm * tstep : cA; const char* nB = has_next ? (const char*)g.Bt + (size_t)nxt.pn * tstep : cB;
        asm volatile(".p2align 8" ::: "memory");
        for (int t = 0; t < nt; t += 2) {
            const bool last = (t == nt - 2);
            const char* a1 = cA + (size_t)(t + 1) * kstep;
            const char* a2 = last ? nA : cA + (size_t)(t + 2) * kstep; const char* b2 = last ? nB : cB + (size_t)(t + 2) * kstep;
            const char* a3 = a2 + kstep; const char* b3 = b2 + kstep;
            if (last && has_next) S.a_ready(nxt);
            if constexpr (SP2) {
#if PG8_STAGE_IN_MMA
            PG8_LDB(B0, 0, 0); PG8_LDB(B1, 0, 1); PG8_SCHED; PG8_LDA(At, 0, 0);
            PG8_WAIT_V(6); PG8_WAIT_L(0); PG8_BAR; PG8_MMA(0, 0, At, B0); PG8_SCHED; PG8_STAGE(PG8_SA(1, 1), a1 + hstep, voffA); PG8_SCHED; PG8_MMA(0, 1, At, B1); PG8_BAR; PG8_SCHED;
            PG8_LDA(At, 0, 1);
            PG8_WAIT_V(2); PG8_WAIT_L(0); PG8_BAR; PG8_STAGE(PG8_SB(0, 0), b2, voffB); PG8_SCHED; PG8_MMA(1, 0, At, B0); PG8_SCHED; PG8_STAGE(PG8_SB(0, 1), b2 + hstep, voffB); PG8_SCHED; PG8_MMA(1, 1, At, B1); PG8_SCHED; PG8_STAGE(PG8_SA(0, 0), a2, voffA); PG8_BAR; PG8_SCHED;
            PG8_LDB(B0, 1, 0); PG8_LDB(B1, 1, 1); PG8_SCHED; PG8_LDA(At, 1, 0);
            PG8_WAIT_V(6); PG8_WAIT_L(0); PG8_BAR; PG8_MMA(0, 0, At, B0); PG8_SCHED; PG8_STAGE(PG8_SA(0, 1), a2 + hstep, voffA); PG8_SCHED; PG8_MMA(0, 1, At, B1); PG8_BAR; PG8_SCHED;
            PG8_LDA(At, 1, 1);
            PG8_WAIT_V(2); PG8_WAIT_L(0); PG8_BAR; PG8_STAGE(PG8_SB(1, 0), b3, voffB); PG8_SCHED; PG8_MMA(1, 0, At, B0); PG8_SCHED; PG8_STAGE(PG8_SB(1, 1), b3 + hstep, voffB); PG8_SCHED; PG8_MMA(1, 1, At, B1); PG8_SCHED; PG8_STAGE(PG8_SA(1, 0), a3, voffA); PG8_BAR; PG8_SCHED;
#else
            PG8_LDB(B0, 0, 0); PG8_LDB(B1, 0, 1); PG8_SCHED; PG8_LDA(At, 0, 0); PG8_STAGE(PG8_SA(1, 1), a1 + hstep, voffA);
            PG8_WAIT_V(8); PG8_WAIT_L(0); PG8_BAR; PG8_MMA(0, 0, At, B0); PG8_MMA(0, 1, At, B1); PG8_BAR; PG8_SCHED;
            PG8_LDA(At, 0, 1); PG8_STAGE(PG8_SB(0, 0), b2, voffB); PG8_STAGE(PG8_SB(0, 1), b2 + hstep, voffB); PG8_STAGE(PG8_SA(0, 0), a2, voffA);
            PG8_WAIT_V(8); PG8_WAIT_L(0); PG8_BAR; PG8_MMA(1, 0, At, B0); PG8_MMA(1, 1, At, B1); PG8_BAR; PG8_SCHED;
            PG8_LDB(B0, 1, 0); PG8_LDB(B1, 1, 1); PG8_SCHED; PG8_LDA(At, 1, 0); PG8_STAGE(PG8_SA(0, 1), a2 + hstep, voffA);
            PG8_WAIT_V(8); PG8_WAIT_L(0); PG8_BAR; PG8_MMA(0, 0, At, B0); PG8_MMA(0, 1, At, B1); PG8_BAR; PG8_SCHED;
            PG8_LDA(At, 1, 1); PG8_STAGE(PG8_SB(1, 0), b3, voffB); PG8_STAGE(PG8_SB(1, 1), b3 + hstep, voffB); PG8_STAGE(PG8_SA(1, 0), a3, voffA);
            PG8_WAIT_V(8); PG8_WAIT_L(0); PG8_BAR; PG8_MMA(1, 0, At, B0); PG8_MMA(1, 1, At, B1); PG8_BAR; PG8_SCHED;
#endif
            } else {
            PG8_LDB(B0, 0, 0); PG8_SCHED; PG8_LDA(At, 0, 0); PG8_STAGE(PG8_SA(1, 1), a1 + hstep, voffA);
            PG8_WAIT_L(8); PG8_BAR; PG8_WAIT_L(0); PG8_MMA(0, 0, At, B0); PG8_BAR; PG8_SCHED;
            PG8_LDB(B1, 0, 1); PG8_STAGE(PG8_SB(0, 0), b2, voffB);
            PG8_BAR; PG8_WAIT_L(0); PG8_MMA(0, 1, At, B1); PG8_BAR;
            PG8_LDA(At, 0, 1); PG8_STAGE(PG8_SA(0, 0), a2, voffA);
            PG8_BAR; PG8_WAIT_L(0); PG8_MMA(1, 0, At, B0); PG8_BAR; PG8_SCHED;
            PG8_STAGE(PG8_SB(0, 1), b2 + hstep, voffB);
            PG8_WAIT_V(6); PG8_BAR; PG8_MMA(1, 1, At, B1); PG8_BAR;
            PG8_LDB(B0, 1, 0); PG8_SCHED; PG8_LDA(At, 1, 0); PG8_STAGE(PG8_SA(0, 1), a2 + hstep, voffA);
            PG8_WAIT_L(8); PG8_BAR; PG8_WAIT_L(0); PG8_MMA(0, 0, At, B0); PG8_BAR; PG8_SCHED;
            PG8_LDB(B1, 1, 1); PG8_STAGE(PG8_SB(1, 0), b3, voffB);
            PG8_BAR; PG8_WAIT_L(0); PG8_MMA(0, 1, At, B1); PG8_BAR;
            PG8_LDA(At, 1, 1); PG8_STAGE(PG8_SA(1, 0), a3, voffA);
            PG8_BAR; PG8_WAIT_L(0); PG8_MMA(1, 0, At, B0); PG8_BAR; PG8_SCHED;
            PG8_STAGE(PG8_SB(1, 1), b3 + hstep, voffB);
            PG8_WAIT_V(6); PG8_BAR; PG8_MMA(1, 1, At, B1); PG8_BAR;
            }
        }
        if constexpr (ALIGN_EPI) { if (wr == 0) PG8_BAR; }
        if constexpr (!Epi::AFTER_DRAIN) { int ln; asm volatile("v_mbcnt_lo_u32_b32 %0, -1, 0\n\tv_mbcnt_hi_u32_b32 %0, -1, %0" : "=v"(ln));     const int fr2 = ln & 15, fq2 = ln >> 4; _Pragma("unroll") for (int er = 0; er < Epi::REPS; ++er) { PROF16_BEGIN; E(acc, cur, wr, wc, fr2, fq2); PROF16_END; if (er + 1 < Epi::REPS) asm volatile("" ::: "memory"); } S.done(cur); }
        if (!has_next) break;
#pragma unroll
        for (int a = 0; a < 2; ++a)
#pragma unroll
            for (int b = 0; b < 2; ++b)
#pragma unroll
                for (int m = 0; m < 4; ++m)
#pragma unroll
                    for (int n = 0; n < 2; ++n) acc[a][b][m][n] = (f32x4){0.f, 0.f, 0.f, 0.f};
        cur = nxt; cA = nA; cB = nB; ++ui;
        if constexpr (ALIGN_EPI) { if (wr == 1) PG8_BAR; }
    }
    PG8_WAIT_V(0);
    if constexpr (!ALIGN_EPI) { if (wr == 0) PG8_BAR; }
    PG8_BAR;
    if constexpr (Epi::AFTER_DRAIN) { E.fused(acc, cur, wr, wc, fr, fq, lds, wid, lane); S.done(cur); }
    PROF16_FLUSH;
#undef PG8_SA
#undef PG8_SB
#undef PG8_STAGE
#undef PG8_LDA
#undef PG8_LDB
#undef PG8_MMA
#undef PG8_WAIT_V
#undef PG8_WAIT_L
#undef PG8_BAR
#undef PG8_SCHED
}
}
#define GAS __attribute__((address_space(1)))
#define LAS __attribute__((address_space(3)))
typedef unsigned short bf16;
typedef unsigned v4u __attribute__((ext_vector_type(4)));
typedef float f32x4 __attribute__((ext_vector_type(4)));
typedef short bf16x8 __attribute__((ext_vector_type(8)));
typedef GAS unsigned gu32;
typedef GAS unsigned long long gu64;
#define RLX_AGENT __ATOMIC_RELAXED, __HIP_MEMORY_SCOPE_AGENT
#define LDS_WAIT() asm volatile("s_waitcnt lgkmcnt(0)" ::: "memory")
#define VM_WAIT() asm volatile("s_waitcnt vmcnt(0)" ::: "memory")
__device__ __forceinline__ unsigned long long rt() { return __builtin_amdgcn_s_memrealtime(); }
__device__ __forceinline__ unsigned f2bf(float f) { unsigned u = __builtin_bit_cast(unsigned, f); return (u + 0x7fffu + ((u >> 16) & 1u)) >> 16; }
__device__ __forceinline__ unsigned pk2(float lo, float hi) { return f2bf(lo) | (f2bf(hi) << 16); }

#define XB_TMO      128
#define XB_XCNT(j)  (256  + 64 * (j))
#define XB_XSUB(j)  (1280 + 64 * (j))
#define XB_XGEN(j)  (2304 + 64 * (j))
#define XB_TOP      3328
#define XB_TOPGEN   3392
#define XCD_BAR_WORDS 3456
#define XB_SPIN_CAP (1u << 18)

__device__ __forceinline__ unsigned xb_ld(unsigned* p)              { return __hip_atomic_load(p, __ATOMIC_RELAXED, __HIP_MEMORY_SCOPE_AGENT); }
__device__ __forceinline__ unsigned xb_add(unsigned* p, unsigned v) { return __hip_atomic_fetch_add(p, v, __ATOMIC_RELAXED, __HIP_MEMORY_SCOPE_AGENT); }
__device__ __forceinline__ unsigned xb_xcc_id() { return (unsigned)__builtin_amdgcn_s_getreg((3 << 11) | 20) & 0xFu; }
#define XB_SPIN(cond, bar) do { unsigned _sp = 0; while (cond) { __builtin_amdgcn_s_sleep(1); \
    if ((++_sp & 255u) == 0u) { if (xb_ld(&(bar)[XB_TMO])) break; if (_sp > XB_SPIN_CAP) { atomicAdd(&(bar)[XB_TMO], 1u); break; } } } } while (0)

struct XcdBarrier {
    unsigned* bar; unsigned x;
    volatile LAS unsigned* st;
};

__device__ __forceinline__ XcdBarrier xcd_barrier_post(unsigned* bar, volatile LAS unsigned* st) {
    XcdBarrier b; b.bar = bar; b.x = xb_xcc_id(); b.st = st;
    if (threadIdx.x == 0) (void)xb_add(&bar[XB_XCNT(b.x)], 1u);
    return b;
}
__device__ __forceinline__ void xcd_barrier_complete(unsigned* bar, unsigned x, unsigned& nloc, unsigned& nx) {
    const unsigned G = gridDim.x * gridDim.y * gridDim.z;
    unsigned sum, cnt, mine, sp = 0u;
    for (;;) {
        sum = 0u; cnt = 0u; mine = 0u;
#pragma unroll
        for (unsigned j = 0; j < 16; ++j) { const unsigned c = xb_ld(&bar[XB_XCNT(j)]); sum += c; cnt += (c > 0u) ? 1u : 0u; mine = (j == x) ? c : mine; }
        if (sum == G) break;
        __builtin_amdgcn_s_sleep(1);
        if ((++sp & 255u) == 0u) { if (xb_ld(&bar[XB_TMO])) break; if (sp > XB_SPIN_CAP) { atomicAdd(&bar[XB_TMO], 1u); break; } }
    }
    nloc = mine > 0u ? mine : 1u; nx = cnt > 0u ? cnt : 1u;
}

__device__ __forceinline__ void xcd_barrier(const XcdBarrier& b) {
    asm volatile("s_waitcnt vmcnt(0)" ::: "memory");
    __syncthreads();
    if (threadIdx.x == 0) {
        unsigned* bar = b.bar;
        __builtin_amdgcn_s_waitcnt(0);
        unsigned nloc = b.st[0], nx = b.st[1];
        if (nloc == 0u) { xcd_barrier_complete(bar, b.x, nloc, nx); b.st[0] = nloc; b.st[1] = nx; }
        const unsigned old = xb_add(&bar[XB_XSUB(b.x)], 1u);
        const unsigned gen = old / nloc;
        if (old + 1u == (gen + 1u) * nloc) {
            __builtin_amdgcn_fence(__ATOMIC_RELEASE, "agent");
            asm volatile("s_waitcnt vmcnt(0)" ::: "memory");
            (void)xb_add(&bar[XB_TOP], 1u);
        }
        XB_SPIN(xb_ld(&bar[XB_TOP]) < (gen + 1u) * nx, bar);
        __builtin_amdgcn_fence(__ATOMIC_ACQUIRE, "agent");
        asm volatile("s_waitcnt vmcnt(0)" ::: "memory");
    }
    __syncthreads();
}

constexpr int NWAVES = 8;
constexpr int NB = 8, SEQ = 4096, D = 1024, M = NB * SEQ, FF = 2816, FF2 = 2 * FF, DC = 512, DR = 512, NH = 8, HD = 64, CW = 31, RW = 4, NMIX = 2048;
constexpr float EPS = 1e-6f;
constexpr int LDM = 11 * D;
constexpr size_t MiB = 1u << 20;
constexpr size_t WS_CTL = 0, CTL_ZERO_BYTES = 1 * MiB;
constexpr size_t WS_MOD = 1 * MiB;
constexpr size_t WS_BIAS1 = 1 * MiB + 512 * 1024;
constexpr size_t WS_BIAS2 = 2 * MiB;
constexpr size_t WS_WGT = 2 * MiB + 128 * 1024;
constexpr size_t WS_CS1 = 2 * MiB + 384 * 1024, WS_CS3 = 2 * MiB + 448 * 1024;
constexpr size_t WS_RS1 = 2 * MiB + 512 * 1024, WS_RS3 = 2 * MiB + 640 * 1024;
constexpr size_t WS_CS2 = 2 * MiB + 480 * 1024, WS_RS2 = 2 * MiB + 768 * 1024;
constexpr size_t WS_TOT = 3 * MiB;
constexpr size_t WS_TOTH = 7 * MiB;
constexpr size_t WS_SSP = 5 * MiB;
constexpr size_t WS_W1I = 8 * MiB, WS_W1O = 19 * MiB, WS_WIN = 25 * MiB, WS_WOUT = 29 * MiB, WS_W2I = 31 * MiB, WS_W2O = 42 * MiB;
constexpr size_t WS_Y = 48 * MiB;
constexpr size_t WS_X1 = 112 * MiB;
constexpr size_t WS_ACT = 240 * MiB;
constexpr size_t WS_U = WS_ACT, WS_UX = WS_ACT + 32 * MiB, WS_GY = WS_ACT + 64 * MiB, WS_YMIX = WS_ACT + 96 * MiB;
constexpr size_t WS_SSPF = 416 * MiB;
constexpr size_t WS_SSPX = 418 * MiB;
constexpr size_t WS_SSPX3 = 422 * MiB;
constexpr size_t WS_END = 426 * MiB;
constexpr int CW_BAR = 4096, CW_SEAM = 16384, CW_SCAN = 32768, CW_SEAM7 = 49152, CW_SEAM3 = 65536, CW_TICKET = 98304;
constexpr int LDS_BYTES = 147456;
constexpr int LDSCTL_OFF = LDS_BYTES - 256;

typedef unsigned short u16;
typedef float f32x16 __attribute__((ext_vector_type(16)));
typedef float f32x2 __attribute__((ext_vector_type(2)));

template <int OFF> __device__ __forceinline__ float sx(float v) {
    const int i = (int)__float_as_uint(v); int r;
    if constexpr (OFF == 1) r = __builtin_amdgcn_update_dpp(0, i, 0xB1, 0xf, 0xf, true);
    else if constexpr (OFF == 2) r = __builtin_amdgcn_update_dpp(0, i, 0x4E, 0xf, 0xf, true);
    else if constexpr (OFF == 4) r = __builtin_amdgcn_ds_swizzle(i, 0x101F);
    else if constexpr (OFF == 8) r = __builtin_amdgcn_update_dpp(0, i, 0x128, 0xf, 0xf, true);
    else if constexpr (OFF == 16) r = __builtin_amdgcn_ds_swizzle(i, 0x401F);
    else { const auto p = __builtin_amdgcn_permlane32_swap(i, i, false, false); r = (threadIdx.x & 32) ? p[0] : p[1]; }
    return __uint_as_float((unsigned)r);
}
__device__ __forceinline__ float wave_sum(float v) { v += sx<1>(v); v += sx<2>(v); v += sx<4>(v); v += sx<8>(v); v += sx<16>(v); v += sx<32>(v); return v; }
__device__ __forceinline__ float sigmoid_fast(float x) { return __builtin_amdgcn_rcpf(1.f + __builtin_amdgcn_exp2f(-1.4426950408889634f * x)); }
__device__ __forceinline__ float silu_fast(float x) { return x * sigmoid_fast(x); }
__device__ __forceinline__ float gelu_tanh_fast(float x) { const float z = 0.7978845608028654f * (x + 0.044715f * x * x * x); return x * sigmoid_fast(2.f * z); }
__device__ __forceinline__ f32x4 sigmoid4(const f32x4 x) { const f32x4 t = x * -1.4426950408889634f; f32x4 e = {__builtin_amdgcn_exp2f(t[0]), __builtin_amdgcn_exp2f(t[1]), __builtin_amdgcn_exp2f(t[2]), __builtin_amdgcn_exp2f(t[3])};
    e = e + 1.0f; return (f32x4){__builtin_amdgcn_rcpf(e[0]), __builtin_amdgcn_rcpf(e[1]), __builtin_amdgcn_rcpf(e[2]), __builtin_amdgcn_rcpf(e[3])}; }
__device__ __forceinline__ f32x4 gelu_tanh4(const f32x4 x) { const f32x4 z2 = (x + (x * x) * x * 0.044715f) * (2.0f * 0.7978845608028654f); return x * sigmoid4(z2); }
__device__ __forceinline__ float bflo(unsigned w) { return __uint_as_float(w << 16); }
__device__ __forceinline__ float bfhi(unsigned w) { return __uint_as_float(w & 0xffff0000u); }
__device__ __forceinline__ unsigned cvtpk(float lo, float hi) { return pg8::cvt_pk_bf16(lo, hi); }
__device__ __forceinline__ v4u pack8(const f32x4 a, const f32x4 b) { v4u w; w.x = cvtpk(a[0], a[1]); w.y = cvtpk(a[2], a[3]); w.z = cvtpk(b[0], b[1]); w.w = cvtpk(b[2], b[3]); return w; }

__device__ __forceinline__ void unpack8(const v4u w, f32x4& a, f32x4& b) { a = (f32x4){bflo(w.x), bfhi(w.x), bflo(w.y), bfhi(w.y)}; b = (f32x4){bflo(w.z), bfhi(w.z), bflo(w.w), bfhi(w.w)}; }
__device__ __forceinline__ unsigned q8(float v) { int q = (int)__builtin_rintf(v); q = q < -127 ? -127 : (q > 127 ? 127 : q); return (unsigned)q & 0xffu; }
__device__ __forceinline__ unsigned q8x4(const f32x4 v) { return q8(v[0]) | (q8(v[1]) << 8) | (q8(v[2]) << 16) | (q8(v[3]) << 24); }
__device__ __forceinline__ float wave_max(float v) { v = fmaxf(v, sx<1>(v)); v = fmaxf(v, sx<2>(v)); v = fmaxf(v, sx<4>(v)); v = fmaxf(v, sx<8>(v)); v = fmaxf(v, sx<16>(v)); v = fmaxf(v, sx<32>(v)); return v; }
typedef int i32x4v __attribute__((ext_vector_type(4)));
__device__ __forceinline__ f32x4 acc_i2f(const f32x4 a) { return __builtin_convertvector(__builtin_bit_cast(i32x4v, a), f32x4); }
__device__ __forceinline__ float clamp448(float v) { return __builtin_fminf(__builtin_fmaxf(v, -448.0f), 448.0f); }
__device__ __forceinline__ unsigned f8x4(const f32x4 v) { int w = __builtin_amdgcn_cvt_pk_fp8_f32(clamp448(v[0]), clamp448(v[1]), 0, false); w = __builtin_amdgcn_cvt_pk_fp8_f32(clamp448(v[2]), clamp448(v[3]), w, true); return (unsigned)w; }
constexpr float F8_ACT_SCALE = 8.0f, F8_W_SCALE = 2048.0f;
__device__ __forceinline__ void load_rstd(const float* ssp, int row0, int fq, float (&rs)[2][4]) {
#pragma unroll
    for (int ai = 0; ai < 2; ++ai)
#pragma unroll
        for (int m = 0; m < 4; ++m) { const f32x4 p = *(const f32x4*)(ssp + (size_t)(row0 + ai * 128 + m * 16) * 16 + 4 * fq);
            float s = (p[0] + p[1]) + (p[2] + p[3]); s += __shfl_xor(s, 16); s += __shfl_xor(s, 32); rs[ai][m] = rsqrtf(s * (1.0f / D) + EPS); }
}
__device__ __forceinline__ void load_rstd_sc1(const float* ssp, int row0, int fq, float (&rs)[2][4]) {
#pragma unroll
    for (int ai = 0; ai < 2; ++ai)
#pragma unroll
        for (int m = 0; m < 4; ++m) { const f32x4 p = *(const f32x4*)(ssp + (size_t)(row0 + ai * 128 + m * 16) * 16 + 4 * fq);
            float s = (p[0] + p[1]) + (p[2] + p[3]); s += __shfl_xor(s, 16); s += __shfl_xor(s, 32); rs[ai][m] = rsqrtf(s * (1.0f / D) + EPS); }
}
#ifndef MK_EPI_SWIGLU_REPS
#define MK_EPI_SWIGLU_REPS 1
#endif
#ifndef MK_EPI_RESID_REPS
#define MK_EPI_RESID_REPS 1
#endif
struct EpiSwiglu {
    static constexpr bool PERM = true, AFTER_DRAIN = false; static constexpr int REPS = MK_EPI_SWIGLU_REPS;
    pg8::bf16_t* act; const float* ssp; const float* bias;
    __device__ __forceinline__ void operator()(const f32x4 (&acc)[2][2][4][2], const pg8::Unit& u, int wr, int wc, int fr, int fq) const {
        const int row0 = u.pm * 256 + wr * 64 + fr, b = u.pm >> 4;
        float rs[2][4]; load_rstd(ssp, row0, fq, rs);
        const float* bp = bias + (size_t)b * FF2 + u.pn * 256 + wc * 32 + 8 * fq;
        const f32x4 bg0 = *(const f32x4*)(bp), bg1 = *(const f32x4*)(bp + 4), bu0 = *(const f32x4*)(bp + 128), bu1 = *(const f32x4*)(bp + 132);
        const int oc = u.pn * 128 + wc * 32 + 8 * fq;
#pragma unroll
        for (int ai = 0; ai < 2; ++ai)
#pragma unroll
            for (int m = 0; m < 4; ++m) { const float r = rs[ai][m];
                const f32x4 g0 = acc[ai][0][m][0] * r + bg0, g1 = acc[ai][0][m][1] * r + bg1, u0 = acc[ai][1][m][0] * r + bu0, u1 = acc[ai][1][m][1] * r + bu1;
                const f32x4 a0 = (g0 * sigmoid4(g0)) * u0, a1 = (g1 * sigmoid4(g1)) * u1;
                *(v4u*)(act + (size_t)(row0 + ai * 128 + m * 16) * FF + oc) = pack8(a0, a1); }
    }
};
template <bool OUT8> struct EpiSwiglu8 {
    static constexpr bool PERM = true, AFTER_DRAIN = false; static constexpr int REPS = 1;
    pg8::bf16_t* act; const float* rs; const float* cs;
    __device__ __forceinline__ void operator()(const f32x4 (&acc)[2][2][4][2], const pg8::Unit& u, int wr, int wc, int fr, int fq) const {
        const int row0 = u.pm * 256 + wr * 64 + fr;
        float rv[2][4];
#pragma unroll
        for (int ai = 0; ai < 2; ++ai)
#pragma unroll
            for (int m = 0; m < 4; ++m) rv[ai][m] = rs[row0 + ai * 128 + m * 16];
        const int cb = u.pn * 256 + wc * 32 + 8 * fq;
        const float* cp = cs + cb;
        const f32x4 cg0 = *(const f32x4*)(cp), cg1 = *(const f32x4*)(cp + 4), cu0 = *(const f32x4*)(cp + 128), cu1 = *(const f32x4*)(cp + 132);
        const int oc = u.pn * 128 + wc * 32 + 8 * fq;
#pragma unroll
        for (int ai = 0; ai < 2; ++ai)
#pragma unroll
            for (int m = 0; m < 4; ++m) { const float r = rv[ai][m];
                const f32x4 g0 = acc_i2f(acc[ai][0][m][0]) * (cg0 * r), g1 = acc_i2f(acc[ai][0][m][1]) * (cg1 * r);
                const f32x4 u0 = acc_i2f(acc[ai][1][m][0]) * (cu0 * r), u1 = acc_i2f(acc[ai][1][m][1]) * (cu1 * r);
                const f32x4 a0 = (g0 * sigmoid4(g0)) * u0, a1 = (g1 * sigmoid4(g1)) * u1;
                if (OUT8) *(unsigned long long*)((unsigned char*)act + (size_t)(row0 + ai * 128 + m * 16) * FF + oc) = (unsigned long long)f8x4(a0 * F8_ACT_SCALE) | ((unsigned long long)f8x4(a1 * F8_ACT_SCALE) << 32);
                else *(v4u*)(act + (size_t)(row0 + ai * 128 + m * 16) * FF + oc) = pack8(a0, a1); }
    }
};
template <int WHALF, bool HASY, bool IN16, bool F8 = false> struct EpiResid {
    static constexpr bool PERM = true, AFTER_DRAIN = false; static constexpr int REPS = (IN16 ? 1 : MK_EPI_RESID_REPS);
    static constexpr float w = (WHALF ? 0.5f : 1.0f) * (F8 ? 1.0f / (F8_ACT_SCALE * F8_W_SCALE) : 1.0f);
    const void* xin; pg8::bf16_t* xout; pg8::bf16_t* y; float* ssp; const float* gt; const float* gnext; const float* scnext;
    __device__ __forceinline__ void operator()(const f32x4 (&acc)[2][2][4][2], const pg8::Unit& u, int wr, int wc, int fr, int fq) const {
        const int row0 = u.pm * 256 + wr * 64 + fr, b = u.pm >> 4;
        float ss[2][4];
#pragma unroll
        for (int ai = 0; ai < 2; ++ai)
#pragma unroll
            for (int m = 0; m < 4; ++m) ss[ai][m] = 0.f;
#pragma unroll
        for (int bj = 0; bj < 2; ++bj) { const int c0 = u.pn * 256 + bj * 128 + wc * 32 + 8 * fq;
            const f32x4 gt0 = *(const f32x4*)(gt + (size_t)b * LDM + c0) * w, gt1 = *(const f32x4*)(gt + (size_t)b * LDM + c0 + 4) * w;
            f32x4 gs0 = {0.f, 0.f, 0.f, 0.f}, gs1 = gs0;
            if (HASY) { gs0 = *(const f32x4*)(gnext + c0) * (*(const f32x4*)(scnext + (size_t)b * LDM + c0) + 1.0f); gs1 = *(const f32x4*)(gnext + c0 + 4) * (*(const f32x4*)(scnext + (size_t)b * LDM + c0 + 4) + 1.0f); }
#pragma unroll
            for (int ai = 0; ai < 2; ++ai)
#pragma unroll
                for (int m = 0; m < 4; ++m) { const size_t off = (size_t)(row0 + ai * 128 + m * 16) * D + c0;
                    f32x4 x0, x1;
                    if (IN16) unpack8(*(const v4u*)((const pg8::bf16_t*)xin + off), x0, x1); else { x0 = *(const f32x4*)((const float*)xin + off); x1 = *(const f32x4*)((const float*)xin + off + 4); }
                    const f32x4 o0 = x0 + gt0 * acc[ai][bj][m][0], o1 = x1 + gt1 * acc[ai][bj][m][1];
                    *(v4u*)(xout + off) = pack8(o0, o1);
                    ss[ai][m] += (o0[0] * o0[0] + o0[1] * o0[1]) + (o0[2] * o0[2] + o0[3] * o0[3]) + (o1[0] * o1[0] + o1[1] * o1[1]) + (o1[2] * o1[2] + o1[3] * o1[3]);
                    if (HASY) *(v4u*)(y + off) = pack8(o0 * gs0, o1 * gs1); } }
#pragma unroll
        for (int ai = 0; ai < 2; ++ai)
#pragma unroll
            for (int m = 0; m < 4; ++m) { float s = ss[ai][m]; s += __shfl_xor(s, 16); s += __shfl_xor(s, 32);
                if (fq == 0) ssp[(size_t)(row0 + ai * 128 + m * 16) * 16 + u.pn * 4 + wc] = s; }
    }
};
template <int WHALF, bool IN16> struct EpiResidQ {
    static constexpr bool PERM = true, AFTER_DRAIN = false; static constexpr int REPS = 1;
    static constexpr float w = WHALF ? 0.5f : 1.0f;
    const void* xin; pg8::bf16_t* xout; unsigned char* a8; float* rs; f32x2* sspx; const float* gt; const float* gnext; const float* scnext; const float* shnext; const float* shmax; unsigned* cnt;
    __device__ __forceinline__ void operator()(f32x4 (&acc)[2][2][4][2], const pg8::Unit& u, int wr, int wc, int fr, int fq) const {
        const int row0 = u.pm * 256 + wr * 64 + fr, b = u.pm >> 4;
        float ss[2][4], am[2][4];
        PROF_BEGIN(17);
#pragma unroll
        for (int ai = 0; ai < 2; ++ai)
#pragma unroll
            for (int m = 0; m < 4; ++m) { ss[ai][m] = 0.f; am[ai][m] = 0.f; }
        const unsigned voff = (unsigned)((row0 * D + u.pn * 256 + wc * 32 + 8 * fq) * 2);
        unsigned vo[8] = {voff, voff, voff, voff, voff, voff, voff, voff};
#pragma unroll
        for (int bj = 0; bj < 2; ++bj) { const int c0 = u.pn * 256 + bj * 128 + wc * 32 + 8 * fq;
            const f32x4 gt0 = *(const f32x4*)(gt + (size_t)b * LDM + c0) * w, gt1 = *(const f32x4*)(gt + (size_t)b * LDM + c0 + 4) * w;
            const f32x4 gs0 = *(const f32x4*)(gnext + c0) * (*(const f32x4*)(scnext + (size_t)b * LDM + c0) + 1.0f), gs1 = *(const f32x4*)(gnext + c0 + 4) * (*(const f32x4*)(scnext + (size_t)b * LDM + c0 + 4) + 1.0f);
#pragma unroll
            for (int ai = 0; ai < 2; ++ai)
#pragma unroll
                for (int m = 0; m < 4; ++m) { const unsigned so = (unsigned)(((ai * 128 + m * 16) * D + bj * 128) * 2); const int g = (ai * 4 + m) & 7;
                    f32x4 x0, x1;
                    if (IN16) unpack8(*(const v4u*)((const char*)xin + (size_t)(vo[g] + so)), x0, x1);
                    else { const char* p = (const char*)xin + 2 * (size_t)(vo[g] + so); x0 = *(const f32x4*)p; x1 = *(const f32x4*)(p + 16); }
                    const f32x4 o0 = x0 + gt0 * acc[ai][bj][m][0], o1 = x1 + gt1 * acc[ai][bj][m][1];
                    *(v4u*)((char*)xout + (size_t)(vo[g] + so)) = pack8(o0, o1);
                    acc[ai][bj][m][0] = o0; acc[ai][bj][m][1] = o1;
                    ss[ai][m] += (o0[0] * o0[0] + o0[1] * o0[1]) + (o0[2] * o0[2] + o0[3] * o0[3]) + (o1[0] * o1[0] + o1[1] * o1[1]) + (o1[2] * o1[2] + o1[3] * o1[3]);
                    const f32x4 t0 = __builtin_elementwise_abs(o0 * gs0), t1 = __builtin_elementwise_abs(o1 * gs1);
                    am[ai][m] = fmaxf(am[ai][m], fmaxf(fmaxf(fmaxf(t0[0], t0[1]), fmaxf(t0[2], t0[3])), fmaxf(fmaxf(t1[0], t1[1]), fmaxf(t1[2], t1[3]))));
                    asm volatile("" : "+v"(vo[g]) : "v"(ss[ai][m])); } }
#pragma unroll
        for (int ai = 0; ai < 2; ++ai)
#pragma unroll
            for (int m = 0; m < 4; ++m) { float s = ss[ai][m], a = am[ai][m]; s += __shfl_xor(s, 16); s += __shfl_xor(s, 32); a = fmaxf(a, __shfl_xor(a, 16)); a = fmaxf(a, __shfl_xor(a, 32));
                if (fq == 0) __hip_atomic_store((gu64*)(sspx + (size_t)(row0 + ai * 128 + m * 16) * 16 + u.pn * 4 + wc), ((unsigned long long)__float_as_uint(a) << 32) | __float_as_uint(s), RLX_AGENT); }
        PROF_END(17);
        PROF_BEGIN(13);
        asm volatile("s_waitcnt vmcnt(0)" ::: "memory");
        unsigned* cw = cnt + 64 * u.pm;
        if ((threadIdx.x & 63) == 0) __hip_atomic_fetch_add(cw, 1u, __ATOMIC_RELAXED, __HIP_MEMORY_SCOPE_AGENT);
        if (threadIdx.x < 64) {
            unsigned sp = 0;
            while ((unsigned)__builtin_amdgcn_readfirstlane(__hip_atomic_load(cw, __ATOMIC_RELAXED, __HIP_MEMORY_SCOPE_AGENT)) < 32u) { __builtin_amdgcn_s_sleep(1); if (++sp > (1u << 20)) break; }
            __builtin_amdgcn_fence(__ATOMIC_ACQUIRE, "agent");
            asm volatile("s_waitcnt vmcnt(0)" ::: "memory");
        }
        asm volatile("" ::: "memory"); __builtin_amdgcn_s_barrier(); asm volatile("" ::: "memory");
        PROF_END(13);
        PROF_BEGIN(18);
        float qs[2][4], qr[2][4];
        const float shm = shmax[b];
#pragma unroll
        for (int ai = 0; ai < 2; ++ai) {
            v4u tq[4][2];
#pragma unroll
            for (int m = 0; m < 4; ++m) { const v4u* p = (const v4u*)(sspx + (size_t)(row0 + ai * 128 + m * 16) * 16 + 4 * fq); tq[m][0] = p[0]; tq[m][1] = p[1]; }
#pragma unroll
            for (int m = 0; m < 4; ++m) { const int row = row0 + ai * 128 + m * 16;
                float s = (__uint_as_float(tq[m][0].x) + __uint_as_float(tq[m][0].z)) + (__uint_as_float(tq[m][1].x) + __uint_as_float(tq[m][1].z));
                float a = fmaxf(fmaxf(__uint_as_float(tq[m][0].y), __uint_as_float(tq[m][0].w)), fmaxf(__uint_as_float(tq[m][1].y), __uint_as_float(tq[m][1].w)));
                s += __shfl_xor(s, 16); s += __shfl_xor(s, 32); a = fmaxf(a, __shfl_xor(a, 16)); a = fmaxf(a, __shfl_xor(a, 32));
                const float rstd = rsqrtf(s * (1.0f / D) + EPS), S = rstd * a + shm;
                qs[ai][m] = S > 0.f ? 127.0f / S : 0.f; qr[ai][m] = rstd * qs[ai][m];
                if (u.pn == 0 && wc == 0 && fq == 0) rs[row] = S * (1.0f / 127.0f); } }
        const unsigned voff8 = (unsigned)((row0 + ((fq & 1) ? 16 : 0)) * D + u.pn * 256 + wc * 32 + 8 * (fq & 2));
#pragma unroll
        for (int bj = 0; bj < 2; ++bj) { const int c0 = u.pn * 256 + bj * 128 + wc * 32 + 8 * fq;
            const f32x4 gs0 = *(const f32x4*)(gnext + c0) * (*(const f32x4*)(scnext + (size_t)b * LDM + c0) + 1.0f), gs1 = *(const f32x4*)(gnext + c0 + 4) * (*(const f32x4*)(scnext + (size_t)b * LDM + c0 + 4) + 1.0f);
            const f32x4 sh0 = *(const f32x4*)(shnext + (size_t)b * LDM + c0), sh1 = *(const f32x4*)(shnext + (size_t)b * LDM + c0 + 4);
#pragma unroll
            for (int ai = 0; ai < 2; ++ai)
#pragma unroll
                for (int mp = 0; mp < 2; ++mp) { const int m0 = 2 * mp, m1 = 2 * mp + 1; const unsigned so = (unsigned)((ai * 128 + m0 * 16) * D + bj * 128);
                    const float q0 = qs[ai][m0], r0 = qr[ai][m0], q1 = qs[ai][m1], r1 = qr[ai][m1];
                    const unsigned xl = q8x4(acc[ai][bj][m0][0] * (gs0 * r0) + sh0 * q0), xh = q8x4(acc[ai][bj][m0][1] * (gs1 * r0) + sh1 * q0);
                    const unsigned yl = q8x4(acc[ai][bj][m1][0] * (gs0 * r1) + sh0 * q1), yh = q8x4(acc[ai][bj][m1][1] * (gs1 * r1) + sh1 * q1);
                    const auto pl = __builtin_amdgcn_permlane16_swap(xl, yl, false, false), ph = __builtin_amdgcn_permlane16_swap(xh, yh, false, false);
                    *(v4u*)(a8 + (size_t)(voff8 + so)) = (v4u){(unsigned)pl[0], (unsigned)ph[0], (unsigned)pl[1], (unsigned)ph[1]}; } }
        PROF_END(18);
    }
};
template <bool F8> struct EpiResidFinal {
    static constexpr bool PERM = true, AFTER_DRAIN = false; static constexpr int REPS = 1;
    static constexpr float ascale = F8 ? 1.0f / (F8_ACT_SCALE * F8_W_SCALE) : 1.0f;
    const pg8::bf16_t* xin; float* out; float* ssp; const float* gt; const float* gf; const float* fsc; const float* fsh; unsigned* cnt;
    __device__ __forceinline__ void operator()(f32x4 (&acc)[2][2][4][2], const pg8::Unit& u, int wr, int wc, int fr, int fq) const {
        const int row0 = u.pm * 256 + wr * 64 + fr, b = u.pm >> 4;
        const __amdgpu_buffer_rsrc_t rx = __builtin_amdgcn_make_buffer_rsrc((void*)xin, 0, M * D * 4, 0x00020000), ro = __builtin_amdgcn_make_buffer_rsrc((void*)out, 0, M * D * 4, 0x00020000);
        const unsigned voff = (unsigned)((row0 * D + u.pn * 256 + wc * 32 + 8 * fq) * 4);
        float ss[2][4];
#pragma unroll
        for (int ai = 0; ai < 2; ++ai)
#pragma unroll
            for (int m = 0; m < 4; ++m) ss[ai][m] = 0.f;
        unsigned vo[4] = {voff, voff, voff, voff};
#pragma unroll
        for (int bj = 0; bj < 2; ++bj) { const int c0 = u.pn * 256 + bj * 128 + wc * 32 + 8 * fq;
            const float hw = 0.5f * ascale; const f32x4 gt0 = *(const f32x4*)(gt + (size_t)b * LDM + c0) * hw, gt1 = *(const f32x4*)(gt + (size_t)b * LDM + c0 + 4) * hw;
#pragma unroll
            for (int ai = 0; ai < 2; ++ai)
#pragma unroll
                for (int m = 0; m < 4; ++m) { const unsigned so = (unsigned)(((ai * 128 + m * 16) * D + bj * 128) * 4); const int g = m & 3;
                    f32x4 x0, x1; unpack8(*(const v4u*)((const char*)xin + (size_t)((vo[g] + so) >> 1)), x0, x1);
                    const f32x4 o0 = x0 + gt0 * acc[ai][bj][m][0], o1 = x1 + gt1 * acc[ai][bj][m][1];
                    acc[ai][bj][m][0] = o0; acc[ai][bj][m][1] = o1;
                    ss[ai][m] += (o0[0] * o0[0] + o0[1] * o0[1]) + (o0[2] * o0[2] + o0[3] * o0[3]) + (o1[0] * o1[0] + o1[1] * o1[1]) + (o1[2] * o1[2] + o1[3] * o1[3]);
                    asm volatile("" : "+v"(vo[g]) : "v"(ss[ai][m])); } }
#pragma unroll
        for (int ai = 0; ai < 2; ++ai)
#pragma unroll
            for (int m = 0; m < 4; ++m) { float s = ss[ai][m]; s += __shfl_xor(s, 16); s += __shfl_xor(s, 32);
                if (fq == 0) __hip_atomic_store((gu32*)(ssp + (size_t)(row0 + ai * 128 + m * 16) * 16 + u.pn * 4 + wc), __float_as_uint(s), RLX_AGENT); }
        PROF_BEGIN(14);
        asm volatile("s_waitcnt vmcnt(0)" ::: "memory");
        unsigned* cw = cnt + 64 * u.pm;
        if ((threadIdx.x & 63) == 0) __hip_atomic_fetch_add(cw, 1u, __ATOMIC_RELAXED, __HIP_MEMORY_SCOPE_AGENT);
        if (threadIdx.x < 64) {
            unsigned sp = 0;
            while ((unsigned)__builtin_amdgcn_readfirstlane(__hip_atomic_load(cw, __ATOMIC_RELAXED, __HIP_MEMORY_SCOPE_AGENT)) < 32u) { __builtin_amdgcn_s_sleep(1); if (++sp > (1u << 20)) break; }
            __builtin_amdgcn_fence(__ATOMIC_ACQUIRE, "agent");
            asm volatile("s_waitcnt vmcnt(0)" ::: "memory");
        }
        asm volatile("" ::: "memory"); __builtin_amdgcn_s_barrier(); asm volatile("" ::: "memory");
        PROF_END(14);
        float rs[2][4]; load_rstd_sc1(ssp, row0, fq, rs);
#pragma unroll
        for (int bj = 0; bj < 2; ++bj) { const int c0 = u.pn * 256 + bj * 128 + wc * 32 + 8 * fq;
            const f32x4 gs0 = *(const f32x4*)(gf + c0) * (*(const f32x4*)(fsc + (size_t)b * LDM + c0) + 1.0f), gs1 = *(const f32x4*)(gf + c0 + 4) * (*(const f32x4*)(fsc + (size_t)b * LDM + c0 + 4) + 1.0f);
            const f32x4 sh0 = *(const f32x4*)(fsh + (size_t)b * LDM + c0), sh1 = *(const f32x4*)(fsh + (size_t)b * LDM + c0 + 4);
#pragma unroll
            for (int ai = 0; ai < 2; ++ai)
#pragma unroll
                for (int m = 0; m < 4; ++m) { const unsigned so = (unsigned)(((ai * 128 + m * 16) * D + bj * 128) * 4); const float r = rs[ai][m];
                    *(f32x4*)((char*)out + (size_t)voff + so) = acc[ai][bj][m][0] * r * gs0 + sh0;
                    *(f32x4*)((char*)out + (size_t)voff + so + 16) = acc[ai][bj][m][1] * r * gs1 + sh1; } }
    }
};
struct EpiMixIn {
    static constexpr bool PERM = true, AFTER_DRAIN = false; static constexpr int REPS = 1;
    pg8::bf16_t *U, *UX, *GY; const float* ssp; const float* bias;
    __device__ __forceinline__ void operator()(const f32x4 (&acc)[2][2][4][2], const pg8::Unit& u, int wr, int wc, int fr, int fq) const {
        const int row0 = u.pm * 256 + wr * 64 + fr, b = u.pm >> 4;
        float rs[2][4]; load_rstd(ssp, row0, fq, rs);
        const float* bp = bias + (size_t)b * NMIX + u.pn * 256 + wc * 32 + 8 * fq;
        const f32x4 b00 = *(const f32x4*)(bp), b01 = *(const f32x4*)(bp + 4), b10 = *(const f32x4*)(bp + 128), b11 = *(const f32x4*)(bp + 132);
        if (u.pn < 4) {
            const int oc = u.pn * 128 + wc * 32 + 8 * fq;
#pragma unroll
            for (int ai = 0; ai < 2; ++ai)
#pragma unroll
                for (int m = 0; m < 4; ++m) { const float r = rs[ai][m];
                    const f32x4 v0 = acc[ai][0][m][0] * r + b00, v1 = acc[ai][0][m][1] * r + b01, g0 = acc[ai][1][m][0] * r + b10, g1 = acc[ai][1][m][1] * r + b11;
                    const f32x4 a0 = v0 * sigmoid4(g0), a1 = v1 * sigmoid4(g1);
                    *(v4u*)(U + (size_t)(row0 + ai * 128 + m * 16) * DC + oc) = pack8(a0, a1); }
        } else {
            pg8::bf16_t* dst = (u.pn < 6) ? UX : GY; const bool gel = u.pn >= 6; const int pc = (u.pn & 1) * 256 + wc * 32 + 8 * fq;
#pragma unroll
            for (int ai = 0; ai < 2; ++ai)
#pragma unroll
                for (int m = 0; m < 4; ++m) { const float r = rs[ai][m];
#pragma unroll
                    for (int bj = 0; bj < 2; ++bj) { f32x4 v0 = acc[ai][bj][m][0] * r + (bj ? b10 : b00), v1 = acc[ai][bj][m][1] * r + (bj ? b11 : b01);
                        if (gel) { v0 = gelu_tanh4(v0); v1 = gelu_tanh4(v1); }
                        *(v4u*)(dst + (size_t)(row0 + ai * 128 + m * 16) * DR + pc + bj * 128) = pack8(v0, v1); } }
        }
    }
};

struct EpiMixIn8 {
    static constexpr bool PERM = true, AFTER_DRAIN = false; static constexpr int REPS = 1;
    pg8::bf16_t *U, *UX, *GY; const float* rs; const float* cs; const float* bias;
    __device__ __forceinline__ void operator()(const f32x4 (&acc)[2][2][4][2], const pg8::Unit& u, int wr, int wc, int fr, int fq) const {
        const int row0 = u.pm * 256 + wr * 64 + fr, b = u.pm >> 4;
        float rv[2][4];
#pragma unroll
        for (int ai = 0; ai < 2; ++ai)
#pragma unroll
            for (int m = 0; m < 4; ++m) rv[ai][m] = rs[row0 + ai * 128 + m * 16];
        const int cb = u.pn * 256 + wc * 32 + 8 * fq;
        const float* bp = bias + (size_t)b * NMIX + cb; const float* cp = cs + cb;
        const f32x4 b00 = *(const f32x4*)(bp), b01 = *(const f32x4*)(bp + 4), b10 = *(const f32x4*)(bp + 128), b11 = *(const f32x4*)(bp + 132);
        const f32x4 c00 = *(const f32x4*)(cp), c01 = *(const f32x4*)(cp + 4), c10 = *(const f32x4*)(cp + 128), c11 = *(const f32x4*)(cp + 132);
        if (u.pn < 4) {
            const int oc = u.pn * 128 + wc * 32 + 8 * fq;
#pragma unroll
            for (int ai = 0; ai < 2; ++ai)
#pragma unroll
                for (int m = 0; m < 4; ++m) { const float r = rv[ai][m];
                    const f32x4 v0 = acc_i2f(acc[ai][0][m][0]) * (c00 * r) + b00, v1 = acc_i2f(acc[ai][0][m][1]) * (c01 * r) + b01;
                    const f32x4 g0 = acc_i2f(acc[ai][1][m][0]) * (c10 * r) + b10, g1 = acc_i2f(acc[ai][1][m][1]) * (c11 * r) + b11;
                    const f32x4 a0 = v0 * sigmoid4(g0), a1 = v1 * sigmoid4(g1);
                    *(v4u*)(U + (size_t)(row0 + ai * 128 + m * 16) * DC + oc) = pack8(a0, a1); }
        } else {
            pg8::bf16_t* dst = (u.pn < 6) ? UX : GY; const bool gel = u.pn >= 6; const int pc = (u.pn & 1) * 256 + wc * 32 + 8 * fq;
#pragma unroll
            for (int ai = 0; ai < 2; ++ai)
#pragma unroll
                for (int m = 0; m < 4; ++m) { const float r = rv[ai][m];
#pragma unroll
                    for (int bj = 0; bj < 2; ++bj) { f32x4 v0 = acc_i2f(acc[ai][bj][m][0]) * ((bj ? c10 : c00) * r) + (bj ? b10 : b00), v1 = acc_i2f(acc[ai][bj][m][1]) * ((bj ? c11 : c01) * r) + (bj ? b11 : b01);
                        if (gel) { v0 = gelu_tanh4(v0); v1 = gelu_tanh4(v1); }
                        *(v4u*)(dst + (size_t)(row0 + ai * 128 + m * 16) * DR + pc + bj * 128) = pack8(v0, v1); } }
        }
    }
};

__device__ __forceinline__ void p0_gemv(LAS unsigned char* lds, const float* c, const float* W, int NC, const float* bias, float* out, int j0, int tid) {
    LAS float* ca = (LAS float*)lds; LAS float* part = (LAS float*)(lds + 32768);
    for (int i = tid; i < NB * D; i += 512) { const float v = c[i]; ca[i] = v / (1.f + expf(-v)); }
    __syncthreads();
    const int cg = tid & 31, ks = tid >> 5;
    const float* wp = W + (size_t)(64 * ks) * NC + j0 + 4 * cg;
    f32x4 acc[NB];
#pragma unroll
    for (int b = 0; b < NB; ++b) acc[b] = (f32x4){0.f, 0.f, 0.f, 0.f};
#pragma unroll 4
    for (int kk = 0; kk < 64; ++kk) { const f32x4 w = *(const f32x4*)(wp + (size_t)kk * NC);
#pragma unroll
        for (int b = 0; b < NB; ++b) acc[b] += w * ca[b * D + 64 * ks + kk]; }
#pragma unroll
    for (int b = 0; b < NB; ++b) *(LAS f32x4*)(part + (ks * NB + b) * 128 + 4 * cg) = acc[b];
    __syncthreads();
#pragma unroll
    for (int r = 0; r < 2; ++r) { const int o = tid + 512 * r, b = o >> 7, col = o & 127; float s = 0.f;
#pragma unroll
        for (int k2 = 0; k2 < 16; ++k2) s += part[(k2 * NB + b) * 128 + col];
        out[(size_t)b * LDM + j0 + col] = s + bias[j0 + col]; }
    __syncthreads();
}
__device__ __forceinline__ int rowmap(int kind, int n0) {
    if (kind == 1) { const int half = n0 / FF, f = n0 - half * FF; return 256 * (f >> 7) + 128 * half + (f & 127); }
    if (kind == 2 && n0 < 1024) { const int half = n0 >> 9, f = n0 & 511; return 256 * (f >> 7) + 128 * half + (f & 127); }
    return n0;
}
__device__ __forceinline__ void p0_transpose_item(const float* W, int K, int N, bf16* WT, int kind, LAS float* scr, int item, int lane) {
    const int nblk = N / 32, kb = item / nblk, nb = item % nblk, k0 = 64 * kb, n0 = 32 * nb, r0 = rowmap(kind, n0);
#pragma unroll 8
    for (int i = 0; i < 32; ++i) { const int kk = 2 * i + (lane >> 5); scr[kk * 33 + (lane & 31)] = W[(size_t)(k0 + kk) * N + n0 + (lane & 31)]; }
    LDS_WAIT(); asm volatile("" ::: "memory");
    const int c = lane & 7;
#pragma unroll
    for (int j = 0; j < 4; ++j) { const int n = (lane >> 3) + 8 * j; const LAS float* s = scr + (8 * c) * 33 + n;
        v4u o; o.x = pk2(s[0 * 33], s[1 * 33]); o.y = pk2(s[2 * 33], s[3 * 33]); o.z = pk2(s[4 * 33], s[5 * 33]); o.w = pk2(s[6 * 33], s[7 * 33]);
        *(GAS v4u*)(WT + (size_t)(r0 + n) * K + k0 + 8 * c) = o; }
    LDS_WAIT(); asm volatile("" ::: "memory");
}

__device__ __forceinline__ void p0_transpose8_item(const float* W, int K, int N, unsigned char* WT, LAS float* scr, int item, int lane) {
    const int nblk = N / 32, kb = item / nblk, nb = item % nblk, k0 = 64 * kb, n0 = 32 * nb;
#pragma unroll 8
    for (int i = 0; i < 32; ++i) { const int kk = 2 * i + (lane >> 5); scr[kk * 33 + (lane & 31)] = W[(size_t)(k0 + kk) * N + n0 + (lane & 31)]; }
    LDS_WAIT(); asm volatile("" ::: "memory");
    const int n = lane >> 1, kh = (lane & 1) * 32; const LAS float* sp = scr + n;
#pragma unroll
    for (int hq = 0; hq < 2; ++hq) { v4u o;
#pragma unroll
        for (int dq = 0; dq < 4; ++dq) { const int k = kh + 16 * hq + 4 * dq;
            const unsigned w4 = f8x4((f32x4){sp[(k + 0) * 33], sp[(k + 1) * 33], sp[(k + 2) * 33], sp[(k + 3) * 33]} * F8_W_SCALE);
            if (dq == 0) o.x = w4; else if (dq == 1) o.y = w4; else if (dq == 2) o.z = w4; else o.w = w4; }
        *(GAS v4u*)(WT + (size_t)(n0 + n) * K + k0 + kh + 16 * hq) = o; }
    LDS_WAIT(); asm volatile("" ::: "memory");
}
__device__ __forceinline__ void p0_quant_item(LAS unsigned char* lds, const float* W, int N, int kind, unsigned char* W8, float* cs, int nb, int lane, int wave) {
    LAS float* scr = (LAS float*)(lds + wave * 16896);
    LAS float* cm = (LAS float*)(lds + 8 * 16896);
    const int n0 = 32 * nb, r0 = rowmap(kind, n0);
#pragma unroll
    for (int tl = 0; tl < 2; ++tl) { const int k0 = 64 * (2 * wave + tl);
#pragma unroll 8
        for (int i = 0; i < 32; ++i) { const int kk = 2 * i + (lane >> 5); scr[tl * 2112 + kk * 33 + (lane & 31)] = W[(size_t)(k0 + kk) * N + n0 + (lane & 31)]; } }
    LDS_WAIT(); asm volatile("" ::: "memory");
    float mx = 0.f;
#pragma unroll
    for (int tl = 0; tl < 2; ++tl)
#pragma unroll 8
        for (int r = 0; r < 32; ++r) mx = fmaxf(mx, fabsf(scr[tl * 2112 + ((lane >> 5) * 32 + r) * 33 + (lane & 31)]));
    mx = fmaxf(mx, __shfl_xor(mx, 32));
    if (lane < 32) cm[wave * 32 + lane] = mx;
    __syncthreads();
    float cmax = 0.f;
#pragma unroll
    for (int w = 0; w < 8; ++w) cmax = fmaxf(cmax, cm[w * 32 + (lane & 31)]);
    const float sc = cmax > 0.f ? 127.0f / cmax : 0.f;
    if (wave == 0 && lane < 32) cs[r0 + lane] = cmax * (1.0f / 127.0f);
    const int n = lane >> 1, kh = (lane & 1) * 32;
    const float sn = __shfl(sc, n);
#pragma unroll
    for (int tl = 0; tl < 2; ++tl) { const int k0 = 64 * (2 * wave + tl); const LAS float* sp = scr + tl * 2112 + n;
#pragma unroll
        for (int hq = 0; hq < 2; ++hq) { v4u o;
#pragma unroll
            for (int dq = 0; dq < 4; ++dq) { const int k = kh + 16 * hq + 4 * dq;
                const unsigned w4 = q8(sp[(k + 0) * 33] * sn) | (q8(sp[(k + 1) * 33] * sn) << 8) | (q8(sp[(k + 2) * 33] * sn) << 16) | (q8(sp[(k + 3) * 33] * sn) << 24);
                if (dq == 0) o.x = w4; else if (dq == 1) o.y = w4; else if (dq == 2) o.z = w4; else o.w = w4; }
            *(GAS v4u*)(W8 + (size_t)(r0 + n) * D + k0 + kh + 16 * hq) = o; } }
    __syncthreads();
}

__device__ __forceinline__ void mix_conv(LAS unsigned char* lds, const bf16* U, const float* conv_w, const float* conv_b, const float* ln_g, const float* ln_b, bf16* YMIX, int G, int bx, int tid, int lane, int wave) {
    LAS unsigned char* IN = lds;
    LAS f32x4* WA = (LAS f32x4*)(lds + 63488);
    LAS f32x4* WB = WA + 31 * 64;
    for (int i = tid; i < 31 * 64; i += 512) { const int k = i >> 6, l = i & 63; WA[i] = *(const f32x4*)(conv_w + k * DC + 8 * l); WB[i] = *(const f32x4*)(conv_w + k * DC + 8 * l + 4); }
    const f32x4 cb0 = *(const f32x4*)(conv_b + 8 * lane), cb1 = *(const f32x4*)(conv_b + 8 * lane + 4);
    const f32x4 lg0 = *(const f32x4*)(ln_g + 8 * lane), lg1 = *(const f32x4*)(ln_g + 8 * lane + 4);
    const f32x4 lb0 = *(const f32x4*)(ln_b + 8 * lane), lb1 = *(const f32x4*)(ln_b + 8 * lane + 4);
    v4u pre[8];
#pragma unroll
    for (int i = 0; i < 8; ++i) { const int q = tid + 512 * i, row = q >> 6, ch = q & 63, tok = (bx & 127) * 32 - 30 + row; pre[i] = (v4u){0u, 0u, 0u, 0u};
        if (bx < NB * (SEQ / 32) && q < 62 * 64 && tok >= 0) pre[i] = *(const v4u*)(U + ((size_t)((bx >> 7) * SEQ + tok)) * DC + 8 * ch); }
    for (int item = bx; item < NB * (SEQ / 32); item += G) {
        const int b = item >> 7, t0 = (item & 127) * 32;
        __syncthreads();
#pragma unroll
        for (int i = 0; i < 8; ++i) { const int q = tid + 512 * i; if (q < 62 * 64) *(LAS v4u*)(IN + (q >> 6) * 1024 + (q & 63) * 16) = pre[i]; }
        { const int nitem = item + G, nb = nitem >> 7, nt0 = (nitem & 127) * 32;
#pragma unroll
            for (int i = 0; i < 8; ++i) { const int q = tid + 512 * i, row = q >> 6, ch = q & 63, tok = nt0 - 30 + row; pre[i] = (v4u){0u, 0u, 0u, 0u};
                if (nitem < NB * (SEQ / 32) && q < 62 * 64 && tok >= 0) pre[i] = *(const v4u*)(U + ((size_t)(nb * SEQ + tok)) * DC + 8 * ch); } }
        __syncthreads();
        f32x4 a0[4], a1[4];
#pragma unroll
        for (int tt = 0; tt < 4; ++tt) { a0[tt] = cb0; a1[tt] = cb1; }
        f32x4 wa0 = {0.f, 0.f, 0.f, 0.f}, wa1 = wa0, wa2 = wa0, wa3 = wa0, wb0 = wa0, wb1 = wa0, wb2 = wa0, wb3 = wa0;
#pragma unroll
        for (int kk = 0; kk < 34; ++kk) {
            const v4u v = *(const LAS v4u*)(IN + (4 * wave + kk) * 1024 + lane * 16);
            const f32x4 x0 = {bflo(v.x), bfhi(v.x), bflo(v.y), bfhi(v.y)}, x1 = {bflo(v.z), bfhi(v.z), bflo(v.w), bfhi(v.w)};
            wa3 = wa2; wa2 = wa1; wa1 = wa0; wb3 = wb2; wb2 = wb1; wb1 = wb0;
            if (kk <= 30) { wa0 = WA[kk * 64 + lane]; wb0 = WB[kk * 64 + lane]; } else { wa0 = (f32x4){0.f, 0.f, 0.f, 0.f}; wb0 = wa0; }
            a0[0] += wa0 * x0; a1[0] += wb0 * x1; a0[1] += wa1 * x0; a1[1] += wb1 * x1; a0[2] += wa2 * x0; a1[2] += wb2 * x1; a0[3] += wa3 * x0; a1[3] += wb3 * x1;
        }
#pragma unroll
        for (int tt = 0; tt < 4; ++tt) {
            float s = (a0[tt][0] + a0[tt][1]) + (a0[tt][2] + a0[tt][3]) + (a1[tt][0] + a1[tt][1]) + (a1[tt][2] + a1[tt][3]);
            const float mean = wave_sum(s) * (1.0f / DC);
            const f32x4 d0 = a0[tt] - mean, d1 = a1[tt] - mean;
            float q = (d0[0] * d0[0] + d0[1] * d0[1]) + (d0[2] * d0[2] + d0[3] * d0[3]) + (d1[0] * d1[0] + d1[1] * d1[1]) + (d1[2] * d1[2] + d1[3] * d1[3]);
            const float rstd = rsqrtf(wave_sum(q) * (1.0f / DC) + EPS);
            f32x4 y0 = d0 * rstd * lg0 + lb0, y1 = d1 * rstd * lg1 + lb1;
#pragma unroll
            for (int j = 0; j < 4; ++j) { y0[j] = silu_fast(y0[j]); y1[j] = silu_fast(y1[j]); }
            *(v4u*)(YMIX + ((size_t)(b * SEQ + t0 + 4 * wave + tt)) * D + 8 * lane) = pack8(y0, y1);
        }
    }
    __syncthreads();
}

__device__ __forceinline__ void mix_conv2(LAS unsigned char* lds, const bf16* U, const float* conv_w, const float* conv_b, const float* ln_g, const float* ln_b, bf16* YMIX, int G, int bx, int tid, int lane, int wave) {
    LAS unsigned char* IN = lds;
    LAS float* RED = (LAS float*)(lds + 63488);
    const int th = wave >> 2, cq = wave & 3, ch = 128 * cq + 2 * lane;
    f32x2 wt[31];
#pragma unroll
    for (int k = 0; k < 31; ++k) wt[k] = *(const f32x2*)(conv_w + k * DC + ch);
    const f32x2 cb = *(const f32x2*)(conv_b + ch), lg = *(const f32x2*)(ln_g + ch), lb = *(const f32x2*)(ln_b + ch);
    v4u pre[8];
#pragma unroll
    for (int i = 0; i < 8; ++i) { const int q = tid + 512 * i, row = q >> 6, c16 = q & 63, tok = (bx & 127) * 32 - 30 + row; pre[i] = (v4u){0u, 0u, 0u, 0u};
        if (bx < NB * (SEQ / 32) && q < 62 * 64 && tok >= 0) pre[i] = *(const v4u*)(U + ((size_t)((bx >> 7) * SEQ + tok)) * DC + 8 * c16); }
    for (int item = bx; item < NB * (SEQ / 32); item += G) {
        const int b = item >> 7, t0 = (item & 127) * 32;
        PROF_BEGIN(10);
        __syncthreads();
#pragma unroll
        for (int i = 0; i < 8; ++i) { const int q = tid + 512 * i; if (q < 62 * 64) *(LAS v4u*)(IN + (q >> 6) * 1024 + (q & 63) * 16) = pre[i]; }
        { const int nitem = item + G, nb = nitem >> 7, nt0 = (nitem & 127) * 32;
#pragma unroll
            for (int i = 0; i < 8; ++i) { const int q = tid + 512 * i, row = q >> 6, c16 = q & 63, tok = nt0 - 30 + row; pre[i] = (v4u){0u, 0u, 0u, 0u};
                if (nitem < NB * (SEQ / 32) && q < 62 * 64 && tok >= 0) pre[i] = *(const v4u*)(U + ((size_t)(nb * SEQ + tok)) * DC + 8 * c16); } }
        __syncthreads();
        PROF_END(10); PROF_BEGIN(11);
        f32x2 acc[16];
#pragma unroll
        for (int tt = 0; tt < 16; ++tt) acc[tt] = cb;
        const LAS unsigned char* ip = IN + (16 * th) * 1024 + ch * 2;
#pragma unroll
        for (int r = 0; r < 46; ++r) {
            const unsigned v = *(const LAS unsigned*)(ip + r * 1024);
            const f32x2 xv = {bflo(v), bfhi(v)};
#pragma unroll
            for (int tt = 0; tt < 16; ++tt) { const int k = r - tt; if (k >= 0 && k <= 30) acc[tt] += wt[k] * xv; }
        }
        PROF_END(11); PROF_BEGIN(12);
        float vals[32];
#pragma unroll
        for (int tt = 0; tt < 16; ++tt) { vals[tt] = acc[tt][0] + acc[tt][1]; vals[16 + tt] = acc[tt][0] * acc[tt][0] + acc[tt][1] * acc[tt][1]; }
#pragma unroll
        for (int i = 0; i < 16; ++i) { const auto p = __builtin_amdgcn_permlane32_swap((int)__float_as_uint(vals[i]), (int)__float_as_uint(vals[i + 16]), false, false); vals[i] = __uint_as_float((unsigned)p[0]) + __uint_as_float((unsigned)p[1]); }
#pragma unroll
        for (int i = 0; i < 8; ++i) { const auto p = __builtin_amdgcn_permlane16_swap((int)__float_as_uint(vals[i]), (int)__float_as_uint(vals[i + 8]), false, false); vals[i] = __uint_as_float((unsigned)p[0]) + __uint_as_float((unsigned)p[1]); }
#define CONV_RED_STEP(off, n) { const bool up = (lane & (off)) != 0; _Pragma("unroll") for (int i = 0; i < (n); ++i) { const float keep = up ? vals[i + (n)] : vals[i], send = up ? vals[i] : vals[i + (n)]; vals[i] = keep + sx<(off)>(send); } }
        CONV_RED_STEP(8, 4) CONV_RED_STEP(4, 2) CONV_RED_STEP(2, 1)
#undef CONV_RED_STEP
        vals[0] += sx<1>(vals[0]);
        if ((lane & 1) == 0) RED[wave * 32 + (lane >> 5) * 16 + ((lane >> 1) & 15)] = vals[0];
        __syncthreads();
        float mean_l = 0.f, rstd_l = 0.f;
        if (lane < 16) { float s1 = 0.f, s2 = 0.f;
#pragma unroll
            for (int q4 = 0; q4 < 4; ++q4) { s1 += RED[(4 * th + q4) * 32 + lane]; s2 += RED[(4 * th + q4) * 32 + 16 + lane]; }
            mean_l = s1 * (1.0f / DC); const float var = fmaxf(s2 * (1.0f / DC) - mean_l * mean_l, 0.f); rstd_l = rsqrtf(var + EPS); }
#pragma unroll
        for (int tt = 0; tt < 16; ++tt) {
            const float mean = __uint_as_float((unsigned)__builtin_amdgcn_readlane((int)__float_as_uint(mean_l), tt)), rstd = __uint_as_float((unsigned)__builtin_amdgcn_readlane((int)__float_as_uint(rstd_l), tt));
            f32x2 y = (acc[tt] - mean) * rstd * lg + lb;
            y[0] = silu_fast(y[0]); y[1] = silu_fast(y[1]);
            *(unsigned*)(YMIX + ((size_t)(b * SEQ + t0 + 16 * th + tt)) * D + ch) = cvtpk(y[0], y[1]);
        }
        PROF_END(12);
    }
    __syncthreads();
}

__device__ __forceinline__ void scan_decode(int it, int& b, int& c) { if (it < 256) { b = it >> 6; c = it & 63; } else { b = 4 + ((it - 256) >> 6); c = 63 - ((it - 256) & 63); } }
__device__ __forceinline__ float neg_expm1(float x, float a) {
    float p = -1.0f / 5040.0f; p = p * x - 1.0f / 720.0f; p = p * x - 1.0f / 120.0f; p = p * x - 1.0f / 24.0f; p = p * x - 1.0f / 6.0f; p = p * x - 0.5f; p = p * x - 1.0f;
    float q = p * x, w = 1.0f - a * a; asm volatile("" : "+v"(q), "+v"(w));
    return x > -0.5f ? q : w;
}
__device__ __forceinline__ void gate_math16(const f32x16 pa, const f32x16 pi, float ba, float bi, float c8, f32x16& av, f32x16& bv) {
#pragma unroll
    for (int g4 = 0; g4 < 4; ++g4) {
        const f32x4 pa4 = {pa[4 * g4], pa[4 * g4 + 1], pa[4 * g4 + 2], pa[4 * g4 + 3]}, pi4 = {pi[4 * g4], pi[4 * g4 + 1], pi[4 * g4 + 2], pi[4 * g4 + 3]};
        const f32x4 rg = sigmoid4(pa4 + ba), ig = sigmoid4(pi4 + bi);
        const f32x4 l2 = rg * c8;
        const f32x4 a = {__builtin_amdgcn_exp2f(l2[0]), __builtin_amdgcn_exp2f(l2[1]), __builtin_amdgcn_exp2f(l2[2]), __builtin_amdgcn_exp2f(l2[3])};
        const f32x4 x = l2 * 1.3862943611198906f;
        f32x4 p = x * (-1.0f / 5040.0f) - 1.0f / 720.0f; p = p * x - 1.0f / 120.0f; p = p * x - 1.0f / 24.0f; p = p * x - 1.0f / 6.0f; p = p * x - 0.5f; p = p * x - 1.0f;
        f32x4 q = p * x, w = 1.0f - a * a; asm volatile("" : "+v"(q), "+v"(w));
        f32x4 m2;
#pragma unroll
        for (int e = 0; e < 4; ++e) m2[e] = __builtin_amdgcn_sqrtf(x[e] > -0.5f ? q[e] : w[e]);
        const f32x4 bb = m2 * ig;
#pragma unroll
        for (int e = 0; e < 4; ++e) { av[4 * g4 + e] = a[e]; bv[4 * g4 + e] = bb[e]; }
        __builtin_amdgcn_sched_barrier(0);
    }
}
template <bool FINAL>
__device__ __forceinline__ void mix_scan(LAS unsigned char* lds, const bf16* UX, const bf16* GY, const bf16* WGT, const float* rw, const float* rb, const float* b_a, const float* b_i, const float* lam,
                                         f32x2* TOT, bf16* YMIX, int G, int bx, int lane, int wave) {
    LAS unsigned char* UXT = lds + wave * 16896;
    LAS unsigned char* XRT = UXT + 8704;
    const int h = wave, j = lane & 31, hh = lane >> 5, dg = lane & 7, tg = lane >> 3;
    float c8v[2], bav[2], biv[2];
#pragma unroll
    for (int ec = 0; ec < 2; ++ec) { const int ch = 64 * h + 32 * ec + j; c8v[ec] = -8.0f * 1.4426950408889634f * log1pf(expf(-lam[ch]));   bav[ec] = b_a[ch]; biv[ec] = b_i[ch]; }
    for (int it = bx; it < 512; it += G) {
        asm volatile("" ::: "memory");
        int b, c; scan_decode(it, b, c);
        const size_t mrow0 = (size_t)b * SEQ + 64 * c;
#pragma unroll
        for (int i = 0; i < 9; ++i) { const int row = i * 8 + tg, tok = 64 * c - 3 + row; v4u v = {0u, 0u, 0u, 0u};
            if (row < 67 && tok >= 0) v = *(const v4u*)(UX + ((size_t)b * SEQ + tok) * DR + 64 * h + 8 * dg);
            if (row < 68) *(LAS v4u*)(UXT + row * 128 + dg * 16) = v; }
        pg8::bf16x8 bfr[2][4];
#pragma unroll
        for (int g = 0; g < 2; ++g)
#pragma unroll
            for (int ks = 0; ks < 4; ++ks) bfr[g][ks] = *(const pg8::bf16x8*)(WGT + ((size_t)(h * 128 + 64 * g + j)) * 64 + 16 * ks + 8 * hh);
        v4u gyv[8];
        if (FINAL) {
#pragma unroll
            for (int i = 0; i < 8; ++i) gyv[i] = *(const v4u*)(GY + (mrow0 + i * 8 + tg) * DR + 64 * h + 8 * dg);
        }
        float Hc = 0.f;
        if (FINAL) { const f32x2* tp = TOT + ((size_t)b * 64) * DR + 64 * h + lane; int cc = 0;
            for (; cc + 8 <= c; cc += 8) { f32x2 t8[8];
#pragma unroll
                for (int u = 0; u < 8; ++u) t8[u] = tp[(size_t)(cc + u) * DR];
#pragma unroll
                for (int u = 0; u < 8; ++u) Hc = Hc * t8[u].x + t8[u].y; }
            for (; cc < c; ++cc) { const f32x2 ab = tp[(size_t)cc * DR]; Hc = Hc * ab.x + ab.y; } }
        {
            f32x4 w4a[4], w4b[4];
#pragma unroll
            for (int k = 0; k < 4; ++k) { w4a[k] = *(const f32x4*)(rw + k * DR + 64 * h + 8 * dg); w4b[k] = *(const f32x4*)(rw + k * DR + 64 * h + 8 * dg + 4); }
            const f32x4 rb0 = *(const f32x4*)(rb + 64 * h + 8 * dg), rb1 = *(const f32x4*)(rb + 64 * h + 8 * dg + 4);
#pragma unroll
            for (int th = 0; th < 2; ++th) {
                f32x4 o0[4], o1[4];
#pragma unroll
                for (int t = 0; t < 4; ++t) { o0[t] = rb0; o1[t] = rb1; }
#pragma unroll
                for (int i = 0; i < 7; ++i) { const v4u v = *(const LAS v4u*)(UXT + (8 * tg + 4 * th + i) * 128 + dg * 16);
                    const f32x4 x0 = {bflo(v.x), bfhi(v.x), bflo(v.y), bfhi(v.y)}, x1 = {bflo(v.z), bfhi(v.z), bflo(v.w), bfhi(v.w)};
#pragma unroll
                    for (int k = 0; k < 4; ++k) { const int t = i - k; if (t >= 0 && t < 4) { o0[t] += w4a[k] * x0; o1[t] += w4b[k] * x1; } } }
#pragma unroll
                for (int t = 0; t < 4; ++t) *(LAS v4u*)(XRT + (8 * tg + 4 * th + t) * 128 + dg * 16) = pack8(o0[t], o1[t]);
            }
        }
        if (FINAL) {
#pragma unroll
            for (int i = 0; i < 8; ++i) *(LAS v4u*)(UXT + (i * 8 + tg) * 128 + dg * 16) = gyv[i];
        }
#pragma unroll
        for (int ec = 0; ec < 2; ++ec) {
            const int ch = 64 * h + 32 * ec + j;
            const float c8 = c8v[ec], ba = bav[ec], bi = biv[ec];
            f32x16 av[2], bv[2];
#pragma unroll
            for (int tt = 0; tt < 2; ++tt) {
                pg8::bf16x8 afr[4];
#pragma unroll
                for (int ks = 0; ks < 4; ++ks) afr[ks] = *(const LAS pg8::bf16x8*)(XRT + (32 * tt + j) * 128 + (16 * ks + 8 * hh) * 2);
                f32x16 pa, pi;
#pragma unroll
                for (int r = 0; r < 16; ++r) { pa[r] = 0.f; pi[r] = 0.f; }
#pragma unroll
                for (int ks = 0; ks < 4; ++ks) {
                    pa = __builtin_amdgcn_mfma_f32_32x32x16_bf16(afr[ks], bfr[0][ks], pa, 0, 0, 0);
                    pi = __builtin_amdgcn_mfma_f32_32x32x16_bf16(afr[ks], bfr[1][ks], pi, 0, 0, 0); }
                if (ec == 0 && tt == 1) {
#pragma unroll
                    for (int g = 0; g < 2; ++g)
#pragma unroll
                        for (int ks = 0; ks < 4; ++ks) bfr[g][ks] = *(const pg8::bf16x8*)(WGT + ((size_t)(h * 128 + 64 * g + 32 + j)) * 64 + 16 * ks + 8 * hh);
                }
                gate_math16(pa, pi, ba, bi, c8, av[tt], bv[tt]);
                {
                    f32x16 px;
#pragma unroll
                    for (int r = 0; r < 16; ++r) px[r] = bv[tt][r] * 0.f;
                    int dd = 32 * ec + j - 8 * hh; asm volatile("" : "+v"(dd));
                    const unsigned one = (dd & 1) ? 0x3F800000u : 0x00003F80u;
#pragma unroll
                    for (int ks = 0; ks < 4; ++ks) {
                        const int dw = (dd - 16 * ks) >> 1;
                        v4u idw; idw.x = dw == 0 ? one : 0u; idw.y = dw == 1 ? one : 0u; idw.z = dw == 2 ? one : 0u; idw.w = dw == 3 ? one : 0u;
                        px = __builtin_amdgcn_mfma_f32_32x32x16_bf16(afr[ks], __builtin_bit_cast(pg8::bf16x8, idw), px, 0, 0, 0); }
#pragma unroll
                    for (int r = 0; r < 16; ++r) bv[tt][r] *= px[r];
                }
            }
            float GA[2][4], GB[2][4], PA[2][4], PB[2][4];
#pragma unroll
            for (int tt = 0; tt < 2; ++tt)
#pragma unroll
                for (int q = 0; q < 4; ++q) { const float a0 = av[tt][4 * q], a1 = av[tt][4 * q + 1], a2 = av[tt][4 * q + 2], a3 = av[tt][4 * q + 3];
                    const float b0 = bv[tt][4 * q], b1 = bv[tt][4 * q + 1], b2 = bv[tt][4 * q + 2], b3 = bv[tt][4 * q + 3];
                    GA[tt][q] = (a0 * a1) * (a2 * a3); GB[tt][q] = ((b0 * a1 + b1) * a2 + b2) * a3 + b3;
                    PA[tt][q] = __shfl_xor(GA[tt][q], 32); PB[tt][q] = __shfl_xor(GB[tt][q], 32); }
            if (!FINAL) {
                float At = 1.f, Bt = 0.f;
#pragma unroll
                for (int tt = 0; tt < 2; ++tt)
#pragma unroll
                    for (int q = 0; q < 4; ++q) { const float A0 = hh ? PA[tt][q] : GA[tt][q], B0 = hh ? PB[tt][q] : GB[tt][q], A1 = hh ? GA[tt][q] : PA[tt][q], B1 = hh ? GB[tt][q] : PB[tt][q];
                        Bt = (Bt * A0 + B0) * A1 + B1; At = (At * A0) * A1; }
                if (hh == 0) TOT[((size_t)b * 64 + c) * DR + ch] = (f32x2){At, Bt};
            } else {
                float hc = __shfl(Hc, 32 * ec + j);
#pragma unroll
                for (int tt = 0; tt < 2; ++tt)
#pragma unroll
                    for (int q = 0; q < 4; ++q) { const float A0 = hh ? PA[tt][q] : GA[tt][q], B0 = hh ? PB[tt][q] : GB[tt][q], A1 = hh ? GA[tt][q] : PA[tt][q], B1 = hh ? GB[tt][q] : PB[tt][q];
                        const float mid = hc * A0 + B0; float hv = hh ? mid : hc; hc = mid * A1 + B1;
#pragma unroll
                        for (int i = 0; i < 4; ++i) { hv = av[tt][4 * q + i] * hv + bv[tt][4 * q + i]; av[tt][4 * q + i] = hv; } }
#pragma unroll
                for (int tt = 0; tt < 2; ++tt)
#pragma unroll
                    for (int r = 0; r < 16; ++r) { const int tk = 32 * tt + (r & 3) + 8 * (r >> 2) + 4 * hh;
                        LAS u16* p = (LAS u16*)(UXT + tk * 128 + (32 * ec + j) * 2);
                        const float gy = __uint_as_float((unsigned)(*p) << 16);
                        *p = (u16)f2bf(gy * av[tt][r]); }
            }
        }
        if (FINAL) {
#pragma unroll
            for (int i = 0; i < 8; ++i) { const int row = i * 8 + tg; *(v4u*)(YMIX + (mrow0 + row) * D + DC + 64 * h + 8 * dg) = *(const LAS v4u*)(UXT + row * 128 + dg * 16); }
        }
    }
    __syncthreads();
}

#ifndef FOLD_B
#define FOLD_B 4
#endif
__device__ __forceinline__ void fold_chunks(const gu64* tp, int c0, int c1, int hh, float& A, float& B) {
    const int mid = (c0 + c1 + 1) >> 1, lo = hh ? mid : c0, hi2 = hh ? c1 : mid;
    float Ar = 1.f, Br = 0.f;
    for (int cc = lo; cc < hi2; cc += FOLD_B) { unsigned long long t8[FOLD_B];
        for (unsigned sp = 0;; ++sp) { unsigned all = 0x80000000u;
#pragma unroll
            for (int u = 0; u < FOLD_B; ++u) t8[u] = __hip_atomic_load(tp + (size_t)(cc + u < 63 ? cc + u : 63) * DR, RLX_AGENT);
#pragma unroll
            for (int u = 0; u < FOLD_B; ++u) all &= (cc + u < hi2) ? (unsigned)t8[u] : 0x80000000u;
            if (all || sp > (1u << 16)) break;
            __builtin_amdgcn_s_sleep(1); }
#pragma unroll
        for (int u = 0; u < FOLD_B; ++u) { const bool ok = cc + u < hi2; const float ta = ok ? __uint_as_float((unsigned)t8[u] & 0x7fffffffu) : 1.f, tb = ok ? __uint_as_float((unsigned)(t8[u] >> 32)) : 0.f; Br = Br * ta + tb; Ar = Ar * ta; } }
    const float Ap = __shfl_xor(Ar, 32), Bp = __shfl_xor(Br, 32);
    A = Ar * Ap; B = hh ? (Bp * Ar + Br) : (Br * Ap + Bp);
}
__device__ __forceinline__ void mix_scan1(LAS unsigned char* lds, const bf16* UX, const bf16* GY, const bf16* WGT, const float* rw, const float* rb, const float* b_a, const float* b_i, const float* lam,
                                          f32x2* TOT, unsigned* cnt, bf16* YMIX, int G, int bx, int lane, int wave) {
    LAS unsigned char* UXT = lds + wave * 16896;
    LAS unsigned char* XRT = UXT + 8704;
    f32x2* TOTH = (f32x2*)((unsigned char*)TOT + (WS_TOTH - WS_TOT));
    const int h = wave, j = lane & 31, hh = lane >> 5, dg = lane & 7, tg = lane >> 3;
    const int gs = G >> 3, b = bx / gs, idx = bx - b * gs;
    float c8v[2], bav[2], biv[2];
#pragma unroll
    for (int ec = 0; ec < 2; ++ec) { const int ch = 64 * h + 32 * ec + j; c8v[ec] = -8.0f * 1.4426950408889634f * log1pf(expf(-lam[ch])); bav[ec] = b_a[ch]; biv[ec] = b_i[ch]; }
    for (int c = idx, round = 0; c < 64; c += gs, ++round) {
        asm volatile("" ::: "memory");
        PROF_BEGIN(3);
        const size_t mrow0 = (size_t)b * SEQ + 64 * c;
#pragma unroll
        for (int i = 0; i < 9; ++i) { const int row = i * 8 + tg, tok = 64 * c - 3 + row; v4u v = {0u, 0u, 0u, 0u};
            if (row < 67 && tok >= 0) v = *(const v4u*)(UX + ((size_t)b * SEQ + tok) * DR + 64 * h + 8 * dg);
            if (row < 68) *(LAS v4u*)(UXT + row * 128 + dg * 16) = v; }
        pg8::bf16x8 bfr[2][4];
#pragma unroll
        for (int g = 0; g < 2; ++g)
#pragma unroll
            for (int ks = 0; ks < 4; ++ks) bfr[g][ks] = *(const pg8::bf16x8*)(WGT + ((size_t)(h * 128 + 64 * g + j)) * 64 + 16 * ks + 8 * hh);
        {
            f32x4 w4a[4], w4b[4];
#pragma unroll
            for (int k = 0; k < 4; ++k) { w4a[k] = *(const f32x4*)(rw + k * DR + 64 * h + 8 * dg); w4b[k] = *(const f32x4*)(rw + k * DR + 64 * h + 8 * dg + 4); }
            const f32x4 rb0 = *(const f32x4*)(rb + 64 * h + 8 * dg), rb1 = *(const f32x4*)(rb + 64 * h + 8 * dg + 4);
#pragma unroll
            for (int th = 0; th < 2; ++th) {
                f32x4 o0[4], o1[4];
#pragma unroll
                for (int t = 0; t < 4; ++t) { o0[t] = rb0; o1[t] = rb1; }
#pragma unroll
                for (int i = 0; i < 7; ++i) { const v4u v = *(const LAS v4u*)(UXT + (8 * tg + 4 * th + i) * 128 + dg * 16);
                    const f32x4 x0 = {bflo(v.x), bfhi(v.x), bflo(v.y), bfhi(v.y)}, x1 = {bflo(v.z), bfhi(v.z), bflo(v.w), bfhi(v.w)};
#pragma unroll
                    for (int k = 0; k < 4; ++k) { const int t = i - k; if (t >= 0 && t < 4) { o0[t] += w4a[k] * x0; o1[t] += w4b[k] * x1; } } }
#pragma unroll
                for (int t = 0; t < 4; ++t) *(LAS v4u*)(XRT + (8 * tg + 4 * th + t) * 128 + dg * 16) = pack8(o0[t], o1[t]);
            }
        }
        PROF_END(3);
#pragma unroll
        for (int ec = 0; ec < 2; ++ec) {
            PROF_BEGIN(4);
            const int ch = 64 * h + 32 * ec + j;
            const float c8 = c8v[ec], ba = bav[ec], bi = biv[ec];
            unsigned* cw = cnt + 64 * (8 * ec + b);
            f32x16 av[2], bv[2];
#pragma unroll
            for (int tt = 0; tt < 2; ++tt) {
                pg8::bf16x8 afr[4];
#pragma unroll
                for (int ks = 0; ks < 4; ++ks) afr[ks] = *(const LAS pg8::bf16x8*)(XRT + (32 * tt + j) * 128 + (16 * ks + 8 * hh) * 2);
                f32x16 pa, pi;
#pragma unroll
                for (int r = 0; r < 16; ++r) { pa[r] = 0.f; pi[r] = 0.f; }
#pragma unroll
                for (int ks = 0; ks < 4; ++ks) {
                    pa = __builtin_amdgcn_mfma_f32_32x32x16_bf16(afr[ks], bfr[0][ks], pa, 0, 0, 0);
                    pi = __builtin_amdgcn_mfma_f32_32x32x16_bf16(afr[ks], bfr[1][ks], pi, 0, 0, 0); }
                if (ec == 0 && tt == 1) {
#pragma unroll
                    for (int g = 0; g < 2; ++g)
#pragma unroll
                        for (int ks = 0; ks < 4; ++ks) bfr[g][ks] = *(const pg8::bf16x8*)(WGT + ((size_t)(h * 128 + 64 * g + 32 + j)) * 64 + 16 * ks + 8 * hh);
                }
                gate_math16(pa, pi, ba, bi, c8, av[tt], bv[tt]);
                {
                    f32x16 px;
#pragma unroll
                    for (int r = 0; r < 16; ++r) px[r] = bv[tt][r] * 0.f;
                    int dd = 32 * ec + j - 8 * hh; asm volatile("" : "+v"(dd));
                    const unsigned one = (dd & 1) ? 0x3F800000u : 0x00003F80u;
#pragma unroll
                    for (int ks = 0; ks < 4; ++ks) {
                        const int dw = (dd - 16 * ks) >> 1;
                        v4u idw; idw.x = dw == 0 ? one : 0u; idw.y = dw == 1 ? one : 0u; idw.z = dw == 2 ? one : 0u; idw.w = dw == 3 ? one : 0u;
                        px = __builtin_amdgcn_mfma_f32_32x32x16_bf16(afr[ks], __builtin_bit_cast(pg8::bf16x8, idw), px, 0, 0, 0); }
#pragma unroll
                    for (int r = 0; r < 16; ++r) bv[tt][r] *= px[r];
                }
            }
            float GA[2][4], GB[2][4], PA[2][4], PB[2][4];
            float At = 1.f, Bt = 0.f;
#pragma unroll
            for (int tt = 0; tt < 2; ++tt)
#pragma unroll
                for (int q = 0; q < 4; ++q) { const float a0 = av[tt][4 * q], a1 = av[tt][4 * q + 1], a2 = av[tt][4 * q + 2], a3 = av[tt][4 * q + 3];
                    const float b0 = bv[tt][4 * q], b1 = bv[tt][4 * q + 1], b2 = bv[tt][4 * q + 2], b3 = bv[tt][4 * q + 3];
                    GA[tt][q] = (a0 * a1) * (a2 * a3); GB[tt][q] = ((b0 * a1 + b1) * a2 + b2) * a3 + b3;
                    PA[tt][q] = __shfl_xor(GA[tt][q], 32); PB[tt][q] = __shfl_xor(GB[tt][q], 32);
                    const float A0 = hh ? PA[tt][q] : GA[tt][q], B0 = hh ? PB[tt][q] : GB[tt][q], A1 = hh ? GA[tt][q] : PA[tt][q], B1 = hh ? GB[tt][q] : PB[tt][q];
                    Bt = (Bt * A0 + B0) * A1 + B1; At = (At * A0) * A1; }
            if (hh == 0) __hip_atomic_store((gu64*)(TOT + ((size_t)b * 64 + c) * DR + ch), ((unsigned long long)__float_as_uint(Bt) << 32) | (__float_as_uint(At) | 0x80000000u), RLX_AGENT);
            PROF_END(4); PROF_BEGIN(7);
            if (ec == 0) {
#pragma unroll
                for (int i = 0; i < 8; ++i) *(LAS v4u*)(UXT + (i * 8 + tg) * 128 + dg * 16) = *(const v4u*)(GY + (mrow0 + i * 8 + tg) * DR + 64 * h + 8 * dg);
            }
            PROF_END(7);
            PROF_BEGIN(2);
            const gu64* tp = (const gu64*)(TOT + ((size_t)b * 64) * DR + ch);
            float hc;
            { const int cpre = round * gs < c ? round * gs : c;
                float Hp = 0.f;
                gu64* hp = (gu64*)(TOTH + ((size_t)b * 8 + (round > 0 ? round - 1 : 0)) * DR + ch);
                if (round > 0) { unsigned long long t = 0; for (unsigned sp = 0;; ++sp) { t = __hip_atomic_load(hp, RLX_AGENT); if ((unsigned)(t >> 32) || sp > (1u << 16)) break; __builtin_amdgcn_s_sleep(1); } Hp = __uint_as_float((unsigned)t); }
                float Aq, Bq; fold_chunks(tp, cpre, c, hh, Aq, Bq); hc = Hp * Aq + Bq; }
            PROF_END(2); PROF_BEGIN(5);
#pragma unroll
            for (int tt = 0; tt < 2; ++tt)
#pragma unroll
                for (int q = 0; q < 4; ++q) { const float A0 = hh ? PA[tt][q] : GA[tt][q], B0 = hh ? PB[tt][q] : GB[tt][q], A1 = hh ? GA[tt][q] : PA[tt][q], B1 = hh ? GB[tt][q] : PB[tt][q];
                    const float mid = hc * A0 + B0; float hv = hh ? mid : hc; hc = mid * A1 + B1;
#pragma unroll
                    for (int i = 0; i < 4; ++i) { hv = av[tt][4 * q + i] * hv + bv[tt][4 * q + i]; av[tt][4 * q + i] = hv; } }
            if (idx == gs - 1 && round < 8 && hh == 0) __hip_atomic_store((gu64*)(TOTH + ((size_t)b * 8 + round) * DR + ch), (0x80000000ull << 32) | __float_as_uint(hc), RLX_AGENT);
#pragma unroll
            for (int tt = 0; tt < 2; ++tt)
#pragma unroll
                for (int r = 0; r < 16; ++r) { const int tk = 32 * tt + (r & 3) + 8 * (r >> 2) + 4 * hh;
                    LAS u16* p = (LAS u16*)(UXT + tk * 128 + (32 * ec + j) * 2);
                    const float gy = __uint_as_float((unsigned)(*p) << 16);
                    *p = (u16)f2bf(gy * av[tt][r]); }
            PROF_END(5);
        }
        PROF_BEGIN(6);
#pragma unroll
        for (int i = 0; i < 8; ++i) { const int row = i * 8 + tg; *(v4u*)(YMIX + (mrow0 + row) * D + DC + 64 * h + 8 * dg) = *(const LAS v4u*)(UXT + row * 128 + dg * 16); }
        PROF_END(6);
    }
    __syncthreads();
}

struct Args { const float* in[27]; float* out; unsigned char* ws; int ph_lo, ph_hi; };
constexpr int NPH = 10;
#ifndef MK_PER_PHASE
#define MK_PER_PHASE 0
#endif
#define MK_STR2(x) #x
#define MK_STR(x) MK_STR2(x)
#ifndef MK_REP_P1X
#define MK_REP_P1X 1
#endif
#ifndef MK_REP_P1B
#define MK_REP_P1B 1
#endif
#ifndef MK_REP_GEMV
#define MK_REP_GEMV 1
#endif
#ifndef MK_REP_QUANT
#define MK_REP_QUANT 1
#endif
#ifndef MK_REP_TRANS
#define MK_REP_TRANS 1
#endif
#ifndef MK_REP_LO
#define MK_REP_LO 0
#define MK_REP_HI 0
#endif

__global__ void __launch_bounds__(NWAVES * 64, 2) mk_fwd(Args args) {
    extern __shared__ __attribute__((aligned(16))) unsigned char lds_raw[];
    LAS unsigned char* lds = (LAS unsigned char*)lds_raw;
    const int tid = threadIdx.x, wave = __builtin_amdgcn_readfirstlane(tid >> 6);
#define LANE_HERE int lane; asm volatile("v_mbcnt_lo_u32_b32 %0, -1, 0\n\tv_mbcnt_hi_u32_b32 %0, -1, %0" : "=v"(lane))
    const int G = gridDim.x, bx = blockIdx.x;
    const int vcu = (G % 8 == 0) ? (bx % 8) * (G / 8) + bx / 8 : bx;
    const int gw = vcu * NWAVES + wave, NGW = G * NWAVES;
    unsigned char* ws = args.ws;
    gu32* ctl = (gu32*)(ws + WS_CTL);
    const float* x = args.in[0]; const float* cvec = args.in[1]; const float* w_mod = args.in[2]; const float* b_mod = args.in[3];
    const float* g1 = args.in[4]; const float* w1i = args.in[5]; const float* w1o = args.in[6]; const float* gm = args.in[7];
    const float* w_in = args.in[8]; const float* conv_w = args.in[9]; const float* conv_b = args.in[10]; const float* ln_g = args.in[11]; const float* ln_b = args.in[12];
    const float* rw = args.in[13]; const float* rb = args.in[14]; const float* wa = args.in[15]; const float* b_a = args.in[16];
    const float* wi = args.in[17]; const float* b_i = args.in[18]; const float* lam = args.in[19]; const float* w_out = args.in[20];
    const float* g2 = args.in[21]; const float* w2i = args.in[22]; const float* w2o = args.in[23]; const float* w_fmod = args.in[24];
    const float* b_fmod = args.in[25]; const float* gf = args.in[26];
    float* out = args.out;
    float* MOD = (float*)(ws + WS_MOD); float* SHMAX3 = (float*)(ws + WS_BIAS1); float* BIAS2 = (float*)(ws + WS_BIAS2);
    bf16* WGT = (bf16*)(ws + WS_WGT); f32x2* TOT = (f32x2*)(ws + WS_TOT); float* SSP = (float*)(ws + WS_SSP);
    bf16 *W1O = (bf16*)(ws + WS_W1O), *WIN = (bf16*)(ws + WS_WIN), *WOUT = (bf16*)(ws + WS_WOUT), *W2O = (bf16*)(ws + WS_W2O);
    unsigned char *W1O8F = ws + WS_W1O, *W2O8F = ws + WS_W2O, *W1I8 = ws + WS_W1I, *W2I8 = ws + WS_W2I, *WIN8 = ws + WS_WIN, *A8 = ws + WS_Y;
    float *CS1 = (float*)(ws + WS_CS1), *CS3 = (float*)(ws + WS_CS3), *CS2 = (float*)(ws + WS_CS2), *RS1 = (float*)(ws + WS_RS1), *RS3 = (float*)(ws + WS_RS3), *RS2 = (float*)(ws + WS_RS2);
    bf16 *Y = (bf16*)(ws + WS_Y), *ACT = (bf16*)(ws + WS_ACT), *U = (bf16*)(ws + WS_U), *UXB = (bf16*)(ws + WS_UX), *GYB = (bf16*)(ws + WS_GY), *YMIX = (bf16*)(ws + WS_YMIX);
    bf16* X1 = (bf16*)(ws + WS_X1);

    for (int u = tid; u < (LDS_BYTES - LDSCTL_OFF) / 4; u += NWAVES * 64) ((LAS unsigned*)(lds + LDSCTL_OFF))[u] = 0u;
    __syncthreads();
    const int lo = args.ph_lo, hi = args.ph_hi;
    const bool use_bar = (hi - lo) > 1;
    XcdBarrier bar; bar.bar = (unsigned*)(ctl + CW_BAR); bar.x = 0; bar.st = nullptr;
    if (use_bar) bar = xcd_barrier_post((unsigned*)(ctl + CW_BAR), (volatile LAS unsigned*)(lds + LDSCTL_OFF) + 8);
#define IN(k) (lo <= (k) && (k) < hi)
#define REPS(k) ((MK_REP_LO <= (k) && (k) < MK_REP_HI) ? 2 : 1)
#define AGAIN(k, rr) do { if ((rr) + 1 < REPS(k)) xcd_barrier(bar); } while (0)
#define SEAM(k) do { if (IN(k) && IN((k) + 1)) { PROF_BEGIN(8); PROF_BEGIN(9); xcd_barrier(bar); PROF_END(8); if ((k) == MK_PROF_SEAM) { PROF_END(9); } } } while (0)

    if (IN(0))
_Pragma("unroll")
    for (int rr = 0; rr < REPS(0); ++rr) { PROF_SETPH(0); PROF_BEGIN(15); LANE_HERE;
#ifdef MK_PAD
        asm volatile(".rept " MK_STR(MK_PAD) "\n\ts_nop 0\n\t.endr" ::: "memory");
#endif
        constexpr int NGEMV = 88, NQ = 2 * (FF2 / 32);
        constexpr int I_1O = (FF / 64) * (D / 32), I_IN = (D / 64) * (NMIX / 32), I_OUT = (D / 64) * (D / 32);
        constexpr int NITEMS = 2 * I_1O + I_IN + I_OUT, NGRP = NITEMS / NWAVES;
        static_assert(NITEMS % NWAVES == 0, "transpose groups");
        auto quant = [&](int it) { if (it < FF2 / 32) p0_quant_item(lds, w1i, FF2, 1, W1I8, CS1, it, lane, wave); else p0_quant_item(lds, w2i, FF2, 1, W2I8, CS3, it - FF2 / 32, lane, wave); };
        auto group = [&](int gidx) { LAS float* scr = (LAS float*)(lds + wave * 16384); const int r = gidx * NWAVES + wave;
            if (r < I_1O) p0_transpose8_item(w1o, FF, D, W1O8F, scr, r, lane);
            else if (r < 2 * I_1O) p0_transpose8_item(w2o, FF, D, W2O8F, scr, r - I_1O, lane);
            else if (r < 2 * I_1O + I_IN) p0_transpose_item(w_in, D, NMIX, WIN, 2, scr, r - 2 * I_1O, lane);
            else p0_transpose_item(w_out, D, D, WOUT, 0, scr, r - 2 * I_1O - I_IN, lane); };
        if (G == 256) {
            if (bx < NGEMV) {
                if (bx < 72) p0_gemv(lds, cvec, w_mod, 9 * D, b_mod, MOD, 128 * bx, tid); else p0_gemv(lds, cvec, w_fmod, 2 * D, b_fmod, MOD + 9 * D, 128 * (bx - 72), tid);
                quant(bx);
            } else { const int j = bx - NGEMV;
                quant(NGEMV + j);
                if (j < 96) { quant(256 + j); group(2 * j); group(2 * j + 1); }
                else { const int g0 = 192 + 5 * (j - 96);
                    for (int q = 0; q < 5; ++q) if (g0 + q < NGRP) group(g0 + q); }
            }
        } else {
            for (int t = bx; t < NGEMV; t += G) { if (t < 72) p0_gemv(lds, cvec, w_mod, 9 * D, b_mod, MOD, 128 * t, tid); else p0_gemv(lds, cvec, w_fmod, 2 * D, b_fmod, MOD + 9 * D, 128 * (t - 72), tid); }
            for (int t = bx; t < NQ; t += G) quant(t);
            for (int t = bx; t < NGRP; t += G) group(t);
        }
        __syncthreads();
        for (int i = bx * 512 + tid; i < NB * 64 * DR / 2; i += G * 512) ((v4u*)TOT)[i] = (v4u){0u, 0u, 0u, 0u};
        for (int i = bx * 512 + tid; i < NB * 8 * DR / 2; i += G * 512) ((v4u*)(ws + WS_TOTH))[i] = (v4u){0u, 0u, 0u, 0u};
        for (int i = bx * 512 + tid; i < NH * 128 * HD; i += G * 512) { const int d = i & 63, e2 = (i >> 6) & 127, hd = i >> 13;
            const float v = e2 < 64 ? wa[(hd * 64 + d) * 64 + e2] : wi[(hd * 64 + d) * 64 + (e2 - 64)]; WGT[i] = (bf16)f2bf(v); }
        PROF_END_PH(15);
        AGAIN(0, rr);
    }
    SEAM(0);
    if (IN(1))
_Pragma("unroll")
    for (int rr = 0; rr < REPS(1); ++rr) { PROF_SETPH(1); PROF_BEGIN(15); LANE_HERE;
        LAS float* shl = (LAS float*)lds;
        for (int i = tid * 4; i < 3 * NB * D; i += 2048) { const int t = i >> 13, r = i & 8191, b = r >> 10, k = r & 1023; *(LAS f32x4*)(shl + i) = *(const f32x4*)(MOD + (size_t)b * LDM + 3 * t * D + k); }
        __syncthreads();
        for (int rp = 0; rp < MK_REP_P1X; ++rp)
        for (int m0 = gw; m0 < M; m0 += 2 * NGW) {
            f32x4 v[2][4];
#pragma unroll
            for (int rr2 = 0; rr2 < 2; ++rr2) { const int m = (m0 + rr2 * NGW < M) ? m0 + rr2 * NGW : m0; const f32x4* xr = (const f32x4*)(x + (size_t)m * D) + lane;
#pragma unroll
                for (int jj = 0; jj < 4; ++jj) v[rr2][jj] = xr[64 * jj]; }
#pragma unroll
            for (int rr2 = 0; rr2 < 2; ++rr2) { const int m = m0 + rr2 * NGW; if (m < M) { const int b = m >> 12;
                float s = 0.f, am = 0.f;
#pragma unroll
                for (int jj = 0; jj < 4; ++jj) s += (v[rr2][jj][0] * v[rr2][jj][0] + v[rr2][jj][1] * v[rr2][jj][1]) + (v[rr2][jj][2] * v[rr2][jj][2] + v[rr2][jj][3] * v[rr2][jj][3]);
                const float rstd = rsqrtf(wave_sum(s) * (1.0f / D) + EPS);
#pragma unroll
                for (int jj = 0; jj < 4; ++jj) { const int k = 4 * lane + 256 * jj;
                    v[rr2][jj] = v[rr2][jj] * (*(const f32x4*)(g1 + k) * (*(const f32x4*)(MOD + (size_t)b * LDM + 1 * D + k) + 1.0f) * rstd) + *(const LAS f32x4*)(shl + (0 * NB + b) * D + k);
                    const f32x4 t = __builtin_elementwise_abs(v[rr2][jj]); am = fmaxf(am, fmaxf(fmaxf(t[0], t[1]), fmaxf(t[2], t[3]))); }
                am = wave_max(am);
                const float q = am > 0.f ? 127.0f / am : 0.f;
#pragma unroll
                for (int jj = 0; jj < 4; ++jj) *(unsigned*)(A8 + (size_t)m * D + 4 * lane + 256 * jj) = q8x4(v[rr2][jj] * q);
                if (lane == 0) RS1[m] = am * (1.0f / 127.0f); } }
        }
        for (int rp = 0; rp < MK_REP_P1B; ++rp)
        if (gw < NB) { float a = 0.f;
            for (int k = lane; k < D; k += 64) a = fmaxf(a, fabsf(shl[(2 * NB + gw) * D + k]));
            a = wave_max(a); if (lane == 0) SHMAX3[gw] = a; }
        for (int it = gw; it < NMIX; it += NGW) {
            {
                const bf16* wrow = WIN + (size_t)it * D; float* op = BIAS2 + it;
                const v4u wA = *(const v4u*)(wrow + 8 * lane), wB = *(const v4u*)(wrow + 512 + 8 * lane);
                f32x4 a0, a1, c0, c1; unpack8(wA, a0, a1); unpack8(wB, c0, c1);
#pragma unroll
                for (int b = 0; b < NB; ++b) { const LAS float* sp = shl + (1 * NB + b) * D + 8 * lane;
                    const f32x4 p = a0 * *(const LAS f32x4*)(sp) + a1 * *(const LAS f32x4*)(sp + 4) + c0 * *(const LAS f32x4*)(sp + 512) + c1 * *(const LAS f32x4*)(sp + 516);
                    const float tot = wave_sum((p[0] + p[1]) + (p[2] + p[3]));
                    if (lane == 0) op[(size_t)b * NMIX] = tot; }
            }
        }
        __syncthreads();
        PROF_END_PH(15);
        AGAIN(1, rr);
    }
    SEAM(1);
    if (IN(2))
_Pragma("unroll")
    for (int rr = 0; rr < REPS(2); ++rr) { PROF_SETPH(2); PROF_BEGIN(15);
        pg8::Gemm g{(const pg8::bf16_t*)A8, (const pg8::bf16_t*)W1I8, M, FF2, D / 2}; pg8::StaticOrder S; S.init(M, FF2, G, bx);
        EpiSwiglu8<true> E{ACT, RS1, CS1};
        pg8::gemm_phase<EpiSwiglu8<true>, pg8::StaticOrder, true, true, 1>(lds, g, S, E);
        PROF_END_PH(15);
        AGAIN(2, rr);
    }
    SEAM(2);
    if (IN(3))
_Pragma("unroll")
    for (int rr = 0; rr < REPS(3); ++rr) { PROF_SETPH(3); PROF_BEGIN(15);
        pg8::Gemm g{ACT, (const pg8::bf16_t*)W1O8F, M, D, FF / 2}; pg8::StaticOrder S; S.init(M, D, G, bx);
        EpiResid<1, true, false, true> E{x, X1, Y, SSP, MOD + 2 * D, gm, MOD + 4 * D};
        pg8::gemm_phase<EpiResid<1, true, false, true>, pg8::StaticOrder, true, true, 2>(lds, g, S, E);
        PROF_END_PH(15);
        AGAIN(3, rr);
    }
    SEAM(3);
    if (IN(4))
_Pragma("unroll")
    for (int rr = 0; rr < REPS(4); ++rr) { PROF_SETPH(4); PROF_BEGIN(15);
        pg8::Gemm g{Y, WIN, M, NMIX, D}; pg8::StaticOrder S; S.init(M, NMIX, G, bx);
        EpiMixIn E{U, UXB, GYB, SSP, BIAS2};
        pg8::gemm_phase<EpiMixIn, pg8::StaticOrder, true, true>(lds, g, S, E);
        PROF_END_PH(15);
        AGAIN(4, rr);
    }
    SEAM(4);
    if (IN(5))
_Pragma("unroll")
    for (int rr = 0; rr < REPS(5); ++rr) { PROF_SETPH(5); PROF_BEGIN(15); LANE_HERE;
        { PROF_BEGIN(0); mix_conv2(lds, U, conv_w, conv_b, ln_g, ln_b, YMIX, G, bx, tid, lane, wave); PROF_END(0); }
#ifdef MK_REP_CONV
        mix_conv2(lds, U, conv_w, conv_b, ln_g, ln_b, YMIX, G, bx, tid, lane, wave);
#endif
        { PROF_BEGIN(1); mix_scan1(lds, UXB, GYB, WGT, rw, rb, b_a, b_i, lam, TOT, (unsigned*)(ctl + CW_SCAN), YMIX, G, bx, lane, wave); PROF_END(1); }
        PROF_END_PH(15);
        AGAIN(5, rr);
    }
    SEAM(5);
    if (IN(7))
_Pragma("unroll")
    for (int rr = 0; rr < REPS(7); ++rr) { PROF_SETPH(7); PROF_BEGIN(15);
        pg8::Gemm g{YMIX, WOUT, M, D, D}; pg8::StaticOrder S; S.init(M, D, G, bx);
        EpiResidQ<0, true> E{X1, X1, A8, RS3, (f32x2*)(ws + WS_SSPX), MOD + 5 * D, g2, MOD + 7 * D, MOD + 6 * D, SHMAX3, (unsigned*)(ctl + CW_SEAM7)};
        pg8::gemm_phase<EpiResidQ<0, true>, pg8::StaticOrder, true, true>(lds, g, S, E);
        PROF_END_PH(15);
        AGAIN(7, rr);
    }
    SEAM(7);
    if (IN(8))
_Pragma("unroll")
    for (int rr = 0; rr < REPS(8); ++rr) { PROF_SETPH(8); PROF_BEGIN(15);
        pg8::Gemm g{(const pg8::bf16_t*)A8, (const pg8::bf16_t*)W2I8, M, FF2, D / 2}; pg8::StaticOrder S; S.init(M, FF2, G, bx);
        EpiSwiglu8<true> E{ACT, RS3, CS3};
        pg8::gemm_phase<EpiSwiglu8<true>, pg8::StaticOrder, true, true, 1>(lds, g, S, E);
        PROF_END_PH(15);
        AGAIN(8, rr);
    }
    SEAM(8);
    if (IN(9))
_Pragma("unroll")
    for (int rr = 0; rr < REPS(9); ++rr) { PROF_SETPH(9); PROF_BEGIN(15);
        pg8::Gemm g{ACT, (const pg8::bf16_t*)W2O8F, M, D, FF / 2}; pg8::StaticOrder S; S.init(M, D, G, bx);
        EpiResidFinal<true> E{X1, out, (float*)(ws + WS_SSPF), MOD + 8 * D, gf, MOD + 10 * D, MOD + 9 * D, (unsigned*)(ctl + CW_SEAM)};
        pg8::gemm_phase<EpiResidFinal<true>, pg8::StaticOrder, true, true, 2>(lds, g, S, E);
        PROF_END_PH(15);
    }
#ifdef MK_PROF_ID
    __syncthreads();
    if (bx == MK_PROF_WG && tid == 0) { const unsigned d = ((LAS unsigned*)(lds + LDSCTL_OFF))[40 + MK_PROF_ID]; const unsigned long long t0 = PROF_T(); while (PROF_T() - t0 < (unsigned long long)d * MK_PROF_K) __builtin_amdgcn_s_sleep(8); }
#endif
#undef IN
#undef SEAM
#undef REPS
#undef AGAIN
}

extern "C" void kernel_launch(void* const* d_in, const int* in_sizes, int n_in, void* d_out, int out_size, void* d_ws, size_t ws_size, hipStream_t stream) {
    static int grid = 0;
    if (grid == 0) {
        if (n_in != 27 || in_sizes[0] != M * D || out_size != M * D || ws_size < WS_END) { fprintf(stderr, "kernel_launch: unexpected shapes (n_in %d, in0 %d, out %d, ws %zu)\n", n_in, n_in > 0 ? in_sizes[0] : -1, out_size, ws_size); grid = -1; return; }
        int dev = 0, cus = 0, per_cu = 0;
        if (hipGetDevice(&dev) != hipSuccess || hipDeviceGetAttribute(&cus, hipDeviceAttributeMultiprocessorCount, dev) != hipSuccess) { grid = -1; return; }
        if (hipFuncSetAttribute((const void*)mk_fwd, hipFuncAttributeMaxDynamicSharedMemorySize, LDS_BYTES) != hipSuccess) { fprintf(stderr, "kernel_launch: hipFuncSetAttribute failed\n"); grid = -1; return; }
        if (hipOccupancyMaxActiveBlocksPerMultiprocessor(&per_cu, (const void*)mk_fwd, NWAVES * 64, LDS_BYTES) != hipSuccess || per_cu < 1) fprintf(stderr, "kernel_launch: occupancy query reports %d blocks per CU\n", per_cu);
        (void)hipGetLastError();
        grid = cus;
        if (grid % 8 != 0 || grid < 8) { fprintf(stderr, "kernel_launch: %d CUs: the scan's chunk rounds need a multiple of 8 workgroups\n", grid); grid = -1; return; }
    }
    if (grid < 0) return;
    if (hipMemsetAsync((char*)d_ws + WS_CTL, 0, CTL_ZERO_BYTES, stream) != hipSuccess) return;
    Args a{};
    for (int i = 0; i < 27; ++i) a.in[i] = (const float*)d_in[i];
    a.out = (float*)d_out; a.ws = (unsigned char*)d_ws;
#if MK_PER_PHASE
    for (int p = 0; p < NPH; ++p) { a.ph_lo = p; a.ph_hi = p + 1; hipLaunchKernelGGL(mk_fwd, dim3(grid), dim3(NWAVES * 64), LDS_BYTES, stream, a); }
#else
    a.ph_lo = 0; a.ph_hi = NPH; hipLaunchKernelGGL(mk_fwd, dim3(grid), dim3(NWAVES * 64), LDS_BYTES, stream, a);
#endif
}
```
